# Optimizing an MI355X kernel written in HIP

```python
import math
import jax, jax.numpy as jnp
from jax import lax
import numpy as np

D_MODEL = 1024
BATCH = 16
SEQ = 256
DEPTH = 2
DEC_BATCH = 4
DEC_SEQ = 1024
PAST_LEN = 256

GRID_W = 64
HEAD_DIM = 64
N_EVEN = (DEPTH + 1) // 2
N_ODD = DEPTH // 2
A_HEADS = 8
A_KV_HEADS = 2
A_GROUP = A_HEADS // A_KV_HEADS
B_HEADS = 8
B_DK = 64
B_DV = 64
C_HEADS = 4
C_VDIM = 2 * HEAD_DIM
D_HEADS = 8
D_KV_HEADS = 2
D_GROUP = D_HEADS // D_KV_HEADS
WINDOW = 128
Q_BLOCK = 128
RET_CHUNK = 128
ROPE_BASE = 10000.0
ROPE_PAIRS = HEAD_DIM // 4
EVEN_WIDTHS = (A_HEADS * HEAD_DIM, A_KV_HEADS * HEAD_DIM, A_KV_HEADS * HEAD_DIM,
               B_HEADS * B_DK, B_HEADS * B_DK, B_HEADS * B_DV, B_HEADS * B_DV)
EVEN_IN = A_HEADS * HEAD_DIM + 2 * A_KV_HEADS * HEAD_DIM + 2 * B_HEADS * B_DK + 2 * B_HEADS * B_DV
ODD_WIDTHS = (C_HEADS * 2 * HEAD_DIM, C_HEADS * 2 * HEAD_DIM, C_HEADS * C_VDIM,
              D_HEADS * HEAD_DIM, D_KV_HEADS * HEAD_DIM, D_KV_HEADS * HEAD_DIM)
ODD_IN = 4 * C_HEADS * HEAD_DIM + C_HEADS * C_VDIM + D_HEADS * HEAD_DIM + 2 * D_KV_HEADS * HEAD_DIM
MIX_WIDTH = A_HEADS * HEAD_DIM + B_HEADS * B_DV
PEER_HEADS = 8
PEER_NKEYS = 128
PEER_N = PEER_NKEYS * PEER_NKEYS
PEER_TOPK = 16
PEER_QDIM = 256
PEER_HALF = PEER_QDIM // 2
PEER_BLOCK = 128
EPS = 1e-6
NEG_INF = -1e30
F32 = jnp.float32

kernel_name = 'hybrid_diffusion_prefix_step'


def rmsnorm(x, g):
    xf = x.astype(F32)
    y = xf * lax.rsqrt(jnp.mean(xf * xf, axis=-1, keepdims=True) + EPS)
    return (y * g.astype(F32)).astype(x.dtype)


def head_norm(x):
    xf = x.astype(F32)
    mu = jnp.mean(xf, axis=-1, keepdims=True)
    var = jnp.mean(jnp.square(xf - mu), axis=-1, keepdims=True)
    return (xf - mu) * lax.rsqrt(var + EPS)


def ada(x, gain, shift, scale):
    return rmsnorm(x, gain) * (1.0 + scale[:, None, :]) + shift[:, None, :]


def split_cols(t, widths):
    points, acc = [], 0
    for w in widths[:-1]:
        acc += w
        points.append(acc)
    return jnp.split(t, points, axis=-1)


def to_heads(t, n_heads):
    bsz, L, _ = t.shape
    return t.reshape(bsz, L, n_heads, -1).transpose(0, 2, 1, 3)


def axial_rope_tables(n_tokens):
    rows = n_tokens // GRID_W
    row = jnp.repeat(jnp.arange(rows, dtype=F32), GRID_W)
    col = jnp.tile(jnp.arange(GRID_W, dtype=F32), rows)
    inv = ROPE_BASE ** (-jnp.arange(ROPE_PAIRS, dtype=F32) / ROPE_PAIRS)
    ang = jnp.concatenate([row[:, None] * inv, col[:, None] * inv], axis=-1)
    return jnp.cos(ang), jnp.sin(ang)


def apply_rope(x, cos, sin):
    half = x.shape[-1] // 2
    x1 = x[..., :half].astype(F32)
    x2 = x[..., half:].astype(F32)
    return jnp.concatenate([x1 * cos - x2 * sin, x1 * sin + x2 * cos], axis=-1).astype(x.dtype)


def block_attn(q, k, v, sink=None):
    bsz, hkv, grp, lq, d = q.shape
    nb = lq // Q_BLOCK
    scale = d ** -0.5
    qs = jnp.moveaxis(q.reshape(bsz, hkv, grp, nb, Q_BLOCK, d), 3, 0)

    def one_block(qb):
        s = jnp.einsum('bhgqd,bhkd->bhgqk', qb, k).astype(F32) * scale
        if sink is not None:
            s0 = jnp.broadcast_to(sink.astype(F32)[None, :, :, None, None], (bsz, hkv, grp, Q_BLOCK, 1))
            s = jnp.concatenate([s0, s], axis=-1)
        p = jax.nn.softmax(s, axis=-1)
        if sink is not None:
            p = p[..., 1:]
        return jnp.einsum('bhgqk,bhkd->bhgqd', p.astype(v.dtype), v)

    o = lax.map(one_block, qs)
    return jnp.moveaxis(o, 0, 3).reshape(bsz, hkv, grp, lq, d)


def diff_attn(q, k, v, lam):
    bsz, h, _, lq, d = q.shape
    nb = lq // Q_BLOCK
    qs = jnp.moveaxis(q.reshape(bsz, h, 2, nb, Q_BLOCK, d), 3, 0)

    def one_block(qb):
        s = jnp.einsum('bhcqd,bhckd->bhcqk', qb, k).astype(F32) * (d ** -0.5)
        p = jax.nn.softmax(s, axis=-1)
        a = p[:, :, 0] - lam * p[:, :, 1]
        return jnp.einsum('bhqk,bhkv->bhqv', a.astype(v.dtype), v)

    o = lax.map(one_block, qs)
    return jnp.moveaxis(o, 0, 2).reshape(bsz, h, lq, v.shape[-1])


def window_attn(q, k, v, k_ctx, v_ctx, sink):
    bsz, hkv, grp, L, d = q.shape
    nb = L // Q_BLOCK
    lc = k_ctx.shape[2]
    scale = d ** -0.5
    qb = q.reshape(bsz, hkv, grp, nb, Q_BLOCK, d)

    def band(t):
        tp = jnp.pad(t, ((0, 0), (0, 0), (Q_BLOCK, Q_BLOCK), (0, 0))).reshape(bsz, hkv, nb + 2, Q_BLOCK, d)
        return jnp.concatenate([tp[:, :, :-2], tp[:, :, 1:-1], tp[:, :, 2:]], axis=3)

    kb, vb = band(k), band(v)
    qi = jnp.arange(Q_BLOCK)
    kj = jnp.arange(3 * Q_BLOCK)
    rel = qi[:, None] + Q_BLOCK - kj[None, :]
    key_pos = jnp.arange(nb)[:, None] * Q_BLOCK - Q_BLOCK + kj[None, :]
    mask = (jnp.abs(rel) <= WINDOW)[None] & ((key_pos >= 0) & (key_pos < L))[:, None, :]
    s_band = jnp.where(mask, jnp.einsum('bhgnqd,bhnkd->bhgnqk', qb, kb).astype(F32) * scale, NEG_INF)
    s_ctx = jnp.einsum('bhgnqd,bhcd->bhgnqc', qb, k_ctx).astype(F32) * scale
    s_sink = jnp.broadcast_to(sink.astype(F32)[None, :, :, None, None, None], (bsz, hkv, grp, nb, Q_BLOCK, 1))
    p = jax.nn.softmax(jnp.concatenate([s_sink, s_ctx, s_band], axis=-1), axis=-1)
    o = (jnp.einsum('bhgnqc,bhcd->bhgnqd', p[..., 1:1 + lc].astype(v.dtype), v_ctx)
         + jnp.einsum('bhgnqk,bhnkd->bhgnqd', p[..., 1 + lc:].astype(v.dtype), vb))
    return o.reshape(bsz, hkv, grp, L, d)


def retention(q, k, v, log_gamma, s0, inclusive):
    bsz, h, L, _ = q.shape
    dv = v.shape[-1]
    n = L // RET_CHUNK
    idx = jnp.arange(RET_CHUNK, dtype=F32)
    diff = idx[:, None] - idx[None, :]
    keep = (diff >= 0) if inclusive else (diff > 0)
    intra = jnp.where(keep, jnp.exp(jnp.where(keep, diff, 0.0) * log_gamma[:, None, None]), 0.0)
    q_dec = jnp.exp((idx + 1.0) * log_gamma[:, None])
    k_dec = jnp.exp((RET_CHUNK - 1.0 - idx) * log_gamma[:, None])
    c_dec = jnp.exp(RET_CHUNK * log_gamma)

    def chunks(t):
        return jnp.moveaxis(t.astype(F32).reshape(bsz, h, n, RET_CHUNK, t.shape[-1]), 2, 0)

    def step(s, blk):
        qc, kc, vc = blk
        o = (jnp.einsum('bhqk,bhkv->bhqv', jnp.einsum('bhqd,bhkd->bhqk', qc, kc) * intra, vc)
             + jnp.einsum('bhqd,bhdv->bhqv', qc * q_dec[..., None], s))
        s = s * c_dec[:, None, None] + jnp.einsum('bhkd,bhkv->bhdv', kc * k_dec[..., None], vc)
        return s, o

    s, o = lax.scan(step, s0.astype(F32), (chunks(q), chunks(k), chunks(v)))
    return jnp.moveaxis(o, 0, 2).reshape(bsz, h, L, dv), s


def even_mixer(h, w_in, w_out, q_gain, k_gain, decay_fwd, decay_bwd, cache):
    bsz, L, _ = h.shape
    aq, ak, av, rq, rk, rv, rg = split_cols(h @ w_in, EVEN_WIDTHS)
    aq = rmsnorm(aq.reshape(bsz, L, A_KV_HEADS, A_GROUP, HEAD_DIM), q_gain).transpose(0, 2, 3, 1, 4)
    ak = rmsnorm(ak.reshape(bsz, L, A_KV_HEADS, HEAD_DIM), k_gain).transpose(0, 2, 1, 3)
    av = av.reshape(bsz, L, A_KV_HEADS, HEAD_DIM).transpose(0, 2, 1, 3)
    rq = to_heads(rq, B_HEADS)
    rk = to_heads(rk, B_HEADS) * (B_DK ** -0.5)
    rv = to_heads(rv, B_HEADS)
    lg_f = jax.nn.log_sigmoid(decay_fwd.astype(F32))
    lg_b = jax.nn.log_sigmoid(decay_bwd.astype(F32))
    if cache is None:
        a_out = block_attn(aq, ak, av)
        s0_f = jnp.zeros((bsz, B_HEADS, B_DK, B_DV), F32)
        s0_b = jnp.zeros((bsz, B_HEADS, B_DK, B_DV), F32)
    else:
        ck, cv, s0_f, s0_b = cache
        cos, sin = axial_rope_tables(L)
        a_out = block_attn(apply_rope(aq, cos, sin),
                           jnp.concatenate([ck, apply_rope(ak, cos, sin)], axis=2),
                           jnp.concatenate([cv, av], axis=2))
    o_f, s_f = retention(rq, rk, rv, lg_f, s0_f, True)
    o_b, s_b = retention(rq[:, :, ::-1], rk[:, :, ::-1], rv[:, :, ::-1], lg_b, s0_b, False)
    r = head_norm(o_f + o_b[:, :, ::-1]).astype(h.dtype)
    r = r.transpose(0, 2, 1, 3).reshape(bsz, L, B_HEADS * B_DV) * jax.nn.silu(rg)
    a_out = a_out.transpose(0, 3, 1, 2, 4).reshape(bsz, L, A_HEADS * HEAD_DIM)
    out = jnp.concatenate([a_out, r], axis=-1) @ w_out
    if cache is None:
        return out, (ak, av, s_f.astype(h.dtype), s_b.astype(h.dtype))
    return out, None


def odd_mixer(h, w_in, w_out, lq1, lk1, lq2, lk2, subln, sink, lam_init, cache):
    bsz, L, _ = h.shape
    cq, ck, cv, dq, dk, dv = split_cols(h @ w_in, ODD_WIDTHS)
    cq = cq.reshape(bsz, L, C_HEADS, 2, HEAD_DIM).transpose(0, 2, 3, 1, 4)
    ck = ck.reshape(bsz, L, C_HEADS, 2, HEAD_DIM).transpose(0, 2, 3, 1, 4)
    cv = cv.reshape(bsz, L, C_HEADS, C_VDIM).transpose(0, 2, 1, 3)
    dq = dq.reshape(bsz, L, D_KV_HEADS, D_GROUP, HEAD_DIM).transpose(0, 2, 3, 1, 4)
    dk = dk.reshape(bsz, L, D_KV_HEADS, HEAD_DIM).transpose(0, 2, 1, 3)
    dv = dv.reshape(bsz, L, D_KV_HEADS, HEAD_DIM).transpose(0, 2, 1, 3)
    lam = (jnp.exp(jnp.sum(lq1.astype(F32) * lk1.astype(F32)))
           - jnp.exp(jnp.sum(lq2.astype(F32) * lk2.astype(F32))) + lam_init)
    sink = sink.reshape(D_KV_HEADS, D_GROUP)
    if cache is None:
        c_out = diff_attn(cq, ck, cv, lam)
        d_out = block_attn(dq, dk, dv, sink)
        new_ctx = (ck.reshape(bsz, 2 * C_HEADS, L, HEAD_DIM), cv, dk, dv)
    else:
        cache_ck, cache_cv, cache_dk, cache_dv = cache
        lc = cache_ck.shape[2]
        cos, sin = axial_rope_tables(L)
        c_out = diff_attn(apply_rope(cq, cos, sin),
                          jnp.concatenate([cache_ck.reshape(bsz, C_HEADS, 2, lc, HEAD_DIM), apply_rope(ck, cos, sin)], axis=3),
                          jnp.concatenate([cache_cv, cv], axis=2), lam)
        d_out = window_attn(apply_rope(dq, cos, sin), apply_rope(dk, cos, sin), dv, cache_dk, cache_dv, sink)
        new_ctx = None
    c_out = rmsnorm(c_out, subln) * (1.0 - lam_init)
    c_out = c_out.transpose(0, 2, 1, 3).reshape(bsz, L, C_HEADS * C_VDIM)
    d_out = d_out.transpose(0, 3, 1, 2, 4).reshape(bsz, L, D_HEADS * HEAD_DIM)
    out = jnp.concatenate([c_out, d_out], axis=-1) @ w_out
    return out, new_ctx


def peer(h, w_q, sub_keys, u, v):
    bsz, L, dm = h.shape
    t = bsz * L
    x = h.reshape(t, dm)
    q = (x @ w_q).reshape(t, PEER_HEADS, 2, PEER_HALF)
    s = jnp.einsum('thcd,hcnd->thcn', q, sub_keys).astype(F32)
    s1, i1 = lax.top_k(s[:, :, 0], PEER_TOPK)
    s2, i2 = lax.top_k(s[:, :, 1], PEER_TOPK)
    cand = (s1[..., :, None] + s2[..., None, :]).reshape(t, PEER_HEADS, PEER_TOPK * PEER_TOPK)
    cidx = (i1[..., :, None] * PEER_NKEYS + i2[..., None, :]).reshape(t, PEER_HEADS, PEER_TOPK * PEER_TOPK)
    top_s, pos = lax.top_k(cand, PEER_TOPK)
    idx = jnp.take_along_axis(cidx, pos, axis=-1)
    g = jax.nn.softmax(top_s, axis=-1)
    nblk = t // PEER_BLOCK

    def one_block(blk):
        xb, ib, gb = blk
        a = jnp.einsum('td,thkd->thk', xb, u[ib])
        w = (gb * jax.nn.gelu(a.astype(F32))).astype(v.dtype)
        return jnp.einsum('thk,thkd->td', w, v[ib])

    out = lax.map(one_block, (x.reshape(nblk, PEER_BLOCK, dm),
                              idx.reshape(nblk, PEER_BLOCK, PEER_HEADS, PEER_TOPK),
                              g.reshape(nblk, PEER_BLOCK, PEER_HEADS, PEER_TOPK)))
    return out.reshape(bsz, L, dm)


def setup_inputs(seed: int = 0) -> dict:
    key = jax.random.key(seed)
    ks = iter(jax.random.split(key, 48))

    def nrm(shape, s):
        return s * jax.random.normal(next(ks), shape, F32)

    gam = 1.0 - 2.0 ** (-5.0 - np.arange(B_HEADS, dtype=np.float32))
    decay_logit = jnp.asarray(np.log(gam / (1.0 - gam)), dtype=F32)
    return {
        'x_prompt': nrm((BATCH, SEQ, D_MODEL), 1.0),
        'x_sample': nrm((DEC_BATCH, DEC_SEQ, D_MODEL), 1.0),
        'c': nrm((DEC_BATCH, D_MODEL), 1.0),
        'c_ctx': nrm((D_MODEL,), 1.0),
        'cache_a_k': nrm((DEC_BATCH, N_EVEN, A_KV_HEADS, PAST_LEN, HEAD_DIM), 1.0),
        'cache_a_v': nrm((DEC_BATCH, N_EVEN, A_KV_HEADS, PAST_LEN, HEAD_DIM), 1.0),
        'state_ret_fwd': nrm((DEC_BATCH, N_EVEN, B_HEADS, B_DK, B_DV), 0.5),
        'state_ret_bwd': nrm((DEC_BATCH, N_EVEN, B_HEADS, B_DK, B_DV), 0.5),
        'cache_c_k': nrm((DEC_BATCH, N_ODD, 2 * C_HEADS, PAST_LEN, HEAD_DIM), 1.0),
        'cache_c_v': nrm((DEC_BATCH, N_ODD, C_HEADS, PAST_LEN, C_VDIM), 1.0),
        'cache_d_k': nrm((DEC_BATCH, N_ODD, D_KV_HEADS, PAST_LEN, HEAD_DIM), 1.0),
        'cache_d_v': nrm((DEC_BATCH, N_ODD, D_KV_HEADS, PAST_LEN, HEAD_DIM), 1.0),
        'mod_w': nrm((DEPTH, D_MODEL, 6 * D_MODEL), 0.5 * D_MODEL ** -0.5),
        'mod_b': nrm((DEPTH, 6 * D_MODEL), 0.01),
        'norm_mix': 1.0 + nrm((DEPTH, D_MODEL), 0.05),
        'norm_ffn': 1.0 + nrm((DEPTH, D_MODEL), 0.05),
        'norm_final': 1.0 + nrm((D_MODEL,), 0.05),
        'ev_w_in': nrm((N_EVEN, D_MODEL, EVEN_IN), D_MODEL ** -0.5),
        'ev_w_out': nrm((N_EVEN, MIX_WIDTH, D_MODEL), MIX_WIDTH ** -0.5),
        'a_q_norm': 1.0 + nrm((N_EVEN, HEAD_DIM), 0.05),
        'a_k_norm': 1.0 + nrm((N_EVEN, HEAD_DIM), 0.05),
        'ret_decay_fwd': decay_logit + nrm((N_EVEN, B_HEADS), 0.05),
        'ret_decay_bwd': decay_logit + nrm((N_EVEN, B_HEADS), 0.05),
        'od_w_in': nrm((N_ODD, D_MODEL, ODD_IN), D_MODEL ** -0.5),
        'od_w_out': nrm((N_ODD, MIX_WIDTH, D_MODEL), MIX_WIDTH ** -0.5),
        'c_lambda_q1': nrm((N_ODD, HEAD_DIM), 0.1),
        'c_lambda_k1': nrm((N_ODD, HEAD_DIM), 0.1),
        'c_lambda_q2': nrm((N_ODD, HEAD_DIM), 0.1),
        'c_lambda_k2': nrm((N_ODD, HEAD_DIM), 0.1),
        'c_subln': 1.0 + nrm((N_ODD, C_VDIM), 0.05),
        'd_sink': nrm((N_ODD, D_HEADS), 0.5),
        'peer_w_q': nrm((DEPTH, D_MODEL, PEER_HEADS * PEER_QDIM), D_MODEL ** -0.5),
        'peer_subkeys': nrm((DEPTH, PEER_HEADS, 2, PEER_NKEYS, PEER_HALF), PEER_HALF ** -0.5),
        'peer_u': nrm((DEPTH, PEER_N, D_MODEL), D_MODEL ** -0.5),
        'peer_v': nrm((DEPTH, PEER_N, D_MODEL), 0.25),
    }


def reference(x_prompt, x_sample, c, c_ctx,
              cache_a_k, cache_a_v, state_ret_fwd, state_ret_bwd,
              cache_c_k, cache_c_v, cache_d_k, cache_d_v,
              mod_w, mod_b, norm_mix, norm_ffn, norm_final,
              ev_w_in, ev_w_out, a_q_norm, a_k_norm, ret_decay_fwd, ret_decay_bwd,
              od_w_in, od_w_out, c_lambda_q1, c_lambda_k1, c_lambda_q2, c_lambda_k2, c_subln, d_sink,
              peer_w_q, peer_subkeys, peer_u, peer_v):
    xp, xs = x_prompt, x_sample
    new_ak, new_av, new_sf, new_sb = [], [], [], []
    new_ck, new_cv, new_dk, new_dv = [], [], [], []
    for layer in range(DEPTH):
        e = layer // 2
        mod_p = jnp.split(jax.nn.silu(c_ctx)[None, :] @ mod_w[layer] + mod_b[layer], 6, axis=-1)
        mod_s = jnp.split(jax.nn.silu(c) @ mod_w[layer] + mod_b[layer], 6, axis=-1)
        hp = ada(xp, norm_mix[layer], mod_p[0], mod_p[1])
        hs = ada(xs, norm_mix[layer], mod_s[0], mod_s[1])
        if layer % 2 == 0:
            out_p, ctx = even_mixer(hp, ev_w_in[e], ev_w_out[e], a_q_norm[e], a_k_norm[e],
                                    ret_decay_fwd[e], ret_decay_bwd[e], None)
            new_ak.append(ctx[0]); new_av.append(ctx[1]); new_sf.append(ctx[2]); new_sb.append(ctx[3])
            out_s, _ = even_mixer(hs, ev_w_in[e], ev_w_out[e], a_q_norm[e], a_k_norm[e],
                                  ret_decay_fwd[e], ret_decay_bwd[e],
                                  (cache_a_k[:, e], cache_a_v[:, e], state_ret_fwd[:, e], state_ret_bwd[:, e]))
        else:
            lam_init = 0.8 - 0.6 * math.exp(-0.3 * layer)
            out_p, ctx = odd_mixer(hp, od_w_in[e], od_w_out[e], c_lambda_q1[e], c_lambda_k1[e],
                                   c_lambda_q2[e], c_lambda_k2[e], c_subln[e], d_sink[e], lam_init, None)
            new_ck.append(ctx[0]); new_cv.append(ctx[1]); new_dk.append(ctx[2]); new_dv.append(ctx[3])
            out_s, _ = odd_mixer(hs, od_w_in[e], od_w_out[e], c_lambda_q1[e], c_lambda_k1[e],
                                 c_lambda_q2[e], c_lambda_k2[e], c_subln[e], d_sink[e], lam_init,
                                 (cache_c_k[:, e], cache_c_v[:, e], cache_d_k[:, e], cache_d_v[:, e]))
        xp = xp + mod_p[2][:, None, :] * out_p
        xs = xs + mod_s[2][:, None, :] * out_s
        xp = xp + mod_p[5][:, None, :] * peer(ada(xp, norm_ffn[layer], mod_p[3], mod_p[4]),
                                              peer_w_q[layer], peer_subkeys[layer], peer_u[layer], peer_v[layer])
        xs = xs + mod_s[5][:, None, :] * peer(ada(xs, norm_ffn[layer], mod_s[3], mod_s[4]),
                                              peer_w_q[layer], peer_subkeys[layer], peer_u[layer], peer_v[layer])
    y_prompt = rmsnorm(xp, norm_final)
    y_sample = rmsnorm(xs, norm_final)
    new_a_k = jnp.stack(new_ak, axis=1)
    new_a_v = jnp.stack(new_av, axis=1)
    new_ret_fwd = jnp.stack(new_sf, axis=1)
    new_ret_bwd = jnp.stack(new_sb, axis=1)
    new_c_k = jnp.stack(new_ck, axis=1)
    new_c_v = jnp.stack(new_cv, axis=1)
    new_d_k = jnp.stack(new_dk, axis=1)
    new_d_v = jnp.stack(new_dv, axis=1)
    return (y_prompt, y_sample, new_a_k, new_a_v, new_ret_fwd, new_ret_bwd, new_c_k, new_c_v, new_d_k, new_d_v)
```

```cpp
#include <hip/hip_runtime.h>
#include <hip/hip_cooperative_groups.h>
#include <cstdio>
namespace cg = cooperative_groups;

#ifndef MULTI_LAUNCH
#define MULTI_LAUNCH 0
#endif

typedef unsigned short u16;
typedef __attribute__((ext_vector_type(8))) short bf16x8;
typedef __attribute__((ext_vector_type(16))) float f32x16;
typedef __attribute__((ext_vector_type(4))) unsigned u32x4;

#define DEV __device__ __forceinline__

constexpr size_t OUT_AK = 8388608, OUT_AV = 8912896, OUT_RF = 9437184, OUT_RB = 9961472,
                 OUT_CK = 10485760, OUT_CV = 12582912, OUT_DK = 14680064, OUT_DV = 15204352;
constexpr float LAM_INIT = 0.35550906f;

struct Params {
  const float *xp, *xs, *c, *cctx, *cak, *cav, *srf, *srb, *cck, *ccv, *cdk, *cdv;
  const float *mod_w, *mod_b, *norm_mix, *norm_ffn, *norm_final;
  const float *ev_w_in, *ev_w_out, *a_q_norm, *a_k_norm, *rdf, *rdb;
  const float *od_w_in, *od_w_out, *lq1, *lk1, *lq2, *lk2, *subln, *dsink;
  const float *peer_wq, *peer_sk, *peer_u, *peer_v;
  float* out;
  float *MOD, *ROPEC, *ROPES, *X, *SC;
  u16 *WT_EVIN, *WT_EVOUT, *WT_ODIN, *WT_ODOUT, *WT_PQ, *SUBK, *U16, *V16, *H, *MIX, *Q1, *Q2, *SG;
  u16 *KA, *VA, *RK, *RV, *KC, *VC, *KD, *VD, *PQ;
};

DEV u16 f2bf(float f) { unsigned u = __float_as_uint(f); u += 0x7fffu + ((u >> 16) & 1u); return (u16)(u >> 16); }
DEV float bf2f(unsigned b) { return __uint_as_float(b << 16); }
DEV unsigned pack2(float a, float b) { return (unsigned)f2bf(a) | ((unsigned)f2bf(b) << 16); }
DEV float bflo(unsigned w) { return __uint_as_float(w << 16); }
DEV float bfhi(unsigned w) { return __uint_as_float(w & 0xffff0000u); }
DEV float silu_f(float v) { return v / (1.f + __expf(-v)); }
DEV float gelu_tanh(float a) {
  float z = 0.7978845608f * (a + 0.044715f * a * a * a);
  float e = __expf(2.f * z);
  float th = 1.f - 2.f / (e + 1.f);
  return 0.5f * a * (1.f + th);
}
template <int CTRL> DEV float dpp_f(float v) {
  return __int_as_float(__builtin_amdgcn_update_dpp(0, __float_as_int(v), CTRL, 0xF, 0xF, true));
}
template <int CTRL> DEV unsigned dpp_u(unsigned v) {
  return (unsigned)__builtin_amdgcn_update_dpp(0, (int)v, CTRL, 0xF, 0xF, true);
}
DEV float row_sum16(float v) {
  v += dpp_f<0xB1>(v); v += dpp_f<0x4E>(v); v += dpp_f<0x141>(v); v += dpp_f<0x140>(v); return v;
}
DEV float row_max16(float v) {
  v = fmaxf(v, dpp_f<0xB1>(v)); v = fmaxf(v, dpp_f<0x4E>(v)); v = fmaxf(v, dpp_f<0x141>(v)); v = fmaxf(v, dpp_f<0x140>(v)); return v;
}
DEV float rlane(float v, int l) { return __int_as_float(__builtin_amdgcn_readlane(__float_as_int(v), l)); }
DEV float wave_sum(float v) {
  v = row_sum16(v);
  return (rlane(v, 0) + rlane(v, 16)) + (rlane(v, 32) + rlane(v, 48));
}
DEV unsigned wave_max_u(unsigned v) {
  v = max(v, dpp_u<0xB1>(v)); v = max(v, dpp_u<0x4E>(v)); v = max(v, dpp_u<0x141>(v)); v = max(v, dpp_u<0x140>(v));
  unsigned a = (unsigned)__builtin_amdgcn_readlane((int)v, 0), b = (unsigned)__builtin_amdgcn_readlane((int)v, 16);
  unsigned c = (unsigned)__builtin_amdgcn_readlane((int)v, 32), d = (unsigned)__builtin_amdgcn_readlane((int)v, 48);
  return max(max(a, b), max(c, d));
}
DEV float half_sum32(float v) { v = row_sum16(v); return v + __shfl_xor(v, 16); }
DEV unsigned fkey(float f) { unsigned u = __float_as_uint(f); return (u & 0x80000000u) ? ~u : (u | 0x80000000u); }
DEV f32x16 mfma32(bf16x8 a, bf16x8 b, f32x16 c) { return __builtin_amdgcn_mfma_f32_32x32x16_bf16(a, b, c, 0, 0, 0); }
DEV void zero16(f32x16& v) {
#pragma unroll
  for (int i = 0; i < 16; i++) v[i] = 0.f;
}
DEV size_t kvoff(bool smp, int b, int hh, int tpos, int H, int DW, int LS, int off) {
  return smp ? (size_t)4096 * H * DW + ((size_t)(b * H + hh) * LS + off + tpos) * DW
             : ((size_t)(b * H + hh) * 256 + tpos) * DW;
}

DEV void prep_transpose(const float* __restrict__ W, int N, u16* __restrict__ Wt, int tile, float* sm) {
  int ntn = N >> 6; int kt = tile / ntn, nt = tile % ntn;
  int k0 = kt * 64, n0 = nt * 64; int t = threadIdx.x;
#pragma unroll
  for (int i = 0; i < 4; i++) {
    int k = (t >> 4) + 16 * i; int c4 = (t & 15) * 4;
    float4 v = *(const float4*)(W + (size_t)(k0 + k) * N + n0 + c4);
    sm[k * 65 + c4] = v.x; sm[k * 65 + c4 + 1] = v.y; sm[k * 65 + c4 + 2] = v.z; sm[k * 65 + c4 + 3] = v.w;
  }
  __syncthreads();
  int n = t >> 2, kc = (t & 3) * 16;
  unsigned pk[8];
#pragma unroll
  for (int j = 0; j < 8; j++) pk[j] = pack2(sm[(kc + 2 * j) * 65 + n], sm[(kc + 2 * j + 1) * 65 + n]);
  uint4* dst = (uint4*)(Wt + (size_t)(n0 + n) * 1024 + k0 + kc);
  dst[0] = make_uint4(pk[0], pk[1], pk[2], pk[3]);
  dst[1] = make_uint4(pk[4], pk[5], pk[6], pk[7]);
  __syncthreads();
}
DEV void conv_item(const float* __restrict__ src, u16* __restrict__ dst) {
  int t = threadIdx.x;
#pragma unroll
  for (int i = 0; i < 8; i++) {
    int e = (i * 256 + t) * 8;
    float4 a = *(const float4*)(src + e), b = *(const float4*)(src + e + 4);
    *(uint4*)(dst + e) = make_uint4(pack2(a.x, a.y), pack2(a.z, a.w), pack2(b.x, b.y), pack2(b.z, b.w));
  }
}
DEV void prep_mod(const Params& p, int it, float* sm) {
  int l = it / 96, n0 = (it % 96) * 64; int t = threadIdx.x;
  float* sc = sm;
  for (int i = t; i < 5120; i += 256) {
    int b = i >> 10, k = i & 1023;
    float v = (b == 0) ? p.cctx[k] : p.c[(b - 1) * 1024 + k];
    sc[i] = silu_f(v);
  }
  __syncthreads();
  int col = t & 63, kg = t >> 6;
  float a0 = 0, a1 = 0, a2 = 0, a3 = 0, a4 = 0;
  const float* w = p.mod_w + (size_t)l * 1024 * 6144 + n0 + col;
  for (int k = kg; k < 1024; k += 4) {
    float wv = w[(size_t)k * 6144];
    a0 += sc[k] * wv; a1 += sc[1024 + k] * wv; a2 += sc[2048 + k] * wv; a3 += sc[3072 + k] * wv; a4 += sc[4096 + k] * wv;
  }
  float* red = sm + 5120;
  red[(kg * 5 + 0) * 64 + col] = a0; red[(kg * 5 + 1) * 64 + col] = a1; red[(kg * 5 + 2) * 64 + col] = a2;
  red[(kg * 5 + 3) * 64 + col] = a3; red[(kg * 5 + 4) * 64 + col] = a4;
  __syncthreads();
  if (t < 64) {
#pragma unroll
    for (int b = 0; b < 5; b++) {
      float s = red[(0 * 5 + b) * 64 + t] + red[(1 * 5 + b) * 64 + t] + red[(2 * 5 + b) * 64 + t] + red[(3 * 5 + b) * 64 + t];
      p.MOD[(size_t)(l * 5 + b) * 6144 + n0 + t] = s + p.mod_b[l * 6144 + n0 + t];
    }
  }
  __syncthreads();
}
DEV void prep_cache(const Params& p, int it) {
  const float* src; u16* dst;
  if (it < 8)       { int ch = it;      src = p.cak + (size_t)ch * 16384; dst = p.KA + (size_t)4096 * 2 * 64 + (size_t)ch * 1280 * 64; }
  else if (it < 16) { int ch = it - 8;  src = p.cav + (size_t)ch * 16384; dst = p.VA + (size_t)4096 * 2 * 64 + (size_t)ch * 1280 * 64; }
  else if (it < 48) { int ch = it - 16; src = p.cck + (size_t)ch * 16384; dst = p.KC + (size_t)4096 * 8 * 64 + (size_t)ch * 1280 * 64; }
  else if (it < 80) { int ch = (it - 48) >> 1, hf = (it - 48) & 1;
                      src = p.ccv + (size_t)ch * 32768 + hf * 16384; dst = p.VC + (size_t)4096 * 4 * 128 + (size_t)ch * 1280 * 128 + hf * 16384; }
  else if (it < 88) { int ch = it - 80; src = p.cdk + (size_t)ch * 16384; dst = p.KD + (size_t)4096 * 2 * 64 + (size_t)ch * 1280 * 64; }
  else              { int ch = it - 88; src = p.cdv + (size_t)ch * 16384; dst = p.VD + (size_t)4096 * 2 * 64 + (size_t)ch * 1280 * 64; }
  conv_item(src, dst);
}
DEV void prep_rope(const Params& p, int it) {
  for (int i = 0; i < 16; i++) {
    int idx = it * 4096 + i * 256 + threadIdx.x;
    int tpos = idx >> 5, a = idx & 31;
    float pos = (a < 16) ? (float)(tpos >> 6) : (float)(tpos & 63);
    float inv = exp2f(-(float)(a & 15) * (13.287712379549449f / 16.f));
    float ang = pos * inv;
    p.ROPEC[idx] = __cosf(ang); p.ROPES[idx] = __sinf(ang);
  }
}
constexpr int PREP_T0 = 704, PREP_T1 = PREP_T0 + 256, PREP_T2 = PREP_T1 + 576, PREP_T3 = PREP_T2 + 256, PREP_T4 = PREP_T3 + 1024;
constexpr int PREP_U = PREP_T4 + 2048, PREP_V = PREP_U + 2048, PREP_SK = PREP_V + 32, PREP_CA = PREP_SK + 96, PREP_RO = PREP_CA + 8, PREP_MOD = PREP_RO + 192;
DEV void phase_prep(const Params& p, int bid, int nb, char* smem) {
  float* sm = (float*)smem;
  for (int it0 = bid; it0 < PREP_MOD; it0 += nb) {
    int it = (it0 < 192) ? (PREP_RO + it0) : (it0 - 192);
    if (it < PREP_T0) prep_transpose(p.ev_w_in, 2816, p.WT_EVIN, it, sm);
    else if (it < PREP_T1) prep_transpose(p.ev_w_out, 1024, p.WT_EVOUT, it - PREP_T0, sm);
    else if (it < PREP_T2) prep_transpose(p.od_w_in, 2304, p.WT_ODIN, it - PREP_T1, sm);
    else if (it < PREP_T3) prep_transpose(p.od_w_out, 1024, p.WT_ODOUT, it - PREP_T2, sm);
    else if (it < PREP_T4) { int j = it - PREP_T3; int l = j >> 9; prep_transpose(p.peer_wq + (size_t)l * 1024 * 2048, 2048, p.WT_PQ + (size_t)l * 2048 * 1024, j & 511, sm); }
    else if (it < PREP_U) { size_t o = (size_t)(it - PREP_T4) * 16384; conv_item(p.peer_u + o, p.U16 + o); }
    else if (it < PREP_V) { size_t o = (size_t)(it - PREP_U) * 16384; conv_item(p.peer_v + o, p.V16 + o); }
    else if (it < PREP_SK) { size_t o = (size_t)(it - PREP_V) * 16384; conv_item(p.peer_sk + o, p.SUBK + o); }
    else if (it < PREP_CA) prep_cache(p, it - PREP_SK);
    else if (it < PREP_RO) prep_rope(p, it - PREP_CA);
    else prep_mod(p, it - PREP_RO, sm);
  }
}

DEV void phase_ada(const Params& p, int layer, const float* __restrict__ gain, int shift_i, int scale_i, bool from_input, int bid, int nb) {
  int wave = threadIdx.x >> 6, lane = threadIdx.x & 63;
  for (int T = bid * 4 + wave; T < 8192; T += nb * 4) {
    const float* xr = from_input ? (T < 4096 ? p.xp + (size_t)T * 1024 : p.xs + (size_t)(T - 4096) * 1024) : p.X + (size_t)T * 1024;
    int mb = T < 4096 ? 0 : 1 + ((T - 4096) >> 10);
    const float* md = p.MOD + (size_t)(layer * 5 + mb) * 6144;
    float4 v[4]; float ss = 0;
#pragma unroll
    for (int i = 0; i < 4; i++) { v[i] = *(const float4*)(xr + (i * 64 + lane) * 4); ss += v[i].x * v[i].x + v[i].y * v[i].y + v[i].z * v[i].z + v[i].w * v[i].w; }
    ss = wave_sum(ss);
    float rstd = rsqrtf(ss * (1.f / 1024.f) + 1e-6f);
#pragma unroll
    for (int i = 0; i < 4; i++) {
      int col = (i * 64 + lane) * 4;
      float4 g = *(const float4*)(gain + col), sh = *(const float4*)(md + shift_i * 1024 + col), sc = *(const float4*)(md + scale_i * 1024 + col);
      float y0 = v[i].x * rstd * g.x * (1.f + sc.x) + sh.x, y1 = v[i].y * rstd * g.y * (1.f + sc.y) + sh.y;
      float y2 = v[i].z * rstd * g.z * (1.f + sc.z) + sh.z, y3 = v[i].w * rstd * g.w * (1.f + sc.w) + sh.w;
      *(uint2*)(p.H + (size_t)T * 1024 + col) = make_uint2(pack2(y0, y1), pack2(y2, y3));
    }
  }
}

DEV void gemm_tile(const u16* __restrict__ A, int lda, const u16* __restrict__ B, int ldb, int K, char* smem, f32x16 (&acc)[2][2]) {
  u16* sA = (u16*)smem; u16* sB = sA + 128 * 72;
  int t = threadIdx.x, lane = t & 63, wave = t >> 6, r = lane & 31, h = lane >> 5;
  int wm = wave >> 1, wn = wave & 1;
  int lrow = t >> 3, lkc = (t & 7) * 8;
  const u16* ap = A + (size_t)lrow * lda + lkc;
  const u16* bp = B + (size_t)lrow * ldb + lkc;
  size_t sa32 = (size_t)32 * lda, sb32 = (size_t)32 * ldb;
  u32x4 ra0 = *(const u32x4*)(ap), ra1 = *(const u32x4*)(ap + sa32), ra2 = *(const u32x4*)(ap + 2 * sa32), ra3 = *(const u32x4*)(ap + 3 * sa32);
  u32x4 rb0 = *(const u32x4*)(bp), rb1 = *(const u32x4*)(bp + sb32), rb2 = *(const u32x4*)(bp + 2 * sb32), rb3 = *(const u32x4*)(bp + 3 * sb32);
  u16* wa = sA + lrow * 72 + lkc; u16* wb = sB + lrow * 72 + lkc;
  for (int k0 = 0; k0 < K; k0 += 64) {
    __syncthreads();
    *(u32x4*)(wa) = ra0; *(u32x4*)(wa + 32 * 72) = ra1; *(u32x4*)(wa + 64 * 72) = ra2; *(u32x4*)(wa + 96 * 72) = ra3;
    *(u32x4*)(wb) = rb0; *(u32x4*)(wb + 32 * 72) = rb1; *(u32x4*)(wb + 64 * 72) = rb2; *(u32x4*)(wb + 96 * 72) = rb3;
    __syncthreads();
    if (k0 + 64 < K) {
      ap += 64; bp += 64;
      ra0 = *(const u32x4*)(ap); ra1 = *(const u32x4*)(ap + sa32); ra2 = *(const u32x4*)(ap + 2 * sa32); ra3 = *(const u32x4*)(ap + 3 * sa32);
      rb0 = *(const u32x4*)(bp); rb1 = *(const u32x4*)(bp + sb32); rb2 = *(const u32x4*)(bp + 2 * sb32); rb3 = *(const u32x4*)(bp + 3 * sb32);
    }
#pragma unroll
    for (int kk = 0; kk < 4; kk++) {
      bf16x8 a0 = *(const bf16x8*)(sA + (wm * 64 + r) * 72 + kk * 16 + h * 8);
      bf16x8 a1 = *(const bf16x8*)(sA + (wm * 64 + 32 + r) * 72 + kk * 16 + h * 8);
      bf16x8 b0 = *(const bf16x8*)(sB + (wn * 64 + r) * 72 + kk * 16 + h * 8);
      bf16x8 b1 = *(const bf16x8*)(sB + (wn * 64 + 32 + r) * 72 + kk * 16 + h * 8);
      acc[0][0] = mfma32(a0, b0, acc[0][0]); acc[0][1] = mfma32(a0, b1, acc[0][1]);
      acc[1][0] = mfma32(a1, b0, acc[1][0]); acc[1][1] = mfma32(a1, b1, acc[1][1]);
    }
  }
  __syncthreads();
  float* Cs = (float*)smem;
#pragma unroll
  for (int i = 0; i < 2; i++)
#pragma unroll
    for (int j = 0; j < 2; j++)
#pragma unroll
      for (int g = 0; g < 16; g++)
        Cs[(wm * 64 + i * 32 + (g & 3) + 8 * (g >> 2) + 4 * h) * 128 + wn * 64 + j * 32 + r] = acc[i][j][g];
  __syncthreads();
}

template <class Epi>
DEV void gemm_phase(const u16* A, int lda, const u16* Bt, int ldb, int K, int MT, int NTl, int bid, int nb, char* smem, Epi epi) {
  for (int it = bid; it < MT * NTl; it += nb) {
    int mt = it / NTl, nt = it % NTl;
    f32x16 acc[2][2];
    zero16(acc[0][0]); zero16(acc[0][1]); zero16(acc[1][0]); zero16(acc[1][1]);
    gemm_tile(A + (size_t)mt * 128 * lda, lda, Bt + (size_t)nt * 128 * ldb, ldb, K, smem, acc);
    epi(mt * 128, nt * 128, (const float*)smem);
  }
}

DEV void tok_decode(int T, bool& smp, int& b, int& tpos) {
  smp = T >= 4096;
  if (!smp) { b = T >> 8; tpos = T & 255; } else { b = (T - 4096) >> 10; tpos = (T - 4096) & 1023; }
}
DEV void rope_pair(const Params& p, float& x, float& y, int tpos, int d) {
  float px = __shfl_xor(x, 16), py = __shfl_xor(y, 16);
  int a = d & 31;
  float c0 = p.ROPEC[tpos * 32 + a], c1 = p.ROPEC[tpos * 32 + a + 1];
  float s0 = p.ROPES[tpos * 32 + a], s1 = p.ROPES[tpos * 32 + a + 1];
  if (d < 32) { x = x * c0 - px * s0; y = y * c1 - py * s1; }
  else        { x = px * s0 + x * c0; y = py * s1 + y * c1; }
}

DEV void epi_inproj0(const Params& p, int m0, int n0, const float* Cs) {
  int lane = threadIdx.x & 63, wave = threadIdx.x >> 6;
  for (int rr = wave; rr < 128; rr += 4) {
    int T = m0 + rr; bool smp; int b, tpos; tok_decode(T, smp, b, tpos);
    float2 c = *(const float2*)(Cs + rr * 128 + lane * 2);
    int col = n0 + lane * 2; int d = col & 63;
    if (n0 < 640) {
      float ss = half_sum32(c.x * c.x + c.y * c.y);
      float rstd = rsqrtf(ss * (1.f / 64.f) + 1e-6f);
      const float* g = (n0 < 512) ? p.a_q_norm : p.a_k_norm;
      c.x *= rstd * g[d]; c.y *= rstd * g[d + 1];
      if (smp) rope_pair(p, c.x, c.y, tpos, d);
      if (n0 < 512) {
        *(unsigned*)(p.Q1 + (size_t)T * 512 + col) = pack2(c.x * 0.125f, c.y * 0.125f);
      } else {
        int hh = (col - 512) >> 6;
        *(unsigned*)(p.KA + kvoff(smp, b, hh, tpos, 2, 64, 1280, 256) + d) = pack2(c.x, c.y);
        if (!smp) *(float2*)(p.out + OUT_AK + ((size_t)(b * 2 + hh) * 256 + tpos) * 64 + d) = c;
      }
    } else if (n0 < 768) {
      int hh = (col - 640) >> 6;
      *(unsigned*)(p.VA + kvoff(smp, b, hh, tpos, 2, 64, 1280, 256) + d) = pack2(c.x, c.y);
      if (!smp) *(float2*)(p.out + OUT_AV + ((size_t)(b * 2 + hh) * 256 + tpos) * 64 + d) = c;
    } else if (n0 < 1280) {
      *(unsigned*)(p.Q2 + (size_t)T * 512 + (col - 768)) = pack2(c.x, c.y);
    } else if (n0 < 1792) {
      int hh = (col - 1280) >> 6;
      *(unsigned*)(p.RK + kvoff(smp, b, hh, tpos, 8, 64, 1024, 0) + d) = pack2(c.x * 0.125f, c.y * 0.125f);
    } else if (n0 < 2304) {
      int hh = (col - 1792) >> 6;
      *(unsigned*)(p.RV + kvoff(smp, b, hh, tpos, 8, 64, 1024, 0) + d) = pack2(c.x, c.y);
    } else {
      *(unsigned*)(p.SG + (size_t)T * 512 + (col - 2304)) = pack2(silu_f(c.x), silu_f(c.y));
    }
  }
}
DEV void epi_inproj1(const Params& p, int m0, int n0, const float* Cs) {
  int lane = threadIdx.x & 63, wave = threadIdx.x >> 6;
  for (int rr = wave; rr < 128; rr += 4) {
    int T = m0 + rr; bool smp; int b, tpos; tok_decode(T, smp, b, tpos);
    float2 c = *(const float2*)(Cs + rr * 128 + lane * 2);
    int col = n0 + lane * 2; int d = col & 63;
    if (n0 < 512) {
      if (smp) rope_pair(p, c.x, c.y, tpos, d);
      *(unsigned*)(p.Q1 + (size_t)T * 512 + col) = pack2(c.x * 0.125f, c.y * 0.125f);
    } else if (n0 < 1024) {
      int mp = (col - 512) >> 6;
      if (!smp) *(float2*)(p.out + OUT_CK + ((size_t)(b * 8 + mp) * 256 + tpos) * 64 + d) = c;
      if (smp) rope_pair(p, c.x, c.y, tpos, d);
      *(unsigned*)(p.KC + kvoff(smp, b, mp, tpos, 8, 64, 1280, 256) + d) = pack2(c.x, c.y);
    } else if (n0 < 1536) {
      int hh = (col - 1024) >> 7; int dd = (col - 1024) & 127;
      if (!smp) *(float2*)(p.out + OUT_CV + ((size_t)(b * 4 + hh) * 256 + tpos) * 128 + dd) = c;
      *(unsigned*)(p.VC + kvoff(smp, b, hh, tpos, 4, 128, 1280, 256) + dd) = pack2(c.x, c.y);
    } else if (n0 < 2048) {
      if (smp) rope_pair(p, c.x, c.y, tpos, d);
      *(unsigned*)(p.Q2 + (size_t)T * 512 + (col - 1536)) = pack2(c.x * 0.125f, c.y * 0.125f);
    } else if (n0 < 2176) {
      int hh = (col - 2048) >> 6;
      if (!smp) *(float2*)(p.out + OUT_DK + ((size_t)(b * 2 + hh) * 256 + tpos) * 64 + d) = c;
      if (smp) rope_pair(p, c.x, c.y, tpos, d);
      *(unsigned*)(p.KD + kvoff(smp, b, hh, tpos, 2, 64, 1280, 256) + d) = pack2(c.x, c.y);
    } else {
      int hh = (col - 2176) >> 6;
      if (!smp) *(float2*)(p.out + OUT_DV + ((size_t)(b * 2 + hh) * 256 + tpos) * 64 + d) = c;
      *(unsigned*)(p.VD + kvoff(smp, b, hh, tpos, 2, 64, 1280, 256) + d) = pack2(c.x, c.y);
    }
  }
}
DEV void epi_outproj(const Params& p, int layer, int m0, int n0, const float* Cs) {
  int lane = threadIdx.x & 63, wave = threadIdx.x >> 6;
  for (int rr = wave; rr < 128; rr += 4) {
    int T = m0 + rr;
    int mb = T < 4096 ? 0 : 1 + ((T - 4096) >> 10);
    const float* xr = (layer == 0) ? (T < 4096 ? p.xp + (size_t)T * 1024 : p.xs + (size_t)(T - 4096) * 1024) : p.X + (size_t)T * 1024;
    float2 c = *(const float2*)(Cs + rr * 128 + lane * 2);
    int col = n0 + lane * 2;
    float2 x = *(const float2*)(xr + col);
    float2 g = *(const float2*)(p.MOD + (size_t)(layer * 5 + mb) * 6144 + 2048 + col);
    x.x += g.x * c.x; x.y += g.y * c.y;
    *(float2*)(p.X + (size_t)T * 1024 + col) = x;
  }
}

DEV void load_k_tile(const u16* __restrict__ k, u16* sK) {
  int t = threadIdx.x;
#pragma unroll
  for (int i = 0; i < 2; i++) {
    int c = t + 256 * i; int key = c >> 3, dc = c & 7;
    *(uint4*)(sK + key * 72 + dc * 8) = *(const uint4*)(k + key * 64 + dc * 8);
  }
}
template <int DV> DEV void load_v_tile(const u16* __restrict__ v, u16* sVT) {
  int lane = threadIdx.x & 63, wave = threadIdx.x >> 6;
#pragma unroll
  for (int i = 0; i < DV / 32; i++) {
    int dc = wave + 4 * i;
    uint4 x = *(const uint4*)(v + (size_t)lane * DV + dc * 8);
    u16* d = sVT + (dc * 8) * 76 + lane;
    d[0 * 76] = (u16)(x.x & 0xffff); d[1 * 76] = (u16)(x.x >> 16);
    d[2 * 76] = (u16)(x.y & 0xffff); d[3 * 76] = (u16)(x.y >> 16);
    d[4 * 76] = (u16)(x.z & 0xffff); d[5 * 76] = (u16)(x.z >> 16);
    d[6 * 76] = (u16)(x.w & 0xffff); d[7 * 76] = (u16)(x.w >> 16);
  }
}
DEV void load_ident_k(u16* sK) {
  int t = threadIdx.x;
#pragma unroll
  for (int i = 0; i < 2; i++) {
    int c = t + 256 * i; int key = c >> 3, dc = c & 7;
    unsigned w[4] = {0u, 0u, 0u, 0u};
    uint4 z = make_uint4(0u, 0u, 0u, 0u);
    if (dc == (key >> 3)) {
      int e = key & 7; unsigned one = (e & 1) ? 0x3F800000u : 0x00003F80u;
      if ((e >> 1) == 0) z.x = one; else if ((e >> 1) == 1) z.y = one; else if ((e >> 1) == 2) z.z = one; else z.w = one;
    }
    (void)w;
    *(uint4*)(sK + key * 72 + dc * 8) = z;
  }
}
DEV void load_state_v(const float* __restrict__ S0, u16* sVT) {
  int lane = threadIdx.x & 63, wave = threadIdx.x >> 6;
#pragma unroll
  for (int i = 0; i < 2; i++) {
    int dc = wave + 4 * i;
    float4 a = *(const float4*)(S0 + lane * 64 + dc * 8), b = *(const float4*)(S0 + lane * 64 + dc * 8 + 4);
    u16* d = sVT + (dc * 8) * 76 + lane;
    d[0 * 76] = f2bf(a.x); d[1 * 76] = f2bf(a.y); d[2 * 76] = f2bf(a.z); d[3 * 76] = f2bf(a.w);
    d[4 * 76] = f2bf(b.x); d[5 * 76] = f2bf(b.y); d[6 * 76] = f2bf(b.z); d[7 * 76] = f2bf(b.w);
  }
}
template <int DV, class F>
DEV void attn_compute(const bf16x8 (&qf)[4], f32x16 (&o)[DV / 32], const u16* sK, const u16* sVT, F&& xform) {
  int lane = threadIdx.x & 63, r = lane & 31, h = lane >> 5;
  f32x16 st[2]; zero16(st[0]); zero16(st[1]);
#pragma unroll
  for (int sub = 0; sub < 2; sub++)
#pragma unroll
    for (int kk = 0; kk < 4; kk++) {
      bf16x8 kf = *(const bf16x8*)(sK + (sub * 32 + r) * 72 + kk * 16 + h * 8);
      st[sub] = mfma32(kf, qf[kk], st[sub]);
    }
  xform(st);
  bf16x8 pf[2][2];
#pragma unroll
  for (int sub = 0; sub < 2; sub++)
#pragma unroll
    for (int s = 0; s < 2; s++) {
      u32x4 w;
      w[0] = pack2(st[sub][8 * s + 0], st[sub][8 * s + 1]); w[1] = pack2(st[sub][8 * s + 2], st[sub][8 * s + 3]);
      w[2] = pack2(st[sub][8 * s + 4], st[sub][8 * s + 5]); w[3] = pack2(st[sub][8 * s + 6], st[sub][8 * s + 7]);
      pf[sub][s] = __builtin_bit_cast(bf16x8, w);
    }
#pragma unroll
  for (int ds = 0; ds < DV / 32; ds++)
#pragma unroll
    for (int sub = 0; sub < 2; sub++)
#pragma unroll
      for (int s = 0; s < 2; s++) {
        const u16* vp = sVT + (ds * 32 + r) * 76 + sub * 32 + s * 16 + 4 * h;
        uint2 lo = *(const uint2*)vp, hi = *(const uint2*)(vp + 8);
        u32x4 w; w[0] = lo.x; w[1] = lo.y; w[2] = hi.x; w[3] = hi.y;
        o[ds] = mfma32(__builtin_bit_cast(bf16x8, w), pf[sub][s], o[ds]);
      }
}
template <int DV>
DEV void softmax_xform(f32x16 (&st)[2], f32x16 (&o)[DV / 32], float& m, float& l, bool masked, int kpos0, int qpos) {
  int h = (threadIdx.x & 63) >> 5;
  float mx = -1e30f;
#pragma unroll
  for (int sub = 0; sub < 2; sub++)
#pragma unroll
    for (int g = 0; g < 16; g++) {
      float s = st[sub][g];
      if (masked) {
        int j = kpos0 + sub * 32 + (g & 3) + 8 * (g >> 2) + 4 * h;
        int dl = qpos - j; if (dl < 0) dl = -dl;
        if (dl > 128) s = -1e30f;
        st[sub][g] = s;
      }
      mx = fmaxf(mx, s);
    }
  mx = fmaxf(mx, __shfl_xor(mx, 32));
  float mnew = fmaxf(m, mx);
  float alpha = __expf(m - mnew);
  m = mnew;
  float ls = 0.f;
#pragma unroll
  for (int sub = 0; sub < 2; sub++)
#pragma unroll
    for (int g = 0; g < 16; g++) { float pv = __expf(st[sub][g] - mnew); st[sub][g] = pv; ls += pv; }
  l = l * alpha + ls;
#pragma unroll
  for (int ds = 0; ds < DV / 32; ds++)
#pragma unroll
    for (int g = 0; g < 16; g++) o[ds][g] *= alpha;
}

template <int DV>
DEV void attn_softmax_job(const Params& p, const u16* Q, int Tq0, int qcol, const u16* kb, const u16* vb,
                          int nplain, int band_lo, int band_hi, int qpos0, bool use_sink, float sinkv,
                          f32x16 (&o)[DV / 32], char* smem) {
  u16* sK = (u16*)smem; u16* sVT = sK + 64 * 72;
  int lane = threadIdx.x & 63, wave = threadIdx.x >> 6, r = lane & 31, h = lane >> 5;
  bf16x8 qf[4];
#pragma unroll
  for (int kk = 0; kk < 4; kk++) qf[kk] = *(const bf16x8*)(Q + (size_t)(Tq0 + wave * 32 + r) * 512 + qcol + kk * 16 + h * 8);
#pragma unroll
  for (int ds = 0; ds < DV / 32; ds++) zero16(o[ds]);
  float m = use_sink ? sinkv : -1e30f;
  float l = (use_sink && h == 0) ? 1.f : 0.f;
  int qpos = qpos0 + wave * 32 + r;
  int ntot = nplain + (band_hi - band_lo);
  for (int ti = 0; ti < ntot; ti++) {
    bool masked = ti >= nplain;
    int key0 = masked ? (256 + (band_lo + ti - nplain) * 64) : ti * 64;
    int kpos0 = key0 - 256;
    __syncthreads();
    load_k_tile(kb + (size_t)key0 * 64, sK);
    load_v_tile<DV>(vb + (size_t)key0 * DV, sVT);
    __syncthreads();
    attn_compute<DV>(qf, o, sK, sVT, [&](f32x16 (&st)[2]) { softmax_xform<DV>(st, o, m, l, masked, kpos0, qpos); });
  }
  float lt = l + __shfl_xor(l, 32);
  float inv = 1.f / lt;
#pragma unroll
  for (int ds = 0; ds < DV / 32; ds++)
#pragma unroll
    for (int g = 0; g < 16; g++) o[ds][g] *= inv;
}
DEV void store_o64(const Params& p, const f32x16 (&o)[2], int Tq0, int mixcol) {
  int lane = threadIdx.x & 63, wave = threadIdx.x >> 6, r = lane & 31, h = lane >> 5;
  int T = Tq0 + wave * 32 + r;
#pragma unroll
  for (int ds = 0; ds < 2; ds++)
#pragma unroll
    for (int g4 = 0; g4 < 4; g4++) {
      int d0 = ds * 32 + 8 * g4 + 4 * h;
      *(uint2*)(p.MIX + (size_t)T * 1024 + mixcol + d0) =
          make_uint2(pack2(o[ds][4 * g4], o[ds][4 * g4 + 1]), pack2(o[ds][4 * g4 + 2], o[ds][4 * g4 + 3]));
    }
}

DEV void ret_job(const Params& p, bool smp, int b, int hh, int qb, char* smem) {
  u16* sK = (u16*)smem; u16* sVT = sK + 64 * 72;
  int lane = threadIdx.x & 63, wave = threadIdx.x >> 6, r = lane & 31, h = lane >> 5;
  int L = smp ? 1024 : 256;
  int Tq0 = (smp ? 4096 + b * 1024 : b * 256) + qb * 128;
  const u16* kb = p.RK + kvoff(smp, b, hh, 0, 8, 64, 1024, 0);
  const u16* vb = p.RV + kvoff(smp, b, hh, 0, 8, 64, 1024, 0);
  float xf = p.rdf[hh], xb = p.rdb[hh];
  float lf2 = -log1pf(__expf(-xf)) * 1.4426950408889634f;
  float lb2 = -log1pf(__expf(-xb)) * 1.4426950408889634f;
  bf16x8 qf[4];
#pragma unroll
  for (int kk = 0; kk < 4; kk++) qf[kk] = *(const bf16x8*)(p.Q2 + (size_t)(Tq0 + wave * 32 + r) * 512 + hh * 64 + kk * 16 + h * 8);
  f32x16 o[2]; zero16(o[0]); zero16(o[1]);
  int qpos = qb * 128 + wave * 32 + r;
  int nt = L / 64;
  for (int ti = 0; ti < nt; ti++) {
    __syncthreads();
    load_k_tile(kb + (size_t)ti * 64 * 64, sK);
    load_v_tile<64>(vb + (size_t)ti * 64 * 64, sVT);
    __syncthreads();
    int kpos0 = ti * 64;
    attn_compute<64>(qf, o, sK, sVT, [&](f32x16 (&st)[2]) {
#pragma unroll
      for (int sub = 0; sub < 2; sub++)
#pragma unroll
        for (int g = 0; g < 16; g++) {
          int j = kpos0 + sub * 32 + (g & 3) + 8 * (g >> 2) + 4 * h;
          int dl = qpos - j;
          float e = dl >= 0 ? lf2 * (float)dl : lb2 * (float)(-dl);
          st[sub][g] *= exp2f(e);
        }
    });
  }
  if (smp) {
    for (int dir = 0; dir < 2; dir++) {
      const float* S0 = (dir == 0 ? p.srf : p.srb) + (size_t)(b * 8 + hh) * 4096;
      float rs = dir == 0 ? exp2f(lf2 * (float)(qpos + 1)) : exp2f(lb2 * (float)(L - qpos));
      __syncthreads();
      load_ident_k(sK);
      load_state_v(S0, sVT);
      __syncthreads();
      attn_compute<64>(qf, o, sK, sVT, [&](f32x16 (&st)[2]) {
#pragma unroll
        for (int sub = 0; sub < 2; sub++)
#pragma unroll
          for (int g = 0; g < 16; g++) st[sub][g] *= rs;
      });
    }
  }
  float sum = 0.f;
#pragma unroll
  for (int ds = 0; ds < 2; ds++)
#pragma unroll
    for (int g = 0; g < 16; g++) sum += o[ds][g];
  sum += __shfl_xor(sum, 32);
  float mean = sum * (1.f / 64.f);
  float vs = 0.f;
#pragma unroll
  for (int ds = 0; ds < 2; ds++)
#pragma unroll
    for (int g = 0; g < 16; g++) { float dlt = o[ds][g] - mean; vs += dlt * dlt; }
  vs += __shfl_xor(vs, 32);
  float rstd = rsqrtf(vs * (1.f / 64.f) + 1e-6f);
  int T = Tq0 + wave * 32 + r;
#pragma unroll
  for (int ds = 0; ds < 2; ds++)
#pragma unroll
    for (int g4 = 0; g4 < 4; g4++) {
      int d0 = ds * 32 + 8 * g4 + 4 * h;
      uint2 gt = *(const uint2*)(p.SG + (size_t)T * 512 + hh * 64 + d0);
      float y0 = (o[ds][4 * g4] - mean) * rstd * bflo(gt.x), y1 = (o[ds][4 * g4 + 1] - mean) * rstd * bfhi(gt.x);
      float y2 = (o[ds][4 * g4 + 2] - mean) * rstd * bflo(gt.y), y3 = (o[ds][4 * g4 + 3] - mean) * rstd * bfhi(gt.y);
      *(uint2*)(p.MIX + (size_t)T * 1024 + 512 + hh * 64 + d0) = make_uint2(pack2(y0, y1), pack2(y2, y3));
    }
}
DEV void ret_state_job(const Params& p, int b, int hh, int dir, char* smem) {
  u16* sKk = (u16*)smem; u16* sVv = sKk + 64 * 64;
  int t = threadIdx.x;
  const u16* kb = p.RK + kvoff(false, b, hh, 0, 8, 64, 1024, 0);
  const u16* vb = p.RV + kvoff(false, b, hh, 0, 8, 64, 1024, 0);
  float xx = dir == 0 ? p.rdf[hh] : p.rdb[hh];
  float lg2 = -log1pf(__expf(-xx)) * 1.4426950408889634f;
  int dk = t >> 2, dvc = (t & 3) * 16;
  float acc[16];
#pragma unroll
  for (int i = 0; i < 16; i++) acc[i] = 0.f;
  for (int ch = 0; ch < 4; ch++) {
    __syncthreads();
#pragma unroll
    for (int i = 0; i < 2; i++) {
      int c = t + 256 * i;
      *(uint4*)(sKk + c * 8) = *(const uint4*)(kb + (size_t)ch * 4096 + c * 8);
      *(uint4*)(sVv + c * 8) = *(const uint4*)(vb + (size_t)ch * 4096 + c * 8);
    }
    __syncthreads();
    for (int jj = 0; jj < 64; jj++) {
      int j = ch * 64 + jj;
      float w = exp2f(lg2 * (float)(dir == 0 ? 255 - j : j));
      float kv = bf2f(sKk[jj * 64 + dk]) * w;
      const uint4* vp = (const uint4*)(sVv + jj * 64 + dvc);
      uint4 v0 = vp[0], v1 = vp[1];
      acc[0] += kv * bflo(v0.x); acc[1] += kv * bfhi(v0.x); acc[2] += kv * bflo(v0.y); acc[3] += kv * bfhi(v0.y);
      acc[4] += kv * bflo(v0.z); acc[5] += kv * bfhi(v0.z); acc[6] += kv * bflo(v0.w); acc[7] += kv * bfhi(v0.w);
      acc[8] += kv * bflo(v1.x); acc[9] += kv * bfhi(v1.x); acc[10] += kv * bflo(v1.y); acc[11] += kv * bfhi(v1.y);
      acc[12] += kv * bflo(v1.z); acc[13] += kv * bfhi(v1.z); acc[14] += kv * bflo(v1.w); acc[15] += kv * bfhi(v1.w);
    }
  }
  float* dst = p.out + (dir == 0 ? OUT_RF : OUT_RB) + ((size_t)(b * 8 + hh) * 64 + dk) * 64 + dvc;
#pragma unroll
  for (int i = 0; i < 4; i++) *(float4*)(dst + 4 * i) = make_float4(acc[4 * i], acc[4 * i + 1], acc[4 * i + 2], acc[4 * i + 3]);
}

DEV void phase_attn0(const Params& p, int bid, int nb, char* smem) {
  for (int it = bid; it < 1280; it += nb) {
    if (it < 256) {
      int b = it >> 6, hq = (it >> 3) & 7, qb = it & 7; int kvh = hq >> 2;
      f32x16 o[2];
      int Tq0 = 4096 + b * 1024 + qb * 128;
      attn_softmax_job<64>(p, p.Q1, Tq0, hq * 64, p.KA + kvoff(true, b, kvh, -256, 2, 64, 1280, 256), p.VA + kvoff(true, b, kvh, -256, 2, 64, 1280, 256),
                           20, 0, 0, qb * 128, false, 0.f, o, smem);
      store_o64(p, o, Tq0, hq * 64);
    } else if (it < 512) {
      int j = it - 256; int b = j >> 6, hh = (j >> 3) & 7, qb = j & 7;
      ret_job(p, true, b, hh, qb, smem);
    } else if (it < 768) {
      int j = it - 512; int b = j >> 4, hq = (j >> 1) & 7, qb = j & 1; int kvh = hq >> 2;
      f32x16 o[2];
      int Tq0 = b * 256 + qb * 128;
      attn_softmax_job<64>(p, p.Q1, Tq0, hq * 64, p.KA + kvoff(false, b, kvh, 0, 2, 64, 1280, 256), p.VA + kvoff(false, b, kvh, 0, 2, 64, 1280, 256),
                           4, 0, 0, qb * 128, false, 0.f, o, smem);
      store_o64(p, o, Tq0, hq * 64);
    } else if (it < 1024) {
      int j = it - 768; int b = j >> 4, hh = (j >> 1) & 7, qb = j & 1;
      ret_job(p, false, b, hh, qb, smem);
    } else {
      int j = it - 1024; int b = j >> 4, hh = (j >> 1) & 7, dir = j & 1;
      ret_state_job(p, b, hh, dir, smem);
    }
  }
}
DEV void diff_job(const Params& p, bool smp, int b, int hh, int qb, float lam, char* smem) {
  int lane = threadIdx.x & 63, wave = threadIdx.x >> 6, r = lane & 31, h = lane >> 5;
  int Tq0 = (smp ? 4096 + b * 1024 : b * 256) + qb * 128;
  int nt = smp ? 20 : 4;
  const u16* vb = p.VC + kvoff(smp, b, hh, smp ? -256 : 0, 4, 128, 1280, 256);
  f32x16 o1[4];
  unsigned* o0s = (unsigned*)(smem + 32768) + threadIdx.x;
  attn_softmax_job<128>(p, p.Q1, Tq0, (2 * hh) * 64, p.KC + kvoff(smp, b, 2 * hh, smp ? -256 : 0, 8, 64, 1280, 256), vb, nt, 0, 0, qb * 128, false, 0.f, o1, smem);
#pragma unroll
  for (int ds = 0; ds < 4; ds++)
#pragma unroll
    for (int g = 0; g < 8; g++) o0s[(ds * 8 + g) * 256] = pack2(o1[ds][2 * g], o1[ds][2 * g + 1]);
  attn_softmax_job<128>(p, p.Q1, Tq0, (2 * hh + 1) * 64, p.KC + kvoff(smp, b, 2 * hh + 1, smp ? -256 : 0, 8, 64, 1280, 256), vb, nt, 0, 0, qb * 128, false, 0.f, o1, smem);
  float ss = 0.f;
  f32x16 o0[4];
#pragma unroll
  for (int ds = 0; ds < 4; ds++)
#pragma unroll
    for (int g = 0; g < 8; g++) {
      unsigned w = o0s[(ds * 8 + g) * 256];
      float d0 = bflo(w) - lam * o1[ds][2 * g], d1 = bfhi(w) - lam * o1[ds][2 * g + 1];
      o0[ds][2 * g] = d0; o0[ds][2 * g + 1] = d1; ss += d0 * d0 + d1 * d1;
    }
  ss += __shfl_xor(ss, 32);
  float rstd = rsqrtf(ss * (1.f / 128.f) + 1e-6f) * (1.f - LAM_INIT);
  int T = Tq0 + wave * 32 + r;
#pragma unroll
  for (int ds = 0; ds < 4; ds++)
#pragma unroll
    for (int g4 = 0; g4 < 4; g4++) {
      int d0 = ds * 32 + 8 * g4 + 4 * h;
      float4 sg = *(const float4*)(p.subln + d0);
      *(uint2*)(p.MIX + (size_t)T * 1024 + hh * 128 + d0) =
          make_uint2(pack2(o0[ds][4 * g4] * rstd * sg.x, o0[ds][4 * g4 + 1] * rstd * sg.y),
                     pack2(o0[ds][4 * g4 + 2] * rstd * sg.z, o0[ds][4 * g4 + 3] * rstd * sg.w));
    }
}
DEV void phase_attn1(const Params& p, int bid, int nb, char* smem) {
  float d1 = 0.f, d2 = 0.f;
  for (int i = 0; i < 64; i++) { d1 += p.lq1[i] * p.lk1[i]; d2 += p.lq2[i] * p.lk2[i]; }
  float lam = __expf(d1) - __expf(d2) + LAM_INIT;
  for (int it = bid; it < 768; it += nb) {
    if (it < 128) {
      int b = it >> 5, hh = (it >> 3) & 3, qb = it & 7;
      diff_job(p, true, b, hh, qb, lam, smem);
    } else if (it < 384) {
      int j = it - 128; int b = j >> 6, hq = (j >> 3) & 7, qb = j & 7; int kvh = hq >> 2;
      int q0 = qb * 128;
      int lo = (q0 - 128 < 0 ? 0 : q0 - 128) >> 6, hi = (q0 + 256 > 1024 ? 1024 : q0 + 256) >> 6;
      f32x16 o[2];
      int Tq0 = 4096 + b * 1024 + q0;
      attn_softmax_job<64>(p, p.Q2, Tq0, hq * 64, p.KD + kvoff(true, b, kvh, -256, 2, 64, 1280, 256), p.VD + kvoff(true, b, kvh, -256, 2, 64, 1280, 256),
                           4, lo, hi, q0, true, p.dsink[hq], o, smem);
      store_o64(p, o, Tq0, 512 + hq * 64);
    } else if (it < 512) {
      int j = it - 384; int b = j >> 3, hh = (j >> 1) & 3, qb = j & 1;
      diff_job(p, false, b, hh, qb, lam, smem);
    } else {
      int j = it - 512; int b = j >> 4, hq = (j >> 1) & 7, qb = j & 1; int kvh = hq >> 2;
      f32x16 o[2];
      int Tq0 = b * 256 + qb * 128;
      attn_softmax_job<64>(p, p.Q2, Tq0, hq * 64, p.KD + kvoff(false, b, kvh, 0, 2, 64, 1280, 256), p.VD + kvoff(false, b, kvh, 0, 2, 64, 1280, 256),
                           4, 0, 0, qb * 128, true, p.dsink[hq], o, smem);
      store_o64(p, o, Tq0, 512 + hq * 64);
    }
  }
}

DEV int top16_select(unsigned k0, unsigned k1, unsigned k2, unsigned k3, int nbits, int lane) {
  unsigned mask = (1u << nbits) - 1u;
  int mine = 0;
  for (int k = 0; k < 16; k++) {
    unsigned best = wave_max_u(max(max(k0, k1), max(k2, k3)));
    int idx = (int)(mask - (best & mask));
    if (lane == k) mine = idx;
    if (k0 == best) k0 = 0u; if (k1 == best) k1 = 0u; if (k2 == best) k2 = 0u; if (k3 == best) k3 = 0u;
  }
  return mine;
}
DEV void phase_peer(const Params& p, int layer, int bid, int nb, char* smem) {
  int wave = threadIdx.x >> 6, lane = threadIdx.x & 63;
  float* ws1 = (float*)(smem + wave * 2048); float* ws2 = ws1 + 16;
  int* wi1 = (int*)(ws2 + 16); int* wi2 = wi1 + 16; int* eidx = wi2 + 16; float* eg = (float*)(eidx + 128);
  const u16* U = p.U16 + (size_t)layer * 16384 * 1024;
  const u16* V = p.V16 + (size_t)layer * 16384 * 1024;
  for (int T = bid * 4 + wave; T < 8192; T += nb * 4) {
    const float* sc = p.SC + (size_t)T * 2048;
    for (int hh = 0; hh < 8; hh++) {
#pragma unroll
      for (int c2 = 0; c2 < 2; c2++) {
        const float* s = sc + (hh * 2 + c2) * 128;
        float v0 = s[lane], v1 = s[lane + 64];
        unsigned k0 = (fkey(v0) & ~127u) | (unsigned)(127 - lane);
        unsigned k1 = (fkey(v1) & ~127u) | (unsigned)(63 - lane);
        int mine = top16_select(k0, k1, 0u, 0u, 7, lane);
        if (lane < 16) {
          float sv = s[mine];
          if (c2 == 0) { ws1[lane] = sv; wi1[lane] = mine; } else { ws2[lane] = sv; wi2[lane] = mine; }
        }
      }
      __builtin_amdgcn_fence(__ATOMIC_ACQ_REL, "wavefront");
      __builtin_amdgcn_wave_barrier();
      int bq = lane & 15, aq = lane >> 4;
      float s2v = ws2[bq];
      float c0 = ws1[aq] + s2v, c1 = ws1[aq + 4] + s2v, c2v = ws1[aq + 8] + s2v, c3 = ws1[aq + 12] + s2v;
      unsigned k0 = (fkey(c0) & ~255u) | (unsigned)(255 - lane);
      unsigned k1 = (fkey(c1) & ~255u) | (unsigned)(255 - (lane + 64));
      unsigned k2 = (fkey(c2v) & ~255u) | (unsigned)(255 - (lane + 128));
      unsigned k3 = (fkey(c3) & ~255u) | (unsigned)(255 - (lane + 192));
      int cm = top16_select(k0, k1, k2, k3, 8, lane);
      int ca = (cm >> 4) & 15, cb = cm & 15;
      float ts = (lane < 16) ? (ws1[ca] + ws2[cb]) : -1e30f;
      int ee = wi1[ca] * 128 + wi2[cb];
      float mx = row_max16(ts);
      float pe = __expf(ts - mx);
      float sm = row_sum16(pe);
      if (lane < 16) { eidx[hh * 16 + lane] = ee; eg[hh * 16 + lane] = pe / sm; }
      __builtin_amdgcn_fence(__ATOMIC_ACQ_REL, "wavefront");
      __builtin_amdgcn_wave_barrier();
    }
    float hx[16], acc[16];
    {
      uint4 ha = *(const uint4*)(p.H + (size_t)T * 1024 + 8 * lane), hb = *(const uint4*)(p.H + (size_t)T * 1024 + 512 + 8 * lane);
      hx[0] = bflo(ha.x); hx[1] = bfhi(ha.x); hx[2] = bflo(ha.y); hx[3] = bfhi(ha.y); hx[4] = bflo(ha.z); hx[5] = bfhi(ha.z); hx[6] = bflo(ha.w); hx[7] = bfhi(ha.w);
      hx[8] = bflo(hb.x); hx[9] = bfhi(hb.x); hx[10] = bflo(hb.y); hx[11] = bfhi(hb.y); hx[12] = bflo(hb.z); hx[13] = bfhi(hb.z); hx[14] = bflo(hb.w); hx[15] = bfhi(hb.w);
    }
#pragma unroll
    for (int i = 0; i < 16; i++) acc[i] = 0.f;
    for (int bi = 0; bi < 16; bi++) {
      uint4 ua[8], ub[8], va[8], vb[8];
#pragma unroll
      for (int j = 0; j < 8; j++) {
        int e = __builtin_amdgcn_readfirstlane(eidx[bi * 8 + j]);
        const u16* up = U + (size_t)e * 1024 + 8 * lane;
        ua[j] = *(const uint4*)up; ub[j] = *(const uint4*)(up + 512);
      }
#pragma unroll
      for (int j = 0; j < 8; j++) {
        int e = __builtin_amdgcn_readfirstlane(eidx[bi * 8 + j]);
        const u16* vp = V + (size_t)e * 1024 + 8 * lane;
        va[j] = *(const uint4*)vp; vb[j] = *(const uint4*)(vp + 512);
      }
#pragma unroll
      for (int j = 0; j < 8; j++) {
        float d = hx[0] * bflo(ua[j].x) + hx[1] * bfhi(ua[j].x) + hx[2] * bflo(ua[j].y) + hx[3] * bfhi(ua[j].y)
                + hx[4] * bflo(ua[j].z) + hx[5] * bfhi(ua[j].z) + hx[6] * bflo(ua[j].w) + hx[7] * bfhi(ua[j].w)
                + hx[8] * bflo(ub[j].x) + hx[9] * bfhi(ub[j].x) + hx[10] * bflo(ub[j].y) + hx[11] * bfhi(ub[j].y)
                + hx[12] * bflo(ub[j].z) + hx[13] * bfhi(ub[j].z) + hx[14] * bflo(ub[j].w) + hx[15] * bfhi(ub[j].w);
        float a = wave_sum(d);
        float w = eg[bi * 8 + j] * gelu_tanh(a);
        acc[0] += w * bflo(va[j].x); acc[1] += w * bfhi(va[j].x); acc[2] += w * bflo(va[j].y); acc[3] += w * bfhi(va[j].y);
        acc[4] += w * bflo(va[j].z); acc[5] += w * bfhi(va[j].z); acc[6] += w * bflo(va[j].w); acc[7] += w * bfhi(va[j].w);
        acc[8] += w * bflo(vb[j].x); acc[9] += w * bfhi(vb[j].x); acc[10] += w * bflo(vb[j].y); acc[11] += w * bfhi(vb[j].y);
        acc[12] += w * bflo(vb[j].z); acc[13] += w * bfhi(vb[j].z); acc[14] += w * bflo(vb[j].w); acc[15] += w * bfhi(vb[j].w);
      }
    }
    int mb = T < 4096 ? 0 : 1 + ((T - 4096) >> 10);
    const float* md = p.MOD + (size_t)(layer * 5 + mb) * 6144;
    float x2[16]; float ss = 0.f;
#pragma unroll
    for (int hf = 0; hf < 2; hf++) {
      int col = hf * 512 + 8 * lane;
      float4 xa = *(const float4*)(p.X + (size_t)T * 1024 + col), xb = *(const float4*)(p.X + (size_t)T * 1024 + col + 4);
      float4 ga = *(const float4*)(md + 5 * 1024 + col), gb = *(const float4*)(md + 5 * 1024 + col + 4);
      x2[hf * 8 + 0] = xa.x + ga.x * acc[hf * 8 + 0]; x2[hf * 8 + 1] = xa.y + ga.y * acc[hf * 8 + 1];
      x2[hf * 8 + 2] = xa.z + ga.z * acc[hf * 8 + 2]; x2[hf * 8 + 3] = xa.w + ga.w * acc[hf * 8 + 3];
      x2[hf * 8 + 4] = xb.x + gb.x * acc[hf * 8 + 4]; x2[hf * 8 + 5] = xb.y + gb.y * acc[hf * 8 + 5];
      x2[hf * 8 + 6] = xb.z + gb.z * acc[hf * 8 + 6]; x2[hf * 8 + 7] = xb.w + gb.w * acc[hf * 8 + 7];
    }
#pragma unroll
    for (int i = 0; i < 16; i++) ss += x2[i] * x2[i];
    ss = wave_sum(ss);
    float rstd = rsqrtf(ss * (1.f / 1024.f) + 1e-6f);
    if (layer == 0) {
      const float* md1 = p.MOD + (size_t)(5 + mb) * 6144;
#pragma unroll
      for (int hf = 0; hf < 2; hf++) {
        int col = hf * 512 + 8 * lane;
        *(float4*)(p.X + (size_t)T * 1024 + col) = make_float4(x2[hf * 8], x2[hf * 8 + 1], x2[hf * 8 + 2], x2[hf * 8 + 3]);
        *(float4*)(p.X + (size_t)T * 1024 + col + 4) = make_float4(x2[hf * 8 + 4], x2[hf * 8 + 5], x2[hf * 8 + 6], x2[hf * 8 + 7]);
        float y[8];
#pragma unroll
        for (int i = 0; i < 8; i++) {
          float g = p.norm_mix[1024 + col + i], sh = md1[col + i], scl = md1[1024 + col + i];
          y[i] = x2[hf * 8 + i] * rstd * g * (1.f + scl) + sh;
        }
        *(uint4*)(p.H + (size_t)T * 1024 + col) = make_uint4(pack2(y[0], y[1]), pack2(y[2], y[3]), pack2(y[4], y[5]), pack2(y[6], y[7]));
      }
    } else {
#pragma unroll
      for (int hf = 0; hf < 2; hf++) {
        int col = hf * 512 + 8 * lane;
        float4 ga = *(const float4*)(p.norm_final + col), gb = *(const float4*)(p.norm_final + col + 4);
        *(float4*)(p.out + (size_t)T * 1024 + col) = make_float4(x2[hf * 8] * rstd * ga.x, x2[hf * 8 + 1] * rstd * ga.y, x2[hf * 8 + 2] * rstd * ga.z, x2[hf * 8 + 3] * rstd * ga.w);
        *(float4*)(p.out + (size_t)T * 1024 + col + 4) = make_float4(x2[hf * 8 + 4] * rstd * gb.x, x2[hf * 8 + 5] * rstd * gb.y, x2[hf * 8 + 6] * rstd * gb.z, x2[hf * 8 + 7] * rstd * gb.w);
      }
    }
  }
}

constexpr int NPHASE = 16;
DEV void run_phase(const Params& p, int ph, int bid, int nb, char* smem) {
  switch (ph) {
    case 0: phase_prep(p, bid, nb, smem); break;
    case 1: phase_ada(p, 0, p.norm_mix, 0, 1, true, bid, nb); break;
    case 2: gemm_phase(p.H, 1024, p.WT_EVIN, 1024, 1024, 64, 22, bid, nb, smem, [&](int m0, int n0, const float* Cs) { epi_inproj0(p, m0, n0, Cs); }); break;
    case 3: phase_attn0(p, bid, nb, smem); break;
    case 4: gemm_phase(p.MIX, 1024, p.WT_EVOUT, 1024, 1024, 64, 8, bid, nb, smem, [&](int m0, int n0, const float* Cs) { epi_outproj(p, 0, m0, n0, Cs); }); break;
    case 5: phase_ada(p, 0, p.norm_ffn, 3, 4, false, bid, nb); break;
    case 12: phase_ada(p, 1, p.norm_ffn + 1024, 3, 4, false, bid, nb); break;
    case 6: case 13: {
      int layer = ph == 6 ? 0 : 1;
      gemm_phase(p.H, 1024, p.WT_PQ + (size_t)layer * 2048 * 1024, 1024, 1024, 64, 16, bid, nb, smem, [&](int m0, int n0, const float* Cs) {
        int lane = threadIdx.x & 63, wave = threadIdx.x >> 6;
        for (int rr = wave; rr < 128; rr += 4) {
          float2 c = *(const float2*)(Cs + rr * 128 + lane * 2);
          *(unsigned*)(p.PQ + (size_t)(m0 + rr) * 2048 + n0 + lane * 2) = pack2(c.x, c.y);
        }
      });
    } break;
    case 7: case 14: {
      int layer = ph == 7 ? 0 : 1;
      const u16* sk = p.SUBK + (size_t)layer * 16 * 128 * 128;
      for (int it = bid; it < 64 * 16; it += nb) {
        int mt = it >> 4, hc = it & 15;
        f32x16 acc[2][2];
        zero16(acc[0][0]); zero16(acc[0][1]); zero16(acc[1][0]); zero16(acc[1][1]);
        gemm_tile(p.PQ + (size_t)mt * 128 * 2048 + hc * 128, 2048, sk + (size_t)hc * 128 * 128, 128, 128, smem, acc);
        const float* Cs = (const float*)smem;
        int lane = threadIdx.x & 63, wave = threadIdx.x >> 6;
        for (int rr = wave; rr < 128; rr += 4) {
          float2 c = *(const float2*)(Cs + rr * 128 + lane * 2);
          *(float2*)(p.SC + (size_t)(mt * 128 + rr) * 2048 + hc * 128 + lane * 2) = c;
        }
      }
    } break;
    case 8: phase_peer(p, 0, bid, nb, smem); break;
    case 15: phase_peer(p, 1, bid, nb, smem); break;
    case 9: gemm_phase(p.H, 1024, p.WT_ODIN, 1024, 1024, 64, 18, bid, nb, smem, [&](int m0, int n0, const float* Cs) { epi_inproj1(p, m0, n0, Cs); }); break;
    case 10: phase_attn1(p, bid, nb, smem); break;
    case 11: gemm_phase(p.MIX, 1024, p.WT_ODOUT, 1024, 1024, 64, 8, bid, nb, smem, [&](int m0, int n0, const float* Cs) { epi_outproj(p, 1, m0, n0, Cs); }); break;
    default: break;
  }
}

template <int PH> DEV void run_all(const Params& p, cg::grid_group& grid, char* smem) {
  run_phase(p, PH, blockIdx.x, gridDim.x, smem);
  if constexpr (PH + 1 < NPHASE) { grid.sync(); run_all<PH + 1>(p, grid, smem); }
}
__global__ void __launch_bounds__(256, 2) mega_kernel(Params p) {
  __shared__ __attribute__((aligned(16))) char smem[65536];
  cg::grid_group grid = cg::this_grid();
  run_all<0>(p, grid, smem);
}
#if MULTI_LAUNCH
template <int PH> __global__ void __launch_bounds__(256, 2) phase_kernel(Params p) {
  __shared__ __attribute__((aligned(16))) char smem[65536];
  run_phase(p, PH, blockIdx.x, gridDim.x, smem);
}
template <int PH> static void launch_all(const Params& p, int grid, hipStream_t s) {
  phase_kernel<PH><<<grid, 256, 0, s>>>(p);
  if constexpr (PH + 1 < NPHASE) launch_all<PH + 1>(p, grid, s);
}
#endif

extern "C" void kernel_launch(void* const* d_in, const int* in_sizes, int n_in, void* d_out, int out_size, void* d_ws, size_t ws_size, hipStream_t stream) {
  Params p{};
  const float* const* in = (const float* const*)d_in;
  p.xp = in[0]; p.xs = in[1]; p.c = in[2]; p.cctx = in[3]; p.cak = in[4]; p.cav = in[5]; p.srf = in[6]; p.srb = in[7];
  p.cck = in[8]; p.ccv = in[9]; p.cdk = in[10]; p.cdv = in[11];
  p.mod_w = in[12]; p.mod_b = in[13]; p.norm_mix = in[14]; p.norm_ffn = in[15]; p.norm_final = in[16];
  p.ev_w_in = in[17]; p.ev_w_out = in[18]; p.a_q_norm = in[19]; p.a_k_norm = in[20]; p.rdf = in[21]; p.rdb = in[22];
  p.od_w_in = in[23]; p.od_w_out = in[24]; p.lq1 = in[25]; p.lk1 = in[26]; p.lq2 = in[27]; p.lk2 = in[28]; p.subln = in[29]; p.dsink = in[30];
  p.peer_wq = in[31]; p.peer_sk = in[32]; p.peer_u = in[33]; p.peer_v = in[34];
  p.out = (float*)d_out;
  char* w = (char*)d_ws; size_t off = 0;
  auto take = [&](size_t bytes) { char* r = w + off; off += (bytes + 255) & ~(size_t)255; return r; };
  p.MOD = (float*)take(61440 * 4);
  p.ROPEC = (float*)take(32768 * 4); p.ROPES = (float*)take(32768 * 4);
  p.X = (float*)take((size_t)8192 * 1024 * 4);
  p.SC = (float*)take((size_t)8192 * 2048 * 4);
  p.WT_EVIN = (u16*)take((size_t)2816 * 1024 * 2); p.WT_EVOUT = (u16*)take((size_t)1024 * 1024 * 2);
  p.WT_ODIN = (u16*)take((size_t)2304 * 1024 * 2); p.WT_ODOUT = (u16*)take((size_t)1024 * 1024 * 2);
  p.WT_PQ = (u16*)take((size_t)2 * 2048 * 1024 * 2); p.SUBK = (u16*)take((size_t)524288 * 2);
  p.U16 = (u16*)take((size_t)2 * 16384 * 1024 * 2); p.V16 = (u16*)take((size_t)2 * 16384 * 1024 * 2);
  p.H = (u16*)take((size_t)8192 * 1024 * 2); p.MIX = (u16*)take((size_t)8192 * 1024 * 2);
  p.Q1 = (u16*)take((size_t)8192 * 512 * 2); p.Q2 = (u16*)take((size_t)8192 * 512 * 2); p.SG = (u16*)take((size_t)8192 * 512 * 2);
  p.KA = (u16*)take((size_t)1179648 * 2); p.VA = (u16*)take((size_t)1179648 * 2);
  p.RK = (u16*)take((size_t)4194304 * 2); p.RV = (u16*)take((size_t)4194304 * 2);
  p.KC = (u16*)take((size_t)4718592 * 2); p.VC = (u16*)take((size_t)4718592 * 2);
  p.KD = (u16*)take((size_t)1179648 * 2); p.VD = (u16*)take((size_t)1179648 * 2);
  p.PQ = (u16*)take((size_t)8192 * 2048 * 2);
  (void)in_sizes; (void)n_in; (void)out_size; (void)ws_size;
#if MULTI_LAUNCH
  launch_all<0>(p, 512, stream);
#else
  static int grid_blocks = 0;
  if (!grid_blocks) {
    int dev = 0, cus = 0, per_cu = 0;
    hipGetDevice(&dev);
    hipDeviceGetAttribute(&cus, hipDeviceAttributeMultiprocessorCount, dev);
    hipOccupancyMaxActiveBlocksPerMultiprocessor(&per_cu, mega_kernel, 256, 0);
    if (per_cu > 2) per_cu = 2;
    if (per_cu < 1) per_cu = 1;
    grid_blocks = cus * per_cu;
  }
  void* args[] = {&p};
  hipError_t e = hipLaunchCooperativeKernel((void*)mega_kernel, dim3(grid_blocks), dim3(256), args, 0, stream);
  if (e != hipSuccess) fprintf(stderr, "cooperative launch failed: %s (grid %d)\n", hipGetErrorString(e), grid_blocks);
#endif
}
```

```cpp
#include <hip/hip_runtime.h>
#include <hip/hip_cooperative_groups.h>
#include <cstdio>
namespace cg = cooperative_groups;

#ifndef MULTI_LAUNCH
#define MULTI_LAUNCH 0
#endif

typedef unsigned short u16;
typedef __attribute__((ext_vector_type(8))) short bf16x8;
typedef __attribute__((ext_vector_type(16))) float f32x16;
typedef __attribute__((ext_vector_type(4))) unsigned u32x4;

#define DEV __device__ __forceinline__

constexpr size_t OUT_AK = 8388608, OUT_AV = 8912896, OUT_RF = 9437184, OUT_RB = 9961472,
                 OUT_CK = 10485760, OUT_CV = 12582912, OUT_DK = 14680064, OUT_DV = 15204352;
constexpr float LAM_INIT = 0.35550906f;

struct Params {
  const float *xp, *xs, *c, *cctx, *cak, *cav, *srf, *srb, *cck, *ccv, *cdk, *cdv;
  const float *mod_w, *mod_b, *norm_mix, *norm_ffn, *norm_final;
  const float *ev_w_in, *ev_w_out, *a_q_norm, *a_k_norm, *rdf, *rdb;
  const float *od_w_in, *od_w_out, *lq1, *lk1, *lq2, *lk2, *subln, *dsink;
  const float *peer_wq, *peer_sk, *peer_u, *peer_v;
  float* out;
  float *MOD, *ROPEC, *ROPES, *X, *SC;
  u16 *WT_EVIN, *WT_EVOUT, *WT_ODIN, *WT_ODOUT, *WT_PQ, *SUBK, *U16, *V16, *H, *MIX, *Q1, *Q2, *SG;
  u16 *KA, *VA, *RK, *RV, *KC, *VC, *KD, *VD, *PQ;
  unsigned* BAR;
};

DEV u16 f2bf(float f) { unsigned u = __float_as_uint(f); u += 0x7fffu + ((u >> 16) & 1u); return (u16)(u >> 16); }
DEV float bf2f(unsigned b) { return __uint_as_float(b << 16); }
DEV unsigned pack2(float a, float b) { return (unsigned)f2bf(a) | ((unsigned)f2bf(b) << 16); }
DEV float bflo(unsigned w) { return __uint_as_float(w << 16); }
DEV float bfhi(unsigned w) { return __uint_as_float(w & 0xffff0000u); }
DEV float silu_f(float v) { return v / (1.f + __expf(-v)); }
DEV float gelu_tanh(float a) {
  float z = 0.7978845608f * (a + 0.044715f * a * a * a);
  float e = __expf(2.f * z);
  float th = 1.f - 2.f / (e + 1.f);
  return 0.5f * a * (1.f + th);
}
template <int CTRL> DEV float dpp_f(float v) {
  return __int_as_float(__builtin_amdgcn_update_dpp(0, __float_as_int(v), CTRL, 0xF, 0xF, true));
}
template <int CTRL> DEV unsigned dpp_u(unsigned v) {
  return (unsigned)__builtin_amdgcn_update_dpp(0, (int)v, CTRL, 0xF, 0xF, true);
}
DEV float row_sum16(float v) {
  v += dpp_f<0xB1>(v); v += dpp_f<0x4E>(v); v += dpp_f<0x141>(v); v += dpp_f<0x140>(v); return v;
}
DEV float row_max16(float v) {
  v = fmaxf(v, dpp_f<0xB1>(v)); v = fmaxf(v, dpp_f<0x4E>(v)); v = fmaxf(v, dpp_f<0x141>(v)); v = fmaxf(v, dpp_f<0x140>(v)); return v;
}
DEV float rlane(float v, int l) { return __int_as_float(__builtin_amdgcn_readlane(__float_as_int(v), l)); }
DEV float wave_sum(float v) {
  v = row_sum16(v);
  return (rlane(v, 0) + rlane(v, 16)) + (rlane(v, 32) + rlane(v, 48));
}
DEV unsigned wave_max_u(unsigned v) {
  v = max(v, dpp_u<0xB1>(v)); v = max(v, dpp_u<0x4E>(v)); v = max(v, dpp_u<0x141>(v)); v = max(v, dpp_u<0x140>(v));
  unsigned a = (unsigned)__builtin_amdgcn_readlane((int)v, 0), b = (unsigned)__builtin_amdgcn_readlane((int)v, 16);
  unsigned c = (unsigned)__builtin_amdgcn_readlane((int)v, 32), d = (unsigned)__builtin_amdgcn_readlane((int)v, 48);
  return max(max(a, b), max(c, d));
}
DEV float half_sum32(float v) { v = row_sum16(v); return v + __shfl_xor(v, 16); }
DEV unsigned fkey(float f) { unsigned u = __float_as_uint(f); return (u & 0x80000000u) ? ~u : (u | 0x80000000u); }
DEV f32x16 mfma32(bf16x8 a, bf16x8 b, f32x16 c) { return __builtin_amdgcn_mfma_f32_32x32x16_bf16(a, b, c, 0, 0, 0); }
DEV void zero16(f32x16& v) {
#pragma unroll
  for (int i = 0; i < 16; i++) v[i] = 0.f;
}
DEV size_t kvoff(bool smp, int b, int hh, int tpos, int H, int DW, int LS, int off) {
  return smp ? (size_t)4096 * H * DW + ((size_t)(b * H + hh) * LS + off + tpos) * DW
             : ((size_t)(b * H + hh) * 256 + tpos) * DW;
}

DEV void prep_transpose(const float* __restrict__ W, int N, u16* __restrict__ Wt, int tile, float* sm) {
  int ntn = N >> 6; int kt = tile / ntn, nt = tile % ntn;
  int k0 = kt * 64, n0 = nt * 64; int t = threadIdx.x;
#pragma unroll
  for (int i = 0; i < 4; i++) {
    int k = (t >> 4) + 16 * i; int c4 = (t & 15) * 4;
    float4 v = *(const float4*)(W + (size_t)(k0 + k) * N + n0 + c4);
    sm[k * 65 + c4] = v.x; sm[k * 65 + c4 + 1] = v.y; sm[k * 65 + c4 + 2] = v.z; sm[k * 65 + c4 + 3] = v.w;
  }
  __syncthreads();
  int n = t >> 2, kc = (t & 3) * 16;
  unsigned pk[8];
#pragma unroll
  for (int j = 0; j < 8; j++) pk[j] = pack2(sm[(kc + 2 * j) * 65 + n], sm[(kc + 2 * j + 1) * 65 + n]);
  uint4* dst = (uint4*)(Wt + (size_t)(n0 + n) * 1024 + k0 + kc);
  dst[0] = make_uint4(pk[0], pk[1], pk[2], pk[3]);
  dst[1] = make_uint4(pk[4], pk[5], pk[6], pk[7]);
  __syncthreads();
}
DEV void conv_item(const float* __restrict__ src, u16* __restrict__ dst) {
  int t = threadIdx.x;
#pragma unroll
  for (int i = 0; i < 8; i++) {
    int e = (i * 256 + t) * 8;
    float4 a = *(const float4*)(src + e), b = *(const float4*)(src + e + 4);
    *(uint4*)(dst + e) = make_uint4(pack2(a.x, a.y), pack2(a.z, a.w), pack2(b.x, b.y), pack2(b.z, b.w));
  }
}
DEV void prep_mod(const Params& p, int it, float* sm) {
  int l = it / 96, n0 = (it % 96) * 64; int t = threadIdx.x;
  float* sc = sm;
  for (int i = t; i < 5120; i += 256) {
    int b = i >> 10, k = i & 1023;
    float v = (b == 0) ? p.cctx[k] : p.c[(b - 1) * 1024 + k];
    sc[i] = silu_f(v);
  }
  __syncthreads();
  int col = t & 63, kg = t >> 6;
  float a0 = 0, a1 = 0, a2 = 0, a3 = 0, a4 = 0;
  const float* w = p.mod_w + (size_t)l * 1024 * 6144 + n0 + col;
  for (int k = kg; k < 1024; k += 4) {
    float wv = w[(size_t)k * 6144];
    a0 += sc[k] * wv; a1 += sc[1024 + k] * wv; a2 += sc[2048 + k] * wv; a3 += sc[3072 + k] * wv; a4 += sc[4096 + k] * wv;
  }
  float* red = sm + 5120;
  red[(kg * 5 + 0) * 64 + col] = a0; red[(kg * 5 + 1) * 64 + col] = a1; red[(kg * 5 + 2) * 64 + col] = a2;
  red[(kg * 5 + 3) * 64 + col] = a3; red[(kg * 5 + 4) * 64 + col] = a4;
  __syncthreads();
  if (t < 64) {
#pragma unroll
    for (int b = 0; b < 5; b++) {
      float s = red[(0 * 5 + b) * 64 + t] + red[(1 * 5 + b) * 64 + t] + red[(2 * 5 + b) * 64 + t] + red[(3 * 5 + b) * 64 + t];
      p.MOD[(size_t)(l * 5 + b) * 6144 + n0 + t] = s + p.mod_b[l * 6144 + n0 + t];
    }
  }
  __syncthreads();
}
DEV void prep_cache(const Params& p, int it) {
  const float* src; u16* dst;
  if (it < 8)       { int ch = it;      src = p.cak + (size_t)ch * 16384; dst = p.KA + (size_t)4096 * 2 * 64 + (size_t)ch * 1280 * 64; }
  else if (it < 16) { int ch = it - 8;  src = p.cav + (size_t)ch * 16384; dst = p.VA + (size_t)4096 * 2 * 64 + (size_t)ch * 1280 * 64; }
  else if (it < 48) { int ch = it - 16; src = p.cck + (size_t)ch * 16384; dst = p.KC + (size_t)4096 * 8 * 64 + (size_t)ch * 1280 * 64; }
  else if (it < 80) { int ch = (it - 48) >> 1, hf = (it - 48) & 1;
                      src = p.ccv + (size_t)ch * 32768 + hf * 16384; dst = p.VC + (size_t)4096 * 4 * 128 + (size_t)ch * 1280 * 128 + hf * 16384; }
  else if (it < 88) { int ch = it - 80; src = p.cdk + (size_t)ch * 16384; dst = p.KD + (size_t)4096 * 2 * 64 + (size_t)ch * 1280 * 64; }
  else              { int ch = it - 88; src = p.cdv + (size_t)ch * 16384; dst = p.VD + (size_t)4096 * 2 * 64 + (size_t)ch * 1280 * 64; }
  conv_item(src, dst);
}
DEV void prep_rope(const Params& p, int it) {
  for (int i = 0; i < 16; i++) {
    int idx = it * 4096 + i * 256 + threadIdx.x;
    int tpos = idx >> 5, a = idx & 31;
    float pos = (a < 16) ? (float)(tpos >> 6) : (float)(tpos & 63);
    float inv = exp2f(-(float)(a & 15) * (13.287712379549449f / 16.f));
    float ang = pos * inv;
    p.ROPEC[idx] = __cosf(ang); p.ROPES[idx] = __sinf(ang);
  }
}
constexpr int PREP_T0 = 704, PREP_T1 = PREP_T0 + 256, PREP_T2 = PREP_T1 + 576, PREP_T3 = PREP_T2 + 256, PREP_T4 = PREP_T3 + 1024;
constexpr int PREP_U = PREP_T4 + 2048, PREP_V = PREP_U + 2048, PREP_SK = PREP_V + 32, PREP_CA = PREP_SK + 96, PREP_RO = PREP_CA + 8, PREP_MOD = PREP_RO + 192;
DEV void phase_prep(const Params& p, int bid, int nb, char* smem) {
  float* sm = (float*)smem;
  for (int it0 = bid; it0 < PREP_MOD; it0 += nb) {
    int it = (it0 < 192) ? (PREP_RO + it0) : (it0 - 192);
    if (it < PREP_T0) prep_transpose(p.ev_w_in, 2816, p.WT_EVIN, it, sm);
    else if (it < PREP_T1) prep_transpose(p.ev_w_out, 1024, p.WT_EVOUT, it - PREP_T0, sm);
    else if (it < PREP_T2) prep_transpose(p.od_w_in, 2304, p.WT_ODIN, it - PREP_T1, sm);
    else if (it < PREP_T3) prep_transpose(p.od_w_out, 1024, p.WT_ODOUT, it - PREP_T2, sm);
    else if (it < PREP_T4) { int j = it - PREP_T3; int l = j >> 9; prep_transpose(p.peer_wq + (size_t)l * 1024 * 2048, 2048, p.WT_PQ + (size_t)l * 2048 * 1024, j & 511, sm); }
    else if (it < PREP_U) { size_t o = (size_t)(it - PREP_T4) * 16384; conv_item(p.peer_u + o, p.U16 + o); }
    else if (it < PREP_V) { size_t o = (size_t)(it - PREP_U) * 16384; conv_item(p.peer_v + o, p.V16 + o); }
    else if (it < PREP_SK) { size_t o = (size_t)(it - PREP_V) * 16384; conv_item(p.peer_sk + o, p.SUBK + o); }
    else if (it < PREP_CA) prep_cache(p, it - PREP_SK);
    else if (it < PREP_RO) prep_rope(p, it - PREP_CA);
    else prep_mod(p, it - PREP_RO, sm);
  }
}

DEV void phase_ada(const Params& p, int layer, const float* __restrict__ gain, int shift_i, int scale_i, bool from_input, int bid, int nb) {
  int wave = threadIdx.x >> 6, lane = threadIdx.x & 63;
  for (int T = bid * 4 + wave; T < 8192; T += nb * 4) {
    const float* xr = from_input ? (T < 4096 ? p.xp + (size_t)T * 1024 : p.xs + (size_t)(T - 4096) * 1024) : p.X + (size_t)T * 1024;
    int mb = T < 4096 ? 0 : 1 + ((T - 4096) >> 10);
    const float* md = p.MOD + (size_t)(layer * 5 + mb) * 6144;
    float4 v[4]; float ss = 0;
#pragma unroll
    for (int i = 0; i < 4; i++) { v[i] = *(const float4*)(xr + (i * 64 + lane) * 4); ss += v[i].x * v[i].x + v[i].y * v[i].y + v[i].z * v[i].z + v[i].w * v[i].w; }
    ss = wave_sum(ss);
    float rstd = rsqrtf(ss * (1.f / 1024.f) + 1e-6f);
#pragma unroll
    for (int i = 0; i < 4; i++) {
      int col = (i * 64 + lane) * 4;
      float4 g = *(const float4*)(gain + col), sh = *(const float4*)(md + shift_i * 1024 + col), sc = *(const float4*)(md + scale_i * 1024 + col);
      float y0 = v[i].x * rstd * g.x * (1.f + sc.x) + sh.x, y1 = v[i].y * rstd * g.y * (1.f + sc.y) + sh.y;
      float y2 = v[i].z * rstd * g.z * (1.f + sc.z) + sh.z, y3 = v[i].w * rstd * g.w * (1.f + sc.w) + sh.w;
      *(uint2*)(p.H + (size_t)T * 1024 + col) = make_uint2(pack2(y0, y1), pack2(y2, y3));
    }
  }
}

DEV void gemm_tile(const u16* __restrict__ A, int lda, const u16* __restrict__ B, int ldb, int K, char* smem, f32x16 (&acc)[2][2]) {
  u16* sA = (u16*)smem; u16* sB = sA + 128 * 72;
  int t = threadIdx.x, lane = t & 63, wave = t >> 6, r = lane & 31, h = lane >> 5;
  int wm = wave >> 1, wn = wave & 1;
  int lrow = t >> 3, lkc = (t & 7) * 8;
  const u16* ap = A + (size_t)lrow * lda + lkc;
  const u16* bp = B + (size_t)lrow * ldb + lkc;
  size_t sa32 = (size_t)32 * lda, sb32 = (size_t)32 * ldb;
  u32x4 ra0 = *(const u32x4*)(ap), ra1 = *(const u32x4*)(ap + sa32), ra2 = *(const u32x4*)(ap + 2 * sa32), ra3 = *(const u32x4*)(ap + 3 * sa32);
  u32x4 rb0 = *(const u32x4*)(bp), rb1 = *(const u32x4*)(bp + sb32), rb2 = *(const u32x4*)(bp + 2 * sb32), rb3 = *(const u32x4*)(bp + 3 * sb32);
  u16* wa = sA + lrow * 72 + lkc; u16* wb = sB + lrow * 72 + lkc;
  for (int k0 = 0; k0 < K; k0 += 64) {
    __syncthreads();
    *(u32x4*)(wa) = ra0; *(u32x4*)(wa + 32 * 72) = ra1; *(u32x4*)(wa + 64 * 72) = ra2; *(u32x4*)(wa + 96 * 72) = ra3;
    *(u32x4*)(wb) = rb0; *(u32x4*)(wb + 32 * 72) = rb1; *(u32x4*)(wb + 64 * 72) = rb2; *(u32x4*)(wb + 96 * 72) = rb3;
    __syncthreads();
    if (k0 + 64 < K) {
      ap += 64; bp += 64;
      ra0 = *(const u32x4*)(ap); ra1 = *(const u32x4*)(ap + sa32); ra2 = *(const u32x4*)(ap + 2 * sa32); ra3 = *(const u32x4*)(ap + 3 * sa32);
      rb0 = *(const u32x4*)(bp); rb1 = *(const u32x4*)(bp + sb32); rb2 = *(const u32x4*)(bp + 2 * sb32); rb3 = *(const u32x4*)(bp + 3 * sb32);
    }
#pragma unroll
    for (int kk = 0; kk < 4; kk++) {
      bf16x8 a0 = *(const bf16x8*)(sA + (wm * 64 + r) * 72 + kk * 16 + h * 8);
      bf16x8 a1 = *(const bf16x8*)(sA + (wm * 64 + 32 + r) * 72 + kk * 16 + h * 8);
      bf16x8 b0 = *(const bf16x8*)(sB + (wn * 64 + r) * 72 + kk * 16 + h * 8);
      bf16x8 b1 = *(const bf16x8*)(sB + (wn * 64 + 32 + r) * 72 + kk * 16 + h * 8);
      acc[0][0] = mfma32(a0, b0, acc[0][0]); acc[0][1] = mfma32(a0, b1, acc[0][1]);
      acc[1][0] = mfma32(a1, b0, acc[1][0]); acc[1][1] = mfma32(a1, b1, acc[1][1]);
    }
  }
  __syncthreads();
  float* Cs = (float*)smem;
#pragma unroll
  for (int i = 0; i < 2; i++)
#pragma unroll
    for (int j = 0; j < 2; j++)
#pragma unroll
      for (int g = 0; g < 16; g++)
        Cs[(wm * 64 + i * 32 + (g & 3) + 8 * (g >> 2) + 4 * h) * 128 + wn * 64 + j * 32 + r] = acc[i][j][g];
  __syncthreads();
}

template <class Epi>
DEV void gemm_phase(const u16* A, int lda, const u16* Bt, int ldb, int K, int MT, int NTl, int bid, int nb, char* smem, Epi epi) {
  for (int it = bid; it < MT * NTl; it += nb) {
    int mt = it / NTl, nt = it % NTl;
    f32x16 acc[2][2];
    zero16(acc[0][0]); zero16(acc[0][1]); zero16(acc[1][0]); zero16(acc[1][1]);
    gemm_tile(A + (size_t)mt * 128 * lda, lda, Bt + (size_t)nt * 128 * ldb, ldb, K, smem, acc);
    epi(mt * 128, nt * 128, (const float*)smem);
  }
}

DEV void tok_decode(int T, bool& smp, int& b, int& tpos) {
  smp = T >= 4096;
  if (!smp) { b = T >> 8; tpos = T & 255; } else { b = (T - 4096) >> 10; tpos = (T - 4096) & 1023; }
}
DEV void rope_pair(const Params& p, float& x, float& y, int tpos, int d) {
  float px = __shfl_xor(x, 16), py = __shfl_xor(y, 16);
  int a = d & 31;
  float c0 = p.ROPEC[tpos * 32 + a], c1 = p.ROPEC[tpos * 32 + a + 1];
  float s0 = p.ROPES[tpos * 32 + a], s1 = p.ROPES[tpos * 32 + a + 1];
  if (d < 32) { x = x * c0 - px * s0; y = y * c1 - py * s1; }
  else        { x = px * s0 + x * c0; y = py * s1 + y * c1; }
}

DEV void epi_inproj0(const Params& p, int m0, int n0, const float* Cs) {
  int lane = threadIdx.x & 63, wave = threadIdx.x >> 6;
  for (int rr = wave; rr < 128; rr += 4) {
    int T = m0 + rr; bool smp; int b, tpos; tok_decode(T, smp, b, tpos);
    float2 c = *(const float2*)(Cs + rr * 128 + lane * 2);
    int col = n0 + lane * 2; int d = col & 63;
    if (n0 < 640) {
      float ss = half_sum32(c.x * c.x + c.y * c.y);
      float rstd = rsqrtf(ss * (1.f / 64.f) + 1e-6f);
      const float* g = (n0 < 512) ? p.a_q_norm : p.a_k_norm;
      c.x *= rstd * g[d]; c.y *= rstd * g[d + 1];
      if (smp) rope_pair(p, c.x, c.y, tpos, d);
      if (n0 < 512) {
        *(unsigned*)(p.Q1 + (size_t)T * 512 + col) = pack2(c.x * 0.125f, c.y * 0.125f);
      } else {
        int hh = (col - 512) >> 6;
        *(unsigned*)(p.KA + kvoff(smp, b, hh, tpos, 2, 64, 1280, 256) + d) = pack2(c.x, c.y);
        if (!smp) *(float2*)(p.out + OUT_AK + ((size_t)(b * 2 + hh) * 256 + tpos) * 64 + d) = c;
      }
    } else if (n0 < 768) {
      int hh = (col - 640) >> 6;
      *(unsigned*)(p.VA + kvoff(smp, b, hh, tpos, 2, 64, 1280, 256) + d) = pack2(c.x, c.y);
      if (!smp) *(float2*)(p.out + OUT_AV + ((size_t)(b * 2 + hh) * 256 + tpos) * 64 + d) = c;
    } else if (n0 < 1280) {
      *(unsigned*)(p.Q2 + (size_t)T * 512 + (col - 768)) = pack2(c.x, c.y);
    } else if (n0 < 1792) {
      int hh = (col - 1280) >> 6;
      *(unsigned*)(p.RK + kvoff(smp, b, hh, tpos, 8, 64, 1024, 0) + d) = pack2(c.x * 0.125f, c.y * 0.125f);
    } else if (n0 < 2304) {
      int hh = (col - 1792) >> 6;
      *(unsigned*)(p.RV + kvoff(smp, b, hh, tpos, 8, 64, 1024, 0) + d) = pack2(c.x, c.y);
    } else {
      *(unsigned*)(p.SG + (size_t)T * 512 + (col - 2304)) = pack2(silu_f(c.x), silu_f(c.y));
    }
  }
}
DEV void epi_inproj1(const Params& p, int m0, int n0, const float* Cs) {
  int lane = threadIdx.x & 63, wave = threadIdx.x >> 6;
  for (int rr = wave; rr < 128; rr += 4) {
    int T = m0 + rr; bool smp; int b, tpos; tok_decode(T, smp, b, tpos);
    float2 c = *(const float2*)(Cs + rr * 128 + lane * 2);
    int col = n0 + lane * 2; int d = col & 63;
    if (n0 < 512) {
      if (smp) rope_pair(p, c.x, c.y, tpos, d);
      *(unsigned*)(p.Q1 + (size_t)T * 512 + col) = pack2(c.x * 0.125f, c.y * 0.125f);
    } else if (n0 < 1024) {
      int mp = (col - 512) >> 6;
      if (!smp) *(float2*)(p.out + OUT_CK + ((size_t)(b * 8 + mp) * 256 + tpos) * 64 + d) = c;
      if (smp) rope_pair(p, c.x, c.y, tpos, d);
      *(unsigned*)(p.KC + kvoff(smp, b, mp, tpos, 8, 64, 1280, 256) + d) = pack2(c.x, c.y);
    } else if (n0 < 1536) {
      int hh = (col - 1024) >> 7; int dd = (col - 1024) & 127;
      if (!smp) *(float2*)(p.out + OUT_CV + ((size_t)(b * 4 + hh) * 256 + tpos) * 128 + dd) = c;
      *(unsigned*)(p.VC + kvoff(smp, b, hh, tpos, 4, 128, 1280, 256) + dd) = pack2(c.x, c.y);
    } else if (n0 < 2048) {
      if (smp) rope_pair(p, c.x, c.y, tpos, d);
      *(unsigned*)(p.Q2 + (size_t)T * 512 + (col - 1536)) = pack2(c.x * 0.125f, c.y * 0.125f);
    } else if (n0 < 2176) {
      int hh = (col - 2048) >> 6;
      if (!smp) *(float2*)(p.out + OUT_DK + ((size_t)(b * 2 + hh) * 256 + tpos) * 64 + d) = c;
      if (smp) rope_pair(p, c.x, c.y, tpos, d);
      *(unsigned*)(p.KD + kvoff(smp, b, hh, tpos, 2, 64, 1280, 256) + d) = pack2(c.x, c.y);
    } else {
      int hh = (col - 2176) >> 6;
      if (!smp) *(float2*)(p.out + OUT_DV + ((size_t)(b * 2 + hh) * 256 + tpos) * 64 + d) = c;
      *(unsigned*)(p.VD + kvoff(smp, b, hh, tpos, 2, 64, 1280, 256) + d) = pack2(c.x, c.y);
    }
  }
}
DEV void epi_outproj(const Params& p, int layer, int m0, int n0, const float* Cs) {
  int lane = threadIdx.x & 63, wave = threadIdx.x >> 6;
  for (int rr = wave; rr < 128; rr += 4) {
    int T = m0 + rr;
    int mb = T < 4096 ? 0 : 1 + ((T - 4096) >> 10);
    const float* xr = (layer == 0) ? (T < 4096 ? p.xp + (size_t)T * 1024 : p.xs + (size_t)(T - 4096) * 1024) : p.X + (size_t)T * 1024;
    float2 c = *(const float2*)(Cs + rr * 128 + lane * 2);
    int col = n0 + lane * 2;
    float2 x = *(const float2*)(xr + col);
    float2 g = *(const float2*)(p.MOD + (size_t)(layer * 5 + mb) * 6144 + 2048 + col);
    x.x += g.x * c.x; x.y += g.y * c.y;
    *(float2*)(p.X + (size_t)T * 1024 + col) = x;
  }
}

DEV void load_k_tile(const u16* __restrict__ k, u16* sK) {
  int t = threadIdx.x;
#pragma unroll
  for (int i = 0; i < 2; i++) {
    int c = t + 256 * i; int key = c >> 3, dc = c & 7;
    *(uint4*)(sK + key * 72 + dc * 8) = *(const uint4*)(k + key * 64 + dc * 8);
  }
}
template <int DV> DEV void load_v_tile(const u16* __restrict__ v, u16* sVT) {
  int lane = threadIdx.x & 63, wave = threadIdx.x >> 6;
#pragma unroll
  for (int i = 0; i < DV / 32; i++) {
    int dc = wave + 4 * i;
    uint4 x = *(const uint4*)(v + (size_t)lane * DV + dc * 8);
    u16* d = sVT + (dc * 8) * 76 + lane;
    d[0 * 76] = (u16)(x.x & 0xffff); d[1 * 76] = (u16)(x.x >> 16);
    d[2 * 76] = (u16)(x.y & 0xffff); d[3 * 76] = (u16)(x.y >> 16);
    d[4 * 76] = (u16)(x.z & 0xffff); d[5 * 76] = (u16)(x.z >> 16);
    d[6 * 76] = (u16)(x.w & 0xffff); d[7 * 76] = (u16)(x.w >> 16);
  }
}
DEV void load_ident_k(u16* sK) {
  int t = threadIdx.x;
#pragma unroll
  for (int i = 0; i < 2; i++) {
    int c = t + 256 * i; int key = c >> 3, dc = c & 7;
    unsigned w[4] = {0u, 0u, 0u, 0u};
    uint4 z = make_uint4(0u, 0u, 0u, 0u);
    if (dc == (key >> 3)) {
      int e = key & 7; unsigned one = (e & 1) ? 0x3F800000u : 0x00003F80u;
      if ((e >> 1) == 0) z.x = one; else if ((e >> 1) == 1) z.y = one; else if ((e >> 1) == 2) z.z = one; else z.w = one;
    }
    (void)w;
    *(uint4*)(sK + key * 72 + dc * 8) = z;
  }
}
DEV void load_state_v(const float* __restrict__ S0, u16* sVT) {
  int lane = threadIdx.x & 63, wave = threadIdx.x >> 6;
#pragma unroll
  for (int i = 0; i < 2; i++) {
    int dc = wave + 4 * i;
    float4 a = *(const float4*)(S0 + lane * 64 + dc * 8), b = *(const float4*)(S0 + lane * 64 + dc * 8 + 4);
    u16* d = sVT + (dc * 8) * 76 + lane;
    d[0 * 76] = f2bf(a.x); d[1 * 76] = f2bf(a.y); d[2 * 76] = f2bf(a.z); d[3 * 76] = f2bf(a.w);
    d[4 * 76] = f2bf(b.x); d[5 * 76] = f2bf(b.y); d[6 * 76] = f2bf(b.z); d[7 * 76] = f2bf(b.w);
  }
}
template <int DV, class F>
DEV void attn_compute(const bf16x8 (&qf)[4], f32x16 (&o)[DV / 32], const u16* sK, const u16* sVT, F&& xform) {
  int lane = threadIdx.x & 63, r = lane & 31, h = lane >> 5;
  f32x16 st[2]; zero16(st[0]); zero16(st[1]);
#pragma unroll
  for (int sub = 0; sub < 2; sub++)
#pragma unroll
    for (int kk = 0; kk < 4; kk++) {
      bf16x8 kf = *(const bf16x8*)(sK + (sub * 32 + r) * 72 + kk * 16 + h * 8);
      st[sub] = mfma32(kf, qf[kk], st[sub]);
    }
  xform(st);
  bf16x8 pf[2][2];
#pragma unroll
  for (int sub = 0; sub < 2; sub++)
#pragma unroll
    for (int s = 0; s < 2; s++) {
      u32x4 w;
      w[0] = pack2(st[sub][8 * s + 0], st[sub][8 * s + 1]); w[1] = pack2(st[sub][8 * s + 2], st[sub][8 * s + 3]);
      w[2] = pack2(st[sub][8 * s + 4], st[sub][8 * s + 5]); w[3] = pack2(st[sub][8 * s + 6], st[sub][8 * s + 7]);
      pf[sub][s] = __builtin_bit_cast(bf16x8, w);
    }
#pragma unroll
  for (int ds = 0; ds < DV / 32; ds++)
#pragma unroll
    for (int sub = 0; sub < 2; sub++)
#pragma unroll
      for (int s = 0; s < 2; s++) {
        const u16* vp = sVT + (ds * 32 + r) * 76 + sub * 32 + s * 16 + 4 * h;
        uint2 lo = *(const uint2*)vp, hi = *(const uint2*)(vp + 8);
        u32x4 w; w[0] = lo.x; w[1] = lo.y; w[2] = hi.x; w[3] = hi.y;
        o[ds] = mfma32(__builtin_bit_cast(bf16x8, w), pf[sub][s], o[ds]);
      }
}
template <int DV>
DEV void softmax_xform(f32x16 (&st)[2], f32x16 (&o)[DV / 32], float& m, float& l, bool masked, int kpos0, int qpos) {
  int h = (threadIdx.x & 63) >> 5;
  float mx = -1e30f;
#pragma unroll
  for (int sub = 0; sub < 2; sub++)
#pragma unroll
    for (int g = 0; g < 16; g++) {
      float s = st[sub][g];
      if (masked) {
        int j = kpos0 + sub * 32 + (g & 3) + 8 * (g >> 2) + 4 * h;
        int dl = qpos - j; if (dl < 0) dl = -dl;
        if (dl > 128) s = -1e30f;
        st[sub][g] = s;
      }
      mx = fmaxf(mx, s);
    }
  mx = fmaxf(mx, __shfl_xor(mx, 32));
  float mnew = fmaxf(m, mx);
  float alpha = __expf(m - mnew);
  m = mnew;
  float ls = 0.f;
#pragma unroll
  for (int sub = 0; sub < 2; sub++)
#pragma unroll
    for (int g = 0; g < 16; g++) { float pv = __expf(st[sub][g] - mnew); st[sub][g] = pv; ls += pv; }
  l = l * alpha + ls;
#pragma unroll
  for (int ds = 0; ds < DV / 32; ds++)
#pragma unroll
    for (int g = 0; g < 16; g++) o[ds][g] *= alpha;
}

template <int DV>
DEV void attn_softmax_job(const Params& p, const u16* Q, int Tq0, int qcol, const u16* kb, const u16* vb,
                          int nplain, int band_lo, int band_hi, int qpos0, bool use_sink, float sinkv,
                          f32x16 (&o)[DV / 32], char* smem) {
  u16* sK = (u16*)smem; u16* sVT = sK + 64 * 72;
  int lane = threadIdx.x & 63, wave = threadIdx.x >> 6, r = lane & 31, h = lane >> 5;
  bf16x8 qf[4];
#pragma unroll
  for (int kk = 0; kk < 4; kk++) qf[kk] = *(const bf16x8*)(Q + (size_t)(Tq0 + wave * 32 + r) * 512 + qcol + kk * 16 + h * 8);
#pragma unroll
  for (int ds = 0; ds < DV / 32; ds++) zero16(o[ds]);
  float m = use_sink ? sinkv : -1e30f;
  float l = (use_sink && h == 0) ? 1.f : 0.f;
  int qpos = qpos0 + wave * 32 + r;
  int ntot = nplain + (band_hi - band_lo);
  for (int ti = 0; ti < ntot; ti++) {
    bool masked = ti >= nplain;
    int key0 = masked ? (256 + (band_lo + ti - nplain) * 64) : ti * 64;
    int kpos0 = key0 - 256;
    __syncthreads();
    load_k_tile(kb + (size_t)key0 * 64, sK);
    load_v_tile<DV>(vb + (size_t)key0 * DV, sVT);
    __syncthreads();
    attn_compute<DV>(qf, o, sK, sVT, [&](f32x16 (&st)[2]) { softmax_xform<DV>(st, o, m, l, masked, kpos0, qpos); });
  }
  float lt = l + __shfl_xor(l, 32);
  float inv = 1.f / lt;
#pragma unroll
  for (int ds = 0; ds < DV / 32; ds++)
#pragma unroll
    for (int g = 0; g < 16; g++) o[ds][g] *= inv;
}
DEV void store_o64(const Params& p, const f32x16 (&o)[2], int Tq0, int mixcol) {
  int lane = threadIdx.x & 63, wave = threadIdx.x >> 6, r = lane & 31, h = lane >> 5;
  int T = Tq0 + wave * 32 + r;
#pragma unroll
  for (int ds = 0; ds < 2; ds++)
#pragma unroll
    for (int g4 = 0; g4 < 4; g4++) {
      int d0 = ds * 32 + 8 * g4 + 4 * h;
      *(uint2*)(p.MIX + (size_t)T * 1024 + mixcol + d0) =
          make_uint2(pack2(o[ds][4 * g4], o[ds][4 * g4 + 1]), pack2(o[ds][4 * g4 + 2], o[ds][4 * g4 + 3]));
    }
}

DEV void ret_job(const Params& p, bool smp, int b, int hh, int qb, char* smem) {
  u16* sK = (u16*)smem; u16* sVT = sK + 64 * 72;
  int lane = threadIdx.x & 63, wave = threadIdx.x >> 6, r = lane & 31, h = lane >> 5;
  int L = smp ? 1024 : 256;
  int Tq0 = (smp ? 4096 + b * 1024 : b * 256) + qb * 128;
  const u16* kb = p.RK + kvoff(smp, b, hh, 0, 8, 64, 1024, 0);
  const u16* vb = p.RV + kvoff(smp, b, hh, 0, 8, 64, 1024, 0);
  float xf = p.rdf[hh], xb = p.rdb[hh];
  float lf2 = -log1pf(__expf(-xf)) * 1.4426950408889634f;
  float lb2 = -log1pf(__expf(-xb)) * 1.4426950408889634f;
  bf16x8 qf[4];
#pragma unroll
  for (int kk = 0; kk < 4; kk++) qf[kk] = *(const bf16x8*)(p.Q2 + (size_t)(Tq0 + wave * 32 + r) * 512 + hh * 64 + kk * 16 + h * 8);
  f32x16 o[2]; zero16(o[0]); zero16(o[1]);
  int qpos = qb * 128 + wave * 32 + r;
  int nt = L / 64;
  for (int ti = 0; ti < nt; ti++) {
    __syncthreads();
    load_k_tile(kb + (size_t)ti * 64 * 64, sK);
    load_v_tile<64>(vb + (size_t)ti * 64 * 64, sVT);
    __syncthreads();
    int kpos0 = ti * 64;
    attn_compute<64>(qf, o, sK, sVT, [&](f32x16 (&st)[2]) {
#pragma unroll
      for (int sub = 0; sub < 2; sub++)
#pragma unroll
        for (int g = 0; g < 16; g++) {
          int j = kpos0 + sub * 32 + (g & 3) + 8 * (g >> 2) + 4 * h;
          int dl = qpos - j;
          float e = dl >= 0 ? lf2 * (float)dl : lb2 * (float)(-dl);
          st[sub][g] *= exp2f(e);
        }
    });
  }
  if (smp) {
    for (int dir = 0; dir < 2; dir++) {
      const float* S0 = (dir == 0 ? p.srf : p.srb) + (size_t)(b * 8 + hh) * 4096;
      float rs = dir == 0 ? exp2f(lf2 * (float)(qpos + 1)) : exp2f(lb2 * (float)(L - qpos));
      __syncthreads();
      load_ident_k(sK);
      load_state_v(S0, sVT);
      __syncthreads();
      attn_compute<64>(qf, o, sK, sVT, [&](f32x16 (&st)[2]) {
#pragma unroll
        for (int sub = 0; sub < 2; sub++)
#pragma unroll
          for (int g = 0; g < 16; g++) st[sub][g] *= rs;
      });
    }
  }
  float sum = 0.f;
#pragma unroll
  for (int ds = 0; ds < 2; ds++)
#pragma unroll
    for (int g = 0; g < 16; g++) sum += o[ds][g];
  sum += __shfl_xor(sum, 32);
  float mean = sum * (1.f / 64.f);
  float vs = 0.f;
#pragma unroll
  for (int ds = 0; ds < 2; ds++)
#pragma unroll
    for (int g = 0; g < 16; g++) { float dlt = o[ds][g] - mean; vs += dlt * dlt; }
  vs += __shfl_xor(vs, 32);
  float rstd = rsqrtf(vs * (1.f / 64.f) + 1e-6f);
  int T = Tq0 + wave * 32 + r;
#pragma unroll
  for (int ds = 0; ds < 2; ds++)
#pragma unroll
    for (int g4 = 0; g4 < 4; g4++) {
      int d0 = ds * 32 + 8 * g4 + 4 * h;
      uint2 gt = *(const uint2*)(p.SG + (size_t)T * 512 + hh * 64 + d0);
      float y0 = (o[ds][4 * g4] - mean) * rstd * bflo(gt.x), y1 = (o[ds][4 * g4 + 1] - mean) * rstd * bfhi(gt.x);
      float y2 = (o[ds][4 * g4 + 2] - mean) * rstd * bflo(gt.y), y3 = (o[ds][4 * g4 + 3] - mean) * rstd * bfhi(gt.y);
      *(uint2*)(p.MIX + (size_t)T * 1024 + 512 + hh * 64 + d0) = make_uint2(pack2(y0, y1), pack2(y2, y3));
    }
}
DEV void ret_state_job(const Params& p, int b, int hh, int dir, char* smem) {
  u16* sKk = (u16*)smem; u16* sVv = sKk + 64 * 64;
  int t = threadIdx.x;
  const u16* kb = p.RK + kvoff(false, b, hh, 0, 8, 64, 1024, 0);
  const u16* vb = p.RV + kvoff(false, b, hh, 0, 8, 64, 1024, 0);
  float xx = dir == 0 ? p.rdf[hh] : p.rdb[hh];
  float lg2 = -log1pf(__expf(-xx)) * 1.4426950408889634f;
  int dk = t >> 2, dvc = (t & 3) * 16;
  float acc[16];
#pragma unroll
  for (int i = 0; i < 16; i++) acc[i] = 0.f;
  for (int ch = 0; ch < 4; ch++) {
    __syncthreads();
#pragma unroll
    for (int i = 0; i < 2; i++) {
      int c = t + 256 * i;
      *(uint4*)(sKk + c * 8) = *(const uint4*)(kb + (size_t)ch * 4096 + c * 8);
      *(uint4*)(sVv + c * 8) = *(const uint4*)(vb + (size_t)ch * 4096 + c * 8);
    }
    __syncthreads();
    for (int jj = 0; jj < 64; jj++) {
      int j = ch * 64 + jj;
      float w = exp2f(lg2 * (float)(dir == 0 ? 255 - j : j));
      float kv = bf2f(sKk[jj * 64 + dk]) * w;
      const uint4* vp = (const uint4*)(sVv + jj * 64 + dvc);
      uint4 v0 = vp[0], v1 = vp[1];
      acc[0] += kv * bflo(v0.x); acc[1] += kv * bfhi(v0.x); acc[2] += kv * bflo(v0.y); acc[3] += kv * bfhi(v0.y);
      acc[4] += kv * bflo(v0.z); acc[5] += kv * bfhi(v0.z); acc[6] += kv * bflo(v0.w); acc[7] += kv * bfhi(v0.w);
      acc[8] += kv * bflo(v1.x); acc[9] += kv * bfhi(v1.x); acc[10] += kv * bflo(v1.y); acc[11] += kv * bfhi(v1.y);
      acc[12] += kv * bflo(v1.z); acc[13] += kv * bfhi(v1.z); acc[14] += kv * bflo(v1.w); acc[15] += kv * bfhi(v1.w);
    }
  }
  float* dst = p.out + (dir == 0 ? OUT_RF : OUT_RB) + ((size_t)(b * 8 + hh) * 64 + dk) * 64 + dvc;
#pragma unroll
  for (int i = 0; i < 4; i++) *(float4*)(dst + 4 * i) = make_float4(acc[4 * i], acc[4 * i + 1], acc[4 * i + 2], acc[4 * i + 3]);
}

DEV void phase_attn0(const Params& p, int bid, int nb, char* smem) {
  for (int it = bid; it < 1280; it += nb) {
    if (it < 256) {
      int b = it >> 6, hq = (it >> 3) & 7, qb = it & 7; int kvh = hq >> 2;
      f32x16 o[2];
      int Tq0 = 4096 + b * 1024 + qb * 128;
      attn_softmax_job<64>(p, p.Q1, Tq0, hq * 64, p.KA + kvoff(true, b, kvh, -256, 2, 64, 1280, 256), p.VA + kvoff(true, b, kvh, -256, 2, 64, 1280, 256),
                           20, 0, 0, qb * 128, false, 0.f, o, smem);
      store_o64(p, o, Tq0, hq * 64);
    } else if (it < 512) {
      int j = it - 256; int b = j >> 6, hh = (j >> 3) & 7, qb = j & 7;
      ret_job(p, true, b, hh, qb, smem);
    } else if (it < 768) {
      int j = it - 512; int b = j >> 4, hq = (j >> 1) & 7, qb = j & 1; int kvh = hq >> 2;
      f32x16 o[2];
      int Tq0 = b * 256 + qb * 128;
      attn_softmax_job<64>(p, p.Q1, Tq0, hq * 64, p.KA + kvoff(false, b, kvh, 0, 2, 64, 1280, 256), p.VA + kvoff(false, b, kvh, 0, 2, 64, 1280, 256),
                           4, 0, 0, qb * 128, false, 0.f, o, smem);
      store_o64(p, o, Tq0, hq * 64);
    } else if (it < 1024) {
      int j = it - 768; int b = j >> 4, hh = (j >> 1) & 7, qb = j & 1;
      ret_job(p, false, b, hh, qb, smem);
    } else {
      int j = it - 1024; int b = j >> 4, hh = (j >> 1) & 7, dir = j & 1;
      ret_state_job(p, b, hh, dir, smem);
    }
  }
}
DEV void diff_job(const Params& p, bool smp, int b, int hh, int qb, float lam, char* smem) {
  int lane = threadIdx.x & 63, wave = threadIdx.x >> 6, r = lane & 31, h = lane >> 5;
  int Tq0 = (smp ? 4096 + b * 1024 : b * 256) + qb * 128;
  int nt = smp ? 20 : 4;
  const u16* vb = p.VC + kvoff(smp, b, hh, smp ? -256 : 0, 4, 128, 1280, 256);
  f32x16 o1[4];
  unsigned* o0s = (unsigned*)(smem + 32768) + threadIdx.x;
  attn_softmax_job<128>(p, p.Q1, Tq0, (2 * hh) * 64, p.KC + kvoff(smp, b, 2 * hh, smp ? -256 : 0, 8, 64, 1280, 256), vb, nt, 0, 0, qb * 128, false, 0.f, o1, smem);
#pragma unroll
  for (int ds = 0; ds < 4; ds++)
#pragma unroll
    for (int g = 0; g < 8; g++) o0s[(ds * 8 + g) * 256] = pack2(o1[ds][2 * g], o1[ds][2 * g + 1]);
  attn_softmax_job<128>(p, p.Q1, Tq0, (2 * hh + 1) * 64, p.KC + kvoff(smp, b, 2 * hh + 1, smp ? -256 : 0, 8, 64, 1280, 256), vb, nt, 0, 0, qb * 128, false, 0.f, o1, smem);
  float ss = 0.f;
  f32x16 o0[4];
#pragma unroll
  for (int ds = 0; ds < 4; ds++)
#pragma unroll
    for (int g = 0; g < 8; g++) {
      unsigned w = o0s[(ds * 8 + g) * 256];
      float d0 = bflo(w) - lam * o1[ds][2 * g], d1 = bfhi(w) - lam * o1[ds][2 * g + 1];
      o0[ds][2 * g] = d0; o0[ds][2 * g + 1] = d1; ss += d0 * d0 + d1 * d1;
    }
  ss += __shfl_xor(ss, 32);
  float rstd = rsqrtf(ss * (1.f / 128.f) + 1e-6f) * (1.f - LAM_INIT);
  int T = Tq0 + wave * 32 + r;
#pragma unroll
  for (int ds = 0; ds < 4; ds++)
#pragma unroll
    for (int g4 = 0; g4 < 4; g4++) {
      int d0 = ds * 32 + 8 * g4 + 4 * h;
      float4 sg = *(const float4*)(p.subln + d0);
      *(uint2*)(p.MIX + (size_t)T * 1024 + hh * 128 + d0) =
          make_uint2(pack2(o0[ds][4 * g4] * rstd * sg.x, o0[ds][4 * g4 + 1] * rstd * sg.y),
                     pack2(o0[ds][4 * g4 + 2] * rstd * sg.z, o0[ds][4 * g4 + 3] * rstd * sg.w));
    }
}
DEV void phase_attn1(const Params& p, int bid, int nb, char* smem) {
  float d1 = 0.f, d2 = 0.f;
  for (int i = 0; i < 64; i++) { d1 += p.lq1[i] * p.lk1[i]; d2 += p.lq2[i] * p.lk2[i]; }
  float lam = __expf(d1) - __expf(d2) + LAM_INIT;
  for (int it = bid; it < 768; it += nb) {
    if (it < 128) {
      int b = it >> 5, hh = (it >> 3) & 3, qb = it & 7;
      diff_job(p, true, b, hh, qb, lam, smem);
    } else if (it < 384) {
      int j = it - 128; int b = j >> 6, hq = (j >> 3) & 7, qb = j & 7; int kvh = hq >> 2;
      int q0 = qb * 128;
      int lo = (q0 - 128 < 0 ? 0 : q0 - 128) >> 6, hi = (q0 + 256 > 1024 ? 1024 : q0 + 256) >> 6;
      f32x16 o[2];
      int Tq0 = 4096 + b * 1024 + q0;
      attn_softmax_job<64>(p, p.Q2, Tq0, hq * 64, p.KD + kvoff(true, b, kvh, -256, 2, 64, 1280, 256), p.VD + kvoff(true, b, kvh, -256, 2, 64, 1280, 256),
                           4, lo, hi, q0, true, p.dsink[hq], o, smem);
      store_o64(p, o, Tq0, 512 + hq * 64);
    } else if (it < 512) {
      int j = it - 384; int b = j >> 3, hh = (j >> 1) & 3, qb = j & 1;
      diff_job(p, false, b, hh, qb, lam, smem);
    } else {
      int j = it - 512; int b = j >> 4, hq = (j >> 1) & 7, qb = j & 1; int kvh = hq >> 2;
      f32x16 o[2];
      int Tq0 = b * 256 + qb * 128;
      attn_softmax_job<64>(p, p.Q2, Tq0, hq * 64, p.KD + kvoff(false, b, kvh, 0, 2, 64, 1280, 256), p.VD + kvoff(false, b, kvh, 0, 2, 64, 1280, 256),
                           4, 0, 0, qb * 128, true, p.dsink[hq], o, smem);
      store_o64(p, o, Tq0, 512 + hq * 64);
    }
  }
}

DEV int top16_select(unsigned k0, unsigned k1, unsigned k2, unsigned k3, int nbits, int lane) {
  unsigned mask = (1u << nbits) - 1u;
  int mine = 0;
  for (int k = 0; k < 16; k++) {
    unsigned best = wave_max_u(max(max(k0, k1), max(k2, k3)));
    int idx = (int)(mask - (best & mask));
    if (lane == k) mine = idx;
    if (k0 == best) k0 = 0u; if (k1 == best) k1 = 0u; if (k2 == best) k2 = 0u; if (k3 == best) k3 = 0u;
  }
  return mine;
}
DEV void phase_peer(const Params& p, int layer, int bid, int nb, char* smem) {
  int wave = threadIdx.x >> 6, lane = threadIdx.x & 63;
  float* ws1 = (float*)(smem + wave * 2048); float* ws2 = ws1 + 16;
  int* wi1 = (int*)(ws2 + 16); int* wi2 = wi1 + 16; int* eidx = wi2 + 16; float* eg = (float*)(eidx + 128);
  const u16* U = p.U16 + (size_t)layer * 16384 * 1024;
  const u16* V = p.V16 + (size_t)layer * 16384 * 1024;
  for (int T = bid * 4 + wave; T < 8192; T += nb * 4) {
    const float* sc = p.SC + (size_t)T * 2048;
    for (int hh = 0; hh < 8; hh++) {
#pragma unroll
      for (int c2 = 0; c2 < 2; c2++) {
        const float* s = sc + (hh * 2 + c2) * 128;
        float v0 = s[lane], v1 = s[lane + 64];
        unsigned k0 = (fkey(v0) & ~127u) | (unsigned)(127 - lane);
        unsigned k1 = (fkey(v1) & ~127u) | (unsigned)(63 - lane);
        int mine = top16_select(k0, k1, 0u, 0u, 7, lane);
        if (lane < 16) {
          float sv = s[mine];
          if (c2 == 0) { ws1[lane] = sv; wi1[lane] = mine; } else { ws2[lane] = sv; wi2[lane] = mine; }
        }
      }
      __builtin_amdgcn_fence(__ATOMIC_ACQ_REL, "wavefront");
      __builtin_amdgcn_wave_barrier();
      int bq = lane & 15, aq = lane >> 4;
      float s2v = ws2[bq];
      float c0 = ws1[aq] + s2v, c1 = ws1[aq + 4] + s2v, c2v = ws1[aq + 8] + s2v, c3 = ws1[aq + 12] + s2v;
      unsigned k0 = (fkey(c0) & ~255u) | (unsigned)(255 - lane);
      unsigned k1 = (fkey(c1) & ~255u) | (unsigned)(255 - (lane + 64));
      unsigned k2 = (fkey(c2v) & ~255u) | (unsigned)(255 - (lane + 128));
      unsigned k3 = (fkey(c3) & ~255u) | (unsigned)(255 - (lane + 192));
      int cm = top16_select(k0, k1, k2, k3, 8, lane);
      int ca = (cm >> 4) & 15, cb = cm & 15;
      float ts = (lane < 16) ? (ws1[ca] + ws2[cb]) : -1e30f;
      int ee = wi1[ca] * 128 + wi2[cb];
      float mx = row_max16(ts);
      float pe = __expf(ts - mx);
      float sm = row_sum16(pe);
      if (lane < 16) { eidx[hh * 16 + lane] = ee; eg[hh * 16 + lane] = pe / sm; }
      __builtin_amdgcn_fence(__ATOMIC_ACQ_REL, "wavefront");
      __builtin_amdgcn_wave_barrier();
    }
    float hx[16], acc[16];
    {
      uint4 ha = *(const uint4*)(p.H + (size_t)T * 1024 + 8 * lane), hb = *(const uint4*)(p.H + (size_t)T * 1024 + 512 + 8 * lane);
      hx[0] = bflo(ha.x); hx[1] = bfhi(ha.x); hx[2] = bflo(ha.y); hx[3] = bfhi(ha.y); hx[4] = bflo(ha.z); hx[5] = bfhi(ha.z); hx[6] = bflo(ha.w); hx[7] = bfhi(ha.w);
      hx[8] = bflo(hb.x); hx[9] = bfhi(hb.x); hx[10] = bflo(hb.y); hx[11] = bfhi(hb.y); hx[12] = bflo(hb.z); hx[13] = bfhi(hb.z); hx[14] = bflo(hb.w); hx[15] = bfhi(hb.w);
    }
#pragma unroll
    for (int i = 0; i < 16; i++) acc[i] = 0.f;
    for (int bi = 0; bi < 16; bi++) {
      uint4 ua[8], ub[8], va[8], vb[8];
#pragma unroll
      for (int j = 0; j < 8; j++) {
        int e = __builtin_amdgcn_readfirstlane(eidx[bi * 8 + j]);
        const u16* up = U + (size_t)e * 1024 + 8 * lane;
        ua[j] = *(const uint4*)up; ub[j] = *(const uint4*)(up + 512);
      }
#pragma unroll
      for (int j = 0; j < 8; j++) {
        int e = __builtin_amdgcn_readfirstlane(eidx[bi * 8 + j]);
        const u16* vp = V + (size_t)e * 1024 + 8 * lane;
        va[j] = *(const uint4*)vp; vb[j] = *(const uint4*)(vp + 512);
      }
#pragma unroll
      for (int j = 0; j < 8; j++) {
        float d = hx[0] * bflo(ua[j].x) + hx[1] * bfhi(ua[j].x) + hx[2] * bflo(ua[j].y) + hx[3] * bfhi(ua[j].y)
                + hx[4] * bflo(ua[j].z) + hx[5] * bfhi(ua[j].z) + hx[6] * bflo(ua[j].w) + hx[7] * bfhi(ua[j].w)
                + hx[8] * bflo(ub[j].x) + hx[9] * bfhi(ub[j].x) + hx[10] * bflo(ub[j].y) + hx[11] * bfhi(ub[j].y)
                + hx[12] * bflo(ub[j].z) + hx[13] * bfhi(ub[j].z) + hx[14] * bflo(ub[j].w) + hx[15] * bfhi(ub[j].w);
        float a = wave_sum(d);
        float w = eg[bi * 8 + j] * gelu_tanh(a);
        acc[0] += w * bflo(va[j].x); acc[1] += w * bfhi(va[j].x); acc[2] += w * bflo(va[j].y); acc[3] += w * bfhi(va[j].y);
        acc[4] += w * bflo(va[j].z); acc[5] += w * bfhi(va[j].z); acc[6] += w * bflo(va[j].w); acc[7] += w * bfhi(va[j].w);
        acc[8] += w * bflo(vb[j].x); acc[9] += w * bfhi(vb[j].x); acc[10] += w * bflo(vb[j].y); acc[11] += w * bfhi(vb[j].y);
        acc[12] += w * bflo(vb[j].z); acc[13] += w * bfhi(vb[j].z); acc[14] += w * bflo(vb[j].w); acc[15] += w * bfhi(vb[j].w);
      }
    }
    int mb = T < 4096 ? 0 : 1 + ((T - 4096) >> 10);
    const float* md = p.MOD + (size_t)(layer * 5 + mb) * 6144;
    float x2[16]; float ss = 0.f;
#pragma unroll
    for (int hf = 0; hf < 2; hf++) {
      int col = hf * 512 + 8 * lane;
      float4 xa = *(const float4*)(p.X + (size_t)T * 1024 + col), xb = *(const float4*)(p.X + (size_t)T * 1024 + col + 4);
      float4 ga = *(const float4*)(md + 5 * 1024 + col), gb = *(const float4*)(md + 5 * 1024 + col + 4);
      x2[hf * 8 + 0] = xa.x + ga.x * acc[hf * 8 + 0]; x2[hf * 8 + 1] = xa.y + ga.y * acc[hf * 8 + 1];
      x2[hf * 8 + 2] = xa.z + ga.z * acc[hf * 8 + 2]; x2[hf * 8 + 3] = xa.w + ga.w * acc[hf * 8 + 3];
      x2[hf * 8 + 4] = xb.x + gb.x * acc[hf * 8 + 4]; x2[hf * 8 + 5] = xb.y + gb.y * acc[hf * 8 + 5];
      x2[hf * 8 + 6] = xb.z + gb.z * acc[hf * 8 + 6]; x2[hf * 8 + 7] = xb.w + gb.w * acc[hf * 8 + 7];
    }
#pragma unroll
    for (int i = 0; i < 16; i++) ss += x2[i] * x2[i];
    ss = wave_sum(ss);
    float rstd = rsqrtf(ss * (1.f / 1024.f) + 1e-6f);
    if (layer == 0) {
      const float* md1 = p.MOD + (size_t)(5 + mb) * 6144;
#pragma unroll
      for (int hf = 0; hf < 2; hf++) {
        int col = hf * 512 + 8 * lane;
        *(float4*)(p.X + (size_t)T * 1024 + col) = make_float4(x2[hf * 8], x2[hf * 8 + 1], x2[hf * 8 + 2], x2[hf * 8 + 3]);
        *(float4*)(p.X + (size_t)T * 1024 + col + 4) = make_float4(x2[hf * 8 + 4], x2[hf * 8 + 5], x2[hf * 8 + 6], x2[hf * 8 + 7]);
        float y[8];
#pragma unroll
        for (int i = 0; i < 8; i++) {
          float g = p.norm_mix[1024 + col + i], sh = md1[col + i], scl = md1[1024 + col + i];
          y[i] = x2[hf * 8 + i] * rstd * g * (1.f + scl) + sh;
        }
        *(uint4*)(p.H + (size_t)T * 1024 + col) = make_uint4(pack2(y[0], y[1]), pack2(y[2], y[3]), pack2(y[4], y[5]), pack2(y[6], y[7]));
      }
    } else {
#pragma unroll
      for (int hf = 0; hf < 2; hf++) {
        int col = hf * 512 + 8 * lane;
        float4 ga = *(const float4*)(p.norm_final + col), gb = *(const float4*)(p.norm_final + col + 4);
        *(float4*)(p.out + (size_t)T * 1024 + col) = make_float4(x2[hf * 8] * rstd * ga.x, x2[hf * 8 + 1] * rstd * ga.y, x2[hf * 8 + 2] * rstd * ga.z, x2[hf * 8 + 3] * rstd * ga.w);
        *(float4*)(p.out + (size_t)T * 1024 + col + 4) = make_float4(x2[hf * 8 + 4] * rstd * gb.x, x2[hf * 8 + 5] * rstd * gb.y, x2[hf * 8 + 6] * rstd * gb.z, x2[hf * 8 + 7] * rstd * gb.w);
      }
    }
  }
}


#define XB_TMO      128
#define XB_XCNT(j)  (256  + 64 * (j))
#define XB_XSUB(j)  (1280 + 64 * (j))
#define XB_XGEN(j)  (2304 + 64 * (j))
#define XB_TOP      3328
#define XB_TOPGEN   3392
#define XCD_BAR_WORDS 3456
#define XB_SPIN_CAP (1u << 20)
#define LAS __attribute__((address_space(3)))
DEV unsigned xb_ld(unsigned* p)              { return __hip_atomic_load(p, __ATOMIC_RELAXED, __HIP_MEMORY_SCOPE_AGENT); }
DEV unsigned xb_add(unsigned* p, unsigned v) { return __hip_atomic_fetch_add(p, v, __ATOMIC_RELAXED, __HIP_MEMORY_SCOPE_AGENT); }
DEV unsigned xb_xcc_id() { return (unsigned)__builtin_amdgcn_s_getreg((3 << 11) | 20) & 0xFu; }
#define XB_SPIN(cond, bar) do { unsigned _sp = 0; while (cond) { __builtin_amdgcn_s_sleep(1); \
    if ((++_sp & 255u) == 0u) { if (xb_ld(&(bar)[XB_TMO])) break; if (_sp > XB_SPIN_CAP) { atomicAdd(&(bar)[XB_TMO], 1u); break; } } } } while (0)
struct XcdBarrier { unsigned* bar; unsigned x; volatile LAS unsigned* st; };
DEV XcdBarrier xcd_barrier_post(unsigned* bar, volatile LAS unsigned* st) {
  XcdBarrier b; b.bar = bar; b.x = xb_xcc_id(); b.st = st;
  if (threadIdx.x == 0) (void)xb_add(&bar[XB_XCNT(b.x)], 1u);
  return b;
}
DEV void xcd_barrier_complete(unsigned* bar, unsigned x, unsigned& nloc, unsigned& nx) {
  const unsigned G = gridDim.x * gridDim.y * gridDim.z;
  unsigned sum, cnt, mine, sp = 0u;
  for (;;) {
    sum = 0u; cnt = 0u; mine = 0u;
#pragma unroll
    for (unsigned j = 0; j < 16; ++j) { const unsigned c = xb_ld(&bar[XB_XCNT(j)]); sum += c; cnt += (c > 0u) ? 1u : 0u; mine = (j == x) ? c : mine; }
    if (sum == G) break;
    __builtin_amdgcn_s_sleep(1);
    if ((++sp & 255u) == 0u) { if (xb_ld(&bar[XB_TMO])) break; if (sp > XB_SPIN_CAP) { atomicAdd(&bar[XB_TMO], 1u); break; } }
  }
  nloc = mine > 0u ? mine : 1u; nx = cnt > 0u ? cnt : 1u;
}
DEV void xcd_barrier(const XcdBarrier& b) {
  asm volatile("s_waitcnt vmcnt(0)" ::: "memory");
  __syncthreads();
  if (threadIdx.x == 0) {
    unsigned* bar = b.bar;
    __builtin_amdgcn_s_waitcnt(0);
    unsigned nloc = b.st[0], nx = b.st[1];
    if (nloc == 0u) { xcd_barrier_complete(bar, b.x, nloc, nx); b.st[0] = nloc; b.st[1] = nx; }
    const unsigned old = xb_add(&bar[XB_XSUB(b.x)], 1u);
    const unsigned gen = old / nloc;
    if (old + 1u == (gen + 1u) * nloc) {
      __builtin_amdgcn_fence(__ATOMIC_RELEASE, "agent");
      asm volatile("s_waitcnt vmcnt(0)" ::: "memory");
      const unsigned og = xb_add(&bar[XB_TOP], 1u);
      const unsigned tg = og / nx;
      if (og + 1u == (tg + 1u) * nx) xb_add(&bar[XB_TOPGEN], 1u);
      else XB_SPIN(xb_ld(&bar[XB_TOPGEN]) == tg, bar);
      __builtin_amdgcn_fence(__ATOMIC_ACQUIRE, "agent");
      xb_add(&bar[XB_XGEN(b.x)], 1u);
      asm volatile("s_waitcnt vmcnt(0)" ::: "memory");
    } else {
      XB_SPIN(xb_ld(&bar[XB_XGEN(b.x)]) == gen, bar);
      __builtin_amdgcn_fence(__ATOMIC_ACQUIRE, "agent");
      asm volatile("s_waitcnt vmcnt(0)" ::: "memory");
    }
  }
  __syncthreads();
}

constexpr int NPHASE = 16;
DEV void run_phase(const Params& p, int ph, int bid, int nb, char* smem) {
  switch (ph) {
    case 0: phase_prep(p, bid, nb, smem); break;
    case 1: phase_ada(p, 0, p.norm_mix, 0, 1, true, bid, nb); break;
    case 2: gemm_phase(p.H, 1024, p.WT_EVIN, 1024, 1024, 64, 22, bid, nb, smem, [&](int m0, int n0, const float* Cs) { epi_inproj0(p, m0, n0, Cs); }); break;
    case 3: phase_attn0(p, bid, nb, smem); break;
    case 4: gemm_phase(p.MIX, 1024, p.WT_EVOUT, 1024, 1024, 64, 8, bid, nb, smem, [&](int m0, int n0, const float* Cs) { epi_outproj(p, 0, m0, n0, Cs); }); break;
    case 5: phase_ada(p, 0, p.norm_ffn, 3, 4, false, bid, nb); break;
    case 12: phase_ada(p, 1, p.norm_ffn + 1024, 3, 4, false, bid, nb); break;
    case 6: case 13: {
      int layer = ph == 6 ? 0 : 1;
      gemm_phase(p.H, 1024, p.WT_PQ + (size_t)layer * 2048 * 1024, 1024, 1024, 64, 16, bid, nb, smem, [&](int m0, int n0, const float* Cs) {
        int lane = threadIdx.x & 63, wave = threadIdx.x >> 6;
        for (int rr = wave; rr < 128; rr += 4) {
          float2 c = *(const float2*)(Cs + rr * 128 + lane * 2);
          *(unsigned*)(p.PQ + (size_t)(m0 + rr) * 2048 + n0 + lane * 2) = pack2(c.x, c.y);
        }
      });
    } break;
    case 7: case 14: {
      int layer = ph == 7 ? 0 : 1;
      const u16* sk = p.SUBK + (size_t)layer * 16 * 128 * 128;
      for (int it = bid; it < 64 * 16; it += nb) {
        int mt = it >> 4, hc = it & 15;
        f32x16 acc[2][2];
        zero16(acc[0][0]); zero16(acc[0][1]); zero16(acc[1][0]); zero16(acc[1][1]);
        gemm_tile(p.PQ + (size_t)mt * 128 * 2048 + hc * 128, 2048, sk + (size_t)hc * 128 * 128, 128, 128, smem, acc);
        const float* Cs = (const float*)smem;
        int lane = threadIdx.x & 63, wave = threadIdx.x >> 6;
        for (int rr = wave; rr < 128; rr += 4) {
          float2 c = *(const float2*)(Cs + rr * 128 + lane * 2);
          *(float2*)(p.SC + (size_t)(mt * 128 + rr) * 2048 + hc * 128 + lane * 2) = c;
        }
      }
    } break;
    case 8: phase_peer(p, 0, bid, nb, smem); break;
    case 15: phase_peer(p, 1, bid, nb, smem); break;
    case 9: gemm_phase(p.H, 1024, p.WT_ODIN, 1024, 1024, 64, 18, bid, nb, smem, [&](int m0, int n0, const float* Cs) { epi_inproj1(p, m0, n0, Cs); }); break;
    case 10: phase_attn1(p, bid, nb, smem); break;
    case 11: gemm_phase(p.MIX, 1024, p.WT_ODOUT, 1024, 1024, 64, 8, bid, nb, smem, [&](int m0, int n0, const float* Cs) { epi_outproj(p, 1, m0, n0, Cs); }); break;
    default: break;
  }
}

template <int PH> DEV void run_all(const Params& p, cg::grid_group& grid, const XcdBarrier& xb, char* smem) {
  run_phase(p, PH, blockIdx.x, gridDim.x, smem);
  if constexpr (PH + 1 < NPHASE) {
    if constexpr (PH == 0) grid.sync(); else xcd_barrier(xb);
    run_all<PH + 1>(p, grid, xb, smem);
  }
}
__global__ void __launch_bounds__(256, 2) mega_kernel(Params p) {
  __shared__ __attribute__((aligned(16))) char smem[65536];
  __shared__ uint4 xb_words;
  if (threadIdx.x == 0) xb_words = make_uint4(0u, 0u, 0u, 0u);
  __syncthreads();
  XcdBarrier xb = xcd_barrier_post(p.BAR, (volatile LAS unsigned*)&xb_words);
  cg::grid_group grid = cg::this_grid();
  run_all<0>(p, grid, xb, smem);
}
#if MULTI_LAUNCH
template <int PH> __global__ void __launch_bounds__(256, 2) phase_kernel(Params p) {
  __shared__ __attribute__((aligned(16))) char smem[65536];
  run_phase(p, PH, blockIdx.x, gridDim.x, smem);
}
template <int PH> static void launch_all(const Params& p, int grid, hipStream_t s) {
  phase_kernel<PH><<<grid, 256, 0, s>>>(p);
  if constexpr (PH + 1 < NPHASE) launch_all<PH + 1>(p, grid, s);
}
#endif

extern "C" void kernel_launch(void* const* d_in, const int* in_sizes, int n_in, void* d_out, int out_size, void* d_ws, size_t ws_size, hipStream_t stream) {
  Params p{};
  const float* const* in = (const float* const*)d_in;
  p.xp = in[0]; p.xs = in[1]; p.c = in[2]; p.cctx = in[3]; p.cak = in[4]; p.cav = in[5]; p.srf = in[6]; p.srb = in[7];
  p.cck = in[8]; p.ccv = in[9]; p.cdk = in[10]; p.cdv = in[11];
  p.mod_w = in[12]; p.mod_b = in[13]; p.norm_mix = in[14]; p.norm_ffn = in[15]; p.norm_final = in[16];
  p.ev_w_in = in[17]; p.ev_w_out = in[18]; p.a_q_norm = in[19]; p.a_k_norm = in[20]; p.rdf = in[21]; p.rdb = in[22];
  p.od_w_in = in[23]; p.od_w_out = in[24]; p.lq1 = in[25]; p.lk1 = in[26]; p.lq2 = in[27]; p.lk2 = in[28]; p.subln = in[29]; p.dsink = in[30];
  p.peer_wq = in[31]; p.peer_sk = in[32]; p.peer_u = in[33]; p.peer_v = in[34];
  p.out = (float*)d_out;
  char* w = (char*)d_ws; size_t off = 0;
  auto take = [&](size_t bytes) { char* r = w + off; off += (bytes + 255) & ~(size_t)255; return r; };
  p.BAR = (unsigned*)take(XCD_BAR_WORDS * 4);
  p.MOD = (float*)take(61440 * 4);
  p.ROPEC = (float*)take(32768 * 4); p.ROPES = (float*)take(32768 * 4);
  p.X = (float*)take((size_t)8192 * 1024 * 4);
  p.SC = (float*)take((size_t)8192 * 2048 * 4);
  p.WT_EVIN = (u16*)take((size_t)2816 * 1024 * 2); p.WT_EVOUT = (u16*)take((size_t)1024 * 1024 * 2);
  p.WT_ODIN = (u16*)take((size_t)2304 * 1024 * 2); p.WT_ODOUT = (u16*)take((size_t)1024 * 1024 * 2);
  p.WT_PQ = (u16*)take((size_t)2 * 2048 * 1024 * 2); p.SUBK = (u16*)take((size_t)524288 * 2);
  p.U16 = (u16*)take((size_t)2 * 16384 * 1024 * 2); p.V16 = (u16*)take((size_t)2 * 16384 * 1024 * 2);
  p.H = (u16*)take((size_t)8192 * 1024 * 2); p.MIX = (u16*)take((size_t)8192 * 1024 * 2);
  p.Q1 = (u16*)take((size_t)8192 * 512 * 2); p.Q2 = (u16*)take((size_t)8192 * 512 * 2); p.SG = (u16*)take((size_t)8192 * 512 * 2);
  p.KA = (u16*)take((size_t)1179648 * 2); p.VA = (u16*)take((size_t)1179648 * 2);
  p.RK = (u16*)take((size_t)4194304 * 2); p.RV = (u16*)take((size_t)4194304 * 2);
  p.KC = (u16*)take((size_t)4718592 * 2); p.VC = (u16*)take((size_t)4718592 * 2);
  p.KD = (u16*)take((size_t)1179648 * 2); p.VD = (u16*)take((size_t)1179648 * 2);
  p.PQ = (u16*)take((size_t)8192 * 2048 * 2);
  (void)in_sizes; (void)n_in; (void)out_size; (void)ws_size;
#if MULTI_LAUNCH
  launch_all<0>(p, 512, stream);
#else
  static int grid_blocks = 0;
  if (!grid_blocks) {
    int dev = 0, cus = 0, per_cu = 0;
    hipGetDevice(&dev);
    hipDeviceGetAttribute(&cus, hipDeviceAttributeMultiprocessorCount, dev);
    hipOccupancyMaxActiveBlocksPerMultiprocessor(&per_cu, mega_kernel, 256, 0);
    if (per_cu > 2) per_cu = 2;
    if (per_cu < 1) per_cu = 1;
    grid_blocks = cus * per_cu;
  }
  (void)hipMemsetAsync(p.BAR, 0, XCD_BAR_WORDS * 4, stream);
  void* args[] = {&p};
  hipError_t e = hipLaunchCooperativeKernel((void*)mega_kernel, dim3(grid_blocks), dim3(256), args, 0, stream);
  if (e != hipSuccess) fprintf(stderr, "cooperative launch failed: %s (grid %d)\n", hipGetErrorString(e), grid_blocks);
#endif
}
```

```cpp
#include <hip/hip_runtime.h>
#include <hip/hip_cooperative_groups.h>
#include <cstdio>
namespace cg = cooperative_groups;

#ifndef MULTI_LAUNCH
#define MULTI_LAUNCH 0
#endif

typedef unsigned short u16;
typedef __attribute__((ext_vector_type(8))) short bf16x8;
typedef __attribute__((ext_vector_type(16))) float f32x16;
typedef __attribute__((ext_vector_type(4))) unsigned u32x4;

#define DEV __device__ __forceinline__

constexpr size_t OUT_AK = 8388608, OUT_AV = 8912896, OUT_RF = 9437184, OUT_RB = 9961472,
                 OUT_CK = 10485760, OUT_CV = 12582912, OUT_DK = 14680064, OUT_DV = 15204352;
constexpr float LAM_INIT = 0.35550906f;

struct Params {
  const float *xp, *xs, *c, *cctx, *cak, *cav, *srf, *srb, *cck, *ccv, *cdk, *cdv;
  const float *mod_w, *mod_b, *norm_mix, *norm_ffn, *norm_final;
  const float *ev_w_in, *ev_w_out, *a_q_norm, *a_k_norm, *rdf, *rdb;
  const float *od_w_in, *od_w_out, *lq1, *lk1, *lq2, *lk2, *subln, *dsink;
  const float *peer_wq, *peer_sk, *peer_u, *peer_v;
  float* out;
  float *MOD, *ROPEC, *ROPES, *X, *SC;
  u16 *WT_EVIN, *WT_EVOUT, *WT_ODIN, *WT_ODOUT, *WT_PQ, *SUBK, *U16, *V16, *H, *MIX, *Q1, *Q2, *SG;
  u16 *KA, *VA, *RK, *RV, *KC, *VC, *KD, *VD, *PQ;
  unsigned* BAR;
  unsigned char *U8, *V8; float *SU, *SV;
};

DEV u16 f2bf(float f) { unsigned u = __float_as_uint(f); u += 0x7fffu + ((u >> 16) & 1u); return (u16)(u >> 16); }
DEV float bf2f(unsigned b) { return __uint_as_float(b << 16); }
DEV unsigned pack2(float a, float b) { return (unsigned)f2bf(a) | ((unsigned)f2bf(b) << 16); }
DEV float bflo(unsigned w) { return __uint_as_float(w << 16); }
DEV float bfhi(unsigned w) { return __uint_as_float(w & 0xffff0000u); }
DEV float silu_f(float v) { return v / (1.f + __expf(-v)); }
DEV float gelu_tanh(float a) {
  float z = 0.7978845608f * (a + 0.044715f * a * a * a);
  float e = __expf(2.f * z);
  float th = 1.f - 2.f / (e + 1.f);
  return 0.5f * a * (1.f + th);
}
template <int CTRL> DEV float dpp_f(float v) {
  return __int_as_float(__builtin_amdgcn_update_dpp(0, __float_as_int(v), CTRL, 0xF, 0xF, true));
}
template <int CTRL> DEV unsigned dpp_u(unsigned v) {
  return (unsigned)__builtin_amdgcn_update_dpp(0, (int)v, CTRL, 0xF, 0xF, true);
}
DEV float row_sum16(float v) {
  v += dpp_f<0xB1>(v); v += dpp_f<0x4E>(v); v += dpp_f<0x141>(v); v += dpp_f<0x140>(v); return v;
}
DEV float row_max16(float v) {
  v = fmaxf(v, dpp_f<0xB1>(v)); v = fmaxf(v, dpp_f<0x4E>(v)); v = fmaxf(v, dpp_f<0x141>(v)); v = fmaxf(v, dpp_f<0x140>(v)); return v;
}
DEV float rlane(float v, int l) { return __int_as_float(__builtin_amdgcn_readlane(__float_as_int(v), l)); }
DEV float wave_sum(float v) {
  v = row_sum16(v);
  return (rlane(v, 0) + rlane(v, 16)) + (rlane(v, 32) + rlane(v, 48));
}
DEV unsigned wave_max_u(unsigned v) {
  v = max(v, dpp_u<0xB1>(v)); v = max(v, dpp_u<0x4E>(v)); v = max(v, dpp_u<0x141>(v)); v = max(v, dpp_u<0x140>(v));
  unsigned a = (unsigned)__builtin_amdgcn_readlane((int)v, 0), b = (unsigned)__builtin_amdgcn_readlane((int)v, 16);
  unsigned c = (unsigned)__builtin_amdgcn_readlane((int)v, 32), d = (unsigned)__builtin_amdgcn_readlane((int)v, 48);
  return max(max(a, b), max(c, d));
}
DEV float half_sum32(float v) { v = row_sum16(v); return v + __shfl_xor(v, 16); }
DEV unsigned fkey(float f) { unsigned u = __float_as_uint(f); return (u & 0x80000000u) ? ~u : (u | 0x80000000u); }
DEV f32x16 mfma32(bf16x8 a, bf16x8 b, f32x16 c) { return __builtin_amdgcn_mfma_f32_32x32x16_bf16(a, b, c, 0, 0, 0); }
DEV void zero16(f32x16& v) {
#pragma unroll
  for (int i = 0; i < 16; i++) v[i] = 0.f;
}
DEV size_t kvoff(bool smp, int b, int hh, int tpos, int H, int DW, int LS, int off) {
  return smp ? (size_t)4096 * H * DW + ((size_t)(b * H + hh) * LS + off + tpos) * DW
             : ((size_t)(b * H + hh) * 256 + tpos) * DW;
}


DEV float wave_max_f(float v) {
  v = row_max16(v);
  return fmaxf(fmaxf(rlane(v, 0), rlane(v, 16)), fmaxf(rlane(v, 32), rlane(v, 48)));
}
DEV int wave_sum_i(int v) {
  v += (int)dpp_u<0xB1>((unsigned)v); v += (int)dpp_u<0x4E>((unsigned)v); v += (int)dpp_u<0x141>((unsigned)v); v += (int)dpp_u<0x140>((unsigned)v);
  return (__builtin_amdgcn_readlane(v, 0) + __builtin_amdgcn_readlane(v, 16)) + (__builtin_amdgcn_readlane(v, 32) + __builtin_amdgcn_readlane(v, 48));
}
DEV int mbcnt64(unsigned long long m) { return (int)__builtin_amdgcn_mbcnt_hi((unsigned)(m >> 32), __builtin_amdgcn_mbcnt_lo((unsigned)m, 0u)); }
template <bool SGN> DEV void prep_quant(const float* __restrict__ src, unsigned char* __restrict__ dst, float* __restrict__ scale, int row0) {
  int lane = threadIdx.x & 63, wave = threadIdx.x >> 6;
  for (int rr = wave; rr < 16; rr += 4) {
    int row = row0 + rr;
    const float* x = src + (size_t)row * 1024;
    float4 v[4]; float mx = 0.f;
#pragma unroll
    for (int i = 0; i < 4; i++) {
      v[i] = *(const float4*)(x + (i * 64 + lane) * 4);
      mx = fmaxf(mx, fmaxf(fmaxf(fabsf(v[i].x), fabsf(v[i].y)), fmaxf(fabsf(v[i].z), fabsf(v[i].w))));
    }
    mx = wave_max_f(mx);
    float inv = mx > 0.f ? 127.f / mx : 0.f;
    unsigned w[4];
#pragma unroll
    for (int i = 0; i < 4; i++) {
      int off = SGN ? 0 : 128;
      unsigned b0 = (unsigned)((int)rintf(v[i].x * inv) + off) & 255u, b1 = (unsigned)((int)rintf(v[i].y * inv) + off) & 255u;
      unsigned b2 = (unsigned)((int)rintf(v[i].z * inv) + off) & 255u, b3 = (unsigned)((int)rintf(v[i].w * inv) + off) & 255u;
      w[i] = b0 | (b1 << 8) | (b2 << 16) | (b3 << 24);
    }
    *(uint4*)(dst + (size_t)row * 1024 + lane * 16) = make_uint4(w[0], w[1], w[2], w[3]);
    if (lane == 0) scale[row] = mx * (1.f / 127.f);
  }
}

DEV void prep_transpose(const float* __restrict__ W, int N, u16* __restrict__ Wt, int tile, float* sm) {
  int ntn = N >> 6; int kt = tile / ntn, nt = tile % ntn;
  int k0 = kt * 64, n0 = nt * 64; int t = threadIdx.x;
#pragma unroll
  for (int i = 0; i < 4; i++) {
    int k = (t >> 4) + 16 * i; int c4 = (t & 15) * 4;
    float4 v = *(const float4*)(W + (size_t)(k0 + k) * N + n0 + c4);
    sm[k * 65 + c4] = v.x; sm[k * 65 + c4 + 1] = v.y; sm[k * 65 + c4 + 2] = v.z; sm[k * 65 + c4 + 3] = v.w;
  }
  __syncthreads();
  int n = t >> 2, kc = (t & 3) * 16;
  unsigned pk[8];
#pragma unroll
  for (int j = 0; j < 8; j++) pk[j] = pack2(sm[(kc + 2 * j) * 65 + n], sm[(kc + 2 * j + 1) * 65 + n]);
  uint4* dst = (uint4*)(Wt + (size_t)(n0 + n) * 1024 + k0 + kc);
  dst[0] = make_uint4(pk[0], pk[1], pk[2], pk[3]);
  dst[1] = make_uint4(pk[4], pk[5], pk[6], pk[7]);
  __syncthreads();
}
DEV void conv_item(const float* __restrict__ src, u16* __restrict__ dst) {
  int t = threadIdx.x;
#pragma unroll
  for (int i = 0; i < 8; i++) {
    int e = (i * 256 + t) * 8;
    float4 a = *(const float4*)(src + e), b = *(const float4*)(src + e + 4);
    *(uint4*)(dst + e) = make_uint4(pack2(a.x, a.y), pack2(a.z, a.w), pack2(b.x, b.y), pack2(b.z, b.w));
  }
}
DEV void prep_mod(const Params& p, int it, float* sm) {
  int l = it / 96, n0 = (it % 96) * 64; int t = threadIdx.x;
  float* sc = sm;
  for (int i = t; i < 5120; i += 256) {
    int b = i >> 10, k = i & 1023;
    float v = (b == 0) ? p.cctx[k] : p.c[(b - 1) * 1024 + k];
    sc[i] = silu_f(v);
  }
  __syncthreads();
  int col = t & 63, kg = t >> 6;
  float a0 = 0, a1 = 0, a2 = 0, a3 = 0, a4 = 0;
  const float* w = p.mod_w + (size_t)l * 1024 * 6144 + n0 + col;
  for (int k = kg; k < 1024; k += 4) {
    float wv = w[(size_t)k * 6144];
    a0 += sc[k] * wv; a1 += sc[1024 + k] * wv; a2 += sc[2048 + k] * wv; a3 += sc[3072 + k] * wv; a4 += sc[4096 + k] * wv;
  }
  float* red = sm + 5120;
  red[(kg * 5 + 0) * 64 + col] = a0; red[(kg * 5 + 1) * 64 + col] = a1; red[(kg * 5 + 2) * 64 + col] = a2;
  red[(kg * 5 + 3) * 64 + col] = a3; red[(kg * 5 + 4) * 64 + col] = a4;
  __syncthreads();
  if (t < 64) {
#pragma unroll
    for (int b = 0; b < 5; b++) {
      float s = red[(0 * 5 + b) * 64 + t] + red[(1 * 5 + b) * 64 + t] + red[(2 * 5 + b) * 64 + t] + red[(3 * 5 + b) * 64 + t];
      p.MOD[(size_t)(l * 5 + b) * 6144 + n0 + t] = s + p.mod_b[l * 6144 + n0 + t];
    }
  }
  __syncthreads();
}
DEV void prep_cache(const Params& p, int it) {
  const float* src; u16* dst;
  if (it < 8)       { int ch = it;      src = p.cak + (size_t)ch * 16384; dst = p.KA + (size_t)4096 * 2 * 64 + (size_t)ch * 1280 * 64; }
  else if (it < 16) { int ch = it - 8;  src = p.cav + (size_t)ch * 16384; dst = p.VA + (size_t)4096 * 2 * 64 + (size_t)ch * 1280 * 64; }
  else if (it < 48) { int ch = it - 16; src = p.cck + (size_t)ch * 16384; dst = p.KC + (size_t)4096 * 8 * 64 + (size_t)ch * 1280 * 64; }
  else if (it < 80) { int ch = (it - 48) >> 1, hf = (it - 48) & 1;
                      src = p.ccv + (size_t)ch * 32768 + hf * 16384; dst = p.VC + (size_t)4096 * 4 * 128 + (size_t)ch * 1280 * 128 + hf * 16384; }
  else if (it < 88) { int ch = it - 80; src = p.cdk + (size_t)ch * 16384; dst = p.KD + (size_t)4096 * 2 * 64 + (size_t)ch * 1280 * 64; }
  else              { int ch = it - 88; src = p.cdv + (size_t)ch * 16384; dst = p.VD + (size_t)4096 * 2 * 64 + (size_t)ch * 1280 * 64; }
  conv_item(src, dst);
}
DEV void prep_rope(const Params& p, int it) {
  for (int i = 0; i < 16; i++) {
    int idx = it * 4096 + i * 256 + threadIdx.x;
    int tpos = idx >> 5, a = idx & 31;
    float pos = (a < 16) ? (float)(tpos >> 6) : (float)(tpos & 63);
    float inv = exp2f(-(float)(a & 15) * (13.287712379549449f / 16.f));
    float ang = pos * inv;
    p.ROPEC[idx] = __cosf(ang); p.ROPES[idx] = __sinf(ang);
  }
}
constexpr int PREP_T0 = 704, PREP_T1 = PREP_T0 + 256, PREP_T2 = PREP_T1 + 576, PREP_T3 = PREP_T2 + 256, PREP_T4 = PREP_T3 + 1024;
constexpr int PREP_U = PREP_T4 + 2048, PREP_V = PREP_U + 2048, PREP_SK = PREP_V + 32, PREP_CA = PREP_SK + 96, PREP_RO = PREP_CA + 8, PREP_MOD = PREP_RO + 192;
DEV void phase_prep(const Params& p, int bid, int nb, char* smem) {
  float* sm = (float*)smem;
  for (int it0 = bid; it0 < PREP_MOD; it0 += nb) {
    int it = (it0 < 192) ? (PREP_RO + it0) : (it0 - 192);
    if (it < PREP_T0) prep_transpose(p.ev_w_in, 2816, p.WT_EVIN, it, sm);
    else if (it < PREP_T1) prep_transpose(p.ev_w_out, 1024, p.WT_EVOUT, it - PREP_T0, sm);
    else if (it < PREP_T2) prep_transpose(p.od_w_in, 2304, p.WT_ODIN, it - PREP_T1, sm);
    else if (it < PREP_T3) prep_transpose(p.od_w_out, 1024, p.WT_ODOUT, it - PREP_T2, sm);
    else if (it < PREP_T4) { int j = it - PREP_T3; int l = j >> 9; prep_transpose(p.peer_wq + (size_t)l * 1024 * 2048, 2048, p.WT_PQ + (size_t)l * 2048 * 1024, j & 511, sm); }
    else if (it < PREP_U) prep_quant<true>(p.peer_u, p.U8, p.SU, (it - PREP_T4) * 16);
    else if (it < PREP_V) prep_quant<false>(p.peer_v, p.V8, p.SV, (it - PREP_U) * 16);
    else if (it < PREP_SK) { size_t o = (size_t)(it - PREP_V) * 16384; conv_item(p.peer_sk + o, p.SUBK + o); }
    else if (it < PREP_CA) prep_cache(p, it - PREP_SK);
    else if (it < PREP_RO) prep_rope(p, it - PREP_CA);
    else prep_mod(p, it - PREP_RO, sm);
  }
}

DEV void phase_ada(const Params& p, int layer, const float* __restrict__ gain, int shift_i, int scale_i, bool from_input, int bid, int nb) {
  int wave = threadIdx.x >> 6, lane = threadIdx.x & 63;
  for (int T = bid * 4 + wave; T < 8192; T += nb * 4) {
    const float* xr = from_input ? (T < 4096 ? p.xp + (size_t)T * 1024 : p.xs + (size_t)(T - 4096) * 1024) : p.X + (size_t)T * 1024;
    int mb = T < 4096 ? 0 : 1 + ((T - 4096) >> 10);
    const float* md = p.MOD + (size_t)(layer * 5 + mb) * 6144;
    float4 v[4]; float ss = 0;
#pragma unroll
    for (int i = 0; i < 4; i++) { v[i] = *(const float4*)(xr + (i * 64 + lane) * 4); ss += v[i].x * v[i].x + v[i].y * v[i].y + v[i].z * v[i].z + v[i].w * v[i].w; }
    ss = wave_sum(ss);
    float rstd = rsqrtf(ss * (1.f / 1024.f) + 1e-6f);
#pragma unroll
    for (int i = 0; i < 4; i++) {
      int col = (i * 64 + lane) * 4;
      float4 g = *(const float4*)(gain + col), sh = *(const float4*)(md + shift_i * 1024 + col), sc = *(const float4*)(md + scale_i * 1024 + col);
      float y0 = v[i].x * rstd * g.x * (1.f + sc.x) + sh.x, y1 = v[i].y * rstd * g.y * (1.f + sc.y) + sh.y;
      float y2 = v[i].z * rstd * g.z * (1.f + sc.z) + sh.z, y3 = v[i].w * rstd * g.w * (1.f + sc.w) + sh.w;
      *(uint2*)(p.H + (size_t)T * 1024 + col) = make_uint2(pack2(y0, y1), pack2(y2, y3));
    }
  }
}

DEV void gemm_tile(const u16* __restrict__ A, int lda, const u16* __restrict__ B, int ldb, int K, char* smem, f32x16 (&acc)[2][2]) {
  u16* sA = (u16*)smem; u16* sB = sA + 128 * 72;
  int t = threadIdx.x, lane = t & 63, wave = t >> 6, r = lane & 31, h = lane >> 5;
  int wm = wave >> 1, wn = wave & 1;
  int lrow = t >> 3, lkc = (t & 7) * 8;
  const u16* ap = A + (size_t)lrow * lda + lkc;
  const u16* bp = B + (size_t)lrow * ldb + lkc;
  size_t sa32 = (size_t)32 * lda, sb32 = (size_t)32 * ldb;
  u32x4 ra0 = *(const u32x4*)(ap), ra1 = *(const u32x4*)(ap + sa32), ra2 = *(const u32x4*)(ap + 2 * sa32), ra3 = *(const u32x4*)(ap + 3 * sa32);
  u32x4 rb0 = *(const u32x4*)(bp), rb1 = *(const u32x4*)(bp + sb32), rb2 = *(const u32x4*)(bp + 2 * sb32), rb3 = *(const u32x4*)(bp + 3 * sb32);
  u16* wa = sA + lrow * 72 + lkc; u16* wb = sB + lrow * 72 + lkc;
  for (int k0 = 0; k0 < K; k0 += 64) {
    __syncthreads();
    *(u32x4*)(wa) = ra0; *(u32x4*)(wa + 32 * 72) = ra1; *(u32x4*)(wa + 64 * 72) = ra2; *(u32x4*)(wa + 96 * 72) = ra3;
    *(u32x4*)(wb) = rb0; *(u32x4*)(wb + 32 * 72) = rb1; *(u32x4*)(wb + 64 * 72) = rb2; *(u32x4*)(wb + 96 * 72) = rb3;
    __syncthreads();
    if (k0 + 64 < K) {
      ap += 64; bp += 64;
      ra0 = *(const u32x4*)(ap); ra1 = *(const u32x4*)(ap + sa32); ra2 = *(const u32x4*)(ap + 2 * sa32); ra3 = *(const u32x4*)(ap + 3 * sa32);
      rb0 = *(const u32x4*)(bp); rb1 = *(const u32x4*)(bp + sb32); rb2 = *(const u32x4*)(bp + 2 * sb32); rb3 = *(const u32x4*)(bp + 3 * sb32);
    }
#pragma unroll
    for (int kk = 0; kk < 4; kk++) {
      bf16x8 a0 = *(const bf16x8*)(sA + (wm * 64 + r) * 72 + kk * 16 + h * 8);
      bf16x8 a1 = *(const bf16x8*)(sA + (wm * 64 + 32 + r) * 72 + kk * 16 + h * 8);
      bf16x8 b0 = *(const bf16x8*)(sB + (wn * 64 + r) * 72 + kk * 16 + h * 8);
      bf16x8 b1 = *(const bf16x8*)(sB + (wn * 64 + 32 + r) * 72 + kk * 16 + h * 8);
      acc[0][0] = mfma32(a0, b0, acc[0][0]); acc[0][1] = mfma32(a0, b1, acc[0][1]);
      acc[1][0] = mfma32(a1, b0, acc[1][0]); acc[1][1] = mfma32(a1, b1, acc[1][1]);
    }
  }
  __syncthreads();
  float* Cs = (float*)smem;
#pragma unroll
  for (int i = 0; i < 2; i++)
#pragma unroll
    for (int j = 0; j < 2; j++)
#pragma unroll
      for (int g = 0; g < 16; g++)
        Cs[(wm * 64 + i * 32 + (g & 3) + 8 * (g >> 2) + 4 * h) * 128 + wn * 64 + j * 32 + r] = acc[i][j][g];
  __syncthreads();
}

template <class Epi>
DEV void gemm_phase(const u16* A, int lda, const u16* Bt, int ldb, int K, int MT, int NTl, int bid, int nb, char* smem, Epi epi) {
  for (int it = bid; it < MT * NTl; it += nb) {
    int mt = it / NTl, nt = it % NTl;
    f32x16 acc[2][2];
    zero16(acc[0][0]); zero16(acc[0][1]); zero16(acc[1][0]); zero16(acc[1][1]);
    gemm_tile(A + (size_t)mt * 128 * lda, lda, Bt + (size_t)nt * 128 * ldb, ldb, K, smem, acc);
    epi(mt * 128, nt * 128, (const float*)smem);
  }
}

DEV void tok_decode(int T, bool& smp, int& b, int& tpos) {
  smp = T >= 4096;
  if (!smp) { b = T >> 8; tpos = T & 255; } else { b = (T - 4096) >> 10; tpos = (T - 4096) & 1023; }
}
DEV void rope_pair(const Params& p, float& x, float& y, int tpos, int d) {
  float px = __shfl_xor(x, 16), py = __shfl_xor(y, 16);
  int a = d & 31;
  float c0 = p.ROPEC[tpos * 32 + a], c1 = p.ROPEC[tpos * 32 + a + 1];
  float s0 = p.ROPES[tpos * 32 + a], s1 = p.ROPES[tpos * 32 + a + 1];
  if (d < 32) { x = x * c0 - px * s0; y = y * c1 - py * s1; }
  else        { x = px * s0 + x * c0; y = py * s1 + y * c1; }
}

DEV void epi_inproj0(const Params& p, int m0, int n0, const float* Cs) {
  int lane = threadIdx.x & 63, wave = threadIdx.x >> 6;
  for (int rr = wave; rr < 128; rr += 4) {
    int T = m0 + rr; bool smp; int b, tpos; tok_decode(T, smp, b, tpos);
    float2 c = *(const float2*)(Cs + rr * 128 + lane * 2);
    int col = n0 + lane * 2; int d = col & 63;
    if (n0 < 640) {
      float ss = half_sum32(c.x * c.x + c.y * c.y);
      float rstd = rsqrtf(ss * (1.f / 64.f) + 1e-6f);
      const float* g = (n0 < 512) ? p.a_q_norm : p.a_k_norm;
      c.x *= rstd * g[d]; c.y *= rstd * g[d + 1];
      if (smp) rope_pair(p, c.x, c.y, tpos, d);
      if (n0 < 512) {
        *(unsigned*)(p.Q1 + (size_t)T * 512 + col) = pack2(c.x * 0.125f, c.y * 0.125f);
      } else {
        int hh = (col - 512) >> 6;
        *(unsigned*)(p.KA + kvoff(smp, b, hh, tpos, 2, 64, 1280, 256) + d) = pack2(c.x, c.y);
        if (!smp) *(float2*)(p.out + OUT_AK + ((size_t)(b * 2 + hh) * 256 + tpos) * 64 + d) = c;
      }
    } else if (n0 < 768) {
      int hh = (col - 640) >> 6;
      *(unsigned*)(p.VA + kvoff(smp, b, hh, tpos, 2, 64, 1280, 256) + d) = pack2(c.x, c.y);
      if (!smp) *(float2*)(p.out + OUT_AV + ((size_t)(b * 2 + hh) * 256 + tpos) * 64 + d) = c;
    } else if (n0 < 1280) {
      *(unsigned*)(p.Q2 + (size_t)T * 512 + (col - 768)) = pack2(c.x, c.y);
    } else if (n0 < 1792) {
      int hh = (col - 1280) >> 6;
      *(unsigned*)(p.RK + kvoff(smp, b, hh, tpos, 8, 64, 1024, 0) + d) = pack2(c.x * 0.125f, c.y * 0.125f);
    } else if (n0 < 2304) {
      int hh = (col - 1792) >> 6;
      *(unsigned*)(p.RV + kvoff(smp, b, hh, tpos, 8, 64, 1024, 0) + d) = pack2(c.x, c.y);
    } else {
      *(unsigned*)(p.SG + (size_t)T * 512 + (col - 2304)) = pack2(silu_f(c.x), silu_f(c.y));
    }
  }
}
DEV void epi_inproj1(const Params& p, int m0, int n0, const float* Cs) {
  int lane = threadIdx.x & 63, wave = threadIdx.x >> 6;
  for (int rr = wave; rr < 128; rr += 4) {
    int T = m0 + rr; bool smp; int b, tpos; tok_decode(T, smp, b, tpos);
    float2 c = *(const float2*)(Cs + rr * 128 + lane * 2);
    int col = n0 + lane * 2; int d = col & 63;
    if (n0 < 512) {
      if (smp) rope_pair(p, c.x, c.y, tpos, d);
      *(unsigned*)(p.Q1 + (size_t)T * 512 + col) = pack2(c.x * 0.125f, c.y * 0.125f);
    } else if (n0 < 1024) {
      int mp = (col - 512) >> 6;
      if (!smp) *(float2*)(p.out + OUT_CK + ((size_t)(b * 8 + mp) * 256 + tpos) * 64 + d) = c;
      if (smp) rope_pair(p, c.x, c.y, tpos, d);
      *(unsigned*)(p.KC + kvoff(smp, b, mp, tpos, 8, 64, 1280, 256) + d) = pack2(c.x, c.y);
    } else if (n0 < 1536) {
      int hh = (col - 1024) >> 7; int dd = (col - 1024) & 127;
      if (!smp) *(float2*)(p.out + OUT_CV + ((size_t)(b * 4 + hh) * 256 + tpos) * 128 + dd) = c;
      *(unsigned*)(p.VC + kvoff(smp, b, hh, tpos, 4, 128, 1280, 256) + dd) = pack2(c.x, c.y);
    } else if (n0 < 2048) {
      if (smp) rope_pair(p, c.x, c.y, tpos, d);
      *(unsigned*)(p.Q2 + (size_t)T * 512 + (col - 1536)) = pack2(c.x * 0.125f, c.y * 0.125f);
    } else if (n0 < 2176) {
      int hh = (col - 2048) >> 6;
      if (!smp) *(float2*)(p.out + OUT_DK + ((size_t)(b * 2 + hh) * 256 + tpos) * 64 + d) = c;
      if (smp) rope_pair(p, c.x, c.y, tpos, d);
      *(unsigned*)(p.KD + kvoff(smp, b, hh, tpos, 2, 64, 1280, 256) + d) = pack2(c.x, c.y);
    } else {
      int hh = (col - 2176) >> 6;
      if (!smp) *(float2*)(p.out + OUT_DV + ((size_t)(b * 2 + hh) * 256 + tpos) * 64 + d) = c;
      *(unsigned*)(p.VD + kvoff(smp, b, hh, tpos, 2, 64, 1280, 256) + d) = pack2(c.x, c.y);
    }
  }
}
DEV void epi_outproj(const Params& p, int layer, int m0, int n0, const float* Cs) {
  int lane = threadIdx.x & 63, wave = threadIdx.x >> 6;
  for (int rr = wave; rr < 128; rr += 4) {
    int T = m0 + rr;
    int mb = T < 4096 ? 0 : 1 + ((T - 4096) >> 10);
    const float* xr = (layer == 0) ? (T < 4096 ? p.xp + (size_t)T * 1024 : p.xs + (size_t)(T - 4096) * 1024) : p.X + (size_t)T * 1024;
    float2 c = *(const float2*)(Cs + rr * 128 + lane * 2);
    int col = n0 + lane * 2;
    float2 x = *(const float2*)(xr + col);
    float2 g = *(const float2*)(p.MOD + (size_t)(layer * 5 + mb) * 6144 + 2048 + col);
    x.x += g.x * c.x; x.y += g.y * c.y;
    *(float2*)(p.X + (size_t)T * 1024 + col) = x;
  }
}

DEV void load_k_tile(const u16* __restrict__ k, u16* sK) {
  int t = threadIdx.x;
#pragma unroll
  for (int i = 0; i < 2; i++) {
    int c = t + 256 * i; int key = c >> 3, dc = c & 7;
    *(uint4*)(sK + key * 72 + dc * 8) = *(const uint4*)(k + key * 64 + dc * 8);
  }
}
template <int DV> DEV void load_v_tile(const u16* __restrict__ v, u16* sVT) {
  int lane = threadIdx.x & 63, wave = threadIdx.x >> 6;
#pragma unroll
  for (int i = 0; i < DV / 32; i++) {
    int dc = wave + 4 * i;
    uint4 x = *(const uint4*)(v + (size_t)lane * DV + dc * 8);
    u16* d = sVT + (dc * 8) * 76 + lane;
    d[0 * 76] = (u16)(x.x & 0xffff); d[1 * 76] = (u16)(x.x >> 16);
    d[2 * 76] = (u16)(x.y & 0xffff); d[3 * 76] = (u16)(x.y >> 16);
    d[4 * 76] = (u16)(x.z & 0xffff); d[5 * 76] = (u16)(x.z >> 16);
    d[6 * 76] = (u16)(x.w & 0xffff); d[7 * 76] = (u16)(x.w >> 16);
  }
}
DEV void load_ident_k(u16* sK) {
  int t = threadIdx.x;
#pragma unroll
  for (int i = 0; i < 2; i++) {
    int c = t + 256 * i; int key = c >> 3, dc = c & 7;
    unsigned w[4] = {0u, 0u, 0u, 0u};
    uint4 z = make_uint4(0u, 0u, 0u, 0u);
    if (dc == (key >> 3)) {
      int e = key & 7; unsigned one = (e & 1) ? 0x3F800000u : 0x00003F80u;
      if ((e >> 1) == 0) z.x = one; else if ((e >> 1) == 1) z.y = one; else if ((e >> 1) == 2) z.z = one; else z.w = one;
    }
    (void)w;
    *(uint4*)(sK + key * 72 + dc * 8) = z;
  }
}
DEV void load_state_v(const float* __restrict__ S0, u16* sVT) {
  int lane = threadIdx.x & 63, wave = threadIdx.x >> 6;
#pragma unroll
  for (int i = 0; i < 2; i++) {
    int dc = wave + 4 * i;
    float4 a = *(const float4*)(S0 + lane * 64 + dc * 8), b = *(const float4*)(S0 + lane * 64 + dc * 8 + 4);
    u16* d = sVT + (dc * 8) * 76 + lane;
    d[0 * 76] = f2bf(a.x); d[1 * 76] = f2bf(a.y); d[2 * 76] = f2bf(a.z); d[3 * 76] = f2bf(a.w);
    d[4 * 76] = f2bf(b.x); d[5 * 76] = f2bf(b.y); d[6 * 76] = f2bf(b.z); d[7 * 76] = f2bf(b.w);
  }
}
template <int DV, class F>
DEV void attn_compute(const bf16x8 (&qf)[4], f32x16 (&o)[DV / 32], const u16* sK, const u16* sVT, F&& xform) {
  int lane = threadIdx.x & 63, r = lane & 31, h = lane >> 5;
  f32x16 st[2]; zero16(st[0]); zero16(st[1]);
#pragma unroll
  for (int sub = 0; sub < 2; sub++)
#pragma unroll
    for (int kk = 0; kk < 4; kk++) {
      bf16x8 kf = *(const bf16x8*)(sK + (sub * 32 + r) * 72 + kk * 16 + h * 8);
      st[sub] = mfma32(kf, qf[kk], st[sub]);
    }
  xform(st);
  bf16x8 pf[2][2];
#pragma unroll
  for (int sub = 0; sub < 2; sub++)
#pragma unroll
    for (int s = 0; s < 2; s++) {
      u32x4 w;
      w[0] = pack2(st[sub][8 * s + 0], st[sub][8 * s + 1]); w[1] = pack2(st[sub][8 * s + 2], st[sub][8 * s + 3]);
      w[2] = pack2(st[sub][8 * s + 4], st[sub][8 * s + 5]); w[3] = pack2(st[sub][8 * s + 6], st[sub][8 * s + 7]);
      pf[sub][s] = __builtin_bit_cast(bf16x8, w);
    }
#pragma unroll
  for (int ds = 0; ds < DV / 32; ds++)
#pragma unroll
    for (int sub = 0; sub < 2; sub++)
#pragma unroll
      for (int s = 0; s < 2; s++) {
        const u16* vp = sVT + (ds * 32 + r) * 76 + sub * 32 + s * 16 + 4 * h;
        uint2 lo = *(const uint2*)vp, hi = *(const uint2*)(vp + 8);
        u32x4 w; w[0] = lo.x; w[1] = lo.y; w[2] = hi.x; w[3] = hi.y;
        o[ds] = mfma32(__builtin_bit_cast(bf16x8, w), pf[sub][s], o[ds]);
      }
}
template <int DV>
DEV void softmax_xform(f32x16 (&st)[2], f32x16 (&o)[DV / 32], float& m, float& l, bool masked, int kpos0, int qpos) {
  int h = (threadIdx.x & 63) >> 5;
  float mx = -1e30f;
#pragma unroll
  for (int sub = 0; sub < 2; sub++)
#pragma unroll
    for (int g = 0; g < 16; g++) {
      float s = st[sub][g];
      if (masked) {
        int j = kpos0 + sub * 32 + (g & 3) + 8 * (g >> 2) + 4 * h;
        int dl = qpos - j; if (dl < 0) dl = -dl;
        if (dl > 128) s = -1e30f;
        st[sub][g] = s;
      }
      mx = fmaxf(mx, s);
    }
  mx = fmaxf(mx, __shfl_xor(mx, 32));
  float mnew = fmaxf(m, mx);
  float alpha = __expf(m - mnew);
  m = mnew;
  float ls = 0.f;
#pragma unroll
  for (int sub = 0; sub < 2; sub++)
#pragma unroll
    for (int g = 0; g < 16; g++) { float pv = __expf(st[sub][g] - mnew); st[sub][g] = pv; ls += pv; }
  l = l * alpha + ls;
#pragma unroll
  for (int ds = 0; ds < DV / 32; ds++)
#pragma unroll
    for (int g = 0; g < 16; g++) o[ds][g] *= alpha;
}

template <int DV>
DEV void attn_softmax_job(const Params& p, const u16* Q, int Tq0, int qcol, const u16* kb, const u16* vb,
                          int nplain, int band_lo, int band_hi, int qpos0, bool use_sink, float sinkv,
                          f32x16 (&o)[DV / 32], char* smem) {
  u16* sK = (u16*)smem; u16* sVT = sK + 64 * 72;
  int lane = threadIdx.x & 63, wave = threadIdx.x >> 6, r = lane & 31, h = lane >> 5;
  bf16x8 qf[4];
#pragma unroll
  for (int kk = 0; kk < 4; kk++) qf[kk] = *(const bf16x8*)(Q + (size_t)(Tq0 + wave * 32 + r) * 512 + qcol + kk * 16 + h * 8);
#pragma unroll
  for (int ds = 0; ds < DV / 32; ds++) zero16(o[ds]);
  float m = use_sink ? sinkv : -1e30f;
  float l = (use_sink && h == 0) ? 1.f : 0.f;
  int qpos = qpos0 + wave * 32 + r;
  int ntot = nplain + (band_hi - band_lo);
  for (int ti = 0; ti < ntot; ti++) {
    bool masked = ti >= nplain;
    int key0 = masked ? (256 + (band_lo + ti - nplain) * 64) : ti * 64;
    int kpos0 = key0 - 256;
    __syncthreads();
    load_k_tile(kb + (size_t)key0 * 64, sK);
    load_v_tile<DV>(vb + (size_t)key0 * DV, sVT);
    __syncthreads();
    attn_compute<DV>(qf, o, sK, sVT, [&](f32x16 (&st)[2]) { softmax_xform<DV>(st, o, m, l, masked, kpos0, qpos); });
  }
  float lt = l + __shfl_xor(l, 32);
  float inv = 1.f / lt;
#pragma unroll
  for (int ds = 0; ds < DV / 32; ds++)
#pragma unroll
    for (int g = 0; g < 16; g++) o[ds][g] *= inv;
}
DEV void store_o64(const Params& p, const f32x16 (&o)[2], int Tq0, int mixcol) {
  int lane = threadIdx.x & 63, wave = threadIdx.x >> 6, r = lane & 31, h = lane >> 5;
  int T = Tq0 + wave * 32 + r;
#pragma unroll
  for (int ds = 0; ds < 2; ds++)
#pragma unroll
    for (int g4 = 0; g4 < 4; g4++) {
      int d0 = ds * 32 + 8 * g4 + 4 * h;
      *(uint2*)(p.MIX + (size_t)T * 1024 + mixcol + d0) =
          make_uint2(pack2(o[ds][4 * g4], o[ds][4 * g4 + 1]), pack2(o[ds][4 * g4 + 2], o[ds][4 * g4 + 3]));
    }
}

DEV void ret_job(const Params& p, bool smp, int b, int hh, int qb, char* smem) {
  u16* sK = (u16*)smem; u16* sVT = sK + 64 * 72;
  int lane = threadIdx.x & 63, wave = threadIdx.x >> 6, r = lane & 31, h = lane >> 5;
  int L = smp ? 1024 : 256;
  int Tq0 = (smp ? 4096 + b * 1024 : b * 256) + qb * 128;
  const u16* kb = p.RK + kvoff(smp, b, hh, 0, 8, 64, 1024, 0);
  const u16* vb = p.RV + kvoff(smp, b, hh, 0, 8, 64, 1024, 0);
  float xf = p.rdf[hh], xb = p.rdb[hh];
  float lf2 = -log1pf(__expf(-xf)) * 1.4426950408889634f;
  float lb2 = -log1pf(__expf(-xb)) * 1.4426950408889634f;
  bf16x8 qf[4];
#pragma unroll
  for (int kk = 0; kk < 4; kk++) qf[kk] = *(const bf16x8*)(p.Q2 + (size_t)(Tq0 + wave * 32 + r) * 512 + hh * 64 + kk * 16 + h * 8);
  f32x16 o[2]; zero16(o[0]); zero16(o[1]);
  int qpos = qb * 128 + wave * 32 + r;
  int nt = L / 64;
  for (int ti = 0; ti < nt; ti++) {
    __syncthreads();
    load_k_tile(kb + (size_t)ti * 64 * 64, sK);
    load_v_tile<64>(vb + (size_t)ti * 64 * 64, sVT);
    __syncthreads();
    int kpos0 = ti * 64;
    attn_compute<64>(qf, o, sK, sVT, [&](f32x16 (&st)[2]) {
#pragma unroll
      for (int sub = 0; sub < 2; sub++)
#pragma unroll
        for (int g = 0; g < 16; g++) {
          int j = kpos0 + sub * 32 + (g & 3) + 8 * (g >> 2) + 4 * h;
          int dl = qpos - j;
          float e = dl >= 0 ? lf2 * (float)dl : lb2 * (float)(-dl);
          st[sub][g] *= exp2f(e);
        }
    });
  }
  if (smp) {
    for (int dir = 0; dir < 2; dir++) {
      const float* S0 = (dir == 0 ? p.srf : p.srb) + (size_t)(b * 8 + hh) * 4096;
      float rs = dir == 0 ? exp2f(lf2 * (float)(qpos + 1)) : exp2f(lb2 * (float)(L - qpos));
      __syncthreads();
      load_ident_k(sK);
      load_state_v(S0, sVT);
      __syncthreads();
      attn_compute<64>(qf, o, sK, sVT, [&](f32x16 (&st)[2]) {
#pragma unroll
        for (int sub = 0; sub < 2; sub++)
#pragma unroll
          for (int g = 0; g < 16; g++) st[sub][g] *= rs;
      });
    }
  }
  float sum = 0.f;
#pragma unroll
  for (int ds = 0; ds < 2; ds++)
#pragma unroll
    for (int g = 0; g < 16; g++) sum += o[ds][g];
  sum += __shfl_xor(sum, 32);
  float mean = sum * (1.f / 64.f);
  float vs = 0.f;
#pragma unroll
  for (int ds = 0; ds < 2; ds++)
#pragma unroll
    for (int g = 0; g < 16; g++) { float dlt = o[ds][g] - mean; vs += dlt * dlt; }
  vs += __shfl_xor(vs, 32);
  float rstd = rsqrtf(vs * (1.f / 64.f) + 1e-6f);
  int T = Tq0 + wave * 32 + r;
#pragma unroll
  for (int ds = 0; ds < 2; ds++)
#pragma unroll
    for (int g4 = 0; g4 < 4; g4++) {
      int d0 = ds * 32 + 8 * g4 + 4 * h;
      uint2 gt = *(const uint2*)(p.SG + (size_t)T * 512 + hh * 64 + d0);
      float y0 = (o[ds][4 * g4] - mean) * rstd * bflo(gt.x), y1 = (o[ds][4 * g4 + 1] - mean) * rstd * bfhi(gt.x);
      float y2 = (o[ds][4 * g4 + 2] - mean) * rstd * bflo(gt.y), y3 = (o[ds][4 * g4 + 3] - mean) * rstd * bfhi(gt.y);
      *(uint2*)(p.MIX + (size_t)T * 1024 + 512 + hh * 64 + d0) = make_uint2(pack2(y0, y1), pack2(y2, y3));
    }
}
DEV void ret_state_job(const Params& p, int b, int hh, int dir, char* smem) {
  u16* sKk = (u16*)smem; u16* sVv = sKk + 64 * 64;
  int t = threadIdx.x;
  const u16* kb = p.RK + kvoff(false, b, hh, 0, 8, 64, 1024, 0);
  const u16* vb = p.RV + kvoff(false, b, hh, 0, 8, 64, 1024, 0);
  float xx = dir == 0 ? p.rdf[hh] : p.rdb[hh];
  float lg2 = -log1pf(__expf(-xx)) * 1.4426950408889634f;
  int dk = t >> 2, dvc = (t & 3) * 16;
  float acc[16];
#pragma unroll
  for (int i = 0; i < 16; i++) acc[i] = 0.f;
  for (int ch = 0; ch < 4; ch++) {
    __syncthreads();
#pragma unroll
    for (int i = 0; i < 2; i++) {
      int c = t + 256 * i;
      *(uint4*)(sKk + c * 8) = *(const uint4*)(kb + (size_t)ch * 4096 + c * 8);
      *(uint4*)(sVv + c * 8) = *(const uint4*)(vb + (size_t)ch * 4096 + c * 8);
    }
    __syncthreads();
    for (int jj = 0; jj < 64; jj++) {
      int j = ch * 64 + jj;
      float w = exp2f(lg2 * (float)(dir == 0 ? 255 - j : j));
      float kv = bf2f(sKk[jj * 64 + dk]) * w;
      const uint4* vp = (const uint4*)(sVv + jj * 64 + dvc);
      uint4 v0 = vp[0], v1 = vp[1];
      acc[0] += kv * bflo(v0.x); acc[1] += kv * bfhi(v0.x); acc[2] += kv * bflo(v0.y); acc[3] += kv * bfhi(v0.y);
      acc[4] += kv * bflo(v0.z); acc[5] += kv * bfhi(v0.z); acc[6] += kv * bflo(v0.w); acc[7] += kv * bfhi(v0.w);
      acc[8] += kv * bflo(v1.x); acc[9] += kv * bfhi(v1.x); acc[10] += kv * bflo(v1.y); acc[11] += kv * bfhi(v1.y);
      acc[12] += kv * bflo(v1.z); acc[13] += kv * bfhi(v1.z); acc[14] += kv * bflo(v1.w); acc[15] += kv * bfhi(v1.w);
    }
  }
  float* dst = p.out + (dir == 0 ? OUT_RF : OUT_RB) + ((size_t)(b * 8 + hh) * 64 + dk) * 64 + dvc;
#pragma unroll
  for (int i = 0; i < 4; i++) *(float4*)(dst + 4 * i) = make_float4(acc[4 * i], acc[4 * i + 1], acc[4 * i + 2], acc[4 * i + 3]);
}

DEV void phase_attn0(const Params& p, int bid, int nb, char* smem) {
  for (int it = bid; it < 1280; it += nb) {
    if (it < 256) {
      int b = it >> 6, hq = (it >> 3) & 7, qb = it & 7; int kvh = hq >> 2;
      f32x16 o[2];
      int Tq0 = 4096 + b * 1024 + qb * 128;
      attn_softmax_job<64>(p, p.Q1, Tq0, hq * 64, p.KA + kvoff(true, b, kvh, -256, 2, 64, 1280, 256), p.VA + kvoff(true, b, kvh, -256, 2, 64, 1280, 256),
                           20, 0, 0, qb * 128, false, 0.f, o, smem);
      store_o64(p, o, Tq0, hq * 64);
    } else if (it < 512) {
      int j = it - 256; int b = j >> 6, hh = (j >> 3) & 7, qb = j & 7;
      ret_job(p, true, b, hh, qb, smem);
    } else if (it < 768) {
      int j = it - 512; int b = j >> 4, hq = (j >> 1) & 7, qb = j & 1; int kvh = hq >> 2;
      f32x16 o[2];
      int Tq0 = b * 256 + qb * 128;
      attn_softmax_job<64>(p, p.Q1, Tq0, hq * 64, p.KA + kvoff(false, b, kvh, 0, 2, 64, 1280, 256), p.VA + kvoff(false, b, kvh, 0, 2, 64, 1280, 256),
                           4, 0, 0, qb * 128, false, 0.f, o, smem);
      store_o64(p, o, Tq0, hq * 64);
    } else if (it < 1024) {
      int j = it - 768; int b = j >> 4, hh = (j >> 1) & 7, qb = j & 1;
      ret_job(p, false, b, hh, qb, smem);
    } else {
      int j = it - 1024; int b = j >> 4, hh = (j >> 1) & 7, dir = j & 1;
      ret_state_job(p, b, hh, dir, smem);
    }
  }
}
DEV void diff_job(const Params& p, bool smp, int b, int hh, int qb, float lam, char* smem) {
  int lane = threadIdx.x & 63, wave = threadIdx.x >> 6, r = lane & 31, h = lane >> 5;
  int Tq0 = (smp ? 4096 + b * 1024 : b * 256) + qb * 128;
  int nt = smp ? 20 : 4;
  const u16* vb = p.VC + kvoff(smp, b, hh, smp ? -256 : 0, 4, 128, 1280, 256);
  f32x16 o1[4];
  unsigned* o0s = (unsigned*)(smem + 32768) + threadIdx.x;
  attn_softmax_job<128>(p, p.Q1, Tq0, (2 * hh) * 64, p.KC + kvoff(smp, b, 2 * hh, smp ? -256 : 0, 8, 64, 1280, 256), vb, nt, 0, 0, qb * 128, false, 0.f, o1, smem);
#pragma unroll
  for (int ds = 0; ds < 4; ds++)
#pragma unroll
    for (int g = 0; g < 8; g++) o0s[(ds * 8 + g) * 256] = pack2(o1[ds][2 * g], o1[ds][2 * g + 1]);
  attn_softmax_job<128>(p, p.Q1, Tq0, (2 * hh + 1) * 64, p.KC + kvoff(smp, b, 2 * hh + 1, smp ? -256 : 0, 8, 64, 1280, 256), vb, nt, 0, 0, qb * 128, false, 0.f, o1, smem);
  float ss = 0.f;
  f32x16 o0[4];
#pragma unroll
  for (int ds = 0; ds < 4; ds++)
#pragma unroll
    for (int g = 0; g < 8; g++) {
      unsigned w = o0s[(ds * 8 + g) * 256];
      float d0 = bflo(w) - lam * o1[ds][2 * g], d1 = bfhi(w) - lam * o1[ds][2 * g + 1];
      o0[ds][2 * g] = d0; o0[ds][2 * g + 1] = d1; ss += d0 * d0 + d1 * d1;
    }
  ss += __shfl_xor(ss, 32);
  float rstd = rsqrtf(ss * (1.f / 128.f) + 1e-6f) * (1.f - LAM_INIT);
  int T = Tq0 + wave * 32 + r;
#pragma unroll
  for (int ds = 0; ds < 4; ds++)
#pragma unroll
    for (int g4 = 0; g4 < 4; g4++) {
      int d0 = ds * 32 + 8 * g4 + 4 * h;
      float4 sg = *(const float4*)(p.subln + d0);
      *(uint2*)(p.MIX + (size_t)T * 1024 + hh * 128 + d0) =
          make_uint2(pack2(o0[ds][4 * g4] * rstd * sg.x, o0[ds][4 * g4 + 1] * rstd * sg.y),
                     pack2(o0[ds][4 * g4 + 2] * rstd * sg.z, o0[ds][4 * g4 + 3] * rstd * sg.w));
    }
}
DEV void phase_attn1(const Params& p, int bid, int nb, char* smem) {
  float d1 = 0.f, d2 = 0.f;
  for (int i = 0; i < 64; i++) { d1 += p.lq1[i] * p.lk1[i]; d2 += p.lq2[i] * p.lk2[i]; }
  float lam = __expf(d1) - __expf(d2) + LAM_INIT;
  for (int it = bid; it < 768; it += nb) {
    if (it < 128) {
      int b = it >> 5, hh = (it >> 3) & 3, qb = it & 7;
      diff_job(p, true, b, hh, qb, lam, smem);
    } else if (it < 384) {
      int j = it - 128; int b = j >> 6, hq = (j >> 3) & 7, qb = j & 7; int kvh = hq >> 2;
      int q0 = qb * 128;
      int lo = (q0 - 128 < 0 ? 0 : q0 - 128) >> 6, hi = (q0 + 256 > 1024 ? 1024 : q0 + 256) >> 6;
      f32x16 o[2];
      int Tq0 = 4096 + b * 1024 + q0;
      attn_softmax_job<64>(p, p.Q2, Tq0, hq * 64, p.KD + kvoff(true, b, kvh, -256, 2, 64, 1280, 256), p.VD + kvoff(true, b, kvh, -256, 2, 64, 1280, 256),
                           4, lo, hi, q0, true, p.dsink[hq], o, smem);
      store_o64(p, o, Tq0, 512 + hq * 64);
    } else if (it < 512) {
      int j = it - 384; int b = j >> 3, hh = (j >> 1) & 3, qb = j & 1;
      diff_job(p, false, b, hh, qb, lam, smem);
    } else {
      int j = it - 512; int b = j >> 4, hq = (j >> 1) & 7, qb = j & 1; int kvh = hq >> 2;
      f32x16 o[2];
      int Tq0 = b * 256 + qb * 128;
      attn_softmax_job<64>(p, p.Q2, Tq0, hq * 64, p.KD + kvoff(false, b, kvh, 0, 2, 64, 1280, 256), p.VD + kvoff(false, b, kvh, 0, 2, 64, 1280, 256),
                           4, 0, 0, qb * 128, true, p.dsink[hq], o, smem);
      store_o64(p, o, Tq0, 512 + hq * 64);
    }
  }
}

DEV float ub0(unsigned w) { return (float)(w & 255u); }
DEV float ub1(unsigned w) { return (float)((w >> 8) & 255u); }
DEV float ub2(unsigned w) { return (float)((w >> 16) & 255u); }
DEV float ub3(unsigned w) { return (float)(w >> 24); }
DEV void phase_peer(const Params& p, int layer, int bid, int nb, char* smem) {
  int wave = threadIdx.x >> 6, lane = threadIdx.x & 63;
  float* ws1 = (float*)(smem + wave * 2048); float* ws2 = ws1 + 16;
  int* wi1 = (int*)(ws2 + 16); int* wi2 = wi1 + 16; float* es = (float*)(wi2 + 16); int* eidx = (int*)(es + 16); float* eg = (float*)(eidx + 128);
  const unsigned char* U = p.U8 + (size_t)layer * 16384 * 1024;
  const unsigned char* V = p.V8 + (size_t)layer * 16384 * 1024;
  const float* SU = p.SU + layer * 16384; const float* SV = p.SV + layer * 16384;
  const float* gain = p.norm_ffn + layer * 1024;
  for (int T = bid * 4 + wave; T < 8192; T += nb * 4) {
    const float* sc = p.SC + (size_t)T * 2048;
    for (int hh = 0; hh < 8; hh++) {
      const float* s = sc + hh * 256;
      float a0 = s[lane], a1 = s[lane + 64], b0 = s[128 + lane], b1 = s[192 + lane];
      unsigned ka0 = (fkey(a0) & ~127u) | (unsigned)(127 - lane), ka1 = (fkey(a1) & ~127u) | (unsigned)(63 - lane);
      unsigned kb0 = (fkey(b0) & ~127u) | (unsigned)(127 - lane), kb1 = (fkey(b1) & ~127u) | (unsigned)(63 - lane);
      unsigned pa = 0u, pb = 0u;
      for (int bit = 31; bit >= 0; --bit) {
        unsigned ta = pa | (1u << bit), tb = pb | (1u << bit);
        int ca = __popcll(__ballot(ka0 >= ta)) + __popcll(__ballot(ka1 >= ta));
        int cb = __popcll(__ballot(kb0 >= tb)) + __popcll(__ballot(kb1 >= tb));
        if (ca >= 16) pa = ta;
        if (cb >= 16) pb = tb;
      }
      {
        unsigned long long m0 = __ballot(ka0 >= pa), m1 = __ballot(ka1 >= pa);
        int p0 = mbcnt64(m0), p1 = __popcll(m0) + mbcnt64(m1);
        if (ka0 >= pa) { ws1[p0 & 15] = a0; wi1[p0 & 15] = lane; }
        if (ka1 >= pa) { ws1[p1 & 15] = a1; wi1[p1 & 15] = lane + 64; }
        unsigned long long n0 = __ballot(kb0 >= pb), n1 = __ballot(kb1 >= pb);
        int q0 = mbcnt64(n0), q1 = __popcll(n0) + mbcnt64(n1);
        if (kb0 >= pb) { ws2[q0 & 15] = b0; wi2[q0 & 15] = lane; }
        if (kb1 >= pb) { ws2[q1 & 15] = b1; wi2[q1 & 15] = lane + 64; }
      }
      __builtin_amdgcn_fence(__ATOMIC_ACQ_REL, "wavefront");
      __builtin_amdgcn_wave_barrier();
      int bq = lane & 15, aq = lane >> 4;
      float s2v = ws2[bq];
      float c0 = ws1[aq] + s2v, c1 = ws1[aq + 4] + s2v, c2 = ws1[aq + 8] + s2v, c3 = ws1[aq + 12] + s2v;
      unsigned k0 = (fkey(c0) & ~255u) | (unsigned)(255 - lane), k1 = (fkey(c1) & ~255u) | (unsigned)(191 - lane);
      unsigned k2 = (fkey(c2) & ~255u) | (unsigned)(127 - lane), k3 = (fkey(c3) & ~255u) | (unsigned)(63 - lane);
      unsigned pc = 0u;
      for (int bit = 31; bit >= 0; --bit) {
        unsigned tc = pc | (1u << bit);
        int cc = __popcll(__ballot(k0 >= tc)) + __popcll(__ballot(k1 >= tc)) + __popcll(__ballot(k2 >= tc)) + __popcll(__ballot(k3 >= tc));
        if (cc >= 16) pc = tc;
      }
      {
        unsigned long long m0 = __ballot(k0 >= pc), m1 = __ballot(k1 >= pc), m2 = __ballot(k2 >= pc), m3 = __ballot(k3 >= pc);
        int n0 = __popcll(m0), n1 = n0 + __popcll(m1), n2 = n1 + __popcll(m2);
        int i2b = wi2[bq];
        if (k0 >= pc) { int q = mbcnt64(m0) & 15; es[q] = c0; eidx[hh * 16 + q] = wi1[aq] * 128 + i2b; }
        if (k1 >= pc) { int q = (n0 + mbcnt64(m1)) & 15; es[q] = c1; eidx[hh * 16 + q] = wi1[aq + 4] * 128 + i2b; }
        if (k2 >= pc) { int q = (n1 + mbcnt64(m2)) & 15; es[q] = c2; eidx[hh * 16 + q] = wi1[aq + 8] * 128 + i2b; }
        if (k3 >= pc) { int q = (n2 + mbcnt64(m3)) & 15; es[q] = c3; eidx[hh * 16 + q] = wi1[aq + 12] * 128 + i2b; }
      }
      __builtin_amdgcn_fence(__ATOMIC_ACQ_REL, "wavefront");
      __builtin_amdgcn_wave_barrier();
      float ts = es[lane & 15];
      float mx = row_max16(ts);
      float pe = __expf(ts - mx);
      float sm = row_sum16(pe);
      if (lane < 16) eg[hh * 16 + lane] = pe / sm;
      __builtin_amdgcn_fence(__ATOMIC_ACQ_REL, "wavefront");
      __builtin_amdgcn_wave_barrier();
    }
    int mb = T < 4096 ? 0 : 1 + ((T - 4096) >> 10);
    const float* md = p.MOD + (size_t)(layer * 5 + mb) * 6144;
    float4 xv[4]; float ssx = 0.f;
#pragma unroll
    for (int i = 0; i < 4; i++) { xv[i] = *(const float4*)(p.X + (size_t)T * 1024 + (i * 64 + lane) * 4); ssx += xv[i].x * xv[i].x + xv[i].y * xv[i].y + xv[i].z * xv[i].z + xv[i].w * xv[i].w; }
    ssx = wave_sum(ssx);
    float rstdx = rsqrtf(ssx * (1.f / 1024.f) + 1e-6f);
    float4 hv[4]; float hmax = 0.f;
#pragma unroll
    for (int i = 0; i < 4; i++) {
      int col = (i * 64 + lane) * 4;
      float4 g = *(const float4*)(gain + col), sh = *(const float4*)(md + 3 * 1024 + col), scl = *(const float4*)(md + 4 * 1024 + col);
      hv[i].x = xv[i].x * rstdx * g.x * (1.f + scl.x) + sh.x; hv[i].y = xv[i].y * rstdx * g.y * (1.f + scl.y) + sh.y;
      hv[i].z = xv[i].z * rstdx * g.z * (1.f + scl.z) + sh.z; hv[i].w = xv[i].w * rstdx * g.w * (1.f + scl.w) + sh.w;
      hmax = fmaxf(hmax, fmaxf(fmaxf(fabsf(hv[i].x), fabsf(hv[i].y)), fmaxf(fabsf(hv[i].z), fabsf(hv[i].w))));
    }
    hmax = wave_max_f(hmax);
    float hinv = hmax > 0.f ? 127.f / hmax : 0.f, hscale = hmax * (1.f / 127.f);
    int hq[4];
#pragma unroll
    for (int i = 0; i < 4; i++) {
      unsigned b0 = (unsigned)((int)rintf(hv[i].x * hinv)) & 255u, b1 = (unsigned)((int)rintf(hv[i].y * hinv)) & 255u;
      unsigned b2 = (unsigned)((int)rintf(hv[i].z * hinv)) & 255u, b3 = (unsigned)((int)rintf(hv[i].w * hinv)) & 255u;
      hq[i] = (int)(b0 | (b1 << 8) | (b2 << 16) | (b3 << 24));
    }
    float acc[16];
#pragma unroll
    for (int i = 0; i < 16; i++) acc[i] = 0.f;
    float wsum = 0.f;
    for (int bi = 0; bi < 8; bi++) {
      uint4 uq[16], vq[16];
#pragma unroll
      for (int j = 0; j < 16; j++) {
        int e = __builtin_amdgcn_readfirstlane(eidx[bi * 16 + j]);
        uq[j] = *(const uint4*)(U + (size_t)e * 1024 + lane * 16);
      }
#pragma unroll
      for (int j = 0; j < 16; j++) {
        int e = __builtin_amdgcn_readfirstlane(eidx[bi * 16 + j]);
        vq[j] = *(const uint4*)(V + (size_t)e * 1024 + lane * 16);
      }
      int myE = eidx[bi * 16 + (lane & 15)];
      float mysu = SU[myE], mysv = SV[myE], myg = eg[bi * 16 + (lane & 15)];
      float aval = 0.f;
#pragma unroll
      for (int j = 0; j < 16; j++) {
        int d = __builtin_amdgcn_sdot4(hq[0], (int)uq[j].x, 0, false);
        d = __builtin_amdgcn_sdot4(hq[1], (int)uq[j].y, d, false);
        d = __builtin_amdgcn_sdot4(hq[2], (int)uq[j].z, d, false);
        d = __builtin_amdgcn_sdot4(hq[3], (int)uq[j].w, d, false);
        int D = wave_sum_i(d);
        aval = ((lane & 15) == j) ? (float)D : aval;
      }
      float wv = myg * gelu_tanh(aval * (mysu * hscale)) * mysv;
#pragma unroll
      for (int j = 0; j < 16; j++) {
        float w = rlane(wv, j);
        wsum += w;
        acc[0] += w * ub0(vq[j].x); acc[1] += w * ub1(vq[j].x); acc[2] += w * ub2(vq[j].x); acc[3] += w * ub3(vq[j].x);
        acc[4] += w * ub0(vq[j].y); acc[5] += w * ub1(vq[j].y); acc[6] += w * ub2(vq[j].y); acc[7] += w * ub3(vq[j].y);
        acc[8] += w * ub0(vq[j].z); acc[9] += w * ub1(vq[j].z); acc[10] += w * ub2(vq[j].z); acc[11] += w * ub3(vq[j].z);
        acc[12] += w * ub0(vq[j].w); acc[13] += w * ub1(vq[j].w); acc[14] += w * ub2(vq[j].w); acc[15] += w * ub3(vq[j].w);
      }
    }
    float x2[16]; float ss = 0.f;
#pragma unroll
    for (int i = 0; i < 4; i++) {
      int col = (i * 64 + lane) * 4;
      float4 ga = *(const float4*)(md + 5 * 1024 + col);
      x2[i * 4 + 0] = xv[i].x + ga.x * (acc[i * 4 + 0] - 128.f * wsum); x2[i * 4 + 1] = xv[i].y + ga.y * (acc[i * 4 + 1] - 128.f * wsum);
      x2[i * 4 + 2] = xv[i].z + ga.z * (acc[i * 4 + 2] - 128.f * wsum); x2[i * 4 + 3] = xv[i].w + ga.w * (acc[i * 4 + 3] - 128.f * wsum);
    }
#pragma unroll
    for (int i = 0; i < 16; i++) ss += x2[i] * x2[i];
    ss = wave_sum(ss);
    float rstd = rsqrtf(ss * (1.f / 1024.f) + 1e-6f);
    if (layer == 0) {
      const float* md1 = p.MOD + (size_t)(5 + mb) * 6144;
#pragma unroll
      for (int i = 0; i < 4; i++) {
        int col = (i * 64 + lane) * 4;
        *(float4*)(p.X + (size_t)T * 1024 + col) = make_float4(x2[i * 4], x2[i * 4 + 1], x2[i * 4 + 2], x2[i * 4 + 3]);
        float4 g = *(const float4*)(p.norm_mix + 1024 + col), sh = *(const float4*)(md1 + col), scl = *(const float4*)(md1 + 1024 + col);
        float y0 = x2[i * 4] * rstd * g.x * (1.f + scl.x) + sh.x, y1 = x2[i * 4 + 1] * rstd * g.y * (1.f + scl.y) + sh.y;
        float y2 = x2[i * 4 + 2] * rstd * g.z * (1.f + scl.z) + sh.z, y3 = x2[i * 4 + 3] * rstd * g.w * (1.f + scl.w) + sh.w;
        *(uint2*)(p.H + (size_t)T * 1024 + col) = make_uint2(pack2(y0, y1), pack2(y2, y3));
      }
    } else {
#pragma unroll
      for (int i = 0; i < 4; i++) {
        int col = (i * 64 + lane) * 4;
        float4 g = *(const float4*)(p.norm_final + col);
        *(float4*)(p.out + (size_t)T * 1024 + col) = make_float4(x2[i * 4] * rstd * g.x, x2[i * 4 + 1] * rstd * g.y, x2[i * 4 + 2] * rstd * g.z, x2[i * 4 + 3] * rstd * g.w);
      }
    }
  }
}

#define XB_TMO      128
#define XB_XCNT(j)  (256  + 64 * (j))
#define XB_XSUB(j)  (1280 + 64 * (j))
#define XB_XGEN(j)  (2304 + 64 * (j))
#define XB_TOP      3328
#define XB_TOPGEN   3392
#define XCD_BAR_WORDS 3456
#define XB_SPIN_CAP (1u << 20)
#define LAS __attribute__((address_space(3)))
DEV unsigned xb_ld(unsigned* p)              { return __hip_atomic_load(p, __ATOMIC_RELAXED, __HIP_MEMORY_SCOPE_AGENT); }
DEV unsigned xb_add(unsigned* p, unsigned v) { return __hip_atomic_fetch_add(p, v, __ATOMIC_RELAXED, __HIP_MEMORY_SCOPE_AGENT); }
DEV unsigned xb_xcc_id() { return (unsigned)__builtin_amdgcn_s_getreg((3 << 11) | 20) & 0xFu; }
#define XB_SPIN(cond, bar) do { unsigned _sp = 0; while (cond) { __builtin_amdgcn_s_sleep(1); \
    if ((++_sp & 255u) == 0u) { if (xb_ld(&(bar)[XB_TMO])) break; if (_sp > XB_SPIN_CAP) { atomicAdd(&(bar)[XB_TMO], 1u); break; } } } } while (0)
struct XcdBarrier { unsigned* bar; unsigned x; volatile LAS unsigned* st; };
DEV XcdBarrier xcd_barrier_post(unsigned* bar, volatile LAS unsigned* st) {
  XcdBarrier b; b.bar = bar; b.x = xb_xcc_id(); b.st = st;
  if (threadIdx.x == 0) (void)xb_add(&bar[XB_XCNT(b.x)], 1u);
  return b;
}
DEV void xcd_barrier_complete(unsigned* bar, unsigned x, unsigned& nloc, unsigned& nx) {
  const unsigned G = gridDim.x * gridDim.y * gridDim.z;
  unsigned sum, cnt, mine, sp = 0u;
  for (;;) {
    sum = 0u; cnt = 0u; mine = 0u;
#pragma unroll
    for (unsigned j = 0; j < 16; ++j) { const unsigned c = xb_ld(&bar[XB_XCNT(j)]); sum += c; cnt += (c > 0u) ? 1u : 0u; mine = (j == x) ? c : mine; }
    if (sum == G) break;
    __builtin_amdgcn_s_sleep(1);
    if ((++sp & 255u) == 0u) { if (xb_ld(&bar[XB_TMO])) break; if (sp > XB_SPIN_CAP) { atomicAdd(&bar[XB_TMO], 1u); break; } }
  }
  nloc = mine > 0u ? mine : 1u; nx = cnt > 0u ? cnt : 1u;
}
DEV void xcd_barrier(const XcdBarrier& b) {
  asm volatile("s_waitcnt vmcnt(0)" ::: "memory");
  __syncthreads();
  if (threadIdx.x == 0) {
    unsigned* bar = b.bar;
    __builtin_amdgcn_s_waitcnt(0);
    unsigned nloc = b.st[0], nx = b.st[1];
    if (nloc == 0u) { xcd_barrier_complete(bar, b.x, nloc, nx); b.st[0] = nloc; b.st[1] = nx; }
    const unsigned old = xb_add(&bar[XB_XSUB(b.x)], 1u);
    const unsigned gen = old / nloc;
    if (old + 1u == (gen + 1u) * nloc) {
      __builtin_amdgcn_fence(__ATOMIC_RELEASE, "agent");
      asm volatile("s_waitcnt vmcnt(0)" ::: "memory");
      const unsigned og = xb_add(&bar[XB_TOP], 1u);
      const unsigned tg = og / nx;
      if (og + 1u == (tg + 1u) * nx) xb_add(&bar[XB_TOPGEN], 1u);
      else XB_SPIN(xb_ld(&bar[XB_TOPGEN]) == tg, bar);
      __builtin_amdgcn_fence(__ATOMIC_ACQUIRE, "agent");
      xb_add(&bar[XB_XGEN(b.x)], 1u);
      asm volatile("s_waitcnt vmcnt(0)" ::: "memory");
    } else {
      XB_SPIN(xb_ld(&bar[XB_XGEN(b.x)]) == gen, bar);
      __builtin_amdgcn_fence(__ATOMIC_ACQUIRE, "agent");
      asm volatile("s_waitcnt vmcnt(0)" ::: "memory");
    }
  }
  __syncthreads();
}

constexpr int NPHASE = 16;
DEV void run_phase(const Params& p, int ph, int bid, int nb, char* smem) {
  switch (ph) {
    case 0: phase_prep(p, bid, nb, smem); break;
    case 1: phase_ada(p, 0, p.norm_mix, 0, 1, true, bid, nb); break;
    case 2: gemm_phase(p.H, 1024, p.WT_EVIN, 1024, 1024, 64, 22, bid, nb, smem, [&](int m0, int n0, const float* Cs) { epi_inproj0(p, m0, n0, Cs); }); break;
    case 3: phase_attn0(p, bid, nb, smem); break;
    case 4: gemm_phase(p.MIX, 1024, p.WT_EVOUT, 1024, 1024, 64, 8, bid, nb, smem, [&](int m0, int n0, const float* Cs) { epi_outproj(p, 0, m0, n0, Cs); }); break;
    case 5: phase_ada(p, 0, p.norm_ffn, 3, 4, false, bid, nb); break;
    case 12: phase_ada(p, 1, p.norm_ffn + 1024, 3, 4, false, bid, nb); break;
    case 6: case 13: {
      int layer = ph == 6 ? 0 : 1;
      gemm_phase(p.H, 1024, p.WT_PQ + (size_t)layer * 2048 * 1024, 1024, 1024, 64, 16, bid, nb, smem, [&](int m0, int n0, const float* Cs) {
        int lane = threadIdx.x & 63, wave = threadIdx.x >> 6;
        for (int rr = wave; rr < 128; rr += 4) {
          float2 c = *(const float2*)(Cs + rr * 128 + lane * 2);
          *(unsigned*)(p.PQ + (size_t)(m0 + rr) * 2048 + n0 + lane * 2) = pack2(c.x, c.y);
        }
      });
    } break;
    case 7: case 14: {
      int layer = ph == 7 ? 0 : 1;
      const u16* sk = p.SUBK + (size_t)layer * 16 * 128 * 128;
      for (int it = bid; it < 64 * 16; it += nb) {
        int mt = it >> 4, hc = it & 15;
        f32x16 acc[2][2];
        zero16(acc[0][0]); zero16(acc[0][1]); zero16(acc[1][0]); zero16(acc[1][1]);
        gemm_tile(p.PQ + (size_t)mt * 128 * 2048 + hc * 128, 2048, sk + (size_t)hc * 128 * 128, 128, 128, smem, acc);
        const float* Cs = (const float*)smem;
        int lane = threadIdx.x & 63, wave = threadIdx.x >> 6;
        for (int rr = wave; rr < 128; rr += 4) {
          float2 c = *(const float2*)(Cs + rr * 128 + lane * 2);
          *(float2*)(p.SC + (size_t)(mt * 128 + rr) * 2048 + hc * 128 + lane * 2) = c;
        }
      }
    } break;
    case 8: phase_peer(p, 0, bid, nb, smem); break;
    case 15: phase_peer(p, 1, bid, nb, smem); break;
    case 9: gemm_phase(p.H, 1024, p.WT_ODIN, 1024, 1024, 64, 18, bid, nb, smem, [&](int m0, int n0, const float* Cs) { epi_inproj1(p, m0, n0, Cs); }); break;
    case 10: phase_attn1(p, bid, nb, smem); break;
    case 11: gemm_phase(p.MIX, 1024, p.WT_ODOUT, 1024, 1024, 64, 8, bid, nb, smem, [&](int m0, int n0, const float* Cs) { epi_outproj(p, 1, m0, n0, Cs); }); break;
    default: break;
  }
}

template <int PH> DEV void run_all(const Params& p, cg::grid_group& grid, const XcdBarrier& xb, char* smem) {
  run_phase(p, PH, blockIdx.x, gridDim.x, smem);
  if constexpr (PH + 1 < NPHASE) {
    if constexpr (PH == 0) grid.sync(); else xcd_barrier(xb);
    run_all<PH + 1>(p, grid, xb, smem);
  }
}
__global__ void __launch_bounds__(256, 2) mega_kernel(Params p) {
  __shared__ __attribute__((aligned(16))) char smem[65536];
  __shared__ uint4 xb_words;
  if (threadIdx.x == 0) xb_words = make_uint4(0u, 0u, 0u, 0u);
  __syncthreads();
  XcdBarrier xb = xcd_barrier_post(p.BAR, (volatile LAS unsigned*)&xb_words);
  cg::grid_group grid = cg::this_grid();
  run_all<0>(p, grid, xb, smem);
}
#if MULTI_LAUNCH
template <int PH> __global__ void __launch_bounds__(256, 2) phase_kernel(Params p) {
  __shared__ __attribute__((aligned(16))) char smem[65536];
  run_phase(p, PH, blockIdx.x, gridDim.x, smem);
}
template <int PH> static void launch_all(const Params& p, int grid, hipStream_t s) {
  phase_kernel<PH><<<grid, 256, 0, s>>>(p);
  if constexpr (PH + 1 < NPHASE) launch_all<PH + 1>(p, grid, s);
}
#endif

extern "C" void kernel_launch(void* const* d_in, const int* in_sizes, int n_in, void* d_out, int out_size, void* d_ws, size_t ws_size, hipStream_t stream) {
  Params p{};
  const float* const* in = (const float* const*)d_in;
  p.xp = in[0]; p.xs = in[1]; p.c = in[2]; p.cctx = in[3]; p.cak = in[4]; p.cav = in[5]; p.srf = in[6]; p.srb = in[7];
  p.cck = in[8]; p.ccv = in[9]; p.cdk = in[10]; p.cdv = in[11];
  p.mod_w = in[12]; p.mod_b = in[13]; p.norm_mix = in[14]; p.norm_ffn = in[15]; p.norm_final = in[16];
  p.ev_w_in = in[17]; p.ev_w_out = in[18]; p.a_q_norm = in[19]; p.a_k_norm = in[20]; p.rdf = in[21]; p.rdb = in[22];
  p.od_w_in = in[23]; p.od_w_out = in[24]; p.lq1 = in[25]; p.lk1 = in[26]; p.lq2 = in[27]; p.lk2 = in[28]; p.subln = in[29]; p.dsink = in[30];
  p.peer_wq = in[31]; p.peer_sk = in[32]; p.peer_u = in[33]; p.peer_v = in[34];
  p.out = (float*)d_out;
  char* w = (char*)d_ws; size_t off = 0;
  auto take = [&](size_t bytes) { char* r = w + off; off += (bytes + 255) & ~(size_t)255; return r; };
  p.BAR = (unsigned*)take(XCD_BAR_WORDS * 4);
  p.MOD = (float*)take(61440 * 4);
  p.ROPEC = (float*)take(32768 * 4); p.ROPES = (float*)take(32768 * 4);
  p.X = (float*)take((size_t)8192 * 1024 * 4);
  p.SC = (float*)take((size_t)8192 * 2048 * 4);
  p.WT_EVIN = (u16*)take((size_t)2816 * 1024 * 2); p.WT_EVOUT = (u16*)take((size_t)1024 * 1024 * 2);
  p.WT_ODIN = (u16*)take((size_t)2304 * 1024 * 2); p.WT_ODOUT = (u16*)take((size_t)1024 * 1024 * 2);
  p.WT_PQ = (u16*)take((size_t)2 * 2048 * 1024 * 2); p.SUBK = (u16*)take((size_t)524288 * 2);
  p.U16 = nullptr; p.V16 = nullptr;
  p.U8 = (unsigned char*)take((size_t)2 * 16384 * 1024); p.V8 = (unsigned char*)take((size_t)2 * 16384 * 1024);
  p.SU = (float*)take(32768 * 4); p.SV = (float*)take(32768 * 4);
  p.H = (u16*)take((size_t)8192 * 1024 * 2); p.MIX = (u16*)take((size_t)8192 * 1024 * 2);
  p.Q1 = (u16*)take((size_t)8192 * 512 * 2); p.Q2 = (u16*)take((size_t)8192 * 512 * 2); p.SG = (u16*)take((size_t)8192 * 512 * 2);
  p.KA = (u16*)take((size_t)1179648 * 2); p.VA = (u16*)take((size_t)1179648 * 2);
  p.RK = (u16*)take((size_t)4194304 * 2); p.RV = (u16*)take((size_t)4194304 * 2);
  p.KC = (u16*)take((size_t)4718592 * 2); p.VC = (u16*)take((size_t)4718592 * 2);
  p.KD = (u16*)take((size_t)1179648 * 2); p.VD = (u16*)take((size_t)1179648 * 2);
  p.PQ = (u16*)take((size_t)8192 * 2048 * 2);
  (void)in_sizes; (void)n_in; (void)out_size; (void)ws_size;
#if MULTI_LAUNCH
  launch_all<0>(p, 512, stream);
#else
  static int grid_blocks = 0;
  if (!grid_blocks) {
    int dev = 0, cus = 0, per_cu = 0;
    hipGetDevice(&dev);
    hipDeviceGetAttribute(&cus, hipDeviceAttributeMultiprocessorCount, dev);
    hipOccupancyMaxActiveBlocksPerMultiprocessor(&per_cu, mega_kernel, 256, 0);
    if (per_cu > 2) per_cu = 2;
    if (per_cu < 1) per_cu = 1;
    grid_blocks = cus * per_cu;
  }
  (void)hipMemsetAsync(p.BAR, 0, XCD_BAR_WORDS * 4, stream);
  void* args[] = {&p};
  hipError_t e = hipLaunchCooperativeKernel((void*)mega_kernel, dim3(grid_blocks), dim3(256), args, 0, stream);
  if (e != hipSuccess) fprintf(stderr, "cooperative launch failed: %s (grid %d)\n", hipGetErrorString(e), grid_blocks);
#endif
}
```

```cpp
#include <hip/hip_runtime.h>
#include <hip/hip_cooperative_groups.h>
#include <cstdio>
namespace cg = cooperative_groups;

#ifndef MULTI_LAUNCH
#define MULTI_LAUNCH 0
#endif

typedef unsigned short u16;
typedef __attribute__((ext_vector_type(8))) short bf16x8;
typedef __attribute__((ext_vector_type(16))) float f32x16;
typedef __attribute__((ext_vector_type(4))) unsigned u32x4;

#define DEV __device__ __forceinline__

constexpr size_t OUT_AK = 8388608, OUT_AV = 8912896, OUT_RF = 9437184, OUT_RB = 9961472,
                 OUT_CK = 10485760, OUT_CV = 12582912, OUT_DK = 14680064, OUT_DV = 15204352;
constexpr float LAM_INIT = 0.35550906f;

struct Params {
  const float *xp, *xs, *c, *cctx, *cak, *cav, *srf, *srb, *cck, *ccv, *cdk, *cdv;
  const float *mod_w, *mod_b, *norm_mix, *norm_ffn, *norm_final;
  const float *ev_w_in, *ev_w_out, *a_q_norm, *a_k_norm, *rdf, *rdb;
  const float *od_w_in, *od_w_out, *lq1, *lk1, *lq2, *lk2, *subln, *dsink;
  const float *peer_wq, *peer_sk, *peer_u, *peer_v;
  float* out;
  float *MOD, *ROPEC, *ROPES, *X, *SC;
  u16 *WT_EVIN, *WT_EVOUT, *WT_ODIN, *WT_ODOUT, *WT_PQ, *SUBK, *U16, *V16, *H, *MIX, *Q1, *Q2, *SG;
  u16 *KA, *VA, *RK, *RV, *KC, *VC, *KD, *VD, *PQ;
  unsigned* BAR;
  unsigned char *U8, *V8; float *SU, *SV;
};

DEV u16 f2bf(float f) { unsigned u = __float_as_uint(f); u += 0x7fffu + ((u >> 16) & 1u); return (u16)(u >> 16); }
DEV float bf2f(unsigned b) { return __uint_as_float(b << 16); }
DEV unsigned pack2(float a, float b) { return (unsigned)f2bf(a) | ((unsigned)f2bf(b) << 16); }
DEV float bflo(unsigned w) { return __uint_as_float(w << 16); }
DEV float bfhi(unsigned w) { return __uint_as_float(w & 0xffff0000u); }
DEV float silu_f(float v) { return v / (1.f + __expf(-v)); }
DEV float gelu_tanh(float a) {
  float z = 0.7978845608f * (a + 0.044715f * a * a * a);
  float e = __expf(2.f * z);
  float th = 1.f - 2.f / (e + 1.f);
  return 0.5f * a * (1.f + th);
}
template <int CTRL> DEV float dpp_f(float v) {
  return __int_as_float(__builtin_amdgcn_update_dpp(0, __float_as_int(v), CTRL, 0xF, 0xF, true));
}
template <int CTRL> DEV unsigned dpp_u(unsigned v) {
  return (unsigned)__builtin_amdgcn_update_dpp(0, (int)v, CTRL, 0xF, 0xF, true);
}
DEV float row_sum16(float v) {
  v += dpp_f<0xB1>(v); v += dpp_f<0x4E>(v); v += dpp_f<0x141>(v); v += dpp_f<0x140>(v); return v;
}
DEV float row_max16(float v) {
  v = fmaxf(v, dpp_f<0xB1>(v)); v = fmaxf(v, dpp_f<0x4E>(v)); v = fmaxf(v, dpp_f<0x141>(v)); v = fmaxf(v, dpp_f<0x140>(v)); return v;
}
DEV float rlane(float v, int l) { return __int_as_float(__builtin_amdgcn_readlane(__float_as_int(v), l)); }
DEV float wave_sum(float v) {
  v = row_sum16(v);
  return (rlane(v, 0) + rlane(v, 16)) + (rlane(v, 32) + rlane(v, 48));
}
DEV unsigned wave_max_u(unsigned v) {
  v = max(v, dpp_u<0xB1>(v)); v = max(v, dpp_u<0x4E>(v)); v = max(v, dpp_u<0x141>(v)); v = max(v, dpp_u<0x140>(v));
  unsigned a = (unsigned)__builtin_amdgcn_readlane((int)v, 0), b = (unsigned)__builtin_amdgcn_readlane((int)v, 16);
  unsigned c = (unsigned)__builtin_amdgcn_readlane((int)v, 32), d = (unsigned)__builtin_amdgcn_readlane((int)v, 48);
  return max(max(a, b), max(c, d));
}
DEV float half_sum32(float v) { v = row_sum16(v); return v + __shfl_xor(v, 16); }
DEV unsigned fkey(float f) { unsigned u = __float_as_uint(f); return (u & 0x80000000u) ? ~u : (u | 0x80000000u); }
DEV f32x16 mfma32(bf16x8 a, bf16x8 b, f32x16 c) { return __builtin_amdgcn_mfma_f32_32x32x16_bf16(a, b, c, 0, 0, 0); }
DEV void zero16(f32x16& v) {
#pragma unroll
  for (int i = 0; i < 16; i++) v[i] = 0.f;
}
DEV size_t kvoff(bool smp, int b, int hh, int tpos, int H, int DW, int LS, int off) {
  return smp ? (size_t)4096 * H * DW + ((size_t)(b * H + hh) * LS + off + tpos) * DW
             : ((size_t)(b * H + hh) * 256 + tpos) * DW;
}


DEV float wave_max_f(float v) {
  v = row_max16(v);
  return fmaxf(fmaxf(rlane(v, 0), rlane(v, 16)), fmaxf(rlane(v, 32), rlane(v, 48)));
}
DEV int wave_sum_i(int v) {
  v += (int)dpp_u<0xB1>((unsigned)v); v += (int)dpp_u<0x4E>((unsigned)v); v += (int)dpp_u<0x141>((unsigned)v); v += (int)dpp_u<0x140>((unsigned)v);
  return (__builtin_amdgcn_readlane(v, 0) + __builtin_amdgcn_readlane(v, 16)) + (__builtin_amdgcn_readlane(v, 32) + __builtin_amdgcn_readlane(v, 48));
}
DEV int mbcnt64(unsigned long long m) { return (int)__builtin_amdgcn_mbcnt_hi((unsigned)(m >> 32), __builtin_amdgcn_mbcnt_lo((unsigned)m, 0u)); }
template <bool SGN> DEV void prep_quant(const float* __restrict__ src, unsigned char* __restrict__ dst, float* __restrict__ scale, int row0) {
  int lane = threadIdx.x & 63, wave = threadIdx.x >> 6;
  for (int rr = wave; rr < 16; rr += 4) {
    int row = row0 + rr;
    const float* x = src + (size_t)row * 1024;
    float4 v[4]; float mx = 0.f;
#pragma unroll
    for (int i = 0; i < 4; i++) {
      v[i] = *(const float4*)(x + (i * 64 + lane) * 4);
      mx = fmaxf(mx, fmaxf(fmaxf(fabsf(v[i].x), fabsf(v[i].y)), fmaxf(fabsf(v[i].z), fabsf(v[i].w))));
    }
    mx = wave_max_f(mx);
    float inv = mx > 0.f ? 127.f / mx : 0.f;
    unsigned w[4];
#pragma unroll
    for (int i = 0; i < 4; i++) {
      int off = SGN ? 0 : 128;
      unsigned b0 = (unsigned)((int)rintf(v[i].x * inv) + off) & 255u, b1 = (unsigned)((int)rintf(v[i].y * inv) + off) & 255u;
      unsigned b2 = (unsigned)((int)rintf(v[i].z * inv) + off) & 255u, b3 = (unsigned)((int)rintf(v[i].w * inv) + off) & 255u;
      w[i] = b0 | (b1 << 8) | (b2 << 16) | (b3 << 24);
    }
    *(uint4*)(dst + (size_t)row * 1024 + lane * 16) = make_uint4(w[0], w[1], w[2], w[3]);
    if (lane == 0) scale[row] = mx * (1.f / 127.f);
  }
}

DEV void prep_transpose(const float* __restrict__ W, int N, u16* __restrict__ Wt, int tile, float* sm) {
  int ntn = N >> 6; int kt = tile / ntn, nt = tile % ntn;
  int k0 = kt * 64, n0 = nt * 64; int t = threadIdx.x;
#pragma unroll
  for (int i = 0; i < 4; i++) {
    int k = (t >> 4) + 16 * i; int c4 = (t & 15) * 4;
    float4 v = *(const float4*)(W + (size_t)(k0 + k) * N + n0 + c4);
    sm[k * 65 + c4] = v.x; sm[k * 65 + c4 + 1] = v.y; sm[k * 65 + c4 + 2] = v.z; sm[k * 65 + c4 + 3] = v.w;
  }
  __syncthreads();
  int n = t >> 2, kc = (t & 3) * 16;
  unsigned pk[8];
#pragma unroll
  for (int j = 0; j < 8; j++) pk[j] = pack2(sm[(kc + 2 * j) * 65 + n], sm[(kc + 2 * j + 1) * 65 + n]);
  uint4* dst = (uint4*)(Wt + (size_t)(n0 + n) * 1024 + k0 + kc);
  dst[0] = make_uint4(pk[0], pk[1], pk[2], pk[3]);
  dst[1] = make_uint4(pk[4], pk[5], pk[6], pk[7]);
  __syncthreads();
}
DEV void conv_item(const float* __restrict__ src, u16* __restrict__ dst) {
  int t = threadIdx.x;
#pragma unroll
  for (int i = 0; i < 8; i++) {
    int e = (i * 256 + t) * 8;
    float4 a = *(const float4*)(src + e), b = *(const float4*)(src + e + 4);
    *(uint4*)(dst + e) = make_uint4(pack2(a.x, a.y), pack2(a.z, a.w), pack2(b.x, b.y), pack2(b.z, b.w));
  }
}
DEV void prep_mod(const Params& p, int it, float* sm) {
  int l = it / 96, n0 = (it % 96) * 64; int t = threadIdx.x;
  float* sc = sm;
  for (int i = t; i < 5120; i += 256) {
    int b = i >> 10, k = i & 1023;
    float v = (b == 0) ? p.cctx[k] : p.c[(b - 1) * 1024 + k];
    sc[i] = silu_f(v);
  }
  __syncthreads();
  int col = t & 63, kg = t >> 6;
  float a0 = 0, a1 = 0, a2 = 0, a3 = 0, a4 = 0;
  const float* w = p.mod_w + (size_t)l * 1024 * 6144 + n0 + col;
  for (int k = kg; k < 1024; k += 4) {
    float wv = w[(size_t)k * 6144];
    a0 += sc[k] * wv; a1 += sc[1024 + k] * wv; a2 += sc[2048 + k] * wv; a3 += sc[3072 + k] * wv; a4 += sc[4096 + k] * wv;
  }
  float* red = sm + 5120;
  red[(kg * 5 + 0) * 64 + col] = a0; red[(kg * 5 + 1) * 64 + col] = a1; red[(kg * 5 + 2) * 64 + col] = a2;
  red[(kg * 5 + 3) * 64 + col] = a3; red[(kg * 5 + 4) * 64 + col] = a4;
  __syncthreads();
  if (t < 64) {
#pragma unroll
    for (int b = 0; b < 5; b++) {
      float s = red[(0 * 5 + b) * 64 + t] + red[(1 * 5 + b) * 64 + t] + red[(2 * 5 + b) * 64 + t] + red[(3 * 5 + b) * 64 + t];
      p.MOD[(size_t)(l * 5 + b) * 6144 + n0 + t] = s + p.mod_b[l * 6144 + n0 + t];
    }
  }
  __syncthreads();
}
DEV void prep_cache(const Params& p, int it) {
  const float* src; u16* dst;
  if (it < 8)       { int ch = it;      src = p.cak + (size_t)ch * 16384; dst = p.KA + (size_t)4096 * 2 * 64 + (size_t)ch * 1280 * 64; }
  else if (it < 16) { int ch = it - 8;  src = p.cav + (size_t)ch * 16384; dst = p.VA + (size_t)4096 * 2 * 64 + (size_t)ch * 1280 * 64; }
  else if (it < 48) { int ch = it - 16; src = p.cck + (size_t)ch * 16384; dst = p.KC + (size_t)4096 * 8 * 64 + (size_t)ch * 1280 * 64; }
  else if (it < 80) { int ch = (it - 48) >> 1, hf = (it - 48) & 1;
                      src = p.ccv + (size_t)ch * 32768 + hf * 16384; dst = p.VC + (size_t)4096 * 4 * 128 + (size_t)ch * 1280 * 128 + hf * 16384; }
  else if (it < 88) { int ch = it - 80; src = p.cdk + (size_t)ch * 16384; dst = p.KD + (size_t)4096 * 2 * 64 + (size_t)ch * 1280 * 64; }
  else              { int ch = it - 88; src = p.cdv + (size_t)ch * 16384; dst = p.VD + (size_t)4096 * 2 * 64 + (size_t)ch * 1280 * 64; }
  conv_item(src, dst);
}
DEV void prep_rope(const Params& p, int it) {
  for (int i = 0; i < 16; i++) {
    int idx = it * 4096 + i * 256 + threadIdx.x;
    int tpos = idx >> 5, a = idx & 31;
    float pos = (a < 16) ? (float)(tpos >> 6) : (float)(tpos & 63);
    float inv = exp2f(-(float)(a & 15) * (13.287712379549449f / 16.f));
    float ang = pos * inv;
    p.ROPEC[idx] = __cosf(ang); p.ROPES[idx] = __sinf(ang);
  }
}
constexpr int PREP_T0 = 704, PREP_T1 = PREP_T0 + 256, PREP_T2 = PREP_T1 + 576, PREP_T3 = PREP_T2 + 256, PREP_T4 = PREP_T3 + 1024;
constexpr int PREP_U = PREP_T4 + 2048, PREP_V = PREP_U + 2048, PREP_SK = PREP_V + 32, PREP_CA = PREP_SK + 96, PREP_RO = PREP_CA + 8, PREP_MOD = PREP_RO + 192;
DEV void phase_prep(const Params& p, int bid, int nb, char* smem) {
  float* sm = (float*)smem;
  for (int it0 = bid; it0 < PREP_MOD; it0 += nb) {
    int it = (it0 < 192) ? (PREP_RO + it0) : (it0 - 192);
    if (it < PREP_T0) prep_transpose(p.ev_w_in, 2816, p.WT_EVIN, it, sm);
    else if (it < PREP_T1) prep_transpose(p.ev_w_out, 1024, p.WT_EVOUT, it - PREP_T0, sm);
    else if (it < PREP_T2) prep_transpose(p.od_w_in, 2304, p.WT_ODIN, it - PREP_T1, sm);
    else if (it < PREP_T3) prep_transpose(p.od_w_out, 1024, p.WT_ODOUT, it - PREP_T2, sm);
    else if (it < PREP_T4) { int j = it - PREP_T3; int l = j >> 9; prep_transpose(p.peer_wq + (size_t)l * 1024 * 2048, 2048, p.WT_PQ + (size_t)l * 2048 * 1024, j & 511, sm); }
    else if (it < PREP_U) prep_quant<true>(p.peer_u, p.U8, p.SU, (it - PREP_T4) * 16);
    else if (it < PREP_V) prep_quant<false>(p.peer_v, p.V8, p.SV, (it - PREP_U) * 16);
    else if (it < PREP_SK) { size_t o = (size_t)(it - PREP_V) * 16384; conv_item(p.peer_sk + o, p.SUBK + o); }
    else if (it < PREP_CA) prep_cache(p, it - PREP_SK);
    else if (it < PREP_RO) prep_rope(p, it - PREP_CA);
    else prep_mod(p, it - PREP_RO, sm);
  }
}

DEV void phase_ada(const Params& p, int layer, const float* __restrict__ gain, int shift_i, int scale_i, bool from_input, int bid, int nb) {
  int wave = threadIdx.x >> 6, lane = threadIdx.x & 63;
  for (int T = bid * 4 + wave; T < 8192; T += nb * 4) {
    const float* xr = from_input ? (T < 4096 ? p.xp + (size_t)T * 1024 : p.xs + (size_t)(T - 4096) * 1024) : p.X + (size_t)T * 1024;
    int mb = T < 4096 ? 0 : 1 + ((T - 4096) >> 10);
    const float* md = p.MOD + (size_t)(layer * 5 + mb) * 6144;
    float4 v[4]; float ss = 0;
#pragma unroll
    for (int i = 0; i < 4; i++) { v[i] = *(const float4*)(xr + (i * 64 + lane) * 4); ss += v[i].x * v[i].x + v[i].y * v[i].y + v[i].z * v[i].z + v[i].w * v[i].w; }
    ss = wave_sum(ss);
    float rstd = rsqrtf(ss * (1.f / 1024.f) + 1e-6f);
#pragma unroll
    for (int i = 0; i < 4; i++) {
      int col = (i * 64 + lane) * 4;
      float4 g = *(const float4*)(gain + col), sh = *(const float4*)(md + shift_i * 1024 + col), sc = *(const float4*)(md + scale_i * 1024 + col);
      float y0 = v[i].x * rstd * g.x * (1.f + sc.x) + sh.x, y1 = v[i].y * rstd * g.y * (1.f + sc.y) + sh.y;
      float y2 = v[i].z * rstd * g.z * (1.f + sc.z) + sh.z, y3 = v[i].w * rstd * g.w * (1.f + sc.w) + sh.w;
      *(uint2*)(p.H + (size_t)T * 1024 + col) = make_uint2(pack2(y0, y1), pack2(y2, y3));
    }
  }
}

#define GLOAD8(PA, PB) \
  ra0 = *(const u32x4*)(PA); ra1 = *(const u32x4*)((PA) + sa32); ra2 = *(const u32x4*)((PA) + 2 * sa32); ra3 = *(const u32x4*)((PA) + 3 * sa32); \
  rb0 = *(const u32x4*)(PB); rb1 = *(const u32x4*)((PB) + sb32); rb2 = *(const u32x4*)((PB) + 2 * sb32); rb3 = *(const u32x4*)((PB) + 3 * sb32);
#define GLOAD8N(PA, PB) \
  na0 = *(const u32x4*)(PA); na1 = *(const u32x4*)((PA) + sa32); na2 = *(const u32x4*)((PA) + 2 * sa32); na3 = *(const u32x4*)((PA) + 3 * sa32); \
  nb0 = *(const u32x4*)(PB); nb1 = *(const u32x4*)((PB) + sb32); nb2 = *(const u32x4*)((PB) + 2 * sb32); nb3 = *(const u32x4*)((PB) + 3 * sb32);
#define GSTORE8(BUF) { u16* wa_ = (u16*)(smem + (BUF) * 36864) + lrow * 72 + lkc; u16* wb_ = wa_ + 128 * 72; \
  *(u32x4*)(wa_) = ra0; *(u32x4*)(wa_ + 32 * 72) = ra1; *(u32x4*)(wa_ + 64 * 72) = ra2; *(u32x4*)(wa_ + 96 * 72) = ra3; \
  *(u32x4*)(wb_) = rb0; *(u32x4*)(wb_ + 32 * 72) = rb1; *(u32x4*)(wb_ + 64 * 72) = rb2; *(u32x4*)(wb_ + 96 * 72) = rb3; }
DEV void gemm_tile(const u16* __restrict__ A, int lda, const u16* __restrict__ B, int ldb, int K, char* smem, f32x16 (&acc)[2][2]) {
  int t = threadIdx.x, lane = t & 63, wave = t >> 6, r = lane & 31, h = lane >> 5;
  int wm = wave >> 1, wn = wave & 1;
  int lrow = t >> 3, lkc = (t & 7) * 8;
  const u16* ap = A + (size_t)lrow * lda + lkc;
  const u16* bp = B + (size_t)lrow * ldb + lkc;
  size_t sa32 = (size_t)32 * lda, sb32 = (size_t)32 * ldb;
  u32x4 ra0, ra1, ra2, ra3, rb0, rb1, rb2, rb3;
  u32x4 na0, na1, na2, na3, nb0, nb1, nb2, nb3;
  int nk = K >> 6;
  GLOAD8(ap, bp)
  __syncthreads();
  GSTORE8(0)
  if (nk > 1) { GLOAD8(ap + 64, bp + 64) }
  na0 = ra0; na1 = ra1; na2 = ra2; na3 = ra3; nb0 = rb0; nb1 = rb1; nb2 = rb2; nb3 = rb3;
  __syncthreads();
  for (int kt = 0; kt < nk; kt++) {
    if (kt + 2 < nk) { GLOAD8N(ap + (kt + 2) * 64, bp + (kt + 2) * 64) }
    const u16* sA = (const u16*)(smem + (kt & 1) * 36864); const u16* sB = sA + 128 * 72;
#pragma unroll
    for (int kk = 0; kk < 4; kk++) {
      bf16x8 a0 = *(const bf16x8*)(sA + (wm * 64 + r) * 72 + kk * 16 + h * 8);
      bf16x8 a1 = *(const bf16x8*)(sA + (wm * 64 + 32 + r) * 72 + kk * 16 + h * 8);
      bf16x8 b0 = *(const bf16x8*)(sB + (wn * 64 + r) * 72 + kk * 16 + h * 8);
      bf16x8 b1 = *(const bf16x8*)(sB + (wn * 64 + 32 + r) * 72 + kk * 16 + h * 8);
      acc[0][0] = mfma32(a0, b0, acc[0][0]); acc[0][1] = mfma32(a0, b1, acc[0][1]);
      acc[1][0] = mfma32(a1, b0, acc[1][0]); acc[1][1] = mfma32(a1, b1, acc[1][1]);
    }
    if (kt + 1 < nk) { GSTORE8((kt + 1) & 1) }
    __syncthreads();
    ra0 = na0; ra1 = na1; ra2 = na2; ra3 = na3; rb0 = nb0; rb1 = nb1; rb2 = nb2; rb3 = nb3;
  }
  __syncthreads();
  float* Cs = (float*)smem;
#pragma unroll
  for (int i = 0; i < 2; i++)
#pragma unroll
    for (int j = 0; j < 2; j++)
#pragma unroll
      for (int g = 0; g < 16; g++)
        Cs[(wm * 64 + i * 32 + (g & 3) + 8 * (g >> 2) + 4 * h) * 128 + wn * 64 + j * 32 + r] = acc[i][j][g];
  __syncthreads();
}

template <class Epi>
DEV void gemm_phase(const u16* A, int lda, const u16* Bt, int ldb, int K, int MT, int NTl, int bid, int nb, char* smem, Epi epi) {
  for (int it = bid; it < MT * NTl; it += nb) {
    int mt = it / NTl, nt = it % NTl;
    f32x16 acc[2][2];
    zero16(acc[0][0]); zero16(acc[0][1]); zero16(acc[1][0]); zero16(acc[1][1]);
    gemm_tile(A + (size_t)mt * 128 * lda, lda, Bt + (size_t)nt * 128 * ldb, ldb, K, smem, acc);
    epi(mt * 128, nt * 128, (const float*)smem);
  }
}

DEV void tok_decode(int T, bool& smp, int& b, int& tpos) {
  smp = T >= 4096;
  if (!smp) { b = T >> 8; tpos = T & 255; } else { b = (T - 4096) >> 10; tpos = (T - 4096) & 1023; }
}
DEV void rope_pair(const Params& p, float& x, float& y, int tpos, int d) {
  float px = __shfl_xor(x, 16), py = __shfl_xor(y, 16);
  int a = d & 31;
  float c0 = p.ROPEC[tpos * 32 + a], c1 = p.ROPEC[tpos * 32 + a + 1];
  float s0 = p.ROPES[tpos * 32 + a], s1 = p.ROPES[tpos * 32 + a + 1];
  if (d < 32) { x = x * c0 - px * s0; y = y * c1 - py * s1; }
  else        { x = px * s0 + x * c0; y = py * s1 + y * c1; }
}

DEV void epi_inproj0(const Params& p, int m0, int n0, const float* Cs) {
  int lane = threadIdx.x & 63, wave = threadIdx.x >> 6;
  for (int rr = wave; rr < 128; rr += 4) {
    int T = m0 + rr; bool smp; int b, tpos; tok_decode(T, smp, b, tpos);
    float2 c = *(const float2*)(Cs + rr * 128 + lane * 2);
    int col = n0 + lane * 2; int d = col & 63;
    if (n0 < 640) {
      float ss = half_sum32(c.x * c.x + c.y * c.y);
      float rstd = rsqrtf(ss * (1.f / 64.f) + 1e-6f);
      const float* g = (n0 < 512) ? p.a_q_norm : p.a_k_norm;
      c.x *= rstd * g[d]; c.y *= rstd * g[d + 1];
      if (smp) rope_pair(p, c.x, c.y, tpos, d);
      if (n0 < 512) {
        *(unsigned*)(p.Q1 + (size_t)T * 512 + col) = pack2(c.x * 0.125f, c.y * 0.125f);
      } else {
        int hh = (col - 512) >> 6;
        *(unsigned*)(p.KA + kvoff(smp, b, hh, tpos, 2, 64, 1280, 256) + d) = pack2(c.x, c.y);
        if (!smp) *(float2*)(p.out + OUT_AK + ((size_t)(b * 2 + hh) * 256 + tpos) * 64 + d) = c;
      }
    } else if (n0 < 768) {
      int hh = (col - 640) >> 6;
      *(unsigned*)(p.VA + kvoff(smp, b, hh, tpos, 2, 64, 1280, 256) + d) = pack2(c.x, c.y);
      if (!smp) *(float2*)(p.out + OUT_AV + ((size_t)(b * 2 + hh) * 256 + tpos) * 64 + d) = c;
    } else if (n0 < 1280) {
      *(unsigned*)(p.Q2 + (size_t)T * 512 + (col - 768)) = pack2(c.x, c.y);
    } else if (n0 < 1792) {
      int hh = (col - 1280) >> 6;
      *(unsigned*)(p.RK + kvoff(smp, b, hh, tpos, 8, 64, 1024, 0) + d) = pack2(c.x * 0.125f, c.y * 0.125f);
    } else if (n0 < 2304) {
      int hh = (col - 1792) >> 6;
      *(unsigned*)(p.RV + kvoff(smp, b, hh, tpos, 8, 64, 1024, 0) + d) = pack2(c.x, c.y);
    } else {
      *(unsigned*)(p.SG + (size_t)T * 512 + (col - 2304)) = pack2(silu_f(c.x), silu_f(c.y));
    }
  }
}
DEV void epi_inproj1(const Params& p, int m0, int n0, const float* Cs) {
  int lane = threadIdx.x & 63, wave = threadIdx.x >> 6;
  for (int rr = wave; rr < 128; rr += 4) {
    int T = m0 + rr; bool smp; int b, tpos; tok_decode(T, smp, b, tpos);
    float2 c = *(const float2*)(Cs + rr * 128 + lane * 2);
    int col = n0 + lane * 2; int d = col & 63;
    if (n0 < 512) {
      if (smp) rope_pair(p, c.x, c.y, tpos, d);
      *(unsigned*)(p.Q1 + (size_t)T * 512 + col) = pack2(c.x * 0.125f, c.y * 0.125f);
    } else if (n0 < 1024) {
      int mp = (col - 512) >> 6;
      if (!smp) *(float2*)(p.out + OUT_CK + ((size_t)(b * 8 + mp) * 256 + tpos) * 64 + d) = c;
      if (smp) rope_pair(p, c.x, c.y, tpos, d);
      *(unsigned*)(p.KC + kvoff(smp, b, mp, tpos, 8, 64, 1280, 256) + d) = pack2(c.x, c.y);
    } else if (n0 < 1536) {
      int hh = (col - 1024) >> 7; int dd = (col - 1024) & 127;
      if (!smp) *(float2*)(p.out + OUT_CV + ((size_t)(b * 4 + hh) * 256 + tpos) * 128 + dd) = c;
      *(unsigned*)(p.VC + kvoff(smp, b, hh, tpos, 4, 128, 1280, 256) + dd) = pack2(c.x, c.y);
    } else if (n0 < 2048) {
      if (smp) rope_pair(p, c.x, c.y, tpos, d);
      *(unsigned*)(p.Q2 + (size_t)T * 512 + (col - 1536)) = pack2(c.x * 0.125f, c.y * 0.125f);
    } else if (n0 < 2176) {
      int hh = (col - 2048) >> 6;
      if (!smp) *(float2*)(p.out + OUT_DK + ((size_t)(b * 2 + hh) * 256 + tpos) * 64 + d) = c;
      if (smp) rope_pair(p, c.x, c.y, tpos, d);
      *(unsigned*)(p.KD + kvoff(smp, b, hh, tpos, 2, 64, 1280, 256) + d) = pack2(c.x, c.y);
    } else {
      int hh = (col - 2176) >> 6;
      if (!smp) *(float2*)(p.out + OUT_DV + ((size_t)(b * 2 + hh) * 256 + tpos) * 64 + d) = c;
      *(unsigned*)(p.VD + kvoff(smp, b, hh, tpos, 2, 64, 1280, 256) + d) = pack2(c.x, c.y);
    }
  }
}
DEV void epi_outproj(const Params& p, int layer, int m0, int n0, const float* Cs) {
  int lane = threadIdx.x & 63, wave = threadIdx.x >> 6;
  for (int rr = wave; rr < 128; rr += 4) {
    int T = m0 + rr;
    int mb = T < 4096 ? 0 : 1 + ((T - 4096) >> 10);
    const float* xr = (layer == 0) ? (T < 4096 ? p.xp + (size_t)T * 1024 : p.xs + (size_t)(T - 4096) * 1024) : p.X + (size_t)T * 1024;
    float2 c = *(const float2*)(Cs + rr * 128 + lane * 2);
    int col = n0 + lane * 2;
    float2 x = *(const float2*)(xr + col);
    float2 g = *(const float2*)(p.MOD + (size_t)(layer * 5 + mb) * 6144 + 2048 + col);
    x.x += g.x * c.x; x.y += g.y * c.y;
    *(float2*)(p.X + (size_t)T * 1024 + col) = x;
  }
}

constexpr int ATT_BUF = 37888;
struct TileRegs { u32x4 k0, k1, k2, k3, v0, v1, v2, v3; };
template <int DV, bool TWOK> DEV TileRegs tile_load(const u16* __restrict__ k, const u16* __restrict__ k2, const u16* __restrict__ v) {
  int t = threadIdx.x, lane = t & 63, wave = t >> 6;
  TileRegs R;
  u32x4 z = {0u, 0u, 0u, 0u};
  R.k0 = *(const u32x4*)(k + t * 8); R.k1 = *(const u32x4*)(k + (t + 256) * 8);
  if (TWOK) { R.k2 = *(const u32x4*)(k2 + t * 8); R.k3 = *(const u32x4*)(k2 + (t + 256) * 8); } else { R.k2 = z; R.k3 = z; }
  R.v0 = *(const u32x4*)(v + (size_t)lane * DV + wave * 8); R.v1 = *(const u32x4*)(v + (size_t)lane * DV + (wave + 4) * 8);
  if (DV == 128) { R.v2 = *(const u32x4*)(v + (size_t)lane * DV + (wave + 8) * 8); R.v3 = *(const u32x4*)(v + (size_t)lane * DV + (wave + 12) * 8); } else { R.v2 = z; R.v3 = z; }
  return R;
}
DEV void store8t(u16* d, u32x4 x) {
  d[0 * 76] = (u16)(x[0] & 0xffff); d[1 * 76] = (u16)(x[0] >> 16);
  d[2 * 76] = (u16)(x[1] & 0xffff); d[3 * 76] = (u16)(x[1] >> 16);
  d[4 * 76] = (u16)(x[2] & 0xffff); d[5 * 76] = (u16)(x[2] >> 16);
  d[6 * 76] = (u16)(x[3] & 0xffff); d[7 * 76] = (u16)(x[3] >> 16);
}
template <int DV, bool TWOK> DEV void tile_store(const TileRegs R, char* buf) {
  int t = threadIdx.x, lane = t & 63, wave = t >> 6;
  u16* sK = (u16*)buf; u16* sK2 = sK + 64 * 72; u16* sVT = sK + 2 * 64 * 72;
  int key = t >> 3, dc = t & 7;
  *(u32x4*)(sK + key * 72 + dc * 8) = R.k0; *(u32x4*)(sK + (key + 32) * 72 + dc * 8) = R.k1;
  if (TWOK) { *(u32x4*)(sK2 + key * 72 + dc * 8) = R.k2; *(u32x4*)(sK2 + (key + 32) * 72 + dc * 8) = R.k3; }
  store8t(sVT + (wave * 8) * 76 + lane, R.v0); store8t(sVT + ((wave + 4) * 8) * 76 + lane, R.v1);
  if (DV == 128) { store8t(sVT + ((wave + 8) * 8) * 76 + lane, R.v2); store8t(sVT + ((wave + 12) * 8) * 76 + lane, R.v3); }
}
DEV void load_ident_k(u16* sK) {
  int t = threadIdx.x;
#pragma unroll
  for (int i = 0; i < 2; i++) {
    int c = t + 256 * i; int key = c >> 3, dc = c & 7;
    unsigned w[4] = {0u, 0u, 0u, 0u};
    uint4 z = make_uint4(0u, 0u, 0u, 0u);
    if (dc == (key >> 3)) {
      int e = key & 7; unsigned one = (e & 1) ? 0x3F800000u : 0x00003F80u;
      if ((e >> 1) == 0) z.x = one; else if ((e >> 1) == 1) z.y = one; else if ((e >> 1) == 2) z.z = one; else z.w = one;
    }
    (void)w;
    *(uint4*)(sK + key * 72 + dc * 8) = z;
  }
}
DEV void load_state_v(const float* __restrict__ S0, u16* sVT) {
  int lane = threadIdx.x & 63, wave = threadIdx.x >> 6;
#pragma unroll
  for (int i = 0; i < 2; i++) {
    int dc = wave + 4 * i;
    float4 a = *(const float4*)(S0 + lane * 64 + dc * 8), b = *(const float4*)(S0 + lane * 64 + dc * 8 + 4);
    u16* d = sVT + (dc * 8) * 76 + lane;
    d[0 * 76] = f2bf(a.x); d[1 * 76] = f2bf(a.y); d[2 * 76] = f2bf(a.z); d[3 * 76] = f2bf(a.w);
    d[4 * 76] = f2bf(b.x); d[5 * 76] = f2bf(b.y); d[6 * 76] = f2bf(b.z); d[7 * 76] = f2bf(b.w);
  }
}
template <int DV, class F>
DEV void attn_compute(const bf16x8 (&qf)[4], f32x16 (&o)[DV / 32], const u16* sK, const u16* sVT, F&& xform) {
  int lane = threadIdx.x & 63, r = lane & 31, h = lane >> 5;
  f32x16 st[2]; zero16(st[0]); zero16(st[1]);
#pragma unroll
  for (int sub = 0; sub < 2; sub++)
#pragma unroll
    for (int kk = 0; kk < 4; kk++) {
      bf16x8 kf = *(const bf16x8*)(sK + (sub * 32 + r) * 72 + kk * 16 + h * 8);
      st[sub] = mfma32(kf, qf[kk], st[sub]);
    }
  xform(st);
  bf16x8 pf[2][2];
#pragma unroll
  for (int sub = 0; sub < 2; sub++)
#pragma unroll
    for (int s = 0; s < 2; s++) {
      u32x4 w;
      w[0] = pack2(st[sub][8 * s + 0], st[sub][8 * s + 1]); w[1] = pack2(st[sub][8 * s + 2], st[sub][8 * s + 3]);
      w[2] = pack2(st[sub][8 * s + 4], st[sub][8 * s + 5]); w[3] = pack2(st[sub][8 * s + 6], st[sub][8 * s + 7]);
      pf[sub][s] = __builtin_bit_cast(bf16x8, w);
    }
#pragma unroll
  for (int ds = 0; ds < DV / 32; ds++)
#pragma unroll
    for (int sub = 0; sub < 2; sub++)
#pragma unroll
      for (int s = 0; s < 2; s++) {
        const u16* vp = sVT + (ds * 32 + r) * 76 + sub * 32 + s * 16 + 4 * h;
        uint2 lo = *(const uint2*)vp, hi = *(const uint2*)(vp + 8);
        u32x4 w; w[0] = lo.x; w[1] = lo.y; w[2] = hi.x; w[3] = hi.y;
        o[ds] = mfma32(__builtin_bit_cast(bf16x8, w), pf[sub][s], o[ds]);
      }
}
template <int DV, class F>
DEV void attn_compute_sub(const bf16x8 (&qf)[4], f32x16 (&o)[DV / 32], const u16* sK, const u16* sVT, F&& xform) {
  int lane = threadIdx.x & 63, r = lane & 31, h = lane >> 5;
#pragma unroll
  for (int sub = 0; sub < 2; sub++) {
    f32x16 st; zero16(st);
#pragma unroll
    for (int kk = 0; kk < 4; kk++) {
      bf16x8 kf = *(const bf16x8*)(sK + (sub * 32 + r) * 72 + kk * 16 + h * 8);
      st = mfma32(kf, qf[kk], st);
    }
    xform(sub, st);
    bf16x8 pf[2];
#pragma unroll
    for (int s2 = 0; s2 < 2; s2++) {
      u32x4 w;
      w[0] = pack2(st[8 * s2 + 0], st[8 * s2 + 1]); w[1] = pack2(st[8 * s2 + 2], st[8 * s2 + 3]);
      w[2] = pack2(st[8 * s2 + 4], st[8 * s2 + 5]); w[3] = pack2(st[8 * s2 + 6], st[8 * s2 + 7]);
      pf[s2] = __builtin_bit_cast(bf16x8, w);
    }
#pragma unroll
    for (int ds = 0; ds < DV / 32; ds++)
#pragma unroll
      for (int s2 = 0; s2 < 2; s2++) {
        const u16* vp = sVT + (ds * 32 + r) * 76 + sub * 32 + s2 * 16 + 4 * h;
        uint2 lo = *(const uint2*)vp, hi = *(const uint2*)(vp + 8);
        u32x4 w; w[0] = lo.x; w[1] = lo.y; w[2] = hi.x; w[3] = hi.y;
        o[ds] = mfma32(__builtin_bit_cast(bf16x8, w), pf[s2], o[ds]);
      }
  }
}
template <int DV>
DEV void softmax_xform1(f32x16& st, f32x16 (&o)[DV / 32], float& m, float& l) {
  float mx = -1e30f;
#pragma unroll
  for (int g = 0; g < 16; g++) mx = fmaxf(mx, st[g]);
  mx = fmaxf(mx, __shfl_xor(mx, 32));
  float mnew = fmaxf(m, mx);
  float alpha = __expf(m - mnew);
  m = mnew;
  float ls = 0.f;
#pragma unroll
  for (int g = 0; g < 16; g++) { float pv = __expf(st[g] - mnew); st[g] = pv; ls += pv; }
  l = l * alpha + ls;
#pragma unroll
  for (int ds = 0; ds < DV / 32; ds++)
#pragma unroll
    for (int g = 0; g < 16; g++) o[ds][g] *= alpha;
}
template <int DV, bool TWOK, class PF, class XF, class XF1>
DEV void attn_loop(int n, PF&& ptrs, const bf16x8 (&qf)[4], f32x16 (&o)[DV / 32], char* smem, XF&& xf, XF1&& xf1) {
  int wave = threadIdx.x >> 6;
  int kofs = (TWOK && wave >= 2) ? 64 * 72 : 0;
  TileRegs R, Rn;
  const u16 *kp, *kp2, *vp;
  ptrs(0, kp, kp2, vp); R = tile_load<DV, TWOK>(kp, kp2, vp);
  __syncthreads();
  tile_store<DV, TWOK>(R, smem);
  if (n > 1) { ptrs(1, kp, kp2, vp); R = tile_load<DV, TWOK>(kp, kp2, vp); }
  Rn = R;
  __syncthreads();
  constexpr bool DEEP = (DV == 64);
  for (int ti = 0; ti < n; ti++) {
    if (DEEP) { if (ti + 2 < n) { ptrs(ti + 2, kp, kp2, vp); Rn = tile_load<DV, TWOK>(kp, kp2, vp); } }
    char* buf = smem + (ti & 1) * ATT_BUF;
    if constexpr (DV == 128) attn_compute_sub<DV>(qf, o, (const u16*)buf + kofs, (const u16*)buf + 2 * 64 * 72, [&](int sub, f32x16& st) { xf1(ti, sub, st); });
    else attn_compute<DV>(qf, o, (const u16*)buf + kofs, (const u16*)buf + 2 * 64 * 72, [&](f32x16 (&st)[2]) { xf(ti, st); });
    if (ti + 1 < n) tile_store<DV, TWOK>(R, smem + ((ti + 1) & 1) * ATT_BUF);
    if (DEEP) { __syncthreads(); R = Rn; }
    else { if (ti + 2 < n) { ptrs(ti + 2, kp, kp2, vp); R = tile_load<DV, TWOK>(kp, kp2, vp); } __syncthreads(); }
  }
}
template <int DV>
DEV void softmax_xform(f32x16 (&st)[2], f32x16 (&o)[DV / 32], float& m, float& l, bool masked, int kpos0, int qpos) {
  int h = (threadIdx.x & 63) >> 5;
  float mx = -1e30f;
#pragma unroll
  for (int sub = 0; sub < 2; sub++)
#pragma unroll
    for (int g = 0; g < 16; g++) {
      float s = st[sub][g];
      if (masked) {
        int j = kpos0 + sub * 32 + (g & 3) + 8 * (g >> 2) + 4 * h;
        int dl = qpos - j; if (dl < 0) dl = -dl;
        if (dl > 128) s = -1e30f;
        st[sub][g] = s;
      }
      mx = fmaxf(mx, s);
    }
  mx = fmaxf(mx, __shfl_xor(mx, 32));
  float mnew = fmaxf(m, mx);
  float alpha = __expf(m - mnew);
  m = mnew;
  float ls = 0.f;
#pragma unroll
  for (int sub = 0; sub < 2; sub++)
#pragma unroll
    for (int g = 0; g < 16; g++) { float pv = __expf(st[sub][g] - mnew); st[sub][g] = pv; ls += pv; }
  l = l * alpha + ls;
#pragma unroll
  for (int ds = 0; ds < DV / 32; ds++)
#pragma unroll
    for (int g = 0; g < 16; g++) o[ds][g] *= alpha;
}

template <int DV, bool TWOK>
DEV void attn_softmax_job(const Params& p, const u16* Q, int Tq0, int qcol, const u16* kb, const u16* kb2, const u16* vb,
                          int nplain, int band_lo, int band_hi, int qpos0, bool use_sink, float sinkv,
                          f32x16 (&o)[DV / 32], char* smem) {
  int lane = threadIdx.x & 63, wave = threadIdx.x >> 6, r = lane & 31, h = lane >> 5;
  int qrow = TWOK ? (wave & 1) * 32 : wave * 32;
  bf16x8 qf[4];
#pragma unroll
  for (int kk = 0; kk < 4; kk++) qf[kk] = *(const bf16x8*)(Q + (size_t)(Tq0 + qrow + r) * 512 + qcol + kk * 16 + h * 8);
#pragma unroll
  for (int ds = 0; ds < DV / 32; ds++) zero16(o[ds]);
  float m = use_sink ? sinkv : -1e30f;
  float l = (use_sink && h == 0) ? 1.f : 0.f;
  int qpos = qpos0 + qrow + r;
  int ntot = nplain + (band_hi - band_lo);
  attn_loop<DV, TWOK>(ntot,
    [&](int ti, const u16*& kp, const u16*& kp2, const u16*& vp) {
      int key0 = (ti >= nplain) ? (256 + (band_lo + ti - nplain) * 64) : ti * 64;
      kp = kb + (size_t)key0 * 64; kp2 = kb2 + (size_t)key0 * 64; vp = vb + (size_t)key0 * DV;
    }, qf, o, smem,
    [&](int ti, f32x16 (&st)[2]) {
      bool masked = ti >= nplain;
      int kpos0 = (band_lo + ti - nplain) * 64;
      softmax_xform<DV>(st, o, m, l, masked, kpos0, qpos);
    },
    [&](int ti, int sub, f32x16& st) { softmax_xform1<DV>(st, o, m, l); });
  float lt = l + __shfl_xor(l, 32);
  float inv = 1.f / lt;
#pragma unroll
  for (int ds = 0; ds < DV / 32; ds++)
#pragma unroll
    for (int g = 0; g < 16; g++) o[ds][g] *= inv;
}
DEV void store_o64(const Params& p, const f32x16 (&o)[2], int Tq0, int mixcol) {
  int lane = threadIdx.x & 63, wave = threadIdx.x >> 6, r = lane & 31, h = lane >> 5;
  int T = Tq0 + wave * 32 + r;
#pragma unroll
  for (int ds = 0; ds < 2; ds++)
#pragma unroll
    for (int g4 = 0; g4 < 4; g4++) {
      int d0 = ds * 32 + 8 * g4 + 4 * h;
      *(uint2*)(p.MIX + (size_t)T * 1024 + mixcol + d0) =
          make_uint2(pack2(o[ds][4 * g4], o[ds][4 * g4 + 1]), pack2(o[ds][4 * g4 + 2], o[ds][4 * g4 + 3]));
    }
}

DEV void ret_job(const Params& p, bool smp, int b, int hh, int qb, char* smem) {
  u16* sK = (u16*)smem; u16* sVT = sK + 2 * 64 * 72;
  int lane = threadIdx.x & 63, wave = threadIdx.x >> 6, r = lane & 31, h = lane >> 5;
  int L = smp ? 1024 : 256;
  int Tq0 = (smp ? 4096 + b * 1024 : b * 256) + qb * 128;
  const u16* kb = p.RK + kvoff(smp, b, hh, 0, 8, 64, 1024, 0);
  const u16* vb = p.RV + kvoff(smp, b, hh, 0, 8, 64, 1024, 0);
  float xf = p.rdf[hh], xb = p.rdb[hh];
  float lf2 = -log1pf(__expf(-xf)) * 1.4426950408889634f;
  float lb2 = -log1pf(__expf(-xb)) * 1.4426950408889634f;
  bf16x8 qf[4];
#pragma unroll
  for (int kk = 0; kk < 4; kk++) qf[kk] = *(const bf16x8*)(p.Q2 + (size_t)(Tq0 + wave * 32 + r) * 512 + hh * 64 + kk * 16 + h * 8);
  f32x16 o[2]; zero16(o[0]); zero16(o[1]);
  int qpos = qb * 128 + wave * 32 + r;
  int nt = L / 64;
  attn_loop<64, false>(nt,
    [&](int ti, const u16*& kp, const u16*& kp2, const u16*& vp) { kp = kb + (size_t)ti * 4096; kp2 = kp; vp = vb + (size_t)ti * 4096; },
    qf, o, smem,
    [&](int ti, f32x16 (&st)[2]) {
      int kpos0 = ti * 64;
#pragma unroll
      for (int sub = 0; sub < 2; sub++)
#pragma unroll
        for (int g = 0; g < 16; g++) {
          int j = kpos0 + sub * 32 + (g & 3) + 8 * (g >> 2) + 4 * h;
          int dl = qpos - j;
          float e = dl >= 0 ? lf2 * (float)dl : lb2 * (float)(-dl);
          st[sub][g] *= exp2f(e);
        }
    },
    [&](int ti, int sub, f32x16& st) {});
  if (smp) {
    for (int dir = 0; dir < 2; dir++) {
      const float* S0 = (dir == 0 ? p.srf : p.srb) + (size_t)(b * 8 + hh) * 4096;
      float rs = dir == 0 ? exp2f(lf2 * (float)(qpos + 1)) : exp2f(lb2 * (float)(L - qpos));
      __syncthreads();
      load_ident_k(sK);
      load_state_v(S0, sVT);
      __syncthreads();
      attn_compute<64>(qf, o, sK, sVT, [&](f32x16 (&st)[2]) {
#pragma unroll
        for (int sub = 0; sub < 2; sub++)
#pragma unroll
          for (int g = 0; g < 16; g++) st[sub][g] *= rs;
      });
    }
  }
  float sum = 0.f;
#pragma unroll
  for (int ds = 0; ds < 2; ds++)
#pragma unroll
    for (int g = 0; g < 16; g++) sum += o[ds][g];
  sum += __shfl_xor(sum, 32);
  float mean = sum * (1.f / 64.f);
  float vs = 0.f;
#pragma unroll
  for (int ds = 0; ds < 2; ds++)
#pragma unroll
    for (int g = 0; g < 16; g++) { float dlt = o[ds][g] - mean; vs += dlt * dlt; }
  vs += __shfl_xor(vs, 32);
  float rstd = rsqrtf(vs * (1.f / 64.f) + 1e-6f);
  int T = Tq0 + wave * 32 + r;
#pragma unroll
  for (int ds = 0; ds < 2; ds++)
#pragma unroll
    for (int g4 = 0; g4 < 4; g4++) {
      int d0 = ds * 32 + 8 * g4 + 4 * h;
      uint2 gt = *(const uint2*)(p.SG + (size_t)T * 512 + hh * 64 + d0);
      float y0 = (o[ds][4 * g4] - mean) * rstd * bflo(gt.x), y1 = (o[ds][4 * g4 + 1] - mean) * rstd * bfhi(gt.x);
      float y2 = (o[ds][4 * g4 + 2] - mean) * rstd * bflo(gt.y), y3 = (o[ds][4 * g4 + 3] - mean) * rstd * bfhi(gt.y);
      *(uint2*)(p.MIX + (size_t)T * 1024 + 512 + hh * 64 + d0) = make_uint2(pack2(y0, y1), pack2(y2, y3));
    }
}
DEV void ret_state_job(const Params& p, int b, int hh, int dir, char* smem) {
  u16* sKk = (u16*)smem; u16* sVv = sKk + 64 * 64;
  int t = threadIdx.x;
  const u16* kb = p.RK + kvoff(false, b, hh, 0, 8, 64, 1024, 0);
  const u16* vb = p.RV + kvoff(false, b, hh, 0, 8, 64, 1024, 0);
  float xx = dir == 0 ? p.rdf[hh] : p.rdb[hh];
  float lg2 = -log1pf(__expf(-xx)) * 1.4426950408889634f;
  int dk = t >> 2, dvc = (t & 3) * 16;
  float acc[16];
#pragma unroll
  for (int i = 0; i < 16; i++) acc[i] = 0.f;
  for (int ch = 0; ch < 4; ch++) {
    __syncthreads();
#pragma unroll
    for (int i = 0; i < 2; i++) {
      int c = t + 256 * i;
      *(uint4*)(sKk + c * 8) = *(const uint4*)(kb + (size_t)ch * 4096 + c * 8);
      *(uint4*)(sVv + c * 8) = *(const uint4*)(vb + (size_t)ch * 4096 + c * 8);
    }
    __syncthreads();
    for (int jj = 0; jj < 64; jj++) {
      int j = ch * 64 + jj;
      float w = exp2f(lg2 * (float)(dir == 0 ? 255 - j : j));
      float kv = bf2f(sKk[jj * 64 + dk]) * w;
      const uint4* vp = (const uint4*)(sVv + jj * 64 + dvc);
      uint4 v0 = vp[0], v1 = vp[1];
      acc[0] += kv * bflo(v0.x); acc[1] += kv * bfhi(v0.x); acc[2] += kv * bflo(v0.y); acc[3] += kv * bfhi(v0.y);
      acc[4] += kv * bflo(v0.z); acc[5] += kv * bfhi(v0.z); acc[6] += kv * bflo(v0.w); acc[7] += kv * bfhi(v0.w);
      acc[8] += kv * bflo(v1.x); acc[9] += kv * bfhi(v1.x); acc[10] += kv * bflo(v1.y); acc[11] += kv * bfhi(v1.y);
      acc[12] += kv * bflo(v1.z); acc[13] += kv * bfhi(v1.z); acc[14] += kv * bflo(v1.w); acc[15] += kv * bfhi(v1.w);
    }
  }
  float* dst = p.out + (dir == 0 ? OUT_RF : OUT_RB) + ((size_t)(b * 8 + hh) * 64 + dk) * 64 + dvc;
#pragma unroll
  for (int i = 0; i < 4; i++) *(float4*)(dst + 4 * i) = make_float4(acc[4 * i], acc[4 * i + 1], acc[4 * i + 2], acc[4 * i + 3]);
}

DEV void phase_attn0(const Params& p, int bid, int nb, char* smem) {
  for (int it = bid; it < 1280; it += nb) {
    if (it < 256) {
      int b = it >> 6, hq = (it >> 3) & 7, qb = it & 7; int kvh = hq >> 2;
      f32x16 o[2];
      int Tq0 = 4096 + b * 1024 + qb * 128;
      attn_softmax_job<64, false>(p, p.Q1, Tq0, hq * 64, p.KA + kvoff(true, b, kvh, -256, 2, 64, 1280, 256), p.KA, p.VA + kvoff(true, b, kvh, -256, 2, 64, 1280, 256),
                           20, 0, 0, qb * 128, false, 0.f, o, smem);
      store_o64(p, o, Tq0, hq * 64);
    } else if (it < 512) {
      int j = it - 256; int b = j >> 6, hh = (j >> 3) & 7, qb = j & 7;
      ret_job(p, true, b, hh, qb, smem);
    } else if (it < 768) {
      int j = it - 512; int b = j >> 4, hq = (j >> 1) & 7, qb = j & 1; int kvh = hq >> 2;
      f32x16 o[2];
      int Tq0 = b * 256 + qb * 128;
      attn_softmax_job<64, false>(p, p.Q1, Tq0, hq * 64, p.KA + kvoff(false, b, kvh, 0, 2, 64, 1280, 256), p.KA, p.VA + kvoff(false, b, kvh, 0, 2, 64, 1280, 256),
                           4, 0, 0, qb * 128, false, 0.f, o, smem);
      store_o64(p, o, Tq0, hq * 64);
    } else if (it < 1024) {
      int j = it - 768; int b = j >> 4, hh = (j >> 1) & 7, qb = j & 1;
      ret_job(p, false, b, hh, qb, smem);
    } else {
      int j = it - 1024; int b = j >> 4, hh = (j >> 1) & 7, dir = j & 1;
      ret_state_job(p, b, hh, dir, smem);
    }
  }
}
DEV void diff_job(const Params& p, bool smp, int b, int hh, int qb, float lam, char* smem) {
  int lane = threadIdx.x & 63, wave = threadIdx.x >> 6, r = lane & 31, h = lane >> 5;
  int c = wave >> 1;
  int Tq0 = (smp ? 4096 + b * 1024 : b * 256) + qb * 64;
  int nt = smp ? 20 : 4;
  const u16* vb = p.VC + kvoff(smp, b, hh, smp ? -256 : 0, 4, 128, 1280, 256);
  const u16* kb0 = p.KC + kvoff(smp, b, 2 * hh, smp ? -256 : 0, 8, 64, 1280, 256);
  const u16* kb1 = p.KC + kvoff(smp, b, 2 * hh + 1, smp ? -256 : 0, 8, 64, 1280, 256);
  f32x16 o[4];
  attn_softmax_job<128, true>(p, p.Q1, Tq0, (2 * hh + c) * 64, kb0, kb1, vb, nt, 0, 0, 0, false, 0.f, o, smem);
  float* ex = (float*)smem;
  if (wave >= 2) {
#pragma unroll
    for (int ds = 0; ds < 4; ds++)
#pragma unroll
      for (int g = 0; g < 16; g++) ex[(ds * 16 + g) * 128 + (threadIdx.x - 128)] = o[ds][g];
  }
  __syncthreads();
  if (wave < 2) {
    float ss = 0.f;
#pragma unroll
    for (int ds = 0; ds < 4; ds++)
#pragma unroll
      for (int g = 0; g < 16; g++) { float dv = o[ds][g] - lam * ex[(ds * 16 + g) * 128 + threadIdx.x]; o[ds][g] = dv; ss += dv * dv; }
    ss += __shfl_xor(ss, 32);
    float rstd = rsqrtf(ss * (1.f / 128.f) + 1e-6f) * (1.f - LAM_INIT);
    int T = Tq0 + wave * 32 + r;
#pragma unroll
    for (int ds = 0; ds < 4; ds++)
#pragma unroll
      for (int g4 = 0; g4 < 4; g4++) {
        int d0 = ds * 32 + 8 * g4 + 4 * h;
        float4 sg = *(const float4*)(p.subln + d0);
        *(uint2*)(p.MIX + (size_t)T * 1024 + hh * 128 + d0) =
            make_uint2(pack2(o[ds][4 * g4] * rstd * sg.x, o[ds][4 * g4 + 1] * rstd * sg.y),
                       pack2(o[ds][4 * g4 + 2] * rstd * sg.z, o[ds][4 * g4 + 3] * rstd * sg.w));
      }
  }
}
DEV void phase_attn1(const Params& p, int bid, int nb, char* smem) {
  float d1 = 0.f, d2 = 0.f;
  for (int i = 0; i < 64; i++) { d1 += p.lq1[i] * p.lk1[i]; d2 += p.lq2[i] * p.lk2[i]; }
  float lam = __expf(d1) - __expf(d2) + LAM_INIT;
  for (int it = bid; it < 1024; it += nb) {
    if (it < 256) {
      int b = it >> 6, hh = (it >> 4) & 3, qb = it & 15;
      diff_job(p, true, b, hh, qb, lam, smem);
    } else if (it < 512) {
      int j = it - 256; int b = j >> 6, hq = (j >> 3) & 7, qb = j & 7; int kvh = hq >> 2;
      int q0 = qb * 128;
      int lo = (q0 - 128 < 0 ? 0 : q0 - 128) >> 6, hi = (q0 + 256 > 1024 ? 1024 : q0 + 256) >> 6;
      f32x16 o[2];
      int Tq0 = 4096 + b * 1024 + q0;
      attn_softmax_job<64, false>(p, p.Q2, Tq0, hq * 64, p.KD + kvoff(true, b, kvh, -256, 2, 64, 1280, 256), p.KD, p.VD + kvoff(true, b, kvh, -256, 2, 64, 1280, 256),
                           4, lo, hi, q0, true, p.dsink[hq], o, smem);
      store_o64(p, o, Tq0, 512 + hq * 64);
    } else if (it < 768) {
      int j = it - 512; int b = j >> 4, hh = (j >> 2) & 3, qb = j & 3;
      diff_job(p, false, b, hh, qb, lam, smem);
    } else {
      int j = it - 768; int b = j >> 4, hq = (j >> 1) & 7, qb = j & 1; int kvh = hq >> 2;
      f32x16 o[2];
      int Tq0 = b * 256 + qb * 128;
      attn_softmax_job<64, false>(p, p.Q2, Tq0, hq * 64, p.KD + kvoff(false, b, kvh, 0, 2, 64, 1280, 256), p.KD, p.VD + kvoff(false, b, kvh, 0, 2, 64, 1280, 256),
                           4, 0, 0, qb * 128, true, p.dsink[hq], o, smem);
      store_o64(p, o, Tq0, 512 + hq * 64);
    }
  }
}

DEV float ub0(unsigned w) { return (float)(w & 255u); }
DEV float ub1(unsigned w) { return (float)((w >> 8) & 255u); }
DEV float ub2(unsigned w) { return (float)((w >> 16) & 255u); }
DEV float ub3(unsigned w) { return (float)(w >> 24); }
DEV void phase_peer(const Params& p, int layer, int bid, int nb, char* smem) {
  int wave = threadIdx.x >> 6, lane = threadIdx.x & 63;
  float* ws1 = (float*)(smem + wave * 2048); float* ws2 = ws1 + 16;
  int* wi1 = (int*)(ws2 + 16); int* wi2 = wi1 + 16; float* es = (float*)(wi2 + 16); int* eidx = (int*)(es + 16); float* eg = (float*)(eidx + 128);
  const unsigned char* U = p.U8 + (size_t)layer * 16384 * 1024;
  const unsigned char* V = p.V8 + (size_t)layer * 16384 * 1024;
  const float* SU = p.SU + layer * 16384; const float* SV = p.SV + layer * 16384;
  const float* gain = p.norm_ffn + layer * 1024;
  for (int T = bid * 4 + wave; T < 8192; T += nb * 4) {
    const float* sc = p.SC + (size_t)T * 2048;
    for (int hh = 0; hh < 8; hh++) {
      const float* s = sc + hh * 256;
      float a0 = s[lane], a1 = s[lane + 64], b0 = s[128 + lane], b1 = s[192 + lane];
      unsigned ka0 = (fkey(a0) & ~127u) | (unsigned)(127 - lane), ka1 = (fkey(a1) & ~127u) | (unsigned)(63 - lane);
      unsigned kb0 = (fkey(b0) & ~127u) | (unsigned)(127 - lane), kb1 = (fkey(b1) & ~127u) | (unsigned)(63 - lane);
      unsigned pa = 0u, pb = 0u;
      for (int bit = 31; bit >= 0; --bit) {
        unsigned ta = pa | (1u << bit), tb = pb | (1u << bit);
        int ca = __popcll(__ballot(ka0 >= ta)) + __popcll(__ballot(ka1 >= ta));
        int cb = __popcll(__ballot(kb0 >= tb)) + __popcll(__ballot(kb1 >= tb));
        if (ca >= 16) pa = ta;
        if (cb >= 16) pb = tb;
      }
      {
        unsigned long long m0 = __ballot(ka0 >= pa), m1 = __ballot(ka1 >= pa);
        int p0 = mbcnt64(m0), p1 = __popcll(m0) + mbcnt64(m1);
        if (ka0 >= pa) { ws1[p0 & 15] = a0; wi1[p0 & 15] = lane; }
        if (ka1 >= pa) { ws1[p1 & 15] = a1; wi1[p1 & 15] = lane + 64; }
        unsigned long long n0 = __ballot(kb0 >= pb), n1 = __ballot(kb1 >= pb);
        int q0 = mbcnt64(n0), q1 = __popcll(n0) + mbcnt64(n1);
        if (kb0 >= pb) { ws2[q0 & 15] = b0; wi2[q0 & 15] = lane; }
        if (kb1 >= pb) { ws2[q1 & 15] = b1; wi2[q1 & 15] = lane + 64; }
      }
      __builtin_amdgcn_fence(__ATOMIC_ACQ_REL, "wavefront");
      __builtin_amdgcn_wave_barrier();
      int bq = lane & 15, aq = lane >> 4;
      float s2v = ws2[bq];
      float c0 = ws1[aq] + s2v, c1 = ws1[aq + 4] + s2v, c2 = ws1[aq + 8] + s2v, c3 = ws1[aq + 12] + s2v;
      unsigned k0 = (fkey(c0) & ~255u) | (unsigned)(255 - lane), k1 = (fkey(c1) & ~255u) | (unsigned)(191 - lane);
      unsigned k2 = (fkey(c2) & ~255u) | (unsigned)(127 - lane), k3 = (fkey(c3) & ~255u) | (unsigned)(63 - lane);
      unsigned pc = 0u;
      for (int bit = 31; bit >= 0; --bit) {
        unsigned tc = pc | (1u << bit);
        int cc = __popcll(__ballot(k0 >= tc)) + __popcll(__ballot(k1 >= tc)) + __popcll(__ballot(k2 >= tc)) + __popcll(__ballot(k3 >= tc));
        if (cc >= 16) pc = tc;
      }
      {
        unsigned long long m0 = __ballot(k0 >= pc), m1 = __ballot(k1 >= pc), m2 = __ballot(k2 >= pc), m3 = __ballot(k3 >= pc);
        int n0 = __popcll(m0), n1 = n0 + __popcll(m1), n2 = n1 + __popcll(m2);
        int i2b = wi2[bq];
        if (k0 >= pc) { int q = mbcnt64(m0) & 15; es[q] = c0; eidx[hh * 16 + q] = wi1[aq] * 128 + i2b; }
        if (k1 >= pc) { int q = (n0 + mbcnt64(m1)) & 15; es[q] = c1; eidx[hh * 16 + q] = wi1[aq + 4] * 128 + i2b; }
        if (k2 >= pc) { int q = (n1 + mbcnt64(m2)) & 15; es[q] = c2; eidx[hh * 16 + q] = wi1[aq + 8] * 128 + i2b; }
        if (k3 >= pc) { int q = (n2 + mbcnt64(m3)) & 15; es[q] = c3; eidx[hh * 16 + q] = wi1[aq + 12] * 128 + i2b; }
      }
      __builtin_amdgcn_fence(__ATOMIC_ACQ_REL, "wavefront");
      __builtin_amdgcn_wave_barrier();
      float ts = es[lane & 15];
      float mx = row_max16(ts);
      float pe = __expf(ts - mx);
      float sm = row_sum16(pe);
      if (lane < 16) eg[hh * 16 + lane] = pe / sm;
      __builtin_amdgcn_fence(__ATOMIC_ACQ_REL, "wavefront");
      __builtin_amdgcn_wave_barrier();
    }
    int mb = T < 4096 ? 0 : 1 + ((T - 4096) >> 10);
    const float* md = p.MOD + (size_t)(layer * 5 + mb) * 6144;
    float4 xv[4]; float ssx = 0.f;
#pragma unroll
    for (int i = 0; i < 4; i++) { xv[i] = *(const float4*)(p.X + (size_t)T * 1024 + (i * 64 + lane) * 4); ssx += xv[i].x * xv[i].x + xv[i].y * xv[i].y + xv[i].z * xv[i].z + xv[i].w * xv[i].w; }
    ssx = wave_sum(ssx);
    float rstdx = rsqrtf(ssx * (1.f / 1024.f) + 1e-6f);
    float4 hv[4]; float hmax = 0.f;
#pragma unroll
    for (int i = 0; i < 4; i++) {
      int col = (i * 64 + lane) * 4;
      float4 g = *(const float4*)(gain + col), sh = *(const float4*)(md + 3 * 1024 + col), scl = *(const float4*)(md + 4 * 1024 + col);
      hv[i].x = xv[i].x * rstdx * g.x * (1.f + scl.x) + sh.x; hv[i].y = xv[i].y * rstdx * g.y * (1.f + scl.y) + sh.y;
      hv[i].z = xv[i].z * rstdx * g.z * (1.f + scl.z) + sh.z; hv[i].w = xv[i].w * rstdx * g.w * (1.f + scl.w) + sh.w;
      hmax = fmaxf(hmax, fmaxf(fmaxf(fabsf(hv[i].x), fabsf(hv[i].y)), fmaxf(fabsf(hv[i].z), fabsf(hv[i].w))));
    }
    hmax = wave_max_f(hmax);
    float hinv = hmax > 0.f ? 127.f / hmax : 0.f, hscale = hmax * (1.f / 127.f);
    int hq[4];
#pragma unroll
    for (int i = 0; i < 4; i++) {
      unsigned b0 = (unsigned)((int)rintf(hv[i].x * hinv)) & 255u, b1 = (unsigned)((int)rintf(hv[i].y * hinv)) & 255u;
      unsigned b2 = (unsigned)((int)rintf(hv[i].z * hinv)) & 255u, b3 = (unsigned)((int)rintf(hv[i].w * hinv)) & 255u;
      hq[i] = (int)(b0 | (b1 << 8) | (b2 << 16) | (b3 << 24));
    }
    float acc[16];
#pragma unroll
    for (int i = 0; i < 16; i++) acc[i] = 0.f;
    float wsum = 0.f;
    for (int bi = 0; bi < 8; bi++) {
      uint4 uq[16], vq[16];
#pragma unroll
      for (int j = 0; j < 16; j++) {
        int e = __builtin_amdgcn_readfirstlane(eidx[bi * 16 + j]);
        uq[j] = *(const uint4*)(U + (size_t)e * 1024 + lane * 16);
      }
#pragma unroll
      for (int j = 0; j < 16; j++) {
        int e = __builtin_amdgcn_readfirstlane(eidx[bi * 16 + j]);
        vq[j] = *(const uint4*)(V + (size_t)e * 1024 + lane * 16);
      }
      int myE = eidx[bi * 16 + (lane & 15)];
      float mysu = SU[myE], mysv = SV[myE], myg = eg[bi * 16 + (lane & 15)];
      float aval = 0.f;
#pragma unroll
      for (int j = 0; j < 16; j++) {
        int d = __builtin_amdgcn_sdot4(hq[0], (int)uq[j].x, 0, false);
        d = __builtin_amdgcn_sdot4(hq[1], (int)uq[j].y, d, false);
        d = __builtin_amdgcn_sdot4(hq[2], (int)uq[j].z, d, false);
        d = __builtin_amdgcn_sdot4(hq[3], (int)uq[j].w, d, false);
        int D = wave_sum_i(d);
        aval = ((lane & 15) == j) ? (float)D : aval;
      }
      float wv = myg * gelu_tanh(aval * (mysu * hscale)) * mysv;
#pragma unroll
      for (int j = 0; j < 16; j++) {
        float w = rlane(wv, j);
        wsum += w;
        acc[0] += w * ub0(vq[j].x); acc[1] += w * ub1(vq[j].x); acc[2] += w * ub2(vq[j].x); acc[3] += w * ub3(vq[j].x);
        acc[4] += w * ub0(vq[j].y); acc[5] += w * ub1(vq[j].y); acc[6] += w * ub2(vq[j].y); acc[7] += w * ub3(vq[j].y);
        acc[8] += w * ub0(vq[j].z); acc[9] += w * ub1(vq[j].z); acc[10] += w * ub2(vq[j].z); acc[11] += w * ub3(vq[j].z);
        acc[12] += w * ub0(vq[j].w); acc[13] += w * ub1(vq[j].w); acc[14] += w * ub2(vq[j].w); acc[15] += w * ub3(vq[j].w);
      }
    }
    float x2[16]; float ss = 0.f;
#pragma unroll
    for (int i = 0; i < 4; i++) {
      int col = (i * 64 + lane) * 4;
      float4 ga = *(const float4*)(md + 5 * 1024 + col);
      x2[i * 4 + 0] = xv[i].x + ga.x * (acc[i * 4 + 0] - 128.f * wsum); x2[i * 4 + 1] = xv[i].y + ga.y * (acc[i * 4 + 1] - 128.f * wsum);
      x2[i * 4 + 2] = xv[i].z + ga.z * (acc[i * 4 + 2] - 128.f * wsum); x2[i * 4 + 3] = xv[i].w + ga.w * (acc[i * 4 + 3] - 128.f * wsum);
    }
#pragma unroll
    for (int i = 0; i < 16; i++) ss += x2[i] * x2[i];
    ss = wave_sum(ss);
    float rstd = rsqrtf(ss * (1.f / 1024.f) + 1e-6f);
    if (layer == 0) {
      const float* md1 = p.MOD + (size_t)(5 + mb) * 6144;
#pragma unroll
      for (int i = 0; i < 4; i++) {
        int col = (i * 64 + lane) * 4;
        *(float4*)(p.X + (size_t)T * 1024 + col) = make_float4(x2[i * 4], x2[i * 4 + 1], x2[i * 4 + 2], x2[i * 4 + 3]);
        float4 g = *(const float4*)(p.norm_mix + 1024 + col), sh = *(const float4*)(md1 + col), scl = *(const float4*)(md1 + 1024 + col);
        float y0 = x2[i * 4] * rstd * g.x * (1.f + scl.x) + sh.x, y1 = x2[i * 4 + 1] * rstd * g.y * (1.f + scl.y) + sh.y;
        float y2 = x2[i * 4 + 2] * rstd * g.z * (1.f + scl.z) + sh.z, y3 = x2[i * 4 + 3] * rstd * g.w * (1.f + scl.w) + sh.w;
        *(uint2*)(p.H + (size_t)T * 1024 + col) = make_uint2(pack2(y0, y1), pack2(y2, y3));
      }
    } else {
#pragma unroll
      for (int i = 0; i < 4; i++) {
        int col = (i * 64 + lane) * 4;
        float4 g = *(const float4*)(p.norm_final + col);
        *(float4*)(p.out + (size_t)T * 1024 + col) = make_float4(x2[i * 4] * rstd * g.x, x2[i * 4 + 1] * rstd * g.y, x2[i * 4 + 2] * rstd * g.z, x2[i * 4 + 3] * rstd * g.w);
      }
    }
  }
}

#define XB_TMO      128
#define XB_XCNT(j)  (256  + 64 * (j))
#define XB_XSUB(j)  (1280 + 64 * (j))
#define XB_XGEN(j)  (2304 + 64 * (j))
#define XB_TOP      3328
#define XB_TOPGEN   3392
#define XCD_BAR_WORDS 3456
#define XB_SPIN_CAP (1u << 20)
#define LAS __attribute__((address_space(3)))
DEV unsigned xb_ld(unsigned* p)              { return __hip_atomic_load(p, __ATOMIC_RELAXED, __HIP_MEMORY_SCOPE_AGENT); }
DEV unsigned xb_add(unsigned* p, unsigned v) { return __hip_atomic_fetch_add(p, v, __ATOMIC_RELAXED, __HIP_MEMORY_SCOPE_AGENT); }
DEV unsigned xb_xcc_id() { return (unsigned)__builtin_amdgcn_s_getreg((3 << 11) | 20) & 0xFu; }
#define XB_SPIN(cond, bar) do { unsigned _sp = 0; while (cond) { __builtin_amdgcn_s_sleep(1); \
    if ((++_sp & 255u) == 0u) { if (xb_ld(&(bar)[XB_TMO])) break; if (_sp > XB_SPIN_CAP) { atomicAdd(&(bar)[XB_TMO], 1u); break; } } } } while (0)
struct XcdBarrier { unsigned* bar; unsigned x; volatile LAS unsigned* st; };
DEV XcdBarrier xcd_barrier_post(unsigned* bar, volatile LAS unsigned* st) {
  XcdBarrier b; b.bar = bar; b.x = xb_xcc_id(); b.st = st;
  if (threadIdx.x == 0) (void)xb_add(&bar[XB_XCNT(b.x)], 1u);
  return b;
}
DEV void xcd_barrier_complete(unsigned* bar, unsigned x, unsigned& nloc, unsigned& nx) {
  const unsigned G = gridDim.x * gridDim.y * gridDim.z;
  unsigned sum, cnt, mine, sp = 0u;
  for (;;) {
    sum = 0u; cnt = 0u; mine = 0u;
#pragma unroll
    for (unsigned j = 0; j < 16; ++j) { const unsigned c = xb_ld(&bar[XB_XCNT(j)]); sum += c; cnt += (c > 0u) ? 1u : 0u; mine = (j == x) ? c : mine; }
    if (sum == G) break;
    __builtin_amdgcn_s_sleep(1);
    if ((++sp & 255u) == 0u) { if (xb_ld(&bar[XB_TMO])) break; if (sp > XB_SPIN_CAP) { atomicAdd(&bar[XB_TMO], 1u); break; } }
  }
  nloc = mine > 0u ? mine : 1u; nx = cnt > 0u ? cnt : 1u;
}
DEV void xcd_barrier(const XcdBarrier& b) {
  asm volatile("s_waitcnt vmcnt(0)" ::: "memory");
  __syncthreads();
  if (threadIdx.x == 0) {
    unsigned* bar = b.bar;
    __builtin_amdgcn_s_waitcnt(0);
    unsigned nloc = b.st[0], nx = b.st[1];
    if (nloc == 0u) { xcd_barrier_complete(bar, b.x, nloc, nx); b.st[0] = nloc; b.st[1] = nx; }
    const unsigned old = xb_add(&bar[XB_XSUB(b.x)], 1u);
    const unsigned gen = old / nloc;
    if (old + 1u == (gen + 1u) * nloc) {
      __builtin_amdgcn_fence(__ATOMIC_RELEASE, "agent");
      asm volatile("s_waitcnt vmcnt(0)" ::: "memory");
      const unsigned og = xb_add(&bar[XB_TOP], 1u);
      const unsigned tg = og / nx;
      if (og + 1u == (tg + 1u) * nx) xb_add(&bar[XB_TOPGEN], 1u);
      else XB_SPIN(xb_ld(&bar[XB_TOPGEN]) == tg, bar);
      __builtin_amdgcn_fence(__ATOMIC_ACQUIRE, "agent");
      xb_add(&bar[XB_XGEN(b.x)], 1u);
      asm volatile("s_waitcnt vmcnt(0)" ::: "memory");
    } else {
      XB_SPIN(xb_ld(&bar[XB_XGEN(b.x)]) == gen, bar);
      __builtin_amdgcn_fence(__ATOMIC_ACQUIRE, "agent");
      asm volatile("s_waitcnt vmcnt(0)" ::: "memory");
    }
  }
  __syncthreads();
}

constexpr int NPHASE = 16;
DEV void run_phase(const Params& p, int ph, int bid, int nb, char* smem) {
  switch (ph) {
    case 0: phase_prep(p, bid, nb, smem); break;
    case 1: phase_ada(p, 0, p.norm_mix, 0, 1, true, bid, nb); break;
    case 2: gemm_phase(p.H, 1024, p.WT_EVIN, 1024, 1024, 64, 22, bid, nb, smem, [&](int m0, int n0, const float* Cs) { epi_inproj0(p, m0, n0, Cs); }); break;
    case 3: phase_attn0(p, bid, nb, smem); break;
    case 4: gemm_phase(p.MIX, 1024, p.WT_EVOUT, 1024, 1024, 64, 8, bid, nb, smem, [&](int m0, int n0, const float* Cs) { epi_outproj(p, 0, m0, n0, Cs); }); break;
    case 5: phase_ada(p, 0, p.norm_ffn, 3, 4, false, bid, nb); break;
    case 12: phase_ada(p, 1, p.norm_ffn + 1024, 3, 4, false, bid, nb); break;
    case 6: case 13: {
      int layer = ph == 6 ? 0 : 1;
      gemm_phase(p.H, 1024, p.WT_PQ + (size_t)layer * 2048 * 1024, 1024, 1024, 64, 16, bid, nb, smem, [&](int m0, int n0, const float* Cs) {
        int lane = threadIdx.x & 63, wave = threadIdx.x >> 6;
        for (int rr = wave; rr < 128; rr += 4) {
          float2 c = *(const float2*)(Cs + rr * 128 + lane * 2);
          *(unsigned*)(p.PQ + (size_t)(m0 + rr) * 2048 + n0 + lane * 2) = pack2(c.x, c.y);
        }
      });
    } break;
    case 7: case 14: {
      int layer = ph == 7 ? 0 : 1;
      const u16* sk = p.SUBK + (size_t)layer * 16 * 128 * 128;
      for (int it = bid; it < 64 * 16; it += nb) {
        int mt = it >> 4, hc = it & 15;
        f32x16 acc[2][2];
        zero16(acc[0][0]); zero16(acc[0][1]); zero16(acc[1][0]); zero16(acc[1][1]);
        gemm_tile(p.PQ + (size_t)mt * 128 * 2048 + hc * 128, 2048, sk + (size_t)hc * 128 * 128, 128, 128, smem, acc);
        const float* Cs = (const float*)smem;
        int lane = threadIdx.x & 63, wave = threadIdx.x >> 6;
        for (int rr = wave; rr < 128; rr += 4) {
          float2 c = *(const float2*)(Cs + rr * 128 + lane * 2);
          *(float2*)(p.SC + (size_t)(mt * 128 + rr) * 2048 + hc * 128 + lane * 2) = c;
        }
      }
    } break;
    case 8: phase_peer(p, 0, bid, nb, smem); break;
    case 15: phase_peer(p, 1, bid, nb, smem); break;
    case 9: gemm_phase(p.H, 1024, p.WT_ODIN, 1024, 1024, 64, 18, bid, nb, smem, [&](int m0, int n0, const float* Cs) { epi_inproj1(p, m0, n0, Cs); }); break;
    case 10: phase_attn1(p, bid, nb, smem); break;
    case 11: gemm_phase(p.MIX, 1024, p.WT_ODOUT, 1024, 1024, 64, 8, bid, nb, smem, [&](int m0, int n0, const float* Cs) { epi_outproj(p, 1, m0, n0, Cs); }); break;
    default: break;
  }
}

template <int PH> DEV void run_all(const Params& p, cg::grid_group& grid, const XcdBarrier& xb, char* smem) {
  run_phase(p, PH, blockIdx.x, gridDim.x, smem);
  if constexpr (PH + 1 < NPHASE) {
    if constexpr (PH == 0) grid.sync(); else xcd_barrier(xb);
    run_all<PH + 1>(p, grid, xb, smem);
  }
}
__global__ void __launch_bounds__(256, 2) mega_kernel(Params p) {
  __shared__ __attribute__((aligned(16))) char smem[77824];
  __shared__ uint4 xb_words;
  if (threadIdx.x == 0) xb_words = make_uint4(0u, 0u, 0u, 0u);
  __syncthreads();
  XcdBarrier xb = xcd_barrier_post(p.BAR, (volatile LAS unsigned*)&xb_words);
  cg::grid_group grid = cg::this_grid();
  run_all<0>(p, grid, xb, smem);
}
#if MULTI_LAUNCH
template <int PH> __global__ void __launch_bounds__(256, 2) phase_kernel(Params p) {
  __shared__ __attribute__((aligned(16))) char smem[77824];
  run_phase(p, PH, blockIdx.x, gridDim.x, smem);
}
template <int PH> static void launch_all(const Params& p, int grid, hipStream_t s) {
  phase_kernel<PH><<<grid, 256, 0, s>>>(p);
  if constexpr (PH + 1 < NPHASE) launch_all<PH + 1>(p, grid, s);
}
#endif

extern "C" void kernel_launch(void* const* d_in, const int* in_sizes, int n_in, void* d_out, int out_size, void* d_ws, size_t ws_size, hipStream_t stream) {
  Params p{};
  const float* const* in = (const float* const*)d_in;
  p.xp = in[0]; p.xs = in[1]; p.c = in[2]; p.cctx = in[3]; p.cak = in[4]; p.cav = in[5]; p.srf = in[6]; p.srb = in[7];
  p.cck = in[8]; p.ccv = in[9]; p.cdk = in[10]; p.cdv = in[11];
  p.mod_w = in[12]; p.mod_b = in[13]; p.norm_mix = in[14]; p.norm_ffn = in[15]; p.norm_final = in[16];
  p.ev_w_in = in[17]; p.ev_w_out = in[18]; p.a_q_norm = in[19]; p.a_k_norm = in[20]; p.rdf = in[21]; p.rdb = in[22];
  p.od_w_in = in[23]; p.od_w_out = in[24]; p.lq1 = in[25]; p.lk1 = in[26]; p.lq2 = in[27]; p.lk2 = in[28]; p.subln = in[29]; p.dsink = in[30];
  p.peer_wq = in[31]; p.peer_sk = in[32]; p.peer_u = in[33]; p.peer_v = in[34];
  p.out = (float*)d_out;
  char* w = (char*)d_ws; size_t off = 0;
  auto take = [&](size_t bytes) { char* r = w + off; off += (bytes + 255) & ~(size_t)255; return r; };
  p.BAR = (unsigned*)take(XCD_BAR_WORDS * 4);
  p.MOD = (float*)take(61440 * 4);
  p.ROPEC = (float*)take(32768 * 4); p.ROPES = (float*)take(32768 * 4);
  p.X = (float*)take((size_t)8192 * 1024 * 4);
  p.SC = (float*)take((size_t)8192 * 2048 * 4);
  p.WT_EVIN = (u16*)take((size_t)2816 * 1024 * 2); p.WT_EVOUT = (u16*)take((size_t)1024 * 1024 * 2);
  p.WT_ODIN = (u16*)take((size_t)2304 * 1024 * 2); p.WT_ODOUT = (u16*)take((size_t)1024 * 1024 * 2);
  p.WT_PQ = (u16*)take((size_t)2 * 2048 * 1024 * 2); p.SUBK = (u16*)take((size_t)524288 * 2);
  p.U16 = nullptr; p.V16 = nullptr;
  p.U8 = (unsigned char*)take((size_t)2 * 16384 * 1024); p.V8 = (unsigned char*)take((size_t)2 * 16384 * 1024);
  p.SU = (float*)take(32768 * 4); p.SV = (float*)take(32768 * 4);
  p.H = (u16*)take((size_t)8192 * 1024 * 2); p.MIX = (u16*)take((size_t)8192 * 1024 * 2);
  p.Q1 = (u16*)take((size_t)8192 * 512 * 2); p.Q2 = (u16*)take((size_t)8192 * 512 * 2); p.SG = (u16*)take((size_t)8192 * 512 * 2);
  p.KA = (u16*)take((size_t)1179648 * 2); p.VA = (u16*)take((size_t)1179648 * 2);
  p.RK = (u16*)take((size_t)4194304 * 2); p.RV = (u16*)take((size_t)4194304 * 2);
  p.KC = (u16*)take((size_t)4718592 * 2); p.VC = (u16*)take((size_t)4718592 * 2);
  p.KD = (u16*)take((size_t)1179648 * 2); p.VD = (u16*)take((size_t)1179648 * 2);
  p.PQ = (u16*)take((size_t)8192 * 2048 * 2);
  (void)in_sizes; (void)n_in; (void)out_size; (void)ws_size;
#if MULTI_LAUNCH
  launch_all<0>(p, 512, stream);
#else
  static int grid_blocks = 0;
  if (!grid_blocks) {
    int dev = 0, cus = 0, per_cu = 0;
    hipGetDevice(&dev);
    hipDeviceGetAttribute(&cus, hipDeviceAttributeMultiprocessorCount, dev);
    hipOccupancyMaxActiveBlocksPerMultiprocessor(&per_cu, mega_kernel, 256, 0);
    if (per_cu > 2) per_cu = 2;
    if (per_cu < 1) per_cu = 1;
    grid_blocks = cus * per_cu;
  }
  (void)hipMemsetAsync(p.BAR, 0, XCD_BAR_WORDS * 4, stream);
  void* args[] = {&p};
  hipError_t e = hipLaunchCooperativeKernel((void*)mega_kernel, dim3(grid_blocks), dim3(256), args, 0, stream);
  if (e != hipSuccess) fprintf(stderr, "cooperative launch failed: %s (grid %d)\n", hipGetErrorString(e), grid_blocks);
#endif
}
```

```cpp
#include <hip/hip_runtime.h>
#include <hip/hip_cooperative_groups.h>
#include <cstdio>
namespace cg = cooperative_groups;

#ifndef MULTI_LAUNCH
#define MULTI_LAUNCH 0
#endif

typedef unsigned short u16;
typedef __attribute__((ext_vector_type(8))) short bf16x8;
typedef __attribute__((ext_vector_type(16))) float f32x16;
typedef __attribute__((ext_vector_type(4))) unsigned u32x4;

#define DEV __device__ __forceinline__

constexpr size_t OUT_AK = 8388608, OUT_AV = 8912896, OUT_RF = 9437184, OUT_RB = 9961472,
                 OUT_CK = 10485760, OUT_CV = 12582912, OUT_DK = 14680064, OUT_DV = 15204352;
constexpr float LAM_INIT = 0.35550906f;

struct Params {
  const float *xp, *xs, *c, *cctx, *cak, *cav, *srf, *srb, *cck, *ccv, *cdk, *cdv;
  const float *mod_w, *mod_b, *norm_mix, *norm_ffn, *norm_final;
  const float *ev_w_in, *ev_w_out, *a_q_norm, *a_k_norm, *rdf, *rdb;
  const float *od_w_in, *od_w_out, *lq1, *lk1, *lq2, *lk2, *subln, *dsink;
  const float *peer_wq, *peer_sk, *peer_u, *peer_v;
  float* out;
  char* ws;
  __device__ __forceinline__ unsigned* BAR() const { return (unsigned*)(ws + 0ull); }
  __device__ __forceinline__ float* MOD() const { return (float*)(ws + 13824ull); }
  __device__ __forceinline__ float* ROPEC() const { return (float*)(ws + 259584ull); }
  __device__ __forceinline__ float* ROPES() const { return (float*)(ws + 390656ull); }
  __device__ __forceinline__ float* X() const { return (float*)(ws + 521728ull); }
  __device__ __forceinline__ float* SC() const { return (float*)(ws + 34076160ull); }
  __device__ __forceinline__ u16* WT_EVIN() const { return (u16*)(ws + 101185024ull); }
  __device__ __forceinline__ u16* WT_EVOUT() const { return (u16*)(ws + 106952192ull); }
  __device__ __forceinline__ u16* WT_ODIN() const { return (u16*)(ws + 109049344ull); }
  __device__ __forceinline__ u16* WT_ODOUT() const { return (u16*)(ws + 113767936ull); }
  __device__ __forceinline__ u16* WT_PQ() const { return (u16*)(ws + 115865088ull); }
  __device__ __forceinline__ u16* SUBK() const { return (u16*)(ws + 124253696ull); }
  __device__ __forceinline__ unsigned char* U8() const { return (unsigned char*)(ws + 125302272ull); }
  __device__ __forceinline__ unsigned char* V8() const { return (unsigned char*)(ws + 158856704ull); }
  __device__ __forceinline__ float* SU() const { return (float*)(ws + 192411136ull); }
  __device__ __forceinline__ float* SV() const { return (float*)(ws + 192542208ull); }
  __device__ __forceinline__ u16* H() const { return (u16*)(ws + 192673280ull); }
  __device__ __forceinline__ u16* MIX() const { return (u16*)(ws + 209450496ull); }
  __device__ __forceinline__ u16* Q1() const { return (u16*)(ws + 226227712ull); }
  __device__ __forceinline__ u16* Q2() const { return (u16*)(ws + 234616320ull); }
  __device__ __forceinline__ u16* SG() const { return (u16*)(ws + 243004928ull); }
  __device__ __forceinline__ u16* KA() const { return (u16*)(ws + 251393536ull); }
  __device__ __forceinline__ u16* VA() const { return (u16*)(ws + 253752832ull); }
  __device__ __forceinline__ u16* RK() const { return (u16*)(ws + 256112128ull); }
  __device__ __forceinline__ u16* RV() const { return (u16*)(ws + 264500736ull); }
  __device__ __forceinline__ u16* KC() const { return (u16*)(ws + 272889344ull); }
  __device__ __forceinline__ u16* VC() const { return (u16*)(ws + 282326528ull); }
  __device__ __forceinline__ u16* KD() const { return (u16*)(ws + 291763712ull); }
  __device__ __forceinline__ u16* VD() const { return (u16*)(ws + 294123008ull); }
  __device__ __forceinline__ u16* PQ() const { return (u16*)(ws + 296482304ull); }
};

DEV u16 f2bf(float f) { unsigned u = __float_as_uint(f); u += 0x7fffu + ((u >> 16) & 1u); return (u16)(u >> 16); }
DEV float bf2f(unsigned b) { return __uint_as_float(b << 16); }
DEV unsigned pack2(float a, float b) { return (unsigned)f2bf(a) | ((unsigned)f2bf(b) << 16); }
DEV float bflo(unsigned w) { return __uint_as_float(w << 16); }
DEV float bfhi(unsigned w) { return __uint_as_float(w & 0xffff0000u); }
DEV float silu_f(float v) { return v / (1.f + __expf(-v)); }
DEV float gelu_tanh(float a) {
  float z = 0.7978845608f * (a + 0.044715f * a * a * a);
  float e = __expf(2.f * z);
  float th = 1.f - 2.f / (e + 1.f);
  return 0.5f * a * (1.f + th);
}
template <int CTRL> DEV float dpp_f(float v) {
  return __int_as_float(__builtin_amdgcn_update_dpp(0, __float_as_int(v), CTRL, 0xF, 0xF, true));
}
template <int CTRL> DEV unsigned dpp_u(unsigned v) {
  return (unsigned)__builtin_amdgcn_update_dpp(0, (int)v, CTRL, 0xF, 0xF, true);
}
DEV float row_sum16(float v) {
  v += dpp_f<0xB1>(v); v += dpp_f<0x4E>(v); v += dpp_f<0x141>(v); v += dpp_f<0x140>(v); return v;
}
DEV float row_max16(float v) {
  v = fmaxf(v, dpp_f<0xB1>(v)); v = fmaxf(v, dpp_f<0x4E>(v)); v = fmaxf(v, dpp_f<0x141>(v)); v = fmaxf(v, dpp_f<0x140>(v)); return v;
}
DEV float rlane(float v, int l) { return __int_as_float(__builtin_amdgcn_readlane(__float_as_int(v), l)); }
DEV float wave_sum(float v) {
  v = row_sum16(v);
  return (rlane(v, 0) + rlane(v, 16)) + (rlane(v, 32) + rlane(v, 48));
}
DEV unsigned wave_max_u(unsigned v) {
  v = max(v, dpp_u<0xB1>(v)); v = max(v, dpp_u<0x4E>(v)); v = max(v, dpp_u<0x141>(v)); v = max(v, dpp_u<0x140>(v));
  unsigned a = (unsigned)__builtin_amdgcn_readlane((int)v, 0), b = (unsigned)__builtin_amdgcn_readlane((int)v, 16);
  unsigned c = (unsigned)__builtin_amdgcn_readlane((int)v, 32), d = (unsigned)__builtin_amdgcn_readlane((int)v, 48);
  return max(max(a, b), max(c, d));
}
DEV float half_sum32(float v) { v = row_sum16(v); return v + __shfl_xor(v, 16); }
DEV unsigned fkey(float f) { unsigned u = __float_as_uint(f); return (u & 0x80000000u) ? ~u : (u | 0x80000000u); }
DEV f32x16 mfma32(bf16x8 a, bf16x8 b, f32x16 c) { return __builtin_amdgcn_mfma_f32_32x32x16_bf16(a, b, c, 0, 0, 0); }
DEV void zero16(f32x16& v) {
#pragma unroll
  for (int i = 0; i < 16; i++) v[i] = 0.f;
}
DEV size_t kvoff(bool smp, int b, int hh, int tpos, int H, int DW, int LS, int off) {
  return smp ? (size_t)4096 * H * DW + ((size_t)(b * H + hh) * LS + off + tpos) * DW
             : ((size_t)(b * H + hh) * 256 + tpos) * DW;
}


DEV float wave_max_f(float v) {
  v = row_max16(v);
  return fmaxf(fmaxf(rlane(v, 0), rlane(v, 16)), fmaxf(rlane(v, 32), rlane(v, 48)));
}
DEV int wave_sum_i(int v) {
  v += (int)dpp_u<0xB1>((unsigned)v); v += (int)dpp_u<0x4E>((unsigned)v); v += (int)dpp_u<0x141>((unsigned)v); v += (int)dpp_u<0x140>((unsigned)v);
  return (__builtin_amdgcn_readlane(v, 0) + __builtin_amdgcn_readlane(v, 16)) + (__builtin_amdgcn_readlane(v, 32) + __builtin_amdgcn_readlane(v, 48));
}
DEV int mbcnt64(unsigned long long m) { return (int)__builtin_amdgcn_mbcnt_hi((unsigned)(m >> 32), __builtin_amdgcn_mbcnt_lo((unsigned)m, 0u)); }
template <bool SGN> DEV void prep_quant(const float* __restrict__ src, unsigned char* __restrict__ dst, float* __restrict__ scale, int row0) {
  int lane = threadIdx.x & 63, wave = threadIdx.x >> 6;
  int rbase = row0 + wave * 4;
  float4 v[4][4];
#pragma unroll
  for (int q = 0; q < 4; q++)
#pragma unroll
    for (int i = 0; i < 4; i++) v[q][i] = *(const float4*)(src + (size_t)(rbase + q) * 1024 + (i * 64 + lane) * 4);
#pragma unroll
  for (int q = 0; q < 4; q++) {
    float mx = 0.f;
#pragma unroll
    for (int i = 0; i < 4; i++) mx = fmaxf(mx, fmaxf(fmaxf(fabsf(v[q][i].x), fabsf(v[q][i].y)), fmaxf(fabsf(v[q][i].z), fabsf(v[q][i].w))));
    mx = wave_max_f(mx);
    float inv = mx > 0.f ? 127.f / mx : 0.f;
    unsigned w[4];
#pragma unroll
    for (int i = 0; i < 4; i++) {
      int off = SGN ? 0 : 128;
      unsigned b0 = (unsigned)((int)rintf(v[q][i].x * inv) + off) & 255u, b1 = (unsigned)((int)rintf(v[q][i].y * inv) + off) & 255u;
      unsigned b2 = (unsigned)((int)rintf(v[q][i].z * inv) + off) & 255u, b3 = (unsigned)((int)rintf(v[q][i].w * inv) + off) & 255u;
      w[i] = b0 | (b1 << 8) | (b2 << 16) | (b3 << 24);
    }
    *(uint4*)(dst + (size_t)(rbase + q) * 1024 + lane * 16) = make_uint4(w[0], w[1], w[2], w[3]);
    if (lane == 0) scale[rbase + q] = mx * (1.f / 127.f);
  }
}

DEV void prep_transpose(const float* __restrict__ W, int N, u16* __restrict__ Wt, int tile, float* sm) {
  int ntn = N >> 6; int kt = tile / ntn, nt = tile % ntn;
  int k0 = kt * 64, n0 = nt * 64; int t = threadIdx.x;
#pragma unroll
  for (int i = 0; i < 4; i++) {
    int k = (t >> 4) + 16 * i; int c4 = (t & 15) * 4;
    float4 v = *(const float4*)(W + (size_t)(k0 + k) * N + n0 + c4);
    sm[k * 65 + c4] = v.x; sm[k * 65 + c4 + 1] = v.y; sm[k * 65 + c4 + 2] = v.z; sm[k * 65 + c4 + 3] = v.w;
  }
  __syncthreads();
  int n = t >> 2, kc = (t & 3) * 16;
  unsigned pk[8];
#pragma unroll
  for (int j = 0; j < 8; j++) pk[j] = pack2(sm[(kc + 2 * j) * 65 + n], sm[(kc + 2 * j + 1) * 65 + n]);
  uint4* dst = (uint4*)(Wt + (size_t)(n0 + n) * 1024 + k0 + kc);
  dst[0] = make_uint4(pk[0], pk[1], pk[2], pk[3]);
  dst[1] = make_uint4(pk[4], pk[5], pk[6], pk[7]);
  __syncthreads();
}
DEV void conv_item(const float* __restrict__ src, u16* __restrict__ dst) {
  int t = threadIdx.x;
#pragma unroll
  for (int i = 0; i < 8; i++) {
    int e = (i * 256 + t) * 8;
    float4 a = *(const float4*)(src + e), b = *(const float4*)(src + e + 4);
    *(uint4*)(dst + e) = make_uint4(pack2(a.x, a.y), pack2(a.z, a.w), pack2(b.x, b.y), pack2(b.z, b.w));
  }
}
DEV void prep_mod(const Params& p, int it, float* sm) {
  int l = it / 96, n0 = (it % 96) * 64; int t = threadIdx.x;
  float* sc = sm;
  for (int i = t; i < 5120; i += 256) {
    int b = i >> 10, k = i & 1023;
    float v = (b == 0) ? p.cctx[k] : p.c[(b - 1) * 1024 + k];
    sc[i] = silu_f(v);
  }
  __syncthreads();
  int col = t & 63, kg = t >> 6;
  float a0 = 0, a1 = 0, a2 = 0, a3 = 0, a4 = 0;
  const float* w = p.mod_w + (size_t)l * 1024 * 6144 + n0 + col;
  for (int k0 = kg; k0 < 1024; k0 += 32) {
    float wv[8];
#pragma unroll
    for (int u = 0; u < 8; u++) wv[u] = w[(size_t)(k0 + 4 * u) * 6144];
#pragma unroll
    for (int u = 0; u < 8; u++) {
      int k = k0 + 4 * u;
      a0 += sc[k] * wv[u]; a1 += sc[1024 + k] * wv[u]; a2 += sc[2048 + k] * wv[u]; a3 += sc[3072 + k] * wv[u]; a4 += sc[4096 + k] * wv[u];
    }
  }
  float* red = sm + 5120;
  red[(kg * 5 + 0) * 64 + col] = a0; red[(kg * 5 + 1) * 64 + col] = a1; red[(kg * 5 + 2) * 64 + col] = a2;
  red[(kg * 5 + 3) * 64 + col] = a3; red[(kg * 5 + 4) * 64 + col] = a4;
  __syncthreads();
  if (t < 64) {
#pragma unroll
    for (int b = 0; b < 5; b++) {
      float s = red[(0 * 5 + b) * 64 + t] + red[(1 * 5 + b) * 64 + t] + red[(2 * 5 + b) * 64 + t] + red[(3 * 5 + b) * 64 + t];
      p.MOD()[(size_t)(l * 5 + b) * 6144 + n0 + t] = s + p.mod_b[l * 6144 + n0 + t];
    }
  }
  __syncthreads();
}
DEV void prep_cache(const Params& p, int it) {
  const float* src; u16* dst;
  if (it < 8)       { int ch = it;      src = p.cak + (size_t)ch * 16384; dst = p.KA() + (size_t)4096 * 2 * 64 + (size_t)ch * 1280 * 64; }
  else if (it < 16) { int ch = it - 8;  src = p.cav + (size_t)ch * 16384; dst = p.VA() + (size_t)4096 * 2 * 64 + (size_t)ch * 1280 * 64; }
  else if (it < 48) { int ch = it - 16; src = p.cck + (size_t)ch * 16384; dst = p.KC() + (size_t)4096 * 8 * 64 + (size_t)ch * 1280 * 64; }
  else if (it < 80) { int ch = (it - 48) >> 1, hf = (it - 48) & 1;
                      src = p.ccv + (size_t)ch * 32768 + hf * 16384; dst = p.VC() + (size_t)4096 * 4 * 128 + (size_t)ch * 1280 * 128 + hf * 16384; }
  else if (it < 88) { int ch = it - 80; src = p.cdk + (size_t)ch * 16384; dst = p.KD() + (size_t)4096 * 2 * 64 + (size_t)ch * 1280 * 64; }
  else              { int ch = it - 88; src = p.cdv + (size_t)ch * 16384; dst = p.VD() + (size_t)4096 * 2 * 64 + (size_t)ch * 1280 * 64; }
  conv_item(src, dst);
}
DEV void prep_rope(const Params& p, int it) {
  for (int i = 0; i < 16; i++) {
    int idx = it * 4096 + i * 256 + threadIdx.x;
    int tpos = idx >> 5, a = idx & 31;
    float pos = (a < 16) ? (float)(tpos >> 6) : (float)(tpos & 63);
    float inv = exp2f(-(float)(a & 15) * (13.287712379549449f / 16.f));
    float ang = pos * inv;
    p.ROPEC()[idx] = __cosf(ang); p.ROPES()[idx] = __sinf(ang);
  }
}
constexpr int PREP_T0 = 704, PREP_T1 = PREP_T0 + 256, PREP_T2 = PREP_T1 + 576, PREP_T3 = PREP_T2 + 256, PREP_T4 = PREP_T3 + 1024;
constexpr int PREP_U = PREP_T4 + 2048, PREP_V = PREP_U + 2048, PREP_SK = PREP_V + 32, PREP_CA = PREP_SK + 96, PREP_RO = PREP_CA + 8, PREP_MOD = PREP_RO + 192;
DEV void phase_prep(const Params& p, int bid, int nb, char* smem) {
  float* sm = (float*)smem;
  for (int it0 = bid; it0 < PREP_MOD; it0 += nb) {
    int it = (it0 < 192) ? (PREP_RO + it0) : (it0 - 192);
    if (it < PREP_T0) prep_transpose(p.ev_w_in, 2816, p.WT_EVIN(), it, sm);
    else if (it < PREP_T1) prep_transpose(p.ev_w_out, 1024, p.WT_EVOUT(), it - PREP_T0, sm);
    else if (it < PREP_T2) prep_transpose(p.od_w_in, 2304, p.WT_ODIN(), it - PREP_T1, sm);
    else if (it < PREP_T3) prep_transpose(p.od_w_out, 1024, p.WT_ODOUT(), it - PREP_T2, sm);
    else if (it < PREP_T4) { int j = it - PREP_T3; int l = j >> 9; prep_transpose(p.peer_wq + (size_t)l * 1024 * 2048, 2048, p.WT_PQ() + (size_t)l * 2048 * 1024, j & 511, sm); }
    else if (it < PREP_U) prep_quant<true>(p.peer_u, p.U8(), p.SU(), (it - PREP_T4) * 16);
    else if (it < PREP_V) prep_quant<false>(p.peer_v, p.V8(), p.SV(), (it - PREP_U) * 16);
    else if (it < PREP_SK) { size_t o = (size_t)(it - PREP_V) * 16384; conv_item(p.peer_sk + o, p.SUBK() + o); }
    else if (it < PREP_CA) prep_cache(p, it - PREP_SK);
    else if (it < PREP_RO) prep_rope(p, it - PREP_CA);
    else prep_mod(p, it - PREP_RO, sm);
  }
}

DEV void phase_ada(const Params& p, int layer, const float* __restrict__ gain, int shift_i, int scale_i, bool from_input, int bid, int nb) {
  int wave = threadIdx.x >> 6, lane = threadIdx.x & 63;
  for (int T = bid * 4 + wave; T < 8192; T += nb * 4) {
    const float* xr = from_input ? (T < 4096 ? p.xp + (size_t)T * 1024 : p.xs + (size_t)(T - 4096) * 1024) : p.X() + (size_t)T * 1024;
    int mb = T < 4096 ? 0 : 1 + ((T - 4096) >> 10);
    const float* md = p.MOD() + (size_t)(layer * 5 + mb) * 6144;
    float4 v[4]; float ss = 0;
#pragma unroll
    for (int i = 0; i < 4; i++) { v[i] = *(const float4*)(xr + (i * 64 + lane) * 4); ss += v[i].x * v[i].x + v[i].y * v[i].y + v[i].z * v[i].z + v[i].w * v[i].w; }
    ss = wave_sum(ss);
    float rstd = rsqrtf(ss * (1.f / 1024.f) + 1e-6f);
#pragma unroll
    for (int i = 0; i < 4; i++) {
      int col = (i * 64 + lane) * 4;
      float4 g = *(const float4*)(gain + col), sh = *(const float4*)(md + shift_i * 1024 + col), sc = *(const float4*)(md + scale_i * 1024 + col);
      float y0 = v[i].x * rstd * g.x * (1.f + sc.x) + sh.x, y1 = v[i].y * rstd * g.y * (1.f + sc.y) + sh.y;
      float y2 = v[i].z * rstd * g.z * (1.f + sc.z) + sh.z, y3 = v[i].w * rstd * g.w * (1.f + sc.w) + sh.w;
      *(uint2*)(p.H() + (size_t)T * 1024 + col) = make_uint2(pack2(y0, y1), pack2(y2, y3));
    }
  }
}

#define GLOAD8(PA, PB) \
  ra0 = *(const u32x4*)(PA); ra1 = *(const u32x4*)((PA) + sa32); ra2 = *(const u32x4*)((PA) + 2 * sa32); ra3 = *(const u32x4*)((PA) + 3 * sa32); \
  rb0 = *(const u32x4*)(PB); rb1 = *(const u32x4*)((PB) + sb32); rb2 = *(const u32x4*)((PB) + 2 * sb32); rb3 = *(const u32x4*)((PB) + 3 * sb32);
#define GLOAD8N(PA, PB) \
  na0 = *(const u32x4*)(PA); na1 = *(const u32x4*)((PA) + sa32); na2 = *(const u32x4*)((PA) + 2 * sa32); na3 = *(const u32x4*)((PA) + 3 * sa32); \
  nb0 = *(const u32x4*)(PB); nb1 = *(const u32x4*)((PB) + sb32); nb2 = *(const u32x4*)((PB) + 2 * sb32); nb3 = *(const u32x4*)((PB) + 3 * sb32);
#define GSTORE8(BUF) { u16* wa_ = (u16*)(smem + (BUF) * 36864) + lrow * 72 + lkc; u16* wb_ = wa_ + 128 * 72; \
  *(u32x4*)(wa_) = ra0; *(u32x4*)(wa_ + 32 * 72) = ra1; *(u32x4*)(wa_ + 64 * 72) = ra2; *(u32x4*)(wa_ + 96 * 72) = ra3; \
  *(u32x4*)(wb_) = rb0; *(u32x4*)(wb_ + 32 * 72) = rb1; *(u32x4*)(wb_ + 64 * 72) = rb2; *(u32x4*)(wb_ + 96 * 72) = rb3; }
DEV void gemm_tile(const u16* __restrict__ A, int lda, const u16* __restrict__ B, int ldb, int K, char* smem, f32x16 (&acc)[2][2]) {
  int t = threadIdx.x, lane = t & 63, wave = t >> 6, r = lane & 31, h = lane >> 5;
  int wm = wave >> 1, wn = wave & 1;
  int lrow = t >> 3, lkc = (t & 7) * 8;
  const u16* ap = A + (size_t)lrow * lda + lkc;
  const u16* bp = B + (size_t)lrow * ldb + lkc;
  size_t sa32 = (size_t)32 * lda, sb32 = (size_t)32 * ldb;
  u32x4 ra0, ra1, ra2, ra3, rb0, rb1, rb2, rb3;
  u32x4 na0, na1, na2, na3, nb0, nb1, nb2, nb3;
  int nk = K >> 6;
#define GSTORE8N(BUF) { u16* wa_ = (u16*)(smem + (BUF) * 36864) + lrow * 72 + lkc; u16* wb_ = wa_ + 128 * 72; \
  *(u32x4*)(wa_) = na0; *(u32x4*)(wa_ + 32 * 72) = na1; *(u32x4*)(wa_ + 64 * 72) = na2; *(u32x4*)(wa_ + 96 * 72) = na3; \
  *(u32x4*)(wb_) = nb0; *(u32x4*)(wb_ + 32 * 72) = nb1; *(u32x4*)(wb_ + 64 * 72) = nb2; *(u32x4*)(wb_ + 96 * 72) = nb3; }
#define GCOMPUTE(BUF) { const u16* sA = (const u16*)(smem + (BUF) * 36864); const u16* sB = sA + 128 * 72; \
    _Pragma("unroll") for (int kk = 0; kk < 4; kk++) { \
      bf16x8 a0 = *(const bf16x8*)(sA + (wm * 64 + r) * 72 + kk * 16 + h * 8); \
      bf16x8 a1 = *(const bf16x8*)(sA + (wm * 64 + 32 + r) * 72 + kk * 16 + h * 8); \
      bf16x8 b0 = *(const bf16x8*)(sB + (wn * 64 + r) * 72 + kk * 16 + h * 8); \
      bf16x8 b1 = *(const bf16x8*)(sB + (wn * 64 + 32 + r) * 72 + kk * 16 + h * 8); \
      acc[0][0] = mfma32(a0, b0, acc[0][0]); acc[0][1] = mfma32(a0, b1, acc[0][1]); \
      acc[1][0] = mfma32(a1, b0, acc[1][0]); acc[1][1] = mfma32(a1, b1, acc[1][1]); } }
  GLOAD8(ap, bp)
  __syncthreads();
  GSTORE8(0)
  if (nk > 1) { GLOAD8(ap + 64, bp + 64) }
  na0 = ra0; na1 = ra1; na2 = ra2; na3 = ra3; nb0 = rb0; nb1 = rb1; nb2 = rb2; nb3 = rb3;
  __syncthreads();
  for (int kt = 0; kt < nk; kt += 2) {
    if (kt + 2 < nk) { GLOAD8N(ap + (kt + 2) * 64, bp + (kt + 2) * 64) }
    GCOMPUTE(0)
    if (kt + 1 < nk) { GSTORE8(1) }
    __syncthreads();
    if (kt + 1 < nk) {
      if (kt + 3 < nk) { GLOAD8(ap + (kt + 3) * 64, bp + (kt + 3) * 64) }
      GCOMPUTE(1)
      if (kt + 2 < nk) { GSTORE8N(0) }
      __syncthreads();
    }
  }
  __syncthreads();
  float* Cs = (float*)smem;
#pragma unroll
  for (int i = 0; i < 2; i++)
#pragma unroll
    for (int j = 0; j < 2; j++)
#pragma unroll
      for (int g = 0; g < 16; g++)
        Cs[(wm * 64 + i * 32 + (g & 3) + 8 * (g >> 2) + 4 * h) * 128 + wn * 64 + j * 32 + r] = acc[i][j][g];
  __syncthreads();
}

DEV bool xcd_tile(int li, int bid, int NTl, int& mt, int& nt) {
  if (li >= 8 * NTl) return false;
  mt = 8 * (bid & 7) + (li & 7); nt = li >> 3; return true;
}
template <class Epi>
DEV void gemm_phase(const u16* A, int lda, const u16* Bt, int ldb, int K, int MT, int NTl, int bid, int nb, char* smem, Epi epi) {
  if ((nb & 7) == 0 && MT == 64) {
    int mt, nt;
    for (int li = bid >> 3; xcd_tile(li, bid, NTl, mt, nt); li += nb >> 3) {
      f32x16 acc[2][2];
      zero16(acc[0][0]); zero16(acc[0][1]); zero16(acc[1][0]); zero16(acc[1][1]);
      gemm_tile(A + (size_t)mt * 128 * lda, lda, Bt + (size_t)nt * 128 * ldb, ldb, K, smem, acc);
      epi(mt * 128, nt * 128, (const float*)smem);
    }
  } else {
    for (int it = bid; it < MT * NTl; it += nb) {
      int mt = it / NTl, nt = it % NTl;
      f32x16 acc[2][2];
      zero16(acc[0][0]); zero16(acc[0][1]); zero16(acc[1][0]); zero16(acc[1][1]);
      gemm_tile(A + (size_t)mt * 128 * lda, lda, Bt + (size_t)nt * 128 * ldb, ldb, K, smem, acc);
      epi(mt * 128, nt * 128, (const float*)smem);
    }
  }
}

DEV void tok_decode(int T, bool& smp, int& b, int& tpos) {
  smp = T >= 4096;
  if (!smp) { b = T >> 8; tpos = T & 255; } else { b = (T - 4096) >> 10; tpos = (T - 4096) & 1023; }
}
DEV void rope_pair(const Params& p, float& x, float& y, int tpos, int d) {
  float px = __shfl_xor(x, 16), py = __shfl_xor(y, 16);
  int a = d & 31;
  float c0 = p.ROPEC()[tpos * 32 + a], c1 = p.ROPEC()[tpos * 32 + a + 1];
  float s0 = p.ROPES()[tpos * 32 + a], s1 = p.ROPES()[tpos * 32 + a + 1];
  if (d < 32) { x = x * c0 - px * s0; y = y * c1 - py * s1; }
  else        { x = px * s0 + x * c0; y = py * s1 + y * c1; }
}

DEV void rope_apply(float& x, float& y, float4 cs, int d) {
  float px = __shfl_xor(x, 16), py = __shfl_xor(y, 16);
  if (d < 32) { x = x * cs.x - px * cs.z; y = y * cs.y - py * cs.w; }
  else        { x = px * cs.z + x * cs.x; y = py * cs.w + y * cs.y; }
}
DEV float4 rope_cs(const Params& p, int tpos, int d) {
  int a = d & 31;
  float2 c = *(const float2*)(p.ROPEC() + tpos * 32 + a), s = *(const float2*)(p.ROPES() + tpos * 32 + a);
  return make_float4(c.x, c.y, s.x, s.y);
}
template <int SEG, bool SMP>
DEV void epi0_rows(const Params& p, int m0, int n0, const float* Cs) {
  int lane = threadIdx.x & 63, wave = threadIdx.x >> 6;
  int col = n0 + lane * 2; int d = col & 63;
  float g0 = 1.f, g1 = 1.f;
  if (SEG == 0) { g0 = p.a_q_norm[d]; g1 = p.a_q_norm[d + 1]; }
  if (SEG == 1) { g0 = p.a_k_norm[d]; g1 = p.a_k_norm[d + 1]; }
  int segbase = SEG == 0 ? 0 : SEG == 1 ? 512 : SEG == 2 ? 640 : SEG == 3 ? 768 : SEG == 4 ? 1280 : SEG == 5 ? 1792 : 2304;
  int hh = (col - segbase) >> 6;
#pragma unroll 4
  for (int i = 0; i < 32; i++) {
    int rr = wave + 4 * i;
    int T = m0 + rr;
    int b = SMP ? (T - 4096) >> 10 : T >> 8;
    int tpos = SMP ? (T - 4096) & 1023 : T & 255;
    float2 c = *(const float2*)(Cs + rr * 128 + lane * 2);
    if (SEG <= 1) {
      float4 cs = make_float4(1.f, 1.f, 0.f, 0.f);
      if (SMP) cs = rope_cs(p, tpos, d);
      float ss = half_sum32(c.x * c.x + c.y * c.y);
      float rstd = rsqrtf(ss * (1.f / 64.f) + 1e-6f);
      c.x *= rstd * g0; c.y *= rstd * g1;
      if (SMP) rope_apply(c.x, c.y, cs, d);
    }
    if (SEG == 0) *(unsigned*)(p.Q1() + (size_t)T * 512 + col) = pack2(c.x * 0.125f, c.y * 0.125f);
    if (SEG == 1) {
      *(unsigned*)(p.KA() + kvoff(SMP, b, hh, tpos, 2, 64, 1280, 256) + d) = pack2(c.x, c.y);
      if (!SMP) *(float2*)(p.out + OUT_AK + ((size_t)(b * 2 + hh) * 256 + tpos) * 64 + d) = c;
    }
    if (SEG == 2) {
      *(unsigned*)(p.VA() + kvoff(SMP, b, hh, tpos, 2, 64, 1280, 256) + d) = pack2(c.x, c.y);
      if (!SMP) *(float2*)(p.out + OUT_AV + ((size_t)(b * 2 + hh) * 256 + tpos) * 64 + d) = c;
    }
    if (SEG == 3) *(unsigned*)(p.Q2() + (size_t)T * 512 + (col - 768)) = pack2(c.x, c.y);
    if (SEG == 4) *(unsigned*)(p.RK() + kvoff(SMP, b, hh, tpos, 8, 64, 1024, 0) + d) = pack2(c.x * 0.125f, c.y * 0.125f);
    if (SEG == 5) *(unsigned*)(p.RV() + kvoff(SMP, b, hh, tpos, 8, 64, 1024, 0) + d) = pack2(c.x, c.y);
    if (SEG == 6) *(unsigned*)(p.SG() + (size_t)T * 512 + (col - 2304)) = pack2(silu_f(c.x), silu_f(c.y));
  }
}
template <bool SMP> DEV void epi0_disp(const Params& p, int m0, int n0, const float* Cs) {
  if (n0 < 512) epi0_rows<0, SMP>(p, m0, n0, Cs);
  else if (n0 < 640) epi0_rows<1, SMP>(p, m0, n0, Cs);
  else if (n0 < 768) epi0_rows<2, SMP>(p, m0, n0, Cs);
  else if (n0 < 1280) epi0_rows<3, SMP>(p, m0, n0, Cs);
  else if (n0 < 1792) epi0_rows<4, SMP>(p, m0, n0, Cs);
  else if (n0 < 2304) epi0_rows<5, SMP>(p, m0, n0, Cs);
  else epi0_rows<6, SMP>(p, m0, n0, Cs);
}
DEV void epi_inproj0(const Params& p, int m0, int n0, const float* Cs) {
  if (m0 >= 4096) epi0_disp<true>(p, m0, n0, Cs); else epi0_disp<false>(p, m0, n0, Cs);
}
template <int SEG, bool SMP>
DEV void epi1_rows(const Params& p, int m0, int n0, const float* Cs) {
  int lane = threadIdx.x & 63, wave = threadIdx.x >> 6;
  int col = n0 + lane * 2; int d = col & 63;
  int segbase = SEG == 0 ? 0 : SEG == 1 ? 512 : SEG == 2 ? 1024 : SEG == 3 ? 1536 : SEG == 4 ? 2048 : 2176;
  int hh = (SEG == 2) ? (col - segbase) >> 7 : (col - segbase) >> 6;
  int dd = (col - 1024) & 127;
  constexpr bool ROPE = SMP && (SEG == 0 || SEG == 1 || SEG == 3 || SEG == 4);
#pragma unroll 4
  for (int i = 0; i < 32; i++) {
    int rr = wave + 4 * i;
    int T = m0 + rr;
    int b = SMP ? (T - 4096) >> 10 : T >> 8;
    int tpos = SMP ? (T - 4096) & 1023 : T & 255;
    float2 c = *(const float2*)(Cs + rr * 128 + lane * 2);
    if (!SMP) {
      if (SEG == 1) *(float2*)(p.out + OUT_CK + ((size_t)(b * 8 + hh) * 256 + tpos) * 64 + d) = c;
      if (SEG == 2) *(float2*)(p.out + OUT_CV + ((size_t)(b * 4 + hh) * 256 + tpos) * 128 + dd) = c;
      if (SEG == 4) *(float2*)(p.out + OUT_DK + ((size_t)(b * 2 + hh) * 256 + tpos) * 64 + d) = c;
      if (SEG == 5) *(float2*)(p.out + OUT_DV + ((size_t)(b * 2 + hh) * 256 + tpos) * 64 + d) = c;
    }
    if (ROPE) { float4 cs = rope_cs(p, tpos, d); rope_apply(c.x, c.y, cs, d); }
    if (SEG == 0) *(unsigned*)(p.Q1() + (size_t)T * 512 + col) = pack2(c.x * 0.125f, c.y * 0.125f);
    if (SEG == 1) *(unsigned*)(p.KC() + kvoff(SMP, b, hh, tpos, 8, 64, 1280, 256) + d) = pack2(c.x, c.y);
    if (SEG == 2) *(unsigned*)(p.VC() + kvoff(SMP, b, hh, tpos, 4, 128, 1280, 256) + dd) = pack2(c.x, c.y);
    if (SEG == 3) *(unsigned*)(p.Q2() + (size_t)T * 512 + (col - 1536)) = pack2(c.x * 0.125f, c.y * 0.125f);
    if (SEG == 4) *(unsigned*)(p.KD() + kvoff(SMP, b, hh, tpos, 2, 64, 1280, 256) + d) = pack2(c.x, c.y);
    if (SEG == 5) *(unsigned*)(p.VD() + kvoff(SMP, b, hh, tpos, 2, 64, 1280, 256) + d) = pack2(c.x, c.y);
  }
}
template <bool SMP> DEV void epi1_disp(const Params& p, int m0, int n0, const float* Cs) {
  if (n0 < 512) epi1_rows<0, SMP>(p, m0, n0, Cs);
  else if (n0 < 1024) epi1_rows<1, SMP>(p, m0, n0, Cs);
  else if (n0 < 1536) epi1_rows<2, SMP>(p, m0, n0, Cs);
  else if (n0 < 2048) epi1_rows<3, SMP>(p, m0, n0, Cs);
  else if (n0 < 2176) epi1_rows<4, SMP>(p, m0, n0, Cs);
  else epi1_rows<5, SMP>(p, m0, n0, Cs);
}
DEV void epi_inproj1(const Params& p, int m0, int n0, const float* Cs) {
  if (m0 >= 4096) epi1_disp<true>(p, m0, n0, Cs); else epi1_disp<false>(p, m0, n0, Cs);
}
DEV void epi_outproj(const Params& p, int layer, int m0, int n0, const float* Cs) {
  int lane = threadIdx.x & 63, wave = threadIdx.x >> 6;
  int mb = m0 < 4096 ? 0 : 1 + ((m0 - 4096) >> 10);
  int col = n0 + lane * 2;
  float2 g = *(const float2*)(p.MOD() + (size_t)(layer * 5 + mb) * 6144 + 2048 + col);
  const float* xbase = (layer == 0) ? (m0 < 4096 ? p.xp + (size_t)m0 * 1024 : p.xs + (size_t)(m0 - 4096) * 1024) : p.X() + (size_t)m0 * 1024;
#pragma unroll 8
  for (int i = 0; i < 32; i++) {
    int rr = wave + 4 * i;
    float2 c = *(const float2*)(Cs + rr * 128 + lane * 2);
    float2 x = *(const float2*)(xbase + (size_t)rr * 1024 + col);
    x.x += g.x * c.x; x.y += g.y * c.y;
    *(float2*)(p.X() + (size_t)(m0 + rr) * 1024 + col) = x;
  }
}

constexpr int ATT_BUF = 37888;
struct TileRegs { u32x4 k0, k1, k2, k3, v0, v1, v2, v3; };
template <int DV, bool TWOK> DEV TileRegs tile_load(const u16* __restrict__ k, const u16* __restrict__ k2, const u16* __restrict__ v) {
  int t = threadIdx.x, lane = t & 63, wave = t >> 6;
  TileRegs R;
  u32x4 z = {0u, 0u, 0u, 0u};
  R.k0 = *(const u32x4*)(k + t * 8); R.k1 = *(const u32x4*)(k + (t + 256) * 8);
  if (TWOK) { R.k2 = *(const u32x4*)(k2 + t * 8); R.k3 = *(const u32x4*)(k2 + (t + 256) * 8); } else { R.k2 = z; R.k3 = z; }
  R.v0 = *(const u32x4*)(v + (size_t)lane * DV + wave * 8); R.v1 = *(const u32x4*)(v + (size_t)lane * DV + (wave + 4) * 8);
  if (DV == 128) { R.v2 = *(const u32x4*)(v + (size_t)lane * DV + (wave + 8) * 8); R.v3 = *(const u32x4*)(v + (size_t)lane * DV + (wave + 12) * 8); } else { R.v2 = z; R.v3 = z; }
  return R;
}
DEV void store8t(u16* d, u32x4 x) {
  d[0 * 76] = (u16)(x[0] & 0xffff); d[1 * 76] = (u16)(x[0] >> 16);
  d[2 * 76] = (u16)(x[1] & 0xffff); d[3 * 76] = (u16)(x[1] >> 16);
  d[4 * 76] = (u16)(x[2] & 0xffff); d[5 * 76] = (u16)(x[2] >> 16);
  d[6 * 76] = (u16)(x[3] & 0xffff); d[7 * 76] = (u16)(x[3] >> 16);
}
template <int DV, bool TWOK> DEV void tile_store(const TileRegs R, char* buf) {
  int t = threadIdx.x, lane = t & 63, wave = t >> 6;
  u16* sK = (u16*)buf; u16* sK2 = sK + 64 * 72; u16* sVT = sK + 2 * 64 * 72;
  int key = t >> 3, dc = t & 7;
  *(u32x4*)(sK + key * 72 + dc * 8) = R.k0; *(u32x4*)(sK + (key + 32) * 72 + dc * 8) = R.k1;
  if (TWOK) { *(u32x4*)(sK2 + key * 72 + dc * 8) = R.k2; *(u32x4*)(sK2 + (key + 32) * 72 + dc * 8) = R.k3; }
  store8t(sVT + (wave * 8) * 76 + lane, R.v0); store8t(sVT + ((wave + 4) * 8) * 76 + lane, R.v1);
  if (DV == 128) { store8t(sVT + ((wave + 8) * 8) * 76 + lane, R.v2); store8t(sVT + ((wave + 12) * 8) * 76 + lane, R.v3); }
}
DEV void load_ident_k(u16* sK) {
  int t = threadIdx.x;
#pragma unroll
  for (int i = 0; i < 2; i++) {
    int c = t + 256 * i; int key = c >> 3, dc = c & 7;
    unsigned w[4] = {0u, 0u, 0u, 0u};
    uint4 z = make_uint4(0u, 0u, 0u, 0u);
    if (dc == (key >> 3)) {
      int e = key & 7; unsigned one = (e & 1) ? 0x3F800000u : 0x00003F80u;
      if ((e >> 1) == 0) z.x = one; else if ((e >> 1) == 1) z.y = one; else if ((e >> 1) == 2) z.z = one; else z.w = one;
    }
    (void)w;
    *(uint4*)(sK + key * 72 + dc * 8) = z;
  }
}
DEV void load_state_v(const float* __restrict__ S0, u16* sVT) {
  int lane = threadIdx.x & 63, wave = threadIdx.x >> 6;
#pragma unroll
  for (int i = 0; i < 2; i++) {
    int dc = wave + 4 * i;
    float4 a = *(const float4*)(S0 + lane * 64 + dc * 8), b = *(const float4*)(S0 + lane * 64 + dc * 8 + 4);
    u16* d = sVT + (dc * 8) * 76 + lane;
    d[0 * 76] = f2bf(a.x); d[1 * 76] = f2bf(a.y); d[2 * 76] = f2bf(a.z); d[3 * 76] = f2bf(a.w);
    d[4 * 76] = f2bf(b.x); d[5 * 76] = f2bf(b.y); d[6 * 76] = f2bf(b.z); d[7 * 76] = f2bf(b.w);
  }
}
template <int DV, class F>
DEV void attn_compute(const bf16x8 (&qf)[4], f32x16 (&o)[DV / 32], const u16* sK, const u16* sVT, F&& xform) {
  int lane = threadIdx.x & 63, r = lane & 31, h = lane >> 5;
  f32x16 st[2]; zero16(st[0]); zero16(st[1]);
#pragma unroll
  for (int sub = 0; sub < 2; sub++)
#pragma unroll
    for (int kk = 0; kk < 4; kk++) {
      bf16x8 kf = *(const bf16x8*)(sK + (sub * 32 + r) * 72 + kk * 16 + h * 8);
      st[sub] = mfma32(kf, qf[kk], st[sub]);
    }
  xform(st);
  bf16x8 pf[2][2];
#pragma unroll
  for (int sub = 0; sub < 2; sub++)
#pragma unroll
    for (int s = 0; s < 2; s++) {
      u32x4 w;
      w[0] = pack2(st[sub][8 * s + 0], st[sub][8 * s + 1]); w[1] = pack2(st[sub][8 * s + 2], st[sub][8 * s + 3]);
      w[2] = pack2(st[sub][8 * s + 4], st[sub][8 * s + 5]); w[3] = pack2(st[sub][8 * s + 6], st[sub][8 * s + 7]);
      pf[sub][s] = __builtin_bit_cast(bf16x8, w);
    }
#pragma unroll
  for (int ds = 0; ds < DV / 32; ds++)
#pragma unroll
    for (int sub = 0; sub < 2; sub++)
#pragma unroll
      for (int s = 0; s < 2; s++) {
        const u16* vp = sVT + (ds * 32 + r) * 76 + sub * 32 + s * 16 + 4 * h;
        uint2 lo = *(const uint2*)vp, hi = *(const uint2*)(vp + 8);
        u32x4 w; w[0] = lo.x; w[1] = lo.y; w[2] = hi.x; w[3] = hi.y;
        o[ds] = mfma32(__builtin_bit_cast(bf16x8, w), pf[sub][s], o[ds]);
      }
}
template <int DV, class F>
DEV void attn_compute_sub(const bf16x8 (&qf)[4], f32x16 (&o)[DV / 32], const u16* sK, const u16* sVT, F&& xform) {
  int lane = threadIdx.x & 63, r = lane & 31, h = lane >> 5;
#pragma unroll
  for (int sub = 0; sub < 2; sub++) {
    f32x16 st; zero16(st);
#pragma unroll
    for (int kk = 0; kk < 4; kk++) {
      bf16x8 kf = *(const bf16x8*)(sK + (sub * 32 + r) * 72 + kk * 16 + h * 8);
      st = mfma32(kf, qf[kk], st);
    }
    xform(sub, st);
    bf16x8 pf[2];
#pragma unroll
    for (int s2 = 0; s2 < 2; s2++) {
      u32x4 w;
      w[0] = pack2(st[8 * s2 + 0], st[8 * s2 + 1]); w[1] = pack2(st[8 * s2 + 2], st[8 * s2 + 3]);
      w[2] = pack2(st[8 * s2 + 4], st[8 * s2 + 5]); w[3] = pack2(st[8 * s2 + 6], st[8 * s2 + 7]);
      pf[s2] = __builtin_bit_cast(bf16x8, w);
    }
#pragma unroll
    for (int ds = 0; ds < DV / 32; ds++)
#pragma unroll
      for (int s2 = 0; s2 < 2; s2++) {
        const u16* vp = sVT + (ds * 32 + r) * 76 + sub * 32 + s2 * 16 + 4 * h;
        uint2 lo = *(const uint2*)vp, hi = *(const uint2*)(vp + 8);
        u32x4 w; w[0] = lo.x; w[1] = lo.y; w[2] = hi.x; w[3] = hi.y;
        o[ds] = mfma32(__builtin_bit_cast(bf16x8, w), pf[s2], o[ds]);
      }
  }
}
template <int DV>
DEV void softmax_xform1(f32x16& st, f32x16 (&o)[DV / 32], float& m, float& l) {
  float mx = -1e30f;
#pragma unroll
  for (int g = 0; g < 16; g++) mx = fmaxf(mx, st[g]);
  mx = fmaxf(mx, __shfl_xor(mx, 32));
  float mnew = fmaxf(m, mx);
  float alpha = __expf(m - mnew);
  m = mnew;
  float ls = 0.f;
#pragma unroll
  for (int g = 0; g < 16; g++) { float pv = __expf(st[g] - mnew); st[g] = pv; ls += pv; }
  l = l * alpha + ls;
#pragma unroll
  for (int ds = 0; ds < DV / 32; ds++)
#pragma unroll
    for (int g = 0; g < 16; g++) o[ds][g] *= alpha;
}
template <int DV, bool TWOK, class PF, class XF, class XF1>
DEV void attn_loop(int n, PF&& ptrs, const bf16x8 (&qf)[4], f32x16 (&o)[DV / 32], char* smem, XF&& xf, XF1&& xf1) {
  int wave = threadIdx.x >> 6;
  int kofs = (TWOK && wave >= 2) ? 64 * 72 : 0;
  TileRegs R;
  const u16 *kp, *kp2, *vp;
  ptrs(0, kp, kp2, vp); R = tile_load<DV, TWOK>(kp, kp2, vp);
  __syncthreads();
  tile_store<DV, TWOK>(R, smem);
  if (n > 1) { ptrs(1, kp, kp2, vp); R = tile_load<DV, TWOK>(kp, kp2, vp); }
  __syncthreads();
  const u16* b0k = (const u16*)smem + kofs; const u16* b0v = (const u16*)smem + 2 * 64 * 72;
  const u16* b1k = (const u16*)(smem + ATT_BUF) + kofs; const u16* b1v = (const u16*)(smem + ATT_BUF) + 2 * 64 * 72;
  for (int ti = 0; ti < n; ti++) {
    const u16* bk = (ti & 1) ? b1k : b0k; const u16* bv = (ti & 1) ? b1v : b0v;
    if constexpr (DV == 128) attn_compute_sub<DV>(qf, o, bk, bv, [&](int sub, f32x16& st) { xf1(ti, sub, st); });
    else attn_compute<DV>(qf, o, bk, bv, [&](f32x16 (&st)[2]) { xf(ti, st); });
    if (ti + 1 < n) tile_store<DV, TWOK>(R, smem + ((ti + 1) & 1) * ATT_BUF);
    if (ti + 2 < n) { ptrs(ti + 2, kp, kp2, vp); R = tile_load<DV, TWOK>(kp, kp2, vp); }
    __syncthreads();
  }
}
template <int DV>
DEV void softmax_xform(f32x16 (&st)[2], f32x16 (&o)[DV / 32], float& m, float& l, bool masked, int kpos0, int qpos) {
  int h = (threadIdx.x & 63) >> 5;
  float mx = -1e30f;
#pragma unroll
  for (int sub = 0; sub < 2; sub++)
#pragma unroll
    for (int g = 0; g < 16; g++) {
      float s = st[sub][g];
      if (masked) {
        int j = kpos0 + sub * 32 + (g & 3) + 8 * (g >> 2) + 4 * h;
        int dl = qpos - j; if (dl < 0) dl = -dl;
        if (dl > 128) s = -1e30f;
        st[sub][g] = s;
      }
      mx = fmaxf(mx, s);
    }
  mx = fmaxf(mx, __shfl_xor(mx, 32));
  float mnew = fmaxf(m, mx);
  float alpha = __expf(m - mnew);
  m = mnew;
  float ls = 0.f;
#pragma unroll
  for (int sub = 0; sub < 2; sub++)
#pragma unroll
    for (int g = 0; g < 16; g++) { float pv = __expf(st[sub][g] - mnew); st[sub][g] = pv; ls += pv; }
  l = l * alpha + ls;
#pragma unroll
  for (int ds = 0; ds < DV / 32; ds++)
#pragma unroll
    for (int g = 0; g < 16; g++) o[ds][g] *= alpha;
}

template <int DV, bool TWOK>
DEV void attn_softmax_job(const Params& p, const u16* Q, int Tq0, int qcol, const u16* kb, const u16* kb2, const u16* vb,
                          int nplain, int band_lo, int band_hi, int qpos0, bool use_sink, float sinkv,
                          f32x16 (&o)[DV / 32], char* smem) {
  int lane = threadIdx.x & 63, wave = threadIdx.x >> 6, r = lane & 31, h = lane >> 5;
  int qrow = TWOK ? (wave & 1) * 32 : wave * 32;
  bf16x8 qf[4];
#pragma unroll
  for (int kk = 0; kk < 4; kk++) qf[kk] = *(const bf16x8*)(Q + (size_t)(Tq0 + qrow + r) * 512 + qcol + kk * 16 + h * 8);
#pragma unroll
  for (int ds = 0; ds < DV / 32; ds++) zero16(o[ds]);
  float m = use_sink ? sinkv : -1e30f;
  float l = (use_sink && h == 0) ? 1.f : 0.f;
  int qpos = qpos0 + qrow + r;
  int ntot = nplain + (band_hi - band_lo);
  attn_loop<DV, TWOK>(ntot,
    [&](int ti, const u16*& kp, const u16*& kp2, const u16*& vp) {
      int key0 = (ti >= nplain) ? (256 + (band_lo + ti - nplain) * 64) : ti * 64;
      kp = kb + (size_t)key0 * 64; kp2 = kb2 + (size_t)key0 * 64; vp = vb + (size_t)key0 * DV;
    }, qf, o, smem,
    [&](int ti, f32x16 (&st)[2]) {
      bool masked = ti >= nplain;
      int kpos0 = (band_lo + ti - nplain) * 64;
      softmax_xform<DV>(st, o, m, l, masked, kpos0, qpos);
    },
    [&](int ti, int sub, f32x16& st) { softmax_xform1<DV>(st, o, m, l); });
  float lt = l + __shfl_xor(l, 32);
  float inv = 1.f / lt;
#pragma unroll
  for (int ds = 0; ds < DV / 32; ds++)
#pragma unroll
    for (int g = 0; g < 16; g++) o[ds][g] *= inv;
}
DEV void store_o64(const Params& p, const f32x16 (&o)[2], int Tq0, int mixcol) {
  int lane = threadIdx.x & 63, wave = threadIdx.x >> 6, r = lane & 31, h = lane >> 5;
  int T = Tq0 + wave * 32 + r;
#pragma unroll
  for (int ds = 0; ds < 2; ds++)
#pragma unroll
    for (int g4 = 0; g4 < 4; g4++) {
      int d0 = ds * 32 + 8 * g4 + 4 * h;
      *(uint2*)(p.MIX() + (size_t)T * 1024 + mixcol + d0) =
          make_uint2(pack2(o[ds][4 * g4], o[ds][4 * g4 + 1]), pack2(o[ds][4 * g4 + 2], o[ds][4 * g4 + 3]));
    }
}

DEV void ret_job(const Params& p, bool smp, int b, int hh, int qb, char* smem) {
  u16* sK = (u16*)smem; u16* sVT = sK + 2 * 64 * 72;
  int lane = threadIdx.x & 63, wave = threadIdx.x >> 6, r = lane & 31, h = lane >> 5;
  int L = smp ? 1024 : 256;
  int Tq0 = (smp ? 4096 + b * 1024 : b * 256) + qb * 128;
  const u16* kb = p.RK() + kvoff(smp, b, hh, 0, 8, 64, 1024, 0);
  const u16* vb = p.RV() + kvoff(smp, b, hh, 0, 8, 64, 1024, 0);
  float xf = p.rdf[hh], xb = p.rdb[hh];
  float lf2 = -log1pf(__expf(-xf)) * 1.4426950408889634f;
  float lb2 = -log1pf(__expf(-xb)) * 1.4426950408889634f;
  bf16x8 qf[4];
#pragma unroll
  for (int kk = 0; kk < 4; kk++) qf[kk] = *(const bf16x8*)(p.Q2() + (size_t)(Tq0 + wave * 32 + r) * 512 + hh * 64 + kk * 16 + h * 8);
  f32x16 o[2]; zero16(o[0]); zero16(o[1]);
  int qpos = qb * 128 + wave * 32 + r;
  int nt = L / 64;
  attn_loop<64, false>(nt,
    [&](int ti, const u16*& kp, const u16*& kp2, const u16*& vp) { kp = kb + (size_t)ti * 4096; kp2 = kp; vp = vb + (size_t)ti * 4096; },
    qf, o, smem,
    [&](int ti, f32x16 (&st)[2]) {
      int kpos0 = ti * 64;
#pragma unroll
      for (int sub = 0; sub < 2; sub++)
#pragma unroll
        for (int g = 0; g < 16; g++) {
          int j = kpos0 + sub * 32 + (g & 3) + 8 * (g >> 2) + 4 * h;
          int dl = qpos - j;
          float e = dl >= 0 ? lf2 * (float)dl : lb2 * (float)(-dl);
          st[sub][g] *= exp2f(e);
        }
    },
    [&](int ti, int sub, f32x16& st) {});
  if (smp) {
    for (int dir = 0; dir < 2; dir++) {
      const float* S0 = (dir == 0 ? p.srf : p.srb) + (size_t)(b * 8 + hh) * 4096;
      float rs = dir == 0 ? exp2f(lf2 * (float)(qpos + 1)) : exp2f(lb2 * (float)(L - qpos));
      __syncthreads();
      load_ident_k(sK);
      load_state_v(S0, sVT);
      __syncthreads();
      attn_compute<64>(qf, o, sK, sVT, [&](f32x16 (&st)[2]) {
#pragma unroll
        for (int sub = 0; sub < 2; sub++)
#pragma unroll
          for (int g = 0; g < 16; g++) st[sub][g] *= rs;
      });
    }
  }
  float sum = 0.f;
#pragma unroll
  for (int ds = 0; ds < 2; ds++)
#pragma unroll
    for (int g = 0; g < 16; g++) sum += o[ds][g];
  sum += __shfl_xor(sum, 32);
  float mean = sum * (1.f / 64.f);
  float vs = 0.f;
#pragma unroll
  for (int ds = 0; ds < 2; ds++)
#pragma unroll
    for (int g = 0; g < 16; g++) { float dlt = o[ds][g] - mean; vs += dlt * dlt; }
  vs += __shfl_xor(vs, 32);
  float rstd = rsqrtf(vs * (1.f / 64.f) + 1e-6f);
  int T = Tq0 + wave * 32 + r;
#pragma unroll
  for (int ds = 0; ds < 2; ds++)
#pragma unroll
    for (int g4 = 0; g4 < 4; g4++) {
      int d0 = ds * 32 + 8 * g4 + 4 * h;
      uint2 gt = *(const uint2*)(p.SG() + (size_t)T * 512 + hh * 64 + d0);
      float y0 = (o[ds][4 * g4] - mean) * rstd * bflo(gt.x), y1 = (o[ds][4 * g4 + 1] - mean) * rstd * bfhi(gt.x);
      float y2 = (o[ds][4 * g4 + 2] - mean) * rstd * bflo(gt.y), y3 = (o[ds][4 * g4 + 3] - mean) * rstd * bfhi(gt.y);
      *(uint2*)(p.MIX() + (size_t)T * 1024 + 512 + hh * 64 + d0) = make_uint2(pack2(y0, y1), pack2(y2, y3));
    }
}
DEV void ret_state_job(const Params& p, int b, int hh, int dir, char* smem) {
  u16* sKk = (u16*)smem; u16* sVv = sKk + 64 * 64;
  int t = threadIdx.x;
  const u16* kb = p.RK() + kvoff(false, b, hh, 0, 8, 64, 1024, 0);
  const u16* vb = p.RV() + kvoff(false, b, hh, 0, 8, 64, 1024, 0);
  float xx = dir == 0 ? p.rdf[hh] : p.rdb[hh];
  float lg2 = -log1pf(__expf(-xx)) * 1.4426950408889634f;
  int dk = t >> 2, dvc = (t & 3) * 16;
  float acc[16];
#pragma unroll
  for (int i = 0; i < 16; i++) acc[i] = 0.f;
  for (int ch = 0; ch < 4; ch++) {
    __syncthreads();
#pragma unroll
    for (int i = 0; i < 2; i++) {
      int c = t + 256 * i;
      *(uint4*)(sKk + c * 8) = *(const uint4*)(kb + (size_t)ch * 4096 + c * 8);
      *(uint4*)(sVv + c * 8) = *(const uint4*)(vb + (size_t)ch * 4096 + c * 8);
    }
    __syncthreads();
    for (int jj = 0; jj < 64; jj++) {
      int j = ch * 64 + jj;
      float w = exp2f(lg2 * (float)(dir == 0 ? 255 - j : j));
      float kv = bf2f(sKk[jj * 64 + dk]) * w;
      const uint4* vp = (const uint4*)(sVv + jj * 64 + dvc);
      uint4 v0 = vp[0], v1 = vp[1];
      acc[0] += kv * bflo(v0.x); acc[1] += kv * bfhi(v0.x); acc[2] += kv * bflo(v0.y); acc[3] += kv * bfhi(v0.y);
      acc[4] += kv * bflo(v0.z); acc[5] += kv * bfhi(v0.z); acc[6] += kv * bflo(v0.w); acc[7] += kv * bfhi(v0.w);
      acc[8] += kv * bflo(v1.x); acc[9] += kv * bfhi(v1.x); acc[10] += kv * bflo(v1.y); acc[11] += kv * bfhi(v1.y);
      acc[12] += kv * bflo(v1.z); acc[13] += kv * bfhi(v1.z); acc[14] += kv * bflo(v1.w); acc[15] += kv * bfhi(v1.w);
    }
  }
  float* dst = p.out + (dir == 0 ? OUT_RF : OUT_RB) + ((size_t)(b * 8 + hh) * 64 + dk) * 64 + dvc;
#pragma unroll
  for (int i = 0; i < 4; i++) *(float4*)(dst + 4 * i) = make_float4(acc[4 * i], acc[4 * i + 1], acc[4 * i + 2], acc[4 * i + 3]);
}

DEV void phase_attn0(const Params& p, int bid, int nb, char* smem) {
  for (int it = bid; it < 1280; it += nb) {
    if (it < 256) {
      int b = it >> 6, hq = (it >> 3) & 7, qb = it & 7; int kvh = hq >> 2;
      f32x16 o[2];
      int Tq0 = 4096 + b * 1024 + qb * 128;
      attn_softmax_job<64, false>(p, p.Q1(), Tq0, hq * 64, p.KA() + kvoff(true, b, kvh, -256, 2, 64, 1280, 256), p.KA(), p.VA() + kvoff(true, b, kvh, -256, 2, 64, 1280, 256),
                           20, 0, 0, qb * 128, false, 0.f, o, smem);
      store_o64(p, o, Tq0, hq * 64);
    } else if (it < 512) {
      int j = it - 256; int b = j >> 6, hh = (j >> 3) & 7, qb = j & 7;
      ret_job(p, true, b, hh, qb, smem);
    } else if (it < 768) {
      int j = it - 512; int b = j >> 4, hq = (j >> 1) & 7, qb = j & 1; int kvh = hq >> 2;
      f32x16 o[2];
      int Tq0 = b * 256 + qb * 128;
      attn_softmax_job<64, false>(p, p.Q1(), Tq0, hq * 64, p.KA() + kvoff(false, b, kvh, 0, 2, 64, 1280, 256), p.KA(), p.VA() + kvoff(false, b, kvh, 0, 2, 64, 1280, 256),
                           4, 0, 0, qb * 128, false, 0.f, o, smem);
      store_o64(p, o, Tq0, hq * 64);
    } else if (it < 1024) {
      int j = it - 768; int b = j >> 4, hh = (j >> 1) & 7, qb = j & 1;
      ret_job(p, false, b, hh, qb, smem);
    } else {
      int j = it - 1024; int b = j >> 4, hh = (j >> 1) & 7, dir = j & 1;
      ret_state_job(p, b, hh, dir, smem);
    }
  }
}
DEV void diff_job(const Params& p, bool smp, int b, int hh, int qb, float lam, char* smem) {
  int lane = threadIdx.x & 63, wave = threadIdx.x >> 6, r = lane & 31, h = lane >> 5;
  int c = wave >> 1;
  int Tq0 = (smp ? 4096 + b * 1024 : b * 256) + qb * 64;
  int nt = smp ? 20 : 4;
  const u16* vb = p.VC() + kvoff(smp, b, hh, smp ? -256 : 0, 4, 128, 1280, 256);
  const u16* kb0 = p.KC() + kvoff(smp, b, 2 * hh, smp ? -256 : 0, 8, 64, 1280, 256);
  const u16* kb1 = p.KC() + kvoff(smp, b, 2 * hh + 1, smp ? -256 : 0, 8, 64, 1280, 256);
  f32x16 o[4];
  attn_softmax_job<128, true>(p, p.Q1(), Tq0, (2 * hh + c) * 64, kb0, kb1, vb, nt, 0, 0, 0, false, 0.f, o, smem);
  float* ex = (float*)smem;
  if (wave >= 2) {
#pragma unroll
    for (int ds = 0; ds < 4; ds++)
#pragma unroll
      for (int g = 0; g < 16; g++) ex[(ds * 16 + g) * 128 + (threadIdx.x - 128)] = o[ds][g];
  }
  __syncthreads();
  if (wave < 2) {
    float ss = 0.f;
#pragma unroll
    for (int ds = 0; ds < 4; ds++)
#pragma unroll
      for (int g = 0; g < 16; g++) { float dv = o[ds][g] - lam * ex[(ds * 16 + g) * 128 + threadIdx.x]; o[ds][g] = dv; ss += dv * dv; }
    ss += __shfl_xor(ss, 32);
    float rstd = rsqrtf(ss * (1.f / 128.f) + 1e-6f) * (1.f - LAM_INIT);
    int T = Tq0 + wave * 32 + r;
#pragma unroll
    for (int ds = 0; ds < 4; ds++)
#pragma unroll
      for (int g4 = 0; g4 < 4; g4++) {
        int d0 = ds * 32 + 8 * g4 + 4 * h;
        float4 sg = *(const float4*)(p.subln + d0);
        *(uint2*)(p.MIX() + (size_t)T * 1024 + hh * 128 + d0) =
            make_uint2(pack2(o[ds][4 * g4] * rstd * sg.x, o[ds][4 * g4 + 1] * rstd * sg.y),
                       pack2(o[ds][4 * g4 + 2] * rstd * sg.z, o[ds][4 * g4 + 3] * rstd * sg.w));
      }
  }
}
DEV void phase_attn1(const Params& p, int bid, int nb, char* smem) {
  float d1 = 0.f, d2 = 0.f;
  for (int i = 0; i < 64; i++) { d1 += p.lq1[i] * p.lk1[i]; d2 += p.lq2[i] * p.lk2[i]; }
  float lam = __expf(d1) - __expf(d2) + LAM_INIT;
  for (int it = bid; it < 1024; it += nb) {
    if (it < 256) {
      int b = it >> 6, hh = (it >> 4) & 3, qb = it & 15;
      diff_job(p, true, b, hh, qb, lam, smem);
    } else if (it < 512) {
      int j = it - 256; int b = j >> 6, hq = (j >> 3) & 7, qb = j & 7; int kvh = hq >> 2;
      int q0 = qb * 128;
      int lo = (q0 - 128 < 0 ? 0 : q0 - 128) >> 6, hi = (q0 + 256 > 1024 ? 1024 : q0 + 256) >> 6;
      f32x16 o[2];
      int Tq0 = 4096 + b * 1024 + q0;
      attn_softmax_job<64, false>(p, p.Q2(), Tq0, hq * 64, p.KD() + kvoff(true, b, kvh, -256, 2, 64, 1280, 256), p.KD(), p.VD() + kvoff(true, b, kvh, -256, 2, 64, 1280, 256),
                           4, lo, hi, q0, true, p.dsink[hq], o, smem);
      store_o64(p, o, Tq0, 512 + hq * 64);
    } else if (it < 768) {
      int j = it - 512; int b = j >> 4, hh = (j >> 2) & 3, qb = j & 3;
      diff_job(p, false, b, hh, qb, lam, smem);
    } else {
      int j = it - 768; int b = j >> 4, hq = (j >> 1) & 7, qb = j & 1; int kvh = hq >> 2;
      f32x16 o[2];
      int Tq0 = b * 256 + qb * 128;
      attn_softmax_job<64, false>(p, p.Q2(), Tq0, hq * 64, p.KD() + kvoff(false, b, kvh, 0, 2, 64, 1280, 256), p.KD(), p.VD() + kvoff(false, b, kvh, 0, 2, 64, 1280, 256),
                           4, 0, 0, qb * 128, true, p.dsink[hq], o, smem);
      store_o64(p, o, Tq0, 512 + hq * 64);
    }
  }
}

DEV float ub0(unsigned w) { return (float)(w & 255u); }
DEV float ub1(unsigned w) { return (float)((w >> 8) & 255u); }
DEV float ub2(unsigned w) { return (float)((w >> 16) & 255u); }
DEV float ub3(unsigned w) { return (float)(w >> 24); }
DEV void phase_peer(const Params& p, int layer, int bid, int nb, char* smem) {
  int wave = threadIdx.x >> 6, lane = threadIdx.x & 63;
  float* ws1 = (float*)(smem + wave * 2048); float* ws2 = ws1 + 16;
  int* wi1 = (int*)(ws2 + 16); int* wi2 = wi1 + 16; float* es = (float*)(wi2 + 16); int* eidx = (int*)(es + 16); float* eg = (float*)(eidx + 128);
  const unsigned char* U = p.U8() + (size_t)layer * 16384 * 1024;
  const unsigned char* V = p.V8() + (size_t)layer * 16384 * 1024;
  const float* SU = p.SU() + layer * 16384; const float* SV = p.SV() + layer * 16384;
  const float* gain = p.norm_ffn + layer * 1024;
  for (int T = bid * 4 + wave; T < 8192; T += nb * 4) {
    const float* sc = p.SC() + (size_t)T * 2048;
    for (int hh = 0; hh < 8; hh++) {
      const float* s = sc + hh * 256;
      float a0 = s[lane], a1 = s[lane + 64], b0 = s[128 + lane], b1 = s[192 + lane];
      unsigned ka0 = (fkey(a0) & ~127u) | (unsigned)(127 - lane), ka1 = (fkey(a1) & ~127u) | (unsigned)(63 - lane);
      unsigned kb0 = (fkey(b0) & ~127u) | (unsigned)(127 - lane), kb1 = (fkey(b1) & ~127u) | (unsigned)(63 - lane);
      unsigned pa = 0u, pb = 0u;
      for (int bit = 31; bit >= 0; --bit) {
        unsigned ta = pa | (1u << bit), tb = pb | (1u << bit);
        int ca = __popcll(__ballot(ka0 >= ta)) + __popcll(__ballot(ka1 >= ta));
        int cb = __popcll(__ballot(kb0 >= tb)) + __popcll(__ballot(kb1 >= tb));
        if (ca >= 16) pa = ta;
        if (cb >= 16) pb = tb;
      }
      {
        unsigned long long m0 = __ballot(ka0 >= pa), m1 = __ballot(ka1 >= pa);
        int p0 = mbcnt64(m0), p1 = __popcll(m0) + mbcnt64(m1);
        if (ka0 >= pa) { ws1[p0 & 15] = a0; wi1[p0 & 15] = lane; }
        if (ka1 >= pa) { ws1[p1 & 15] = a1; wi1[p1 & 15] = lane + 64; }
        unsigned long long n0 = __ballot(kb0 >= pb), n1 = __ballot(kb1 >= pb);
        int q0 = mbcnt64(n0), q1 = __popcll(n0) + mbcnt64(n1);
        if (kb0 >= pb) { ws2[q0 & 15] = b0; wi2[q0 & 15] = lane; }
        if (kb1 >= pb) { ws2[q1 & 15] = b1; wi2[q1 & 15] = lane + 64; }
      }
      __builtin_amdgcn_fence(__ATOMIC_ACQ_REL, "wavefront");
      __builtin_amdgcn_wave_barrier();
      int bq = lane & 15, aq = lane >> 4;
      float s2v = ws2[bq];
      float c0 = ws1[aq] + s2v, c1 = ws1[aq + 4] + s2v, c2 = ws1[aq + 8] + s2v, c3 = ws1[aq + 12] + s2v;
      unsigned k0 = (fkey(c0) & ~255u) | (unsigned)(255 - lane), k1 = (fkey(c1) & ~255u) | (unsigned)(191 - lane);
      unsigned k2 = (fkey(c2) & ~255u) | (unsigned)(127 - lane), k3 = (fkey(c3) & ~255u) | (unsigned)(63 - lane);
      unsigned pc = 0u;
      for (int bit = 31; bit >= 0; --bit) {
        unsigned tc = pc | (1u << bit);
        int cc = __popcll(__ballot(k0 >= tc)) + __popcll(__ballot(k1 >= tc)) + __popcll(__ballot(k2 >= tc)) + __popcll(__ballot(k3 >= tc));
        if (cc >= 16) pc = tc;
      }
      {
        unsigned long long m0 = __ballot(k0 >= pc), m1 = __ballot(k1 >= pc), m2 = __ballot(k2 >= pc), m3 = __ballot(k3 >= pc);
        int n0 = __popcll(m0), n1 = n0 + __popcll(m1), n2 = n1 + __popcll(m2);
        int i2b = wi2[bq];
        if (k0 >= pc) { int q = mbcnt64(m0) & 15; es[q] = c0; eidx[hh * 16 + q] = wi1[aq] * 128 + i2b; }
        if (k1 >= pc) { int q = (n0 + mbcnt64(m1)) & 15; es[q] = c1; eidx[hh * 16 + q] = wi1[aq + 4] * 128 + i2b; }
        if (k2 >= pc) { int q = (n1 + mbcnt64(m2)) & 15; es[q] = c2; eidx[hh * 16 + q] = wi1[aq + 8] * 128 + i2b; }
        if (k3 >= pc) { int q = (n2 + mbcnt64(m3)) & 15; es[q] = c3; eidx[hh * 16 + q] = wi1[aq + 12] * 128 + i2b; }
      }
      __builtin_amdgcn_fence(__ATOMIC_ACQ_REL, "wavefront");
      __builtin_amdgcn_wave_barrier();
      float ts = es[lane & 15];
      float mx = row_max16(ts);
      float pe = __expf(ts - mx);
      float sm = row_sum16(pe);
      if (lane < 16) eg[hh * 16 + lane] = pe / sm;
      __builtin_amdgcn_fence(__ATOMIC_ACQ_REL, "wavefront");
      __builtin_amdgcn_wave_barrier();
    }
    int mb = T < 4096 ? 0 : 1 + ((T - 4096) >> 10);
    const float* md = p.MOD() + (size_t)(layer * 5 + mb) * 6144;
    float4 xv[4]; float ssx = 0.f;
#pragma unroll
    for (int i = 0; i < 4; i++) { xv[i] = *(const float4*)(p.X() + (size_t)T * 1024 + (i * 64 + lane) * 4); ssx += xv[i].x * xv[i].x + xv[i].y * xv[i].y + xv[i].z * xv[i].z + xv[i].w * xv[i].w; }
    ssx = wave_sum(ssx);
    float rstdx = rsqrtf(ssx * (1.f / 1024.f) + 1e-6f);
    float4 hv[4]; float hmax = 0.f;
#pragma unroll
    for (int i = 0; i < 4; i++) {
      int col = (i * 64 + lane) * 4;
      float4 g = *(const float4*)(gain + col), sh = *(const float4*)(md + 3 * 1024 + col), scl = *(const float4*)(md + 4 * 1024 + col);
      hv[i].x = xv[i].x * rstdx * g.x * (1.f + scl.x) + sh.x; hv[i].y = xv[i].y * rstdx * g.y * (1.f + scl.y) + sh.y;
      hv[i].z = xv[i].z * rstdx * g.z * (1.f + scl.z) + sh.z; hv[i].w = xv[i].w * rstdx * g.w * (1.f + scl.w) + sh.w;
      hmax = fmaxf(hmax, fmaxf(fmaxf(fabsf(hv[i].x), fabsf(hv[i].y)), fmaxf(fabsf(hv[i].z), fabsf(hv[i].w))));
    }
    hmax = wave_max_f(hmax);
    float hinv = hmax > 0.f ? 127.f / hmax : 0.f, hscale = hmax * (1.f / 127.f);
    int hq[4];
#pragma unroll
    for (int i = 0; i < 4; i++) {
      unsigned b0 = (unsigned)((int)rintf(hv[i].x * hinv)) & 255u, b1 = (unsigned)((int)rintf(hv[i].y * hinv)) & 255u;
      unsigned b2 = (unsigned)((int)rintf(hv[i].z * hinv)) & 255u, b3 = (unsigned)((int)rintf(hv[i].w * hinv)) & 255u;
      hq[i] = (int)(b0 | (b1 << 8) | (b2 << 16) | (b3 << 24));
    }
#define PLOAD8(SET, TBL, B0) _Pragma("unroll") for (int j = 0; j < 8; j++) { \
        int e_ = __builtin_amdgcn_readfirstlane(eidx[(B0) * 8 + j]); SET[j] = *(const u32x4*)(TBL + (size_t)e_ * 1024 + lane * 16); }
#define PDOT8(SET, B0) _Pragma("unroll") for (int j = 0; j < 8; j++) { \
        int d_ = __builtin_amdgcn_sdot4(hq[0], (int)SET[j][0], 0, false); d_ = __builtin_amdgcn_sdot4(hq[1], (int)SET[j][1], d_, false); \
        d_ = __builtin_amdgcn_sdot4(hq[2], (int)SET[j][2], d_, false); d_ = __builtin_amdgcn_sdot4(hq[3], (int)SET[j][3], d_, false); \
        float D_ = (float)wave_sum_i(d_); int e_ = (B0) * 8 + j; bool me_ = lane == (e_ & 63); \
        a0 = (me_ && e_ < 64) ? D_ : a0; a1 = (me_ && e_ >= 64) ? D_ : a1; }
#define PACC8(SET, B0) _Pragma("unroll") for (int j = 0; j < 8; j++) { \
        int e_ = (B0) * 8 + j; float w = rlane(e_ < 64 ? w0 : w1, e_ & 63); \
        acc[0] += w * ub0(SET[j][0]); acc[1] += w * ub1(SET[j][0]); acc[2] += w * ub2(SET[j][0]); acc[3] += w * ub3(SET[j][0]); \
        acc[4] += w * ub0(SET[j][1]); acc[5] += w * ub1(SET[j][1]); acc[6] += w * ub2(SET[j][1]); acc[7] += w * ub3(SET[j][1]); \
        acc[8] += w * ub0(SET[j][2]); acc[9] += w * ub1(SET[j][2]); acc[10] += w * ub2(SET[j][2]); acc[11] += w * ub3(SET[j][2]); \
        acc[12] += w * ub0(SET[j][3]); acc[13] += w * ub1(SET[j][3]); acc[14] += w * ub2(SET[j][3]); acc[15] += w * ub3(SET[j][3]); }
    float acc[16];
#pragma unroll
    for (int i = 0; i < 16; i++) acc[i] = 0.f;
    float a0 = 0.f, a1 = 0.f;
    u32x4 sa[8], sb[8];
    PLOAD8(sa, U, 0)
#pragma unroll 1
    for (int bi = 0; bi < 16; bi += 2) {
      PLOAD8(sb, U, bi + 1)
      PDOT8(sa, bi)
      if (bi + 2 < 16) { PLOAD8(sa, U, bi + 2) } else { PLOAD8(sa, V, 0) }
      PDOT8(sb, bi + 1)
    }
    int e0 = eidx[lane], e1 = eidx[lane + 64];
    float w0 = eg[lane] * gelu_tanh(a0 * (SU[e0] * hscale)) * SV[e0];
    float w1 = eg[lane + 64] * gelu_tanh(a1 * (SU[e1] * hscale)) * SV[e1];
    float wsum = wave_sum(w0 + w1);
#pragma unroll 1
    for (int bi = 0; bi < 16; bi += 2) {
      PLOAD8(sb, V, bi + 1)
      PACC8(sa, bi)
      if (bi + 2 < 16) { PLOAD8(sa, V, bi + 2) }
      PACC8(sb, bi + 1)
    }
    float x2[16]; float ss = 0.f;
#pragma unroll
    for (int i = 0; i < 4; i++) {
      int col = (i * 64 + lane) * 4;
      float4 ga = *(const float4*)(md + 5 * 1024 + col);
      x2[i * 4 + 0] = xv[i].x + ga.x * (acc[i * 4 + 0] - 128.f * wsum); x2[i * 4 + 1] = xv[i].y + ga.y * (acc[i * 4 + 1] - 128.f * wsum);
      x2[i * 4 + 2] = xv[i].z + ga.z * (acc[i * 4 + 2] - 128.f * wsum); x2[i * 4 + 3] = xv[i].w + ga.w * (acc[i * 4 + 3] - 128.f * wsum);
    }
#pragma unroll
    for (int i = 0; i < 16; i++) ss += x2[i] * x2[i];
    ss = wave_sum(ss);
    float rstd = rsqrtf(ss * (1.f / 1024.f) + 1e-6f);
    if (layer == 0) {
      const float* md1 = p.MOD() + (size_t)(5 + mb) * 6144;
#pragma unroll
      for (int i = 0; i < 4; i++) {
        int col = (i * 64 + lane) * 4;
        *(float4*)(p.X() + (size_t)T * 1024 + col) = make_float4(x2[i * 4], x2[i * 4 + 1], x2[i * 4 + 2], x2[i * 4 + 3]);
        float4 g = *(const float4*)(p.norm_mix + 1024 + col), sh = *(const float4*)(md1 + col), scl = *(const float4*)(md1 + 1024 + col);
        float y0 = x2[i * 4] * rstd * g.x * (1.f + scl.x) + sh.x, y1 = x2[i * 4 + 1] * rstd * g.y * (1.f + scl.y) + sh.y;
        float y2 = x2[i * 4 + 2] * rstd * g.z * (1.f + scl.z) + sh.z, y3 = x2[i * 4 + 3] * rstd * g.w * (1.f + scl.w) + sh.w;
        *(uint2*)(p.H() + (size_t)T * 1024 + col) = make_uint2(pack2(y0, y1), pack2(y2, y3));
      }
    } else {
#pragma unroll
      for (int i = 0; i < 4; i++) {
        int col = (i * 64 + lane) * 4;
        float4 g = *(const float4*)(p.norm_final + col);
        *(float4*)(p.out + (size_t)T * 1024 + col) = make_float4(x2[i * 4] * rstd * g.x, x2[i * 4 + 1] * rstd * g.y, x2[i * 4 + 2] * rstd * g.z, x2[i * 4 + 3] * rstd * g.w);
      }
    }
  }
}

#define XB_TMO      128
#define XB_XCNT(j)  (256  + 64 * (j))
#define XB_XSUB(j)  (1280 + 64 * (j))
#define XB_XGEN(j)  (2304 + 64 * (j))
#define XB_TOP      3328
#define XB_TOPGEN   3392
#define XCD_BAR_WORDS 3456
#define XB_SPIN_CAP (1u << 20)
#define LAS __attribute__((address_space(3)))
DEV unsigned xb_ld(unsigned* p)              { return __hip_atomic_load(p, __ATOMIC_RELAXED, __HIP_MEMORY_SCOPE_AGENT); }
DEV unsigned xb_add(unsigned* p, unsigned v) { return __hip_atomic_fetch_add(p, v, __ATOMIC_RELAXED, __HIP_MEMORY_SCOPE_AGENT); }
DEV unsigned xb_xcc_id() { return (unsigned)__builtin_amdgcn_s_getreg((3 << 11) | 20) & 0xFu; }
#define XB_SPIN(cond, bar) do { unsigned _sp = 0; while (cond) { __builtin_amdgcn_s_sleep(1); \
    if ((++_sp & 255u) == 0u) { if (xb_ld(&(bar)[XB_TMO])) break; if (_sp > XB_SPIN_CAP) { atomicAdd(&(bar)[XB_TMO], 1u); break; } } } } while (0)
struct XcdBarrier { unsigned* bar; unsigned x; volatile LAS unsigned* st; };
DEV XcdBarrier xcd_barrier_post(unsigned* bar, volatile LAS unsigned* st) {
  XcdBarrier b; b.bar = bar; b.x = xb_xcc_id(); b.st = st;
  if (threadIdx.x == 0) (void)xb_add(&bar[XB_XCNT(b.x)], 1u);
  return b;
}
DEV void xcd_barrier_complete(unsigned* bar, unsigned x, unsigned& nloc, unsigned& nx) {
  const unsigned G = gridDim.x * gridDim.y * gridDim.z;
  unsigned sum, cnt, mine, sp = 0u;
  for (;;) {
    sum = 0u; cnt = 0u; mine = 0u;
#pragma unroll
    for (unsigned j = 0; j < 16; ++j) { const unsigned c = xb_ld(&bar[XB_XCNT(j)]); sum += c; cnt += (c > 0u) ? 1u : 0u; mine = (j == x) ? c : mine; }
    if (sum == G) break;
    __builtin_amdgcn_s_sleep(1);
    if ((++sp & 255u) == 0u) { if (xb_ld(&bar[XB_TMO])) break; if (sp > XB_SPIN_CAP) { atomicAdd(&bar[XB_TMO], 1u); break; } }
  }
  nloc = mine > 0u ? mine : 1u; nx = cnt > 0u ? cnt : 1u;
}
DEV void xcd_barrier(const XcdBarrier& b) {
  asm volatile("s_waitcnt vmcnt(0)" ::: "memory");
  __syncthreads();
  if (threadIdx.x == 0) {
    unsigned* bar = b.bar;
    __builtin_amdgcn_s_waitcnt(0);
    unsigned nloc = b.st[0], nx = b.st[1];
    if (nloc == 0u) { xcd_barrier_complete(bar, b.x, nloc, nx); b.st[0] = nloc; b.st[1] = nx; }
    const unsigned old = xb_add(&bar[XB_XSUB(b.x)], 1u);
    const unsigned gen = old / nloc;
    if (old + 1u == (gen + 1u) * nloc) {
      __builtin_amdgcn_fence(__ATOMIC_RELEASE, "agent");
      asm volatile("s_waitcnt vmcnt(0)" ::: "memory");
      const unsigned og = xb_add(&bar[XB_TOP], 1u);
      const unsigned tg = og / nx;
      if (og + 1u == (tg + 1u) * nx) xb_add(&bar[XB_TOPGEN], 1u);
      else XB_SPIN(xb_ld(&bar[XB_TOPGEN]) == tg, bar);
      __builtin_amdgcn_fence(__ATOMIC_ACQUIRE, "agent");
      xb_add(&bar[XB_XGEN(b.x)], 1u);
      asm volatile("s_waitcnt vmcnt(0)" ::: "memory");
    } else {
      XB_SPIN(xb_ld(&bar[XB_XGEN(b.x)]) == gen, bar);
      __builtin_amdgcn_fence(__ATOMIC_ACQUIRE, "agent");
      asm volatile("s_waitcnt vmcnt(0)" ::: "memory");
    }
  }
  __syncthreads();
}

constexpr int NPHASE = 16;
DEV void run_phase(const Params& p, int ph, int bid, int nb, char* smem) {
  switch (ph) {
    case 0: phase_prep(p, bid, nb, smem); break;
    case 1: phase_ada(p, 0, p.norm_mix, 0, 1, true, bid, nb); break;
    case 2: gemm_phase(p.H(), 1024, p.WT_EVIN(), 1024, 1024, 64, 22, bid, nb, smem, [&](int m0, int n0, const float* Cs) { epi_inproj0(p, m0, n0, Cs); }); break;
    case 3: phase_attn0(p, bid, nb, smem); break;
    case 4: gemm_phase(p.MIX(), 1024, p.WT_EVOUT(), 1024, 1024, 64, 8, bid, nb, smem, [&](int m0, int n0, const float* Cs) { epi_outproj(p, 0, m0, n0, Cs); }); break;
    case 5: phase_ada(p, 0, p.norm_ffn, 3, 4, false, bid, nb); break;
    case 12: phase_ada(p, 1, p.norm_ffn + 1024, 3, 4, false, bid, nb); break;
    case 6: case 13: {
      int layer = ph == 6 ? 0 : 1;
      gemm_phase(p.H(), 1024, p.WT_PQ() + (size_t)layer * 2048 * 1024, 1024, 1024, 64, 16, bid, nb, smem, [&](int m0, int n0, const float* Cs) {
        int lane = threadIdx.x & 63, wave = threadIdx.x >> 6;
#pragma unroll 8
        for (int rr = wave; rr < 128; rr += 4) {
          float2 c = *(const float2*)(Cs + rr * 128 + lane * 2);
          *(unsigned*)(p.PQ() + (size_t)(m0 + rr) * 2048 + n0 + lane * 2) = pack2(c.x, c.y);
        }
      });
    } break;
    case 7: case 14: {
      int layer = ph == 7 ? 0 : 1;
      const u16* sk = p.SUBK() + (size_t)layer * 16 * 128 * 128;
      for (int it = bid; it < 64 * 16; it += nb) {
        int mt, hc;
        if ((nb & 7) == 0) { int li = (it - (bid & 7)) >> 3; mt = 8 * (bid & 7) + (li & 7); hc = (li >> 3) & 15; } else { mt = it >> 4; hc = it & 15; }
        f32x16 acc[2][2];
        zero16(acc[0][0]); zero16(acc[0][1]); zero16(acc[1][0]); zero16(acc[1][1]);
        gemm_tile(p.PQ() + (size_t)mt * 128 * 2048 + hc * 128, 2048, sk + (size_t)hc * 128 * 128, 128, 128, smem, acc);
        const float* Cs = (const float*)smem;
        int lane = threadIdx.x & 63, wave = threadIdx.x >> 6;
#pragma unroll 8
        for (int rr = wave; rr < 128; rr += 4) {
          float2 c = *(const float2*)(Cs + rr * 128 + lane * 2);
          *(float2*)(p.SC() + (size_t)(mt * 128 + rr) * 2048 + hc * 128 + lane * 2) = c;
        }
      }
    } break;
    case 8: phase_peer(p, 0, bid, nb, smem); break;
    case 15: phase_peer(p, 1, bid, nb, smem); break;
    case 9: gemm_phase(p.H(), 1024, p.WT_ODIN(), 1024, 1024, 64, 18, bid, nb, smem, [&](int m0, int n0, const float* Cs) { epi_inproj1(p, m0, n0, Cs); }); break;
    case 10: phase_attn1(p, bid, nb, smem); break;
    case 11: gemm_phase(p.MIX(), 1024, p.WT_ODOUT(), 1024, 1024, 64, 8, bid, nb, smem, [&](int m0, int n0, const float* Cs) { epi_outproj(p, 1, m0, n0, Cs); }); break;
    default: break;
  }
}

template <int PH> DEV void run_all(const Params& p, cg::grid_group& grid, const XcdBarrier& xb, char* smem) {
  run_phase(p, PH, blockIdx.x, gridDim.x, smem);
  if constexpr (PH + 1 < NPHASE) {
    if constexpr (PH == 0) grid.sync(); else xcd_barrier(xb);
    run_all<PH + 1>(p, grid, xb, smem);
  }
}
__global__ void __launch_bounds__(256, 2) mega_kernel(Params p) {
  __shared__ __attribute__((aligned(16))) char smem[77824];
  __shared__ uint4 xb_words;
  if (threadIdx.x == 0) xb_words = make_uint4(0u, 0u, 0u, 0u);
  __syncthreads();
  XcdBarrier xb = xcd_barrier_post(p.BAR(), (volatile LAS unsigned*)&xb_words);
  cg::grid_group grid = cg::this_grid();
  run_all<0>(p, grid, xb, smem);
}
#if MULTI_LAUNCH
template <int PH> __global__ void __launch_bounds__(256, 2) phase_kernel(Params p) {
  __shared__ __attribute__((aligned(16))) char smem[77824];
  run_phase(p, PH, blockIdx.x, gridDim.x, smem);
}
template <int PH> static void launch_all(const Params& p, int grid, hipStream_t s) {
  phase_kernel<PH><<<grid, 256, 0, s>>>(p);
  if constexpr (PH + 1 < NPHASE) launch_all<PH + 1>(p, grid, s);
}
#endif

extern "C" void kernel_launch(void* const* d_in, const int* in_sizes, int n_in, void* d_out, int out_size, void* d_ws, size_t ws_size, hipStream_t stream) {
  Params p{};
  const float* const* in = (const float* const*)d_in;
  p.xp = in[0]; p.xs = in[1]; p.c = in[2]; p.cctx = in[3]; p.cak = in[4]; p.cav = in[5]; p.srf = in[6]; p.srb = in[7];
  p.cck = in[8]; p.ccv = in[9]; p.cdk = in[10]; p.cdv = in[11];
  p.mod_w = in[12]; p.mod_b = in[13]; p.norm_mix = in[14]; p.norm_ffn = in[15]; p.norm_final = in[16];
  p.ev_w_in = in[17]; p.ev_w_out = in[18]; p.a_q_norm = in[19]; p.a_k_norm = in[20]; p.rdf = in[21]; p.rdb = in[22];
  p.od_w_in = in[23]; p.od_w_out = in[24]; p.lq1 = in[25]; p.lk1 = in[26]; p.lq2 = in[27]; p.lk2 = in[28]; p.subln = in[29]; p.dsink = in[30];
  p.peer_wq = in[31]; p.peer_sk = in[32]; p.peer_u = in[33]; p.peer_v = in[34];
  p.out = (float*)d_out;
  p.ws = (char*)d_ws;
  (void)in_sizes; (void)n_in; (void)out_size; (void)ws_size;
#if MULTI_LAUNCH
  launch_all<0>(p, 512, stream);
#else
  static int grid_blocks = 0;
  if (!grid_blocks) {
    int dev = 0, cus = 0, per_cu = 0;
    hipGetDevice(&dev);
    hipDeviceGetAttribute(&cus, hipDeviceAttributeMultiprocessorCount, dev);
    hipOccupancyMaxActiveBlocksPerMultiprocessor(&per_cu, mega_kernel, 256, 0);
    if (per_cu > 2) per_cu = 2;
    if (per_cu < 1) per_cu = 1;
    grid_blocks = cus * per_cu;
  }
  (void)hipMemsetAsync(d_ws, 0, XCD_BAR_WORDS * 4, stream);
  void* args[] = {&p};
  hipError_t e = hipLaunchCooperativeKernel((void*)mega_kernel, dim3(grid_blocks), dim3(256), args, 0, stream);
  if (e != hipSuccess) fprintf(stderr, "cooperative launch failed: %s (grid %d)\n", hipGetErrorString(e), grid_blocks);
#endif
}
```

```cpp
#include <hip/hip_runtime.h>
#include <hip/hip_cooperative_groups.h>
#include <cstdio>
namespace cg = cooperative_groups;

#ifndef MULTI_LAUNCH
#define MULTI_LAUNCH 0
#endif

typedef unsigned short u16;
typedef __attribute__((ext_vector_type(8))) short bf16x8;
typedef __attribute__((ext_vector_type(16))) float f32x16;
typedef __attribute__((ext_vector_type(4))) unsigned u32x4;

#define DEV __device__ __forceinline__

constexpr size_t OUT_AK = 8388608, OUT_AV = 8912896, OUT_RF = 9437184, OUT_RB = 9961472,
                 OUT_CK = 10485760, OUT_CV = 12582912, OUT_DK = 14680064, OUT_DV = 15204352;
constexpr float LAM_INIT = 0.35550906f;

struct Params {
  const float *xp, *xs, *c, *cctx, *cak, *cav, *srf, *srb, *cck, *ccv, *cdk, *cdv;
  const float *mod_w, *mod_b, *norm_mix, *norm_ffn, *norm_final;
  const float *ev_w_in, *ev_w_out, *a_q_norm, *a_k_norm, *rdf, *rdb;
  const float *od_w_in, *od_w_out, *lq1, *lk1, *lq2, *lk2, *subln, *dsink;
  const float *peer_wq, *peer_sk, *peer_u, *peer_v;
  float* out;
  char* ws;
  __device__ __forceinline__ unsigned* BAR() const { return (unsigned*)(ws + 0ull); }
  __device__ __forceinline__ float* MOD() const { return (float*)(ws + 13824ull); }
  __device__ __forceinline__ float* ROPEC() const { return (float*)(ws + 259584ull); }
  __device__ __forceinline__ float* ROPES() const { return (float*)(ws + 390656ull); }
  __device__ __forceinline__ float* X() const { return (float*)(ws + 521728ull); }
  __device__ __forceinline__ float* SC() const { return (float*)(ws + 34076160ull); }
  __device__ __forceinline__ u16* WT_EVIN() const { return (u16*)(ws + 101185024ull); }
  __device__ __forceinline__ u16* WT_EVOUT() const { return (u16*)(ws + 106952192ull); }
  __device__ __forceinline__ u16* WT_ODIN() const { return (u16*)(ws + 109049344ull); }
  __device__ __forceinline__ u16* WT_ODOUT() const { return (u16*)(ws + 113767936ull); }
  __device__ __forceinline__ u16* WT_PQ() const { return (u16*)(ws + 115865088ull); }
  __device__ __forceinline__ u16* SUBK() const { return (u16*)(ws + 124253696ull); }
  __device__ __forceinline__ unsigned char* U8() const { return (unsigned char*)(ws + 125302272ull); }
  __device__ __forceinline__ unsigned char* V8() const { return (unsigned char*)(ws + 158856704ull); }
  __device__ __forceinline__ float* SU() const { return (float*)(ws + 192411136ull); }
  __device__ __forceinline__ float* SV() const { return (float*)(ws + 192542208ull); }
  __device__ __forceinline__ u16* H() const { return (u16*)(ws + 192673280ull); }
  __device__ __forceinline__ u16* MIX() const { return (u16*)(ws + 209450496ull); }
  __device__ __forceinline__ u16* Q1() const { return (u16*)(ws + 226227712ull); }
  __device__ __forceinline__ u16* Q2() const { return (u16*)(ws + 234616320ull); }
  __device__ __forceinline__ u16* SG() const { return (u16*)(ws + 243004928ull); }
  __device__ __forceinline__ u16* KA() const { return (u16*)(ws + 251393536ull); }
  __device__ __forceinline__ u16* VA() const { return (u16*)(ws + 253752832ull); }
  __device__ __forceinline__ u16* RK() const { return (u16*)(ws + 256112128ull); }
  __device__ __forceinline__ u16* RV() const { return (u16*)(ws + 264500736ull); }
  __device__ __forceinline__ u16* KC() const { return (u16*)(ws + 272889344ull); }
  __device__ __forceinline__ u16* VC() const { return (u16*)(ws + 282326528ull); }
  __device__ __forceinline__ u16* KD() const { return (u16*)(ws + 291763712ull); }
  __device__ __forceinline__ u16* VD() const { return (u16*)(ws + 294123008ull); }
  __device__ __forceinline__ u16* PQ() const { return (u16*)(ws + 296482304ull); }
};

DEV u16 f2bf(float f) { unsigned u = __float_as_uint(f); u += 0x7fffu + ((u >> 16) & 1u); return (u16)(u >> 16); }
DEV float bf2f(unsigned b) { return __uint_as_float(b << 16); }
DEV unsigned pack2(float a, float b) { return (unsigned)f2bf(a) | ((unsigned)f2bf(b) << 16); }
DEV float bflo(unsigned w) { return __uint_as_float(w << 16); }
DEV float bfhi(unsigned w) { return __uint_as_float(w & 0xffff0000u); }
DEV float silu_f(float v) { return v / (1.f + __expf(-v)); }
DEV float gelu_tanh(float a) {
  float z = 0.7978845608f * (a + 0.044715f * a * a * a);
  float e = __expf(2.f * z);
  float th = 1.f - 2.f / (e + 1.f);
  return 0.5f * a * (1.f + th);
}
template <int CTRL> DEV float dpp_f(float v) {
  return __int_as_float(__builtin_amdgcn_update_dpp(0, __float_as_int(v), CTRL, 0xF, 0xF, true));
}
template <int CTRL> DEV unsigned dpp_u(unsigned v) {
  return (unsigned)__builtin_amdgcn_update_dpp(0, (int)v, CTRL, 0xF, 0xF, true);
}
DEV float row_sum16(float v) {
  v += dpp_f<0xB1>(v); v += dpp_f<0x4E>(v); v += dpp_f<0x141>(v); v += dpp_f<0x140>(v); return v;
}
DEV float row_max16(float v) {
  v = fmaxf(v, dpp_f<0xB1>(v)); v = fmaxf(v, dpp_f<0x4E>(v)); v = fmaxf(v, dpp_f<0x141>(v)); v = fmaxf(v, dpp_f<0x140>(v)); return v;
}
DEV float rlane(float v, int l) { return __int_as_float(__builtin_amdgcn_readlane(__float_as_int(v), l)); }
DEV float wave_sum(float v) {
  v = row_sum16(v);
  return (rlane(v, 0) + rlane(v, 16)) + (rlane(v, 32) + rlane(v, 48));
}
DEV unsigned wave_max_u(unsigned v) {
  v = max(v, dpp_u<0xB1>(v)); v = max(v, dpp_u<0x4E>(v)); v = max(v, dpp_u<0x141>(v)); v = max(v, dpp_u<0x140>(v));
  unsigned a = (unsigned)__builtin_amdgcn_readlane((int)v, 0), b = (unsigned)__builtin_amdgcn_readlane((int)v, 16);
  unsigned c = (unsigned)__builtin_amdgcn_readlane((int)v, 32), d = (unsigned)__builtin_amdgcn_readlane((int)v, 48);
  return max(max(a, b), max(c, d));
}
DEV float half_sum32(float v) { v = row_sum16(v); return v + __shfl_xor(v, 16); }
DEV unsigned fkey(float f) { unsigned u = __float_as_uint(f); return (u & 0x80000000u) ? ~u : (u | 0x80000000u); }
DEV f32x16 mfma32(bf16x8 a, bf16x8 b, f32x16 c) { return __builtin_amdgcn_mfma_f32_32x32x16_bf16(a, b, c, 0, 0, 0); }
DEV void zero16(f32x16& v) {
#pragma unroll
  for (int i = 0; i < 16; i++) v[i] = 0.f;
}
DEV size_t kvoff(bool smp, int b, int hh, int tpos, int H, int DW, int LS, int off) {
  return smp ? (size_t)4096 * H * DW + ((size_t)(b * H + hh) * LS + off + tpos) * DW
             : ((size_t)(b * H + hh) * 256 + tpos) * DW;
}


DEV float wave_max_f(float v) {
  v = row_max16(v);
  return fmaxf(fmaxf(rlane(v, 0), rlane(v, 16)), fmaxf(rlane(v, 32), rlane(v, 48)));
}
DEV int wave_sum_i(int v) {
  v += (int)dpp_u<0xB1>((unsigned)v); v += (int)dpp_u<0x4E>((unsigned)v); v += (int)dpp_u<0x141>((unsigned)v); v += (int)dpp_u<0x140>((unsigned)v);
  return (__builtin_amdgcn_readlane(v, 0) + __builtin_amdgcn_readlane(v, 16)) + (__builtin_amdgcn_readlane(v, 32) + __builtin_amdgcn_readlane(v, 48));
}
DEV int mbcnt64(unsigned long long m) { return (int)__builtin_amdgcn_mbcnt_hi((unsigned)(m >> 32), __builtin_amdgcn_mbcnt_lo((unsigned)m, 0u)); }
template <bool SGN> DEV void prep_quant(const float* __restrict__ src, unsigned char* __restrict__ dst, float* __restrict__ scale, int row0) {
  int lane = threadIdx.x & 63, wave = threadIdx.x >> 6;
  int rbase = row0 + wave * 4;
  float4 v[4][4];
#pragma unroll
  for (int q = 0; q < 4; q++)
#pragma unroll
    for (int i = 0; i < 4; i++) v[q][i] = *(const float4*)(src + (size_t)(rbase + q) * 1024 + (i * 64 + lane) * 4);
#pragma unroll
  for (int q = 0; q < 4; q++) {
    float mx = 0.f;
#pragma unroll
    for (int i = 0; i < 4; i++) mx = fmaxf(mx, fmaxf(fmaxf(fabsf(v[q][i].x), fabsf(v[q][i].y)), fmaxf(fabsf(v[q][i].z), fabsf(v[q][i].w))));
    mx = wave_max_f(mx);
    float inv = mx > 0.f ? 127.f / mx : 0.f;
    unsigned w[4];
#pragma unroll
    for (int i = 0; i < 4; i++) {
      int off = SGN ? 0 : 128;
      unsigned b0 = (unsigned)((int)rintf(v[q][i].x * inv) + off) & 255u, b1 = (unsigned)((int)rintf(v[q][i].y * inv) + off) & 255u;
      unsigned b2 = (unsigned)((int)rintf(v[q][i].z * inv) + off) & 255u, b3 = (unsigned)((int)rintf(v[q][i].w * inv) + off) & 255u;
      w[i] = b0 | (b1 << 8) | (b2 << 16) | (b3 << 24);
    }
    *(uint4*)(dst + (size_t)(rbase + q) * 1024 + lane * 16) = make_uint4(w[0], w[1], w[2], w[3]);
    if (lane == 0) scale[rbase + q] = mx * (1.f / 127.f);
  }
}

DEV void prep_transpose(const float* __restrict__ W, int N, u16* __restrict__ Wt, int tile, float* sm) {
  int ntn = N >> 6; int kt = tile / ntn, nt = tile % ntn;
  int k0 = kt * 64, n0 = nt * 64; int t = threadIdx.x;
#pragma unroll
  for (int i = 0; i < 4; i++) {
    int k = (t >> 4) + 16 * i; int c4 = (t & 15) * 4;
    float4 v = *(const float4*)(W + (size_t)(k0 + k) * N + n0 + c4);
    sm[k * 65 + c4] = v.x; sm[k * 65 + c4 + 1] = v.y; sm[k * 65 + c4 + 2] = v.z; sm[k * 65 + c4 + 3] = v.w;
  }
  __syncthreads();
  int n = t >> 2, kc = (t & 3) * 16;
  unsigned pk[8];
#pragma unroll
  for (int j = 0; j < 8; j++) pk[j] = pack2(sm[(kc + 2 * j) * 65 + n], sm[(kc + 2 * j + 1) * 65 + n]);
  uint4* dst = (uint4*)(Wt + (size_t)(n0 + n) * 1024 + k0 + kc);
  dst[0] = make_uint4(pk[0], pk[1], pk[2], pk[3]);
  dst[1] = make_uint4(pk[4], pk[5], pk[6], pk[7]);
  __syncthreads();
}
DEV void conv_item(const float* __restrict__ src, u16* __restrict__ dst) {
  int t = threadIdx.x;
#pragma unroll
  for (int i = 0; i < 8; i++) {
    int e = (i * 256 + t) * 8;
    float4 a = *(const float4*)(src + e), b = *(const float4*)(src + e + 4);
    *(uint4*)(dst + e) = make_uint4(pack2(a.x, a.y), pack2(a.z, a.w), pack2(b.x, b.y), pack2(b.z, b.w));
  }
}
DEV void prep_mod(const Params& p, int it, float* sm) {
  int l = it / 96, n0 = (it % 96) * 64; int t = threadIdx.x;
  float* sc = sm;
  for (int i = t; i < 5120; i += 256) {
    int b = i >> 10, k = i & 1023;
    float v = (b == 0) ? p.cctx[k] : p.c[(b - 1) * 1024 + k];
    sc[i] = silu_f(v);
  }
  __syncthreads();
  int col = t & 63, kg = t >> 6;
  float a0 = 0, a1 = 0, a2 = 0, a3 = 0, a4 = 0;
  const float* w = p.mod_w + (size_t)l * 1024 * 6144 + n0 + col;
  for (int k0 = kg; k0 < 1024; k0 += 32) {
    float wv[8];
#pragma unroll
    for (int u = 0; u < 8; u++) wv[u] = w[(size_t)(k0 + 4 * u) * 6144];
#pragma unroll
    for (int u = 0; u < 8; u++) {
      int k = k0 + 4 * u;
      a0 += sc[k] * wv[u]; a1 += sc[1024 + k] * wv[u]; a2 += sc[2048 + k] * wv[u]; a3 += sc[3072 + k] * wv[u]; a4 += sc[4096 + k] * wv[u];
    }
  }
  float* red = sm + 5120;
  red[(kg * 5 + 0) * 64 + col] = a0; red[(kg * 5 + 1) * 64 + col] = a1; red[(kg * 5 + 2) * 64 + col] = a2;
  red[(kg * 5 + 3) * 64 + col] = a3; red[(kg * 5 + 4) * 64 + col] = a4;
  __syncthreads();
  if (t < 64) {
#pragma unroll
    for (int b = 0; b < 5; b++) {
      float s = red[(0 * 5 + b) * 64 + t] + red[(1 * 5 + b) * 64 + t] + red[(2 * 5 + b) * 64 + t] + red[(3 * 5 + b) * 64 + t];
      p.MOD()[(size_t)(l * 5 + b) * 6144 + n0 + t] = s + p.mod_b[l * 6144 + n0 + t];
    }
  }
  __syncthreads();
}
DEV void prep_cache(const Params& p, int it) {
  const float* src; u16* dst;
  if (it < 8)       { int ch = it;      src = p.cak + (size_t)ch * 16384; dst = p.KA() + (size_t)4096 * 2 * 64 + (size_t)ch * 1280 * 64; }
  else if (it < 16) { int ch = it - 8;  src = p.cav + (size_t)ch * 16384; dst = p.VA() + (size_t)4096 * 2 * 64 + (size_t)ch * 1280 * 64; }
  else if (it < 48) { int ch = it - 16; src = p.cck + (size_t)ch * 16384; dst = p.KC() + (size_t)4096 * 8 * 64 + (size_t)ch * 1280 * 64; }
  else if (it < 80) { int ch = (it - 48) >> 1, hf = (it - 48) & 1;
                      src = p.ccv + (size_t)ch * 32768 + hf * 16384; dst = p.VC() + (size_t)4096 * 4 * 128 + (size_t)ch * 1280 * 128 + hf * 16384; }
  else if (it < 88) { int ch = it - 80; src = p.cdk + (size_t)ch * 16384; dst = p.KD() + (size_t)4096 * 2 * 64 + (size_t)ch * 1280 * 64; }
  else              { int ch = it - 88; src = p.cdv + (size_t)ch * 16384; dst = p.VD() + (size_t)4096 * 2 * 64 + (size_t)ch * 1280 * 64; }
  conv_item(src, dst);
}
DEV void prep_rope(const Params& p, int it) {
  for (int i = 0; i < 16; i++) {
    int idx = it * 4096 + i * 256 + threadIdx.x;
    int tpos = idx >> 5, a = idx & 31;
    float pos = (a < 16) ? (float)(tpos >> 6) : (float)(tpos & 63);
    float inv = exp2f(-(float)(a & 15) * (13.287712379549449f / 16.f));
    float ang = pos * inv;
    p.ROPEC()[idx] = __cosf(ang); p.ROPES()[idx] = __sinf(ang);
  }
}
constexpr int PREP_T0 = 704, PREP_T1 = PREP_T0 + 256, PREP_T2 = PREP_T1 + 576, PREP_T3 = PREP_T2 + 256, PREP_T4 = PREP_T3 + 1024;
constexpr int PREP_U = PREP_T4 + 2048, PREP_V = PREP_U + 2048, PREP_SK = PREP_V + 32, PREP_CA = PREP_SK + 96, PREP_RO = PREP_CA + 8, PREP_MOD = PREP_RO + 192;
DEV void phase_prep(const Params& p, int bid, int nb, char* smem) {
  float* sm = (float*)smem;
  for (int it0 = bid; it0 < PREP_MOD; it0 += nb) {
    int it = (it0 < 192) ? (PREP_RO + it0) : (it0 - 192);
    if (it >= PREP_T4 && it < PREP_V) continue;
    if (it < PREP_T0) prep_transpose(p.ev_w_in, 2816, p.WT_EVIN(), it, sm);
    else if (it < PREP_T1) prep_transpose(p.ev_w_out, 1024, p.WT_EVOUT(), it - PREP_T0, sm);
    else if (it < PREP_T2) prep_transpose(p.od_w_in, 2304, p.WT_ODIN(), it - PREP_T1, sm);
    else if (it < PREP_T3) prep_transpose(p.od_w_out, 1024, p.WT_ODOUT(), it - PREP_T2, sm);
    else if (it < PREP_T4) { int j = it - PREP_T3; int l = j >> 9; prep_transpose(p.peer_wq + (size_t)l * 1024 * 2048, 2048, p.WT_PQ() + (size_t)l * 2048 * 1024, j & 511, sm); }
    else if (it < PREP_V) { }
    else if (it < PREP_SK) { size_t o = (size_t)(it - PREP_V) * 16384; conv_item(p.peer_sk + o, p.SUBK() + o); }
    else if (it < PREP_CA) prep_cache(p, it - PREP_SK);
    else if (it < PREP_RO) prep_rope(p, it - PREP_CA);
    else prep_mod(p, it - PREP_RO, sm);
  }
}

DEV void phase_ada(const Params& p, int layer, const float* __restrict__ gain, int shift_i, int scale_i, bool from_input, int bid, int nb) {
  int wave = threadIdx.x >> 6, lane = threadIdx.x & 63;
  for (int T0 = (bid * 4 + wave) * 2; T0 < 8192; T0 += nb * 8) {
    float4 v[2][4]; float ss[2];
#pragma unroll
    for (int q = 0; q < 2; q++) {
      int T = T0 + q;
      const float* xr = from_input ? (T < 4096 ? p.xp + (size_t)T * 1024 : p.xs + (size_t)(T - 4096) * 1024) : p.X() + (size_t)T * 1024;
#pragma unroll
      for (int i = 0; i < 4; i++) v[q][i] = *(const float4*)(xr + (i * 64 + lane) * 4);
    }
    int mb = T0 < 4096 ? 0 : 1 + ((T0 - 4096) >> 10);
    const float* md = p.MOD() + (size_t)(layer * 5 + mb) * 6144;
    float4 g[4], sh[4], sc[4];
#pragma unroll
    for (int i = 0; i < 4; i++) {
      int col = (i * 64 + lane) * 4;
      g[i] = *(const float4*)(gain + col); sh[i] = *(const float4*)(md + shift_i * 1024 + col); sc[i] = *(const float4*)(md + scale_i * 1024 + col);
    }
#pragma unroll
    for (int q = 0; q < 2; q++) {
      float s2 = 0.f;
#pragma unroll
      for (int i = 0; i < 4; i++) s2 += v[q][i].x * v[q][i].x + v[q][i].y * v[q][i].y + v[q][i].z * v[q][i].z + v[q][i].w * v[q][i].w;
      ss[q] = wave_sum(s2);
    }
#pragma unroll
    for (int q = 0; q < 2; q++) {
      float rstd = rsqrtf(ss[q] * (1.f / 1024.f) + 1e-6f);
#pragma unroll
      for (int i = 0; i < 4; i++) {
        int col = (i * 64 + lane) * 4;
        float y0 = v[q][i].x * rstd * g[i].x * (1.f + sc[i].x) + sh[i].x, y1 = v[q][i].y * rstd * g[i].y * (1.f + sc[i].y) + sh[i].y;
        float y2 = v[q][i].z * rstd * g[i].z * (1.f + sc[i].z) + sh[i].z, y3 = v[q][i].w * rstd * g[i].w * (1.f + sc[i].w) + sh[i].w;
        *(uint2*)(p.H() + (size_t)(T0 + q) * 1024 + col) = make_uint2(pack2(y0, y1), pack2(y2, y3));
      }
    }
  }
}

#define GLOAD8(PA, PB) \
  ra0 = *(const u32x4*)(PA); ra1 = *(const u32x4*)((PA) + sa32); ra2 = *(const u32x4*)((PA) + 2 * sa32); ra3 = *(const u32x4*)((PA) + 3 * sa32); \
  rb0 = *(const u32x4*)(PB); rb1 = *(const u32x4*)((PB) + sb32); rb2 = *(const u32x4*)((PB) + 2 * sb32); rb3 = *(const u32x4*)((PB) + 3 * sb32);
#define GLOAD8N(PA, PB) \
  na0 = *(const u32x4*)(PA); na1 = *(const u32x4*)((PA) + sa32); na2 = *(const u32x4*)((PA) + 2 * sa32); na3 = *(const u32x4*)((PA) + 3 * sa32); \
  nb0 = *(const u32x4*)(PB); nb1 = *(const u32x4*)((PB) + sb32); nb2 = *(const u32x4*)((PB) + 2 * sb32); nb3 = *(const u32x4*)((PB) + 3 * sb32);
#define GSTORE8(BUF) { u16* wa_ = (u16*)(smem + (BUF) * 36864) + lrow * 72 + lkc; u16* wb_ = wa_ + 128 * 72; \
  *(u32x4*)(wa_) = ra0; *(u32x4*)(wa_ + 32 * 72) = ra1; *(u32x4*)(wa_ + 64 * 72) = ra2; *(u32x4*)(wa_ + 96 * 72) = ra3; \
  *(u32x4*)(wb_) = rb0; *(u32x4*)(wb_ + 32 * 72) = rb1; *(u32x4*)(wb_ + 64 * 72) = rb2; *(u32x4*)(wb_ + 96 * 72) = rb3; }
DEV void gemm_tile(const u16* __restrict__ A, int lda, const u16* __restrict__ B, int ldb, int K, char* smem, f32x16 (&acc)[2][2]) {
  int t = threadIdx.x, lane = t & 63, wave = t >> 6, r = lane & 31, h = lane >> 5;
  int wm = wave >> 1, wn = wave & 1;
  int lrow = t >> 3, lkc = (t & 7) * 8;
  const u16* ap = A + (size_t)lrow * lda + lkc;
  const u16* bp = B + (size_t)lrow * ldb + lkc;
  size_t sa32 = (size_t)32 * lda, sb32 = (size_t)32 * ldb;
  u32x4 ra0, ra1, ra2, ra3, rb0, rb1, rb2, rb3;
  u32x4 na0, na1, na2, na3, nb0, nb1, nb2, nb3;
  int nk = K >> 6;
#define GSTORE8N(BUF) { u16* wa_ = (u16*)(smem + (BUF) * 36864) + lrow * 72 + lkc; u16* wb_ = wa_ + 128 * 72; \
  *(u32x4*)(wa_) = na0; *(u32x4*)(wa_ + 32 * 72) = na1; *(u32x4*)(wa_ + 64 * 72) = na2; *(u32x4*)(wa_ + 96 * 72) = na3; \
  *(u32x4*)(wb_) = nb0; *(u32x4*)(wb_ + 32 * 72) = nb1; *(u32x4*)(wb_ + 64 * 72) = nb2; *(u32x4*)(wb_ + 96 * 72) = nb3; }
#define GCOMPUTE(BUF) { const u16* sA = (const u16*)(smem + (BUF) * 36864); const u16* sB = sA + 128 * 72; \
    _Pragma("unroll") for (int kk = 0; kk < 4; kk++) { \
      bf16x8 a0 = *(const bf16x8*)(sA + (wm * 64 + r) * 72 + kk * 16 + h * 8); \
      bf16x8 a1 = *(const bf16x8*)(sA + (wm * 64 + 32 + r) * 72 + kk * 16 + h * 8); \
      bf16x8 b0 = *(const bf16x8*)(sB + (wn * 64 + r) * 72 + kk * 16 + h * 8); \
      bf16x8 b1 = *(const bf16x8*)(sB + (wn * 64 + 32 + r) * 72 + kk * 16 + h * 8); \
      acc[0][0] = mfma32(a0, b0, acc[0][0]); acc[0][1] = mfma32(a0, b1, acc[0][1]); \
      acc[1][0] = mfma32(a1, b0, acc[1][0]); acc[1][1] = mfma32(a1, b1, acc[1][1]); } }
  GLOAD8(ap, bp)
  __syncthreads();
  GSTORE8(0)
  if (nk > 1) { GLOAD8(ap + 64, bp + 64) }
  na0 = ra0; na1 = ra1; na2 = ra2; na3 = ra3; nb0 = rb0; nb1 = rb1; nb2 = rb2; nb3 = rb3;
  __syncthreads();
  for (int kt = 0; kt < nk; kt += 2) {
    if (kt + 2 < nk) { GLOAD8N(ap + (kt + 2) * 64, bp + (kt + 2) * 64) }
    GCOMPUTE(0)
    if (kt + 1 < nk) { GSTORE8(1) }
    __syncthreads();
    if (kt + 1 < nk) {
      if (kt + 3 < nk) { GLOAD8(ap + (kt + 3) * 64, bp + (kt + 3) * 64) }
      GCOMPUTE(1)
      if (kt + 2 < nk) { GSTORE8N(0) }
      __syncthreads();
    }
  }
  __syncthreads();
  float* Cs = (float*)smem;
#pragma unroll
  for (int i = 0; i < 2; i++)
#pragma unroll
    for (int j = 0; j < 2; j++)
#pragma unroll
      for (int g = 0; g < 16; g++)
        Cs[(wm * 64 + i * 32 + (g & 3) + 8 * (g >> 2) + 4 * h) * 128 + wn * 64 + j * 32 + r] = acc[i][j][g];
  __syncthreads();
}

DEV bool xcd_tile(int li, int bid, int NTl, int& mt, int& nt) {
  if (li >= 8 * NTl) return false;
  mt = 8 * (bid & 7) + (li & 7); nt = li >> 3; return true;
}
template <class Epi>
DEV void gemm_phase(const u16* A, int lda, const u16* Bt, int ldb, int K, int MT, int NTl, int bid, int nb, char* smem, Epi epi) {
  if ((nb & 7) == 0 && MT == 64) {
    int mt, nt;
    for (int li = bid >> 3; xcd_tile(li, bid, NTl, mt, nt); li += nb >> 3) {
      f32x16 acc[2][2];
      zero16(acc[0][0]); zero16(acc[0][1]); zero16(acc[1][0]); zero16(acc[1][1]);
      gemm_tile(A + (size_t)mt * 128 * lda, lda, Bt + (size_t)nt * 128 * ldb, ldb, K, smem, acc);
      epi(mt * 128, nt * 128, (const float*)smem);
    }
  } else {
    for (int it = bid; it < MT * NTl; it += nb) {
      int mt = it / NTl, nt = it % NTl;
      f32x16 acc[2][2];
      zero16(acc[0][0]); zero16(acc[0][1]); zero16(acc[1][0]); zero16(acc[1][1]);
      gemm_tile(A + (size_t)mt * 128 * lda, lda, Bt + (size_t)nt * 128 * ldb, ldb, K, smem, acc);
      epi(mt * 128, nt * 128, (const float*)smem);
    }
  }
}

DEV void tok_decode(int T, bool& smp, int& b, int& tpos) {
  smp = T >= 4096;
  if (!smp) { b = T >> 8; tpos = T & 255; } else { b = (T - 4096) >> 10; tpos = (T - 4096) & 1023; }
}
DEV void rope_pair(const Params& p, float& x, float& y, int tpos, int d) {
  float px = __shfl_xor(x, 16), py = __shfl_xor(y, 16);
  int a = d & 31;
  float c0 = p.ROPEC()[tpos * 32 + a], c1 = p.ROPEC()[tpos * 32 + a + 1];
  float s0 = p.ROPES()[tpos * 32 + a], s1 = p.ROPES()[tpos * 32 + a + 1];
  if (d < 32) { x = x * c0 - px * s0; y = y * c1 - py * s1; }
  else        { x = px * s0 + x * c0; y = py * s1 + y * c1; }
}

DEV void rope_apply(float& x, float& y, float4 cs, int d) {
  float px = __shfl_xor(x, 16), py = __shfl_xor(y, 16);
  if (d < 32) { x = x * cs.x - px * cs.z; y = y * cs.y - py * cs.w; }
  else        { x = px * cs.z + x * cs.x; y = py * cs.w + y * cs.y; }
}
DEV float4 rope_cs(const Params& p, int tpos, int d) {
  int a = d & 31;
  float2 c = *(const float2*)(p.ROPEC() + tpos * 32 + a), s = *(const float2*)(p.ROPES() + tpos * 32 + a);
  return make_float4(c.x, c.y, s.x, s.y);
}
template <int SEG, bool SMP>
DEV void epi0_rows(const Params& p, int m0, int n0, const float* Cs) {
  int lane = threadIdx.x & 63, wave = threadIdx.x >> 6;
  int col = n0 + lane * 2; int d = col & 63;
  float g0 = 1.f, g1 = 1.f;
  if (SEG == 0) { g0 = p.a_q_norm[d]; g1 = p.a_q_norm[d + 1]; }
  if (SEG == 1) { g0 = p.a_k_norm[d]; g1 = p.a_k_norm[d + 1]; }
  int segbase = SEG == 0 ? 0 : SEG == 1 ? 512 : SEG == 2 ? 640 : SEG == 3 ? 768 : SEG == 4 ? 1280 : SEG == 5 ? 1792 : 2304;
  int hh = (col - segbase) >> 6;
#pragma unroll 4
  for (int i = 0; i < 32; i++) {
    int rr = wave + 4 * i;
    int T = m0 + rr;
    int b = SMP ? (T - 4096) >> 10 : T >> 8;
    int tpos = SMP ? (T - 4096) & 1023 : T & 255;
    float2 c = *(const float2*)(Cs + rr * 128 + lane * 2);
    if (SEG <= 1) {
      float4 cs = make_float4(1.f, 1.f, 0.f, 0.f);
      if (SMP) cs = rope_cs(p, tpos, d);
      float ss = half_sum32(c.x * c.x + c.y * c.y);
      float rstd = rsqrtf(ss * (1.f / 64.f) + 1e-6f);
      c.x *= rstd * g0; c.y *= rstd * g1;
      if (SMP) rope_apply(c.x, c.y, cs, d);
    }
    if (SEG == 0) *(unsigned*)(p.Q1() + (size_t)T * 512 + col) = pack2(c.x * 0.125f, c.y * 0.125f);
    if (SEG == 1) {
      *(unsigned*)(p.KA() + kvoff(SMP, b, hh, tpos, 2, 64, 1280, 256) + d) = pack2(c.x, c.y);
      if (!SMP) *(float2*)(p.out + OUT_AK + ((size_t)(b * 2 + hh) * 256 + tpos) * 64 + d) = c;
    }
    if (SEG == 2) {
      *(unsigned*)(p.VA() + kvoff(SMP, b, hh, tpos, 2, 64, 1280, 256) + d) = pack2(c.x, c.y);
      if (!SMP) *(float2*)(p.out + OUT_AV + ((size_t)(b * 2 + hh) * 256 + tpos) * 64 + d) = c;
    }
    if (SEG == 3) *(unsigned*)(p.Q2() + (size_t)T * 512 + (col - 768)) = pack2(c.x, c.y);
    if (SEG == 4) *(unsigned*)(p.RK() + kvoff(SMP, b, hh, tpos, 8, 64, 1024, 0) + d) = pack2(c.x * 0.125f, c.y * 0.125f);
    if (SEG == 5) *(unsigned*)(p.RV() + kvoff(SMP, b, hh, tpos, 8, 64, 1024, 0) + d) = pack2(c.x, c.y);
    if (SEG == 6) *(unsigned*)(p.SG() + (size_t)T * 512 + (col - 2304)) = pack2(silu_f(c.x), silu_f(c.y));
  }
}
template <bool SMP> DEV void epi0_disp(const Params& p, int m0, int n0, const float* Cs) {
  if (n0 < 512) epi0_rows<0, SMP>(p, m0, n0, Cs);
  else if (n0 < 640) epi0_rows<1, SMP>(p, m0, n0, Cs);
  else if (n0 < 768) epi0_rows<2, SMP>(p, m0, n0, Cs);
  else if (n0 < 1280) epi0_rows<3, SMP>(p, m0, n0, Cs);
  else if (n0 < 1792) epi0_rows<4, SMP>(p, m0, n0, Cs);
  else if (n0 < 2304) epi0_rows<5, SMP>(p, m0, n0, Cs);
  else epi0_rows<6, SMP>(p, m0, n0, Cs);
}
DEV void epi_inproj0(const Params& p, int m0, int n0, const float* Cs) {
  if (m0 >= 4096) epi0_disp<true>(p, m0, n0, Cs); else epi0_disp<false>(p, m0, n0, Cs);
}
template <int SEG, bool SMP>
DEV void epi1_rows(const Params& p, int m0, int n0, const float* Cs) {
  int lane = threadIdx.x & 63, wave = threadIdx.x >> 6;
  int col = n0 + lane * 2; int d = col & 63;
  int segbase = SEG == 0 ? 0 : SEG == 1 ? 512 : SEG == 2 ? 1024 : SEG == 3 ? 1536 : SEG == 4 ? 2048 : 2176;
  int hh = (SEG == 2) ? (col - segbase) >> 7 : (col - segbase) >> 6;
  int dd = (col - 1024) & 127;
  constexpr bool ROPE = SMP && (SEG == 0 || SEG == 1 || SEG == 3 || SEG == 4);
#pragma unroll 4
  for (int i = 0; i < 32; i++) {
    int rr = wave + 4 * i;
    int T = m0 + rr;
    int b = SMP ? (T - 4096) >> 10 : T >> 8;
    int tpos = SMP ? (T - 4096) & 1023 : T & 255;
    float2 c = *(const float2*)(Cs + rr * 128 + lane * 2);
    if (!SMP) {
      if (SEG == 1) *(float2*)(p.out + OUT_CK + ((size_t)(b * 8 + hh) * 256 + tpos) * 64 + d) = c;
      if (SEG == 2) *(float2*)(p.out + OUT_CV + ((size_t)(b * 4 + hh) * 256 + tpos) * 128 + dd) = c;
      if (SEG == 4) *(float2*)(p.out + OUT_DK + ((size_t)(b * 2 + hh) * 256 + tpos) * 64 + d) = c;
      if (SEG == 5) *(float2*)(p.out + OUT_DV + ((size_t)(b * 2 + hh) * 256 + tpos) * 64 + d) = c;
    }
    if (ROPE) { float4 cs = rope_cs(p, tpos, d); rope_apply(c.x, c.y, cs, d); }
    if (SEG == 0) *(unsigned*)(p.Q1() + (size_t)T * 512 + col) = pack2(c.x * 0.125f, c.y * 0.125f);
    if (SEG == 1) *(unsigned*)(p.KC() + kvoff(SMP, b, hh, tpos, 8, 64, 1280, 256) + d) = pack2(c.x, c.y);
    if (SEG == 2) *(unsigned*)(p.VC() + kvoff(SMP, b, hh, tpos, 4, 128, 1280, 256) + dd) = pack2(c.x, c.y);
    if (SEG == 3) *(unsigned*)(p.Q2() + (size_t)T * 512 + (col - 1536)) = pack2(c.x * 0.125f, c.y * 0.125f);
    if (SEG == 4) *(unsigned*)(p.KD() + kvoff(SMP, b, hh, tpos, 2, 64, 1280, 256) + d) = pack2(c.x, c.y);
    if (SEG == 5) *(unsigned*)(p.VD() + kvoff(SMP, b, hh, tpos, 2, 64, 1280, 256) + d) = pack2(c.x, c.y);
  }
}
template <bool SMP> DEV void epi1_disp(const Params& p, int m0, int n0, const float* Cs) {
  if (n0 < 512) epi1_rows<0, SMP>(p, m0, n0, Cs);
  else if (n0 < 1024) epi1_rows<1, SMP>(p, m0, n0, Cs);
  else if (n0 < 1536) epi1_rows<2, SMP>(p, m0, n0, Cs);
  else if (n0 < 2048) epi1_rows<3, SMP>(p, m0, n0, Cs);
  else if (n0 < 2176) epi1_rows<4, SMP>(p, m0, n0, Cs);
  else epi1_rows<5, SMP>(p, m0, n0, Cs);
}
DEV void epi_inproj1(const Params& p, int m0, int n0, const float* Cs) {
  if (m0 >= 4096) epi1_disp<true>(p, m0, n0, Cs); else epi1_disp<false>(p, m0, n0, Cs);
}
DEV void epi_outproj(const Params& p, int layer, int m0, int n0, const float* Cs) {
  int lane = threadIdx.x & 63, wave = threadIdx.x >> 6;
  int mb = m0 < 4096 ? 0 : 1 + ((m0 - 4096) >> 10);
  int col = n0 + lane * 2;
  float2 g = *(const float2*)(p.MOD() + (size_t)(layer * 5 + mb) * 6144 + 2048 + col);
  const float* xbase = (layer == 0) ? (m0 < 4096 ? p.xp + (size_t)m0 * 1024 : p.xs + (size_t)(m0 - 4096) * 1024) : p.X() + (size_t)m0 * 1024;
#pragma unroll 8
  for (int i = 0; i < 32; i++) {
    int rr = wave + 4 * i;
    float2 c = *(const float2*)(Cs + rr * 128 + lane * 2);
    float2 x = *(const float2*)(xbase + (size_t)rr * 1024 + col);
    x.x += g.x * c.x; x.y += g.y * c.y;
    *(float2*)(p.X() + (size_t)(m0 + rr) * 1024 + col) = x;
  }
}

constexpr int ATT_BUF = 37888;
struct TileRegs { u32x4 k0, k1, k2, k3, v0, v1, v2, v3; };
template <int DV, bool TWOK> DEV TileRegs tile_load(const u16* __restrict__ k, const u16* __restrict__ k2, const u16* __restrict__ v) {
  int t = threadIdx.x, lane = t & 63, wave = t >> 6;
  TileRegs R;
  u32x4 z = {0u, 0u, 0u, 0u};
  R.k0 = *(const u32x4*)(k + t * 8); R.k1 = *(const u32x4*)(k + (t + 256) * 8);
  if (TWOK) { R.k2 = *(const u32x4*)(k2 + t * 8); R.k3 = *(const u32x4*)(k2 + (t + 256) * 8); } else { R.k2 = z; R.k3 = z; }
  R.v0 = *(const u32x4*)(v + (size_t)lane * DV + wave * 8); R.v1 = *(const u32x4*)(v + (size_t)lane * DV + (wave + 4) * 8);
  if (DV == 128) { R.v2 = *(const u32x4*)(v + (size_t)lane * DV + (wave + 8) * 8); R.v3 = *(const u32x4*)(v + (size_t)lane * DV + (wave + 12) * 8); } else { R.v2 = z; R.v3 = z; }
  return R;
}
DEV void store8t(u16* d, u32x4 x) {
  d[0 * 76] = (u16)(x[0] & 0xffff); d[1 * 76] = (u16)(x[0] >> 16);
  d[2 * 76] = (u16)(x[1] & 0xffff); d[3 * 76] = (u16)(x[1] >> 16);
  d[4 * 76] = (u16)(x[2] & 0xffff); d[5 * 76] = (u16)(x[2] >> 16);
  d[6 * 76] = (u16)(x[3] & 0xffff); d[7 * 76] = (u16)(x[3] >> 16);
}
template <int DV, bool TWOK> DEV void tile_store(const TileRegs R, char* buf) {
  int t = threadIdx.x, lane = t & 63, wave = t >> 6;
  u16* sK = (u16*)buf; u16* sK2 = sK + 64 * 72; u16* sVT = sK + 2 * 64 * 72;
  int key = t >> 3, dc = t & 7;
  *(u32x4*)(sK + key * 72 + dc * 8) = R.k0; *(u32x4*)(sK + (key + 32) * 72 + dc * 8) = R.k1;
  if (TWOK) { *(u32x4*)(sK2 + key * 72 + dc * 8) = R.k2; *(u32x4*)(sK2 + (key + 32) * 72 + dc * 8) = R.k3; }
  store8t(sVT + (wave * 8) * 76 + lane, R.v0); store8t(sVT + ((wave + 4) * 8) * 76 + lane, R.v1);
  if (DV == 128) { store8t(sVT + ((wave + 8) * 8) * 76 + lane, R.v2); store8t(sVT + ((wave + 12) * 8) * 76 + lane, R.v3); }
}
DEV void load_ident_k(u16* sK) {
  int t = threadIdx.x;
#pragma unroll
  for (int i = 0; i < 2; i++) {
    int c = t + 256 * i; int key = c >> 3, dc = c & 7;
    unsigned w[4] = {0u, 0u, 0u, 0u};
    uint4 z = make_uint4(0u, 0u, 0u, 0u);
    if (dc == (key >> 3)) {
      int e = key & 7; unsigned one = (e & 1) ? 0x3F800000u : 0x00003F80u;
      if ((e >> 1) == 0) z.x = one; else if ((e >> 1) == 1) z.y = one; else if ((e >> 1) == 2) z.z = one; else z.w = one;
    }
    (void)w;
    *(uint4*)(sK + key * 72 + dc * 8) = z;
  }
}
DEV void load_state_v(const float* __restrict__ S0, u16* sVT) {
  int lane = threadIdx.x & 63, wave = threadIdx.x >> 6;
#pragma unroll
  for (int i = 0; i < 2; i++) {
    int dc = wave + 4 * i;
    float4 a = *(const float4*)(S0 + lane * 64 + dc * 8), b = *(const float4*)(S0 + lane * 64 + dc * 8 + 4);
    u16* d = sVT + (dc * 8) * 76 + lane;
    d[0 * 76] = f2bf(a.x); d[1 * 76] = f2bf(a.y); d[2 * 76] = f2bf(a.z); d[3 * 76] = f2bf(a.w);
    d[4 * 76] = f2bf(b.x); d[5 * 76] = f2bf(b.y); d[6 * 76] = f2bf(b.z); d[7 * 76] = f2bf(b.w);
  }
}
template <int DV, class F>
DEV void attn_compute(const bf16x8 (&qf)[4], f32x16 (&o)[DV / 32], const u16* sK, const u16* sVT, F&& xform) {
  int lane = threadIdx.x & 63, r = lane & 31, h = lane >> 5;
  f32x16 st[2]; zero16(st[0]); zero16(st[1]);
#pragma unroll
  for (int sub = 0; sub < 2; sub++)
#pragma unroll
    for (int kk = 0; kk < 4; kk++) {
      bf16x8 kf = *(const bf16x8*)(sK + (sub * 32 + r) * 72 + kk * 16 + h * 8);
      st[sub] = mfma32(kf, qf[kk], st[sub]);
    }
  xform(st);
  bf16x8 pf[2][2];
#pragma unroll
  for (int sub = 0; sub < 2; sub++)
#pragma unroll
    for (int s = 0; s < 2; s++) {
      u32x4 w;
      w[0] = pack2(st[sub][8 * s + 0], st[sub][8 * s + 1]); w[1] = pack2(st[sub][8 * s + 2], st[sub][8 * s + 3]);
      w[2] = pack2(st[sub][8 * s + 4], st[sub][8 * s + 5]); w[3] = pack2(st[sub][8 * s + 6], st[sub][8 * s + 7]);
      pf[sub][s] = __builtin_bit_cast(bf16x8, w);
    }
#pragma unroll
  for (int ds = 0; ds < DV / 32; ds++)
#pragma unroll
    for (int sub = 0; sub < 2; sub++)
#pragma unroll
      for (int s = 0; s < 2; s++) {
        const u16* vp = sVT + (ds * 32 + r) * 76 + sub * 32 + s * 16 + 4 * h;
        uint2 lo = *(const uint2*)vp, hi = *(const uint2*)(vp + 8);
        u32x4 w; w[0] = lo.x; w[1] = lo.y; w[2] = hi.x; w[3] = hi.y;
        o[ds] = mfma32(__builtin_bit_cast(bf16x8, w), pf[sub][s], o[ds]);
      }
}
template <int DV, class F>
DEV void attn_compute_sub(const bf16x8 (&qf)[4], f32x16 (&o)[DV / 32], const u16* sK, const u16* sVT, F&& xform) {
  int lane = threadIdx.x & 63, r = lane & 31, h = lane >> 5;
#pragma unroll
  for (int sub = 0; sub < 2; sub++) {
    f32x16 st; zero16(st);
#pragma unroll
    for (int kk = 0; kk < 4; kk++) {
      bf16x8 kf = *(const bf16x8*)(sK + (sub * 32 + r) * 72 + kk * 16 + h * 8);
      st = mfma32(kf, qf[kk], st);
    }
    xform(sub, st);
    bf16x8 pf[2];
#pragma unroll
    for (int s2 = 0; s2 < 2; s2++) {
      u32x4 w;
      w[0] = pack2(st[8 * s2 + 0], st[8 * s2 + 1]); w[1] = pack2(st[8 * s2 + 2], st[8 * s2 + 3]);
      w[2] = pack2(st[8 * s2 + 4], st[8 * s2 + 5]); w[3] = pack2(st[8 * s2 + 6], st[8 * s2 + 7]);
      pf[s2] = __builtin_bit_cast(bf16x8, w);
    }
#pragma unroll
    for (int ds = 0; ds < DV / 32; ds++)
#pragma unroll
      for (int s2 = 0; s2 < 2; s2++) {
        const u16* vp = sVT + (ds * 32 + r) * 76 + sub * 32 + s2 * 16 + 4 * h;
        uint2 lo = *(const uint2*)vp, hi = *(const uint2*)(vp + 8);
        u32x4 w; w[0] = lo.x; w[1] = lo.y; w[2] = hi.x; w[3] = hi.y;
        o[ds] = mfma32(__builtin_bit_cast(bf16x8, w), pf[s2], o[ds]);
      }
  }
}
template <int DV>
DEV void softmax_xform1(f32x16& st, f32x16 (&o)[DV / 32], float& m, float& l) {
  float mx = -1e30f;
#pragma unroll
  for (int g = 0; g < 16; g++) mx = fmaxf(mx, st[g]);
  mx = fmaxf(mx, __shfl_xor(mx, 32));
  float mnew = fmaxf(m, mx);
  float alpha = __expf(m - mnew);
  m = mnew;
  float ls = 0.f;
#pragma unroll
  for (int g = 0; g < 16; g++) { float pv = __expf(st[g] - mnew); st[g] = pv; ls += pv; }
  l = l * alpha + ls;
#pragma unroll
  for (int ds = 0; ds < DV / 32; ds++)
#pragma unroll
    for (int g = 0; g < 16; g++) o[ds][g] *= alpha;
}
template <int DV, bool TWOK, class PF, class XF, class XF1>
DEV void attn_loop(int n, PF&& ptrs, const bf16x8 (&qf)[4], f32x16 (&o)[DV / 32], char* smem, XF&& xf, XF1&& xf1) {
  int wave = threadIdx.x >> 6;
  int kofs = (TWOK && wave >= 2) ? 64 * 72 : 0;
  TileRegs R;
  const u16 *kp, *kp2, *vp;
  ptrs(0, kp, kp2, vp); R = tile_load<DV, TWOK>(kp, kp2, vp);
  __syncthreads();
  tile_store<DV, TWOK>(R, smem);
  if (n > 1) { ptrs(1, kp, kp2, vp); R = tile_load<DV, TWOK>(kp, kp2, vp); }
  __syncthreads();
  const u16* b0k = (const u16*)smem + kofs; const u16* b0v = (const u16*)smem + 2 * 64 * 72;
  const u16* b1k = (const u16*)(smem + ATT_BUF) + kofs; const u16* b1v = (const u16*)(smem + ATT_BUF) + 2 * 64 * 72;
  for (int ti = 0; ti < n; ti++) {
    const u16* bk = (ti & 1) ? b1k : b0k; const u16* bv = (ti & 1) ? b1v : b0v;
    if constexpr (DV == 128) attn_compute_sub<DV>(qf, o, bk, bv, [&](int sub, f32x16& st) { xf1(ti, sub, st); });
    else attn_compute<DV>(qf, o, bk, bv, [&](f32x16 (&st)[2]) { xf(ti, st); });
    if (ti + 1 < n) tile_store<DV, TWOK>(R, smem + ((ti + 1) & 1) * ATT_BUF);
    if (ti + 2 < n) { ptrs(ti + 2, kp, kp2, vp); R = tile_load<DV, TWOK>(kp, kp2, vp); }
    __syncthreads();
  }
}
template <int DV>
DEV void softmax_xform(f32x16 (&st)[2], f32x16 (&o)[DV / 32], float& m, float& l, bool masked, int kpos0, int qpos) {
  int h = (threadIdx.x & 63) >> 5;
  float mx = -1e30f;
#pragma unroll
  for (int sub = 0; sub < 2; sub++)
#pragma unroll
    for (int g = 0; g < 16; g++) {
      float s = st[sub][g];
      if (masked) {
        int j = kpos0 + sub * 32 + (g & 3) + 8 * (g >> 2) + 4 * h;
        int dl = qpos - j; if (dl < 0) dl = -dl;
        if (dl > 128) s = -1e30f;
        st[sub][g] = s;
      }
      mx = fmaxf(mx, s);
    }
  mx = fmaxf(mx, __shfl_xor(mx, 32));
  float mnew = fmaxf(m, mx);
  float alpha = __expf(m - mnew);
  m = mnew;
  float ls = 0.f;
#pragma unroll
  for (int sub = 0; sub < 2; sub++)
#pragma unroll
    for (int g = 0; g < 16; g++) { float pv = __expf(st[sub][g] - mnew); st[sub][g] = pv; ls += pv; }
  l = l * alpha + ls;
#pragma unroll
  for (int ds = 0; ds < DV / 32; ds++)
#pragma unroll
    for (int g = 0; g < 16; g++) o[ds][g] *= alpha;
}

template <int DV, bool TWOK>
DEV void attn_softmax_job(const Params& p, const u16* Q, int Tq0, int qcol, const u16* kb, const u16* kb2, const u16* vb,
                          int nplain, int band_lo, int band_hi, int qpos0, bool use_sink, float sinkv,
                          f32x16 (&o)[DV / 32], char* smem) {
  int lane = threadIdx.x & 63, wave = threadIdx.x >> 6, r = lane & 31, h = lane >> 5;
  int qrow = TWOK ? (wave & 1) * 32 : wave * 32;
  bf16x8 qf[4];
#pragma unroll
  for (int kk = 0; kk < 4; kk++) qf[kk] = *(const bf16x8*)(Q + (size_t)(Tq0 + qrow + r) * 512 + qcol + kk * 16 + h * 8);
#pragma unroll
  for (int ds = 0; ds < DV / 32; ds++) zero16(o[ds]);
  float m = use_sink ? sinkv : -1e30f;
  float l = (use_sink && h == 0) ? 1.f : 0.f;
  int qpos = qpos0 + qrow + r;
  int ntot = nplain + (band_hi - band_lo);
  attn_loop<DV, TWOK>(ntot,
    [&](int ti, const u16*& kp, const u16*& kp2, const u16*& vp) {
      int key0 = (ti >= nplain) ? (256 + (band_lo + ti - nplain) * 64) : ti * 64;
      kp = kb + (size_t)key0 * 64; kp2 = kb2 + (size_t)key0 * 64; vp = vb + (size_t)key0 * DV;
    }, qf, o, smem,
    [&](int ti, f32x16 (&st)[2]) {
      bool masked = ti >= nplain;
      int kpos0 = (band_lo + ti - nplain) * 64;
      softmax_xform<DV>(st, o, m, l, masked, kpos0, qpos);
    },
    [&](int ti, int sub, f32x16& st) { softmax_xform1<DV>(st, o, m, l); });
  float lt = l + __shfl_xor(l, 32);
  float inv = 1.f / lt;
#pragma unroll
  for (int ds = 0; ds < DV / 32; ds++)
#pragma unroll
    for (int g = 0; g < 16; g++) o[ds][g] *= inv;
}
DEV void store_o64(const Params& p, const f32x16 (&o)[2], int Tq0, int mixcol) {
  int lane = threadIdx.x & 63, wave = threadIdx.x >> 6, r = lane & 31, h = lane >> 5;
  int T = Tq0 + wave * 32 + r;
#pragma unroll
  for (int ds = 0; ds < 2; ds++)
#pragma unroll
    for (int g4 = 0; g4 < 4; g4++) {
      int d0 = ds * 32 + 8 * g4 + 4 * h;
      *(uint2*)(p.MIX() + (size_t)T * 1024 + mixcol + d0) =
          make_uint2(pack2(o[ds][4 * g4], o[ds][4 * g4 + 1]), pack2(o[ds][4 * g4 + 2], o[ds][4 * g4 + 3]));
    }
}

DEV void ret_job(const Params& p, bool smp, int b, int hh, int qb, char* smem) {
  u16* sK = (u16*)smem; u16* sVT = sK + 2 * 64 * 72;
  int lane = threadIdx.x & 63, wave = threadIdx.x >> 6, r = lane & 31, h = lane >> 5;
  int L = smp ? 1024 : 256;
  int Tq0 = (smp ? 4096 + b * 1024 : b * 256) + qb * 128;
  const u16* kb = p.RK() + kvoff(smp, b, hh, 0, 8, 64, 1024, 0);
  const u16* vb = p.RV() + kvoff(smp, b, hh, 0, 8, 64, 1024, 0);
  float xf = p.rdf[hh], xb = p.rdb[hh];
  float lf2 = -log1pf(__expf(-xf)) * 1.4426950408889634f;
  float lb2 = -log1pf(__expf(-xb)) * 1.4426950408889634f;
  bf16x8 qf[4];
#pragma unroll
  for (int kk = 0; kk < 4; kk++) qf[kk] = *(const bf16x8*)(p.Q2() + (size_t)(Tq0 + wave * 32 + r) * 512 + hh * 64 + kk * 16 + h * 8);
  f32x16 o[2]; zero16(o[0]); zero16(o[1]);
  int qpos = qb * 128 + wave * 32 + r;
  int nt = L / 64;
  attn_loop<64, false>(nt,
    [&](int ti, const u16*& kp, const u16*& kp2, const u16*& vp) { kp = kb + (size_t)ti * 4096; kp2 = kp; vp = vb + (size_t)ti * 4096; },
    qf, o, smem,
    [&](int ti, f32x16 (&st)[2]) {
      int kpos0 = ti * 64;
#pragma unroll
      for (int sub = 0; sub < 2; sub++)
#pragma unroll
        for (int g = 0; g < 16; g++) {
          int j = kpos0 + sub * 32 + (g & 3) + 8 * (g >> 2) + 4 * h;
          int dl = qpos - j;
          float e = dl >= 0 ? lf2 * (float)dl : lb2 * (float)(-dl);
          st[sub][g] *= exp2f(e);
        }
    },
    [&](int ti, int sub, f32x16& st) {});
  if (smp) {
    for (int dir = 0; dir < 2; dir++) {
      const float* S0 = (dir == 0 ? p.srf : p.srb) + (size_t)(b * 8 + hh) * 4096;
      float rs = dir == 0 ? exp2f(lf2 * (float)(qpos + 1)) : exp2f(lb2 * (float)(L - qpos));
      __syncthreads();
      load_ident_k(sK);
      load_state_v(S0, sVT);
      __syncthreads();
      attn_compute<64>(qf, o, sK, sVT, [&](f32x16 (&st)[2]) {
#pragma unroll
        for (int sub = 0; sub < 2; sub++)
#pragma unroll
          for (int g = 0; g < 16; g++) st[sub][g] *= rs;
      });
    }
  }
  float sum = 0.f;
#pragma unroll
  for (int ds = 0; ds < 2; ds++)
#pragma unroll
    for (int g = 0; g < 16; g++) sum += o[ds][g];
  sum += __shfl_xor(sum, 32);
  float mean = sum * (1.f / 64.f);
  float vs = 0.f;
#pragma unroll
  for (int ds = 0; ds < 2; ds++)
#pragma unroll
    for (int g = 0; g < 16; g++) { float dlt = o[ds][g] - mean; vs += dlt * dlt; }
  vs += __shfl_xor(vs, 32);
  float rstd = rsqrtf(vs * (1.f / 64.f) + 1e-6f);
  int T = Tq0 + wave * 32 + r;
#pragma unroll
  for (int ds = 0; ds < 2; ds++)
#pragma unroll
    for (int g4 = 0; g4 < 4; g4++) {
      int d0 = ds * 32 + 8 * g4 + 4 * h;
      uint2 gt = *(const uint2*)(p.SG() + (size_t)T * 512 + hh * 64 + d0);
      float y0 = (o[ds][4 * g4] - mean) * rstd * bflo(gt.x), y1 = (o[ds][4 * g4 + 1] - mean) * rstd * bfhi(gt.x);
      float y2 = (o[ds][4 * g4 + 2] - mean) * rstd * bflo(gt.y), y3 = (o[ds][4 * g4 + 3] - mean) * rstd * bfhi(gt.y);
      *(uint2*)(p.MIX() + (size_t)T * 1024 + 512 + hh * 64 + d0) = make_uint2(pack2(y0, y1), pack2(y2, y3));
    }
}
DEV void ret_state_job(const Params& p, int b, int hh, int dir, char* smem) {
  u16* sKk = (u16*)smem; u16* sVv = sKk + 64 * 64;
  int t = threadIdx.x;
  const u16* kb = p.RK() + kvoff(false, b, hh, 0, 8, 64, 1024, 0);
  const u16* vb = p.RV() + kvoff(false, b, hh, 0, 8, 64, 1024, 0);
  float xx = dir == 0 ? p.rdf[hh] : p.rdb[hh];
  float lg2 = -log1pf(__expf(-xx)) * 1.4426950408889634f;
  int dk = t >> 2, dvc = (t & 3) * 16;
  float acc[16];
#pragma unroll
  for (int i = 0; i < 16; i++) acc[i] = 0.f;
  for (int ch = 0; ch < 4; ch++) {
    __syncthreads();
#pragma unroll
    for (int i = 0; i < 2; i++) {
      int c = t + 256 * i;
      *(uint4*)(sKk + c * 8) = *(const uint4*)(kb + (size_t)ch * 4096 + c * 8);
      *(uint4*)(sVv + c * 8) = *(const uint4*)(vb + (size_t)ch * 4096 + c * 8);
    }
    __syncthreads();
    for (int jj = 0; jj < 64; jj++) {
      int j = ch * 64 + jj;
      float w = exp2f(lg2 * (float)(dir == 0 ? 255 - j : j));
      float kv = bf2f(sKk[jj * 64 + dk]) * w;
      const uint4* vp = (const uint4*)(sVv + jj * 64 + dvc);
      uint4 v0 = vp[0], v1 = vp[1];
      acc[0] += kv * bflo(v0.x); acc[1] += kv * bfhi(v0.x); acc[2] += kv * bflo(v0.y); acc[3] += kv * bfhi(v0.y);
      acc[4] += kv * bflo(v0.z); acc[5] += kv * bfhi(v0.z); acc[6] += kv * bflo(v0.w); acc[7] += kv * bfhi(v0.w);
      acc[8] += kv * bflo(v1.x); acc[9] += kv * bfhi(v1.x); acc[10] += kv * bflo(v1.y); acc[11] += kv * bfhi(v1.y);
      acc[12] += kv * bflo(v1.z); acc[13] += kv * bfhi(v1.z); acc[14] += kv * bflo(v1.w); acc[15] += kv * bfhi(v1.w);
    }
  }
  float* dst = p.out + (dir == 0 ? OUT_RF : OUT_RB) + ((size_t)(b * 8 + hh) * 64 + dk) * 64 + dvc;
#pragma unroll
  for (int i = 0; i < 4; i++) *(float4*)(dst + 4 * i) = make_float4(acc[4 * i], acc[4 * i + 1], acc[4 * i + 2], acc[4 * i + 3]);
}

DEV void phase_attn0(const Params& p, int bid, int nb, char* smem) {
  for (int it = bid; it < 1280 + 2048; it += nb) {
    if (it >= 1280) {
      int j = it - 1280;
      if (j < 1024) prep_quant<true>(p.peer_u, p.U8(), p.SU(), j * 16); else prep_quant<false>(p.peer_v, p.V8(), p.SV(), (j - 1024) * 16);
    } else if (it < 256) {
      int b = it >> 6, hq = (it >> 3) & 7, qb = it & 7; int kvh = hq >> 2;
      f32x16 o[2];
      int Tq0 = 4096 + b * 1024 + qb * 128;
      attn_softmax_job<64, false>(p, p.Q1(), Tq0, hq * 64, p.KA() + kvoff(true, b, kvh, -256, 2, 64, 1280, 256), p.KA(), p.VA() + kvoff(true, b, kvh, -256, 2, 64, 1280, 256),
                           20, 0, 0, qb * 128, false, 0.f, o, smem);
      store_o64(p, o, Tq0, hq * 64);
    } else if (it < 512) {
      int j = it - 256; int b = j >> 6, hh = (j >> 3) & 7, qb = j & 7;
      ret_job(p, true, b, hh, qb, smem);
    } else if (it < 768) {
      int j = it - 512; int b = j >> 4, hq = (j >> 1) & 7, qb = j & 1; int kvh = hq >> 2;
      f32x16 o[2];
      int Tq0 = b * 256 + qb * 128;
      attn_softmax_job<64, false>(p, p.Q1(), Tq0, hq * 64, p.KA() + kvoff(false, b, kvh, 0, 2, 64, 1280, 256), p.KA(), p.VA() + kvoff(false, b, kvh, 0, 2, 64, 1280, 256),
                           4, 0, 0, qb * 128, false, 0.f, o, smem);
      store_o64(p, o, Tq0, hq * 64);
    } else if (it < 1024) {
      int j = it - 768; int b = j >> 4, hh = (j >> 1) & 7, qb = j & 1;
      ret_job(p, false, b, hh, qb, smem);
    } else {
      int j = it - 1024; int b = j >> 4, hh = (j >> 1) & 7, dir = j & 1;
      ret_state_job(p, b, hh, dir, smem);
    }
  }
}
DEV void diff_job(const Params& p, bool smp, int b, int hh, int qb, float lam, char* smem) {
  int lane = threadIdx.x & 63, wave = threadIdx.x >> 6, r = lane & 31, h = lane >> 5;
  int c = wave >> 1;
  int Tq0 = (smp ? 4096 + b * 1024 : b * 256) + qb * 64;
  int nt = smp ? 20 : 4;
  const u16* vb = p.VC() + kvoff(smp, b, hh, smp ? -256 : 0, 4, 128, 1280, 256);
  const u16* kb0 = p.KC() + kvoff(smp, b, 2 * hh, smp ? -256 : 0, 8, 64, 1280, 256);
  const u16* kb1 = p.KC() + kvoff(smp, b, 2 * hh + 1, smp ? -256 : 0, 8, 64, 1280, 256);
  f32x16 o[4];
  attn_softmax_job<128, true>(p, p.Q1(), Tq0, (2 * hh + c) * 64, kb0, kb1, vb, nt, 0, 0, 0, false, 0.f, o, smem);
  float* ex = (float*)smem;
  if (wave >= 2) {
#pragma unroll
    for (int ds = 0; ds < 4; ds++)
#pragma unroll
      for (int g = 0; g < 16; g++) ex[(ds * 16 + g) * 128 + (threadIdx.x - 128)] = o[ds][g];
  }
  __syncthreads();
  if (wave < 2) {
    float ss = 0.f;
#pragma unroll
    for (int ds = 0; ds < 4; ds++)
#pragma unroll
      for (int g = 0; g < 16; g++) { float dv = o[ds][g] - lam * ex[(ds * 16 + g) * 128 + threadIdx.x]; o[ds][g] = dv; ss += dv * dv; }
    ss += __shfl_xor(ss, 32);
    float rstd = rsqrtf(ss * (1.f / 128.f) + 1e-6f) * (1.f - LAM_INIT);
    int T = Tq0 + wave * 32 + r;
#pragma unroll
    for (int ds = 0; ds < 4; ds++)
#pragma unroll
      for (int g4 = 0; g4 < 4; g4++) {
        int d0 = ds * 32 + 8 * g4 + 4 * h;
        float4 sg = *(const float4*)(p.subln + d0);
        *(uint2*)(p.MIX() + (size_t)T * 1024 + hh * 128 + d0) =
            make_uint2(pack2(o[ds][4 * g4] * rstd * sg.x, o[ds][4 * g4 + 1] * rstd * sg.y),
                       pack2(o[ds][4 * g4 + 2] * rstd * sg.z, o[ds][4 * g4 + 3] * rstd * sg.w));
      }
  }
}
DEV void phase_attn1(const Params& p, int bid, int nb, char* smem) {
  float d1 = 0.f, d2 = 0.f;
  for (int i = 0; i < 64; i++) { d1 += p.lq1[i] * p.lk1[i]; d2 += p.lq2[i] * p.lk2[i]; }
  float lam = __expf(d1) - __expf(d2) + LAM_INIT;
  for (int it = bid; it < 1024 + 2048; it += nb) {
    if (it >= 1024) {
      int j = it - 1024;
      if (j < 1024) prep_quant<true>(p.peer_u, p.U8(), p.SU(), 16384 + j * 16); else prep_quant<false>(p.peer_v, p.V8(), p.SV(), 16384 + (j - 1024) * 16);
    } else if (it < 256) {
      int b = it >> 6, hh = (it >> 4) & 3, qb = it & 15;
      diff_job(p, true, b, hh, qb, lam, smem);
    } else if (it < 512) {
      int j = it - 256; int b = j >> 6, hq = (j >> 3) & 7, qb = j & 7; int kvh = hq >> 2;
      int q0 = qb * 128;
      int lo = (q0 - 128 < 0 ? 0 : q0 - 128) >> 6, hi = (q0 + 256 > 1024 ? 1024 : q0 + 256) >> 6;
      f32x16 o[2];
      int Tq0 = 4096 + b * 1024 + q0;
      attn_softmax_job<64, false>(p, p.Q2(), Tq0, hq * 64, p.KD() + kvoff(true, b, kvh, -256, 2, 64, 1280, 256), p.KD(), p.VD() + kvoff(true, b, kvh, -256, 2, 64, 1280, 256),
                           4, lo, hi, q0, true, p.dsink[hq], o, smem);
      store_o64(p, o, Tq0, 512 + hq * 64);
    } else if (it < 768) {
      int j = it - 512; int b = j >> 4, hh = (j >> 2) & 3, qb = j & 3;
      diff_job(p, false, b, hh, qb, lam, smem);
    } else {
      int j = it - 768; int b = j >> 4, hq = (j >> 1) & 7, qb = j & 1; int kvh = hq >> 2;
      f32x16 o[2];
      int Tq0 = b * 256 + qb * 128;
      attn_softmax_job<64, false>(p, p.Q2(), Tq0, hq * 64, p.KD() + kvoff(false, b, kvh, 0, 2, 64, 1280, 256), p.KD(), p.VD() + kvoff(false, b, kvh, 0, 2, 64, 1280, 256),
                           4, 0, 0, qb * 128, true, p.dsink[hq], o, smem);
      store_o64(p, o, Tq0, 512 + hq * 64);
    }
  }
}

DEV float ub0(unsigned w) { return (float)(w & 255u); }
DEV float ub1(unsigned w) { return (float)((w >> 8) & 255u); }
DEV float ub2(unsigned w) { return (float)((w >> 16) & 255u); }
DEV float ub3(unsigned w) { return (float)(w >> 24); }
DEV void phase_peer(const Params& p, int layer, int bid, int nb, char* smem) {
  int wave = threadIdx.x >> 6, lane = threadIdx.x & 63;
  float* ws1 = (float*)(smem + wave * 2048); float* ws2 = ws1 + 16;
  int* wi1 = (int*)(ws2 + 16); int* wi2 = wi1 + 16; float* es = (float*)(wi2 + 16); int* eidx = (int*)(es + 16); float* eg = (float*)(eidx + 128);
  const unsigned char* U = p.U8() + (size_t)layer * 16384 * 1024;
  const unsigned char* V = p.V8() + (size_t)layer * 16384 * 1024;
  const float* SU = p.SU() + layer * 16384; const float* SV = p.SV() + layer * 16384;
  const float* gain = p.norm_ffn + layer * 1024;
  for (int T = bid * 4 + wave; T < 8192; T += nb * 4) {
    const float* sc = p.SC() + (size_t)T * 2048;
    for (int hh = 0; hh < 8; hh++) {
      const float* s = sc + hh * 256;
      float a0 = s[lane], a1 = s[lane + 64], b0 = s[128 + lane], b1 = s[192 + lane];
      unsigned ka0 = (fkey(a0) & ~127u) | (unsigned)(127 - lane), ka1 = (fkey(a1) & ~127u) | (unsigned)(63 - lane);
      unsigned kb0 = (fkey(b0) & ~127u) | (unsigned)(127 - lane), kb1 = (fkey(b1) & ~127u) | (unsigned)(63 - lane);
      unsigned pa = 0u, pb = 0u;
      for (int bit = 31; bit >= 0; --bit) {
        unsigned ta = pa | (1u << bit), tb = pb | (1u << bit);
        int ca = __popcll(__ballot(ka0 >= ta)) + __popcll(__ballot(ka1 >= ta));
        int cb = __popcll(__ballot(kb0 >= tb)) + __popcll(__ballot(kb1 >= tb));
        if (ca >= 16) pa = ta;
        if (cb >= 16) pb = tb;
      }
      {
        unsigned long long m0 = __ballot(ka0 >= pa), m1 = __ballot(ka1 >= pa);
        int p0 = mbcnt64(m0), p1 = __popcll(m0) + mbcnt64(m1);
        if (ka0 >= pa) { ws1[p0 & 15] = a0; wi1[p0 & 15] = lane; }
        if (ka1 >= pa) { ws1[p1 & 15] = a1; wi1[p1 & 15] = lane + 64; }
        unsigned long long n0 = __ballot(kb0 >= pb), n1 = __ballot(kb1 >= pb);
        int q0 = mbcnt64(n0), q1 = __popcll(n0) + mbcnt64(n1);
        if (kb0 >= pb) { ws2[q0 & 15] = b0; wi2[q0 & 15] = lane; }
        if (kb1 >= pb) { ws2[q1 & 15] = b1; wi2[q1 & 15] = lane + 64; }
      }
      __builtin_amdgcn_fence(__ATOMIC_ACQ_REL, "wavefront");
      __builtin_amdgcn_wave_barrier();
      int bq = lane & 15, aq = lane >> 4;
      float s2v = ws2[bq];
      float c0 = ws1[aq] + s2v, c1 = ws1[aq + 4] + s2v, c2 = ws1[aq + 8] + s2v, c3 = ws1[aq + 12] + s2v;
      unsigned k0 = (fkey(c0) & ~255u) | (unsigned)(255 - lane), k1 = (fkey(c1) & ~255u) | (unsigned)(191 - lane);
      unsigned k2 = (fkey(c2) & ~255u) | (unsigned)(127 - lane), k3 = (fkey(c3) & ~255u) | (unsigned)(63 - lane);
      unsigned pc = 0u;
      for (int bit = 31; bit >= 0; --bit) {
        unsigned tc = pc | (1u << bit);
        int cc = __popcll(__ballot(k0 >= tc)) + __popcll(__ballot(k1 >= tc)) + __popcll(__ballot(k2 >= tc)) + __popcll(__ballot(k3 >= tc));
        if (cc >= 16) pc = tc;
      }
      {
        unsigned long long m0 = __ballot(k0 >= pc), m1 = __ballot(k1 >= pc), m2 = __ballot(k2 >= pc), m3 = __ballot(k3 >= pc);
        int n0 = __popcll(m0), n1 = n0 + __popcll(m1), n2 = n1 + __popcll(m2);
        int i2b = wi2[bq];
        if (k0 >= pc) { int q = mbcnt64(m0) & 15; es[q] = c0; eidx[hh * 16 + q] = wi1[aq] * 128 + i2b; }
        if (k1 >= pc) { int q = (n0 + mbcnt64(m1)) & 15; es[q] = c1; eidx[hh * 16 + q] = wi1[aq + 4] * 128 + i2b; }
        if (k2 >= pc) { int q = (n1 + mbcnt64(m2)) & 15; es[q] = c2; eidx[hh * 16 + q] = wi1[aq + 8] * 128 + i2b; }
        if (k3 >= pc) { int q = (n2 + mbcnt64(m3)) & 15; es[q] = c3; eidx[hh * 16 + q] = wi1[aq + 12] * 128 + i2b; }
      }
      __builtin_amdgcn_fence(__ATOMIC_ACQ_REL, "wavefront");
      __builtin_amdgcn_wave_barrier();
      float ts = es[lane & 15];
      float mx = row_max16(ts);
      float pe = __expf(ts - mx);
      float sm = row_sum16(pe);
      if (lane < 16) eg[hh * 16 + lane] = pe / sm;
      __builtin_amdgcn_fence(__ATOMIC_ACQ_REL, "wavefront");
      __builtin_amdgcn_wave_barrier();
    }
    int mb = T < 4096 ? 0 : 1 + ((T - 4096) >> 10);
    const float* md = p.MOD() + (size_t)(layer * 5 + mb) * 6144;
    float4 xv[4]; float ssx = 0.f;
#pragma unroll
    for (int i = 0; i < 4; i++) { xv[i] = *(const float4*)(p.X() + (size_t)T * 1024 + (i * 64 + lane) * 4); ssx += xv[i].x * xv[i].x + xv[i].y * xv[i].y + xv[i].z * xv[i].z + xv[i].w * xv[i].w; }
    ssx = wave_sum(ssx);
    float rstdx = rsqrtf(ssx * (1.f / 1024.f) + 1e-6f);
    float4 hv[4]; float hmax = 0.f;
#pragma unroll
    for (int i = 0; i < 4; i++) {
      int col = (i * 64 + lane) * 4;
      float4 g = *(const float4*)(gain + col), sh = *(const float4*)(md + 3 * 1024 + col), scl = *(const float4*)(md + 4 * 1024 + col);
      hv[i].x = xv[i].x * rstdx * g.x * (1.f + scl.x) + sh.x; hv[i].y = xv[i].y * rstdx * g.y * (1.f + scl.y) + sh.y;
      hv[i].z = xv[i].z * rstdx * g.z * (1.f + scl.z) + sh.z; hv[i].w = xv[i].w * rstdx * g.w * (1.f + scl.w) + sh.w;
      hmax = fmaxf(hmax, fmaxf(fmaxf(fabsf(hv[i].x), fabsf(hv[i].y)), fmaxf(fabsf(hv[i].z), fabsf(hv[i].w))));
    }
    hmax = wave_max_f(hmax);
    float hinv = hmax > 0.f ? 127.f / hmax : 0.f, hscale = hmax * (1.f / 127.f);
    int hq[4];
#pragma unroll
    for (int i = 0; i < 4; i++) {
      unsigned b0 = (unsigned)((int)rintf(hv[i].x * hinv)) & 255u, b1 = (unsigned)((int)rintf(hv[i].y * hinv)) & 255u;
      unsigned b2 = (unsigned)((int)rintf(hv[i].z * hinv)) & 255u, b3 = (unsigned)((int)rintf(hv[i].w * hinv)) & 255u;
      hq[i] = (int)(b0 | (b1 << 8) | (b2 << 16) | (b3 << 24));
    }
#define PLOAD8(SET, TBL, B0) _Pragma("unroll") for (int j = 0; j < 8; j++) { \
        int e_ = __builtin_amdgcn_readfirstlane(eidx[(B0) * 8 + j]); SET[j] = *(const u32x4*)(TBL + (size_t)e_ * 1024 + lane * 16); }
#define PDOT8(SET, B0) _Pragma("unroll") for (int j = 0; j < 8; j++) { \
        int d_ = __builtin_amdgcn_sdot4(hq[0], (int)SET[j][0], 0, false); d_ = __builtin_amdgcn_sdot4(hq[1], (int)SET[j][1], d_, false); \
        d_ = __builtin_amdgcn_sdot4(hq[2], (int)SET[j][2], d_, false); d_ = __builtin_amdgcn_sdot4(hq[3], (int)SET[j][3], d_, false); \
        float D_ = (float)wave_sum_i(d_); int e_ = (B0) * 8 + j; bool me_ = lane == (e_ & 63); \
        a0 = (me_ && e_ < 64) ? D_ : a0; a1 = (me_ && e_ >= 64) ? D_ : a1; }
#define PACC8(SET, B0) _Pragma("unroll") for (int j = 0; j < 8; j++) { \
        int e_ = (B0) * 8 + j; float w = rlane(e_ < 64 ? w0 : w1, e_ & 63); \
        acc[0] += w * ub0(SET[j][0]); acc[1] += w * ub1(SET[j][0]); acc[2] += w * ub2(SET[j][0]); acc[3] += w * ub3(SET[j][0]); \
        acc[4] += w * ub0(SET[j][1]); acc[5] += w * ub1(SET[j][1]); acc[6] += w * ub2(SET[j][1]); acc[7] += w * ub3(SET[j][1]); \
        acc[8] += w * ub0(SET[j][2]); acc[9] += w * ub1(SET[j][2]); acc[10] += w * ub2(SET[j][2]); acc[11] += w * ub3(SET[j][2]); \
        acc[12] += w * ub0(SET[j][3]); acc[13] += w * ub1(SET[j][3]); acc[14] += w * ub2(SET[j][3]); acc[15] += w * ub3(SET[j][3]); }
    float acc[16];
#pragma unroll
    for (int i = 0; i < 16; i++) acc[i] = 0.f;
    float a0 = 0.f, a1 = 0.f;
    u32x4 sa[8], sb[8];
    PLOAD8(sa, U, 0)
#pragma unroll 1
    for (int bi = 0; bi < 16; bi += 2) {
      PLOAD8(sb, U, bi + 1)
      PDOT8(sa, bi)
      if (bi + 2 < 16) { PLOAD8(sa, U, bi + 2) } else { PLOAD8(sa, V, 0) }
      PDOT8(sb, bi + 1)
    }
    int e0 = eidx[lane], e1 = eidx[lane + 64];
    float w0 = eg[lane] * gelu_tanh(a0 * (SU[e0] * hscale)) * SV[e0];
    float w1 = eg[lane + 64] * gelu_tanh(a1 * (SU[e1] * hscale)) * SV[e1];
    float wsum = wave_sum(w0 + w1);
#pragma unroll 1
    for (int bi = 0; bi < 16; bi += 2) {
      PLOAD8(sb, V, bi + 1)
      PACC8(sa, bi)
      if (bi + 2 < 16) { PLOAD8(sa, V, bi + 2) }
      PACC8(sb, bi + 1)
    }
    float x2[16]; float ss = 0.f;
#pragma unroll
    for (int i = 0; i < 4; i++) {
      int col = (i * 64 + lane) * 4;
      float4 ga = *(const float4*)(md + 5 * 1024 + col);
      x2[i * 4 + 0] = xv[i].x + ga.x * (acc[i * 4 + 0] - 128.f * wsum); x2[i * 4 + 1] = xv[i].y + ga.y * (acc[i * 4 + 1] - 128.f * wsum);
      x2[i * 4 + 2] = xv[i].z + ga.z * (acc[i * 4 + 2] - 128.f * wsum); x2[i * 4 + 3] = xv[i].w + ga.w * (acc[i * 4 + 3] - 128.f * wsum);
    }
#pragma unroll
    for (int i = 0; i < 16; i++) ss += x2[i] * x2[i];
    ss = wave_sum(ss);
    float rstd = rsqrtf(ss * (1.f / 1024.f) + 1e-6f);
    if (layer == 0) {
      const float* md1 = p.MOD() + (size_t)(5 + mb) * 6144;
#pragma unroll
      for (int i = 0; i < 4; i++) {
        int col = (i * 64 + lane) * 4;
        *(float4*)(p.X() + (size_t)T * 1024 + col) = make_float4(x2[i * 4], x2[i * 4 + 1], x2[i * 4 + 2], x2[i * 4 + 3]);
        float4 g = *(const float4*)(p.norm_mix + 1024 + col), sh = *(const float4*)(md1 + col), scl = *(const float4*)(md1 + 1024 + col);
        float y0 = x2[i * 4] * rstd * g.x * (1.f + scl.x) + sh.x, y1 = x2[i * 4 + 1] * rstd * g.y * (1.f + scl.y) + sh.y;
        float y2 = x2[i * 4 + 2] * rstd * g.z * (1.f + scl.z) + sh.z, y3 = x2[i * 4 + 3] * rstd * g.w * (1.f + scl.w) + sh.w;
        *(uint2*)(p.H() + (size_t)T * 1024 + col) = make_uint2(pack2(y0, y1), pack2(y2, y3));
      }
    } else {
#pragma unroll
      for (int i = 0; i < 4; i++) {
        int col = (i * 64 + lane) * 4;
        float4 g = *(const float4*)(p.norm_final + col);
        *(float4*)(p.out + (size_t)T * 1024 + col) = make_float4(x2[i * 4] * rstd * g.x, x2[i * 4 + 1] * rstd * g.y, x2[i * 4 + 2] * rstd * g.z, x2[i * 4 + 3] * rstd * g.w);
      }
    }
  }
}

#define XB_TMO      128
#define XB_XCNT(j)  (256  + 64 * (j))
#define XB_XSUB(j)  (1280 + 64 * (j))
#define XB_XGEN(j)  (2304 + 64 * (j))
#define XB_TOP      3328
#define XB_TOPGEN   3392
#define XCD_BAR_WORDS 3456
#define XB_SPIN_CAP (1u << 20)
#define LAS __attribute__((address_space(3)))
DEV unsigned xb_ld(unsigned* p)              { return __hip_atomic_load(p, __ATOMIC_RELAXED, __HIP_MEMORY_SCOPE_AGENT); }
DEV unsigned xb_add(unsigned* p, unsigned v) { return __hip_atomic_fetch_add(p, v, __ATOMIC_RELAXED, __HIP_MEMORY_SCOPE_AGENT); }
DEV unsigned xb_xcc_id() { return (unsigned)__builtin_amdgcn_s_getreg((3 << 11) | 20) & 0xFu; }
#define XB_SPIN(cond, bar) do { unsigned _sp = 0; while (cond) { __builtin_amdgcn_s_sleep(1); \
    if ((++_sp & 255u) == 0u) { if (xb_ld(&(bar)[XB_TMO])) break; if (_sp > XB_SPIN_CAP) { atomicAdd(&(bar)[XB_TMO], 1u); break; } } } } while (0)
struct XcdBarrier { unsigned* bar; unsigned x; volatile LAS unsigned* st; };
DEV XcdBarrier xcd_barrier_post(unsigned* bar, volatile LAS unsigned* st) {
  XcdBarrier b; b.bar = bar; b.x = xb_xcc_id(); b.st = st;
  if (threadIdx.x == 0) (void)xb_add(&bar[XB_XCNT(b.x)], 1u);
  return b;
}
DEV void xcd_barrier_complete(unsigned* bar, unsigned x, unsigned& nloc, unsigned& nx) {
  const unsigned G = gridDim.x * gridDim.y * gridDim.z;
  unsigned sum, cnt, mine, sp = 0u;
  for (;;) {
    sum = 0u; cnt = 0u; mine = 0u;
#pragma unroll
    for (unsigned j = 0; j < 16; ++j) { const unsigned c = xb_ld(&bar[XB_XCNT(j)]); sum += c; cnt += (c > 0u) ? 1u : 0u; mine = (j == x) ? c : mine; }
    if (sum == G) break;
    __builtin_amdgcn_s_sleep(1);
    if ((++sp & 255u) == 0u) { if (xb_ld(&bar[XB_TMO])) break; if (sp > XB_SPIN_CAP) { atomicAdd(&bar[XB_TMO], 1u); break; } }
  }
  nloc = mine > 0u ? mine : 1u; nx = cnt > 0u ? cnt : 1u;
}
DEV void xcd_barrier(const XcdBarrier& b) {
  asm volatile("s_waitcnt vmcnt(0)" ::: "memory");
  __syncthreads();
  if (threadIdx.x == 0) {
    unsigned* bar = b.bar;
    __builtin_amdgcn_s_waitcnt(0);
    unsigned nloc = b.st[0], nx = b.st[1];
    if (nloc == 0u) { xcd_barrier_complete(bar, b.x, nloc, nx); b.st[0] = nloc; b.st[1] = nx; }
    const unsigned old = xb_add(&bar[XB_XSUB(b.x)], 1u);
    const unsigned gen = old / nloc;
    if (old + 1u == (gen + 1u) * nloc) {
      __builtin_amdgcn_fence(__ATOMIC_RELEASE, "agent");
      asm volatile("s_waitcnt vmcnt(0)" ::: "memory");
      const unsigned og = xb_add(&bar[XB_TOP], 1u);
      const unsigned tg = og / nx;
      if (og + 1u == (tg + 1u) * nx) xb_add(&bar[XB_TOPGEN], 1u);
      else XB_SPIN(xb_ld(&bar[XB_TOPGEN]) == tg, bar);
      __builtin_amdgcn_fence(__ATOMIC_ACQUIRE, "agent");
      xb_add(&bar[XB_XGEN(b.x)], 1u);
      asm volatile("s_waitcnt vmcnt(0)" ::: "memory");
    } else {
      XB_SPIN(xb_ld(&bar[XB_XGEN(b.x)]) == gen, bar);
      __builtin_amdgcn_fence(__ATOMIC_ACQUIRE, "agent");
      asm volatile("s_waitcnt vmcnt(0)" ::: "memory");
    }
  }
  __syncthreads();
}

constexpr int NPHASE = 16;
DEV void run_phase(const Params& p, int ph, int bid, int nb, char* smem) {
  switch (ph) {
    case 0: phase_prep(p, bid, nb, smem); break;
    case 1: phase_ada(p, 0, p.norm_mix, 0, 1, true, bid, nb); break;
    case 2: gemm_phase(p.H(), 1024, p.WT_EVIN(), 1024, 1024, 64, 22, bid, nb, smem, [&](int m0, int n0, const float* Cs) { epi_inproj0(p, m0, n0, Cs); }); break;
    case 3: phase_attn0(p, bid, nb, smem); break;
    case 4: gemm_phase(p.MIX(), 1024, p.WT_EVOUT(), 1024, 1024, 64, 8, bid, nb, smem, [&](int m0, int n0, const float* Cs) { epi_outproj(p, 0, m0, n0, Cs); }); break;
    case 5: phase_ada(p, 0, p.norm_ffn, 3, 4, false, bid, nb); break;
    case 12: phase_ada(p, 1, p.norm_ffn + 1024, 3, 4, false, bid, nb); break;
    case 6: case 13: {
      int layer = ph == 6 ? 0 : 1;
      gemm_phase(p.H(), 1024, p.WT_PQ() + (size_t)layer * 2048 * 1024, 1024, 1024, 64, 16, bid, nb, smem, [&](int m0, int n0, const float* Cs) {
        int lane = threadIdx.x & 63, wave = threadIdx.x >> 6;
#pragma unroll 8
        for (int rr = wave; rr < 128; rr += 4) {
          float2 c = *(const float2*)(Cs + rr * 128 + lane * 2);
          *(unsigned*)(p.PQ() + (size_t)(m0 + rr) * 2048 + n0 + lane * 2) = pack2(c.x, c.y);
        }
      });
    } break;
    case 7: case 14: {
      int layer = ph == 7 ? 0 : 1;
      const u16* sk = p.SUBK() + (size_t)layer * 16 * 128 * 128;
      for (int it = bid; it < 64 * 16; it += nb) {
        int mt, hc;
        if ((nb & 7) == 0) { int li = (it - (bid & 7)) >> 3; mt = 8 * (bid & 7) + (li & 7); hc = (li >> 3) & 15; } else { mt = it >> 4; hc = it & 15; }
        f32x16 acc[2][2];
        zero16(acc[0][0]); zero16(acc[0][1]); zero16(acc[1][0]); zero16(acc[1][1]);
        gemm_tile(p.PQ() + (size_t)mt * 128 * 2048 + hc * 128, 2048, sk + (size_t)hc * 128 * 128, 128, 128, smem, acc);
        const float* Cs = (const float*)smem;
        int lane = threadIdx.x & 63, wave = threadIdx.x >> 6;
#pragma unroll 8
        for (int rr = wave; rr < 128; rr += 4) {
          float2 c = *(const float2*)(Cs + rr * 128 + lane * 2);
          *(float2*)(p.SC() + (size_t)(mt * 128 + rr) * 2048 + hc * 128 + lane * 2) = c;
        }
      }
    } break;
    case 8: phase_peer(p, 0, bid, nb, smem); break;
    case 15: phase_peer(p, 1, bid, nb, smem); break;
    case 9: gemm_phase(p.H(), 1024, p.WT_ODIN(), 1024, 1024, 64, 18, bid, nb, smem, [&](int m0, int n0, const float* Cs) { epi_inproj1(p, m0, n0, Cs); }); break;
    case 10: phase_attn1(p, bid, nb, smem); break;
    case 11: gemm_phase(p.MIX(), 1024, p.WT_ODOUT(), 1024, 1024, 64, 8, bid, nb, smem, [&](int m0, int n0, const float* Cs) { epi_outproj(p, 1, m0, n0, Cs); }); break;
    default: break;
  }
}

constexpr size_t PARAMS_OFF = 330036736ull;
template <int PH> DEV void run_all(const Params& p, cg::grid_group& grid, const XcdBarrier& xb, char* smem) {
  if constexpr (PH == 0) {
    if (blockIdx.x == 0 && threadIdx.x < sizeof(Params) / 8) ((unsigned long long*)(p.ws + PARAMS_OFF))[threadIdx.x] = ((const unsigned long long*)&p)[threadIdx.x];
    run_phase(p, PH, blockIdx.x, gridDim.x, smem);
  } else {
    run_phase(p, PH, blockIdx.x, gridDim.x, smem);
  }
  if constexpr (PH + 1 < NPHASE) {
    if (PH == 0 && p.ws == nullptr) grid.sync();
    xcd_barrier(xb);
    run_all<PH + 1>(p, grid, xb, smem);
  }
}
__global__ void __launch_bounds__(256, 2) mega_kernel(Params p) {
  __shared__ __attribute__((aligned(16))) char smem[77824];
  __shared__ uint4 xb_words;
  if (threadIdx.x == 0) xb_words = make_uint4(0u, 0u, 0u, 0u);
  __syncthreads();
  XcdBarrier xb = xcd_barrier_post(p.BAR(), (volatile LAS unsigned*)&xb_words);
  cg::grid_group grid = cg::this_grid();
  run_all<0>(p, grid, xb, smem);
}
#if MULTI_LAUNCH
template <int PH> __global__ void __launch_bounds__(256, 2) phase_kernel(Params p) {
  __shared__ __attribute__((aligned(16))) char smem[77824];
  run_phase(p, PH, blockIdx.x, gridDim.x, smem);
}
template <int PH> static void launch_all(const Params& p, int grid, hipStream_t s) {
  phase_kernel<PH><<<grid, 256, 0, s>>>(p);
  if constexpr (PH + 1 < NPHASE) launch_all<PH + 1>(p, grid, s);
}
#endif

extern "C" void kernel_launch(void* const* d_in, const int* in_sizes, int n_in, void* d_out, int out_size, void* d_ws, size_t ws_size, hipStream_t stream) {
  Params p{};
  const float* const* in = (const float* const*)d_in;
  p.xp = in[0]; p.xs = in[1]; p.c = in[2]; p.cctx = in[3]; p.cak = in[4]; p.cav = in[5]; p.srf = in[6]; p.srb = in[7];
  p.cck = in[8]; p.ccv = in[9]; p.cdk = in[10]; p.cdv = in[11];
  p.mod_w = in[12]; p.mod_b = in[13]; p.norm_mix = in[14]; p.norm_ffn = in[15]; p.norm_final = in[16];
  p.ev_w_in = in[17]; p.ev_w_out = in[18]; p.a_q_norm = in[19]; p.a_k_norm = in[20]; p.rdf = in[21]; p.rdb = in[22];
  p.od_w_in = in[23]; p.od_w_out = in[24]; p.lq1 = in[25]; p.lk1 = in[26]; p.lq2 = in[27]; p.lk2 = in[28]; p.subln = in[29]; p.dsink = in[30];
  p.peer_wq = in[31]; p.peer_sk = in[32]; p.peer_u = in[33]; p.peer_v = in[34];
  p.out = (float*)d_out;
  p.ws = (char*)d_ws;
  (void)in_sizes; (void)n_in; (void)out_size; (void)ws_size;
#if MULTI_LAUNCH
  launch_all<0>(p, 512, stream);
#else
  static int grid_blocks = 0;
  if (!grid_blocks) {
    int dev = 0, cus = 0, per_cu = 0;
    hipGetDevice(&dev);
    hipDeviceGetAttribute(&cus, hipDeviceAttributeMultiprocessorCount, dev);
    hipOccupancyMaxActiveBlocksPerMultiprocessor(&per_cu, mega_kernel, 256, 0);
    if (per_cu > 2) per_cu = 2;
    if (per_cu < 1) per_cu = 1;
    grid_blocks = cus * per_cu;
  }
  (void)hipMemsetAsync(d_ws, 0, XCD_BAR_WORDS * 4, stream);
  void* args[] = {&p};
  hipError_t e = hipLaunchCooperativeKernel((void*)mega_kernel, dim3(grid_blocks), dim3(256), args, 0, stream);
  if (e != hipSuccess) fprintf(stderr, "cooperative launch failed: %s (grid %d)\n", hipGetErrorString(e), grid_blocks);
#endif
}
```

```cpp
#include <hip/hip_runtime.h>
#include <hip/hip_cooperative_groups.h>
#include <cstdio>
namespace cg = cooperative_groups;

#ifndef MULTI_LAUNCH
#define MULTI_LAUNCH 0
#endif

typedef unsigned short u16;
typedef __attribute__((ext_vector_type(8))) short bf16x8;
typedef __attribute__((ext_vector_type(16))) float f32x16;
typedef __attribute__((ext_vector_type(4))) unsigned u32x4;

#define DEV __device__ __forceinline__

constexpr size_t OUT_AK = 8388608, OUT_AV = 8912896, OUT_RF = 9437184, OUT_RB = 9961472,
                 OUT_CK = 10485760, OUT_CV = 12582912, OUT_DK = 14680064, OUT_DV = 15204352;
constexpr float LAM_INIT = 0.35550906f;

struct Params {
  const float *xp, *xs, *c, *cctx, *cak, *cav, *srf, *srb, *cck, *ccv, *cdk, *cdv;
  const float *mod_w, *mod_b, *norm_mix, *norm_ffn, *norm_final;
  const float *ev_w_in, *ev_w_out, *a_q_norm, *a_k_norm, *rdf, *rdb;
  const float *od_w_in, *od_w_out, *lq1, *lk1, *lq2, *lk2, *subln, *dsink;
  const float *peer_wq, *peer_sk, *peer_u, *peer_v;
  float* out;
  char* ws;
  __device__ __forceinline__ unsigned* BAR() const { return (unsigned*)(ws + 0ull); }
  __device__ __forceinline__ float* MOD() const { return (float*)(ws + 13824ull); }
  __device__ __forceinline__ float* ROPEC() const { return (float*)(ws + 259584ull); }
  __device__ __forceinline__ float* ROPES() const { return (float*)(ws + 390656ull); }
  __device__ __forceinline__ float* X() const { return (float*)(ws + 521728ull); }
  __device__ __forceinline__ float* SC() const { return (float*)(ws + 34076160ull); }
  __device__ __forceinline__ u16* WT_EVIN() const { return (u16*)(ws + 101185024ull); }
  __device__ __forceinline__ u16* WT_EVOUT() const { return (u16*)(ws + 106952192ull); }
  __device__ __forceinline__ u16* WT_ODIN() const { return (u16*)(ws + 109049344ull); }
  __device__ __forceinline__ u16* WT_ODOUT() const { return (u16*)(ws + 113767936ull); }
  __device__ __forceinline__ u16* WT_PQ() const { return (u16*)(ws + 115865088ull); }
  __device__ __forceinline__ u16* SUBK() const { return (u16*)(ws + 124253696ull); }
  __device__ __forceinline__ unsigned char* U8() const { return (unsigned char*)(ws + 125302272ull); }
  __device__ __forceinline__ unsigned char* V8() const { return (unsigned char*)(ws + 158856704ull); }
  __device__ __forceinline__ float* SU() const { return (float*)(ws + 192411136ull); }
  __device__ __forceinline__ float* SV() const { return (float*)(ws + 192542208ull); }
  __device__ __forceinline__ u16* H() const { return (u16*)(ws + 192673280ull); }
  __device__ __forceinline__ u16* MIX() const { return (u16*)(ws + 209450496ull); }
  __device__ __forceinline__ u16* Q1() const { return (u16*)(ws + 226227712ull); }
  __device__ __forceinline__ u16* Q2() const { return (u16*)(ws + 234616320ull); }
  __device__ __forceinline__ u16* SG() const { return (u16*)(ws + 243004928ull); }
  __device__ __forceinline__ u16* KA() const { return (u16*)(ws + 251393536ull); }
  __device__ __forceinline__ u16* VA() const { return (u16*)(ws + 253752832ull); }
  __device__ __forceinline__ u16* RK() const { return (u16*)(ws + 256112128ull); }
  __device__ __forceinline__ u16* RV() const { return (u16*)(ws + 264500736ull); }
  __device__ __forceinline__ u16* KC() const { return (u16*)(ws + 272889344ull); }
  __device__ __forceinline__ u16* VC() const { return (u16*)(ws + 282326528ull); }
  __device__ __forceinline__ u16* KD() const { return (u16*)(ws + 291763712ull); }
  __device__ __forceinline__ u16* VD() const { return (u16*)(ws + 294123008ull); }
  __device__ __forceinline__ u16* PQ() const { return (u16*)(ws + 296482304ull); }
};

DEV float bf2f(unsigned b) { return __uint_as_float(b << 16); }
typedef __bf16 bf16v2 __attribute__((ext_vector_type(2)));
typedef float f32v2 __attribute__((ext_vector_type(2)));
DEV unsigned pack2(float a, float b) { f32v2 v = {a, b}; return __builtin_bit_cast(unsigned, __builtin_convertvector(v, bf16v2)); }
DEV u16 f2bf(float f) { return (u16)(pack2(f, 0.f) & 0xffffu); }
DEV float bflo(unsigned w) { return __uint_as_float(w << 16); }
DEV float bfhi(unsigned w) { return __uint_as_float(w & 0xffff0000u); }
DEV float silu_f(float v) { return v / (1.f + __expf(-v)); }
DEV float gelu_tanh(float a) {
  float z = 0.7978845608f * (a + 0.044715f * a * a * a);
  float e = __expf(2.f * z);
  float th = 1.f - 2.f / (e + 1.f);
  return 0.5f * a * (1.f + th);
}
template <int CTRL> DEV float dpp_f(float v) {
  return __int_as_float(__builtin_amdgcn_update_dpp(0, __float_as_int(v), CTRL, 0xF, 0xF, true));
}
template <int CTRL> DEV unsigned dpp_u(unsigned v) {
  return (unsigned)__builtin_amdgcn_update_dpp(0, (int)v, CTRL, 0xF, 0xF, true);
}
DEV float row_sum16(float v) {
  v += dpp_f<0xB1>(v); v += dpp_f<0x4E>(v); v += dpp_f<0x141>(v); v += dpp_f<0x140>(v); return v;
}
DEV float row_max16(float v) {
  v = fmaxf(v, dpp_f<0xB1>(v)); v = fmaxf(v, dpp_f<0x4E>(v)); v = fmaxf(v, dpp_f<0x141>(v)); v = fmaxf(v, dpp_f<0x140>(v)); return v;
}
DEV float rlane(float v, int l) { return __int_as_float(__builtin_amdgcn_readlane(__float_as_int(v), l)); }
DEV float wave_sum(float v) {
  v = row_sum16(v);
  return (rlane(v, 0) + rlane(v, 16)) + (rlane(v, 32) + rlane(v, 48));
}
DEV unsigned wave_max_u(unsigned v) {
  v = max(v, dpp_u<0xB1>(v)); v = max(v, dpp_u<0x4E>(v)); v = max(v, dpp_u<0x141>(v)); v = max(v, dpp_u<0x140>(v));
  unsigned a = (unsigned)__builtin_amdgcn_readlane((int)v, 0), b = (unsigned)__builtin_amdgcn_readlane((int)v, 16);
  unsigned c = (unsigned)__builtin_amdgcn_readlane((int)v, 32), d = (unsigned)__builtin_amdgcn_readlane((int)v, 48);
  return max(max(a, b), max(c, d));
}
DEV float half_sum32(float v) { v = row_sum16(v); return v + __shfl_xor(v, 16); }
DEV unsigned fkey(float f) { unsigned u = __float_as_uint(f); return (u & 0x80000000u) ? ~u : (u | 0x80000000u); }
DEV f32x16 mfma32(bf16x8 a, bf16x8 b, f32x16 c) { return __builtin_amdgcn_mfma_f32_32x32x16_bf16(a, b, c, 0, 0, 0); }
DEV void zero16(f32x16& v) {
#pragma unroll
  for (int i = 0; i < 16; i++) v[i] = 0.f;
}
DEV size_t kvoff(bool smp, int b, int hh, int tpos, int H, int DW, int LS, int off) {
  return smp ? (size_t)4096 * H * DW + ((size_t)(b * H + hh) * LS + off + tpos) * DW
             : ((size_t)(b * H + hh) * 256 + tpos) * DW;
}


DEV float wave_max_f(float v) {
  v = row_max16(v);
  return fmaxf(fmaxf(rlane(v, 0), rlane(v, 16)), fmaxf(rlane(v, 32), rlane(v, 48)));
}
DEV int wave_sum_i(int v) {
  v += (int)dpp_u<0xB1>((unsigned)v); v += (int)dpp_u<0x4E>((unsigned)v); v += (int)dpp_u<0x141>((unsigned)v); v += (int)dpp_u<0x140>((unsigned)v);
  return (__builtin_amdgcn_readlane(v, 0) + __builtin_amdgcn_readlane(v, 16)) + (__builtin_amdgcn_readlane(v, 32) + __builtin_amdgcn_readlane(v, 48));
}
DEV int mbcnt64(unsigned long long m) { return (int)__builtin_amdgcn_mbcnt_hi((unsigned)(m >> 32), __builtin_amdgcn_mbcnt_lo((unsigned)m, 0u)); }
template <bool SGN> DEV void prep_quant(const float* __restrict__ src, unsigned char* __restrict__ dst, float* __restrict__ scale, int row0) {
  int lane = threadIdx.x & 63, wave = threadIdx.x >> 6;
  int rbase = row0 + wave * 4;
  float4 v[4][4];
#pragma unroll
  for (int q = 0; q < 4; q++)
#pragma unroll
    for (int i = 0; i < 4; i++) v[q][i] = *(const float4*)(src + (size_t)(rbase + q) * 1024 + (i * 64 + lane) * 4);
#pragma unroll
  for (int q = 0; q < 4; q++) {
    float mx = 0.f;
#pragma unroll
    for (int i = 0; i < 4; i++) mx = fmaxf(mx, fmaxf(fmaxf(fabsf(v[q][i].x), fabsf(v[q][i].y)), fmaxf(fabsf(v[q][i].z), fabsf(v[q][i].w))));
    mx = wave_max_f(mx);
    float inv = mx > 0.f ? 127.f / mx : 0.f;
    unsigned w[4];
#pragma unroll
    for (int i = 0; i < 4; i++) {
      int off = SGN ? 0 : 128;
      unsigned b0 = (unsigned)((int)rintf(v[q][i].x * inv) + off) & 255u, b1 = (unsigned)((int)rintf(v[q][i].y * inv) + off) & 255u;
      unsigned b2 = (unsigned)((int)rintf(v[q][i].z * inv) + off) & 255u, b3 = (unsigned)((int)rintf(v[q][i].w * inv) + off) & 255u;
      w[i] = b0 | (b1 << 8) | (b2 << 16) | (b3 << 24);
    }
    *(uint4*)(dst + (size_t)(rbase + q) * 1024 + lane * 16) = make_uint4(w[0], w[1], w[2], w[3]);
    if (lane == 0) scale[rbase + q] = mx * (1.f / 127.f);
  }
}

DEV void prep_transpose(const float* __restrict__ W, int N, u16* __restrict__ Wt, int tile, float* sm) {
  int ntn = N >> 6; int kt = tile / ntn, nt = tile % ntn;
  int k0 = kt * 64, n0 = nt * 64; int t = threadIdx.x;
#pragma unroll
  for (int i = 0; i < 4; i++) {
    int k = (t >> 4) + 16 * i; int c4 = (t & 15) * 4;
    float4 v = *(const float4*)(W + (size_t)(k0 + k) * N + n0 + c4);
    sm[k * 65 + c4] = v.x; sm[k * 65 + c4 + 1] = v.y; sm[k * 65 + c4 + 2] = v.z; sm[k * 65 + c4 + 3] = v.w;
  }
  __syncthreads();
  int n = t >> 2, kc = (t & 3) * 16;
  unsigned pk[8];
#pragma unroll
  for (int j = 0; j < 8; j++) pk[j] = pack2(sm[(kc + 2 * j) * 65 + n], sm[(kc + 2 * j + 1) * 65 + n]);
  uint4* dst = (uint4*)(Wt + (size_t)(n0 + n) * 1024 + k0 + kc);
  dst[0] = make_uint4(pk[0], pk[1], pk[2], pk[3]);
  dst[1] = make_uint4(pk[4], pk[5], pk[6], pk[7]);
  __syncthreads();
}
DEV void conv_item(const float* __restrict__ src, u16* __restrict__ dst) {
  int t = threadIdx.x;
#pragma unroll
  for (int i = 0; i < 8; i++) {
    int e = (i * 256 + t) * 8;
    float4 a = *(const float4*)(src + e), b = *(const float4*)(src + e + 4);
    *(uint4*)(dst + e) = make_uint4(pack2(a.x, a.y), pack2(a.z, a.w), pack2(b.x, b.y), pack2(b.z, b.w));
  }
}
DEV void prep_mod(const Params& p, int it, float* sm) {
  int l = it / 96, n0 = (it % 96) * 64; int t = threadIdx.x;
  float* sc = sm;
  for (int i = t; i < 5120; i += 256) {
    int b = i >> 10, k = i & 1023;
    float v = (b == 0) ? p.cctx[k] : p.c[(b - 1) * 1024 + k];
    sc[i] = silu_f(v);
  }
  __syncthreads();
  int col = t & 63, kg = t >> 6;
  float a0 = 0, a1 = 0, a2 = 0, a3 = 0, a4 = 0;
  const float* w = p.mod_w + (size_t)l * 1024 * 6144 + n0 + col;
  for (int k0 = kg; k0 < 1024; k0 += 32) {
    float wv[8];
#pragma unroll
    for (int u = 0; u < 8; u++) wv[u] = w[(size_t)(k0 + 4 * u) * 6144];
#pragma unroll
    for (int u = 0; u < 8; u++) {
      int k = k0 + 4 * u;
      a0 += sc[k] * wv[u]; a1 += sc[1024 + k] * wv[u]; a2 += sc[2048 + k] * wv[u]; a3 += sc[3072 + k] * wv[u]; a4 += sc[4096 + k] * wv[u];
    }
  }
  float* red = sm + 5120;
  red[(kg * 5 + 0) * 64 + col] = a0; red[(kg * 5 + 1) * 64 + col] = a1; red[(kg * 5 + 2) * 64 + col] = a2;
  red[(kg * 5 + 3) * 64 + col] = a3; red[(kg * 5 + 4) * 64 + col] = a4;
  __syncthreads();
  if (t < 64) {
#pragma unroll
    for (int b = 0; b < 5; b++) {
      float s = red[(0 * 5 + b) * 64 + t] + red[(1 * 5 + b) * 64 + t] + red[(2 * 5 + b) * 64 + t] + red[(3 * 5 + b) * 64 + t];
      p.MOD()[(size_t)(l * 5 + b) * 6144 + n0 + t] = s + p.mod_b[l * 6144 + n0 + t];
    }
  }
  __syncthreads();
}
DEV void prep_cache(const Params& p, int it) {
  const float* src; u16* dst;
  if (it < 8)       { int ch = it;      src = p.cak + (size_t)ch * 16384; dst = p.KA() + (size_t)4096 * 2 * 64 + (size_t)ch * 1280 * 64; }
  else if (it < 16) { int ch = it - 8;  src = p.cav + (size_t)ch * 16384; dst = p.VA() + (size_t)4096 * 2 * 64 + (size_t)ch * 1280 * 64; }
  else if (it < 48) { int ch = it - 16; src = p.cck + (size_t)ch * 16384; dst = p.KC() + (size_t)4096 * 8 * 64 + (size_t)ch * 1280 * 64; }
  else if (it < 80) { int ch = (it - 48) >> 1, hf = (it - 48) & 1;
                      src = p.ccv + (size_t)ch * 32768 + hf * 16384; dst = p.VC() + (size_t)4096 * 4 * 128 + (size_t)ch * 1280 * 128 + hf * 16384; }
  else if (it < 88) { int ch = it - 80; src = p.cdk + (size_t)ch * 16384; dst = p.KD() + (size_t)4096 * 2 * 64 + (size_t)ch * 1280 * 64; }
  else              { int ch = it - 88; src = p.cdv + (size_t)ch * 16384; dst = p.VD() + (size_t)4096 * 2 * 64 + (size_t)ch * 1280 * 64; }
  conv_item(src, dst);
}
DEV void prep_rope(const Params& p, int it) {
  for (int i = 0; i < 16; i++) {
    int idx = it * 4096 + i * 256 + threadIdx.x;
    int tpos = idx >> 5, a = idx & 31;
    float pos = (a < 16) ? (float)(tpos >> 6) : (float)(tpos & 63);
    float inv = exp2f(-(float)(a & 15) * (13.287712379549449f / 16.f));
    float ang = pos * inv;
    p.ROPEC()[idx] = __cosf(ang); p.ROPES()[idx] = __sinf(ang);
  }
}
constexpr int PREP_T0 = 704, PREP_T1 = PREP_T0 + 256, PREP_T2 = PREP_T1 + 576, PREP_T3 = PREP_T2 + 256, PREP_T4 = PREP_T3 + 1024;
constexpr int PREP_U = PREP_T4 + 2048, PREP_V = PREP_U + 2048, PREP_SK = PREP_V + 32, PREP_CA = PREP_SK + 96, PREP_RO = PREP_CA + 8, PREP_MOD = PREP_RO + 192;
DEV void phase_prep(const Params& p, int bid, int nb, char* smem) {
  float* sm = (float*)smem;
  for (int it0 = bid; it0 < PREP_MOD; it0 += nb) {
    int it = (it0 < 192) ? (PREP_RO + it0) : (it0 - 192);
    if (it >= PREP_T4 && it < PREP_V) continue;
    if (it < PREP_T0) prep_transpose(p.ev_w_in, 2816, p.WT_EVIN(), it, sm);
    else if (it < PREP_T1) prep_transpose(p.ev_w_out, 1024, p.WT_EVOUT(), it - PREP_T0, sm);
    else if (it < PREP_T2) prep_transpose(p.od_w_in, 2304, p.WT_ODIN(), it - PREP_T1, sm);
    else if (it < PREP_T3) prep_transpose(p.od_w_out, 1024, p.WT_ODOUT(), it - PREP_T2, sm);
    else if (it < PREP_T4) { int j = it - PREP_T3; int l = j >> 9; prep_transpose(p.peer_wq + (size_t)l * 1024 * 2048, 2048, p.WT_PQ() + (size_t)l * 2048 * 1024, j & 511, sm); }
    else if (it < PREP_V) { }
    else if (it < PREP_SK) { size_t o = (size_t)(it - PREP_V) * 16384; conv_item(p.peer_sk + o, p.SUBK() + o); }
    else if (it < PREP_CA) prep_cache(p, it - PREP_SK);
    else if (it < PREP_RO) prep_rope(p, it - PREP_CA);
    else prep_mod(p, it - PREP_RO, sm);
  }
}

DEV void phase_ada(const Params& p, int layer, const float* __restrict__ gain, int shift_i, int scale_i, bool from_input, int bid, int nb) {
  int wave = threadIdx.x >> 6, lane = threadIdx.x & 63;
  for (int T0 = (bid * 4 + wave) * 2; T0 < 8192; T0 += nb * 8) {
    float4 v[2][4]; float ss[2];
#pragma unroll
    for (int q = 0; q < 2; q++) {
      int T = T0 + q;
      const float* xr = from_input ? (T < 4096 ? p.xp + (size_t)T * 1024 : p.xs + (size_t)(T - 4096) * 1024) : p.X() + (size_t)T * 1024;
#pragma unroll
      for (int i = 0; i < 4; i++) v[q][i] = *(const float4*)(xr + (i * 64 + lane) * 4);
    }
    int mb = T0 < 4096 ? 0 : 1 + ((T0 - 4096) >> 10);
    const float* md = p.MOD() + (size_t)(layer * 5 + mb) * 6144;
    float4 g[4], sh[4], sc[4];
#pragma unroll
    for (int i = 0; i < 4; i++) {
      int col = (i * 64 + lane) * 4;
      g[i] = *(const float4*)(gain + col); sh[i] = *(const float4*)(md + shift_i * 1024 + col); sc[i] = *(const float4*)(md + scale_i * 1024 + col);
    }
#pragma unroll
    for (int q = 0; q < 2; q++) {
      float s2 = 0.f;
#pragma unroll
      for (int i = 0; i < 4; i++) s2 += v[q][i].x * v[q][i].x + v[q][i].y * v[q][i].y + v[q][i].z * v[q][i].z + v[q][i].w * v[q][i].w;
      ss[q] = wave_sum(s2);
    }
#pragma unroll
    for (int q = 0; q < 2; q++) {
      float rstd = rsqrtf(ss[q] * (1.f / 1024.f) + 1e-6f);
#pragma unroll
      for (int i = 0; i < 4; i++) {
        int col = (i * 64 + lane) * 4;
        float y0 = v[q][i].x * rstd * g[i].x * (1.f + sc[i].x) + sh[i].x, y1 = v[q][i].y * rstd * g[i].y * (1.f + sc[i].y) + sh[i].y;
        float y2 = v[q][i].z * rstd * g[i].z * (1.f + sc[i].z) + sh[i].z, y3 = v[q][i].w * rstd * g[i].w * (1.f + sc[i].w) + sh[i].w;
        *(uint2*)(p.H() + (size_t)(T0 + q) * 1024 + col) = make_uint2(pack2(y0, y1), pack2(y2, y3));
      }
    }
  }
}

#define GLOAD8(PA, PB) \
  ra0 = *(const u32x4*)(PA); ra1 = *(const u32x4*)((PA) + sa32); ra2 = *(const u32x4*)((PA) + 2 * sa32); ra3 = *(const u32x4*)((PA) + 3 * sa32); \
  rb0 = *(const u32x4*)(PB); rb1 = *(const u32x4*)((PB) + sb32); rb2 = *(const u32x4*)((PB) + 2 * sb32); rb3 = *(const u32x4*)((PB) + 3 * sb32);
#define GLOAD8N(PA, PB) \
  na0 = *(const u32x4*)(PA); na1 = *(const u32x4*)((PA) + sa32); na2 = *(const u32x4*)((PA) + 2 * sa32); na3 = *(const u32x4*)((PA) + 3 * sa32); \
  nb0 = *(const u32x4*)(PB); nb1 = *(const u32x4*)((PB) + sb32); nb2 = *(const u32x4*)((PB) + 2 * sb32); nb3 = *(const u32x4*)((PB) + 3 * sb32);
#define GSTORE8(BUF) { u16* wa_ = (u16*)(smem + (BUF) * 36864) + lrow * 72 + lkc; u16* wb_ = wa_ + 128 * 72; \
  *(u32x4*)(wa_) = ra0; *(u32x4*)(wa_ + 32 * 72) = ra1; *(u32x4*)(wa_ + 64 * 72) = ra2; *(u32x4*)(wa_ + 96 * 72) = ra3; \
  *(u32x4*)(wb_) = rb0; *(u32x4*)(wb_ + 32 * 72) = rb1; *(u32x4*)(wb_ + 64 * 72) = rb2; *(u32x4*)(wb_ + 96 * 72) = rb3; }
DEV void gemm_tile(const u16* __restrict__ A, int lda, const u16* __restrict__ B, int ldb, int K, char* smem, f32x16 (&acc)[2][2]) {
  int t = threadIdx.x, lane = t & 63, wave = t >> 6, r = lane & 31, h = lane >> 5;
  int wm = wave >> 1, wn = wave & 1;
  int lrow = t >> 3, lkc = (t & 7) * 8;
  const u16* ap = A + (size_t)lrow * lda + lkc;
  const u16* bp = B + (size_t)lrow * ldb + lkc;
  size_t sa32 = (size_t)32 * lda, sb32 = (size_t)32 * ldb;
  u32x4 ra0, ra1, ra2, ra3, rb0, rb1, rb2, rb3;
  u32x4 na0, na1, na2, na3, nb0, nb1, nb2, nb3;
  int nk = K >> 6;
#define GSTORE8N(BUF) { u16* wa_ = (u16*)(smem + (BUF) * 36864) + lrow * 72 + lkc; u16* wb_ = wa_ + 128 * 72; \
  *(u32x4*)(wa_) = na0; *(u32x4*)(wa_ + 32 * 72) = na1; *(u32x4*)(wa_ + 64 * 72) = na2; *(u32x4*)(wa_ + 96 * 72) = na3; \
  *(u32x4*)(wb_) = nb0; *(u32x4*)(wb_ + 32 * 72) = nb1; *(u32x4*)(wb_ + 64 * 72) = nb2; *(u32x4*)(wb_ + 96 * 72) = nb3; }
#define GCOMPUTE(BUF) { const u16* sA = (const u16*)(smem + (BUF) * 36864); const u16* sB = sA + 128 * 72; \
    _Pragma("unroll") for (int kk = 0; kk < 4; kk++) { \
      bf16x8 a0 = *(const bf16x8*)(sA + (wm * 64 + r) * 72 + kk * 16 + h * 8); \
      bf16x8 a1 = *(const bf16x8*)(sA + (wm * 64 + 32 + r) * 72 + kk * 16 + h * 8); \
      bf16x8 b0 = *(const bf16x8*)(sB + (wn * 64 + r) * 72 + kk * 16 + h * 8); \
      bf16x8 b1 = *(const bf16x8*)(sB + (wn * 64 + 32 + r) * 72 + kk * 16 + h * 8); \
      acc[0][0] = mfma32(a0, b0, acc[0][0]); acc[0][1] = mfma32(a0, b1, acc[0][1]); \
      acc[1][0] = mfma32(a1, b0, acc[1][0]); acc[1][1] = mfma32(a1, b1, acc[1][1]); } }
  GLOAD8(ap, bp)
  __syncthreads();
  GSTORE8(0)
  if (nk > 1) { GLOAD8(ap + 64, bp + 64) }
  na0 = ra0; na1 = ra1; na2 = ra2; na3 = ra3; nb0 = rb0; nb1 = rb1; nb2 = rb2; nb3 = rb3;
  __syncthreads();
  for (int kt = 0; kt < nk; kt += 2) {
    if (kt + 2 < nk) { GLOAD8N(ap + (kt + 2) * 64, bp + (kt + 2) * 64) }
    GCOMPUTE(0)
    if (kt + 1 < nk) { GSTORE8(1) }
    __syncthreads();
    if (kt + 1 < nk) {
      if (kt + 3 < nk) { GLOAD8(ap + (kt + 3) * 64, bp + (kt + 3) * 64) }
      GCOMPUTE(1)
      if (kt + 2 < nk) { GSTORE8N(0) }
      __syncthreads();
    }
  }
  __syncthreads();
  float* Cs = (float*)smem;
#pragma unroll
  for (int i = 0; i < 2; i++)
#pragma unroll
    for (int j = 0; j < 2; j++)
#pragma unroll
      for (int g = 0; g < 16; g++)
        Cs[(wm * 64 + i * 32 + (g & 3) + 8 * (g >> 2) + 4 * h) * 128 + wn * 64 + j * 32 + r] = acc[i][j][g];
  __syncthreads();
}

DEV bool xcd_tile(int li, int bid, int NTl, int& mt, int& nt) {
  if (li >= 8 * NTl) return false;
  mt = 8 * (bid & 7) + (li & 7); nt = li >> 3; return true;
}
template <class Epi>
DEV void gemm_phase(const u16* A, int lda, const u16* Bt, int ldb, int K, int MT, int NTl, int bid, int nb, char* smem, Epi epi) {
  if ((nb & 7) == 0 && MT == 64) {
    int mt, nt;
    for (int li = bid >> 3; xcd_tile(li, bid, NTl, mt, nt); li += nb >> 3) {
      f32x16 acc[2][2];
      zero16(acc[0][0]); zero16(acc[0][1]); zero16(acc[1][0]); zero16(acc[1][1]);
      gemm_tile(A + (size_t)mt * 128 * lda, lda, Bt + (size_t)nt * 128 * ldb, ldb, K, smem, acc);
      epi(mt * 128, nt * 128, (const float*)smem);
    }
  } else {
    for (int it = bid; it < MT * NTl; it += nb) {
      int mt = it / NTl, nt = it % NTl;
      f32x16 acc[2][2];
      zero16(acc[0][0]); zero16(acc[0][1]); zero16(acc[1][0]); zero16(acc[1][1]);
      gemm_tile(A + (size_t)mt * 128 * lda, lda, Bt + (size_t)nt * 128 * ldb, ldb, K, smem, acc);
      epi(mt * 128, nt * 128, (const float*)smem);
    }
  }
}

DEV void tok_decode(int T, bool& smp, int& b, int& tpos) {
  smp = T >= 4096;
  if (!smp) { b = T >> 8; tpos = T & 255; } else { b = (T - 4096) >> 10; tpos = (T - 4096) & 1023; }
}
DEV void rope_pair(const Params& p, float& x, float& y, int tpos, int d) {
  float px = __shfl_xor(x, 16), py = __shfl_xor(y, 16);
  int a = d & 31;
  float c0 = p.ROPEC()[tpos * 32 + a], c1 = p.ROPEC()[tpos * 32 + a + 1];
  float s0 = p.ROPES()[tpos * 32 + a], s1 = p.ROPES()[tpos * 32 + a + 1];
  if (d < 32) { x = x * c0 - px * s0; y = y * c1 - py * s1; }
  else        { x = px * s0 + x * c0; y = py * s1 + y * c1; }
}

DEV void rope_apply(float& x, float& y, float4 cs, int d) {
  float px = __shfl_xor(x, 16), py = __shfl_xor(y, 16);
  if (d < 32) { x = x * cs.x - px * cs.z; y = y * cs.y - py * cs.w; }
  else        { x = px * cs.z + x * cs.x; y = py * cs.w + y * cs.y; }
}
DEV float4 rope_cs(const Params& p, int tpos, int d) {
  int a = d & 31;
  float2 c = *(const float2*)(p.ROPEC() + tpos * 32 + a), s = *(const float2*)(p.ROPES() + tpos * 32 + a);
  return make_float4(c.x, c.y, s.x, s.y);
}
template <int SEG, bool SMP>
DEV void epi0_rows(const Params& p, int m0, int n0, const float* Cs) {
  int lane = threadIdx.x & 63, wave = threadIdx.x >> 6;
  int col = n0 + lane * 2; int d = col & 63;
  float g0 = 1.f, g1 = 1.f;
  if (SEG == 0) { g0 = p.a_q_norm[d]; g1 = p.a_q_norm[d + 1]; }
  if (SEG == 1) { g0 = p.a_k_norm[d]; g1 = p.a_k_norm[d + 1]; }
  int segbase = SEG == 0 ? 0 : SEG == 1 ? 512 : SEG == 2 ? 640 : SEG == 3 ? 768 : SEG == 4 ? 1280 : SEG == 5 ? 1792 : 2304;
  int hh = (col - segbase) >> 6;
#pragma unroll 4
  for (int i = 0; i < 32; i++) {
    int rr = wave + 4 * i;
    int T = m0 + rr;
    int b = SMP ? (T - 4096) >> 10 : T >> 8;
    int tpos = SMP ? (T - 4096) & 1023 : T & 255;
    float2 c = *(const float2*)(Cs + rr * 128 + lane * 2);
    if (SEG <= 1) {
      float4 cs = make_float4(1.f, 1.f, 0.f, 0.f);
      if (SMP) cs = rope_cs(p, tpos, d);
      float ss = half_sum32(c.x * c.x + c.y * c.y);
      float rstd = rsqrtf(ss * (1.f / 64.f) + 1e-6f);
      c.x *= rstd * g0; c.y *= rstd * g1;
      if (SMP) rope_apply(c.x, c.y, cs, d);
    }
    if (SEG == 0) *(unsigned*)(p.Q1() + (size_t)T * 512 + col) = pack2(c.x * 0.18033688011112042f, c.y * 0.18033688011112042f);
    if (SEG == 1) {
      *(unsigned*)(p.KA() + kvoff(SMP, b, hh, tpos, 2, 64, 1280, 256) + d) = pack2(c.x, c.y);
      if (!SMP) *(float2*)(p.out + OUT_AK + ((size_t)(b * 2 + hh) * 256 + tpos) * 64 + d) = c;
    }
    if (SEG == 2) {
      *(unsigned*)(p.VA() + kvoff(SMP, b, hh, tpos, 2, 64, 1280, 256) + d) = pack2(c.x, c.y);
      if (!SMP) *(float2*)(p.out + OUT_AV + ((size_t)(b * 2 + hh) * 256 + tpos) * 64 + d) = c;
    }
    if (SEG == 3) *(unsigned*)(p.Q2() + (size_t)T * 512 + (col - 768)) = pack2(c.x, c.y);
    if (SEG == 4) *(unsigned*)(p.RK() + kvoff(SMP, b, hh, tpos, 8, 64, 1024, 0) + d) = pack2(c.x * 0.125f, c.y * 0.125f);
    if (SEG == 5) *(unsigned*)(p.RV() + kvoff(SMP, b, hh, tpos, 8, 64, 1024, 0) + d) = pack2(c.x, c.y);
    if (SEG == 6) *(unsigned*)(p.SG() + (size_t)T * 512 + (col - 2304)) = pack2(silu_f(c.x), silu_f(c.y));
  }
}
template <bool SMP> DEV void epi0_disp(const Params& p, int m0, int n0, const float* Cs) {
  if (n0 < 512) epi0_rows<0, SMP>(p, m0, n0, Cs);
  else if (n0 < 640) epi0_rows<1, SMP>(p, m0, n0, Cs);
  else if (n0 < 768) epi0_rows<2, SMP>(p, m0, n0, Cs);
  else if (n0 < 1280) epi0_rows<3, SMP>(p, m0, n0, Cs);
  else if (n0 < 1792) epi0_rows<4, SMP>(p, m0, n0, Cs);
  else if (n0 < 2304) epi0_rows<5, SMP>(p, m0, n0, Cs);
  else epi0_rows<6, SMP>(p, m0, n0, Cs);
}
DEV void epi_inproj0(const Params& p, int m0, int n0, const float* Cs) {
  if (m0 >= 4096) epi0_disp<true>(p, m0, n0, Cs); else epi0_disp<false>(p, m0, n0, Cs);
}
template <int SEG, bool SMP>
DEV void epi1_rows(const Params& p, int m0, int n0, const float* Cs) {
  int lane = threadIdx.x & 63, wave = threadIdx.x >> 6;
  int col = n0 + lane * 2; int d = col & 63;
  int segbase = SEG == 0 ? 0 : SEG == 1 ? 512 : SEG == 2 ? 1024 : SEG == 3 ? 1536 : SEG == 4 ? 2048 : 2176;
  int hh = (SEG == 2) ? (col - segbase) >> 7 : (col - segbase) >> 6;
  int dd = (col - 1024) & 127;
  constexpr bool ROPE = SMP && (SEG == 0 || SEG == 1 || SEG == 3 || SEG == 4);
#pragma unroll 4
  for (int i = 0; i < 32; i++) {
    int rr = wave + 4 * i;
    int T = m0 + rr;
    int b = SMP ? (T - 4096) >> 10 : T >> 8;
    int tpos = SMP ? (T - 4096) & 1023 : T & 255;
    float2 c = *(const float2*)(Cs + rr * 128 + lane * 2);
    if (!SMP) {
      if (SEG == 1) *(float2*)(p.out + OUT_CK + ((size_t)(b * 8 + hh) * 256 + tpos) * 64 + d) = c;
      if (SEG == 2) *(float2*)(p.out + OUT_CV + ((size_t)(b * 4 + hh) * 256 + tpos) * 128 + dd) = c;
      if (SEG == 4) *(float2*)(p.out + OUT_DK + ((size_t)(b * 2 + hh) * 256 + tpos) * 64 + d) = c;
      if (SEG == 5) *(float2*)(p.out + OUT_DV + ((size_t)(b * 2 + hh) * 256 + tpos) * 64 + d) = c;
    }
    if (ROPE) { float4 cs = rope_cs(p, tpos, d); rope_apply(c.x, c.y, cs, d); }
    if (SEG == 0) *(unsigned*)(p.Q1() + (size_t)T * 512 + col) = pack2(c.x * 0.18033688011112042f, c.y * 0.18033688011112042f);
    if (SEG == 1) *(unsigned*)(p.KC() + kvoff(SMP, b, hh, tpos, 8, 64, 1280, 256) + d) = pack2(c.x, c.y);
    if (SEG == 2) *(unsigned*)(p.VC() + kvoff(SMP, b, hh, tpos, 4, 128, 1280, 256) + dd) = pack2(c.x, c.y);
    if (SEG == 3) *(unsigned*)(p.Q2() + (size_t)T * 512 + (col - 1536)) = pack2(c.x * 0.18033688011112042f, c.y * 0.18033688011112042f);
    if (SEG == 4) *(unsigned*)(p.KD() + kvoff(SMP, b, hh, tpos, 2, 64, 1280, 256) + d) = pack2(c.x, c.y);
    if (SEG == 5) *(unsigned*)(p.VD() + kvoff(SMP, b, hh, tpos, 2, 64, 1280, 256) + d) = pack2(c.x, c.y);
  }
}
template <bool SMP> DEV void epi1_disp(const Params& p, int m0, int n0, const float* Cs) {
  if (n0 < 512) epi1_rows<0, SMP>(p, m0, n0, Cs);
  else if (n0 < 1024) epi1_rows<1, SMP>(p, m0, n0, Cs);
  else if (n0 < 1536) epi1_rows<2, SMP>(p, m0, n0, Cs);
  else if (n0 < 2048) epi1_rows<3, SMP>(p, m0, n0, Cs);
  else if (n0 < 2176) epi1_rows<4, SMP>(p, m0, n0, Cs);
  else epi1_rows<5, SMP>(p, m0, n0, Cs);
}
DEV void epi_inproj1(const Params& p, int m0, int n0, const float* Cs) {
  if (m0 >= 4096) epi1_disp<true>(p, m0, n0, Cs); else epi1_disp<false>(p, m0, n0, Cs);
}
DEV void epi_outproj(const Params& p, int layer, int m0, int n0, const float* Cs) {
  int lane = threadIdx.x & 63, wave = threadIdx.x >> 6;
  int mb = m0 < 4096 ? 0 : 1 + ((m0 - 4096) >> 10);
  int col = n0 + lane * 2;
  float2 g = *(const float2*)(p.MOD() + (size_t)(layer * 5 + mb) * 6144 + 2048 + col);
  const float* xbase = (layer == 0) ? (m0 < 4096 ? p.xp + (size_t)m0 * 1024 : p.xs + (size_t)(m0 - 4096) * 1024) : p.X() + (size_t)m0 * 1024;
#pragma unroll 8
  for (int i = 0; i < 32; i++) {
    int rr = wave + 4 * i;
    float2 c = *(const float2*)(Cs + rr * 128 + lane * 2);
    float2 x = *(const float2*)(xbase + (size_t)rr * 1024 + col);
    x.x += g.x * c.x; x.y += g.y * c.y;
    *(float2*)(p.X() + (size_t)(m0 + rr) * 1024 + col) = x;
  }
}

constexpr int ATT_BUF = 37888;
struct TileRegs { u32x4 k0, k1, k2, k3, v0, v1, v2, v3; };
template <int DV, bool TWOK> DEV TileRegs tile_load(const u16* __restrict__ k, const u16* __restrict__ k2, const u16* __restrict__ v) {
  int t = threadIdx.x, lane = t & 63, wave = t >> 6;
  TileRegs R;
  u32x4 z = {0u, 0u, 0u, 0u};
  R.k0 = *(const u32x4*)(k + t * 8); R.k1 = *(const u32x4*)(k + (t + 256) * 8);
  if (TWOK) { R.k2 = *(const u32x4*)(k2 + t * 8); R.k3 = *(const u32x4*)(k2 + (t + 256) * 8); } else { R.k2 = z; R.k3 = z; }
  R.v0 = *(const u32x4*)(v + (size_t)lane * DV + wave * 8); R.v1 = *(const u32x4*)(v + (size_t)lane * DV + (wave + 4) * 8);
  if (DV == 128) { R.v2 = *(const u32x4*)(v + (size_t)lane * DV + (wave + 8) * 8); R.v3 = *(const u32x4*)(v + (size_t)lane * DV + (wave + 12) * 8); } else { R.v2 = z; R.v3 = z; }
  return R;
}
DEV void store8t(u16* d, u32x4 x) {
  d[0 * 76] = (u16)(x[0] & 0xffff); d[1 * 76] = (u16)(x[0] >> 16);
  d[2 * 76] = (u16)(x[1] & 0xffff); d[3 * 76] = (u16)(x[1] >> 16);
  d[4 * 76] = (u16)(x[2] & 0xffff); d[5 * 76] = (u16)(x[2] >> 16);
  d[6 * 76] = (u16)(x[3] & 0xffff); d[7 * 76] = (u16)(x[3] >> 16);
}
template <int DV, bool TWOK> DEV void tile_store(const TileRegs R, char* buf) {
  int t = threadIdx.x, lane = t & 63, wave = t >> 6;
  u16* sK = (u16*)buf; u16* sK2 = sK + 64 * 72; u16* sVT = sK + 2 * 64 * 72;
  int key = t >> 3, dc = t & 7;
  *(u32x4*)(sK + key * 72 + dc * 8) = R.k0; *(u32x4*)(sK + (key + 32) * 72 + dc * 8) = R.k1;
  if (TWOK) { *(u32x4*)(sK2 + key * 72 + dc * 8) = R.k2; *(u32x4*)(sK2 + (key + 32) * 72 + dc * 8) = R.k3; }
  store8t(sVT + (wave * 8) * 76 + lane, R.v0); store8t(sVT + ((wave + 4) * 8) * 76 + lane, R.v1);
  if (DV == 128) { store8t(sVT + ((wave + 8) * 8) * 76 + lane, R.v2); store8t(sVT + ((wave + 12) * 8) * 76 + lane, R.v3); }
}
DEV void load_ident_k(u16* sK) {
  int t = threadIdx.x;
#pragma unroll
  for (int i = 0; i < 2; i++) {
    int c = t + 256 * i; int key = c >> 3, dc = c & 7;
    unsigned w[4] = {0u, 0u, 0u, 0u};
    uint4 z = make_uint4(0u, 0u, 0u, 0u);
    if (dc == (key >> 3)) {
      int e = key & 7; unsigned one = (e & 1) ? 0x3F800000u : 0x00003F80u;
      if ((e >> 1) == 0) z.x = one; else if ((e >> 1) == 1) z.y = one; else if ((e >> 1) == 2) z.z = one; else z.w = one;
    }
    (void)w;
    *(uint4*)(sK + key * 72 + dc * 8) = z;
  }
}
DEV void load_state_v(const float* __restrict__ S0, u16* sVT) {
  int lane = threadIdx.x & 63, wave = threadIdx.x >> 6;
#pragma unroll
  for (int i = 0; i < 2; i++) {
    int dc = wave + 4 * i;
    float4 a = *(const float4*)(S0 + lane * 64 + dc * 8), b = *(const float4*)(S0 + lane * 64 + dc * 8 + 4);
    u16* d = sVT + (dc * 8) * 76 + lane;
    d[0 * 76] = f2bf(a.x); d[1 * 76] = f2bf(a.y); d[2 * 76] = f2bf(a.z); d[3 * 76] = f2bf(a.w);
    d[4 * 76] = f2bf(b.x); d[5 * 76] = f2bf(b.y); d[6 * 76] = f2bf(b.z); d[7 * 76] = f2bf(b.w);
  }
}
template <int DV, class F>
DEV void attn_compute(const bf16x8 (&qf)[4], f32x16 (&o)[DV / 32], const u16* sK, const u16* sVT, F&& xform) {
  int lane = threadIdx.x & 63, r = lane & 31, h = lane >> 5;
  f32x16 st[2]; zero16(st[0]); zero16(st[1]);
#pragma unroll
  for (int sub = 0; sub < 2; sub++)
#pragma unroll
    for (int kk = 0; kk < 4; kk++) {
      bf16x8 kf = *(const bf16x8*)(sK + (sub * 32 + r) * 72 + kk * 16 + h * 8);
      st[sub] = mfma32(kf, qf[kk], st[sub]);
    }
  xform(st);
  bf16x8 pf[2][2];
#pragma unroll
  for (int sub = 0; sub < 2; sub++)
#pragma unroll
    for (int s = 0; s < 2; s++) {
      u32x4 w;
      w[0] = pack2(st[sub][8 * s + 0], st[sub][8 * s + 1]); w[1] = pack2(st[sub][8 * s + 2], st[sub][8 * s + 3]);
      w[2] = pack2(st[sub][8 * s + 4], st[sub][8 * s + 5]); w[3] = pack2(st[sub][8 * s + 6], st[sub][8 * s + 7]);
      pf[sub][s] = __builtin_bit_cast(bf16x8, w);
    }
#pragma unroll
  for (int ds = 0; ds < DV / 32; ds++)
#pragma unroll
    for (int sub = 0; sub < 2; sub++)
#pragma unroll
      for (int s = 0; s < 2; s++) {
        const u16* vp = sVT + (ds * 32 + r) * 76 + sub * 32 + s * 16 + 4 * h;
        uint2 lo = *(const uint2*)vp, hi = *(const uint2*)(vp + 8);
        u32x4 w; w[0] = lo.x; w[1] = lo.y; w[2] = hi.x; w[3] = hi.y;
        o[ds] = mfma32(__builtin_bit_cast(bf16x8, w), pf[sub][s], o[ds]);
      }
}
template <int DV, class F>
DEV void attn_compute_sub(const bf16x8 (&qf)[4], f32x16 (&o)[DV / 32], const u16* sK, const u16* sVT, F&& xform) {
  int lane = threadIdx.x & 63, r = lane & 31, h = lane >> 5;
#pragma unroll
  for (int sub = 0; sub < 2; sub++) {
    f32x16 st; zero16(st);
#pragma unroll
    for (int kk = 0; kk < 4; kk++) {
      bf16x8 kf = *(const bf16x8*)(sK + (sub * 32 + r) * 72 + kk * 16 + h * 8);
      st = mfma32(kf, qf[kk], st);
    }
    xform(sub, st);
    bf16x8 pf[2];
#pragma unroll
    for (int s2 = 0; s2 < 2; s2++) {
      u32x4 w;
      w[0] = pack2(st[8 * s2 + 0], st[8 * s2 + 1]); w[1] = pack2(st[8 * s2 + 2], st[8 * s2 + 3]);
      w[2] = pack2(st[8 * s2 + 4], st[8 * s2 + 5]); w[3] = pack2(st[8 * s2 + 6], st[8 * s2 + 7]);
      pf[s2] = __builtin_bit_cast(bf16x8, w);
    }
#pragma unroll
    for (int ds = 0; ds < DV / 32; ds++)
#pragma unroll
      for (int s2 = 0; s2 < 2; s2++) {
        const u16* vp = sVT + (ds * 32 + r) * 76 + sub * 32 + s2 * 16 + 4 * h;
        uint2 lo = *(const uint2*)vp, hi = *(const uint2*)(vp + 8);
        u32x4 w; w[0] = lo.x; w[1] = lo.y; w[2] = hi.x; w[3] = hi.y;
        o[ds] = mfma32(__builtin_bit_cast(bf16x8, w), pf[s2], o[ds]);
      }
  }
}
template <int DV>
DEV void softmax_xform1(f32x16& st, f32x16 (&o)[DV / 32], float& m, float& l) {
  float mx = -1e30f;
#pragma unroll
  for (int g = 0; g < 16; g++) mx = fmaxf(mx, st[g]);
  mx = fmaxf(mx, __shfl_xor(mx, 32));
  float mnew = fmaxf(m, mx);
  float alpha = __builtin_amdgcn_exp2f(m - mnew);
  m = mnew;
  float ls = 0.f;
#pragma unroll
  for (int g = 0; g < 16; g++) { float pv = __builtin_amdgcn_exp2f(st[g] - mnew); st[g] = pv; ls += pv; }
  l = l * alpha + ls;
#pragma unroll
  for (int ds = 0; ds < DV / 32; ds++)
#pragma unroll
    for (int g = 0; g < 16; g++) o[ds][g] *= alpha;
}
template <int DV, bool TWOK, class PF, class XF, class XF1>
DEV void attn_loop(int n, PF&& ptrs, const bf16x8 (&qf)[4], f32x16 (&o)[DV / 32], char* smem, XF&& xf, XF1&& xf1) {
  int wave = threadIdx.x >> 6;
  int kofs = (TWOK && wave >= 2) ? 64 * 72 : 0;
  TileRegs R;
  const u16 *kp, *kp2, *vp;
  ptrs(0, kp, kp2, vp); R = tile_load<DV, TWOK>(kp, kp2, vp);
  __syncthreads();
  tile_store<DV, TWOK>(R, smem);
  if (n > 1) { ptrs(1, kp, kp2, vp); R = tile_load<DV, TWOK>(kp, kp2, vp); }
  __syncthreads();
  const u16* b0k = (const u16*)smem + kofs; const u16* b0v = (const u16*)smem + 2 * 64 * 72;
  const u16* b1k = (const u16*)(smem + ATT_BUF) + kofs; const u16* b1v = (const u16*)(smem + ATT_BUF) + 2 * 64 * 72;
  for (int ti = 0; ti < n; ti++) {
    const u16* bk = (ti & 1) ? b1k : b0k; const u16* bv = (ti & 1) ? b1v : b0v;
    if constexpr (DV == 128) attn_compute_sub<DV>(qf, o, bk, bv, [&](int sub, f32x16& st) { xf1(ti, sub, st); });
    else attn_compute<DV>(qf, o, bk, bv, [&](f32x16 (&st)[2]) { xf(ti, st); });
    if (ti + 1 < n) tile_store<DV, TWOK>(R, smem + ((ti + 1) & 1) * ATT_BUF);
    if (ti + 2 < n) { ptrs(ti + 2, kp, kp2, vp); R = tile_load<DV, TWOK>(kp, kp2, vp); }
    __syncthreads();
  }
}
template <int DV>
DEV void softmax_xform(f32x16 (&st)[2], f32x16 (&o)[DV / 32], float& m, float& l, bool masked, int kpos0, int qpos) {
  int h = (threadIdx.x & 63) >> 5;
  float mx = -1e30f;
#pragma unroll
  for (int sub = 0; sub < 2; sub++)
#pragma unroll
    for (int g = 0; g < 16; g++) {
      float s = st[sub][g];
      if (masked) {
        int j = kpos0 + sub * 32 + (g & 3) + 8 * (g >> 2) + 4 * h;
        int dl = qpos - j; if (dl < 0) dl = -dl;
        if (dl > 128) s = -1e30f;
        st[sub][g] = s;
      }
      mx = fmaxf(mx, s);
    }
  mx = fmaxf(mx, __shfl_xor(mx, 32));
  float mnew = fmaxf(m, mx);
  float alpha = __builtin_amdgcn_exp2f(m - mnew);
  m = mnew;
  float ls = 0.f;
#pragma unroll
  for (int sub = 0; sub < 2; sub++)
#pragma unroll
    for (int g = 0; g < 16; g++) { float pv = __builtin_amdgcn_exp2f(st[sub][g] - mnew); st[sub][g] = pv; ls += pv; }
  l = l * alpha + ls;
#pragma unroll
  for (int ds = 0; ds < DV / 32; ds++)
#pragma unroll
    for (int g = 0; g < 16; g++) o[ds][g] *= alpha;
}

template <int DV, bool TWOK>
DEV void attn_softmax_job(const Params& p, const u16* Q, int Tq0, int qcol, const u16* kb, const u16* kb2, const u16* vb,
                          int nplain, int band_lo, int band_hi, int qpos0, bool use_sink, float sinkv,
                          f32x16 (&o)[DV / 32], char* smem) {
  int lane = threadIdx.x & 63, wave = threadIdx.x >> 6, r = lane & 31, h = lane >> 5;
  int qrow = TWOK ? (wave & 1) * 32 : wave * 32;
  bf16x8 qf[4];
#pragma unroll
  for (int kk = 0; kk < 4; kk++) qf[kk] = *(const bf16x8*)(Q + (size_t)(Tq0 + qrow + r) * 512 + qcol + kk * 16 + h * 8);
#pragma unroll
  for (int ds = 0; ds < DV / 32; ds++) zero16(o[ds]);
  float m = use_sink ? sinkv : -1e30f;
  float l = (use_sink && h == 0) ? 1.f : 0.f;
  int qpos = qpos0 + qrow + r;
  int ntot = nplain + (band_hi - band_lo);
  attn_loop<DV, TWOK>(ntot,
    [&](int ti, const u16*& kp, const u16*& kp2, const u16*& vp) {
      int key0 = (ti >= nplain) ? (256 + (band_lo + ti - nplain) * 64) : ti * 64;
      kp = kb + (size_t)key0 * 64; kp2 = kb2 + (size_t)key0 * 64; vp = vb + (size_t)key0 * DV;
    }, qf, o, smem,
    [&](int ti, f32x16 (&st)[2]) {
      bool masked = ti >= nplain;
      int kpos0 = (band_lo + ti - nplain) * 64;
      softmax_xform<DV>(st, o, m, l, masked, kpos0, qpos);
    },
    [&](int ti, int sub, f32x16& st) { softmax_xform1<DV>(st, o, m, l); });
  float lt = l + __shfl_xor(l, 32);
  float inv = 1.f / lt;
#pragma unroll
  for (int ds = 0; ds < DV / 32; ds++)
#pragma unroll
    for (int g = 0; g < 16; g++) o[ds][g] *= inv;
}
DEV void store_o64(const Params& p, const f32x16 (&o)[2], int Tq0, int mixcol) {
  int lane = threadIdx.x & 63, wave = threadIdx.x >> 6, r = lane & 31, h = lane >> 5;
  int T = Tq0 + wave * 32 + r;
#pragma unroll
  for (int ds = 0; ds < 2; ds++)
#pragma unroll
    for (int g4 = 0; g4 < 4; g4++) {
      int d0 = ds * 32 + 8 * g4 + 4 * h;
      *(uint2*)(p.MIX() + (size_t)T * 1024 + mixcol + d0) =
          make_uint2(pack2(o[ds][4 * g4], o[ds][4 * g4 + 1]), pack2(o[ds][4 * g4 + 2], o[ds][4 * g4 + 3]));
    }
}

DEV void ret_job(const Params& p, bool smp, int b, int hh, int qb, char* smem) {
  u16* sK = (u16*)smem; u16* sVT = sK + 2 * 64 * 72;
  int lane = threadIdx.x & 63, wave = threadIdx.x >> 6, r = lane & 31, h = lane >> 5;
  int L = smp ? 1024 : 256;
  int Tq0 = (smp ? 4096 + b * 1024 : b * 256) + qb * 128;
  const u16* kb = p.RK() + kvoff(smp, b, hh, 0, 8, 64, 1024, 0);
  const u16* vb = p.RV() + kvoff(smp, b, hh, 0, 8, 64, 1024, 0);
  float xf = p.rdf[hh], xb = p.rdb[hh];
  float lf2 = -log1pf(__expf(-xf)) * 1.4426950408889634f;
  float lb2 = -log1pf(__expf(-xb)) * 1.4426950408889634f;
  bf16x8 qf[4];
#pragma unroll
  for (int kk = 0; kk < 4; kk++) qf[kk] = *(const bf16x8*)(p.Q2() + (size_t)(Tq0 + wave * 32 + r) * 512 + hh * 64 + kk * 16 + h * 8);
  f32x16 o[2]; zero16(o[0]); zero16(o[1]);
  int qpos = qb * 128 + wave * 32 + r;
  int nt = L / 64;
  attn_loop<64, false>(nt,
    [&](int ti, const u16*& kp, const u16*& kp2, const u16*& vp) { kp = kb + (size_t)ti * 4096; kp2 = kp; vp = vb + (size_t)ti * 4096; },
    qf, o, smem,
    [&](int ti, f32x16 (&st)[2]) {
      int kpos0 = ti * 64;
#pragma unroll
      for (int sub = 0; sub < 2; sub++)
#pragma unroll
        for (int g = 0; g < 16; g++) {
          int j = kpos0 + sub * 32 + (g & 3) + 8 * (g >> 2) + 4 * h;
          int dl = qpos - j;
          float e = dl >= 0 ? lf2 * (float)dl : lb2 * (float)(-dl);
          st[sub][g] *= __builtin_amdgcn_exp2f(e);
        }
    },
    [&](int ti, int sub, f32x16& st) {});
  if (smp) {
    for (int dir = 0; dir < 2; dir++) {
      const float* S0 = (dir == 0 ? p.srf : p.srb) + (size_t)(b * 8 + hh) * 4096;
      float rs = dir == 0 ? exp2f(lf2 * (float)(qpos + 1)) : exp2f(lb2 * (float)(L - qpos));
      __syncthreads();
      load_ident_k(sK);
      load_state_v(S0, sVT);
      __syncthreads();
      attn_compute<64>(qf, o, sK, sVT, [&](f32x16 (&st)[2]) {
#pragma unroll
        for (int sub = 0; sub < 2; sub++)
#pragma unroll
          for (int g = 0; g < 16; g++) st[sub][g] *= rs;
      });
    }
  }
  float sum = 0.f;
#pragma unroll
  for (int ds = 0; ds < 2; ds++)
#pragma unroll
    for (int g = 0; g < 16; g++) sum += o[ds][g];
  sum += __shfl_xor(sum, 32);
  float mean = sum * (1.f / 64.f);
  float vs = 0.f;
#pragma unroll
  for (int ds = 0; ds < 2; ds++)
#pragma unroll
    for (int g = 0; g < 16; g++) { float dlt = o[ds][g] - mean; vs += dlt * dlt; }
  vs += __shfl_xor(vs, 32);
  float rstd = rsqrtf(vs * (1.f / 64.f) + 1e-6f);
  int T = Tq0 + wave * 32 + r;
#pragma unroll
  for (int ds = 0; ds < 2; ds++)
#pragma unroll
    for (int g4 = 0; g4 < 4; g4++) {
      int d0 = ds * 32 + 8 * g4 + 4 * h;
      uint2 gt = *(const uint2*)(p.SG() + (size_t)T * 512 + hh * 64 + d0);
      float y0 = (o[ds][4 * g4] - mean) * rstd * bflo(gt.x), y1 = (o[ds][4 * g4 + 1] - mean) * rstd * bfhi(gt.x);
      float y2 = (o[ds][4 * g4 + 2] - mean) * rstd * bflo(gt.y), y3 = (o[ds][4 * g4 + 3] - mean) * rstd * bfhi(gt.y);
      *(uint2*)(p.MIX() + (size_t)T * 1024 + 512 + hh * 64 + d0) = make_uint2(pack2(y0, y1), pack2(y2, y3));
    }
}
DEV void ret_state_job(const Params& p, int b, int hh, int dir, char* smem) {
  u16* sKk = (u16*)smem; u16* sVv = sKk + 64 * 64;
  int t = threadIdx.x;
  const u16* kb = p.RK() + kvoff(false, b, hh, 0, 8, 64, 1024, 0);
  const u16* vb = p.RV() + kvoff(false, b, hh, 0, 8, 64, 1024, 0);
  float xx = dir == 0 ? p.rdf[hh] : p.rdb[hh];
  float lg2 = -log1pf(__expf(-xx)) * 1.4426950408889634f;
  int dk = t >> 2, dvc = (t & 3) * 16;
  float acc[16];
#pragma unroll
  for (int i = 0; i < 16; i++) acc[i] = 0.f;
  for (int ch = 0; ch < 4; ch++) {
    __syncthreads();
#pragma unroll
    for (int i = 0; i < 2; i++) {
      int c = t + 256 * i;
      *(uint4*)(sKk + c * 8) = *(const uint4*)(kb + (size_t)ch * 4096 + c * 8);
      *(uint4*)(sVv + c * 8) = *(const uint4*)(vb + (size_t)ch * 4096 + c * 8);
    }
    __syncthreads();
    for (int jj = 0; jj < 64; jj++) {
      int j = ch * 64 + jj;
      float w = exp2f(lg2 * (float)(dir == 0 ? 255 - j : j));
      float kv = bf2f(sKk[jj * 64 + dk]) * w;
      const uint4* vp = (const uint4*)(sVv + jj * 64 + dvc);
      uint4 v0 = vp[0], v1 = vp[1];
      acc[0] += kv * bflo(v0.x); acc[1] += kv * bfhi(v0.x); acc[2] += kv * bflo(v0.y); acc[3] += kv * bfhi(v0.y);
      acc[4] += kv * bflo(v0.z); acc[5] += kv * bfhi(v0.z); acc[6] += kv * bflo(v0.w); acc[7] += kv * bfhi(v0.w);
      acc[8] += kv * bflo(v1.x); acc[9] += kv * bfhi(v1.x); acc[10] += kv * bflo(v1.y); acc[11] += kv * bfhi(v1.y);
      acc[12] += kv * bflo(v1.z); acc[13] += kv * bfhi(v1.z); acc[14] += kv * bflo(v1.w); acc[15] += kv * bfhi(v1.w);
    }
  }
  float* dst = p.out + (dir == 0 ? OUT_RF : OUT_RB) + ((size_t)(b * 8 + hh) * 64 + dk) * 64 + dvc;
#pragma unroll
  for (int i = 0; i < 4; i++) *(float4*)(dst + 4 * i) = make_float4(acc[4 * i], acc[4 * i + 1], acc[4 * i + 2], acc[4 * i + 3]);
}

DEV void phase_attn0(const Params& p, int bid, int nb, char* smem) {
  for (int it = bid; it < 1280 + 2048; it += nb) {
    if (it >= 1280) {
      int j = it - 1280;
      if (j < 1024) prep_quant<true>(p.peer_u, p.U8(), p.SU(), j * 16); else prep_quant<false>(p.peer_v, p.V8(), p.SV(), (j - 1024) * 16);
    } else if (it < 256) {
      int b = it >> 6, hq = (it >> 3) & 7, qb = it & 7; int kvh = hq >> 2;
      f32x16 o[2];
      int Tq0 = 4096 + b * 1024 + qb * 128;
      attn_softmax_job<64, false>(p, p.Q1(), Tq0, hq * 64, p.KA() + kvoff(true, b, kvh, -256, 2, 64, 1280, 256), p.KA(), p.VA() + kvoff(true, b, kvh, -256, 2, 64, 1280, 256),
                           20, 0, 0, qb * 128, false, 0.f, o, smem);
      store_o64(p, o, Tq0, hq * 64);
    } else if (it < 512) {
      int j = it - 256; int b = j >> 6, hh = (j >> 3) & 7, qb = j & 7;
      ret_job(p, true, b, hh, qb, smem);
    } else if (it < 768) {
      int j = it - 512; int b = j >> 4, hq = (j >> 1) & 7, qb = j & 1; int kvh = hq >> 2;
      f32x16 o[2];
      int Tq0 = b * 256 + qb * 128;
      attn_softmax_job<64, false>(p, p.Q1(), Tq0, hq * 64, p.KA() + kvoff(false, b, kvh, 0, 2, 64, 1280, 256), p.KA(), p.VA() + kvoff(false, b, kvh, 0, 2, 64, 1280, 256),
                           4, 0, 0, qb * 128, false, 0.f, o, smem);
      store_o64(p, o, Tq0, hq * 64);
    } else if (it < 1024) {
      int j = it - 768; int b = j >> 4, hh = (j >> 1) & 7, qb = j & 1;
      ret_job(p, false, b, hh, qb, smem);
    } else {
      int j = it - 1024; int b = j >> 4, hh = (j >> 1) & 7, dir = j & 1;
      ret_state_job(p, b, hh, dir, smem);
    }
  }
}
DEV void diff_job(const Params& p, bool smp, int b, int hh, int qb, float lam, char* smem) {
  int lane = threadIdx.x & 63, wave = threadIdx.x >> 6, r = lane & 31, h = lane >> 5;
  int c = wave >> 1;
  int Tq0 = (smp ? 4096 + b * 1024 : b * 256) + qb * 64;
  int nt = smp ? 20 : 4;
  const u16* vb = p.VC() + kvoff(smp, b, hh, smp ? -256 : 0, 4, 128, 1280, 256);
  const u16* kb0 = p.KC() + kvoff(smp, b, 2 * hh, smp ? -256 : 0, 8, 64, 1280, 256);
  const u16* kb1 = p.KC() + kvoff(smp, b, 2 * hh + 1, smp ? -256 : 0, 8, 64, 1280, 256);
  f32x16 o[4];
  attn_softmax_job<128, true>(p, p.Q1(), Tq0, (2 * hh + c) * 64, kb0, kb1, vb, nt, 0, 0, 0, false, 0.f, o, smem);
  float* ex = (float*)smem;
  if (wave >= 2) {
#pragma unroll
    for (int ds = 0; ds < 4; ds++)
#pragma unroll
      for (int g = 0; g < 16; g++) ex[(ds * 16 + g) * 128 + (threadIdx.x - 128)] = o[ds][g];
  }
  __syncthreads();
  if (wave < 2) {
    float ss = 0.f;
#pragma unroll
    for (int ds = 0; ds < 4; ds++)
#pragma unroll
      for (int g = 0; g < 16; g++) { float dv = o[ds][g] - lam * ex[(ds * 16 + g) * 128 + threadIdx.x]; o[ds][g] = dv; ss += dv * dv; }
    ss += __shfl_xor(ss, 32);
    float rstd = rsqrtf(ss * (1.f / 128.f) + 1e-6f) * (1.f - LAM_INIT);
    int T = Tq0 + wave * 32 + r;
#pragma unroll
    for (int ds = 0; ds < 4; ds++)
#pragma unroll
      for (int g4 = 0; g4 < 4; g4++) {
        int d0 = ds * 32 + 8 * g4 + 4 * h;
        float4 sg = *(const float4*)(p.subln + d0);
        *(uint2*)(p.MIX() + (size_t)T * 1024 + hh * 128 + d0) =
            make_uint2(pack2(o[ds][4 * g4] * rstd * sg.x, o[ds][4 * g4 + 1] * rstd * sg.y),
                       pack2(o[ds][4 * g4 + 2] * rstd * sg.z, o[ds][4 * g4 + 3] * rstd * sg.w));
      }
  }
}
DEV void phase_attn1(const Params& p, int bid, int nb, char* smem) {
  float d1 = 0.f, d2 = 0.f;
  for (int i = 0; i < 64; i++) { d1 += p.lq1[i] * p.lk1[i]; d2 += p.lq2[i] * p.lk2[i]; }
  float lam = __expf(d1) - __expf(d2) + LAM_INIT;
  for (int it = bid; it < 1024 + 2048; it += nb) {
    if (it >= 1024) {
      int j = it - 1024;
      if (j < 1024) prep_quant<true>(p.peer_u, p.U8(), p.SU(), 16384 + j * 16); else prep_quant<false>(p.peer_v, p.V8(), p.SV(), 16384 + (j - 1024) * 16);
    } else if (it < 256) {
      int b = it >> 6, hh = (it >> 4) & 3, qb = it & 15;
      diff_job(p, true, b, hh, qb, lam, smem);
    } else if (it < 512) {
      int j = it - 256; int b = j >> 6, hq = (j >> 3) & 7, qb = j & 7; int kvh = hq >> 2;
      int q0 = qb * 128;
      int lo = (q0 - 128 < 0 ? 0 : q0 - 128) >> 6, hi = (q0 + 256 > 1024 ? 1024 : q0 + 256) >> 6;
      f32x16 o[2];
      int Tq0 = 4096 + b * 1024 + q0;
      attn_softmax_job<64, false>(p, p.Q2(), Tq0, hq * 64, p.KD() + kvoff(true, b, kvh, -256, 2, 64, 1280, 256), p.KD(), p.VD() + kvoff(true, b, kvh, -256, 2, 64, 1280, 256),
                           4, lo, hi, q0, true, p.dsink[hq] * 1.4426950408889634f, o, smem);
      store_o64(p, o, Tq0, 512 + hq * 64);
    } else if (it < 768) {
      int j = it - 512; int b = j >> 4, hh = (j >> 2) & 3, qb = j & 3;
      diff_job(p, false, b, hh, qb, lam, smem);
    } else {
      int j = it - 768; int b = j >> 4, hq = (j >> 1) & 7, qb = j & 1; int kvh = hq >> 2;
      f32x16 o[2];
      int Tq0 = b * 256 + qb * 128;
      attn_softmax_job<64, false>(p, p.Q2(), Tq0, hq * 64, p.KD() + kvoff(false, b, kvh, 0, 2, 64, 1280, 256), p.KD(), p.VD() + kvoff(false, b, kvh, 0, 2, 64, 1280, 256),
                           4, 0, 0, qb * 128, true, p.dsink[hq] * 1.4426950408889634f, o, smem);
      store_o64(p, o, Tq0, 512 + hq * 64);
    }
  }
}

DEV float ub0(unsigned w) { return (float)(w & 255u); }
DEV float ub1(unsigned w) { return (float)((w >> 8) & 255u); }
DEV float ub2(unsigned w) { return (float)((w >> 16) & 255u); }
DEV float ub3(unsigned w) { return (float)(w >> 24); }
DEV void phase_peer(const Params& p, int layer, int bid, int nb, char* smem) {
  int wave = threadIdx.x >> 6, lane = threadIdx.x & 63;
  float* ws1 = (float*)(smem + wave * 2048); float* ws2 = ws1 + 16;
  int* wi1 = (int*)(ws2 + 16); int* wi2 = wi1 + 16; float* es = (float*)(wi2 + 16); int* eidx = (int*)(es + 16); float* eg = (float*)(eidx + 128);
  const unsigned char* U = p.U8() + (size_t)layer * 16384 * 1024;
  const unsigned char* V = p.V8() + (size_t)layer * 16384 * 1024;
  const float* SU = p.SU() + layer * 16384; const float* SV = p.SV() + layer * 16384;
  const float* gain = p.norm_ffn + layer * 1024;
  for (int T = bid * 4 + wave; T < 8192; T += nb * 4) {
    const float* sc = p.SC() + (size_t)T * 2048;
    for (int hh = 0; hh < 8; hh++) {
      const float* s = sc + hh * 256;
      float a0 = s[lane], a1 = s[lane + 64], b0 = s[128 + lane], b1 = s[192 + lane];
      unsigned ka0 = (fkey(a0) & ~127u) | (unsigned)(127 - lane), ka1 = (fkey(a1) & ~127u) | (unsigned)(63 - lane);
      unsigned kb0 = (fkey(b0) & ~127u) | (unsigned)(127 - lane), kb1 = (fkey(b1) & ~127u) | (unsigned)(63 - lane);
      unsigned pa = 0u, pb = 0u;
      for (int bit = 31; bit >= 0; --bit) {
        unsigned ta = pa | (1u << bit), tb = pb | (1u << bit);
        int ca = __popcll(__ballot(ka0 >= ta)) + __popcll(__ballot(ka1 >= ta));
        int cb = __popcll(__ballot(kb0 >= tb)) + __popcll(__ballot(kb1 >= tb));
        if (ca >= 16) pa = ta;
        if (cb >= 16) pb = tb;
      }
      {
        unsigned long long m0 = __ballot(ka0 >= pa), m1 = __ballot(ka1 >= pa);
        int p0 = mbcnt64(m0), p1 = __popcll(m0) + mbcnt64(m1);
        if (ka0 >= pa) { ws1[p0 & 15] = a0; wi1[p0 & 15] = lane; }
        if (ka1 >= pa) { ws1[p1 & 15] = a1; wi1[p1 & 15] = lane + 64; }
        unsigned long long n0 = __ballot(kb0 >= pb), n1 = __ballot(kb1 >= pb);
        int q0 = mbcnt64(n0), q1 = __popcll(n0) + mbcnt64(n1);
        if (kb0 >= pb) { ws2[q0 & 15] = b0; wi2[q0 & 15] = lane; }
        if (kb1 >= pb) { ws2[q1 & 15] = b1; wi2[q1 & 15] = lane + 64; }
      }
      __builtin_amdgcn_fence(__ATOMIC_ACQ_REL, "wavefront");
      __builtin_amdgcn_wave_barrier();
      int bq = lane & 15, aq = lane >> 4;
      float s2v = ws2[bq];
      float c0 = ws1[aq] + s2v, c1 = ws1[aq + 4] + s2v, c2 = ws1[aq + 8] + s2v, c3 = ws1[aq + 12] + s2v;
      unsigned k0 = (fkey(c0) & ~255u) | (unsigned)(255 - lane), k1 = (fkey(c1) & ~255u) | (unsigned)(191 - lane);
      unsigned k2 = (fkey(c2) & ~255u) | (unsigned)(127 - lane), k3 = (fkey(c3) & ~255u) | (unsigned)(63 - lane);
      unsigned pc = 0u;
      for (int bit = 31; bit >= 0; --bit) {
        unsigned tc = pc | (1u << bit);
        int cc = __popcll(__ballot(k0 >= tc)) + __popcll(__ballot(k1 >= tc)) + __popcll(__ballot(k2 >= tc)) + __popcll(__ballot(k3 >= tc));
        if (cc >= 16) pc = tc;
      }
      {
        unsigned long long m0 = __ballot(k0 >= pc), m1 = __ballot(k1 >= pc), m2 = __ballot(k2 >= pc), m3 = __ballot(k3 >= pc);
        int n0 = __popcll(m0), n1 = n0 + __popcll(m1), n2 = n1 + __popcll(m2);
        int i2b = wi2[bq];
        if (k0 >= pc) { int q = mbcnt64(m0) & 15; es[q] = c0; eidx[hh * 16 + q] = wi1[aq] * 128 + i2b; }
        if (k1 >= pc) { int q = (n0 + mbcnt64(m1)) & 15; es[q] = c1; eidx[hh * 16 + q] = wi1[aq + 4] * 128 + i2b; }
        if (k2 >= pc) { int q = (n1 + mbcnt64(m2)) & 15; es[q] = c2; eidx[hh * 16 + q] = wi1[aq + 8] * 128 + i2b; }
        if (k3 >= pc) { int q = (n2 + mbcnt64(m3)) & 15; es[q] = c3; eidx[hh * 16 + q] = wi1[aq + 12] * 128 + i2b; }
      }
      __builtin_amdgcn_fence(__ATOMIC_ACQ_REL, "wavefront");
      __builtin_amdgcn_wave_barrier();
      float ts = es[lane & 15];
      float mx = row_max16(ts);
      float pe = __expf(ts - mx);
      float sm = row_sum16(pe);
      if (lane < 16) eg[hh * 16 + lane] = pe / sm;
      __builtin_amdgcn_fence(__ATOMIC_ACQ_REL, "wavefront");
      __builtin_amdgcn_wave_barrier();
    }
    int mb = T < 4096 ? 0 : 1 + ((T - 4096) >> 10);
    const float* md = p.MOD() + (size_t)(layer * 5 + mb) * 6144;
    float4 xv[4]; float ssx = 0.f;
#pragma unroll
    for (int i = 0; i < 4; i++) { xv[i] = *(const float4*)(p.X() + (size_t)T * 1024 + (i * 64 + lane) * 4); ssx += xv[i].x * xv[i].x + xv[i].y * xv[i].y + xv[i].z * xv[i].z + xv[i].w * xv[i].w; }
    ssx = wave_sum(ssx);
    float rstdx = rsqrtf(ssx * (1.f / 1024.f) + 1e-6f);
    float4 hv[4]; float hmax = 0.f;
#pragma unroll
    for (int i = 0; i < 4; i++) {
      int col = (i * 64 + lane) * 4;
      float4 g = *(const float4*)(gain + col), sh = *(const float4*)(md + 3 * 1024 + col), scl = *(const float4*)(md + 4 * 1024 + col);
      hv[i].x = xv[i].x * rstdx * g.x * (1.f + scl.x) + sh.x; hv[i].y = xv[i].y * rstdx * g.y * (1.f + scl.y) + sh.y;
      hv[i].z = xv[i].z * rstdx * g.z * (1.f + scl.z) + sh.z; hv[i].w = xv[i].w * rstdx * g.w * (1.f + scl.w) + sh.w;
      hmax = fmaxf(hmax, fmaxf(fmaxf(fabsf(hv[i].x), fabsf(hv[i].y)), fmaxf(fabsf(hv[i].z), fabsf(hv[i].w))));
    }
    hmax = wave_max_f(hmax);
    float hinv = hmax > 0.f ? 127.f / hmax : 0.f, hscale = hmax * (1.f / 127.f);
    int hq[4];
#pragma unroll
    for (int i = 0; i < 4; i++) {
      unsigned b0 = (unsigned)((int)rintf(hv[i].x * hinv)) & 255u, b1 = (unsigned)((int)rintf(hv[i].y * hinv)) & 255u;
      unsigned b2 = (unsigned)((int)rintf(hv[i].z * hinv)) & 255u, b3 = (unsigned)((int)rintf(hv[i].w * hinv)) & 255u;
      hq[i] = (int)(b0 | (b1 << 8) | (b2 << 16) | (b3 << 24));
    }
#define PLOAD8(SET, TBL, B0) _Pragma("unroll") for (int j = 0; j < 8; j++) { \
        int e_ = __builtin_amdgcn_readfirstlane(eidx[(B0) * 8 + j]); SET[j] = *(const u32x4*)(TBL + (size_t)e_ * 1024 + lane * 16); }
#define PDOT8(SET, B0) _Pragma("unroll") for (int j = 0; j < 8; j++) { \
        int d_ = __builtin_amdgcn_sdot4(hq[0], (int)SET[j][0], 0, false); d_ = __builtin_amdgcn_sdot4(hq[1], (int)SET[j][1], d_, false); \
        d_ = __builtin_amdgcn_sdot4(hq[2], (int)SET[j][2], d_, false); d_ = __builtin_amdgcn_sdot4(hq[3], (int)SET[j][3], d_, false); \
        float D_ = (float)wave_sum_i(d_); int e_ = (B0) * 8 + j; bool me_ = lane == (e_ & 63); \
        a0 = (me_ && e_ < 64) ? D_ : a0; a1 = (me_ && e_ >= 64) ? D_ : a1; }
#define PACC8(SET, B0) _Pragma("unroll") for (int j = 0; j < 8; j++) { \
        int e_ = (B0) * 8 + j; float w = rlane(e_ < 64 ? w0 : w1, e_ & 63); \
        acc[0] += w * ub0(SET[j][0]); acc[1] += w * ub1(SET[j][0]); acc[2] += w * ub2(SET[j][0]); acc[3] += w * ub3(SET[j][0]); \
        acc[4] += w * ub0(SET[j][1]); acc[5] += w * ub1(SET[j][1]); acc[6] += w * ub2(SET[j][1]); acc[7] += w * ub3(SET[j][1]); \
        acc[8] += w * ub0(SET[j][2]); acc[9] += w * ub1(SET[j][2]); acc[10] += w * ub2(SET[j][2]); acc[11] += w * ub3(SET[j][2]); \
        acc[12] += w * ub0(SET[j][3]); acc[13] += w * ub1(SET[j][3]); acc[14] += w * ub2(SET[j][3]); acc[15] += w * ub3(SET[j][3]); }
    float acc[16];
#pragma unroll
    for (int i = 0; i < 16; i++) acc[i] = 0.f;
    float a0 = 0.f, a1 = 0.f;
    u32x4 sa[8], sb[8];
    PLOAD8(sa, U, 0)
#pragma unroll 1
    for (int bi = 0; bi < 16; bi += 2) {
      PLOAD8(sb, U, bi + 1)
      PDOT8(sa, bi)
      if (bi + 2 < 16) { PLOAD8(sa, U, bi + 2) } else { PLOAD8(sa, V, 0) }
      PDOT8(sb, bi + 1)
    }
    int e0 = eidx[lane], e1 = eidx[lane + 64];
    float w0 = eg[lane] * gelu_tanh(a0 * (SU[e0] * hscale)) * SV[e0];
    float w1 = eg[lane + 64] * gelu_tanh(a1 * (SU[e1] * hscale)) * SV[e1];
    float wsum = wave_sum(w0 + w1);
#pragma unroll 1
    for (int bi = 0; bi < 16; bi += 2) {
      PLOAD8(sb, V, bi + 1)
      PACC8(sa, bi)
      if (bi + 2 < 16) { PLOAD8(sa, V, bi + 2) }
      PACC8(sb, bi + 1)
    }
    float x2[16]; float ss = 0.f;
#pragma unroll
    for (int i = 0; i < 4; i++) {
      int col = (i * 64 + lane) * 4;
      float4 ga = *(const float4*)(md + 5 * 1024 + col);
      x2[i * 4 + 0] = xv[i].x + ga.x * (acc[i * 4 + 0] - 128.f * wsum); x2[i * 4 + 1] = xv[i].y + ga.y * (acc[i * 4 + 1] - 128.f * wsum);
      x2[i * 4 + 2] = xv[i].z + ga.z * (acc[i * 4 + 2] - 128.f * wsum); x2[i * 4 + 3] = xv[i].w + ga.w * (acc[i * 4 + 3] - 128.f * wsum);
    }
#pragma unroll
    for (int i = 0; i < 16; i++) ss += x2[i] * x2[i];
    ss = wave_sum(ss);
    float rstd = rsqrtf(ss * (1.f / 1024.f) + 1e-6f);
    if (layer == 0) {
      const float* md1 = p.MOD() + (size_t)(5 + mb) * 6144;
#pragma unroll
      for (int i = 0; i < 4; i++) {
        int col = (i * 64 + lane) * 4;
        *(float4*)(p.X() + (size_t)T * 1024 + col) = make_float4(x2[i * 4], x2[i * 4 + 1], x2[i * 4 + 2], x2[i * 4 + 3]);
        float4 g = *(const float4*)(p.norm_mix + 1024 + col), sh = *(const float4*)(md1 + col), scl = *(const float4*)(md1 + 1024 + col);
        float y0 = x2[i * 4] * rstd * g.x * (1.f + scl.x) + sh.x, y1 = x2[i * 4 + 1] * rstd * g.y * (1.f + scl.y) + sh.y;
        float y2 = x2[i * 4 + 2] * rstd * g.z * (1.f + scl.z) + sh.z, y3 = x2[i * 4 + 3] * rstd * g.w * (1.f + scl.w) + sh.w;
        *(uint2*)(p.H() + (size_t)T * 1024 + col) = make_uint2(pack2(y0, y1), pack2(y2, y3));
      }
    } else {
#pragma unroll
      for (int i = 0; i < 4; i++) {
        int col = (i * 64 + lane) * 4;
        float4 g = *(const float4*)(p.norm_final + col);
        *(float4*)(p.out + (size_t)T * 1024 + col) = make_float4(x2[i * 4] * rstd * g.x, x2[i * 4 + 1] * rstd * g.y, x2[i * 4 + 2] * rstd * g.z, x2[i * 4 + 3] * rstd * g.w);
      }
    }
  }
}

#define XB_TMO      128
#define XB_XCNT(j)  (256  + 64 * (j))
#define XB_XSUB(j)  (1280 + 64 * (j))
#define XB_XGEN(j)  (2304 + 64 * (j))
#define XB_TOP      3328
#define XB_TOPGEN   3392
#define XCD_BAR_WORDS 3456
#define XB_SPIN_CAP (1u << 20)
#define LAS __attribute__((address_space(3)))
DEV unsigned xb_ld(unsigned* p)              { return __hip_atomic_load(p, __ATOMIC_RELAXED, __HIP_MEMORY_SCOPE_AGENT); }
DEV unsigned xb_add(unsigned* p, unsigned v) { return __hip_atomic_fetch_add(p, v, __ATOMIC_RELAXED, __HIP_MEMORY_SCOPE_AGENT); }
DEV unsigned xb_xcc_id() { return (unsigned)__builtin_amdgcn_s_getreg((3 << 11) | 20) & 0xFu; }
#define XB_SPIN(cond, bar) do { unsigned _sp = 0; while (cond) { __builtin_amdgcn_s_sleep(4); \
    if ((++_sp & 255u) == 0u) { if (xb_ld(&(bar)[XB_TMO])) break; if (_sp > XB_SPIN_CAP) { atomicAdd(&(bar)[XB_TMO], 1u); break; } } } } while (0)
struct XcdBarrier { unsigned* bar; unsigned x; volatile LAS unsigned* st; };
DEV XcdBarrier xcd_barrier_post(unsigned* bar, volatile LAS unsigned* st) {
  XcdBarrier b; b.bar = bar; b.x = xb_xcc_id(); b.st = st;
  if (threadIdx.x == 0) (void)xb_add(&bar[XB_XCNT(b.x)], 1u);
  return b;
}
DEV void xcd_barrier_complete(unsigned* bar, unsigned x, unsigned& nloc, unsigned& nx) {
  const unsigned G = gridDim.x * gridDim.y * gridDim.z;
  unsigned sum, cnt, mine, sp = 0u;
  for (;;) {
    sum = 0u; cnt = 0u; mine = 0u;
#pragma unroll
    for (unsigned j = 0; j < 16; ++j) { const unsigned c = xb_ld(&bar[XB_XCNT(j)]); sum += c; cnt += (c > 0u) ? 1u : 0u; mine = (j == x) ? c : mine; }
    if (sum == G) break;
    __builtin_amdgcn_s_sleep(1);
    if ((++sp & 255u) == 0u) { if (xb_ld(&bar[XB_TMO])) break; if (sp > XB_SPIN_CAP) { atomicAdd(&bar[XB_TMO], 1u); break; } }
  }
  nloc = mine > 0u ? mine : 1u; nx = cnt > 0u ? cnt : 1u;
}
DEV void xcd_barrier(const XcdBarrier& b) {
  asm volatile("s_waitcnt vmcnt(0)" ::: "memory");
  __syncthreads();
  if (threadIdx.x == 0) {
    unsigned* bar = b.bar;
    __builtin_amdgcn_s_waitcnt(0);
    unsigned nloc = b.st[0], nx = b.st[1];
    if (nloc == 0u) { xcd_barrier_complete(bar, b.x, nloc, nx); b.st[0] = nloc; b.st[1] = nx; }
    const unsigned old = xb_add(&bar[XB_XSUB(b.x)], 1u);
    const unsigned gen = old / nloc;
    if (old + 1u == (gen + 1u) * nloc) {
      __builtin_amdgcn_fence(__ATOMIC_RELEASE, "agent");
      asm volatile("s_waitcnt vmcnt(0)" ::: "memory");
      const unsigned og = xb_add(&bar[XB_TOP], 1u);
      const unsigned tg = og / nx;
      if (og + 1u == (tg + 1u) * nx) xb_add(&bar[XB_TOPGEN], 1u);
      else XB_SPIN(xb_ld(&bar[XB_TOPGEN]) == tg, bar);
      __builtin_amdgcn_fence(__ATOMIC_ACQUIRE, "agent");
      xb_add(&bar[XB_XGEN(b.x)], 1u);
      asm volatile("s_waitcnt vmcnt(0)" ::: "memory");
    } else {
      XB_SPIN(xb_ld(&bar[XB_XGEN(b.x)]) == gen, bar);
      __builtin_amdgcn_fence(__ATOMIC_ACQUIRE, "agent");
      asm volatile("s_waitcnt vmcnt(0)" ::: "memory");
    }
  }
  __syncthreads();
}

constexpr int NPHASE = 16;
DEV void run_phase(const Params& p, int ph, int bid, int nb, char* smem) {
  switch (ph) {
    case 0: phase_prep(p, bid, nb, smem); break;
    case 1: phase_ada(p, 0, p.norm_mix, 0, 1, true, bid, nb); break;
    case 2: gemm_phase(p.H(), 1024, p.WT_EVIN(), 1024, 1024, 64, 22, bid, nb, smem, [&](int m0, int n0, const float* Cs) { epi_inproj0(p, m0, n0, Cs); }); break;
    case 3: phase_attn0(p, bid, nb, smem); break;
    case 4: gemm_phase(p.MIX(), 1024, p.WT_EVOUT(), 1024, 1024, 64, 8, bid, nb, smem, [&](int m0, int n0, const float* Cs) { epi_outproj(p, 0, m0, n0, Cs); }); break;
    case 5: phase_ada(p, 0, p.norm_ffn, 3, 4, false, bid, nb); break;
    case 12: phase_ada(p, 1, p.norm_ffn + 1024, 3, 4, false, bid, nb); break;
    case 6: case 13: {
      int layer = ph == 6 ? 0 : 1;
      gemm_phase(p.H(), 1024, p.WT_PQ() + (size_t)layer * 2048 * 1024, 1024, 1024, 64, 16, bid, nb, smem, [&](int m0, int n0, const float* Cs) {
        int lane = threadIdx.x & 63, wave = threadIdx.x >> 6;
#pragma unroll 8
        for (int rr = wave; rr < 128; rr += 4) {
          float2 c = *(const float2*)(Cs + rr * 128 + lane * 2);
          *(unsigned*)(p.PQ() + (size_t)(m0 + rr) * 2048 + n0 + lane * 2) = pack2(c.x, c.y);
        }
      });
    } break;
    case 7: case 14: {
      int layer = ph == 7 ? 0 : 1;
      const u16* sk = p.SUBK() + (size_t)layer * 16 * 128 * 128;
      for (int it = bid; it < 64 * 16; it += nb) {
        int mt, hc;
        if ((nb & 7) == 0) { int li = (it - (bid & 7)) >> 3; mt = 8 * (bid & 7) + (li & 7); hc = (li >> 3) & 15; } else { mt = it >> 4; hc = it & 15; }
        f32x16 acc[2][2];
        zero16(acc[0][0]); zero16(acc[0][1]); zero16(acc[1][0]); zero16(acc[1][1]);
        gemm_tile(p.PQ() + (size_t)mt * 128 * 2048 + hc * 128, 2048, sk + (size_t)hc * 128 * 128, 128, 128, smem, acc);
        const float* Cs = (const float*)smem;
        int lane = threadIdx.x & 63, wave = threadIdx.x >> 6;
#pragma unroll 8
        for (int rr = wave; rr < 128; rr += 4) {
          float2 c = *(const float2*)(Cs + rr * 128 + lane * 2);
          *(float2*)(p.SC() + (size_t)(mt * 128 + rr) * 2048 + hc * 128 + lane * 2) = c;
        }
      }
    } break;
    case 8: phase_peer(p, 0, bid, nb, smem); break;
    case 15: phase_peer(p, 1, bid, nb, smem); break;
    case 9: gemm_phase(p.H(), 1024, p.WT_ODIN(), 1024, 1024, 64, 18, bid, nb, smem, [&](int m0, int n0, const float* Cs) { epi_inproj1(p, m0, n0, Cs); }); break;
    case 10: phase_attn1(p, bid, nb, smem); break;
    case 11: gemm_phase(p.MIX(), 1024, p.WT_ODOUT(), 1024, 1024, 64, 8, bid, nb, smem, [&](int m0, int n0, const float* Cs) { epi_outproj(p, 1, m0, n0, Cs); }); break;
    default: break;
  }
}

constexpr size_t PARAMS_OFF = 330036736ull;
template <int PH> DEV void run_all(const Params& p, cg::grid_group& grid, const XcdBarrier& xb, char* smem) {
  if constexpr (PH == 0) {
    if (blockIdx.x == 0 && threadIdx.x < sizeof(Params) / 8) ((unsigned long long*)(p.ws + PARAMS_OFF))[threadIdx.x] = ((const unsigned long long*)&p)[threadIdx.x];
    run_phase(p, PH, blockIdx.x, gridDim.x, smem);
  } else {
    run_phase(p, PH, blockIdx.x, gridDim.x, smem);
  }
  if constexpr (PH + 1 < NPHASE) {
    if (PH == 0 && p.ws == nullptr) grid.sync();
    xcd_barrier(xb);
    run_all<PH + 1>(p, grid, xb, smem);
  }
}
__global__ void __launch_bounds__(256, 2) mega_kernel(Params p) {
  __shared__ __attribute__((aligned(16))) char smem[77824];
  __shared__ uint4 xb_words;
  if (threadIdx.x == 0) xb_words = make_uint4(0u, 0u, 0u, 0u);
  __syncthreads();
  XcdBarrier xb = xcd_barrier_post(p.BAR(), (volatile LAS unsigned*)&xb_words);
  cg::grid_group grid = cg::this_grid();
  run_all<0>(p, grid, xb, smem);
}
#if MULTI_LAUNCH
template <int PH> __global__ void __launch_bounds__(256, 2) phase_kernel(Params p) {
  __shared__ __attribute__((aligned(16))) char smem[77824];
  run_phase(p, PH, blockIdx.x, gridDim.x, smem);
}
template <int PH> static void launch_all(const Params& p, int grid, hipStream_t s) {
  phase_kernel<PH><<<grid, 256, 0, s>>>(p);
  if constexpr (PH + 1 < NPHASE) launch_all<PH + 1>(p, grid, s);
}
#endif

extern "C" void kernel_launch(void* const* d_in, const int* in_sizes, int n_in, void* d_out, int out_size, void* d_ws, size_t ws_size, hipStream_t stream) {
  Params p{};
  const float* const* in = (const float* const*)d_in;
  p.xp = in[0]; p.xs = in[1]; p.c = in[2]; p.cctx = in[3]; p.cak = in[4]; p.cav = in[5]; p.srf = in[6]; p.srb = in[7];
  p.cck = in[8]; p.ccv = in[9]; p.cdk = in[10]; p.cdv = in[11];
  p.mod_w = in[12]; p.mod_b = in[13]; p.norm_mix = in[14]; p.norm_ffn = in[15]; p.norm_final = in[16];
  p.ev_w_in = in[17]; p.ev_w_out = in[18]; p.a_q_norm = in[19]; p.a_k_norm = in[20]; p.rdf = in[21]; p.rdb = in[22];
  p.od_w_in = in[23]; p.od_w_out = in[24]; p.lq1 = in[25]; p.lk1 = in[26]; p.lq2 = in[27]; p.lk2 = in[28]; p.subln = in[29]; p.dsink = in[30];
  p.peer_wq = in[31]; p.peer_sk = in[32]; p.peer_u = in[33]; p.peer_v = in[34];
  p.out = (float*)d_out;
  p.ws = (char*)d_ws;
  (void)in_sizes; (void)n_in; (void)out_size; (void)ws_size;
#if MULTI_LAUNCH
  launch_all<0>(p, 512, stream);
#else
  static int grid_blocks = 0;
  if (!grid_blocks) {
    int dev = 0, cus = 0, per_cu = 0;
    hipGetDevice(&dev);
    hipDeviceGetAttribute(&cus, hipDeviceAttributeMultiprocessorCount, dev);
    hipOccupancyMaxActiveBlocksPerMultiprocessor(&per_cu, mega_kernel, 256, 0);
    if (per_cu > 2) per_cu = 2;
    if (per_cu < 1) per_cu = 1;
    grid_blocks = cus * per_cu;
  }
  (void)hipMemsetAsync(d_ws, 0, XCD_BAR_WORDS * 4, stream);
  void* args[] = {&p};
  hipError_t e = hipLaunchCooperativeKernel((void*)mega_kernel, dim3(grid_blocks), dim3(256), args, 0, stream);
  if (e != hipSuccess) fprintf(stderr, "cooperative launch failed: %s (grid %d)\n", hipGetErrorString(e), grid_blocks);
#endif
}
```

```cpp
#include <hip/hip_runtime.h>
#include <hip/hip_cooperative_groups.h>
#include <cstdio>
namespace cg = cooperative_groups;

#ifndef MULTI_LAUNCH
#define MULTI_LAUNCH 0
#endif

typedef unsigned short u16;
typedef __attribute__((ext_vector_type(8))) short bf16x8;
typedef __attribute__((ext_vector_type(16))) float f32x16;
typedef __attribute__((ext_vector_type(4))) unsigned u32x4;

#define DEV __device__ __forceinline__

constexpr size_t OUT_AK = 8388608, OUT_AV = 8912896, OUT_RF = 9437184, OUT_RB = 9961472,
                 OUT_CK = 10485760, OUT_CV = 12582912, OUT_DK = 14680064, OUT_DV = 15204352;
constexpr float LAM_INIT = 0.35550906f;

struct Params {
  const float *xp, *xs, *c, *cctx, *cak, *cav, *srf, *srb, *cck, *ccv, *cdk, *cdv;
  const float *mod_w, *mod_b, *norm_mix, *norm_ffn, *norm_final;
  const float *ev_w_in, *ev_w_out, *a_q_norm, *a_k_norm, *rdf, *rdb;
  const float *od_w_in, *od_w_out, *lq1, *lk1, *lq2, *lk2, *subln, *dsink;
  const float *peer_wq, *peer_sk, *peer_u, *peer_v;
  float* out;
  char* ws;
  __device__ __forceinline__ unsigned* BAR() const { return (unsigned*)(ws + 0ull); }
  __device__ __forceinline__ float* MOD() const { return (float*)(ws + 13824ull); }
  __device__ __forceinline__ float* ROPEC() const { return (float*)(ws + 259584ull); }
  __device__ __forceinline__ float* ROPES() const { return (float*)(ws + 390656ull); }
  __device__ __forceinline__ float* X() const { return (float*)(ws + 521728ull); }
  __device__ __forceinline__ float* SC() const { return (float*)(ws + 34076160ull); }
  __device__ __forceinline__ u16* WT_EVIN() const { return (u16*)(ws + 101185024ull); }
  __device__ __forceinline__ u16* WT_EVOUT() const { return (u16*)(ws + 106952192ull); }
  __device__ __forceinline__ u16* WT_ODIN() const { return (u16*)(ws + 109049344ull); }
  __device__ __forceinline__ u16* WT_ODOUT() const { return (u16*)(ws + 113767936ull); }
  __device__ __forceinline__ u16* WT_PQ() const { return (u16*)(ws + 115865088ull); }
  __device__ __forceinline__ u16* SUBK() const { return (u16*)(ws + 124253696ull); }
  __device__ __forceinline__ unsigned char* U8() const { return (unsigned char*)(ws + 125302272ull); }
  __device__ __forceinline__ unsigned char* V8() const { return (unsigned char*)(ws + 158856704ull); }
  __device__ __forceinline__ float* SU() const { return (float*)(ws + 192411136ull); }
  __device__ __forceinline__ float* SV() const { return (float*)(ws + 192542208ull); }
  __device__ __forceinline__ u16* H() const { return (u16*)(ws + 192673280ull); }
  __device__ __forceinline__ u16* MIX() const { return (u16*)(ws + 209450496ull); }
  __device__ __forceinline__ u16* Q1() const { return (u16*)(ws + 226227712ull); }
  __device__ __forceinline__ u16* Q2() const { return (u16*)(ws + 234616320ull); }
  __device__ __forceinline__ u16* SG() const { return (u16*)(ws + 243004928ull); }
  __device__ __forceinline__ u16* KA() const { return (u16*)(ws + 251393536ull); }
  __device__ __forceinline__ u16* VA() const { return (u16*)(ws + 253752832ull); }
  __device__ __forceinline__ u16* RK() const { return (u16*)(ws + 256112128ull); }
  __device__ __forceinline__ u16* RV() const { return (u16*)(ws + 264500736ull); }
  __device__ __forceinline__ u16* KC() const { return (u16*)(ws + 272889344ull); }
  __device__ __forceinline__ u16* VC() const { return (u16*)(ws + 282326528ull); }
  __device__ __forceinline__ u16* KD() const { return (u16*)(ws + 291763712ull); }
  __device__ __forceinline__ u16* VD() const { return (u16*)(ws + 294123008ull); }
  __device__ __forceinline__ u16* PQ() const { return (u16*)(ws + 296482304ull); }
};

DEV float bf2f(unsigned b) { return __uint_as_float(b << 16); }
typedef __bf16 bf16v2 __attribute__((ext_vector_type(2)));
typedef float f32v2 __attribute__((ext_vector_type(2)));
DEV unsigned pack2(float a, float b) { f32v2 v = {a, b}; return __builtin_bit_cast(unsigned, __builtin_convertvector(v, bf16v2)); }
DEV u16 f2bf(float f) { return (u16)(pack2(f, 0.f) & 0xffffu); }
DEV float bflo(unsigned w) { return __uint_as_float(w << 16); }
DEV float bfhi(unsigned w) { return __uint_as_float(w & 0xffff0000u); }
DEV float silu_f(float v) { return v / (1.f + __expf(-v)); }
DEV float gelu_tanh(float a) {
  float z = 0.7978845608f * (a + 0.044715f * a * a * a);
  float e = __expf(2.f * z);
  float th = 1.f - 2.f / (e + 1.f);
  return 0.5f * a * (1.f + th);
}
template <int CTRL> DEV float dpp_f(float v) {
  return __int_as_float(__builtin_amdgcn_update_dpp(0, __float_as_int(v), CTRL, 0xF, 0xF, true));
}
template <int CTRL> DEV unsigned dpp_u(unsigned v) {
  return (unsigned)__builtin_amdgcn_update_dpp(0, (int)v, CTRL, 0xF, 0xF, true);
}
DEV float row_sum16(float v) {
  v += dpp_f<0xB1>(v); v += dpp_f<0x4E>(v); v += dpp_f<0x141>(v); v += dpp_f<0x140>(v); return v;
}
DEV float row_max16(float v) {
  v = fmaxf(v, dpp_f<0xB1>(v)); v = fmaxf(v, dpp_f<0x4E>(v)); v = fmaxf(v, dpp_f<0x141>(v)); v = fmaxf(v, dpp_f<0x140>(v)); return v;
}
DEV float rlane(float v, int l) { return __int_as_float(__builtin_amdgcn_readlane(__float_as_int(v), l)); }
DEV float wave_sum(float v) {
  v = row_sum16(v);
  return (rlane(v, 0) + rlane(v, 16)) + (rlane(v, 32) + rlane(v, 48));
}
DEV unsigned wave_max_u(unsigned v) {
  v = max(v, dpp_u<0xB1>(v)); v = max(v, dpp_u<0x4E>(v)); v = max(v, dpp_u<0x141>(v)); v = max(v, dpp_u<0x140>(v));
  unsigned a = (unsigned)__builtin_amdgcn_readlane((int)v, 0), b = (unsigned)__builtin_amdgcn_readlane((int)v, 16);
  unsigned c = (unsigned)__builtin_amdgcn_readlane((int)v, 32), d = (unsigned)__builtin_amdgcn_readlane((int)v, 48);
  return max(max(a, b), max(c, d));
}
DEV float half_sum32(float v) { v = row_sum16(v); return v + __shfl_xor(v, 16); }
DEV unsigned fkey(float f) { unsigned u = __float_as_uint(f); return (u & 0x80000000u) ? ~u : (u | 0x80000000u); }
DEV f32x16 mfma32(bf16x8 a, bf16x8 b, f32x16 c) { return __builtin_amdgcn_mfma_f32_32x32x16_bf16(a, b, c, 0, 0, 0); }
DEV void zero16(f32x16& v) {
#pragma unroll
  for (int i = 0; i < 16; i++) v[i] = 0.f;
}
DEV size_t kvoff(bool smp, int b, int hh, int tpos, int H, int DW, int LS, int off) {
  return smp ? (size_t)4096 * H * DW + ((size_t)(b * H + hh) * LS + off + tpos) * DW
             : ((size_t)(b * H + hh) * 256 + tpos) * DW;
}


DEV float wave_max_f(float v) {
  v = row_max16(v);
  return fmaxf(fmaxf(rlane(v, 0), rlane(v, 16)), fmaxf(rlane(v, 32), rlane(v, 48)));
}
DEV int wave_sum_i(int v) {
  v += (int)dpp_u<0xB1>((unsigned)v); v += (int)dpp_u<0x4E>((unsigned)v); v += (int)dpp_u<0x141>((unsigned)v); v += (int)dpp_u<0x140>((unsigned)v);
  return (__builtin_amdgcn_readlane(v, 0) + __builtin_amdgcn_readlane(v, 16)) + (__builtin_amdgcn_readlane(v, 32) + __builtin_amdgcn_readlane(v, 48));
}
DEV int mbcnt64(unsigned long long m) { return (int)__builtin_amdgcn_mbcnt_hi((unsigned)(m >> 32), __builtin_amdgcn_mbcnt_lo((unsigned)m, 0u)); }
template <bool SGN> DEV void prep_quant(const float* __restrict__ src, unsigned char* __restrict__ dst, float* __restrict__ scale, int row0) {
  int lane = threadIdx.x & 63, wave = threadIdx.x >> 6;
  int rbase = row0 + wave * 4;
  float4 v[4][4];
#pragma unroll
  for (int q = 0; q < 4; q++)
#pragma unroll
    for (int i = 0; i < 4; i++) v[q][i] = *(const float4*)(src + (size_t)(rbase + q) * 1024 + (i * 64 + lane) * 4);
#pragma unroll
  for (int q = 0; q < 4; q++) {
    float mx = 0.f;
#pragma unroll
    for (int i = 0; i < 4; i++) mx = fmaxf(mx, fmaxf(fmaxf(fabsf(v[q][i].x), fabsf(v[q][i].y)), fmaxf(fabsf(v[q][i].z), fabsf(v[q][i].w))));
    mx = wave_max_f(mx);
    float inv = mx > 0.f ? 127.f / mx : 0.f;
    unsigned w[4];
#pragma unroll
    for (int i = 0; i < 4; i++) {
      int off = SGN ? 0 : 128;
      unsigned b0 = (unsigned)((int)rintf(v[q][i].x * inv) + off) & 255u, b1 = (unsigned)((int)rintf(v[q][i].y * inv) + off) & 255u;
      unsigned b2 = (unsigned)((int)rintf(v[q][i].z * inv) + off) & 255u, b3 = (unsigned)((int)rintf(v[q][i].w * inv) + off) & 255u;
      w[i] = b0 | (b1 << 8) | (b2 << 16) | (b3 << 24);
    }
    *(uint4*)(dst + (size_t)(rbase + q) * 1024 + lane * 16) = make_uint4(w[0], w[1], w[2], w[3]);
    if (lane == 0) scale[rbase + q] = mx * (1.f / 127.f);
  }
}

DEV void prep_transpose(const float* __restrict__ W, int N, u16* __restrict__ Wt, int tile, float* sm) {
  int ntn = N >> 6; int kt = tile / ntn, nt = tile % ntn;
  int k0 = kt * 64, n0 = nt * 64; int t = threadIdx.x;
#pragma unroll
  for (int i = 0; i < 4; i++) {
    int k = (t >> 4) + 16 * i; int c4 = (t & 15) * 4;
    float4 v = *(const float4*)(W + (size_t)(k0 + k) * N + n0 + c4);
    sm[k * 65 + c4] = v.x; sm[k * 65 + c4 + 1] = v.y; sm[k * 65 + c4 + 2] = v.z; sm[k * 65 + c4 + 3] = v.w;
  }
  __syncthreads();
  int n = t >> 2, kc = (t & 3) * 16;
  unsigned pk[8];
#pragma unroll
  for (int j = 0; j < 8; j++) pk[j] = pack2(sm[(kc + 2 * j) * 65 + n], sm[(kc + 2 * j + 1) * 65 + n]);
  uint4* dst = (uint4*)(Wt + (size_t)(n0 + n) * 1024 + k0 + kc);
  dst[0] = make_uint4(pk[0], pk[1], pk[2], pk[3]);
  dst[1] = make_uint4(pk[4], pk[5], pk[6], pk[7]);
  __syncthreads();
}
DEV void conv_item(const float* __restrict__ src, u16* __restrict__ dst) {
  int t = threadIdx.x;
#pragma unroll
  for (int i = 0; i < 8; i++) {
    int e = (i * 256 + t) * 8;
    float4 a = *(const float4*)(src + e), b = *(const float4*)(src + e + 4);
    *(uint4*)(dst + e) = make_uint4(pack2(a.x, a.y), pack2(a.z, a.w), pack2(b.x, b.y), pack2(b.z, b.w));
  }
}
DEV void prep_mod(const Params& p, int it, float* sm) {
  int l = it / 96, n0 = (it % 96) * 64; int t = threadIdx.x;
  float* sc = sm;
  for (int i = t; i < 5120; i += 256) {
    int b = i >> 10, k = i & 1023;
    float v = (b == 0) ? p.cctx[k] : p.c[(b - 1) * 1024 + k];
    sc[i] = silu_f(v);
  }
  __syncthreads();
  int col = t & 63, kg = t >> 6;
  float a0 = 0, a1 = 0, a2 = 0, a3 = 0, a4 = 0;
  const float* w = p.mod_w + (size_t)l * 1024 * 6144 + n0 + col;
  for (int k0 = kg; k0 < 1024; k0 += 32) {
    float wv[8];
#pragma unroll
    for (int u = 0; u < 8; u++) wv[u] = w[(size_t)(k0 + 4 * u) * 6144];
#pragma unroll
    for (int u = 0; u < 8; u++) {
      int k = k0 + 4 * u;
      a0 += sc[k] * wv[u]; a1 += sc[1024 + k] * wv[u]; a2 += sc[2048 + k] * wv[u]; a3 += sc[3072 + k] * wv[u]; a4 += sc[4096 + k] * wv[u];
    }
  }
  float* red = sm + 5120;
  red[(kg * 5 + 0) * 64 + col] = a0; red[(kg * 5 + 1) * 64 + col] = a1; red[(kg * 5 + 2) * 64 + col] = a2;
  red[(kg * 5 + 3) * 64 + col] = a3; red[(kg * 5 + 4) * 64 + col] = a4;
  __syncthreads();
  if (t < 64) {
#pragma unroll
    for (int b = 0; b < 5; b++) {
      float s = red[(0 * 5 + b) * 64 + t] + red[(1 * 5 + b) * 64 + t] + red[(2 * 5 + b) * 64 + t] + red[(3 * 5 + b) * 64 + t];
      p.MOD()[(size_t)(l * 5 + b) * 6144 + n0 + t] = s + p.mod_b[l * 6144 + n0 + t];
    }
  }
  __syncthreads();
}
DEV void prep_cache(const Params& p, int it) {
  const float* src; u16* dst;
  if (it < 8)       { int ch = it;      src = p.cak + (size_t)ch * 16384; dst = p.KA() + (size_t)4096 * 2 * 64 + (size_t)ch * 1280 * 64; }
  else if (it < 16) { int ch = it - 8;  src = p.cav + (size_t)ch * 16384; dst = p.VA() + (size_t)4096 * 2 * 64 + (size_t)ch * 1280 * 64; }
  else if (it < 48) { int ch = it - 16; src = p.cck + (size_t)ch * 16384; dst = p.KC() + (size_t)4096 * 8 * 64 + (size_t)ch * 1280 * 64; }
  else if (it < 80) { int ch = (it - 48) >> 1, hf = (it - 48) & 1;
                      src = p.ccv + (size_t)ch * 32768 + hf * 16384; dst = p.VC() + (size_t)4096 * 4 * 128 + (size_t)ch * 1280 * 128 + hf * 16384; }
  else if (it < 88) { int ch = it - 80; src = p.cdk + (size_t)ch * 16384; dst = p.KD() + (size_t)4096 * 2 * 64 + (size_t)ch * 1280 * 64; }
  else              { int ch = it - 88; src = p.cdv + (size_t)ch * 16384; dst = p.VD() + (size_t)4096 * 2 * 64 + (size_t)ch * 1280 * 64; }
  conv_item(src, dst);
}
DEV void prep_rope(const Params& p, int it) {
  for (int i = 0; i < 16; i++) {
    int idx = it * 4096 + i * 256 + threadIdx.x;
    int tpos = idx >> 5, a = idx & 31;
    float pos = (a < 16) ? (float)(tpos >> 6) : (float)(tpos & 63);
    float inv = exp2f(-(float)(a & 15) * (13.287712379549449f / 16.f));
    float ang = pos * inv;
    p.ROPEC()[idx] = __cosf(ang); p.ROPES()[idx] = __sinf(ang);
  }
}
constexpr int PREP_T0 = 704, PREP_T1 = PREP_T0 + 256, PREP_T2 = PREP_T1 + 576, PREP_T3 = PREP_T2 + 256, PREP_T4 = PREP_T3 + 1024;
constexpr int PREP_U = PREP_T4 + 2048, PREP_V = PREP_U + 2048, PREP_SK = PREP_V + 32, PREP_CA = PREP_SK + 96, PREP_RO = PREP_CA + 8, PREP_MOD = PREP_RO + 192;
DEV void phase_prep(const Params& p, int bid, int nb, char* smem) {
  float* sm = (float*)smem;
  for (int it0 = bid; it0 < PREP_MOD; it0 += nb) {
    int it = (it0 < 192) ? (PREP_RO + it0) : (it0 - 192);
    if (it >= PREP_T4 && it < PREP_V) continue;
    if (it < PREP_T0) prep_transpose(p.ev_w_in, 2816, p.WT_EVIN(), it, sm);
    else if (it < PREP_T1) prep_transpose(p.ev_w_out, 1024, p.WT_EVOUT(), it - PREP_T0, sm);
    else if (it < PREP_T2) prep_transpose(p.od_w_in, 2304, p.WT_ODIN(), it - PREP_T1, sm);
    else if (it < PREP_T3) prep_transpose(p.od_w_out, 1024, p.WT_ODOUT(), it - PREP_T2, sm);
    else if (it < PREP_T4) { int j = it - PREP_T3; int l = j >> 9; prep_transpose(p.peer_wq + (size_t)l * 1024 * 2048, 2048, p.WT_PQ() + (size_t)l * 2048 * 1024, j & 511, sm); }
    else if (it < PREP_V) { }
    else if (it < PREP_SK) { size_t o = (size_t)(it - PREP_V) * 16384; conv_item(p.peer_sk + o, p.SUBK() + o); }
    else if (it < PREP_CA) prep_cache(p, it - PREP_SK);
    else if (it < PREP_RO) prep_rope(p, it - PREP_CA);
    else prep_mod(p, it - PREP_RO, sm);
  }
}

DEV void phase_ada(const Params& p, int layer, const float* __restrict__ gain, int shift_i, int scale_i, bool from_input, int bid, int nb) {
  int wave = threadIdx.x >> 6, lane = threadIdx.x & 63;
  for (int T0 = (bid * 4 + wave) * 2; T0 < 8192; T0 += nb * 8) {
    float4 v[2][4]; float ss[2];
#pragma unroll
    for (int q = 0; q < 2; q++) {
      int T = T0 + q;
      const float* xr = from_input ? (T < 4096 ? p.xp + (size_t)T * 1024 : p.xs + (size_t)(T - 4096) * 1024) : p.X() + (size_t)T * 1024;
#pragma unroll
      for (int i = 0; i < 4; i++) v[q][i] = *(const float4*)(xr + (i * 64 + lane) * 4);
    }
    int mb = T0 < 4096 ? 0 : 1 + ((T0 - 4096) >> 10);
    const float* md = p.MOD() + (size_t)(layer * 5 + mb) * 6144;
    float4 g[4], sh[4], sc[4];
#pragma unroll
    for (int i = 0; i < 4; i++) {
      int col = (i * 64 + lane) * 4;
      g[i] = *(const float4*)(gain + col); sh[i] = *(const float4*)(md + shift_i * 1024 + col); sc[i] = *(const float4*)(md + scale_i * 1024 + col);
    }
#pragma unroll
    for (int q = 0; q < 2; q++) {
      float s2 = 0.f;
#pragma unroll
      for (int i = 0; i < 4; i++) s2 += v[q][i].x * v[q][i].x + v[q][i].y * v[q][i].y + v[q][i].z * v[q][i].z + v[q][i].w * v[q][i].w;
      ss[q] = wave_sum(s2);
    }
#pragma unroll
    for (int q = 0; q < 2; q++) {
      float rstd = rsqrtf(ss[q] * (1.f / 1024.f) + 1e-6f);
#pragma unroll
      for (int i = 0; i < 4; i++) {
        int col = (i * 64 + lane) * 4;
        float y0 = v[q][i].x * rstd * g[i].x * (1.f + sc[i].x) + sh[i].x, y1 = v[q][i].y * rstd * g[i].y * (1.f + sc[i].y) + sh[i].y;
        float y2 = v[q][i].z * rstd * g[i].z * (1.f + sc[i].z) + sh[i].z, y3 = v[q][i].w * rstd * g[i].w * (1.f + sc[i].w) + sh[i].w;
        *(uint2*)(p.H() + (size_t)(T0 + q) * 1024 + col) = make_uint2(pack2(y0, y1), pack2(y2, y3));
      }
    }
  }
}

#define GLOAD8(PA, PB) \
  ra0 = *(const u32x4*)(PA); ra1 = *(const u32x4*)((PA) + sa32); ra2 = *(const u32x4*)((PA) + 2 * sa32); ra3 = *(const u32x4*)((PA) + 3 * sa32); \
  rb0 = *(const u32x4*)(PB); rb1 = *(const u32x4*)((PB) + sb32); rb2 = *(const u32x4*)((PB) + 2 * sb32); rb3 = *(const u32x4*)((PB) + 3 * sb32);
#define GLOAD8N(PA, PB) \
  na0 = *(const u32x4*)(PA); na1 = *(const u32x4*)((PA) + sa32); na2 = *(const u32x4*)((PA) + 2 * sa32); na3 = *(const u32x4*)((PA) + 3 * sa32); \
  nb0 = *(const u32x4*)(PB); nb1 = *(const u32x4*)((PB) + sb32); nb2 = *(const u32x4*)((PB) + 2 * sb32); nb3 = *(const u32x4*)((PB) + 3 * sb32);
#define GSTORE8(BUF) { u16* wa_ = (u16*)(smem + (BUF) * 36864) + lrow * 72 + lkc; u16* wb_ = wa_ + 128 * 72; \
  *(u32x4*)(wa_) = ra0; *(u32x4*)(wa_ + 32 * 72) = ra1; *(u32x4*)(wa_ + 64 * 72) = ra2; *(u32x4*)(wa_ + 96 * 72) = ra3; \
  *(u32x4*)(wb_) = rb0; *(u32x4*)(wb_ + 32 * 72) = rb1; *(u32x4*)(wb_ + 64 * 72) = rb2; *(u32x4*)(wb_ + 96 * 72) = rb3; }
DEV void gemm_tile(const u16* __restrict__ A, int lda, const u16* __restrict__ B, int ldb, int K, char* smem, f32x16 (&acc)[2][2]) {
  int t = threadIdx.x, lane = t & 63, wave = t >> 6, r = lane & 31, h = lane >> 5;
  int wm = wave >> 1, wn = wave & 1;
  int lrow = t >> 3, lkc = (t & 7) * 8;
  const u16* ap = A + (size_t)lrow * lda + lkc;
  const u16* bp = B + (size_t)lrow * ldb + lkc;
  size_t sa32 = (size_t)32 * lda, sb32 = (size_t)32 * ldb;
  u32x4 ra0, ra1, ra2, ra3, rb0, rb1, rb2, rb3;
  u32x4 na0, na1, na2, na3, nb0, nb1, nb2, nb3;
  int nk = K >> 6;
#define GSTORE8N(BUF) { u16* wa_ = (u16*)(smem + (BUF) * 36864) + lrow * 72 + lkc; u16* wb_ = wa_ + 128 * 72; \
  *(u32x4*)(wa_) = na0; *(u32x4*)(wa_ + 32 * 72) = na1; *(u32x4*)(wa_ + 64 * 72) = na2; *(u32x4*)(wa_ + 96 * 72) = na3; \
  *(u32x4*)(wb_) = nb0; *(u32x4*)(wb_ + 32 * 72) = nb1; *(u32x4*)(wb_ + 64 * 72) = nb2; *(u32x4*)(wb_ + 96 * 72) = nb3; }
#define GCOMPUTE(BUF) { const u16* sA = (const u16*)(smem + (BUF) * 36864); const u16* sB = sA + 128 * 72; \
    _Pragma("unroll") for (int kk = 0; kk < 4; kk++) { \
      bf16x8 a0 = *(const bf16x8*)(sA + (wm * 64 + r) * 72 + kk * 16 + h * 8); \
      bf16x8 a1 = *(const bf16x8*)(sA + (wm * 64 + 32 + r) * 72 + kk * 16 + h * 8); \
      bf16x8 b0 = *(const bf16x8*)(sB + (wn * 64 + r) * 72 + kk * 16 + h * 8); \
      bf16x8 b1 = *(const bf16x8*)(sB + (wn * 64 + 32 + r) * 72 + kk * 16 + h * 8); \
      acc[0][0] = mfma32(a0, b0, acc[0][0]); acc[0][1] = mfma32(a0, b1, acc[0][1]); \
      acc[1][0] = mfma32(a1, b0, acc[1][0]); acc[1][1] = mfma32(a1, b1, acc[1][1]); } }
  GLOAD8(ap, bp)
  __syncthreads();
  GSTORE8(0)
  if (nk > 1) { GLOAD8(ap + 64, bp + 64) }
  na0 = ra0; na1 = ra1; na2 = ra2; na3 = ra3; nb0 = rb0; nb1 = rb1; nb2 = rb2; nb3 = rb3;
  __syncthreads();
  for (int kt = 0; kt < nk; kt += 2) {
    if (kt + 2 < nk) { GLOAD8N(ap + (kt + 2) * 64, bp + (kt + 2) * 64) }
    GCOMPUTE(0)
    if (kt + 1 < nk) { GSTORE8(1) }
    __syncthreads();
    if (kt + 1 < nk) {
      if (kt + 3 < nk) { GLOAD8(ap + (kt + 3) * 64, bp + (kt + 3) * 64) }
      GCOMPUTE(1)
      if (kt + 2 < nk) { GSTORE8N(0) }
      __syncthreads();
    }
  }
  __syncthreads();
  float* Cs = (float*)smem;
#pragma unroll
  for (int i = 0; i < 2; i++)
#pragma unroll
    for (int j = 0; j < 2; j++)
#pragma unroll
      for (int g = 0; g < 16; g++)
        Cs[(wm * 64 + i * 32 + (g & 3) + 8 * (g >> 2) + 4 * h) * 128 + wn * 64 + j * 32 + r] = acc[i][j][g];
  __syncthreads();
}

DEV bool xcd_tile(int li, int bid, int NTl, int& mt, int& nt) {
  if (li >= 8 * NTl) return false;
  mt = 8 * (bid & 7) + (li & 7); nt = li >> 3; return true;
}
template <class Epi>
DEV void gemm_phase(const u16* A, int lda, const u16* Bt, int ldb, int K, int MT, int NTl, int bid, int nb, char* smem, Epi epi) {
  if ((nb & 7) == 0 && MT == 64) {
    int mt, nt;
    for (int li = bid >> 3; xcd_tile(li, bid, NTl, mt, nt); li += nb >> 3) {
      f32x16 acc[2][2];
      zero16(acc[0][0]); zero16(acc[0][1]); zero16(acc[1][0]); zero16(acc[1][1]);
      gemm_tile(A + (size_t)mt * 128 * lda, lda, Bt + (size_t)nt * 128 * ldb, ldb, K, smem, acc);
      epi(mt * 128, nt * 128, (const float*)smem);
    }
  } else {
    for (int it = bid; it < MT * NTl; it += nb) {
      int mt = it / NTl, nt = it % NTl;
      f32x16 acc[2][2];
      zero16(acc[0][0]); zero16(acc[0][1]); zero16(acc[1][0]); zero16(acc[1][1]);
      gemm_tile(A + (size_t)mt * 128 * lda, lda, Bt + (size_t)nt * 128 * ldb, ldb, K, smem, acc);
      epi(mt * 128, nt * 128, (const float*)smem);
    }
  }
}

DEV void tok_decode(int T, bool& smp, int& b, int& tpos) {
  smp = T >= 4096;
  if (!smp) { b = T >> 8; tpos = T & 255; } else { b = (T - 4096) >> 10; tpos = (T - 4096) & 1023; }
}
DEV void rope_pair(const Params& p, float& x, float& y, int tpos, int d) {
  float px = __shfl_xor(x, 16), py = __shfl_xor(y, 16);
  int a = d & 31;
  float c0 = p.ROPEC()[tpos * 32 + a], c1 = p.ROPEC()[tpos * 32 + a + 1];
  float s0 = p.ROPES()[tpos * 32 + a], s1 = p.ROPES()[tpos * 32 + a + 1];
  if (d < 32) { x = x * c0 - px * s0; y = y * c1 - py * s1; }
  else        { x = px * s0 + x * c0; y = py * s1 + y * c1; }
}

DEV void rope_apply(float& x, float& y, float4 cs, int d) {
  float px = __shfl_xor(x, 16), py = __shfl_xor(y, 16);
  if (d < 32) { x = x * cs.x - px * cs.z; y = y * cs.y - py * cs.w; }
  else        { x = px * cs.z + x * cs.x; y = py * cs.w + y * cs.y; }
}
DEV float4 rope_cs(const Params& p, int tpos, int d) {
  int a = d & 31;
  float2 c = *(const float2*)(p.ROPEC() + tpos * 32 + a), s = *(const float2*)(p.ROPES() + tpos * 32 + a);
  return make_float4(c.x, c.y, s.x, s.y);
}
template <int SEG, bool SMP>
DEV void epi0_rows(const Params& p, int m0, int n0, const float* Cs) {
  int lane = threadIdx.x & 63, wave = threadIdx.x >> 6;
  int col = n0 + lane * 2; int d = col & 63;
  float g0 = 1.f, g1 = 1.f;
  if (SEG == 0) { g0 = p.a_q_norm[d]; g1 = p.a_q_norm[d + 1]; }
  if (SEG == 1) { g0 = p.a_k_norm[d]; g1 = p.a_k_norm[d + 1]; }
  int segbase = SEG == 0 ? 0 : SEG == 1 ? 512 : SEG == 2 ? 640 : SEG == 3 ? 768 : SEG == 4 ? 1280 : SEG == 5 ? 1792 : 2304;
  int hh = (col - segbase) >> 6;
#pragma unroll 4
  for (int i = 0; i < 32; i++) {
    int rr = wave + 4 * i;
    int T = m0 + rr;
    int b = SMP ? (T - 4096) >> 10 : T >> 8;
    int tpos = SMP ? (T - 4096) & 1023 : T & 255;
    float2 c = *(const float2*)(Cs + rr * 128 + lane * 2);
    if (SEG <= 1) {
      float4 cs = make_float4(1.f, 1.f, 0.f, 0.f);
      if (SMP) cs = rope_cs(p, tpos, d);
      float ss = half_sum32(c.x * c.x + c.y * c.y);
      float rstd = rsqrtf(ss * (1.f / 64.f) + 1e-6f);
      c.x *= rstd * g0; c.y *= rstd * g1;
      if (SMP) rope_apply(c.x, c.y, cs, d);
    }
    if (SEG == 0) *(unsigned*)(p.Q1() + (size_t)T * 512 + col) = pack2(c.x * 0.18033688011112042f, c.y * 0.18033688011112042f);
    if (SEG == 1) {
      *(unsigned*)(p.KA() + kvoff(SMP, b, hh, tpos, 2, 64, 1280, 256) + d) = pack2(c.x, c.y);
      if (!SMP) *(float2*)(p.out + OUT_AK + ((size_t)(b * 2 + hh) * 256 + tpos) * 64 + d) = c;
    }
    if (SEG == 2) {
      *(unsigned*)(p.VA() + kvoff(SMP, b, hh, tpos, 2, 64, 1280, 256) + d) = pack2(c.x, c.y);
      if (!SMP) *(float2*)(p.out + OUT_AV + ((size_t)(b * 2 + hh) * 256 + tpos) * 64 + d) = c;
    }
    if (SEG == 3) *(unsigned*)(p.Q2() + (size_t)T * 512 + (col - 768)) = pack2(c.x, c.y);
    if (SEG == 4) *(unsigned*)(p.RK() + kvoff(SMP, b, hh, tpos, 8, 64, 1024, 0) + d) = pack2(c.x * 0.125f, c.y * 0.125f);
    if (SEG == 5) *(unsigned*)(p.RV() + kvoff(SMP, b, hh, tpos, 8, 64, 1024, 0) + d) = pack2(c.x, c.y);
    if (SEG == 6) *(unsigned*)(p.SG() + (size_t)T * 512 + (col - 2304)) = pack2(silu_f(c.x), silu_f(c.y));
  }
}
template <bool SMP> DEV void epi0_disp(const Params& p, int m0, int n0, const float* Cs) {
  if (n0 < 512) epi0_rows<0, SMP>(p, m0, n0, Cs);
  else if (n0 < 640) epi0_rows<1, SMP>(p, m0, n0, Cs);
  else if (n0 < 768) epi0_rows<2, SMP>(p, m0, n0, Cs);
  else if (n0 < 1280) epi0_rows<3, SMP>(p, m0, n0, Cs);
  else if (n0 < 1792) epi0_rows<4, SMP>(p, m0, n0, Cs);
  else if (n0 < 2304) epi0_rows<5, SMP>(p, m0, n0, Cs);
  else epi0_rows<6, SMP>(p, m0, n0, Cs);
}
DEV void epi_inproj0(const Params& p, int m0, int n0, const float* Cs) {
  if (m0 >= 4096) epi0_disp<true>(p, m0, n0, Cs); else epi0_disp<false>(p, m0, n0, Cs);
}
template <int SEG, bool SMP>
DEV void epi1_rows(const Params& p, int m0, int n0, const float* Cs) {
  int lane = threadIdx.x & 63, wave = threadIdx.x >> 6;
  int col = n0 + lane * 2; int d = col & 63;
  int segbase = SEG == 0 ? 0 : SEG == 1 ? 512 : SEG == 2 ? 1024 : SEG == 3 ? 1536 : SEG == 4 ? 2048 : 2176;
  int hh = (SEG == 2) ? (col - segbase) >> 7 : (col - segbase) >> 6;
  int dd = (col - 1024) & 127;
  constexpr bool ROPE = SMP && (SEG == 0 || SEG == 1 || SEG == 3 || SEG == 4);
#pragma unroll 4
  for (int i = 0; i < 32; i++) {
    int rr = wave + 4 * i;
    int T = m0 + rr;
    int b = SMP ? (T - 4096) >> 10 : T >> 8;
    int tpos = SMP ? (T - 4096) & 1023 : T & 255;
    float2 c = *(const float2*)(Cs + rr * 128 + lane * 2);
    if (!SMP) {
      if (SEG == 1) *(float2*)(p.out + OUT_CK + ((size_t)(b * 8 + hh) * 256 + tpos) * 64 + d) = c;
      if (SEG == 2) *(float2*)(p.out + OUT_CV + ((size_t)(b * 4 + hh) * 256 + tpos) * 128 + dd) = c;
      if (SEG == 4) *(float2*)(p.out + OUT_DK + ((size_t)(b * 2 + hh) * 256 + tpos) * 64 + d) = c;
      if (SEG == 5) *(float2*)(p.out + OUT_DV + ((size_t)(b * 2 + hh) * 256 + tpos) * 64 + d) = c;
    }
    if (ROPE) { float4 cs = rope_cs(p, tpos, d); rope_apply(c.x, c.y, cs, d); }
    if (SEG == 0) *(unsigned*)(p.Q1() + (size_t)T * 512 + col) = pack2(c.x * 0.18033688011112042f, c.y * 0.18033688011112042f);
    if (SEG == 1) *(unsigned*)(p.KC() + kvoff(SMP, b, hh, tpos, 8, 64, 1280, 256) + d) = pack2(c.x, c.y);
    if (SEG == 2) *(unsigned*)(p.VC() + kvoff(SMP, b, hh, tpos, 4, 128, 1280, 256) + dd) = pack2(c.x, c.y);
    if (SEG == 3) *(unsigned*)(p.Q2() + (size_t)T * 512 + (col - 1536)) = pack2(c.x * 0.18033688011112042f, c.y * 0.18033688011112042f);
    if (SEG == 4) *(unsigned*)(p.KD() + kvoff(SMP, b, hh, tpos, 2, 64, 1280, 256) + d) = pack2(c.x, c.y);
    if (SEG == 5) *(unsigned*)(p.VD() + kvoff(SMP, b, hh, tpos, 2, 64, 1280, 256) + d) = pack2(c.x, c.y);
  }
}
template <bool SMP> DEV void epi1_disp(const Params& p, int m0, int n0, const float* Cs) {
  if (n0 < 512) epi1_rows<0, SMP>(p, m0, n0, Cs);
  else if (n0 < 1024) epi1_rows<1, SMP>(p, m0, n0, Cs);
  else if (n0 < 1536) epi1_rows<2, SMP>(p, m0, n0, Cs);
  else if (n0 < 2048) epi1_rows<3, SMP>(p, m0, n0, Cs);
  else if (n0 < 2176) epi1_rows<4, SMP>(p, m0, n0, Cs);
  else epi1_rows<5, SMP>(p, m0, n0, Cs);
}
DEV void epi_inproj1(const Params& p, int m0, int n0, const float* Cs) {
  if (m0 >= 4096) epi1_disp<true>(p, m0, n0, Cs); else epi1_disp<false>(p, m0, n0, Cs);
}
DEV void epi_outproj(const Params& p, int layer, int m0, int n0, const float* Cs) {
  int lane = threadIdx.x & 63, wave = threadIdx.x >> 6;
  int mb = m0 < 4096 ? 0 : 1 + ((m0 - 4096) >> 10);
  int col = n0 + lane * 2;
  float2 g = *(const float2*)(p.MOD() + (size_t)(layer * 5 + mb) * 6144 + 2048 + col);
  const float* xbase = (layer == 0) ? (m0 < 4096 ? p.xp + (size_t)m0 * 1024 : p.xs + (size_t)(m0 - 4096) * 1024) : p.X() + (size_t)m0 * 1024;
#pragma unroll 8
  for (int i = 0; i < 32; i++) {
    int rr = wave + 4 * i;
    float2 c = *(const float2*)(Cs + rr * 128 + lane * 2);
    float2 x = *(const float2*)(xbase + (size_t)rr * 1024 + col);
    x.x += g.x * c.x; x.y += g.y * c.y;
    *(float2*)(p.X() + (size_t)(m0 + rr) * 1024 + col) = x;
  }
}

constexpr int ATT_BUF = 37888;
struct TileRegs { u32x4 k0, k1, k2, k3, v0, v1, v2, v3; };
template <int DV, bool TWOK> DEV TileRegs tile_load(const u16* __restrict__ k, const u16* __restrict__ k2, const u16* __restrict__ v) {
  int t = threadIdx.x, lane = t & 63, wave = t >> 6;
  TileRegs R;
  u32x4 z = {0u, 0u, 0u, 0u};
  R.k0 = *(const u32x4*)(k + t * 8); R.k1 = *(const u32x4*)(k + (t + 256) * 8);
  if (TWOK) { R.k2 = *(const u32x4*)(k2 + t * 8); R.k3 = *(const u32x4*)(k2 + (t + 256) * 8); } else { R.k2 = z; R.k3 = z; }
  R.v0 = *(const u32x4*)(v + (size_t)lane * DV + wave * 8); R.v1 = *(const u32x4*)(v + (size_t)lane * DV + (wave + 4) * 8);
  if (DV == 128) { R.v2 = *(const u32x4*)(v + (size_t)lane * DV + (wave + 8) * 8); R.v3 = *(const u32x4*)(v + (size_t)lane * DV + (wave + 12) * 8); } else { R.v2 = z; R.v3 = z; }
  return R;
}
DEV void store8t(u16* d, u32x4 x) {
  d[0 * 76] = (u16)(x[0] & 0xffff); d[1 * 76] = (u16)(x[0] >> 16);
  d[2 * 76] = (u16)(x[1] & 0xffff); d[3 * 76] = (u16)(x[1] >> 16);
  d[4 * 76] = (u16)(x[2] & 0xffff); d[5 * 76] = (u16)(x[2] >> 16);
  d[6 * 76] = (u16)(x[3] & 0xffff); d[7 * 76] = (u16)(x[3] >> 16);
}
template <int DV, bool TWOK> DEV void tile_store(const TileRegs R, char* buf) {
  int t = threadIdx.x, lane = t & 63, wave = t >> 6;
  u16* sK = (u16*)buf; u16* sK2 = sK + 64 * 72; u16* sVT = sK + 2 * 64 * 72;
  int key = t >> 3, dc = t & 7;
  *(u32x4*)(sK + key * 72 + dc * 8) = R.k0; *(u32x4*)(sK + (key + 32) * 72 + dc * 8) = R.k1;
  if (TWOK) { *(u32x4*)(sK2 + key * 72 + dc * 8) = R.k2; *(u32x4*)(sK2 + (key + 32) * 72 + dc * 8) = R.k3; }
  store8t(sVT + (wave * 8) * 76 + lane, R.v0); store8t(sVT + ((wave + 4) * 8) * 76 + lane, R.v1);
  if (DV == 128) { store8t(sVT + ((wave + 8) * 8) * 76 + lane, R.v2); store8t(sVT + ((wave + 12) * 8) * 76 + lane, R.v3); }
}
DEV void load_ident_k(u16* sK) {
  int t = threadIdx.x;
#pragma unroll
  for (int i = 0; i < 2; i++) {
    int c = t + 256 * i; int key = c >> 3, dc = c & 7;
    unsigned w[4] = {0u, 0u, 0u, 0u};
    uint4 z = make_uint4(0u, 0u, 0u, 0u);
    if (dc == (key >> 3)) {
      int e = key & 7; unsigned one = (e & 1) ? 0x3F800000u : 0x00003F80u;
      if ((e >> 1) == 0) z.x = one; else if ((e >> 1) == 1) z.y = one; else if ((e >> 1) == 2) z.z = one; else z.w = one;
    }
    (void)w;
    *(uint4*)(sK + key * 72 + dc * 8) = z;
  }
}
DEV void load_state_v(const float* __restrict__ S0, u16* sVT) {
  int lane = threadIdx.x & 63, wave = threadIdx.x >> 6;
#pragma unroll
  for (int i = 0; i < 2; i++) {
    int dc = wave + 4 * i;
    float4 a = *(const float4*)(S0 + lane * 64 + dc * 8), b = *(const float4*)(S0 + lane * 64 + dc * 8 + 4);
    u16* d = sVT + (dc * 8) * 76 + lane;
    d[0 * 76] = f2bf(a.x); d[1 * 76] = f2bf(a.y); d[2 * 76] = f2bf(a.z); d[3 * 76] = f2bf(a.w);
    d[4 * 76] = f2bf(b.x); d[5 * 76] = f2bf(b.y); d[6 * 76] = f2bf(b.z); d[7 * 76] = f2bf(b.w);
  }
}
template <int DV, class F>
DEV void attn_compute(const bf16x8 (&qf)[4], f32x16 (&o)[DV / 32], const u16* sK, const u16* sVT, F&& xform) {
  int lane = threadIdx.x & 63, r = lane & 31, h = lane >> 5;
  f32x16 st[2]; zero16(st[0]); zero16(st[1]);
#pragma unroll
  for (int sub = 0; sub < 2; sub++)
#pragma unroll
    for (int kk = 0; kk < 4; kk++) {
      bf16x8 kf = *(const bf16x8*)(sK + (sub * 32 + r) * 72 + kk * 16 + h * 8);
      st[sub] = mfma32(kf, qf[kk], st[sub]);
    }
  xform(st);
  bf16x8 pf[2][2];
#pragma unroll
  for (int sub = 0; sub < 2; sub++)
#pragma unroll
    for (int s = 0; s < 2; s++) {
      u32x4 w;
      w[0] = pack2(st[sub][8 * s + 0], st[sub][8 * s + 1]); w[1] = pack2(st[sub][8 * s + 2], st[sub][8 * s + 3]);
      w[2] = pack2(st[sub][8 * s + 4], st[sub][8 * s + 5]); w[3] = pack2(st[sub][8 * s + 6], st[sub][8 * s + 7]);
      pf[sub][s] = __builtin_bit_cast(bf16x8, w);
    }
#pragma unroll
  for (int ds = 0; ds < DV / 32; ds++)
#pragma unroll
    for (int sub = 0; sub < 2; sub++)
#pragma unroll
      for (int s = 0; s < 2; s++) {
        const u16* vp = sVT + (ds * 32 + r) * 76 + sub * 32 + s * 16 + 4 * h;
        uint2 lo = *(const uint2*)vp, hi = *(const uint2*)(vp + 8);
        u32x4 w; w[0] = lo.x; w[1] = lo.y; w[2] = hi.x; w[3] = hi.y;
        o[ds] = mfma32(__builtin_bit_cast(bf16x8, w), pf[sub][s], o[ds]);
      }
}
template <int DV, class F>
DEV void attn_compute_sub(const bf16x8 (&qf)[4], f32x16 (&o)[DV / 32], const u16* sK, const u16* sVT, F&& xform) {
  int lane = threadIdx.x & 63, r = lane & 31, h = lane >> 5;
#pragma unroll
  for (int sub = 0; sub < 2; sub++) {
    f32x16 st; zero16(st);
#pragma unroll
    for (int kk = 0; kk < 4; kk++) {
      bf16x8 kf = *(const bf16x8*)(sK + (sub * 32 + r) * 72 + kk * 16 + h * 8);
      st = mfma32(kf, qf[kk], st);
    }
    xform(sub, st);
    bf16x8 pf[2];
#pragma unroll
    for (int s2 = 0; s2 < 2; s2++) {
      u32x4 w;
      w[0] = pack2(st[8 * s2 + 0], st[8 * s2 + 1]); w[1] = pack2(st[8 * s2 + 2], st[8 * s2 + 3]);
      w[2] = pack2(st[8 * s2 + 4], st[8 * s2 + 5]); w[3] = pack2(st[8 * s2 + 6], st[8 * s2 + 7]);
      pf[s2] = __builtin_bit_cast(bf16x8, w);
    }
#pragma unroll
    for (int ds = 0; ds < DV / 32; ds++)
#pragma unroll
      for (int s2 = 0; s2 < 2; s2++) {
        const u16* vp = sVT + (ds * 32 + r) * 76 + sub * 32 + s2 * 16 + 4 * h;
        uint2 lo = *(const uint2*)vp, hi = *(const uint2*)(vp + 8);
        u32x4 w; w[0] = lo.x; w[1] = lo.y; w[2] = hi.x; w[3] = hi.y;
        o[ds] = mfma32(__builtin_bit_cast(bf16x8, w), pf[s2], o[ds]);
      }
  }
}
template <int DV>
DEV void softmax_xform1(f32x16& st, f32x16 (&o)[DV / 32], float& m, float& l) {
  float mx = -1e30f;
#pragma unroll
  for (int g = 0; g < 16; g++) mx = fmaxf(mx, st[g]);
  mx = fmaxf(mx, __shfl_xor(mx, 32));
  float mnew = fmaxf(m, mx);
  float alpha = __builtin_amdgcn_exp2f(m - mnew);
  m = mnew;
  float ls = 0.f;
#pragma unroll
  for (int g = 0; g < 16; g++) { float pv = __builtin_amdgcn_exp2f(st[g] - mnew); st[g] = pv; ls += pv; }
  l = l * alpha + ls;
#pragma unroll
  for (int ds = 0; ds < DV / 32; ds++)
#pragma unroll
    for (int g = 0; g < 16; g++) o[ds][g] *= alpha;
}
template <int DV, bool TWOK, class PF, class XF, class XF1>
DEV void attn_loop(int n, PF&& ptrs, const bf16x8 (&qf)[4], f32x16 (&o)[DV / 32], char* smem, XF&& xf, XF1&& xf1) {
  int wave = threadIdx.x >> 6;
  int kofs = (TWOK && wave >= 2) ? 64 * 72 : 0;
  TileRegs R;
  const u16 *kp, *kp2, *vp;
  ptrs(0, kp, kp2, vp); R = tile_load<DV, TWOK>(kp, kp2, vp);
  __syncthreads();
  tile_store<DV, TWOK>(R, smem);
  if (n > 1) { ptrs(1, kp, kp2, vp); R = tile_load<DV, TWOK>(kp, kp2, vp); }
  __syncthreads();
  const u16* b0k = (const u16*)smem + kofs; const u16* b0v = (const u16*)smem + 2 * 64 * 72;
  const u16* b1k = (const u16*)(smem + ATT_BUF) + kofs; const u16* b1v = (const u16*)(smem + ATT_BUF) + 2 * 64 * 72;
  for (int ti = 0; ti < n; ti++) {
    const u16* bk = (ti & 1) ? b1k : b0k; const u16* bv = (ti & 1) ? b1v : b0v;
    if constexpr (DV == 128) attn_compute_sub<DV>(qf, o, bk, bv, [&](int sub, f32x16& st) { xf1(ti, sub, st); });
    else attn_compute<DV>(qf, o, bk, bv, [&](f32x16 (&st)[2]) { xf(ti, st); });
    if (ti + 1 < n) tile_store<DV, TWOK>(R, smem + ((ti + 1) & 1) * ATT_BUF);
    if (ti + 2 < n) { ptrs(ti + 2, kp, kp2, vp); R = tile_load<DV, TWOK>(kp, kp2, vp); }
    __syncthreads();
  }
}
template <int DV>
DEV void softmax_xform(f32x16 (&st)[2], f32x16 (&o)[DV / 32], float& m, float& l, bool masked, int kpos0, int qpos) {
  int h = (threadIdx.x & 63) >> 5;
  float mx = -1e30f;
#pragma unroll
  for (int sub = 0; sub < 2; sub++)
#pragma unroll
    for (int g = 0; g < 16; g++) {
      float s = st[sub][g];
      if (masked) {
        int j = kpos0 + sub * 32 + (g & 3) + 8 * (g >> 2) + 4 * h;
        int dl = qpos - j; if (dl < 0) dl = -dl;
        if (dl > 128) s = -1e30f;
        st[sub][g] = s;
      }
      mx = fmaxf(mx, s);
    }
  mx = fmaxf(mx, __shfl_xor(mx, 32));
  float mnew = fmaxf(m, mx);
  float alpha = __builtin_amdgcn_exp2f(m - mnew);
  m = mnew;
  float ls = 0.f;
#pragma unroll
  for (int sub = 0; sub < 2; sub++)
#pragma unroll
    for (int g = 0; g < 16; g++) { float pv = __builtin_amdgcn_exp2f(st[sub][g] - mnew); st[sub][g] = pv; ls += pv; }
  l = l * alpha + ls;
#pragma unroll
  for (int ds = 0; ds < DV / 32; ds++)
#pragma unroll
    for (int g = 0; g < 16; g++) o[ds][g] *= alpha;
}

template <int DV, bool TWOK>
DEV void attn_softmax_job(const Params& p, const u16* Q, int Tq0, int qcol, const u16* kb, const u16* kb2, const u16* vb,
                          int nplain, int band_lo, int band_hi, int qpos0, bool use_sink, float sinkv,
                          f32x16 (&o)[DV / 32], char* smem) {
  int lane = threadIdx.x & 63, wave = threadIdx.x >> 6, r = lane & 31, h = lane >> 5;
  int qrow = TWOK ? (wave & 1) * 32 : wave * 32;
  bf16x8 qf[4];
#pragma unroll
  for (int kk = 0; kk < 4; kk++) qf[kk] = *(const bf16x8*)(Q + (size_t)(Tq0 + qrow + r) * 512 + qcol + kk * 16 + h * 8);
#pragma unroll
  for (int ds = 0; ds < DV / 32; ds++) zero16(o[ds]);
  float m = use_sink ? sinkv : -1e30f;
  float l = (use_sink && h == 0) ? 1.f : 0.f;
  int qpos = qpos0 + qrow + r;
  int ntot = nplain + (band_hi - band_lo);
  attn_loop<DV, TWOK>(ntot,
    [&](int ti, const u16*& kp, const u16*& kp2, const u16*& vp) {
      int key0 = (ti >= nplain) ? (256 + (band_lo + ti - nplain) * 64) : ti * 64;
      kp = kb + (size_t)key0 * 64; kp2 = kb2 + (size_t)key0 * 64; vp = vb + (size_t)key0 * DV;
    }, qf, o, smem,
    [&](int ti, f32x16 (&st)[2]) {
      bool masked = ti >= nplain;
      int kpos0 = (band_lo + ti - nplain) * 64;
      softmax_xform<DV>(st, o, m, l, masked, kpos0, qpos);
    },
    [&](int ti, int sub, f32x16& st) { softmax_xform1<DV>(st, o, m, l); });
  float lt = l + __shfl_xor(l, 32);
  float inv = 1.f / lt;
#pragma unroll
  for (int ds = 0; ds < DV / 32; ds++)
#pragma unroll
    for (int g = 0; g < 16; g++) o[ds][g] *= inv;
}
DEV void store_o64(const Params& p, const f32x16 (&o)[2], int Tq0, int mixcol) {
  int lane = threadIdx.x & 63, wave = threadIdx.x >> 6, r = lane & 31, h = lane >> 5;
  int T = Tq0 + wave * 32 + r;
#pragma unroll
  for (int ds = 0; ds < 2; ds++)
#pragma unroll
    for (int g4 = 0; g4 < 4; g4++) {
      int d0 = ds * 32 + 8 * g4 + 4 * h;
      *(uint2*)(p.MIX() + (size_t)T * 1024 + mixcol + d0) =
          make_uint2(pack2(o[ds][4 * g4], o[ds][4 * g4 + 1]), pack2(o[ds][4 * g4 + 2], o[ds][4 * g4 + 3]));
    }
}

DEV void ret_job(const Params& p, bool smp, int b, int hh, int qb, char* smem) {
  u16* sK = (u16*)smem; u16* sVT = sK + 2 * 64 * 72;
  int lane = threadIdx.x & 63, wave = threadIdx.x >> 6, r = lane & 31, h = lane >> 5;
  int L = smp ? 1024 : 256;
  int Tq0 = (smp ? 4096 + b * 1024 : b * 256) + qb * 128;
  const u16* kb = p.RK() + kvoff(smp, b, hh, 0, 8, 64, 1024, 0);
  const u16* vb = p.RV() + kvoff(smp, b, hh, 0, 8, 64, 1024, 0);
  float xf = p.rdf[hh], xb = p.rdb[hh];
  float lf2 = -log1pf(__expf(-xf)) * 1.4426950408889634f;
  float lb2 = -log1pf(__expf(-xb)) * 1.4426950408889634f;
  bf16x8 qf[4];
#pragma unroll
  for (int kk = 0; kk < 4; kk++) qf[kk] = *(const bf16x8*)(p.Q2() + (size_t)(Tq0 + wave * 32 + r) * 512 + hh * 64 + kk * 16 + h * 8);
  f32x16 o[2]; zero16(o[0]); zero16(o[1]);
  int qpos = qb * 128 + wave * 32 + r;
  int nt = L / 64;
  attn_loop<64, false>(nt,
    [&](int ti, const u16*& kp, const u16*& kp2, const u16*& vp) { kp = kb + (size_t)ti * 4096; kp2 = kp; vp = vb + (size_t)ti * 4096; },
    qf, o, smem,
    [&](int ti, f32x16 (&st)[2]) {
      int kpos0 = ti * 64;
#pragma unroll
      for (int sub = 0; sub < 2; sub++)
#pragma unroll
        for (int g = 0; g < 16; g++) {
          int j = kpos0 + sub * 32 + (g & 3) + 8 * (g >> 2) + 4 * h;
          int dl = qpos - j;
          float e = dl >= 0 ? lf2 * (float)dl : lb2 * (float)(-dl);
          st[sub][g] *= __builtin_amdgcn_exp2f(e);
        }
    },
    [&](int ti, int sub, f32x16& st) {});
  if (smp) {
    for (int dir = 0; dir < 2; dir++) {
      const float* S0 = (dir == 0 ? p.srf : p.srb) + (size_t)(b * 8 + hh) * 4096;
      float rs = dir == 0 ? exp2f(lf2 * (float)(qpos + 1)) : exp2f(lb2 * (float)(L - qpos));
      __syncthreads();
      load_ident_k(sK);
      load_state_v(S0, sVT);
      __syncthreads();
      attn_compute<64>(qf, o, sK, sVT, [&](f32x16 (&st)[2]) {
#pragma unroll
        for (int sub = 0; sub < 2; sub++)
#pragma unroll
          for (int g = 0; g < 16; g++) st[sub][g] *= rs;
      });
    }
  }
  float sum = 0.f;
#pragma unroll
  for (int ds = 0; ds < 2; ds++)
#pragma unroll
    for (int g = 0; g < 16; g++) sum += o[ds][g];
  sum += __shfl_xor(sum, 32);
  float mean = sum * (1.f / 64.f);
  float vs = 0.f;
#pragma unroll
  for (int ds = 0; ds < 2; ds++)
#pragma unroll
    for (int g = 0; g < 16; g++) { float dlt = o[ds][g] - mean; vs += dlt * dlt; }
  vs += __shfl_xor(vs, 32);
  float rstd = rsqrtf(vs * (1.f / 64.f) + 1e-6f);
  int T = Tq0 + wave * 32 + r;
#pragma unroll
  for (int ds = 0; ds < 2; ds++)
#pragma unroll
    for (int g4 = 0; g4 < 4; g4++) {
      int d0 = ds * 32 + 8 * g4 + 4 * h;
      uint2 gt = *(const uint2*)(p.SG() + (size_t)T * 512 + hh * 64 + d0);
      float y0 = (o[ds][4 * g4] - mean) * rstd * bflo(gt.x), y1 = (o[ds][4 * g4 + 1] - mean) * rstd * bfhi(gt.x);
      float y2 = (o[ds][4 * g4 + 2] - mean) * rstd * bflo(gt.y), y3 = (o[ds][4 * g4 + 3] - mean) * rstd * bfhi(gt.y);
      *(uint2*)(p.MIX() + (size_t)T * 1024 + 512 + hh * 64 + d0) = make_uint2(pack2(y0, y1), pack2(y2, y3));
    }
}
DEV void ret_state_job(const Params& p, int b, int hh, int dir, char* smem) {
  u16* sKk = (u16*)smem; u16* sVv = sKk + 64 * 64;
  int t = threadIdx.x;
  const u16* kb = p.RK() + kvoff(false, b, hh, 0, 8, 64, 1024, 0);
  const u16* vb = p.RV() + kvoff(false, b, hh, 0, 8, 64, 1024, 0);
  float xx = dir == 0 ? p.rdf[hh] : p.rdb[hh];
  float lg2 = -log1pf(__expf(-xx)) * 1.4426950408889634f;
  int dk = t >> 2, dvc = (t & 3) * 16;
  float acc[16];
#pragma unroll
  for (int i = 0; i < 16; i++) acc[i] = 0.f;
  for (int ch = 0; ch < 4; ch++) {
    __syncthreads();
#pragma unroll
    for (int i = 0; i < 2; i++) {
      int c = t + 256 * i;
      *(uint4*)(sKk + c * 8) = *(const uint4*)(kb + (size_t)ch * 4096 + c * 8);
      *(uint4*)(sVv + c * 8) = *(const uint4*)(vb + (size_t)ch * 4096 + c * 8);
    }
    __syncthreads();
    for (int jj = 0; jj < 64; jj++) {
      int j = ch * 64 + jj;
      float w = exp2f(lg2 * (float)(dir == 0 ? 255 - j : j));
      float kv = bf2f(sKk[jj * 64 + dk]) * w;
      const uint4* vp = (const uint4*)(sVv + jj * 64 + dvc);
      uint4 v0 = vp[0], v1 = vp[1];
      acc[0] += kv * bflo(v0.x); acc[1] += kv * bfhi(v0.x); acc[2] += kv * bflo(v0.y); acc[3] += kv * bfhi(v0.y);
      acc[4] += kv * bflo(v0.z); acc[5] += kv * bfhi(v0.z); acc[6] += kv * bflo(v0.w); acc[7] += kv * bfhi(v0.w);
      acc[8] += kv * bflo(v1.x); acc[9] += kv * bfhi(v1.x); acc[10] += kv * bflo(v1.y); acc[11] += kv * bfhi(v1.y);
      acc[12] += kv * bflo(v1.z); acc[13] += kv * bfhi(v1.z); acc[14] += kv * bflo(v1.w); acc[15] += kv * bfhi(v1.w);
    }
  }
  float* dst = p.out + (dir == 0 ? OUT_RF : OUT_RB) + ((size_t)(b * 8 + hh) * 64 + dk) * 64 + dvc;
#pragma unroll
  for (int i = 0; i < 4; i++) *(float4*)(dst + 4 * i) = make_float4(acc[4 * i], acc[4 * i + 1], acc[4 * i + 2], acc[4 * i + 3]);
}

DEV void phase_attn0(const Params& p, int bid, int nb, char* smem) {
  for (int it = bid; it < 1280 + 2048; it += nb) {
    if (it >= 1280) {
      int j = it - 1280;
      if (j < 1024) prep_quant<true>(p.peer_u, p.U8(), p.SU(), j * 16); else prep_quant<false>(p.peer_v, p.V8(), p.SV(), (j - 1024) * 16);
    } else if (it < 256) {
      int b = it >> 6, hq = (it >> 3) & 7, qb = it & 7; int kvh = hq >> 2;
      f32x16 o[2];
      int Tq0 = 4096 + b * 1024 + qb * 128;
      attn_softmax_job<64, false>(p, p.Q1(), Tq0, hq * 64, p.KA() + kvoff(true, b, kvh, -256, 2, 64, 1280, 256), p.KA(), p.VA() + kvoff(true, b, kvh, -256, 2, 64, 1280, 256),
                           20, 0, 0, qb * 128, false, 0.f, o, smem);
      store_o64(p, o, Tq0, hq * 64);
    } else if (it < 512) {
      int j = it - 256; int b = j >> 6, hh = (j >> 3) & 7, qb = j & 7;
      ret_job(p, true, b, hh, qb, smem);
    } else if (it < 768) {
      int j = it - 512; int b = j >> 4, hq = (j >> 1) & 7, qb = j & 1; int kvh = hq >> 2;
      f32x16 o[2];
      int Tq0 = b * 256 + qb * 128;
      attn_softmax_job<64, false>(p, p.Q1(), Tq0, hq * 64, p.KA() + kvoff(false, b, kvh, 0, 2, 64, 1280, 256), p.KA(), p.VA() + kvoff(false, b, kvh, 0, 2, 64, 1280, 256),
                           4, 0, 0, qb * 128, false, 0.f, o, smem);
      store_o64(p, o, Tq0, hq * 64);
    } else if (it < 1024) {
      int j = it - 768; int b = j >> 4, hh = (j >> 1) & 7, qb = j & 1;
      ret_job(p, false, b, hh, qb, smem);
    } else {
      int j = it - 1024; int b = j >> 4, hh = (j >> 1) & 7, dir = j & 1;
      ret_state_job(p, b, hh, dir, smem);
    }
  }
}
DEV void diff_job(const Params& p, bool smp, int b, int hh, int qb, float lam, char* smem) {
  int lane = threadIdx.x & 63, wave = threadIdx.x >> 6, r = lane & 31, h = lane >> 5;
  int c = wave >> 1;
  int Tq0 = (smp ? 4096 + b * 1024 : b * 256) + qb * 64;
  int nt = smp ? 20 : 4;
  const u16* vb = p.VC() + kvoff(smp, b, hh, smp ? -256 : 0, 4, 128, 1280, 256);
  const u16* kb0 = p.KC() + kvoff(smp, b, 2 * hh, smp ? -256 : 0, 8, 64, 1280, 256);
  const u16* kb1 = p.KC() + kvoff(smp, b, 2 * hh + 1, smp ? -256 : 0, 8, 64, 1280, 256);
  f32x16 o[4];
  attn_softmax_job<128, true>(p, p.Q1(), Tq0, (2 * hh + c) * 64, kb0, kb1, vb, nt, 0, 0, 0, false, 0.f, o, smem);
  float* ex = (float*)smem;
  if (wave >= 2) {
#pragma unroll
    for (int ds = 0; ds < 4; ds++)
#pragma unroll
      for (int g = 0; g < 16; g++) ex[(ds * 16 + g) * 128 + (threadIdx.x - 128)] = o[ds][g];
  }
  __syncthreads();
  if (wave < 2) {
    float ss = 0.f;
#pragma unroll
    for (int ds = 0; ds < 4; ds++)
#pragma unroll
      for (int g = 0; g < 16; g++) { float dv = o[ds][g] - lam * ex[(ds * 16 + g) * 128 + threadIdx.x]; o[ds][g] = dv; ss += dv * dv; }
    ss += __shfl_xor(ss, 32);
    float rstd = rsqrtf(ss * (1.f / 128.f) + 1e-6f) * (1.f - LAM_INIT);
    int T = Tq0 + wave * 32 + r;
#pragma unroll
    for (int ds = 0; ds < 4; ds++)
#pragma unroll
      for (int g4 = 0; g4 < 4; g4++) {
        int d0 = ds * 32 + 8 * g4 + 4 * h;
        float4 sg = *(const float4*)(p.subln + d0);
        *(uint2*)(p.MIX() + (size_t)T * 1024 + hh * 128 + d0) =
            make_uint2(pack2(o[ds][4 * g4] * rstd * sg.x, o[ds][4 * g4 + 1] * rstd * sg.y),
                       pack2(o[ds][4 * g4 + 2] * rstd * sg.z, o[ds][4 * g4 + 3] * rstd * sg.w));
      }
  }
}
DEV void phase_attn1(const Params& p, int bid, int nb, char* smem) {
  float d1 = 0.f, d2 = 0.f;
  for (int i = 0; i < 64; i++) { d1 += p.lq1[i] * p.lk1[i]; d2 += p.lq2[i] * p.lk2[i]; }
  float lam = __expf(d1) - __expf(d2) + LAM_INIT;
  for (int it = bid; it < 1024 + 2048; it += nb) {
    if (it >= 1024) {
      int j = it - 1024;
      if (j < 1024) prep_quant<true>(p.peer_u, p.U8(), p.SU(), 16384 + j * 16); else prep_quant<false>(p.peer_v, p.V8(), p.SV(), 16384 + (j - 1024) * 16);
    } else if (it < 256) {
      int b = it >> 6, hh = (it >> 4) & 3, qb = it & 15;
      diff_job(p, true, b, hh, qb, lam, smem);
    } else if (it < 512) {
      int j = it - 256; int b = j >> 6, hq = (j >> 3) & 7, qb = j & 7; int kvh = hq >> 2;
      int q0 = qb * 128;
      int lo = (q0 - 128 < 0 ? 0 : q0 - 128) >> 6, hi = (q0 + 256 > 1024 ? 1024 : q0 + 256) >> 6;
      f32x16 o[2];
      int Tq0 = 4096 + b * 1024 + q0;
      attn_softmax_job<64, false>(p, p.Q2(), Tq0, hq * 64, p.KD() + kvoff(true, b, kvh, -256, 2, 64, 1280, 256), p.KD(), p.VD() + kvoff(true, b, kvh, -256, 2, 64, 1280, 256),
                           4, lo, hi, q0, true, p.dsink[hq] * 1.4426950408889634f, o, smem);
      store_o64(p, o, Tq0, 512 + hq * 64);
    } else if (it < 768) {
      int j = it - 512; int b = j >> 4, hh = (j >> 2) & 3, qb = j & 3;
      diff_job(p, false, b, hh, qb, lam, smem);
    } else {
      int j = it - 768; int b = j >> 4, hq = (j >> 1) & 7, qb = j & 1; int kvh = hq >> 2;
      f32x16 o[2];
      int Tq0 = b * 256 + qb * 128;
      attn_softmax_job<64, false>(p, p.Q2(), Tq0, hq * 64, p.KD() + kvoff(false, b, kvh, 0, 2, 64, 1280, 256), p.KD(), p.VD() + kvoff(false, b, kvh, 0, 2, 64, 1280, 256),
                           4, 0, 0, qb * 128, true, p.dsink[hq] * 1.4426950408889634f, o, smem);
      store_o64(p, o, Tq0, 512 + hq * 64);
    }
  }
}

DEV float ub0(unsigned w) { return (float)(w & 255u); }
DEV float ub1(unsigned w) { return (float)((w >> 8) & 255u); }
DEV float ub2(unsigned w) { return (float)((w >> 16) & 255u); }
DEV float ub3(unsigned w) { return (float)(w >> 24); }
DEV void phase_peer(const Params& p, int layer, int bid, int nb, char* smem) {
  int wave = threadIdx.x >> 6, lane = threadIdx.x & 63;
  float* ws1 = (float*)(smem + wave * 2048); float* ws2 = ws1 + 16;
  int* wi1 = (int*)(ws2 + 16); int* wi2 = wi1 + 16; float* es = (float*)(wi2 + 16); int* eidx = (int*)(es + 16); float* eg = (float*)(eidx + 128);
  const unsigned char* U = p.U8() + (size_t)layer * 16384 * 1024;
  const unsigned char* V = p.V8() + (size_t)layer * 16384 * 1024;
  const float* SU = p.SU() + layer * 16384; const float* SV = p.SV() + layer * 16384;
  const float* gain = p.norm_ffn + layer * 1024;
  for (int T = bid * 4 + wave; T < 8192; T += nb * 4) {
    const float* sc = p.SC() + (size_t)T * 2048;
    for (int hh = 0; hh < 8; hh++) {
      const float* s = sc + hh * 256;
      float a0 = s[lane], a1 = s[lane + 64], b0 = s[128 + lane], b1 = s[192 + lane];
      unsigned ka0 = (fkey(a0) & ~127u) | (unsigned)(127 - lane), ka1 = (fkey(a1) & ~127u) | (unsigned)(63 - lane);
      unsigned kb0 = (fkey(b0) & ~127u) | (unsigned)(127 - lane), kb1 = (fkey(b1) & ~127u) | (unsigned)(63 - lane);
      unsigned pa = 0u, pb = 0u;
      for (int bit = 31; bit >= 0; --bit) {
        unsigned ta = pa | (1u << bit), tb = pb | (1u << bit);
        int ca = __popcll(__ballot(ka0 >= ta)) + __popcll(__ballot(ka1 >= ta));
        int cb = __popcll(__ballot(kb0 >= tb)) + __popcll(__ballot(kb1 >= tb));
        if (ca >= 16) pa = ta;
        if (cb >= 16) pb = tb;
      }
      {
        unsigned long long m0 = __ballot(ka0 >= pa), m1 = __ballot(ka1 >= pa);
        int p0 = mbcnt64(m0), p1 = __popcll(m0) + mbcnt64(m1);
        if (ka0 >= pa) { ws1[p0 & 15] = a0; wi1[p0 & 15] = lane; }
        if (ka1 >= pa) { ws1[p1 & 15] = a1; wi1[p1 & 15] = lane + 64; }
        unsigned long long n0 = __ballot(kb0 >= pb), n1 = __ballot(kb1 >= pb);
        int q0 = mbcnt64(n0), q1 = __popcll(n0) + mbcnt64(n1);
        if (kb0 >= pb) { ws2[q0 & 15] = b0; wi2[q0 & 15] = lane; }
        if (kb1 >= pb) { ws2[q1 & 15] = b1; wi2[q1 & 15] = lane + 64; }
      }
      __builtin_amdgcn_fence(__ATOMIC_ACQ_REL, "wavefront");
      __builtin_amdgcn_wave_barrier();
      int bq = lane & 15, aq = lane >> 4;
      float s2v = ws2[bq];
      float c0 = ws1[aq] + s2v, c1 = ws1[aq + 4] + s2v, c2 = ws1[aq + 8] + s2v, c3 = ws1[aq + 12] + s2v;
      unsigned k0 = (fkey(c0) & ~255u) | (unsigned)(255 - lane), k1 = (fkey(c1) & ~255u) | (unsigned)(191 - lane);
      unsigned k2 = (fkey(c2) & ~255u) | (unsigned)(127 - lane), k3 = (fkey(c3) & ~255u) | (unsigned)(63 - lane);
      unsigned pc = 0u;
      for (int bit = 31; bit >= 0; --bit) {
        unsigned tc = pc | (1u << bit);
        int cc = __popcll(__ballot(k0 >= tc)) + __popcll(__ballot(k1 >= tc)) + __popcll(__ballot(k2 >= tc)) + __popcll(__ballot(k3 >= tc));
        if (cc >= 16) pc = tc;
      }
      {
        unsigned long long m0 = __ballot(k0 >= pc), m1 = __ballot(k1 >= pc), m2 = __ballot(k2 >= pc), m3 = __ballot(k3 >= pc);
        int n0 = __popcll(m0), n1 = n0 + __popcll(m1), n2 = n1 + __popcll(m2);
        int i2b = wi2[bq];
        if (k0 >= pc) { int q = mbcnt64(m0) & 15; es[q] = c0; eidx[hh * 16 + q] = wi1[aq] * 128 + i2b; }
        if (k1 >= pc) { int q = (n0 + mbcnt64(m1)) & 15; es[q] = c1; eidx[hh * 16 + q] = wi1[aq + 4] * 128 + i2b; }
        if (k2 >= pc) { int q = (n1 + mbcnt64(m2)) & 15; es[q] = c2; eidx[hh * 16 + q] = wi1[aq + 8] * 128 + i2b; }
        if (k3 >= pc) { int q = (n2 + mbcnt64(m3)) & 15; es[q] = c3; eidx[hh * 16 + q] = wi1[aq + 12] * 128 + i2b; }
      }
      __builtin_amdgcn_fence(__ATOMIC_ACQ_REL, "wavefront");
      __builtin_amdgcn_wave_barrier();
      float ts = es[lane & 15];
      float mx = row_max16(ts);
      float pe = __expf(ts - mx);
      float sm = row_sum16(pe);
      if (lane < 16) eg[hh * 16 + lane] = pe / sm;
      __builtin_amdgcn_fence(__ATOMIC_ACQ_REL, "wavefront");
      __builtin_amdgcn_wave_barrier();
    }
    int mb = T < 4096 ? 0 : 1 + ((T - 4096) >> 10);
    const float* md = p.MOD() + (size_t)(layer * 5 + mb) * 6144;
    float4 xv[4]; float ssx = 0.f;
#pragma unroll
    for (int i = 0; i < 4; i++) { xv[i] = *(const float4*)(p.X() + (size_t)T * 1024 + (i * 64 + lane) * 4); ssx += xv[i].x * xv[i].x + xv[i].y * xv[i].y + xv[i].z * xv[i].z + xv[i].w * xv[i].w; }
    ssx = wave_sum(ssx);
    float rstdx = rsqrtf(ssx * (1.f / 1024.f) + 1e-6f);
    float4 hv[4]; float hmax = 0.f;
#pragma unroll
    for (int i = 0; i < 4; i++) {
      int col = (i * 64 + lane) * 4;
      float4 g = *(const float4*)(gain + col), sh = *(const float4*)(md + 3 * 1024 + col), scl = *(const float4*)(md + 4 * 1024 + col);
      hv[i].x = xv[i].x * rstdx * g.x * (1.f + scl.x) + sh.x; hv[i].y = xv[i].y * rstdx * g.y * (1.f + scl.y) + sh.y;
      hv[i].z = xv[i].z * rstdx * g.z * (1.f + scl.z) + sh.z; hv[i].w = xv[i].w * rstdx * g.w * (1.f + scl.w) + sh.w;
      hmax = fmaxf(hmax, fmaxf(fmaxf(fabsf(hv[i].x), fabsf(hv[i].y)), fmaxf(fabsf(hv[i].z), fabsf(hv[i].w))));
    }
    hmax = wave_max_f(hmax);
    float hinv = hmax > 0.f ? 127.f / hmax : 0.f, hscale = hmax * (1.f / 127.f);
    int hq[4];
#pragma unroll
    for (int i = 0; i < 4; i++) {
      unsigned b0 = (unsigned)((int)rintf(hv[i].x * hinv)) & 255u, b1 = (unsigned)((int)rintf(hv[i].y * hinv)) & 255u;
      unsigned b2 = (unsigned)((int)rintf(hv[i].z * hinv)) & 255u, b3 = (unsigned)((int)rintf(hv[i].w * hinv)) & 255u;
      hq[i] = (int)(b0 | (b1 << 8) | (b2 << 16) | (b3 << 24));
    }
#define PLOAD8(SET, TBL, B0) _Pragma("unroll") for (int j = 0; j < 8; j++) { \
        int e_ = __builtin_amdgcn_readfirstlane(eidx[(B0) * 8 + j]); SET[j] = *(const u32x4*)(TBL + (size_t)e_ * 1024 + lane * 16); }
#define PDOT8(SET, B0) _Pragma("unroll") for (int j = 0; j < 8; j++) { \
        int d_ = __builtin_amdgcn_sdot4(hq[0], (int)SET[j][0], 0, false); d_ = __builtin_amdgcn_sdot4(hq[1], (int)SET[j][1], d_, false); \
        d_ = __builtin_amdgcn_sdot4(hq[2], (int)SET[j][2], d_, false); d_ = __builtin_amdgcn_sdot4(hq[3], (int)SET[j][3], d_, false); \
        float D_ = (float)wave_sum_i(d_); int e_ = (B0) * 8 + j; bool me_ = lane == (e_ & 63); \
        a0 = (me_ && e_ < 64) ? D_ : a0; a1 = (me_ && e_ >= 64) ? D_ : a1; }
#define PACC8(SET, B0) _Pragma("unroll") for (int j = 0; j < 8; j++) { \
        int e_ = (B0) * 8 + j; float w = rlane(e_ < 64 ? w0 : w1, e_ & 63); \
        acc[0] += w * ub0(SET[j][0]); acc[1] += w * ub1(SET[j][0]); acc[2] += w * ub2(SET[j][0]); acc[3] += w * ub3(SET[j][0]); \
        acc[4] += w * ub0(SET[j][1]); acc[5] += w * ub1(SET[j][1]); acc[6] += w * ub2(SET[j][1]); acc[7] += w * ub3(SET[j][1]); \
        acc[8] += w * ub0(SET[j][2]); acc[9] += w * ub1(SET[j][2]); acc[10] += w * ub2(SET[j][2]); acc[11] += w * ub3(SET[j][2]); \
        acc[12] += w * ub0(SET[j][3]); acc[13] += w * ub1(SET[j][3]); acc[14] += w * ub2(SET[j][3]); acc[15] += w * ub3(SET[j][3]); }
    float acc[16];
#pragma unroll
    for (int i = 0; i < 16; i++) acc[i] = 0.f;
    float a0 = 0.f, a1 = 0.f;
    u32x4 sa[8], sb[8];
    PLOAD8(sa, U, 0)
#pragma unroll 1
    for (int bi = 0; bi < 16; bi += 2) {
      PLOAD8(sb, U, bi + 1)
      PDOT8(sa, bi)
      if (bi + 2 < 16) { PLOAD8(sa, U, bi + 2) } else { PLOAD8(sa, V, 0) }
      PDOT8(sb, bi + 1)
    }
    int e0 = eidx[lane], e1 = eidx[lane + 64];
    float w0 = eg[lane] * gelu_tanh(a0 * (SU[e0] * hscale)) * SV[e0];
    float w1 = eg[lane + 64] * gelu_tanh(a1 * (SU[e1] * hscale)) * SV[e1];
    float wsum = wave_sum(w0 + w1);
#pragma unroll 1
    for (int bi = 0; bi < 16; bi += 2) {
      PLOAD8(sb, V, bi + 1)
      PACC8(sa, bi)
      if (bi + 2 < 16) { PLOAD8(sa, V, bi + 2) }
      PACC8(sb, bi + 1)
    }
    float x2[16]; float ss = 0.f;
#pragma unroll
    for (int i = 0; i < 4; i++) {
      int col = (i * 64 + lane) * 4;
      float4 ga = *(const float4*)(md + 5 * 1024 + col);
      x2[i * 4 + 0] = xv[i].x + ga.x * (acc[i * 4 + 0] - 128.f * wsum); x2[i * 4 + 1] = xv[i].y + ga.y * (acc[i * 4 + 1] - 128.f * wsum);
      x2[i * 4 + 2] = xv[i].z + ga.z * (acc[i * 4 + 2] - 128.f * wsum); x2[i * 4 + 3] = xv[i].w + ga.w * (acc[i * 4 + 3] - 128.f * wsum);
    }
#pragma unroll
    for (int i = 0; i < 16; i++) ss += x2[i] * x2[i];
    ss = wave_sum(ss);
    float rstd = rsqrtf(ss * (1.f / 1024.f) + 1e-6f);
    if (layer == 0) {
      const float* md1 = p.MOD() + (size_t)(5 + mb) * 6144;
#pragma unroll
      for (int i = 0; i < 4; i++) {
        int col = (i * 64 + lane) * 4;
        *(float4*)(p.X() + (size_t)T * 1024 + col) = make_float4(x2[i * 4], x2[i * 4 + 1], x2[i * 4 + 2], x2[i * 4 + 3]);
        float4 g = *(const float4*)(p.norm_mix + 1024 + col), sh = *(const float4*)(md1 + col), scl = *(const float4*)(md1 + 1024 + col);
        float y0 = x2[i * 4] * rstd * g.x * (1.f + scl.x) + sh.x, y1 = x2[i * 4 + 1] * rstd * g.y * (1.f + scl.y) + sh.y;
        float y2 = x2[i * 4 + 2] * rstd * g.z * (1.f + scl.z) + sh.z, y3 = x2[i * 4 + 3] * rstd * g.w * (1.f + scl.w) + sh.w;
        *(uint2*)(p.H() + (size_t)T * 1024 + col) = make_uint2(pack2(y0, y1), pack2(y2, y3));
      }
    } else {
#pragma unroll
      for (int i = 0; i < 4; i++) {
        int col = (i * 64 + lane) * 4;
        float4 g = *(const float4*)(p.norm_final + col);
        *(float4*)(p.out + (size_t)T * 1024 + col) = make_float4(x2[i * 4] * rstd * g.x, x2[i * 4 + 1] * rstd * g.y, x2[i * 4 + 2] * rstd * g.z, x2[i * 4 + 3] * rstd * g.w);
      }
    }
  }
}

#define XB_TMO      128
#define XB_XCNT(j)  (256  + 64 * (j))
#define XB_XSUB(j)  (1280 + 64 * (j))
#define XB_XGEN(j)  (2304 + 64 * (j))
#define XB_TOP      3328
#define XB_TOPGEN   3392
#define XCD_BAR_WORDS 3456
#define XB_SPIN_CAP (1u << 20)
#define LAS __attribute__((address_space(3)))
DEV unsigned xb_ld(unsigned* p)              { return __hip_atomic_load(p, __ATOMIC_RELAXED, __HIP_MEMORY_SCOPE_AGENT); }
DEV unsigned xb_add(unsigned* p, unsigned v) { return __hip_atomic_fetch_add(p, v, __ATOMIC_RELAXED, __HIP_MEMORY_SCOPE_AGENT); }
DEV unsigned xb_xcc_id() { return (unsigned)__builtin_amdgcn_s_getreg((3 << 11) | 20) & 0xFu; }
#define XB_SPIN(cond, bar) do { unsigned _sp = 0; while (cond) { __builtin_amdgcn_s_sleep(4); \
    if ((++_sp & 255u) == 0u) { if (xb_ld(&(bar)[XB_TMO])) break; if (_sp > XB_SPIN_CAP) { atomicAdd(&(bar)[XB_TMO], 1u); break; } } } } while (0)
struct XcdBarrier { unsigned* bar; unsigned x; volatile LAS unsigned* st; };
DEV XcdBarrier xcd_barrier_post(unsigned* bar, volatile LAS unsigned* st) {
  XcdBarrier b; b.bar = bar; b.x = xb_xcc_id(); b.st = st;
  if (threadIdx.x == 0) (void)xb_add(&bar[XB_XCNT(b.x)], 1u);
  return b;
}
DEV void xcd_barrier_complete(unsigned* bar, unsigned x, unsigned& nloc, unsigned& nx) {
  const unsigned G = gridDim.x * gridDim.y * gridDim.z;
  unsigned sum, cnt, mine, sp = 0u;
  for (;;) {
    sum = 0u; cnt = 0u; mine = 0u;
#pragma unroll
    for (unsigned j = 0; j < 16; ++j) { const unsigned c = xb_ld(&bar[XB_XCNT(j)]); sum += c; cnt += (c > 0u) ? 1u : 0u; mine = (j == x) ? c : mine; }
    if (sum == G) break;
    __builtin_amdgcn_s_sleep(1);
    if ((++sp & 255u) == 0u) { if (xb_ld(&bar[XB_TMO])) break; if (sp > XB_SPIN_CAP) { atomicAdd(&bar[XB_TMO], 1u); break; } }
  }
  nloc = mine > 0u ? mine : 1u; nx = cnt > 0u ? cnt : 1u;
}
DEV void xcd_barrier(const XcdBarrier& b) {
  asm volatile("s_waitcnt vmcnt(0)" ::: "memory");
  __syncthreads();
  if (threadIdx.x == 0) {
    unsigned* bar = b.bar;
    __builtin_amdgcn_s_waitcnt(0);
    unsigned nloc = b.st[0], nx = b.st[1];
    if (nloc == 0u) { xcd_barrier_complete(bar, b.x, nloc, nx); b.st[0] = nloc; b.st[1] = nx; }
    const unsigned old = xb_add(&bar[XB_XSUB(b.x)], 1u);
    const unsigned gen = old / nloc;
    if (old + 1u == (gen + 1u) * nloc) {
      __builtin_amdgcn_fence(__ATOMIC_RELEASE, "agent");
      asm volatile("s_waitcnt vmcnt(0)" ::: "memory");
      const unsigned og = xb_add(&bar[XB_TOP], 1u);
      const unsigned tg = og / nx;
      if (og + 1u == (tg + 1u) * nx) xb_add(&bar[XB_TOPGEN], 1u);
      else XB_SPIN(xb_ld(&bar[XB_TOPGEN]) == tg, bar);
      __builtin_amdgcn_fence(__ATOMIC_ACQUIRE, "agent");
      xb_add(&bar[XB_XGEN(b.x)], 1u);
      asm volatile("s_waitcnt vmcnt(0)" ::: "memory");
    } else {
      XB_SPIN(xb_ld(&bar[XB_XGEN(b.x)]) == gen, bar);
      __builtin_amdgcn_fence(__ATOMIC_ACQUIRE, "agent");
      asm volatile("s_waitcnt vmcnt(0)" ::: "memory");
    }
  }
  __syncthreads();
}

constexpr int NPHASE = 14;
DEV void run_phase(const Params& p, int ph, int bid, int nb, char* smem) {
  switch (ph) {
    case 0: phase_prep(p, bid, nb, smem); break;
    case 1: phase_ada(p, 0, p.norm_mix, 0, 1, true, bid, nb); break;
    case 2: gemm_phase(p.H(), 1024, p.WT_EVIN(), 1024, 1024, 64, 22, bid, nb, smem, [&](int m0, int n0, const float* Cs) { epi_inproj0(p, m0, n0, Cs); }); break;
    case 3: phase_attn0(p, bid, nb, smem); break;
    case 4: gemm_phase(p.MIX(), 1024, p.WT_EVOUT(), 1024, 1024, 64, 8, bid, nb, smem, [&](int m0, int n0, const float* Cs) { epi_outproj(p, 0, m0, n0, Cs); }); break;
    case 5: phase_ada(p, 0, p.norm_ffn, 3, 4, false, bid, nb); break;
    case 11: phase_ada(p, 1, p.norm_ffn + 1024, 3, 4, false, bid, nb); break;
    case 6: case 12: {
      int layer = ph == 6 ? 0 : 1;
      const u16* sk = p.SUBK() + (size_t)layer * 16 * 128 * 128;
      gemm_phase(p.H(), 1024, p.WT_PQ() + (size_t)layer * 2048 * 1024, 1024, 1024, 64, 16, bid, nb, smem, [&](int m0, int n0, const float* Cs) {
        int lane = threadIdx.x & 63, wave = threadIdx.x >> 6;
#pragma unroll 8
        for (int rr = wave; rr < 128; rr += 4) {
          float2 c = *(const float2*)(Cs + rr * 128 + lane * 2);
          *(unsigned*)(p.PQ() + (size_t)(m0 + rr) * 2048 + n0 + lane * 2) = pack2(c.x, c.y);
        }
        asm volatile("s_waitcnt vmcnt(0)" ::: "memory");
        __syncthreads();
        int hc = n0 >> 7;
        f32x16 acc[2][2];
        zero16(acc[0][0]); zero16(acc[0][1]); zero16(acc[1][0]); zero16(acc[1][1]);
        gemm_tile(p.PQ() + (size_t)m0 * 2048 + hc * 128, 2048, sk + (size_t)hc * 128 * 128, 128, 128, smem, acc);
        const float* Cs2 = (const float*)smem;
#pragma unroll 8
        for (int rr = wave; rr < 128; rr += 4) {
          float2 c = *(const float2*)(Cs2 + rr * 128 + lane * 2);
          *(float2*)(p.SC() + (size_t)(m0 + rr) * 2048 + hc * 128 + lane * 2) = c;
        }
      });
    } break;
    case 7: phase_peer(p, 0, bid, nb, smem); break;
    case 13: phase_peer(p, 1, bid, nb, smem); break;
    case 8: gemm_phase(p.H(), 1024, p.WT_ODIN(), 1024, 1024, 64, 18, bid, nb, smem, [&](int m0, int n0, const float* Cs) { epi_inproj1(p, m0, n0, Cs); }); break;
    case 9: phase_attn1(p, bid, nb, smem); break;
    case 10: gemm_phase(p.MIX(), 1024, p.WT_ODOUT(), 1024, 1024, 64, 8, bid, nb, smem, [&](int m0, int n0, const float* Cs) { epi_outproj(p, 1, m0, n0, Cs); }); break;
    default: break;
  }
}

constexpr size_t PARAMS_OFF = 330036736ull;
template <int PH> DEV void run_all(const Params& p, cg::grid_group& grid, const XcdBarrier& xb, char* smem) {
  if constexpr (PH == 0) {
    if (blockIdx.x == 0 && threadIdx.x < sizeof(Params) / 8) ((unsigned long long*)(p.ws + PARAMS_OFF))[threadIdx.x] = ((const unsigned long long*)&p)[threadIdx.x];
    run_phase(p, PH, blockIdx.x, gridDim.x, smem);
  } else {
    run_phase(p, PH, blockIdx.x, gridDim.x, smem);
  }
  if constexpr (PH + 1 < NPHASE) {
    if (PH == 0 && p.ws == nullptr) grid.sync();
    xcd_barrier(xb);
    run_all<PH + 1>(p, grid, xb, smem);
  }
}
__global__ void __launch_bounds__(256, 2) mega_kernel(Params p) {
  __shared__ __attribute__((aligned(16))) char smem[77824];
  __shared__ uint4 xb_words;
  if (threadIdx.x == 0) xb_words = make_uint4(0u, 0u, 0u, 0u);
  __syncthreads();
  XcdBarrier xb = xcd_barrier_post(p.BAR(), (volatile LAS unsigned*)&xb_words);
  cg::grid_group grid = cg::this_grid();
  run_all<0>(p, grid, xb, smem);
}
#if MULTI_LAUNCH
template <int PH> __global__ void __launch_bounds__(256, 2) phase_kernel(Params p) {
  __shared__ __attribute__((aligned(16))) char smem[77824];
  run_phase(p, PH, blockIdx.x, gridDim.x, smem);
}
template <int PH> static void launch_all(const Params& p, int grid, hipStream_t s) {
  phase_kernel<PH><<<grid, 256, 0, s>>>(p);
  if constexpr (PH + 1 < NPHASE) launch_all<PH + 1>(p, grid, s);
}
#endif

extern "C" void kernel_launch(void* const* d_in, const int* in_sizes, int n_in, void* d_out, int out_size, void* d_ws, size_t ws_size, hipStream_t stream) {
  Params p{};
  const float* const* in = (const float* const*)d_in;
  p.xp = in[0]; p.xs = in[1]; p.c = in[2]; p.cctx = in[3]; p.cak = in[4]; p.cav = in[5]; p.srf = in[6]; p.srb = in[7];
  p.cck = in[8]; p.ccv = in[9]; p.cdk = in[10]; p.cdv = in[11];
  p.mod_w = in[12]; p.mod_b = in[13]; p.norm_mix = in[14]; p.norm_ffn = in[15]; p.norm_final = in[16];
  p.ev_w_in = in[17]; p.ev_w_out = in[18]; p.a_q_norm = in[19]; p.a_k_norm = in[20]; p.rdf = in[21]; p.rdb = in[22];
  p.od_w_in = in[23]; p.od_w_out = in[24]; p.lq1 = in[25]; p.lk1 = in[26]; p.lq2 = in[27]; p.lk2 = in[28]; p.subln = in[29]; p.dsink = in[30];
  p.peer_wq = in[31]; p.peer_sk = in[32]; p.peer_u = in[33]; p.peer_v = in[34];
  p.out = (float*)d_out;
  p.ws = (char*)d_ws;
  (void)in_sizes; (void)n_in; (void)out_size; (void)ws_size;
#if MULTI_LAUNCH
  launch_all<0>(p, 512, stream);
#else
  static int grid_blocks = 0;
  if (!grid_blocks) {
    int dev = 0, cus = 0, per_cu = 0;
    hipGetDevice(&dev);
    hipDeviceGetAttribute(&cus, hipDeviceAttributeMultiprocessorCount, dev);
    hipOccupancyMaxActiveBlocksPerMultiprocessor(&per_cu, mega_kernel, 256, 0);
    if (per_cu > 2) per_cu = 2;
    if (per_cu < 1) per_cu = 1;
    grid_blocks = cus * per_cu;
  }
  (void)hipMemsetAsync(d_ws, 0, XCD_BAR_WORDS * 4, stream);
  void* args[] = {&p};
  hipError_t e = hipLaunchCooperativeKernel((void*)mega_kernel, dim3(grid_blocks), dim3(256), args, 0, stream);
  if (e != hipSuccess) fprintf(stderr, "cooperative launch failed: %s (grid %d)\n", hipGetErrorString(e), grid_blocks);
#endif
}
```

```cpp
#include <hip/hip_runtime.h>
#include <hip/hip_cooperative_groups.h>
#include <cstdio>
namespace cg = cooperative_groups;

#ifndef MULTI_LAUNCH
#define MULTI_LAUNCH 0
#endif

typedef unsigned short u16;
typedef __attribute__((ext_vector_type(8))) short bf16x8;
typedef __attribute__((ext_vector_type(16))) float f32x16;
typedef __attribute__((ext_vector_type(4))) unsigned u32x4;

#define DEV __device__ __forceinline__

constexpr size_t OUT_AK = 8388608, OUT_AV = 8912896, OUT_RF = 9437184, OUT_RB = 9961472,
                 OUT_CK = 10485760, OUT_CV = 12582912, OUT_DK = 14680064, OUT_DV = 15204352;
constexpr float LAM_INIT = 0.35550906f;

struct Params {
  const float *xp, *xs, *c, *cctx, *cak, *cav, *srf, *srb, *cck, *ccv, *cdk, *cdv;
  const float *mod_w, *mod_b, *norm_mix, *norm_ffn, *norm_final;
  const float *ev_w_in, *ev_w_out, *a_q_norm, *a_k_norm, *rdf, *rdb;
  const float *od_w_in, *od_w_out, *lq1, *lk1, *lq2, *lk2, *subln, *dsink;
  const float *peer_wq, *peer_sk, *peer_u, *peer_v;
  float* out;
  char* ws;
  __device__ __forceinline__ unsigned* BAR() const { return (unsigned*)(ws + 0ull); }
  __device__ __forceinline__ float* MOD() const { return (float*)(ws + 13824ull); }
  __device__ __forceinline__ float* ROPEC() const { return (float*)(ws + 259584ull); }
  __device__ __forceinline__ float* ROPES() const { return (float*)(ws + 390656ull); }
  __device__ __forceinline__ float* X() const { return (float*)(ws + 521728ull); }
  __device__ __forceinline__ float* SC() const { return (float*)(ws + 34076160ull); }
  __device__ __forceinline__ u16* WT_EVIN() const { return (u16*)(ws + 101185024ull); }
  __device__ __forceinline__ u16* WT_EVOUT() const { return (u16*)(ws + 106952192ull); }
  __device__ __forceinline__ u16* WT_ODIN() const { return (u16*)(ws + 109049344ull); }
  __device__ __forceinline__ u16* WT_ODOUT() const { return (u16*)(ws + 113767936ull); }
  __device__ __forceinline__ u16* WT_PQ() const { return (u16*)(ws + 115865088ull); }
  __device__ __forceinline__ u16* SUBK() const { return (u16*)(ws + 124253696ull); }
  __device__ __forceinline__ unsigned char* U8() const { return (unsigned char*)(ws + 125302272ull); }
  __device__ __forceinline__ unsigned char* V8() const { return (unsigned char*)(ws + 158856704ull); }
  __device__ __forceinline__ float* SU() const { return (float*)(ws + 192411136ull); }
  __device__ __forceinline__ float* SV() const { return (float*)(ws + 192542208ull); }
  __device__ __forceinline__ u16* H() const { return (u16*)(ws + 192673280ull); }
  __device__ __forceinline__ u16* MIX() const { return (u16*)(ws + 209450496ull); }
  __device__ __forceinline__ u16* Q1() const { return (u16*)(ws + 226227712ull); }
  __device__ __forceinline__ u16* Q2() const { return (u16*)(ws + 234616320ull); }
  __device__ __forceinline__ u16* SG() const { return (u16*)(ws + 243004928ull); }
  __device__ __forceinline__ u16* KA() const { return (u16*)(ws + 251393536ull); }
  __device__ __forceinline__ u16* VA() const { return (u16*)(ws + 253752832ull); }
  __device__ __forceinline__ u16* RK() const { return (u16*)(ws + 256112128ull); }
  __device__ __forceinline__ u16* RV() const { return (u16*)(ws + 264500736ull); }
  __device__ __forceinline__ u16* KC() const { return (u16*)(ws + 272889344ull); }
  __device__ __forceinline__ u16* VC() const { return (u16*)(ws + 282326528ull); }
  __device__ __forceinline__ u16* KD() const { return (u16*)(ws + 291763712ull); }
  __device__ __forceinline__ u16* VD() const { return (u16*)(ws + 294123008ull); }
  __device__ __forceinline__ u16* PQ() const { return (u16*)(ws + 296482304ull); }
};

DEV float bf2f(unsigned b) { return __uint_as_float(b << 16); }
typedef __bf16 bf16v2 __attribute__((ext_vector_type(2)));
typedef float f32v2 __attribute__((ext_vector_type(2)));
DEV unsigned pack2(float a, float b) { f32v2 v = {a, b}; return __builtin_bit_cast(unsigned, __builtin_convertvector(v, bf16v2)); }
DEV u16 f2bf(float f) { return (u16)(pack2(f, 0.f) & 0xffffu); }
DEV float bflo(unsigned w) { return __uint_as_float(w << 16); }
DEV float bfhi(unsigned w) { return __uint_as_float(w & 0xffff0000u); }
DEV float silu_f(float v) { return v / (1.f + __expf(-v)); }
DEV float gelu_tanh(float a) {
  float z = 0.7978845608f * (a + 0.044715f * a * a * a);
  float e = __expf(2.f * z);
  float th = 1.f - 2.f / (e + 1.f);
  return 0.5f * a * (1.f + th);
}
template <int CTRL> DEV float dpp_f(float v) {
  return __int_as_float(__builtin_amdgcn_update_dpp(0, __float_as_int(v), CTRL, 0xF, 0xF, true));
}
template <int CTRL> DEV unsigned dpp_u(unsigned v) {
  return (unsigned)__builtin_amdgcn_update_dpp(0, (int)v, CTRL, 0xF, 0xF, true);
}
DEV float row_sum16(float v) {
  v += dpp_f<0xB1>(v); v += dpp_f<0x4E>(v); v += dpp_f<0x141>(v); v += dpp_f<0x140>(v); return v;
}
DEV float row_max16(float v) {
  v = fmaxf(v, dpp_f<0xB1>(v)); v = fmaxf(v, dpp_f<0x4E>(v)); v = fmaxf(v, dpp_f<0x141>(v)); v = fmaxf(v, dpp_f<0x140>(v)); return v;
}
DEV float rlane(float v, int l) { return __int_as_float(__builtin_amdgcn_readlane(__float_as_int(v), l)); }
DEV float wave_sum(float v) {
  v = row_sum16(v);
  return (rlane(v, 0) + rlane(v, 16)) + (rlane(v, 32) + rlane(v, 48));
}
DEV unsigned wave_max_u(unsigned v) {
  v = max(v, dpp_u<0xB1>(v)); v = max(v, dpp_u<0x4E>(v)); v = max(v, dpp_u<0x141>(v)); v = max(v, dpp_u<0x140>(v));
  unsigned a = (unsigned)__builtin_amdgcn_readlane((int)v, 0), b = (unsigned)__builtin_amdgcn_readlane((int)v, 16);
  unsigned c = (unsigned)__builtin_amdgcn_readlane((int)v, 32), d = (unsigned)__builtin_amdgcn_readlane((int)v, 48);
  return max(max(a, b), max(c, d));
}
DEV float half_sum32(float v) { v = row_sum16(v); return v + __shfl_xor(v, 16); }
DEV unsigned fkey(float f) { unsigned u = __float_as_uint(f); return (u & 0x80000000u) ? ~u : (u | 0x80000000u); }
DEV f32x16 mfma32(bf16x8 a, bf16x8 b, f32x16 c) { return __builtin_amdgcn_mfma_f32_32x32x16_bf16(a, b, c, 0, 0, 0); }
DEV void zero16(f32x16& v) {
#pragma unroll
  for (int i = 0; i < 16; i++) v[i] = 0.f;
}
DEV size_t kvoff(bool smp, int b, int hh, int tpos, int H, int DW, int LS, int off) {
  return smp ? (size_t)4096 * H * DW + ((size_t)(b * H + hh) * LS + off + tpos) * DW
             : ((size_t)(b * H + hh) * 256 + tpos) * DW;
}


DEV float wave_max_f(float v) {
  v = row_max16(v);
  return fmaxf(fmaxf(rlane(v, 0), rlane(v, 16)), fmaxf(rlane(v, 32), rlane(v, 48)));
}
DEV int wave_sum_i(int v) {
  v += (int)dpp_u<0xB1>((unsigned)v); v += (int)dpp_u<0x4E>((unsigned)v); v += (int)dpp_u<0x141>((unsigned)v); v += (int)dpp_u<0x140>((unsigned)v);
  return (__builtin_amdgcn_readlane(v, 0) + __builtin_amdgcn_readlane(v, 16)) + (__builtin_amdgcn_readlane(v, 32) + __builtin_amdgcn_readlane(v, 48));
}
DEV int mbcnt64(unsigned long long m) { return (int)__builtin_amdgcn_mbcnt_hi((unsigned)(m >> 32), __builtin_amdgcn_mbcnt_lo((unsigned)m, 0u)); }
template <bool SGN> DEV void prep_quant(const float* __restrict__ src, unsigned char* __restrict__ dst, float* __restrict__ scale, int row0) {
  int lane = threadIdx.x & 63, wave = threadIdx.x >> 6;
  int rbase = row0 + wave * 4;
  float4 v[4][4];
#pragma unroll
  for (int q = 0; q < 4; q++)
#pragma unroll
    for (int i = 0; i < 4; i++) v[q][i] = *(const float4*)(src + (size_t)(rbase + q) * 1024 + (i * 64 + lane) * 4);
#pragma unroll
  for (int q = 0; q < 4; q++) {
    float mx = 0.f;
#pragma unroll
    for (int i = 0; i < 4; i++) mx = fmaxf(mx, fmaxf(fmaxf(fabsf(v[q][i].x), fabsf(v[q][i].y)), fmaxf(fabsf(v[q][i].z), fabsf(v[q][i].w))));
    mx = wave_max_f(mx);
    float inv = mx > 0.f ? 127.f / mx : 0.f;
    unsigned w[4];
#pragma unroll
    for (int i = 0; i < 4; i++) {
      int off = SGN ? 0 : 128;
      unsigned b0 = (unsigned)((int)rintf(v[q][i].x * inv) + off) & 255u, b1 = (unsigned)((int)rintf(v[q][i].y * inv) + off) & 255u;
      unsigned b2 = (unsigned)((int)rintf(v[q][i].z * inv) + off) & 255u, b3 = (unsigned)((int)rintf(v[q][i].w * inv) + off) & 255u;
      w[i] = b0 | (b1 << 8) | (b2 << 16) | (b3 << 24);
    }
    *(uint4*)(dst + (size_t)(rbase + q) * 1024 + lane * 16) = make_uint4(w[0], w[1], w[2], w[3]);
    if (lane == 0) scale[rbase + q] = mx * (1.f / 127.f);
  }
}

DEV void prep_transpose(const float* __restrict__ W, int N, u16* __restrict__ Wt, int tile, float* sm) {
  int ntn = N >> 6; int kt = tile / ntn, nt = tile % ntn;
  int k0 = kt * 64, n0 = nt * 64; int t = threadIdx.x;
#pragma unroll
  for (int i = 0; i < 4; i++) {
    int k = (t >> 4) + 16 * i; int c4 = (t & 15) * 4;
    float4 v = *(const float4*)(W + (size_t)(k0 + k) * N + n0 + c4);
    sm[k * 65 + c4] = v.x; sm[k * 65 + c4 + 1] = v.y; sm[k * 65 + c4 + 2] = v.z; sm[k * 65 + c4 + 3] = v.w;
  }
  __syncthreads();
  int n = t >> 2, kc = (t & 3) * 16;
  unsigned pk[8];
#pragma unroll
  for (int j = 0; j < 8; j++) pk[j] = pack2(sm[(kc + 2 * j) * 65 + n], sm[(kc + 2 * j + 1) * 65 + n]);
  uint4* dst = (uint4*)(Wt + (size_t)(n0 + n) * 1024 + k0 + kc);
  dst[0] = make_uint4(pk[0], pk[1], pk[2], pk[3]);
  dst[1] = make_uint4(pk[4], pk[5], pk[6], pk[7]);
  __syncthreads();
}
DEV void conv_item(const float* __restrict__ src, u16* __restrict__ dst) {
  int t = threadIdx.x;
#pragma unroll
  for (int i = 0; i < 8; i++) {
    int e = (i * 256 + t) * 8;
    float4 a = *(const float4*)(src + e), b = *(const float4*)(src + e + 4);
    *(uint4*)(dst + e) = make_uint4(pack2(a.x, a.y), pack2(a.z, a.w), pack2(b.x, b.y), pack2(b.z, b.w));
  }
}
DEV void prep_mod(const Params& p, int it, float* sm) {
  int l = it / 96, n0 = (it % 96) * 64; int t = threadIdx.x;
  float* sc = sm;
  for (int i = t; i < 5120; i += 256) {
    int b = i >> 10, k = i & 1023;
    float v = (b == 0) ? p.cctx[k] : p.c[(b - 1) * 1024 + k];
    sc[i] = silu_f(v);
  }
  __syncthreads();
  int col = t & 63, kg = t >> 6;
  float a0 = 0, a1 = 0, a2 = 0, a3 = 0, a4 = 0;
  const float* w = p.mod_w + (size_t)l * 1024 * 6144 + n0 + col;
  for (int k0 = kg; k0 < 1024; k0 += 32) {
    float wv[8];
#pragma unroll
    for (int u = 0; u < 8; u++) wv[u] = w[(size_t)(k0 + 4 * u) * 6144];
#pragma unroll
    for (int u = 0; u < 8; u++) {
      int k = k0 + 4 * u;
      a0 += sc[k] * wv[u]; a1 += sc[1024 + k] * wv[u]; a2 += sc[2048 + k] * wv[u]; a3 += sc[3072 + k] * wv[u]; a4 += sc[4096 + k] * wv[u];
    }
  }
  float* red = sm + 5120;
  red[(kg * 5 + 0) * 64 + col] = a0; red[(kg * 5 + 1) * 64 + col] = a1; red[(kg * 5 + 2) * 64 + col] = a2;
  red[(kg * 5 + 3) * 64 + col] = a3; red[(kg * 5 + 4) * 64 + col] = a4;
  __syncthreads();
  if (t < 64) {
#pragma unroll
    for (int b = 0; b < 5; b++) {
      float s = red[(0 * 5 + b) * 64 + t] + red[(1 * 5 + b) * 64 + t] + red[(2 * 5 + b) * 64 + t] + red[(3 * 5 + b) * 64 + t];
      p.MOD()[(size_t)(l * 5 + b) * 6144 + n0 + t] = s + p.mod_b[l * 6144 + n0 + t];
    }
  }
  __syncthreads();
}
DEV void prep_cache(const Params& p, int it) {
  const float* src; u16* dst;
  if (it < 8)       { int ch = it;      src = p.cak + (size_t)ch * 16384; dst = p.KA() + (size_t)4096 * 2 * 64 + (size_t)ch * 1280 * 64; }
  else if (it < 16) { int ch = it - 8;  src = p.cav + (size_t)ch * 16384; dst = p.VA() + (size_t)4096 * 2 * 64 + (size_t)ch * 1280 * 64; }
  else if (it < 48) { int ch = it - 16; src = p.cck + (size_t)ch * 16384; dst = p.KC() + (size_t)4096 * 8 * 64 + (size_t)ch * 1280 * 64; }
  else if (it < 80) { int ch = (it - 48) >> 1, hf = (it - 48) & 1;
                      src = p.ccv + (size_t)ch * 32768 + hf * 16384; dst = p.VC() + (size_t)4096 * 4 * 128 + (size_t)ch * 1280 * 128 + hf * 16384; }
  else if (it < 88) { int ch = it - 80; src = p.cdk + (size_t)ch * 16384; dst = p.KD() + (size_t)4096 * 2 * 64 + (size_t)ch * 1280 * 64; }
  else              { int ch = it - 88; src = p.cdv + (size_t)ch * 16384; dst = p.VD() + (size_t)4096 * 2 * 64 + (size_t)ch * 1280 * 64; }
  conv_item(src, dst);
}
DEV void prep_rope(const Params& p, int it) {
  for (int i = 0; i < 16; i++) {
    int idx = it * 4096 + i * 256 + threadIdx.x;
    int tpos = idx >> 5, a = idx & 31;
    float pos = (a < 16) ? (float)(tpos >> 6) : (float)(tpos & 63);
    float inv = exp2f(-(float)(a & 15) * (13.287712379549449f / 16.f));
    float ang = pos * inv;
    p.ROPEC()[idx] = __cosf(ang); p.ROPES()[idx] = __sinf(ang);
  }
}
constexpr int PREP_T0 = 704, PREP_T1 = PREP_T0 + 256, PREP_T2 = PREP_T1 + 576, PREP_T3 = PREP_T2 + 256, PREP_T4 = PREP_T3 + 1024;
constexpr int PREP_U = PREP_T4 + 2048, PREP_V = PREP_U + 2048, PREP_SK = PREP_V + 32, PREP_CA = PREP_SK + 96, PREP_RO = PREP_CA + 8, PREP_MOD = PREP_RO + 192;
DEV void phase_prep(const Params& p, int bid, int nb, char* smem) {
  float* sm = (float*)smem;
  for (int it0 = bid; it0 < PREP_MOD; it0 += nb) {
    int it = (it0 < 192) ? (PREP_RO + it0) : (it0 - 192);
    if (it >= PREP_T4 && it < PREP_V) continue;
    if (it < PREP_T0) prep_transpose(p.ev_w_in, 2816, p.WT_EVIN(), it, sm);
    else if (it < PREP_T1) prep_transpose(p.ev_w_out, 1024, p.WT_EVOUT(), it - PREP_T0, sm);
    else if (it < PREP_T2) prep_transpose(p.od_w_in, 2304, p.WT_ODIN(), it - PREP_T1, sm);
    else if (it < PREP_T3) prep_transpose(p.od_w_out, 1024, p.WT_ODOUT(), it - PREP_T2, sm);
    else if (it < PREP_T4) { int j = it - PREP_T3; int l = j >> 9; prep_transpose(p.peer_wq + (size_t)l * 1024 * 2048, 2048, p.WT_PQ() + (size_t)l * 2048 * 1024, j & 511, sm); }
    else if (it < PREP_V) { }
    else if (it < PREP_SK) { size_t o = (size_t)(it - PREP_V) * 16384; conv_item(p.peer_sk + o, p.SUBK() + o); }
    else if (it < PREP_CA) prep_cache(p, it - PREP_SK);
    else if (it < PREP_RO) prep_rope(p, it - PREP_CA);
    else prep_mod(p, it - PREP_RO, sm);
  }
}

DEV void phase_ada(const Params& p, int layer, const float* __restrict__ gain, int shift_i, int scale_i, bool from_input, int bid, int nb) {
  int wave = threadIdx.x >> 6, lane = threadIdx.x & 63;
  for (int T0 = (bid * 4 + wave) * 2; T0 < 8192; T0 += nb * 8) {
    float4 v[2][4]; float ss[2];
#pragma unroll
    for (int q = 0; q < 2; q++) {
      int T = T0 + q;
      const float* xr = from_input ? (T < 4096 ? p.xp + (size_t)T * 1024 : p.xs + (size_t)(T - 4096) * 1024) : p.X() + (size_t)T * 1024;
#pragma unroll
      for (int i = 0; i < 4; i++) v[q][i] = *(const float4*)(xr + (i * 64 + lane) * 4);
    }
    int mb = T0 < 4096 ? 0 : 1 + ((T0 - 4096) >> 10);
    const float* md = p.MOD() + (size_t)(layer * 5 + mb) * 6144;
    float4 g[4], sh[4], sc[4];
#pragma unroll
    for (int i = 0; i < 4; i++) {
      int col = (i * 64 + lane) * 4;
      g[i] = *(const float4*)(gain + col); sh[i] = *(const float4*)(md + shift_i * 1024 + col); sc[i] = *(const float4*)(md + scale_i * 1024 + col);
    }
#pragma unroll
    for (int q = 0; q < 2; q++) {
      float s2 = 0.f;
#pragma unroll
      for (int i = 0; i < 4; i++) s2 += v[q][i].x * v[q][i].x + v[q][i].y * v[q][i].y + v[q][i].z * v[q][i].z + v[q][i].w * v[q][i].w;
      ss[q] = wave_sum(s2);
    }
#pragma unroll
    for (int q = 0; q < 2; q++) {
      float rstd = rsqrtf(ss[q] * (1.f / 1024.f) + 1e-6f);
#pragma unroll
      for (int i = 0; i < 4; i++) {
        int col = (i * 64 + lane) * 4;
        float y0 = v[q][i].x * rstd * g[i].x * (1.f + sc[i].x) + sh[i].x, y1 = v[q][i].y * rstd * g[i].y * (1.f + sc[i].y) + sh[i].y;
        float y2 = v[q][i].z * rstd * g[i].z * (1.f + sc[i].z) + sh[i].z, y3 = v[q][i].w * rstd * g[i].w * (1.f + sc[i].w) + sh[i].w;
        *(uint2*)(p.H() + (size_t)(T0 + q) * 1024 + col) = make_uint2(pack2(y0, y1), pack2(y2, y3));
      }
    }
  }
}

#define GLOAD8(PA, PB) \
  ra0 = *(const u32x4*)(PA); ra1 = *(const u32x4*)((PA) + sa32); ra2 = *(const u32x4*)((PA) + 2 * sa32); ra3 = *(const u32x4*)((PA) + 3 * sa32); \
  rb0 = *(const u32x4*)(PB); rb1 = *(const u32x4*)((PB) + sb32); rb2 = *(const u32x4*)((PB) + 2 * sb32); rb3 = *(const u32x4*)((PB) + 3 * sb32);
#define GLOAD8N(PA, PB) \
  na0 = *(const u32x4*)(PA); na1 = *(const u32x4*)((PA) + sa32); na2 = *(const u32x4*)((PA) + 2 * sa32); na3 = *(const u32x4*)((PA) + 3 * sa32); \
  nb0 = *(const u32x4*)(PB); nb1 = *(const u32x4*)((PB) + sb32); nb2 = *(const u32x4*)((PB) + 2 * sb32); nb3 = *(const u32x4*)((PB) + 3 * sb32);
#define GSTORE8(BUF) { u16* wa_ = (u16*)(smem + (BUF) * 36864) + lrow * 72 + lkc; u16* wb_ = wa_ + 128 * 72; \
  *(u32x4*)(wa_) = ra0; *(u32x4*)(wa_ + 32 * 72) = ra1; *(u32x4*)(wa_ + 64 * 72) = ra2; *(u32x4*)(wa_ + 96 * 72) = ra3; \
  *(u32x4*)(wb_) = rb0; *(u32x4*)(wb_ + 32 * 72) = rb1; *(u32x4*)(wb_ + 64 * 72) = rb2; *(u32x4*)(wb_ + 96 * 72) = rb3; }
DEV void gemm_tile(const u16* __restrict__ A, int lda, const u16* __restrict__ B, int ldb, int K, char* smem, f32x16 (&acc)[2][2]) {
  int t = threadIdx.x, lane = t & 63, wave = t >> 6, r = lane & 31, h = lane >> 5;
  int wm = wave >> 1, wn = wave & 1;
  int lrow = t >> 3, lkc = (t & 7) * 8;
  const u16* ap = A + (size_t)lrow * lda + lkc;
  const u16* bp = B + (size_t)lrow * ldb + lkc;
  size_t sa32 = (size_t)32 * lda, sb32 = (size_t)32 * ldb;
  u32x4 ra0, ra1, ra2, ra3, rb0, rb1, rb2, rb3;
  u32x4 na0, na1, na2, na3, nb0, nb1, nb2, nb3;
  int nk = K >> 6;
#define GSTORE8N(BUF) { u16* wa_ = (u16*)(smem + (BUF) * 36864) + lrow * 72 + lkc; u16* wb_ = wa_ + 128 * 72; \
  *(u32x4*)(wa_) = na0; *(u32x4*)(wa_ + 32 * 72) = na1; *(u32x4*)(wa_ + 64 * 72) = na2; *(u32x4*)(wa_ + 96 * 72) = na3; \
  *(u32x4*)(wb_) = nb0; *(u32x4*)(wb_ + 32 * 72) = nb1; *(u32x4*)(wb_ + 64 * 72) = nb2; *(u32x4*)(wb_ + 96 * 72) = nb3; }
#define GCOMPUTE(BUF) { const u16* sA = (const u16*)(smem + (BUF) * 36864); const u16* sB = sA + 128 * 72; \
    _Pragma("unroll") for (int kk = 0; kk < 4; kk++) { \
      bf16x8 a0 = *(const bf16x8*)(sA + (wm * 64 + r) * 72 + kk * 16 + h * 8); \
      bf16x8 a1 = *(const bf16x8*)(sA + (wm * 64 + 32 + r) * 72 + kk * 16 + h * 8); \
      bf16x8 b0 = *(const bf16x8*)(sB + (wn * 64 + r) * 72 + kk * 16 + h * 8); \
      bf16x8 b1 = *(const bf16x8*)(sB + (wn * 64 + 32 + r) * 72 + kk * 16 + h * 8); \
      acc[0][0] = mfma32(a0, b0, acc[0][0]); acc[0][1] = mfma32(a0, b1, acc[0][1]); \
      acc[1][0] = mfma32(a1, b0, acc[1][0]); acc[1][1] = mfma32(a1, b1, acc[1][1]); } }
  GLOAD8(ap, bp)
  __syncthreads();
  GSTORE8(0)
  if (nk > 1) { GLOAD8(ap + 64, bp + 64) }
  na0 = ra0; na1 = ra1; na2 = ra2; na3 = ra3; nb0 = rb0; nb1 = rb1; nb2 = rb2; nb3 = rb3;
  __syncthreads();
  for (int kt = 0; kt < nk; kt += 2) {
    if (kt + 2 < nk) { GLOAD8N(ap + (kt + 2) * 64, bp + (kt + 2) * 64) }
    GCOMPUTE(0)
    if (kt + 1 < nk) { GSTORE8(1) }
    __syncthreads();
    if (kt + 1 < nk) {
      if (kt + 3 < nk) { GLOAD8(ap + (kt + 3) * 64, bp + (kt + 3) * 64) }
      GCOMPUTE(1)
      if (kt + 2 < nk) { GSTORE8N(0) }
      __syncthreads();
    }
  }
  __syncthreads();
  float* Cs = (float*)smem;
#pragma unroll
  for (int i = 0; i < 2; i++)
#pragma unroll
    for (int j = 0; j < 2; j++)
#pragma unroll
      for (int g = 0; g < 16; g++)
        Cs[(wm * 64 + i * 32 + (g & 3) + 8 * (g >> 2) + 4 * h) * 128 + wn * 64 + j * 32 + r] = acc[i][j][g];
  __syncthreads();
}

DEV bool xcd_tile(int li, int bid, int NTl, int& mt, int& nt) {
  if (li >= 8 * NTl) return false;
  mt = 8 * (bid & 7) + (li & 7); nt = li >> 3; return true;
}
template <class Epi>
DEV void gemm_phase(const u16* A, int lda, const u16* Bt, int ldb, int K, int MT, int NTl, int bid, int nb, char* smem, Epi epi) {
  if ((nb & 7) == 0 && MT == 64) {
    int mt, nt;
    for (int li = bid >> 3; xcd_tile(li, bid, NTl, mt, nt); li += nb >> 3) {
      f32x16 acc[2][2];
      zero16(acc[0][0]); zero16(acc[0][1]); zero16(acc[1][0]); zero16(acc[1][1]);
      gemm_tile(A + (size_t)mt * 128 * lda, lda, Bt + (size_t)nt * 128 * ldb, ldb, K, smem, acc);
      epi(mt * 128, nt * 128, (const float*)smem);
    }
  } else {
    for (int it = bid; it < MT * NTl; it += nb) {
      int mt = it / NTl, nt = it % NTl;
      f32x16 acc[2][2];
      zero16(acc[0][0]); zero16(acc[0][1]); zero16(acc[1][0]); zero16(acc[1][1]);
      gemm_tile(A + (size_t)mt * 128 * lda, lda, Bt + (size_t)nt * 128 * ldb, ldb, K, smem, acc);
      epi(mt * 128, nt * 128, (const float*)smem);
    }
  }
}

DEV void tok_decode(int T, bool& smp, int& b, int& tpos) {
  smp = T >= 4096;
  if (!smp) { b = T >> 8; tpos = T & 255; } else { b = (T - 4096) >> 10; tpos = (T - 4096) & 1023; }
}
DEV void rope_pair(const Params& p, float& x, float& y, int tpos, int d) {
  float px = __shfl_xor(x, 16), py = __shfl_xor(y, 16);
  int a = d & 31;
  float c0 = p.ROPEC()[tpos * 32 + a], c1 = p.ROPEC()[tpos * 32 + a + 1];
  float s0 = p.ROPES()[tpos * 32 + a], s1 = p.ROPES()[tpos * 32 + a + 1];
  if (d < 32) { x = x * c0 - px * s0; y = y * c1 - py * s1; }
  else        { x = px * s0 + x * c0; y = py * s1 + y * c1; }
}

DEV void rope_apply(float& x, float& y, float4 cs, int d) {
  float px = __shfl_xor(x, 16), py = __shfl_xor(y, 16);
  if (d < 32) { x = x * cs.x - px * cs.z; y = y * cs.y - py * cs.w; }
  else        { x = px * cs.z + x * cs.x; y = py * cs.w + y * cs.y; }
}
DEV float4 rope_cs(const Params& p, int tpos, int d) {
  int a = d & 31;
  float2 c = *(const float2*)(p.ROPEC() + tpos * 32 + a), s = *(const float2*)(p.ROPES() + tpos * 32 + a);
  return make_float4(c.x, c.y, s.x, s.y);
}
template <int SEG, bool SMP>
DEV void epi0_rows(const Params& p, int m0, int n0, const float* Cs) {
  int lane = threadIdx.x & 63, wave = threadIdx.x >> 6;
  int col = n0 + lane * 2; int d = col & 63;
  float g0 = 1.f, g1 = 1.f;
  if (SEG == 0) { g0 = p.a_q_norm[d]; g1 = p.a_q_norm[d + 1]; }
  if (SEG == 1) { g0 = p.a_k_norm[d]; g1 = p.a_k_norm[d + 1]; }
  int segbase = SEG == 0 ? 0 : SEG == 1 ? 512 : SEG == 2 ? 640 : SEG == 3 ? 768 : SEG == 4 ? 1280 : SEG == 5 ? 1792 : 2304;
  int hh = (col - segbase) >> 6;
#pragma unroll 4
  for (int i = 0; i < 32; i++) {
    int rr = wave + 4 * i;
    int T = m0 + rr;
    int b = SMP ? (T - 4096) >> 10 : T >> 8;
    int tpos = SMP ? (T - 4096) & 1023 : T & 255;
    float2 c = *(const float2*)(Cs + rr * 128 + lane * 2);
    if (SEG <= 1) {
      float4 cs = make_float4(1.f, 1.f, 0.f, 0.f);
      if (SMP) cs = rope_cs(p, tpos, d);
      float ss = half_sum32(c.x * c.x + c.y * c.y);
      float rstd = rsqrtf(ss * (1.f / 64.f) + 1e-6f);
      c.x *= rstd * g0; c.y *= rstd * g1;
      if (SMP) rope_apply(c.x, c.y, cs, d);
    }
    if (SEG == 0) *(unsigned*)(p.Q1() + (size_t)T * 512 + col) = pack2(c.x * 0.18033688011112042f, c.y * 0.18033688011112042f);
    if (SEG == 1) {
      *(unsigned*)(p.KA() + kvoff(SMP, b, hh, tpos, 2, 64, 1280, 256) + d) = pack2(c.x, c.y);
      if (!SMP) *(float2*)(p.out + OUT_AK + ((size_t)(b * 2 + hh) * 256 + tpos) * 64 + d) = c;
    }
    if (SEG == 2) {
      *(unsigned*)(p.VA() + kvoff(SMP, b, hh, tpos, 2, 64, 1280, 256) + d) = pack2(c.x, c.y);
      if (!SMP) *(float2*)(p.out + OUT_AV + ((size_t)(b * 2 + hh) * 256 + tpos) * 64 + d) = c;
    }
    if (SEG == 3) *(unsigned*)(p.Q2() + (size_t)T * 512 + (col - 768)) = pack2(c.x, c.y);
    if (SEG == 4) *(unsigned*)(p.RK() + kvoff(SMP, b, hh, tpos, 8, 64, 1024, 0) + d) = pack2(c.x * 0.125f, c.y * 0.125f);
    if (SEG == 5) *(unsigned*)(p.RV() + kvoff(SMP, b, hh, tpos, 8, 64, 1024, 0) + d) = pack2(c.x, c.y);
    if (SEG == 6) *(unsigned*)(p.SG() + (size_t)T * 512 + (col - 2304)) = pack2(silu_f(c.x), silu_f(c.y));
  }
}
template <bool SMP> DEV void epi0_disp(const Params& p, int m0, int n0, const float* Cs) {
  if (n0 < 512) epi0_rows<0, SMP>(p, m0, n0, Cs);
  else if (n0 < 640) epi0_rows<1, SMP>(p, m0, n0, Cs);
  else if (n0 < 768) epi0_rows<2, SMP>(p, m0, n0, Cs);
  else if (n0 < 1280) epi0_rows<3, SMP>(p, m0, n0, Cs);
  else if (n0 < 1792) epi0_rows<4, SMP>(p, m0, n0, Cs);
  else if (n0 < 2304) epi0_rows<5, SMP>(p, m0, n0, Cs);
  else epi0_rows<6, SMP>(p, m0, n0, Cs);
}
DEV void epi_inproj0(const Params& p, int m0, int n0, const float* Cs) {
  if (m0 >= 4096) epi0_disp<true>(p, m0, n0, Cs); else epi0_disp<false>(p, m0, n0, Cs);
}
template <int SEG, bool SMP>
DEV void epi1_rows(const Params& p, int m0, int n0, const float* Cs) {
  int lane = threadIdx.x & 63, wave = threadIdx.x >> 6;
  int col = n0 + lane * 2; int d = col & 63;
  int segbase = SEG == 0 ? 0 : SEG == 1 ? 512 : SEG == 2 ? 1024 : SEG == 3 ? 1536 : SEG == 4 ? 2048 : 2176;
  int hh = (SEG == 2) ? (col - segbase) >> 7 : (col - segbase) >> 6;
  int dd = (col - 1024) & 127;
  constexpr bool ROPE = SMP && (SEG == 0 || SEG == 1 || SEG == 3 || SEG == 4);
#pragma unroll 4
  for (int i = 0; i < 32; i++) {
    int rr = wave + 4 * i;
    int T = m0 + rr;
    int b = SMP ? (T - 4096) >> 10 : T >> 8;
    int tpos = SMP ? (T - 4096) & 1023 : T & 255;
    float2 c = *(const float2*)(Cs + rr * 128 + lane * 2);
    if (!SMP) {
      if (SEG == 1) *(float2*)(p.out + OUT_CK + ((size_t)(b * 8 + hh) * 256 + tpos) * 64 + d) = c;
      if (SEG == 2) *(float2*)(p.out + OUT_CV + ((size_t)(b * 4 + hh) * 256 + tpos) * 128 + dd) = c;
      if (SEG == 4) *(float2*)(p.out + OUT_DK + ((size_t)(b * 2 + hh) * 256 + tpos) * 64 + d) = c;
      if (SEG == 5) *(float2*)(p.out + OUT_DV + ((size_t)(b * 2 + hh) * 256 + tpos) * 64 + d) = c;
    }
    if (ROPE) { float4 cs = rope_cs(p, tpos, d); rope_apply(c.x, c.y, cs, d); }
    if (SEG == 0) *(unsigned*)(p.Q1() + (size_t)T * 512 + col) = pack2(c.x * 0.18033688011112042f, c.y * 0.18033688011112042f);
    if (SEG == 1) *(unsigned*)(p.KC() + kvoff(SMP, b, hh, tpos, 8, 64, 1280, 256) + d) = pack2(c.x, c.y);
    if (SEG == 2) *(unsigned*)(p.VC() + kvoff(SMP, b, hh, tpos, 4, 128, 1280, 256) + dd) = pack2(c.x, c.y);
    if (SEG == 3) *(unsigned*)(p.Q2() + (size_t)T * 512 + (col - 1536)) = pack2(c.x * 0.18033688011112042f, c.y * 0.18033688011112042f);
    if (SEG == 4) *(unsigned*)(p.KD() + kvoff(SMP, b, hh, tpos, 2, 64, 1280, 256) + d) = pack2(c.x, c.y);
    if (SEG == 5) *(unsigned*)(p.VD() + kvoff(SMP, b, hh, tpos, 2, 64, 1280, 256) + d) = pack2(c.x, c.y);
  }
}
template <bool SMP> DEV void epi1_disp(const Params& p, int m0, int n0, const float* Cs) {
  if (n0 < 512) epi1_rows<0, SMP>(p, m0, n0, Cs);
  else if (n0 < 1024) epi1_rows<1, SMP>(p, m0, n0, Cs);
  else if (n0 < 1536) epi1_rows<2, SMP>(p, m0, n0, Cs);
  else if (n0 < 2048) epi1_rows<3, SMP>(p, m0, n0, Cs);
  else if (n0 < 2176) epi1_rows<4, SMP>(p, m0, n0, Cs);
  else epi1_rows<5, SMP>(p, m0, n0, Cs);
}
DEV void epi_inproj1(const Params& p, int m0, int n0, const float* Cs) {
  if (m0 >= 4096) epi1_disp<true>(p, m0, n0, Cs); else epi1_disp<false>(p, m0, n0, Cs);
}
DEV void epi_outproj(const Params& p, int layer, int m0, int n0, const float* Cs) {
  int lane = threadIdx.x & 63, wave = threadIdx.x >> 6;
  int mb = m0 < 4096 ? 0 : 1 + ((m0 - 4096) >> 10);
  int col = n0 + lane * 2;
  float2 g = *(const float2*)(p.MOD() + (size_t)(layer * 5 + mb) * 6144 + 2048 + col);
  const float* xbase = (layer == 0) ? (m0 < 4096 ? p.xp + (size_t)m0 * 1024 : p.xs + (size_t)(m0 - 4096) * 1024) : p.X() + (size_t)m0 * 1024;
#pragma unroll 8
  for (int i = 0; i < 32; i++) {
    int rr = wave + 4 * i;
    float2 c = *(const float2*)(Cs + rr * 128 + lane * 2);
    float2 x = *(const float2*)(xbase + (size_t)rr * 1024 + col);
    x.x += g.x * c.x; x.y += g.y * c.y;
    *(float2*)(p.X() + (size_t)(m0 + rr) * 1024 + col) = x;
  }
}

constexpr int ATT_BUF = 37888;
struct TileRegs { u32x4 k0, k1, k2, k3, v0, v1, v2, v3; };
template <int DV, bool TWOK> DEV TileRegs tile_load(const u16* __restrict__ k, const u16* __restrict__ k2, const u16* __restrict__ v) {
  int t = threadIdx.x, lane = t & 63, wave = t >> 6;
  TileRegs R;
  u32x4 z = {0u, 0u, 0u, 0u};
  R.k0 = *(const u32x4*)(k + t * 8); R.k1 = *(const u32x4*)(k + (t + 256) * 8);
  if (TWOK) { R.k2 = *(const u32x4*)(k2 + t * 8); R.k3 = *(const u32x4*)(k2 + (t + 256) * 8); } else { R.k2 = z; R.k3 = z; }
  R.v0 = *(const u32x4*)(v + (size_t)lane * DV + wave * 8); R.v1 = *(const u32x4*)(v + (size_t)lane * DV + (wave + 4) * 8);
  if (DV == 128) { R.v2 = *(const u32x4*)(v + (size_t)lane * DV + (wave + 8) * 8); R.v3 = *(const u32x4*)(v + (size_t)lane * DV + (wave + 12) * 8); } else { R.v2 = z; R.v3 = z; }
  return R;
}
DEV void store8t(u16* d, u32x4 x) {
  d[0 * 76] = (u16)(x[0] & 0xffff); d[1 * 76] = (u16)(x[0] >> 16);
  d[2 * 76] = (u16)(x[1] & 0xffff); d[3 * 76] = (u16)(x[1] >> 16);
  d[4 * 76] = (u16)(x[2] & 0xffff); d[5 * 76] = (u16)(x[2] >> 16);
  d[6 * 76] = (u16)(x[3] & 0xffff); d[7 * 76] = (u16)(x[3] >> 16);
}
template <int DV, bool TWOK> DEV void tile_store(const TileRegs R, char* buf) {
  int t = threadIdx.x, lane = t & 63, wave = t >> 6;
  u16* sK = (u16*)buf; u16* sK2 = sK + 64 * 72; u16* sVT = sK + 2 * 64 * 72;
  int key = t >> 3, dc = t & 7;
  *(u32x4*)(sK + key * 72 + dc * 8) = R.k0; *(u32x4*)(sK + (key + 32) * 72 + dc * 8) = R.k1;
  if (TWOK) { *(u32x4*)(sK2 + key * 72 + dc * 8) = R.k2; *(u32x4*)(sK2 + (key + 32) * 72 + dc * 8) = R.k3; }
  store8t(sVT + (wave * 8) * 76 + lane, R.v0); store8t(sVT + ((wave + 4) * 8) * 76 + lane, R.v1);
  if (DV == 128) { store8t(sVT + ((wave + 8) * 8) * 76 + lane, R.v2); store8t(sVT + ((wave + 12) * 8) * 76 + lane, R.v3); }
}
DEV void load_ident_k(u16* sK) {
  int t = threadIdx.x;
#pragma unroll
  for (int i = 0; i < 2; i++) {
    int c = t + 256 * i; int key = c >> 3, dc = c & 7;
    unsigned w[4] = {0u, 0u, 0u, 0u};
    uint4 z = make_uint4(0u, 0u, 0u, 0u);
    if (dc == (key >> 3)) {
      int e = key & 7; unsigned one = (e & 1) ? 0x3F800000u : 0x00003F80u;
      if ((e >> 1) == 0) z.x = one; else if ((e >> 1) == 1) z.y = one; else if ((e >> 1) == 2) z.z = one; else z.w = one;
    }
    (void)w;
    *(uint4*)(sK + key * 72 + dc * 8) = z;
  }
}
DEV void load_state_v(const float* __restrict__ S0, u16* sVT) {
  int lane = threadIdx.x & 63, wave = threadIdx.x >> 6;
#pragma unroll
  for (int i = 0; i < 2; i++) {
    int dc = wave + 4 * i;
    float4 a = *(const float4*)(S0 + lane * 64 + dc * 8), b = *(const float4*)(S0 + lane * 64 + dc * 8 + 4);
    u16* d = sVT + (dc * 8) * 76 + lane;
    d[0 * 76] = f2bf(a.x); d[1 * 76] = f2bf(a.y); d[2 * 76] = f2bf(a.z); d[3 * 76] = f2bf(a.w);
    d[4 * 76] = f2bf(b.x); d[5 * 76] = f2bf(b.y); d[6 * 76] = f2bf(b.z); d[7 * 76] = f2bf(b.w);
  }
}
template <int DV, class F>
DEV void attn_compute(const bf16x8 (&qf)[4], f32x16 (&o)[DV / 32], const u16* sK, const u16* sVT, F&& xform) {
  int lane = threadIdx.x & 63, r = lane & 31, h = lane >> 5;
  f32x16 st[2]; zero16(st[0]); zero16(st[1]);
#pragma unroll
  for (int sub = 0; sub < 2; sub++)
#pragma unroll
    for (int kk = 0; kk < 4; kk++) {
      bf16x8 kf = *(const bf16x8*)(sK + (sub * 32 + r) * 72 + kk * 16 + h * 8);
      st[sub] = mfma32(kf, qf[kk], st[sub]);
    }
  xform(st);
  bf16x8 pf[2][2];
#pragma unroll
  for (int sub = 0; sub < 2; sub++)
#pragma unroll
    for (int s = 0; s < 2; s++) {
      u32x4 w;
      w[0] = pack2(st[sub][8 * s + 0], st[sub][8 * s + 1]); w[1] = pack2(st[sub][8 * s + 2], st[sub][8 * s + 3]);
      w[2] = pack2(st[sub][8 * s + 4], st[sub][8 * s + 5]); w[3] = pack2(st[sub][8 * s + 6], st[sub][8 * s + 7]);
      pf[sub][s] = __builtin_bit_cast(bf16x8, w);
    }
#pragma unroll
  for (int ds = 0; ds < DV / 32; ds++)
#pragma unroll
    for (int sub = 0; sub < 2; sub++)
#pragma unroll
      for (int s = 0; s < 2; s++) {
        const u16* vp = sVT + (ds * 32 + r) * 76 + sub * 32 + s * 16 + 4 * h;
        uint2 lo = *(const uint2*)vp, hi = *(const uint2*)(vp + 8);
        u32x4 w; w[0] = lo.x; w[1] = lo.y; w[2] = hi.x; w[3] = hi.y;
        o[ds] = mfma32(__builtin_bit_cast(bf16x8, w), pf[sub][s], o[ds]);
      }
}
template <int DV, class F>
DEV void attn_compute_sub(const bf16x8 (&qf)[4], f32x16 (&o)[DV / 32], const u16* sK, const u16* sVT, F&& xform) {
  int lane = threadIdx.x & 63, r = lane & 31, h = lane >> 5;
#pragma unroll
  for (int sub = 0; sub < 2; sub++) {
    f32x16 st; zero16(st);
#pragma unroll
    for (int kk = 0; kk < 4; kk++) {
      bf16x8 kf = *(const bf16x8*)(sK + (sub * 32 + r) * 72 + kk * 16 + h * 8);
      st = mfma32(kf, qf[kk], st);
    }
    xform(sub, st);
    bf16x8 pf[2];
#pragma unroll
    for (int s2 = 0; s2 < 2; s2++) {
      u32x4 w;
      w[0] = pack2(st[8 * s2 + 0], st[8 * s2 + 1]); w[1] = pack2(st[8 * s2 + 2], st[8 * s2 + 3]);
      w[2] = pack2(st[8 * s2 + 4], st[8 * s2 + 5]); w[3] = pack2(st[8 * s2 + 6], st[8 * s2 + 7]);
      pf[s2] = __builtin_bit_cast(bf16x8, w);
    }
#pragma unroll
    for (int ds = 0; ds < DV / 32; ds++)
#pragma unroll
      for (int s2 = 0; s2 < 2; s2++) {
        const u16* vp = sVT + (ds * 32 + r) * 76 + sub * 32 + s2 * 16 + 4 * h;
        uint2 lo = *(const uint2*)vp, hi = *(const uint2*)(vp + 8);
        u32x4 w; w[0] = lo.x; w[1] = lo.y; w[2] = hi.x; w[3] = hi.y;
        o[ds] = mfma32(__builtin_bit_cast(bf16x8, w), pf[s2], o[ds]);
      }
  }
}
template <int DV>
DEV void softmax_xform1(f32x16& st, f32x16 (&o)[DV / 32], float& m, float& l) {
  float mx = -1e30f;
#pragma unroll
  for (int g = 0; g < 16; g++) mx = fmaxf(mx, st[g]);
  mx = fmaxf(mx, __shfl_xor(mx, 32));
  float mnew = fmaxf(m, mx);
  float alpha = __builtin_amdgcn_exp2f(m - mnew);
  m = mnew;
  float ls = 0.f;
#pragma unroll
  for (int g = 0; g < 16; g++) { float pv = __builtin_amdgcn_exp2f(st[g] - mnew); st[g] = pv; ls += pv; }
  l = l * alpha + ls;
#pragma unroll
  for (int ds = 0; ds < DV / 32; ds++)
#pragma unroll
    for (int g = 0; g < 16; g++) o[ds][g] *= alpha;
}
template <int DV, bool TWOK, class PF, class XF, class XF1>
DEV void attn_loop(int n, PF&& ptrs, const bf16x8 (&qf)[4], f32x16 (&o)[DV / 32], char* smem, XF&& xf, XF1&& xf1) {
  int wave = threadIdx.x >> 6;
  int kofs = (TWOK && wave >= 2) ? 64 * 72 : 0;
  TileRegs R;
  const u16 *kp, *kp2, *vp;
  ptrs(0, kp, kp2, vp); R = tile_load<DV, TWOK>(kp, kp2, vp);
  __syncthreads();
  tile_store<DV, TWOK>(R, smem);
  if (n > 1) { ptrs(1, kp, kp2, vp); R = tile_load<DV, TWOK>(kp, kp2, vp); }
  __syncthreads();
  const u16* b0k = (const u16*)smem + kofs; const u16* b0v = (const u16*)smem + 2 * 64 * 72;
  const u16* b1k = (const u16*)(smem + ATT_BUF) + kofs; const u16* b1v = (const u16*)(smem + ATT_BUF) + 2 * 64 * 72;
  for (int ti = 0; ti < n; ti++) {
    const u16* bk = (ti & 1) ? b1k : b0k; const u16* bv = (ti & 1) ? b1v : b0v;
    if constexpr (DV == 128) attn_compute_sub<DV>(qf, o, bk, bv, [&](int sub, f32x16& st) { xf1(ti, sub, st); });
    else attn_compute<DV>(qf, o, bk, bv, [&](f32x16 (&st)[2]) { xf(ti, st); });
    if (ti + 1 < n) tile_store<DV, TWOK>(R, smem + ((ti + 1) & 1) * ATT_BUF);
    if (ti + 2 < n) { ptrs(ti + 2, kp, kp2, vp); R = tile_load<DV, TWOK>(kp, kp2, vp); }
    __syncthreads();
  }
}
template <int DV>
DEV void softmax_xform(f32x16 (&st)[2], f32x16 (&o)[DV / 32], float& m, float& l, bool masked, int kpos0, int qpos) {
  int h = (threadIdx.x & 63) >> 5;
  float mx = -1e30f;
#pragma unroll
  for (int sub = 0; sub < 2; sub++)
#pragma unroll
    for (int g = 0; g < 16; g++) {
      float s = st[sub][g];
      if (masked) {
        int j = kpos0 + sub * 32 + (g & 3) + 8 * (g >> 2) + 4 * h;
        int dl = qpos - j; if (dl < 0) dl = -dl;
        if (dl > 128) s = -1e30f;
        st[sub][g] = s;
      }
      mx = fmaxf(mx, s);
    }
  mx = fmaxf(mx, __shfl_xor(mx, 32));
  float mnew = fmaxf(m, mx);
  float alpha = __builtin_amdgcn_exp2f(m - mnew);
  m = mnew;
  float ls = 0.f;
#pragma unroll
  for (int sub = 0; sub < 2; sub++)
#pragma unroll
    for (int g = 0; g < 16; g++) { float pv = __builtin_amdgcn_exp2f(st[sub][g] - mnew); st[sub][g] = pv; ls += pv; }
  l = l * alpha + ls;
#pragma unroll
  for (int ds = 0; ds < DV / 32; ds++)
#pragma unroll
    for (int g = 0; g < 16; g++) o[ds][g] *= alpha;
}

template <int DV, bool TWOK>
DEV void attn_softmax_job(const Params& p, const u16* Q, int Tq0, int qcol, const u16* kb, const u16* kb2, const u16* vb,
                          int nplain, int band_lo, int band_hi, int qpos0, bool use_sink, float sinkv,
                          f32x16 (&o)[DV / 32], char* smem) {
  int lane = threadIdx.x & 63, wave = threadIdx.x >> 6, r = lane & 31, h = lane >> 5;
  int qrow = TWOK ? (wave & 1) * 32 : wave * 32;
  bf16x8 qf[4];
#pragma unroll
  for (int kk = 0; kk < 4; kk++) qf[kk] = *(const bf16x8*)(Q + (size_t)(Tq0 + qrow + r) * 512 + qcol + kk * 16 + h * 8);
#pragma unroll
  for (int ds = 0; ds < DV / 32; ds++) zero16(o[ds]);
  float m = use_sink ? sinkv : -1e30f;
  float l = (use_sink && h == 0) ? 1.f : 0.f;
  int qpos = qpos0 + qrow + r;
  int ntot = nplain + (band_hi - band_lo);
  attn_loop<DV, TWOK>(ntot,
    [&](int ti, const u16*& kp, const u16*& kp2, const u16*& vp) {
      int key0 = (ti >= nplain) ? (256 + (band_lo + ti - nplain) * 64) : ti * 64;
      kp = kb + (size_t)key0 * 64; kp2 = kb2 + (size_t)key0 * 64; vp = vb + (size_t)key0 * DV;
    }, qf, o, smem,
    [&](int ti, f32x16 (&st)[2]) {
      bool masked = ti >= nplain;
      int kpos0 = (band_lo + ti - nplain) * 64;
      softmax_xform<DV>(st, o, m, l, masked, kpos0, qpos);
    },
    [&](int ti, int sub, f32x16& st) { softmax_xform1<DV>(st, o, m, l); });
  float lt = l + __shfl_xor(l, 32);
  float inv = 1.f / lt;
#pragma unroll
  for (int ds = 0; ds < DV / 32; ds++)
#pragma unroll
    for (int g = 0; g < 16; g++) o[ds][g] *= inv;
}
DEV void store_o64(const Params& p, const f32x16 (&o)[2], int Tq0, int mixcol) {
  int lane = threadIdx.x & 63, wave = threadIdx.x >> 6, r = lane & 31, h = lane >> 5;
  int T = Tq0 + wave * 32 + r;
#pragma unroll
  for (int ds = 0; ds < 2; ds++)
#pragma unroll
    for (int g4 = 0; g4 < 4; g4++) {
      int d0 = ds * 32 + 8 * g4 + 4 * h;
      *(uint2*)(p.MIX() + (size_t)T * 1024 + mixcol + d0) =
          make_uint2(pack2(o[ds][4 * g4], o[ds][4 * g4 + 1]), pack2(o[ds][4 * g4 + 2], o[ds][4 * g4 + 3]));
    }
}

DEV void ret_job(const Params& p, bool smp, int b, int hh, int qb, char* smem) {
  u16* sK = (u16*)smem; u16* sVT = sK + 2 * 64 * 72;
  int lane = threadIdx.x & 63, wave = threadIdx.x >> 6, r = lane & 31, h = lane >> 5;
  int L = smp ? 1024 : 256;
  int Tq0 = (smp ? 4096 + b * 1024 : b * 256) + qb * 128;
  const u16* kb = p.RK() + kvoff(smp, b, hh, 0, 8, 64, 1024, 0);
  const u16* vb = p.RV() + kvoff(smp, b, hh, 0, 8, 64, 1024, 0);
  float xf = p.rdf[hh], xb = p.rdb[hh];
  float lf2 = -log1pf(__expf(-xf)) * 1.4426950408889634f;
  float lb2 = -log1pf(__expf(-xb)) * 1.4426950408889634f;
  bf16x8 qf[4];
#pragma unroll
  for (int kk = 0; kk < 4; kk++) qf[kk] = *(const bf16x8*)(p.Q2() + (size_t)(Tq0 + wave * 32 + r) * 512 + hh * 64 + kk * 16 + h * 8);
  f32x16 o[2]; zero16(o[0]); zero16(o[1]);
  int qpos = qb * 128 + wave * 32 + r;
  int nt = L / 64;
  attn_loop<64, false>(nt,
    [&](int ti, const u16*& kp, const u16*& kp2, const u16*& vp) { kp = kb + (size_t)ti * 4096; kp2 = kp; vp = vb + (size_t)ti * 4096; },
    qf, o, smem,
    [&](int ti, f32x16 (&st)[2]) {
      int kpos0 = ti * 64;
#pragma unroll
      for (int sub = 0; sub < 2; sub++)
#pragma unroll
        for (int g = 0; g < 16; g++) {
          int j = kpos0 + sub * 32 + (g & 3) + 8 * (g >> 2) + 4 * h;
          int dl = qpos - j;
          float e = dl >= 0 ? lf2 * (float)dl : lb2 * (float)(-dl);
          st[sub][g] *= __builtin_amdgcn_exp2f(e);
        }
    },
    [&](int ti, int sub, f32x16& st) {});
  if (smp) {
    for (int dir = 0; dir < 2; dir++) {
      const float* S0 = (dir == 0 ? p.srf : p.srb) + (size_t)(b * 8 + hh) * 4096;
      float rs = dir == 0 ? exp2f(lf2 * (float)(qpos + 1)) : exp2f(lb2 * (float)(L - qpos));
      __syncthreads();
      load_ident_k(sK);
      load_state_v(S0, sVT);
      __syncthreads();
      attn_compute<64>(qf, o, sK, sVT, [&](f32x16 (&st)[2]) {
#pragma unroll
        for (int sub = 0; sub < 2; sub++)
#pragma unroll
          for (int g = 0; g < 16; g++) st[sub][g] *= rs;
      });
    }
  }
  float sum = 0.f;
#pragma unroll
  for (int ds = 0; ds < 2; ds++)
#pragma unroll
    for (int g = 0; g < 16; g++) sum += o[ds][g];
  sum += __shfl_xor(sum, 32);
  float mean = sum * (1.f / 64.f);
  float vs = 0.f;
#pragma unroll
  for (int ds = 0; ds < 2; ds++)
#pragma unroll
    for (int g = 0; g < 16; g++) { float dlt = o[ds][g] - mean; vs += dlt * dlt; }
  vs += __shfl_xor(vs, 32);
  float rstd = rsqrtf(vs * (1.f / 64.f) + 1e-6f);
  int T = Tq0 + wave * 32 + r;
#pragma unroll
  for (int ds = 0; ds < 2; ds++)
#pragma unroll
    for (int g4 = 0; g4 < 4; g4++) {
      int d0 = ds * 32 + 8 * g4 + 4 * h;
      uint2 gt = *(const uint2*)(p.SG() + (size_t)T * 512 + hh * 64 + d0);
      float y0 = (o[ds][4 * g4] - mean) * rstd * bflo(gt.x), y1 = (o[ds][4 * g4 + 1] - mean) * rstd * bfhi(gt.x);
      float y2 = (o[ds][4 * g4 + 2] - mean) * rstd * bflo(gt.y), y3 = (o[ds][4 * g4 + 3] - mean) * rstd * bfhi(gt.y);
      *(uint2*)(p.MIX() + (size_t)T * 1024 + 512 + hh * 64 + d0) = make_uint2(pack2(y0, y1), pack2(y2, y3));
    }
}
DEV void ret_state_job(const Params& p, int b, int hh, int dir, char* smem) {
  u16* sKk = (u16*)smem; u16* sVv = sKk + 64 * 64;
  int t = threadIdx.x;
  const u16* kb = p.RK() + kvoff(false, b, hh, 0, 8, 64, 1024, 0);
  const u16* vb = p.RV() + kvoff(false, b, hh, 0, 8, 64, 1024, 0);
  float xx = dir == 0 ? p.rdf[hh] : p.rdb[hh];
  float lg2 = -log1pf(__expf(-xx)) * 1.4426950408889634f;
  int dk = t >> 2, dvc = (t & 3) * 16;
  float acc[16];
#pragma unroll
  for (int i = 0; i < 16; i++) acc[i] = 0.f;
  for (int ch = 0; ch < 4; ch++) {
    __syncthreads();
#pragma unroll
    for (int i = 0; i < 2; i++) {
      int c = t + 256 * i;
      *(uint4*)(sKk + c * 8) = *(const uint4*)(kb + (size_t)ch * 4096 + c * 8);
      *(uint4*)(sVv + c * 8) = *(const uint4*)(vb + (size_t)ch * 4096 + c * 8);
    }
    __syncthreads();
    for (int jj = 0; jj < 64; jj++) {
      int j = ch * 64 + jj;
      float w = exp2f(lg2 * (float)(dir == 0 ? 255 - j : j));
      float kv = bf2f(sKk[jj * 64 + dk]) * w;
      const uint4* vp = (const uint4*)(sVv + jj * 64 + dvc);
      uint4 v0 = vp[0], v1 = vp[1];
      acc[0] += kv * bflo(v0.x); acc[1] += kv * bfhi(v0.x); acc[2] += kv * bflo(v0.y); acc[3] += kv * bfhi(v0.y);
      acc[4] += kv * bflo(v0.z); acc[5] += kv * bfhi(v0.z); acc[6] += kv * bflo(v0.w); acc[7] += kv * bfhi(v0.w);
      acc[8] += kv * bflo(v1.x); acc[9] += kv * bfhi(v1.x); acc[10] += kv * bflo(v1.y); acc[11] += kv * bfhi(v1.y);
      acc[12] += kv * bflo(v1.z); acc[13] += kv * bfhi(v1.z); acc[14] += kv * bflo(v1.w); acc[15] += kv * bfhi(v1.w);
    }
  }
  float* dst = p.out + (dir == 0 ? OUT_RF : OUT_RB) + ((size_t)(b * 8 + hh) * 64 + dk) * 64 + dvc;
#pragma unroll
  for (int i = 0; i < 4; i++) *(float4*)(dst + 4 * i) = make_float4(acc[4 * i], acc[4 * i + 1], acc[4 * i + 2], acc[4 * i + 3]);
}

DEV void phase_attn0(const Params& p, int bid, int nb, char* smem) {
  for (int it = bid; it < 1280 + 2048; it += nb) {
    if (it >= 1280) {
      int j = it - 1280;
      if (j < 1024) prep_quant<true>(p.peer_u, p.U8(), p.SU(), j * 16); else prep_quant<false>(p.peer_v, p.V8(), p.SV(), (j - 1024) * 16);
    } else if (it < 256) {
      int b = it >> 6, hq = (it >> 3) & 7, qb = it & 7; int kvh = hq >> 2;
      f32x16 o[2];
      int Tq0 = 4096 + b * 1024 + qb * 128;
      attn_softmax_job<64, false>(p, p.Q1(), Tq0, hq * 64, p.KA() + kvoff(true, b, kvh, -256, 2, 64, 1280, 256), p.KA(), p.VA() + kvoff(true, b, kvh, -256, 2, 64, 1280, 256),
                           20, 0, 0, qb * 128, false, 0.f, o, smem);
      store_o64(p, o, Tq0, hq * 64);
    } else if (it < 512) {
      int j = it - 256; int b = j >> 6, hh = (j >> 3) & 7, qb = j & 7;
      ret_job(p, true, b, hh, qb, smem);
    } else if (it < 768) {
      int j = it - 512; int b = j >> 4, hq = (j >> 1) & 7, qb = j & 1; int kvh = hq >> 2;
      f32x16 o[2];
      int Tq0 = b * 256 + qb * 128;
      attn_softmax_job<64, false>(p, p.Q1(), Tq0, hq * 64, p.KA() + kvoff(false, b, kvh, 0, 2, 64, 1280, 256), p.KA(), p.VA() + kvoff(false, b, kvh, 0, 2, 64, 1280, 256),
                           4, 0, 0, qb * 128, false, 0.f, o, smem);
      store_o64(p, o, Tq0, hq * 64);
    } else if (it < 1024) {
      int j = it - 768; int b = j >> 4, hh = (j >> 1) & 7, qb = j & 1;
      ret_job(p, false, b, hh, qb, smem);
    } else {
      int j = it - 1024; int b = j >> 4, hh = (j >> 1) & 7, dir = j & 1;
      ret_state_job(p, b, hh, dir, smem);
    }
  }
}
DEV void diff_job(const Params& p, bool smp, int b, int hh, int qb, float lam, char* smem) {
  int lane = threadIdx.x & 63, wave = threadIdx.x >> 6, r = lane & 31, h = lane >> 5;
  int c = wave >> 1;
  int Tq0 = (smp ? 4096 + b * 1024 : b * 256) + qb * 64;
  int nt = smp ? 20 : 4;
  const u16* vb = p.VC() + kvoff(smp, b, hh, smp ? -256 : 0, 4, 128, 1280, 256);
  const u16* kb0 = p.KC() + kvoff(smp, b, 2 * hh, smp ? -256 : 0, 8, 64, 1280, 256);
  const u16* kb1 = p.KC() + kvoff(smp, b, 2 * hh + 1, smp ? -256 : 0, 8, 64, 1280, 256);
  f32x16 o[4];
  attn_softmax_job<128, true>(p, p.Q1(), Tq0, (2 * hh + c) * 64, kb0, kb1, vb, nt, 0, 0, 0, false, 0.f, o, smem);
  float* ex = (float*)smem;
  if (wave >= 2) {
#pragma unroll
    for (int ds = 0; ds < 4; ds++)
#pragma unroll
      for (int g = 0; g < 16; g++) ex[(ds * 16 + g) * 128 + (threadIdx.x - 128)] = o[ds][g];
  }
  __syncthreads();
  if (wave < 2) {
    float ss = 0.f;
#pragma unroll
    for (int ds = 0; ds < 4; ds++)
#pragma unroll
      for (int g = 0; g < 16; g++) { float dv = o[ds][g] - lam * ex[(ds * 16 + g) * 128 + threadIdx.x]; o[ds][g] = dv; ss += dv * dv; }
    ss += __shfl_xor(ss, 32);
    float rstd = rsqrtf(ss * (1.f / 128.f) + 1e-6f) * (1.f - LAM_INIT);
    int T = Tq0 + wave * 32 + r;
#pragma unroll
    for (int ds = 0; ds < 4; ds++)
#pragma unroll
      for (int g4 = 0; g4 < 4; g4++) {
        int d0 = ds * 32 + 8 * g4 + 4 * h;
        float4 sg = *(const float4*)(p.subln + d0);
        *(uint2*)(p.MIX() + (size_t)T * 1024 + hh * 128 + d0) =
            make_uint2(pack2(o[ds][4 * g4] * rstd * sg.x, o[ds][4 * g4 + 1] * rstd * sg.y),
                       pack2(o[ds][4 * g4 + 2] * rstd * sg.z, o[ds][4 * g4 + 3] * rstd * sg.w));
      }
  }
}
DEV void phase_attn1(const Params& p, int bid, int nb, char* smem) {
  float d1 = 0.f, d2 = 0.f;
  for (int i = 0; i < 64; i++) { d1 += p.lq1[i] * p.lk1[i]; d2 += p.lq2[i] * p.lk2[i]; }
  float lam = __expf(d1) - __expf(d2) + LAM_INIT;
  for (int it = bid; it < 1024; it += nb) {
    if (it < 256) {
      int b = it >> 6, hh = (it >> 4) & 3, qb = it & 15;
      diff_job(p, true, b, hh, qb, lam, smem);
    } else if (it < 512) {
      int j = it - 256; int b = j >> 6, hq = (j >> 3) & 7, qb = j & 7; int kvh = hq >> 2;
      int q0 = qb * 128;
      int lo = (q0 - 128 < 0 ? 0 : q0 - 128) >> 6, hi = (q0 + 256 > 1024 ? 1024 : q0 + 256) >> 6;
      f32x16 o[2];
      int Tq0 = 4096 + b * 1024 + q0;
      attn_softmax_job<64, false>(p, p.Q2(), Tq0, hq * 64, p.KD() + kvoff(true, b, kvh, -256, 2, 64, 1280, 256), p.KD(), p.VD() + kvoff(true, b, kvh, -256, 2, 64, 1280, 256),
                           4, lo, hi, q0, true, p.dsink[hq] * 1.4426950408889634f, o, smem);
      store_o64(p, o, Tq0, 512 + hq * 64);
    } else if (it < 768) {
      int j = it - 512; int b = j >> 4, hh = (j >> 2) & 3, qb = j & 3;
      diff_job(p, false, b, hh, qb, lam, smem);
    } else {
      int j = it - 768; int b = j >> 4, hq = (j >> 1) & 7, qb = j & 1; int kvh = hq >> 2;
      f32x16 o[2];
      int Tq0 = b * 256 + qb * 128;
      attn_softmax_job<64, false>(p, p.Q2(), Tq0, hq * 64, p.KD() + kvoff(false, b, kvh, 0, 2, 64, 1280, 256), p.KD(), p.VD() + kvoff(false, b, kvh, 0, 2, 64, 1280, 256),
                           4, 0, 0, qb * 128, true, p.dsink[hq] * 1.4426950408889634f, o, smem);
      store_o64(p, o, Tq0, 512 + hq * 64);
    }
  }
}

DEV float ub0(unsigned w) { return (float)(w & 255u); }
DEV float ub1(unsigned w) { return (float)((w >> 8) & 255u); }
DEV float ub2(unsigned w) { return (float)((w >> 16) & 255u); }
DEV float ub3(unsigned w) { return (float)(w >> 24); }
DEV void phase_peer(const Params& p, int layer, int bid, int nb, char* smem) {
  int wave = threadIdx.x >> 6, lane = threadIdx.x & 63;
  float* ws1 = (float*)(smem + wave * 2048); float* ws2 = ws1 + 16;
  int* wi1 = (int*)(ws2 + 16); int* wi2 = wi1 + 16; float* es = (float*)(wi2 + 16); int* eidx = (int*)(es + 16); float* eg = (float*)(eidx + 128);
  const unsigned char* U = p.U8() + (size_t)layer * 16384 * 1024;
  const unsigned char* V = p.V8() + (size_t)layer * 16384 * 1024;
  const float* SU = p.SU() + layer * 16384; const float* SV = p.SV() + layer * 16384;
  const float* gain = p.norm_ffn + layer * 1024;
  for (int T = bid * 4 + wave; T < 8192; T += nb * 4) {
    const float* sc = p.SC() + (size_t)T * 2048;
    for (int hh = 0; hh < 8; hh++) {
      const float* s = sc + hh * 256;
      float a0 = s[lane], a1 = s[lane + 64], b0 = s[128 + lane], b1 = s[192 + lane];
      unsigned ka0 = (fkey(a0) & ~127u) | (unsigned)(127 - lane), ka1 = (fkey(a1) & ~127u) | (unsigned)(63 - lane);
      unsigned kb0 = (fkey(b0) & ~127u) | (unsigned)(127 - lane), kb1 = (fkey(b1) & ~127u) | (unsigned)(63 - lane);
      unsigned pa = 0u, pb = 0u;
      for (int bit = 31; bit >= 0; --bit) {
        unsigned ta = pa | (1u << bit), tb = pb | (1u << bit);
        int ca = __popcll(__ballot(ka0 >= ta)) + __popcll(__ballot(ka1 >= ta));
        int cb = __popcll(__ballot(kb0 >= tb)) + __popcll(__ballot(kb1 >= tb));
        if (ca >= 16) pa = ta;
        if (cb >= 16) pb = tb;
      }
      {
        unsigned long long m0 = __ballot(ka0 >= pa), m1 = __ballot(ka1 >= pa);
        int p0 = mbcnt64(m0), p1 = __popcll(m0) + mbcnt64(m1);
        if (ka0 >= pa) { ws1[p0 & 15] = a0; wi1[p0 & 15] = lane; }
        if (ka1 >= pa) { ws1[p1 & 15] = a1; wi1[p1 & 15] = lane + 64; }
        unsigned long long n0 = __ballot(kb0 >= pb), n1 = __ballot(kb1 >= pb);
        int q0 = mbcnt64(n0), q1 = __popcll(n0) + mbcnt64(n1);
        if (kb0 >= pb) { ws2[q0 & 15] = b0; wi2[q0 & 15] = lane; }
        if (kb1 >= pb) { ws2[q1 & 15] = b1; wi2[q1 & 15] = lane + 64; }
      }
      __builtin_amdgcn_fence(__ATOMIC_ACQ_REL, "wavefront");
      __builtin_amdgcn_wave_barrier();
      int bq = lane & 15, aq = lane >> 4;
      float s2v = ws2[bq];
      float c0 = ws1[aq] + s2v, c1 = ws1[aq + 4] + s2v, c2 = ws1[aq + 8] + s2v, c3 = ws1[aq + 12] + s2v;
      unsigned k0 = (fkey(c0) & ~255u) | (unsigned)(255 - lane), k1 = (fkey(c1) & ~255u) | (unsigned)(191 - lane);
      unsigned k2 = (fkey(c2) & ~255u) | (unsigned)(127 - lane), k3 = (fkey(c3) & ~255u) | (unsigned)(63 - lane);
      unsigned pc = 0u;
      for (int bit = 31; bit >= 0; --bit) {
        unsigned tc = pc | (1u << bit);
        int cc = __popcll(__ballot(k0 >= tc)) + __popcll(__ballot(k1 >= tc)) + __popcll(__ballot(k2 >= tc)) + __popcll(__ballot(k3 >= tc));
        if (cc >= 16) pc = tc;
      }
      {
        unsigned long long m0 = __ballot(k0 >= pc), m1 = __ballot(k1 >= pc), m2 = __ballot(k2 >= pc), m3 = __ballot(k3 >= pc);
        int n0 = __popcll(m0), n1 = n0 + __popcll(m1), n2 = n1 + __popcll(m2);
        int i2b = wi2[bq];
        if (k0 >= pc) { int q = mbcnt64(m0) & 15; es[q] = c0; eidx[hh * 16 + q] = wi1[aq] * 128 + i2b; }
        if (k1 >= pc) { int q = (n0 + mbcnt64(m1)) & 15; es[q] = c1; eidx[hh * 16 + q] = wi1[aq + 4] * 128 + i2b; }
        if (k2 >= pc) { int q = (n1 + mbcnt64(m2)) & 15; es[q] = c2; eidx[hh * 16 + q] = wi1[aq + 8] * 128 + i2b; }
        if (k3 >= pc) { int q = (n2 + mbcnt64(m3)) & 15; es[q] = c3; eidx[hh * 16 + q] = wi1[aq + 12] * 128 + i2b; }
      }
      __builtin_amdgcn_fence(__ATOMIC_ACQ_REL, "wavefront");
      __builtin_amdgcn_wave_barrier();
      float ts = es[lane & 15];
      float mx = row_max16(ts);
      float pe = __expf(ts - mx);
      float sm = row_sum16(pe);
      if (lane < 16) eg[hh * 16 + lane] = pe / sm;
      __builtin_amdgcn_fence(__ATOMIC_ACQ_REL, "wavefront");
      __builtin_amdgcn_wave_barrier();
    }
    int mb = T < 4096 ? 0 : 1 + ((T - 4096) >> 10);
    const float* md = p.MOD() + (size_t)(layer * 5 + mb) * 6144;
    float4 xv[4]; float ssx = 0.f;
#pragma unroll
    for (int i = 0; i < 4; i++) { xv[i] = *(const float4*)(p.X() + (size_t)T * 1024 + (i * 64 + lane) * 4); ssx += xv[i].x * xv[i].x + xv[i].y * xv[i].y + xv[i].z * xv[i].z + xv[i].w * xv[i].w; }
    ssx = wave_sum(ssx);
    float rstdx = rsqrtf(ssx * (1.f / 1024.f) + 1e-6f);
    float4 hv[4]; float hmax = 0.f;
#pragma unroll
    for (int i = 0; i < 4; i++) {
      int col = (i * 64 + lane) * 4;
      float4 g = *(const float4*)(gain + col), sh = *(const float4*)(md + 3 * 1024 + col), scl = *(const float4*)(md + 4 * 1024 + col);
      hv[i].x = xv[i].x * rstdx * g.x * (1.f + scl.x) + sh.x; hv[i].y = xv[i].y * rstdx * g.y * (1.f + scl.y) + sh.y;
      hv[i].z = xv[i].z * rstdx * g.z * (1.f + scl.z) + sh.z; hv[i].w = xv[i].w * rstdx * g.w * (1.f + scl.w) + sh.w;
      hmax = fmaxf(hmax, fmaxf(fmaxf(fabsf(hv[i].x), fabsf(hv[i].y)), fmaxf(fabsf(hv[i].z), fabsf(hv[i].w))));
    }
    hmax = wave_max_f(hmax);
    float hinv = hmax > 0.f ? 127.f / hmax : 0.f, hscale = hmax * (1.f / 127.f);
    int hq[4];
#pragma unroll
    for (int i = 0; i < 4; i++) {
      unsigned b0 = (unsigned)((int)rintf(hv[i].x * hinv)) & 255u, b1 = (unsigned)((int)rintf(hv[i].y * hinv)) & 255u;
      unsigned b2 = (unsigned)((int)rintf(hv[i].z * hinv)) & 255u, b3 = (unsigned)((int)rintf(hv[i].w * hinv)) & 255u;
      hq[i] = (int)(b0 | (b1 << 8) | (b2 << 16) | (b3 << 24));
    }
#define PLOAD8(SET, TBL, B0) _Pragma("unroll") for (int j = 0; j < 8; j++) { \
        int e_ = __builtin_amdgcn_readfirstlane(eidx[(B0) * 8 + j]); SET[j] = *(const u32x4*)(TBL + (size_t)e_ * 1024 + lane * 16); }
#define PDOT8(SET, B0) _Pragma("unroll") for (int j = 0; j < 8; j++) { \
        int d_ = __builtin_amdgcn_sdot4(hq[0], (int)SET[j][0], 0, false); d_ = __builtin_amdgcn_sdot4(hq[1], (int)SET[j][1], d_, false); \
        d_ = __builtin_amdgcn_sdot4(hq[2], (int)SET[j][2], d_, false); d_ = __builtin_amdgcn_sdot4(hq[3], (int)SET[j][3], d_, false); \
        float D_ = (float)wave_sum_i(d_); int e_ = (B0) * 8 + j; bool me_ = lane == (e_ & 63); \
        a0 = (me_ && e_ < 64) ? D_ : a0; a1 = (me_ && e_ >= 64) ? D_ : a1; }
#define PACC8(SET, B0) _Pragma("unroll") for (int j = 0; j < 8; j++) { \
        int e_ = (B0) * 8 + j; float w = rlane(e_ < 64 ? w0 : w1, e_ & 63); \
        acc[0] += w * ub0(SET[j][0]); acc[1] += w * ub1(SET[j][0]); acc[2] += w * ub2(SET[j][0]); acc[3] += w * ub3(SET[j][0]); \
        acc[4] += w * ub0(SET[j][1]); acc[5] += w * ub1(SET[j][1]); acc[6] += w * ub2(SET[j][1]); acc[7] += w * ub3(SET[j][1]); \
        acc[8] += w * ub0(SET[j][2]); acc[9] += w * ub1(SET[j][2]); acc[10] += w * ub2(SET[j][2]); acc[11] += w * ub3(SET[j][2]); \
        acc[12] += w * ub0(SET[j][3]); acc[13] += w * ub1(SET[j][3]); acc[14] += w * ub2(SET[j][3]); acc[15] += w * ub3(SET[j][3]); }
    float acc[16];
#pragma unroll
    for (int i = 0; i < 16; i++) acc[i] = 0.f;
    float a0 = 0.f, a1 = 0.f;
    u32x4 sa[8], sb[8];
    PLOAD8(sa, U, 0)
#pragma unroll 1
    for (int bi = 0; bi < 16; bi += 2) {
      PLOAD8(sb, U, bi + 1)
      PDOT8(sa, bi)
      if (bi + 2 < 16) { PLOAD8(sa, U, bi + 2) } else { PLOAD8(sa, V, 0) }
      PDOT8(sb, bi + 1)
    }
    int e0 = eidx[lane], e1 = eidx[lane + 64];
    float w0 = eg[lane] * gelu_tanh(a0 * (SU[e0] * hscale)) * SV[e0];
    float w1 = eg[lane + 64] * gelu_tanh(a1 * (SU[e1] * hscale)) * SV[e1];
    float wsum = wave_sum(w0 + w1);
#pragma unroll 1
    for (int bi = 0; bi < 16; bi += 2) {
      PLOAD8(sb, V, bi + 1)
      PACC8(sa, bi)
      if (bi + 2 < 16) { PLOAD8(sa, V, bi + 2) }
      PACC8(sb, bi + 1)
    }
    float x2[16]; float ss = 0.f;
#pragma unroll
    for (int i = 0; i < 4; i++) {
      int col = (i * 64 + lane) * 4;
      float4 ga = *(const float4*)(md + 5 * 1024 + col);
      x2[i * 4 + 0] = xv[i].x + ga.x * (acc[i * 4 + 0] - 128.f * wsum); x2[i * 4 + 1] = xv[i].y + ga.y * (acc[i * 4 + 1] - 128.f * wsum);
      x2[i * 4 + 2] = xv[i].z + ga.z * (acc[i * 4 + 2] - 128.f * wsum); x2[i * 4 + 3] = xv[i].w + ga.w * (acc[i * 4 + 3] - 128.f * wsum);
    }
#pragma unroll
    for (int i = 0; i < 16; i++) ss += x2[i] * x2[i];
    ss = wave_sum(ss);
    float rstd = rsqrtf(ss * (1.f / 1024.f) + 1e-6f);
    if (layer == 0) {
      const float* md1 = p.MOD() + (size_t)(5 + mb) * 6144;
#pragma unroll
      for (int i = 0; i < 4; i++) {
        int col = (i * 64 + lane) * 4;
        *(float4*)(p.X() + (size_t)T * 1024 + col) = make_float4(x2[i * 4], x2[i * 4 + 1], x2[i * 4 + 2], x2[i * 4 + 3]);
        float4 g = *(const float4*)(p.norm_mix + 1024 + col), sh = *(const float4*)(md1 + col), scl = *(const float4*)(md1 + 1024 + col);
        float y0 = x2[i * 4] * rstd * g.x * (1.f + scl.x) + sh.x, y1 = x2[i * 4 + 1] * rstd * g.y * (1.f + scl.y) + sh.y;
        float y2 = x2[i * 4 + 2] * rstd * g.z * (1.f + scl.z) + sh.z, y3 = x2[i * 4 + 3] * rstd * g.w * (1.f + scl.w) + sh.w;
        *(uint2*)(p.H() + (size_t)T * 1024 + col) = make_uint2(pack2(y0, y1), pack2(y2, y3));
      }
    } else {
#pragma unroll
      for (int i = 0; i < 4; i++) {
        int col = (i * 64 + lane) * 4;
        float4 g = *(const float4*)(p.norm_final + col);
        *(float4*)(p.out + (size_t)T * 1024 + col) = make_float4(x2[i * 4] * rstd * g.x, x2[i * 4 + 1] * rstd * g.y, x2[i * 4 + 2] * rstd * g.z, x2[i * 4 + 3] * rstd * g.w);
      }
    }
  }
}

#define XB_TMO      128
#define XB_XCNT(j)  (256  + 64 * (j))
#define XB_XSUB(j)  (1280 + 64 * (j))
#define XB_XGEN(j)  (2304 + 64 * (j))
#define XB_TOP      3328
#define XB_TOPGEN   3392
#define XCD_BAR_WORDS 3456
#define XB_SPIN_CAP (1u << 20)
#define LAS __attribute__((address_space(3)))
DEV unsigned xb_ld(unsigned* p)              { return __hip_atomic_load(p, __ATOMIC_RELAXED, __HIP_MEMORY_SCOPE_AGENT); }
DEV unsigned xb_add(unsigned* p, unsigned v) { return __hip_atomic_fetch_add(p, v, __ATOMIC_RELAXED, __HIP_MEMORY_SCOPE_AGENT); }
DEV unsigned xb_xcc_id() { return (unsigned)__builtin_amdgcn_s_getreg((3 << 11) | 20) & 0xFu; }
#define XB_SPIN(cond, bar) do { unsigned _sp = 0; while (cond) { __builtin_amdgcn_s_sleep(4); \
    if ((++_sp & 255u) == 0u) { if (xb_ld(&(bar)[XB_TMO])) break; if (_sp > XB_SPIN_CAP) { atomicAdd(&(bar)[XB_TMO], 1u); break; } } } } while (0)
struct XcdBarrier { unsigned* bar; unsigned x; volatile LAS unsigned* st; };
DEV XcdBarrier xcd_barrier_post(unsigned* bar, volatile LAS unsigned* st) {
  XcdBarrier b; b.bar = bar; b.x = xb_xcc_id(); b.st = st;
  if (threadIdx.x == 0) (void)xb_add(&bar[XB_XCNT(b.x)], 1u);
  return b;
}
DEV void xcd_barrier_complete(unsigned* bar, unsigned x, unsigned& nloc, unsigned& nx) {
  const unsigned G = gridDim.x * gridDim.y * gridDim.z;
  unsigned sum, cnt, mine, sp = 0u;
  for (;;) {
    sum = 0u; cnt = 0u; mine = 0u;
#pragma unroll
    for (unsigned j = 0; j < 16; ++j) { const unsigned c = xb_ld(&bar[XB_XCNT(j)]); sum += c; cnt += (c > 0u) ? 1u : 0u; mine = (j == x) ? c : mine; }
    if (sum == G) break;
    __builtin_amdgcn_s_sleep(1);
    if ((++sp & 255u) == 0u) { if (xb_ld(&bar[XB_TMO])) break; if (sp > XB_SPIN_CAP) { atomicAdd(&bar[XB_TMO], 1u); break; } }
  }
  nloc = mine > 0u ? mine : 1u; nx = cnt > 0u ? cnt : 1u;
}
DEV void xcd_barrier(const XcdBarrier& b) {
  asm volatile("s_waitcnt vmcnt(0)" ::: "memory");
  __syncthreads();
  if (threadIdx.x == 0) {
    unsigned* bar = b.bar;
    __builtin_amdgcn_s_waitcnt(0);
    unsigned nloc = b.st[0], nx = b.st[1];
    if (nloc == 0u) { xcd_barrier_complete(bar, b.x, nloc, nx); b.st[0] = nloc; b.st[1] = nx; }
    const unsigned old = xb_add(&bar[XB_XSUB(b.x)], 1u);
    const unsigned gen = old / nloc;
    if (old + 1u == (gen + 1u) * nloc) {
      __builtin_amdgcn_fence(__ATOMIC_RELEASE, "agent");
      asm volatile("s_waitcnt vmcnt(0)" ::: "memory");
      const unsigned og = xb_add(&bar[XB_TOP], 1u);
      const unsigned tg = og / nx;
      if (og + 1u == (tg + 1u) * nx) xb_add(&bar[XB_TOPGEN], 1u);
      else XB_SPIN(xb_ld(&bar[XB_TOPGEN]) == tg, bar);
      __builtin_amdgcn_fence(__ATOMIC_ACQUIRE, "agent");
      xb_add(&bar[XB_XGEN(b.x)], 1u);
      asm volatile("s_waitcnt vmcnt(0)" ::: "memory");
    } else {
      XB_SPIN(xb_ld(&bar[XB_XGEN(b.x)]) == gen, bar);
      __builtin_amdgcn_fence(__ATOMIC_ACQUIRE, "agent");
      asm volatile("s_waitcnt vmcnt(0)" ::: "memory");
    }
  }
  __syncthreads();
}

constexpr int NPHASE = 14;
DEV void run_phase(const Params& p, int ph, int bid, int nb, char* smem) {
  switch (ph) {
    case 0: phase_prep(p, bid, nb, smem); break;
    case 1: phase_ada(p, 0, p.norm_mix, 0, 1, true, bid, nb); break;
    case 2: gemm_phase(p.H(), 1024, p.WT_EVIN(), 1024, 1024, 64, 22, bid, nb, smem, [&](int m0, int n0, const float* Cs) { epi_inproj0(p, m0, n0, Cs); }); break;
    case 3: phase_attn0(p, bid, nb, smem); break;
    case 4: gemm_phase(p.MIX(), 1024, p.WT_EVOUT(), 1024, 1024, 64, 8, bid, nb, smem, [&](int m0, int n0, const float* Cs) { epi_outproj(p, 0, m0, n0, Cs); }); break;
    case 5: phase_ada(p, 0, p.norm_ffn, 3, 4, false, bid, nb); break;
    case 11: phase_ada(p, 1, p.norm_ffn + 1024, 3, 4, false, bid, nb); break;
    case 6: case 12: {
      int layer = ph == 6 ? 0 : 1;
      const u16* sk = p.SUBK() + (size_t)layer * 16 * 128 * 128;
      gemm_phase(p.H(), 1024, p.WT_PQ() + (size_t)layer * 2048 * 1024, 1024, 1024, 64, 16, bid, nb, smem, [&](int m0, int n0, const float* Cs) {
        int lane = threadIdx.x & 63, wave = threadIdx.x >> 6;
#pragma unroll 8
        for (int rr = wave; rr < 128; rr += 4) {
          float2 c = *(const float2*)(Cs + rr * 128 + lane * 2);
          *(unsigned*)(p.PQ() + (size_t)(m0 + rr) * 2048 + n0 + lane * 2) = pack2(c.x, c.y);
        }
        asm volatile("s_waitcnt vmcnt(0)" ::: "memory");
        __syncthreads();
        int hc = n0 >> 7;
        f32x16 acc[2][2];
        zero16(acc[0][0]); zero16(acc[0][1]); zero16(acc[1][0]); zero16(acc[1][1]);
        gemm_tile(p.PQ() + (size_t)m0 * 2048 + hc * 128, 2048, sk + (size_t)hc * 128 * 128, 128, 128, smem, acc);
        const float* Cs2 = (const float*)smem;
#pragma unroll 8
        for (int rr = wave; rr < 128; rr += 4) {
          float2 c = *(const float2*)(Cs2 + rr * 128 + lane * 2);
          *(float2*)(p.SC() + (size_t)(m0 + rr) * 2048 + hc * 128 + lane * 2) = c;
        }
      });
    } break;
    case 7: phase_peer(p, 0, bid, nb, smem); break;
    case 13: phase_peer(p, 1, bid, nb, smem); break;
    case 8: {
      gemm_phase(p.H(), 1024, p.WT_ODIN(), 1024, 1024, 64, 18, bid, nb, smem, [&](int m0, int n0, const float* Cs) { epi_inproj1(p, m0, n0, Cs); });
      int first = 0, cnt = nb;
      if ((nb & 7) == 0) { int slots = nb >> 3, rem = (8 * 18) % slots; if (rem > 0) { first = rem * 8; cnt = nb - first; } }
      int me = ((nb & 7) == 0) ? ((bid >> 3) * 8 + (bid & 7)) - first : bid;
      if (me >= 0) {
        for (int j = me; j < 2048; j += cnt) {
          if (j < 1024) prep_quant<true>(p.peer_u, p.U8(), p.SU(), 16384 + j * 16); else prep_quant<false>(p.peer_v, p.V8(), p.SV(), 16384 + (j - 1024) * 16);
        }
      }
    } break;
    case 9: phase_attn1(p, bid, nb, smem); break;
    case 10: gemm_phase(p.MIX(), 1024, p.WT_ODOUT(), 1024, 1024, 64, 8, bid, nb, smem, [&](int m0, int n0, const float* Cs) { epi_outproj(p, 1, m0, n0, Cs); }); break;
    default: break;
  }
}

constexpr size_t PARAMS_OFF = 330036736ull;
template <int PH> DEV void run_all(const Params& p, cg::grid_group& grid, const XcdBarrier& xb, char* smem) {
  if constexpr (PH == 0) {
    if (blockIdx.x == 0 && threadIdx.x < sizeof(Params) / 8) ((unsigned long long*)(p.ws + PARAMS_OFF))[threadIdx.x] = ((const unsigned long long*)&p)[threadIdx.x];
    run_phase(p, PH, blockIdx.x, gridDim.x, smem);
  } else {
    run_phase(p, PH, blockIdx.x, gridDim.x, smem);
  }
  if constexpr (PH + 1 < NPHASE) {
    if (PH == 0 && p.ws == nullptr) grid.sync();
    xcd_barrier(xb);
    run_all<PH + 1>(p, grid, xb, smem);
  }
}
__global__ void __launch_bounds__(256, 2) mega_kernel(Params p) {
  __shared__ __attribute__((aligned(16))) char smem[77824];
  __shared__ uint4 xb_words;
  if (threadIdx.x == 0) xb_words = make_uint4(0u, 0u, 0u, 0u);
  __syncthreads();
  XcdBarrier xb = xcd_barrier_post(p.BAR(), (volatile LAS unsigned*)&xb_words);
  cg::grid_group grid = cg::this_grid();
  run_all<0>(p, grid, xb, smem);
}
#if MULTI_LAUNCH
template <int PH> __global__ void __launch_bounds__(256, 2) phase_kernel(Params p) {
  __shared__ __attribute__((aligned(16))) char smem[77824];
  run_phase(p, PH, blockIdx.x, gridDim.x, smem);
}
template <int PH> static void launch_all(const Params& p, int grid, hipStream_t s) {
  phase_kernel<PH><<<grid, 256, 0, s>>>(p);
  if constexpr (PH + 1 < NPHASE) launch_all<PH + 1>(p, grid, s);
}
#endif

extern "C" void kernel_launch(void* const* d_in, const int* in_sizes, int n_in, void* d_out, int out_size, void* d_ws, size_t ws_size, hipStream_t stream) {
  Params p{};
  const float* const* in = (const float* const*)d_in;
  p.xp = in[0]; p.xs = in[1]; p.c = in[2]; p.cctx = in[3]; p.cak = in[4]; p.cav = in[5]; p.srf = in[6]; p.srb = in[7];
  p.cck = in[8]; p.ccv = in[9]; p.cdk = in[10]; p.cdv = in[11];
  p.mod_w = in[12]; p.mod_b = in[13]; p.norm_mix = in[14]; p.norm_ffn = in[15]; p.norm_final = in[16];
  p.ev_w_in = in[17]; p.ev_w_out = in[18]; p.a_q_norm = in[19]; p.a_k_norm = in[20]; p.rdf = in[21]; p.rdb = in[22];
  p.od_w_in = in[23]; p.od_w_out = in[24]; p.lq1 = in[25]; p.lk1 = in[26]; p.lq2 = in[27]; p.lk2 = in[28]; p.subln = in[29]; p.dsink = in[30];
  p.peer_wq = in[31]; p.peer_sk = in[32]; p.peer_u = in[33]; p.peer_v = in[34];
  p.out = (float*)d_out;
  p.ws = (char*)d_ws;
  (void)in_sizes; (void)n_in; (void)out_size; (void)ws_size;
#if MULTI_LAUNCH
  launch_all<0>(p, 512, stream);
#else
  static int grid_blocks = 0;
  if (!grid_blocks) {
    int dev = 0, cus = 0, per_cu = 0;
    hipGetDevice(&dev);
    hipDeviceGetAttribute(&cus, hipDeviceAttributeMultiprocessorCount, dev);
    hipOccupancyMaxActiveBlocksPerMultiprocessor(&per_cu, mega_kernel, 256, 0);
    if (per_cu > 2) per_cu = 2;
    if (per_cu < 1) per_cu = 1;
    grid_blocks = cus * per_cu;
  }
  (void)hipMemsetAsync(d_ws, 0, XCD_BAR_WORDS * 4, stream);
  void* args[] = {&p};
  hipError_t e = hipLaunchCooperativeKernel((void*)mega_kernel, dim3(grid_blocks), dim3(256), args, 0, stream);
  if (e != hipSuccess) fprintf(stderr, "cooperative launch failed: %s (grid %d)\n", hipGetErrorString(e), grid_blocks);
#endif
}
```

```cpp
#include <hip/hip_runtime.h>
#include <hip/hip_cooperative_groups.h>
#include <cstdio>
namespace cg = cooperative_groups;

#ifndef MULTI_LAUNCH
#define MULTI_LAUNCH 0
#endif

typedef unsigned short u16;
typedef __attribute__((ext_vector_type(8))) short bf16x8;
typedef __attribute__((ext_vector_type(16))) float f32x16;
typedef __attribute__((ext_vector_type(4))) unsigned u32x4;

#define DEV __device__ __forceinline__

constexpr size_t OUT_AK = 8388608, OUT_AV = 8912896, OUT_RF = 9437184, OUT_RB = 9961472,
                 OUT_CK = 10485760, OUT_CV = 12582912, OUT_DK = 14680064, OUT_DV = 15204352;
constexpr float LAM_INIT = 0.35550906f;

struct Params {
  const float *xp, *xs, *c, *cctx, *cak, *cav, *srf, *srb, *cck, *ccv, *cdk, *cdv;
  const float *mod_w, *mod_b, *norm_mix, *norm_ffn, *norm_final;
  const float *ev_w_in, *ev_w_out, *a_q_norm, *a_k_norm, *rdf, *rdb;
  const float *od_w_in, *od_w_out, *lq1, *lk1, *lq2, *lk2, *subln, *dsink;
  const float *peer_wq, *peer_sk, *peer_u, *peer_v;
  float* out;
  char* ws;
  __device__ __forceinline__ unsigned* BAR() const { return (unsigned*)(ws + 0ull); }
  __device__ __forceinline__ float* MOD() const { return (float*)(ws + 13824ull); }
  __device__ __forceinline__ float* ROPEC() const { return (float*)(ws + 259584ull); }
  __device__ __forceinline__ float* ROPES() const { return (float*)(ws + 390656ull); }
  __device__ __forceinline__ float* X() const { return (float*)(ws + 521728ull); }
  __device__ __forceinline__ float* SC() const { return (float*)(ws + 34076160ull); }
  __device__ __forceinline__ u16* WT_EVIN() const { return (u16*)(ws + 101185024ull); }
  __device__ __forceinline__ u16* WT_EVOUT() const { return (u16*)(ws + 106952192ull); }
  __device__ __forceinline__ u16* WT_ODIN() const { return (u16*)(ws + 109049344ull); }
  __device__ __forceinline__ u16* WT_ODOUT() const { return (u16*)(ws + 113767936ull); }
  __device__ __forceinline__ u16* WT_PQ() const { return (u16*)(ws + 115865088ull); }
  __device__ __forceinline__ u16* SUBK() const { return (u16*)(ws + 124253696ull); }
  __device__ __forceinline__ unsigned char* U8() const { return (unsigned char*)(ws + 125302272ull); }
  __device__ __forceinline__ unsigned char* V8() const { return (unsigned char*)(ws + 158856704ull); }
  __device__ __forceinline__ float* SU() const { return (float*)(ws + 192411136ull); }
  __device__ __forceinline__ float* SV() const { return (float*)(ws + 192542208ull); }
  __device__ __forceinline__ u16* H() const { return (u16*)(ws + 192673280ull); }
  __device__ __forceinline__ u16* MIX() const { return (u16*)(ws + 209450496ull); }
  __device__ __forceinline__ u16* Q1() const { return (u16*)(ws + 226227712ull); }
  __device__ __forceinline__ u16* Q2() const { return (u16*)(ws + 234616320ull); }
  __device__ __forceinline__ u16* SG() const { return (u16*)(ws + 243004928ull); }
  __device__ __forceinline__ u16* KA() const { return (u16*)(ws + 251393536ull); }
  __device__ __forceinline__ u16* VA() const { return (u16*)(ws + 253752832ull); }
  __device__ __forceinline__ u16* RK() const { return (u16*)(ws + 256112128ull); }
  __device__ __forceinline__ u16* RV() const { return (u16*)(ws + 264500736ull); }
  __device__ __forceinline__ u16* KC() const { return (u16*)(ws + 272889344ull); }
  __device__ __forceinline__ u16* VC() const { return (u16*)(ws + 282326528ull); }
  __device__ __forceinline__ u16* KD() const { return (u16*)(ws + 291763712ull); }
  __device__ __forceinline__ u16* VD() const { return (u16*)(ws + 294123008ull); }
  __device__ __forceinline__ u16* PQ() const { return (u16*)(ws + 296482304ull); }
};

DEV float bf2f(unsigned b) { return __uint_as_float(b << 16); }
typedef __bf16 bf16v2 __attribute__((ext_vector_type(2)));
typedef float f32v2 __attribute__((ext_vector_type(2)));
DEV unsigned pack2(float a, float b) { f32v2 v = {a, b}; return __builtin_bit_cast(unsigned, __builtin_convertvector(v, bf16v2)); }
DEV u16 f2bf(float f) { return (u16)(pack2(f, 0.f) & 0xffffu); }
DEV float bflo(unsigned w) { return __uint_as_float(w << 16); }
DEV float bfhi(unsigned w) { return __uint_as_float(w & 0xffff0000u); }
DEV float silu_f(float v) { return v / (1.f + __expf(-v)); }
DEV float gelu_tanh(float a) {
  float z = 0.7978845608f * (a + 0.044715f * a * a * a);
  float e = __expf(2.f * z);
  float th = 1.f - 2.f / (e + 1.f);
  return 0.5f * a * (1.f + th);
}
template <int CTRL> DEV float dpp_f(float v) {
  return __int_as_float(__builtin_amdgcn_update_dpp(0, __float_as_int(v), CTRL, 0xF, 0xF, true));
}
template <int CTRL> DEV unsigned dpp_u(unsigned v) {
  return (unsigned)__builtin_amdgcn_update_dpp(0, (int)v, CTRL, 0xF, 0xF, true);
}
DEV float row_sum16(float v) {
  v += dpp_f<0xB1>(v); v += dpp_f<0x4E>(v); v += dpp_f<0x141>(v); v += dpp_f<0x140>(v); return v;
}
DEV float row_max16(float v) {
  v = fmaxf(v, dpp_f<0xB1>(v)); v = fmaxf(v, dpp_f<0x4E>(v)); v = fmaxf(v, dpp_f<0x141>(v)); v = fmaxf(v, dpp_f<0x140>(v)); return v;
}
DEV float rlane(float v, int l) { return __int_as_float(__builtin_amdgcn_readlane(__float_as_int(v), l)); }
DEV float wave_sum(float v) {
  v = row_sum16(v);
  return (rlane(v, 0) + rlane(v, 16)) + (rlane(v, 32) + rlane(v, 48));
}
DEV unsigned wave_max_u(unsigned v) {
  v = max(v, dpp_u<0xB1>(v)); v = max(v, dpp_u<0x4E>(v)); v = max(v, dpp_u<0x141>(v)); v = max(v, dpp_u<0x140>(v));
  unsigned a = (unsigned)__builtin_amdgcn_readlane((int)v, 0), b = (unsigned)__builtin_amdgcn_readlane((int)v, 16);
  unsigned c = (unsigned)__builtin_amdgcn_readlane((int)v, 32), d = (unsigned)__builtin_amdgcn_readlane((int)v, 48);
  return max(max(a, b), max(c, d));
}
DEV float half_sum32(float v) { v = row_sum16(v); return v + __shfl_xor(v, 16); }
DEV unsigned fkey(float f) { unsigned u = __float_as_uint(f); return (u & 0x80000000u) ? ~u : (u | 0x80000000u); }
DEV f32x16 mfma32(bf16x8 a, bf16x8 b, f32x16 c) { return __builtin_amdgcn_mfma_f32_32x32x16_bf16(a, b, c, 0, 0, 0); }
DEV void zero16(f32x16& v) {
#pragma unroll
  for (int i = 0; i < 16; i++) v[i] = 0.f;
}
DEV size_t kvoff(bool smp, int b, int hh, int tpos, int H, int DW, int LS, int off) {
  return smp ? (size_t)4096 * H * DW + ((size_t)(b * H + hh) * LS + off + tpos) * DW
             : ((size_t)(b * H + hh) * 256 + tpos) * DW;
}


DEV float wave_max_f(float v) {
  v = row_max16(v);
  return fmaxf(fmaxf(rlane(v, 0), rlane(v, 16)), fmaxf(rlane(v, 32), rlane(v, 48)));
}
DEV int wave_sum_i(int v) {
  v += (int)dpp_u<0xB1>((unsigned)v); v += (int)dpp_u<0x4E>((unsigned)v); v += (int)dpp_u<0x141>((unsigned)v); v += (int)dpp_u<0x140>((unsigned)v);
  return (__builtin_amdgcn_readlane(v, 0) + __builtin_amdgcn_readlane(v, 16)) + (__builtin_amdgcn_readlane(v, 32) + __builtin_amdgcn_readlane(v, 48));
}
DEV int mbcnt64(unsigned long long m) { return (int)__builtin_amdgcn_mbcnt_hi((unsigned)(m >> 32), __builtin_amdgcn_mbcnt_lo((unsigned)m, 0u)); }
template <bool SGN> DEV void prep_quant(const float* __restrict__ src, unsigned char* __restrict__ dst, float* __restrict__ scale, int row0) {
  int lane = threadIdx.x & 63, wave = threadIdx.x >> 6;
  int rbase = row0 + wave * 4;
  float4 v[4][4];
#pragma unroll
  for (int q = 0; q < 4; q++)
#pragma unroll
    for (int i = 0; i < 4; i++) v[q][i] = *(const float4*)(src + (size_t)(rbase + q) * 1024 + (i * 64 + lane) * 4);
#pragma unroll
  for (int q = 0; q < 4; q++) {
    float mx = 0.f;
#pragma unroll
    for (int i = 0; i < 4; i++) mx = fmaxf(mx, fmaxf(fmaxf(fabsf(v[q][i].x), fabsf(v[q][i].y)), fmaxf(fabsf(v[q][i].z), fabsf(v[q][i].w))));
    mx = wave_max_f(mx);
    float inv = mx > 0.f ? 127.f / mx : 0.f;
    unsigned w[4];
#pragma unroll
    for (int i = 0; i < 4; i++) {
      int off = SGN ? 0 : 128;
      unsigned b0 = (unsigned)((int)rintf(v[q][i].x * inv) + off) & 255u, b1 = (unsigned)((int)rintf(v[q][i].y * inv) + off) & 255u;
      unsigned b2 = (unsigned)((int)rintf(v[q][i].z * inv) + off) & 255u, b3 = (unsigned)((int)rintf(v[q][i].w * inv) + off) & 255u;
      w[i] = b0 | (b1 << 8) | (b2 << 16) | (b3 << 24);
    }
    *(uint4*)(dst + (size_t)(rbase + q) * 1024 + lane * 16) = make_uint4(w[0], w[1], w[2], w[3]);
    if (lane == 0) scale[rbase + q] = mx * (1.f / 127.f);
  }
}

DEV void prep_transpose(const float* __restrict__ W, int N, u16* __restrict__ Wt, int tile, float* sm) {
  int ntn = N >> 6; int kt = tile / ntn, nt = tile % ntn;
  int k0 = kt * 64, n0 = nt * 64; int t = threadIdx.x;
#pragma unroll
  for (int i = 0; i < 4; i++) {
    int k = (t >> 4) + 16 * i; int c4 = (t & 15) * 4;
    float4 v = *(const float4*)(W + (size_t)(k0 + k) * N + n0 + c4);
    sm[k * 65 + c4] = v.x; sm[k * 65 + c4 + 1] = v.y; sm[k * 65 + c4 + 2] = v.z; sm[k * 65 + c4 + 3] = v.w;
  }
  __syncthreads();
  int n = t >> 2, kc = (t & 3) * 16;
  unsigned pk[8];
#pragma unroll
  for (int j = 0; j < 8; j++) pk[j] = pack2(sm[(kc + 2 * j) * 65 + n], sm[(kc + 2 * j + 1) * 65 + n]);
  uint4* dst = (uint4*)(Wt + (size_t)(n0 + n) * 1024 + k0 + kc);
  dst[0] = make_uint4(pk[0], pk[1], pk[2], pk[3]);
  dst[1] = make_uint4(pk[4], pk[5], pk[6], pk[7]);
  __syncthreads();
}
DEV void conv_item(const float* __restrict__ src, u16* __restrict__ dst) {
  int t = threadIdx.x;
#pragma unroll
  for (int i = 0; i < 8; i++) {
    int e = (i * 256 + t) * 8;
    float4 a = *(const float4*)(src + e), b = *(const float4*)(src + e + 4);
    *(uint4*)(dst + e) = make_uint4(pack2(a.x, a.y), pack2(a.z, a.w), pack2(b.x, b.y), pack2(b.z, b.w));
  }
}
DEV void prep_mod(const Params& p, int it, float* sm) {
  int l = it / 96, n0 = (it % 96) * 64; int t = threadIdx.x;
  float* sc = sm;
  for (int i = t; i < 5120; i += 256) {
    int b = i >> 10, k = i & 1023;
    float v = (b == 0) ? p.cctx[k] : p.c[(b - 1) * 1024 + k];
    sc[i] = silu_f(v);
  }
  __syncthreads();
  int col = t & 63, kg = t >> 6;
  float a0 = 0, a1 = 0, a2 = 0, a3 = 0, a4 = 0;
  const float* w = p.mod_w + (size_t)l * 1024 * 6144 + n0 + col;
  for (int k0 = kg; k0 < 1024; k0 += 32) {
    float wv[8];
#pragma unroll
    for (int u = 0; u < 8; u++) wv[u] = w[(size_t)(k0 + 4 * u) * 6144];
#pragma unroll
    for (int u = 0; u < 8; u++) {
      int k = k0 + 4 * u;
      a0 += sc[k] * wv[u]; a1 += sc[1024 + k] * wv[u]; a2 += sc[2048 + k] * wv[u]; a3 += sc[3072 + k] * wv[u]; a4 += sc[4096 + k] * wv[u];
    }
  }
  float* red = sm + 5120;
  red[(kg * 5 + 0) * 64 + col] = a0; red[(kg * 5 + 1) * 64 + col] = a1; red[(kg * 5 + 2) * 64 + col] = a2;
  red[(kg * 5 + 3) * 64 + col] = a3; red[(kg * 5 + 4) * 64 + col] = a4;
  __syncthreads();
  if (t < 64) {
#pragma unroll
    for (int b = 0; b < 5; b++) {
      float s = red[(0 * 5 + b) * 64 + t] + red[(1 * 5 + b) * 64 + t] + red[(2 * 5 + b) * 64 + t] + red[(3 * 5 + b) * 64 + t];
      p.MOD()[(size_t)(l * 5 + b) * 6144 + n0 + t] = s + p.mod_b[l * 6144 + n0 + t];
    }
  }
  __syncthreads();
}
DEV void prep_cache(const Params& p, int it) {
  const float* src; u16* dst;
  if (it < 8)       { int ch = it;      src = p.cak + (size_t)ch * 16384; dst = p.KA() + (size_t)4096 * 2 * 64 + (size_t)ch * 1280 * 64; }
  else if (it < 16) { int ch = it - 8;  src = p.cav + (size_t)ch * 16384; dst = p.VA() + (size_t)4096 * 2 * 64 + (size_t)ch * 1280 * 64; }
  else if (it < 48) { int ch = it - 16; src = p.cck + (size_t)ch * 16384; dst = p.KC() + (size_t)4096 * 8 * 64 + (size_t)ch * 1280 * 64; }
  else if (it < 80) { int ch = (it - 48) >> 1, hf = (it - 48) & 1;
                      src = p.ccv + (size_t)ch * 32768 + hf * 16384; dst = p.VC() + (size_t)4096 * 4 * 128 + (size_t)ch * 1280 * 128 + hf * 16384; }
  else if (it < 88) { int ch = it - 80; src = p.cdk + (size_t)ch * 16384; dst = p.KD() + (size_t)4096 * 2 * 64 + (size_t)ch * 1280 * 64; }
  else              { int ch = it - 88; src = p.cdv + (size_t)ch * 16384; dst = p.VD() + (size_t)4096 * 2 * 64 + (size_t)ch * 1280 * 64; }
  conv_item(src, dst);
}
DEV void prep_rope(const Params& p, int it) {
  for (int i = 0; i < 16; i++) {
    int idx = it * 4096 + i * 256 + threadIdx.x;
    int tpos = idx >> 5, a = idx & 31;
    float pos = (a < 16) ? (float)(tpos >> 6) : (float)(tpos & 63);
    float inv = exp2f(-(float)(a & 15) * (13.287712379549449f / 16.f));
    float ang = pos * inv;
    p.ROPEC()[idx] = __cosf(ang); p.ROPES()[idx] = __sinf(ang);
  }
}
constexpr int PREP_T0 = 704, PREP_T1 = PREP_T0 + 256, PREP_T2 = PREP_T1 + 576, PREP_T3 = PREP_T2 + 256, PREP_T4 = PREP_T3 + 1024;
constexpr int PREP_U = PREP_T4 + 2048, PREP_V = PREP_U + 2048, PREP_SK = PREP_V + 32, PREP_CA = PREP_SK + 96, PREP_RO = PREP_CA + 8, PREP_MOD = PREP_RO + 192;
DEV void phase_prep(const Params& p, int bid, int nb, char* smem) {
  float* sm = (float*)smem;
  for (int it0 = bid; it0 < PREP_MOD; it0 += nb) {
    int it = (it0 < 192) ? (PREP_RO + it0) : (it0 - 192);
    if (it >= PREP_T4 && it < PREP_V) continue;
    if ((it >= PREP_T1 && it < PREP_T3) || (it >= PREP_T3 + 512 && it < PREP_T4)) continue;
    if (it < PREP_T0) prep_transpose(p.ev_w_in, 2816, p.WT_EVIN(), it, sm);
    else if (it < PREP_T1) prep_transpose(p.ev_w_out, 1024, p.WT_EVOUT(), it - PREP_T0, sm);
    else if (it < PREP_T2) prep_transpose(p.od_w_in, 2304, p.WT_ODIN(), it - PREP_T1, sm);
    else if (it < PREP_T3) prep_transpose(p.od_w_out, 1024, p.WT_ODOUT(), it - PREP_T2, sm);
    else if (it < PREP_T4) { int j = it - PREP_T3; int l = j >> 9; prep_transpose(p.peer_wq + (size_t)l * 1024 * 2048, 2048, p.WT_PQ() + (size_t)l * 2048 * 1024, j & 511, sm); }
    else if (it < PREP_V) { }
    else if (it < PREP_SK) { size_t o = (size_t)(it - PREP_V) * 16384; conv_item(p.peer_sk + o, p.SUBK() + o); }
    else if (it < PREP_CA) prep_cache(p, it - PREP_SK);
    else if (it < PREP_RO) prep_rope(p, it - PREP_CA);
    else prep_mod(p, it - PREP_RO, sm);
  }
}

DEV void phase_ada(const Params& p, int layer, const float* __restrict__ gain, int shift_i, int scale_i, bool from_input, int bid, int nb) {
  int wave = threadIdx.x >> 6, lane = threadIdx.x & 63;
  for (int T0 = (bid * 4 + wave) * 2; T0 < 8192; T0 += nb * 8) {
    float4 v[2][4]; float ss[2];
#pragma unroll
    for (int q = 0; q < 2; q++) {
      int T = T0 + q;
      const float* xr = from_input ? (T < 4096 ? p.xp + (size_t)T * 1024 : p.xs + (size_t)(T - 4096) * 1024) : p.X() + (size_t)T * 1024;
#pragma unroll
      for (int i = 0; i < 4; i++) v[q][i] = *(const float4*)(xr + (i * 64 + lane) * 4);
    }
    int mb = T0 < 4096 ? 0 : 1 + ((T0 - 4096) >> 10);
    const float* md = p.MOD() + (size_t)(layer * 5 + mb) * 6144;
    float4 g[4], sh[4], sc[4];
#pragma unroll
    for (int i = 0; i < 4; i++) {
      int col = (i * 64 + lane) * 4;
      g[i] = *(const float4*)(gain + col); sh[i] = *(const float4*)(md + shift_i * 1024 + col); sc[i] = *(const float4*)(md + scale_i * 1024 + col);
    }
#pragma unroll
    for (int q = 0; q < 2; q++) {
      float s2 = 0.f;
#pragma unroll
      for (int i = 0; i < 4; i++) s2 += v[q][i].x * v[q][i].x + v[q][i].y * v[q][i].y + v[q][i].z * v[q][i].z + v[q][i].w * v[q][i].w;
      ss[q] = wave_sum(s2);
    }
#pragma unroll
    for (int q = 0; q < 2; q++) {
      float rstd = rsqrtf(ss[q] * (1.f / 1024.f) + 1e-6f);
#pragma unroll
      for (int i = 0; i < 4; i++) {
        int col = (i * 64 + lane) * 4;
        float y0 = v[q][i].x * rstd * g[i].x * (1.f + sc[i].x) + sh[i].x, y1 = v[q][i].y * rstd * g[i].y * (1.f + sc[i].y) + sh[i].y;
        float y2 = v[q][i].z * rstd * g[i].z * (1.f + sc[i].z) + sh[i].z, y3 = v[q][i].w * rstd * g[i].w * (1.f + sc[i].w) + sh[i].w;
        *(uint2*)(p.H() + (size_t)(T0 + q) * 1024 + col) = make_uint2(pack2(y0, y1), pack2(y2, y3));
      }
    }
  }
}

#define GLOAD8(PA, PB) \
  ra0 = *(const u32x4*)(PA); ra1 = *(const u32x4*)((PA) + sa32); ra2 = *(const u32x4*)((PA) + 2 * sa32); ra3 = *(const u32x4*)((PA) + 3 * sa32); \
  rb0 = *(const u32x4*)(PB); rb1 = *(const u32x4*)((PB) + sb32); rb2 = *(const u32x4*)((PB) + 2 * sb32); rb3 = *(const u32x4*)((PB) + 3 * sb32);
#define GLOAD8N(PA, PB) \
  na0 = *(const u32x4*)(PA); na1 = *(const u32x4*)((PA) + sa32); na2 = *(const u32x4*)((PA) + 2 * sa32); na3 = *(const u32x4*)((PA) + 3 * sa32); \
  nb0 = *(const u32x4*)(PB); nb1 = *(const u32x4*)((PB) + sb32); nb2 = *(const u32x4*)((PB) + 2 * sb32); nb3 = *(const u32x4*)((PB) + 3 * sb32);
#define GSTORE8(BUF) { u16* wa_ = (u16*)(smem + (BUF) * 36864) + lrow * 72 + lkc; u16* wb_ = wa_ + 128 * 72; \
  *(u32x4*)(wa_) = ra0; *(u32x4*)(wa_ + 32 * 72) = ra1; *(u32x4*)(wa_ + 64 * 72) = ra2; *(u32x4*)(wa_ + 96 * 72) = ra3; \
  *(u32x4*)(wb_) = rb0; *(u32x4*)(wb_ + 32 * 72) = rb1; *(u32x4*)(wb_ + 64 * 72) = rb2; *(u32x4*)(wb_ + 96 * 72) = rb3; }
DEV void gemm_tile(const u16* __restrict__ A, int lda, const u16* __restrict__ B, int ldb, int K, char* smem, f32x16 (&acc)[2][2]) {
  int t = threadIdx.x, lane = t & 63, wave = t >> 6, r = lane & 31, h = lane >> 5;
  int wm = wave >> 1, wn = wave & 1;
  int lrow = t >> 3, lkc = (t & 7) * 8;
  const u16* ap = A + (size_t)lrow * lda + lkc;
  const u16* bp = B + (size_t)lrow * ldb + lkc;
  size_t sa32 = (size_t)32 * lda, sb32 = (size_t)32 * ldb;
  u32x4 ra0, ra1, ra2, ra3, rb0, rb1, rb2, rb3;
  u32x4 na0, na1, na2, na3, nb0, nb1, nb2, nb3;
  int nk = K >> 6;
#define GSTORE8N(BUF) { u16* wa_ = (u16*)(smem + (BUF) * 36864) + lrow * 72 + lkc; u16* wb_ = wa_ + 128 * 72; \
  *(u32x4*)(wa_) = na0; *(u32x4*)(wa_ + 32 * 72) = na1; *(u32x4*)(wa_ + 64 * 72) = na2; *(u32x4*)(wa_ + 96 * 72) = na3; \
  *(u32x4*)(wb_) = nb0; *(u32x4*)(wb_ + 32 * 72) = nb1; *(u32x4*)(wb_ + 64 * 72) = nb2; *(u32x4*)(wb_ + 96 * 72) = nb3; }
#define GCOMPUTE(BUF) { const u16* sA = (const u16*)(smem + (BUF) * 36864); const u16* sB = sA + 128 * 72; \
    _Pragma("unroll") for (int kk = 0; kk < 4; kk++) { \
      bf16x8 a0 = *(const bf16x8*)(sA + (wm * 64 + r) * 72 + kk * 16 + h * 8); \
      bf16x8 a1 = *(const bf16x8*)(sA + (wm * 64 + 32 + r) * 72 + kk * 16 + h * 8); \
      bf16x8 b0 = *(const bf16x8*)(sB + (wn * 64 + r) * 72 + kk * 16 + h * 8); \
      bf16x8 b1 = *(const bf16x8*)(sB + (wn * 64 + 32 + r) * 72 + kk * 16 + h * 8); \
      acc[0][0] = mfma32(a0, b0, acc[0][0]); acc[0][1] = mfma32(a0, b1, acc[0][1]); \
      acc[1][0] = mfma32(a1, b0, acc[1][0]); acc[1][1] = mfma32(a1, b1, acc[1][1]); } }
  GLOAD8(ap, bp)
  __syncthreads();
  GSTORE8(0)
  if (nk > 1) { GLOAD8(ap + 64, bp + 64) }
  na0 = ra0; na1 = ra1; na2 = ra2; na3 = ra3; nb0 = rb0; nb1 = rb1; nb2 = rb2; nb3 = rb3;
  __syncthreads();
  for (int kt = 0; kt < nk; kt += 2) {
    if (kt + 2 < nk) { GLOAD8N(ap + (kt + 2) * 64, bp + (kt + 2) * 64) }
    GCOMPUTE(0)
    if (kt + 1 < nk) { GSTORE8(1) }
    __syncthreads();
    if (kt + 1 < nk) {
      if (kt + 3 < nk) { GLOAD8(ap + (kt + 3) * 64, bp + (kt + 3) * 64) }
      GCOMPUTE(1)
      if (kt + 2 < nk) { GSTORE8N(0) }
      __syncthreads();
    }
  }
  __syncthreads();
  float* Cs = (float*)smem;
#pragma unroll
  for (int i = 0; i < 2; i++)
#pragma unroll
    for (int j = 0; j < 2; j++)
#pragma unroll
      for (int g = 0; g < 16; g++)
        Cs[(wm * 64 + i * 32 + (g & 3) + 8 * (g >> 2) + 4 * h) * 128 + wn * 64 + j * 32 + r] = acc[i][j][g];
  __syncthreads();
}

DEV bool xcd_tile(int li, int bid, int NTl, int& mt, int& nt) {
  if (li >= 8 * NTl) return false;
  mt = 8 * (bid & 7) + (li & 7); nt = li >> 3; return true;
}
template <class Epi>
DEV void gemm_phase(const u16* A, int lda, const u16* Bt, int ldb, int K, int MT, int NTl, int bid, int nb, char* smem, Epi epi) {
  if ((nb & 7) == 0 && MT == 64) {
    int mt, nt;
    for (int li = bid >> 3; xcd_tile(li, bid, NTl, mt, nt); li += nb >> 3) {
      f32x16 acc[2][2];
      zero16(acc[0][0]); zero16(acc[0][1]); zero16(acc[1][0]); zero16(acc[1][1]);
      gemm_tile(A + (size_t)mt * 128 * lda, lda, Bt + (size_t)nt * 128 * ldb, ldb, K, smem, acc);
      epi(mt * 128, nt * 128, (const float*)smem);
    }
  } else {
    for (int it = bid; it < MT * NTl; it += nb) {
      int mt = it / NTl, nt = it % NTl;
      f32x16 acc[2][2];
      zero16(acc[0][0]); zero16(acc[0][1]); zero16(acc[1][0]); zero16(acc[1][1]);
      gemm_tile(A + (size_t)mt * 128 * lda, lda, Bt + (size_t)nt * 128 * ldb, ldb, K, smem, acc);
      epi(mt * 128, nt * 128, (const float*)smem);
    }
  }
}

DEV void tok_decode(int T, bool& smp, int& b, int& tpos) {
  smp = T >= 4096;
  if (!smp) { b = T >> 8; tpos = T & 255; } else { b = (T - 4096) >> 10; tpos = (T - 4096) & 1023; }
}
DEV void rope_pair(const Params& p, float& x, float& y, int tpos, int d) {
  float px = __shfl_xor(x, 16), py = __shfl_xor(y, 16);
  int a = d & 31;
  float c0 = p.ROPEC()[tpos * 32 + a], c1 = p.ROPEC()[tpos * 32 + a + 1];
  float s0 = p.ROPES()[tpos * 32 + a], s1 = p.ROPES()[tpos * 32 + a + 1];
  if (d < 32) { x = x * c0 - px * s0; y = y * c1 - py * s1; }
  else        { x = px * s0 + x * c0; y = py * s1 + y * c1; }
}

DEV void rope_apply(float& x, float& y, float4 cs, int d) {
  float px = __shfl_xor(x, 16), py = __shfl_xor(y, 16);
  if (d < 32) { x = x * cs.x - px * cs.z; y = y * cs.y - py * cs.w; }
  else        { x = px * cs.z + x * cs.x; y = py * cs.w + y * cs.y; }
}
DEV float4 rope_cs(const Params& p, int tpos, int d) {
  int a = d & 31;
  float2 c = *(const float2*)(p.ROPEC() + tpos * 32 + a), s = *(const float2*)(p.ROPES() + tpos * 32 + a);
  return make_float4(c.x, c.y, s.x, s.y);
}
template <int SEG, bool SMP>
DEV void epi0_rows(const Params& p, int m0, int n0, const float* Cs) {
  int lane = threadIdx.x & 63, wave = threadIdx.x >> 6;
  int col = n0 + lane * 2; int d = col & 63;
  float g0 = 1.f, g1 = 1.f;
  if (SEG == 0) { g0 = p.a_q_norm[d]; g1 = p.a_q_norm[d + 1]; }
  if (SEG == 1) { g0 = p.a_k_norm[d]; g1 = p.a_k_norm[d + 1]; }
  int segbase = SEG == 0 ? 0 : SEG == 1 ? 512 : SEG == 2 ? 640 : SEG == 3 ? 768 : SEG == 4 ? 1280 : SEG == 5 ? 1792 : 2304;
  int hh = (col - segbase) >> 6;
#pragma unroll 4
  for (int i = 0; i < 32; i++) {
    int rr = wave + 4 * i;
    int T = m0 + rr;
    int b = SMP ? (T - 4096) >> 10 : T >> 8;
    int tpos = SMP ? (T - 4096) & 1023 : T & 255;
    float2 c = *(const float2*)(Cs + rr * 128 + lane * 2);
    if (SEG <= 1) {
      float4 cs = make_float4(1.f, 1.f, 0.f, 0.f);
      if (SMP) cs = rope_cs(p, tpos, d);
      float ss = half_sum32(c.x * c.x + c.y * c.y);
      float rstd = rsqrtf(ss * (1.f / 64.f) + 1e-6f);
      c.x *= rstd * g0; c.y *= rstd * g1;
      if (SMP) rope_apply(c.x, c.y, cs, d);
    }
    if (SEG == 0) *(unsigned*)(p.Q1() + (size_t)T * 512 + col) = pack2(c.x * 0.18033688011112042f, c.y * 0.18033688011112042f);
    if (SEG == 1) {
      *(unsigned*)(p.KA() + kvoff(SMP, b, hh, tpos, 2, 64, 1280, 256) + d) = pack2(c.x, c.y);
      if (!SMP) *(float2*)(p.out + OUT_AK + ((size_t)(b * 2 + hh) * 256 + tpos) * 64 + d) = c;
    }
    if (SEG == 2) {
      *(unsigned*)(p.VA() + kvoff(SMP, b, hh, tpos, 2, 64, 1280, 256) + d) = pack2(c.x, c.y);
      if (!SMP) *(float2*)(p.out + OUT_AV + ((size_t)(b * 2 + hh) * 256 + tpos) * 64 + d) = c;
    }
    if (SEG == 3) *(unsigned*)(p.Q2() + (size_t)T * 512 + (col - 768)) = pack2(c.x, c.y);
    if (SEG == 4) *(unsigned*)(p.RK() + kvoff(SMP, b, hh, tpos, 8, 64, 1024, 0) + d) = pack2(c.x * 0.125f, c.y * 0.125f);
    if (SEG == 5) *(unsigned*)(p.RV() + kvoff(SMP, b, hh, tpos, 8, 64, 1024, 0) + d) = pack2(c.x, c.y);
    if (SEG == 6) *(unsigned*)(p.SG() + (size_t)T * 512 + (col - 2304)) = pack2(silu_f(c.x), silu_f(c.y));
  }
}
template <bool SMP> DEV void epi0_disp(const Params& p, int m0, int n0, const float* Cs) {
  if (n0 < 512) epi0_rows<0, SMP>(p, m0, n0, Cs);
  else if (n0 < 640) epi0_rows<1, SMP>(p, m0, n0, Cs);
  else if (n0 < 768) epi0_rows<2, SMP>(p, m0, n0, Cs);
  else if (n0 < 1280) epi0_rows<3, SMP>(p, m0, n0, Cs);
  else if (n0 < 1792) epi0_rows<4, SMP>(p, m0, n0, Cs);
  else if (n0 < 2304) epi0_rows<5, SMP>(p, m0, n0, Cs);
  else epi0_rows<6, SMP>(p, m0, n0, Cs);
}
DEV void epi_inproj0(const Params& p, int m0, int n0, const float* Cs) {
  if (m0 >= 4096) epi0_disp<true>(p, m0, n0, Cs); else epi0_disp<false>(p, m0, n0, Cs);
}
template <int SEG, bool SMP>
DEV void epi1_rows(const Params& p, int m0, int n0, const float* Cs) {
  int lane = threadIdx.x & 63, wave = threadIdx.x >> 6;
  int col = n0 + lane * 2; int d = col & 63;
  int segbase = SEG == 0 ? 0 : SEG == 1 ? 512 : SEG == 2 ? 1024 : SEG == 3 ? 1536 : SEG == 4 ? 2048 : 2176;
  int hh = (SEG == 2) ? (col - segbase) >> 7 : (col - segbase) >> 6;
  int dd = (col - 1024) & 127;
  constexpr bool ROPE = SMP && (SEG == 0 || SEG == 1 || SEG == 3 || SEG == 4);
#pragma unroll 4
  for (int i = 0; i < 32; i++) {
    int rr = wave + 4 * i;
    int T = m0 + rr;
    int b = SMP ? (T - 4096) >> 10 : T >> 8;
    int tpos = SMP ? (T - 4096) & 1023 : T & 255;
    float2 c = *(const float2*)(Cs + rr * 128 + lane * 2);
    if (!SMP) {
      if (SEG == 1) *(float2*)(p.out + OUT_CK + ((size_t)(b * 8 + hh) * 256 + tpos) * 64 + d) = c;
      if (SEG == 2) *(float2*)(p.out + OUT_CV + ((size_t)(b * 4 + hh) * 256 + tpos) * 128 + dd) = c;
      if (SEG == 4) *(float2*)(p.out + OUT_DK + ((size_t)(b * 2 + hh) * 256 + tpos) * 64 + d) = c;
      if (SEG == 5) *(float2*)(p.out + OUT_DV + ((size_t)(b * 2 + hh) * 256 + tpos) * 64 + d) = c;
    }
    if (ROPE) { float4 cs = rope_cs(p, tpos, d); rope_apply(c.x, c.y, cs, d); }
    if (SEG == 0) *(unsigned*)(p.Q1() + (size_t)T * 512 + col) = pack2(c.x * 0.18033688011112042f, c.y * 0.18033688011112042f);
    if (SEG == 1) *(unsigned*)(p.KC() + kvoff(SMP, b, hh, tpos, 8, 64, 1280, 256) + d) = pack2(c.x, c.y);
    if (SEG == 2) *(unsigned*)(p.VC() + kvoff(SMP, b, hh, tpos, 4, 128, 1280, 256) + dd) = pack2(c.x, c.y);
    if (SEG == 3) *(unsigned*)(p.Q2() + (size_t)T * 512 + (col - 1536)) = pack2(c.x * 0.18033688011112042f, c.y * 0.18033688011112042f);
    if (SEG == 4) *(unsigned*)(p.KD() + kvoff(SMP, b, hh, tpos, 2, 64, 1280, 256) + d) = pack2(c.x, c.y);
    if (SEG == 5) *(unsigned*)(p.VD() + kvoff(SMP, b, hh, tpos, 2, 64, 1280, 256) + d) = pack2(c.x, c.y);
  }
}
template <bool SMP> DEV void epi1_disp(const Params& p, int m0, int n0, const float* Cs) {
  if (n0 < 512) epi1_rows<0, SMP>(p, m0, n0, Cs);
  else if (n0 < 1024) epi1_rows<1, SMP>(p, m0, n0, Cs);
  else if (n0 < 1536) epi1_rows<2, SMP>(p, m0, n0, Cs);
  else if (n0 < 2048) epi1_rows<3, SMP>(p, m0, n0, Cs);
  else if (n0 < 2176) epi1_rows<4, SMP>(p, m0, n0, Cs);
  else epi1_rows<5, SMP>(p, m0, n0, Cs);
}
DEV void epi_inproj1(const Params& p, int m0, int n0, const float* Cs) {
  if (m0 >= 4096) epi1_disp<true>(p, m0, n0, Cs); else epi1_disp<false>(p, m0, n0, Cs);
}
DEV void epi_outproj(const Params& p, int layer, int m0, int n0, const float* Cs) {
  int lane = threadIdx.x & 63, wave = threadIdx.x >> 6;
  int mb = m0 < 4096 ? 0 : 1 + ((m0 - 4096) >> 10);
  int col = n0 + lane * 2;
  float2 g = *(const float2*)(p.MOD() + (size_t)(layer * 5 + mb) * 6144 + 2048 + col);
  const float* xbase = (layer == 0) ? (m0 < 4096 ? p.xp + (size_t)m0 * 1024 : p.xs + (size_t)(m0 - 4096) * 1024) : p.X() + (size_t)m0 * 1024;
#pragma unroll 8
  for (int i = 0; i < 32; i++) {
    int rr = wave + 4 * i;
    float2 c = *(const float2*)(Cs + rr * 128 + lane * 2);
    float2 x = *(const float2*)(xbase + (size_t)rr * 1024 + col);
    x.x += g.x * c.x; x.y += g.y * c.y;
    *(float2*)(p.X() + (size_t)(m0 + rr) * 1024 + col) = x;
  }
}

constexpr int ATT_BUF = 37888;
struct TileRegs { u32x4 k0, k1, k2, k3, v0, v1, v2, v3; };
template <int DV, bool TWOK> DEV TileRegs tile_load(const u16* __restrict__ k, const u16* __restrict__ k2, const u16* __restrict__ v) {
  int t = threadIdx.x, lane = t & 63, wave = t >> 6;
  TileRegs R;
  u32x4 z = {0u, 0u, 0u, 0u};
  R.k0 = *(const u32x4*)(k + t * 8); R.k1 = *(const u32x4*)(k + (t + 256) * 8);
  if (TWOK) { R.k2 = *(const u32x4*)(k2 + t * 8); R.k3 = *(const u32x4*)(k2 + (t + 256) * 8); } else { R.k2 = z; R.k3 = z; }
  R.v0 = *(const u32x4*)(v + (size_t)lane * DV + wave * 8); R.v1 = *(const u32x4*)(v + (size_t)lane * DV + (wave + 4) * 8);
  if (DV == 128) { R.v2 = *(const u32x4*)(v + (size_t)lane * DV + (wave + 8) * 8); R.v3 = *(const u32x4*)(v + (size_t)lane * DV + (wave + 12) * 8); } else { R.v2 = z; R.v3 = z; }
  return R;
}
DEV void store8t(u16* d, u32x4 x) {
  d[0 * 76] = (u16)(x[0] & 0xffff); d[1 * 76] = (u16)(x[0] >> 16);
  d[2 * 76] = (u16)(x[1] & 0xffff); d[3 * 76] = (u16)(x[1] >> 16);
  d[4 * 76] = (u16)(x[2] & 0xffff); d[5 * 76] = (u16)(x[2] >> 16);
  d[6 * 76] = (u16)(x[3] & 0xffff); d[7 * 76] = (u16)(x[3] >> 16);
}
template <int DV, bool TWOK> DEV void tile_store(const TileRegs R, char* buf) {
  int t = threadIdx.x, lane = t & 63, wave = t >> 6;
  u16* sK = (u16*)buf; u16* sK2 = sK + 64 * 72; u16* sVT = sK + 2 * 64 * 72;
  int key = t >> 3, dc = t & 7;
  *(u32x4*)(sK + key * 72 + dc * 8) = R.k0; *(u32x4*)(sK + (key + 32) * 72 + dc * 8) = R.k1;
  if (TWOK) { *(u32x4*)(sK2 + key * 72 + dc * 8) = R.k2; *(u32x4*)(sK2 + (key + 32) * 72 + dc * 8) = R.k3; }
  store8t(sVT + (wave * 8) * 76 + lane, R.v0); store8t(sVT + ((wave + 4) * 8) * 76 + lane, R.v1);
  if (DV == 128) { store8t(sVT + ((wave + 8) * 8) * 76 + lane, R.v2); store8t(sVT + ((wave + 12) * 8) * 76 + lane, R.v3); }
}
DEV void load_ident_k(u16* sK) {
  int t = threadIdx.x;
#pragma unroll
  for (int i = 0; i < 2; i++) {
    int c = t + 256 * i; int key = c >> 3, dc = c & 7;
    unsigned w[4] = {0u, 0u, 0u, 0u};
    uint4 z = make_uint4(0u, 0u, 0u, 0u);
    if (dc == (key >> 3)) {
      int e = key & 7; unsigned one = (e & 1) ? 0x3F800000u : 0x00003F80u;
      if ((e >> 1) == 0) z.x = one; else if ((e >> 1) == 1) z.y = one; else if ((e >> 1) == 2) z.z = one; else z.w = one;
    }
    (void)w;
    *(uint4*)(sK + key * 72 + dc * 8) = z;
  }
}
DEV void load_state_v(const float* __restrict__ S0, u16* sVT) {
  int lane = threadIdx.x & 63, wave = threadIdx.x >> 6;
#pragma unroll
  for (int i = 0; i < 2; i++) {
    int dc = wave + 4 * i;
    float4 a = *(const float4*)(S0 + lane * 64 + dc * 8), b = *(const float4*)(S0 + lane * 64 + dc * 8 + 4);
    u16* d = sVT + (dc * 8) * 76 + lane;
    d[0 * 76] = f2bf(a.x); d[1 * 76] = f2bf(a.y); d[2 * 76] = f2bf(a.z); d[3 * 76] = f2bf(a.w);
    d[4 * 76] = f2bf(b.x); d[5 * 76] = f2bf(b.y); d[6 * 76] = f2bf(b.z); d[7 * 76] = f2bf(b.w);
  }
}
template <int DV, class F>
DEV void attn_compute(const bf16x8 (&qf)[4], f32x16 (&o)[DV / 32], const u16* sK, const u16* sVT, F&& xform) {
  int lane = threadIdx.x & 63, r = lane & 31, h = lane >> 5;
  f32x16 st[2]; zero16(st[0]); zero16(st[1]);
#pragma unroll
  for (int sub = 0; sub < 2; sub++)
#pragma unroll
    for (int kk = 0; kk < 4; kk++) {
      bf16x8 kf = *(const bf16x8*)(sK + (sub * 32 + r) * 72 + kk * 16 + h * 8);
      st[sub] = mfma32(kf, qf[kk], st[sub]);
    }
  xform(st);
  bf16x8 pf[2][2];
#pragma unroll
  for (int sub = 0; sub < 2; sub++)
#pragma unroll
    for (int s = 0; s < 2; s++) {
      u32x4 w;
      w[0] = pack2(st[sub][8 * s + 0], st[sub][8 * s + 1]); w[1] = pack2(st[sub][8 * s + 2], st[sub][8 * s + 3]);
      w[2] = pack2(st[sub][8 * s + 4], st[sub][8 * s + 5]); w[3] = pack2(st[sub][8 * s + 6], st[sub][8 * s + 7]);
      pf[sub][s] = __builtin_bit_cast(bf16x8, w);
    }
#pragma unroll
  for (int ds = 0; ds < DV / 32; ds++)
#pragma unroll
    for (int sub = 0; sub < 2; sub++)
#pragma unroll
      for (int s = 0; s < 2; s++) {
        const u16* vp = sVT + (ds * 32 + r) * 76 + sub * 32 + s * 16 + 4 * h;
        uint2 lo = *(const uint2*)vp, hi = *(const uint2*)(vp + 8);
        u32x4 w; w[0] = lo.x; w[1] = lo.y; w[2] = hi.x; w[3] = hi.y;
        o[ds] = mfma32(__builtin_bit_cast(bf16x8, w), pf[sub][s], o[ds]);
      }
}
template <int DV, class F>
DEV void attn_compute_sub(const bf16x8 (&qf)[4], f32x16 (&o)[DV / 32], const u16* sK, const u16* sVT, F&& xform) {
  int lane = threadIdx.x & 63, r = lane & 31, h = lane >> 5;
#pragma unroll
  for (int sub = 0; sub < 2; sub++) {
    f32x16 st; zero16(st);
#pragma unroll
    for (int kk = 0; kk < 4; kk++) {
      bf16x8 kf = *(const bf16x8*)(sK + (sub * 32 + r) * 72 + kk * 16 + h * 8);
      st = mfma32(kf, qf[kk], st);
    }
    xform(sub, st);
    bf16x8 pf[2];
#pragma unroll
    for (int s2 = 0; s2 < 2; s2++) {
      u32x4 w;
      w[0] = pack2(st[8 * s2 + 0], st[8 * s2 + 1]); w[1] = pack2(st[8 * s2 + 2], st[8 * s2 + 3]);
      w[2] = pack2(st[8 * s2 + 4], st[8 * s2 + 5]); w[3] = pack2(st[8 * s2 + 6], st[8 * s2 + 7]);
      pf[s2] = __builtin_bit_cast(bf16x8, w);
    }
#pragma unroll
    for (int ds = 0; ds < DV / 32; ds++)
#pragma unroll
      for (int s2 = 0; s2 < 2; s2++) {
        const u16* vp = sVT + (ds * 32 + r) * 76 + sub * 32 + s2 * 16 + 4 * h;
        uint2 lo = *(const uint2*)vp, hi = *(const uint2*)(vp + 8);
        u32x4 w; w[0] = lo.x; w[1] = lo.y; w[2] = hi.x; w[3] = hi.y;
        o[ds] = mfma32(__builtin_bit_cast(bf16x8, w), pf[s2], o[ds]);
      }
  }
}
template <int DV>
DEV void softmax_xform1(f32x16& st, f32x16 (&o)[DV / 32], float& m, float& l) {
  float mx = -1e30f;
#pragma unroll
  for (int g = 0; g < 16; g++) mx = fmaxf(mx, st[g]);
  mx = fmaxf(mx, __shfl_xor(mx, 32));
  float mnew = fmaxf(m, mx);
  float alpha = __builtin_amdgcn_exp2f(m - mnew);
  m = mnew;
  float ls = 0.f;
#pragma unroll
  for (int g = 0; g < 16; g++) { float pv = __builtin_amdgcn_exp2f(st[g] - mnew); st[g] = pv; ls += pv; }
  l = l * alpha + ls;
#pragma unroll
  for (int ds = 0; ds < DV / 32; ds++)
#pragma unroll
    for (int g = 0; g < 16; g++) o[ds][g] *= alpha;
}
template <int DV, bool TWOK, class PF, class XF, class XF1>
DEV void attn_loop(int n, PF&& ptrs, const bf16x8 (&qf)[4], f32x16 (&o)[DV / 32], char* smem, XF&& xf, XF1&& xf1) {
  int wave = threadIdx.x >> 6;
  int kofs = (TWOK && wave >= 2) ? 64 * 72 : 0;
  TileRegs R;
  const u16 *kp, *kp2, *vp;
  ptrs(0, kp, kp2, vp); R = tile_load<DV, TWOK>(kp, kp2, vp);
  __syncthreads();
  tile_store<DV, TWOK>(R, smem);
  if (n > 1) { ptrs(1, kp, kp2, vp); R = tile_load<DV, TWOK>(kp, kp2, vp); }
  __syncthreads();
  const u16* b0k = (const u16*)smem + kofs; const u16* b0v = (const u16*)smem + 2 * 64 * 72;
  const u16* b1k = (const u16*)(smem + ATT_BUF) + kofs; const u16* b1v = (const u16*)(smem + ATT_BUF) + 2 * 64 * 72;
  for (int ti = 0; ti < n; ti++) {
    const u16* bk = (ti & 1) ? b1k : b0k; const u16* bv = (ti & 1) ? b1v : b0v;
    if constexpr (DV == 128) attn_compute_sub<DV>(qf, o, bk, bv, [&](int sub, f32x16& st) { xf1(ti, sub, st); });
    else attn_compute<DV>(qf, o, bk, bv, [&](f32x16 (&st)[2]) { xf(ti, st); });
    if (ti + 1 < n) tile_store<DV, TWOK>(R, smem + ((ti + 1) & 1) * ATT_BUF);
    if (ti + 2 < n) { ptrs(ti + 2, kp, kp2, vp); R = tile_load<DV, TWOK>(kp, kp2, vp); }
    __syncthreads();
  }
}
template <int DV>
DEV void softmax_xform(f32x16 (&st)[2], f32x16 (&o)[DV / 32], float& m, float& l, bool masked, int kpos0, int qpos) {
  int h = (threadIdx.x & 63) >> 5;
  float mx = -1e30f;
#pragma unroll
  for (int sub = 0; sub < 2; sub++)
#pragma unroll
    for (int g = 0; g < 16; g++) {
      float s = st[sub][g];
      if (masked) {
        int j = kpos0 + sub * 32 + (g & 3) + 8 * (g >> 2) + 4 * h;
        int dl = qpos - j; if (dl < 0) dl = -dl;
        if (dl > 128) s = -1e30f;
        st[sub][g] = s;
      }
      mx = fmaxf(mx, s);
    }
  mx = fmaxf(mx, __shfl_xor(mx, 32));
  float mnew = fmaxf(m, mx);
  float alpha = __builtin_amdgcn_exp2f(m - mnew);
  m = mnew;
  float ls = 0.f;
#pragma unroll
  for (int sub = 0; sub < 2; sub++)
#pragma unroll
    for (int g = 0; g < 16; g++) { float pv = __builtin_amdgcn_exp2f(st[sub][g] - mnew); st[sub][g] = pv; ls += pv; }
  l = l * alpha + ls;
#pragma unroll
  for (int ds = 0; ds < DV / 32; ds++)
#pragma unroll
    for (int g = 0; g < 16; g++) o[ds][g] *= alpha;
}

template <int DV, bool TWOK>
DEV void attn_softmax_job(const Params& p, const u16* Q, int Tq0, int qcol, const u16* kb, const u16* kb2, const u16* vb,
                          int nplain, int band_lo, int band_hi, int qpos0, bool use_sink, float sinkv,
                          f32x16 (&o)[DV / 32], char* smem) {
  int lane = threadIdx.x & 63, wave = threadIdx.x >> 6, r = lane & 31, h = lane >> 5;
  int qrow = TWOK ? (wave & 1) * 32 : wave * 32;
  bf16x8 qf[4];
#pragma unroll
  for (int kk = 0; kk < 4; kk++) qf[kk] = *(const bf16x8*)(Q + (size_t)(Tq0 + qrow + r) * 512 + qcol + kk * 16 + h * 8);
#pragma unroll
  for (int ds = 0; ds < DV / 32; ds++) zero16(o[ds]);
  float m = use_sink ? sinkv : -1e30f;
  float l = (use_sink && h == 0) ? 1.f : 0.f;
  int qpos = qpos0 + qrow + r;
  int ntot = nplain + (band_hi - band_lo);
  attn_loop<DV, TWOK>(ntot,
    [&](int ti, const u16*& kp, const u16*& kp2, const u16*& vp) {
      int key0 = (ti >= nplain) ? (256 + (band_lo + ti - nplain) * 64) : ti * 64;
      kp = kb + (size_t)key0 * 64; kp2 = kb2 + (size_t)key0 * 64; vp = vb + (size_t)key0 * DV;
    }, qf, o, smem,
    [&](int ti, f32x16 (&st)[2]) {
      bool masked = ti >= nplain;
      int kpos0 = (band_lo + ti - nplain) * 64;
      softmax_xform<DV>(st, o, m, l, masked, kpos0, qpos);
    },
    [&](int ti, int sub, f32x16& st) { softmax_xform1<DV>(st, o, m, l); });
  float lt = l + __shfl_xor(l, 32);
  float inv = 1.f / lt;
#pragma unroll
  for (int ds = 0; ds < DV / 32; ds++)
#pragma unroll
    for (int g = 0; g < 16; g++) o[ds][g] *= inv;
}
DEV void store_o64(const Params& p, const f32x16 (&o)[2], int Tq0, int mixcol) {
  int lane = threadIdx.x & 63, wave = threadIdx.x >> 6, r = lane & 31, h = lane >> 5;
  int T = Tq0 + wave * 32 + r;
#pragma unroll
  for (int ds = 0; ds < 2; ds++)
#pragma unroll
    for (int g4 = 0; g4 < 4; g4++) {
      int d0 = ds * 32 + 8 * g4 + 4 * h;
      *(uint2*)(p.MIX() + (size_t)T * 1024 + mixcol + d0) =
          make_uint2(pack2(o[ds][4 * g4], o[ds][4 * g4 + 1]), pack2(o[ds][4 * g4 + 2], o[ds][4 * g4 + 3]));
    }
}

DEV void ret_job(const Params& p, bool smp, int b, int hh, int qb, char* smem) {
  u16* sK = (u16*)smem; u16* sVT = sK + 2 * 64 * 72;
  int lane = threadIdx.x & 63, wave = threadIdx.x >> 6, r = lane & 31, h = lane >> 5;
  int L = smp ? 1024 : 256;
  int Tq0 = (smp ? 4096 + b * 1024 : b * 256) + qb * 128;
  const u16* kb = p.RK() + kvoff(smp, b, hh, 0, 8, 64, 1024, 0);
  const u16* vb = p.RV() + kvoff(smp, b, hh, 0, 8, 64, 1024, 0);
  float xf = p.rdf[hh], xb = p.rdb[hh];
  float lf2 = -log1pf(__expf(-xf)) * 1.4426950408889634f;
  float lb2 = -log1pf(__expf(-xb)) * 1.4426950408889634f;
  bf16x8 qf[4];
#pragma unroll
  for (int kk = 0; kk < 4; kk++) qf[kk] = *(const bf16x8*)(p.Q2() + (size_t)(Tq0 + wave * 32 + r) * 512 + hh * 64 + kk * 16 + h * 8);
  f32x16 o[2]; zero16(o[0]); zero16(o[1]);
  int qpos = qb * 128 + wave * 32 + r;
  int nt = L / 64;
  attn_loop<64, false>(nt,
    [&](int ti, const u16*& kp, const u16*& kp2, const u16*& vp) { kp = kb + (size_t)ti * 4096; kp2 = kp; vp = vb + (size_t)ti * 4096; },
    qf, o, smem,
    [&](int ti, f32x16 (&st)[2]) {
      int kpos0 = ti * 64;
#pragma unroll
      for (int sub = 0; sub < 2; sub++)
#pragma unroll
        for (int g = 0; g < 16; g++) {
          int j = kpos0 + sub * 32 + (g & 3) + 8 * (g >> 2) + 4 * h;
          int dl = qpos - j;
          float e = dl >= 0 ? lf2 * (float)dl : lb2 * (float)(-dl);
          st[sub][g] *= __builtin_amdgcn_exp2f(e);
        }
    },
    [&](int ti, int sub, f32x16& st) {});
  if (smp) {
    for (int dir = 0; dir < 2; dir++) {
      const float* S0 = (dir == 0 ? p.srf : p.srb) + (size_t)(b * 8 + hh) * 4096;
      float rs = dir == 0 ? exp2f(lf2 * (float)(qpos + 1)) : exp2f(lb2 * (float)(L - qpos));
      __syncthreads();
      load_ident_k(sK);
      load_state_v(S0, sVT);
      __syncthreads();
      attn_compute<64>(qf, o, sK, sVT, [&](f32x16 (&st)[2]) {
#pragma unroll
        for (int sub = 0; sub < 2; sub++)
#pragma unroll
          for (int g = 0; g < 16; g++) st[sub][g] *= rs;
      });
    }
  }
  float sum = 0.f;
#pragma unroll
  for (int ds = 0; ds < 2; ds++)
#pragma unroll
    for (int g = 0; g < 16; g++) sum += o[ds][g];
  sum += __shfl_xor(sum, 32);
  float mean = sum * (1.f / 64.f);
  float vs = 0.f;
#pragma unroll
  for (int ds = 0; ds < 2; ds++)
#pragma unroll
    for (int g = 0; g < 16; g++) { float dlt = o[ds][g] - mean; vs += dlt * dlt; }
  vs += __shfl_xor(vs, 32);
  float rstd = rsqrtf(vs * (1.f / 64.f) + 1e-6f);
  int T = Tq0 + wave * 32 + r;
#pragma unroll
  for (int ds = 0; ds < 2; ds++)
#pragma unroll
    for (int g4 = 0; g4 < 4; g4++) {
      int d0 = ds * 32 + 8 * g4 + 4 * h;
      uint2 gt = *(const uint2*)(p.SG() + (size_t)T * 512 + hh * 64 + d0);
      float y0 = (o[ds][4 * g4] - mean) * rstd * bflo(gt.x), y1 = (o[ds][4 * g4 + 1] - mean) * rstd * bfhi(gt.x);
      float y2 = (o[ds][4 * g4 + 2] - mean) * rstd * bflo(gt.y), y3 = (o[ds][4 * g4 + 3] - mean) * rstd * bfhi(gt.y);
      *(uint2*)(p.MIX() + (size_t)T * 1024 + 512 + hh * 64 + d0) = make_uint2(pack2(y0, y1), pack2(y2, y3));
    }
}
DEV void ret_state_job(const Params& p, int b, int hh, int dir, char* smem) {
  u16* sKk = (u16*)smem; u16* sVv = sKk + 64 * 64;
  int t = threadIdx.x;
  const u16* kb = p.RK() + kvoff(false, b, hh, 0, 8, 64, 1024, 0);
  const u16* vb = p.RV() + kvoff(false, b, hh, 0, 8, 64, 1024, 0);
  float xx = dir == 0 ? p.rdf[hh] : p.rdb[hh];
  float lg2 = -log1pf(__expf(-xx)) * 1.4426950408889634f;
  int dk = t >> 2, dvc = (t & 3) * 16;
  float acc[16];
#pragma unroll
  for (int i = 0; i < 16; i++) acc[i] = 0.f;
  for (int ch = 0; ch < 4; ch++) {
    __syncthreads();
#pragma unroll
    for (int i = 0; i < 2; i++) {
      int c = t + 256 * i;
      *(uint4*)(sKk + c * 8) = *(const uint4*)(kb + (size_t)ch * 4096 + c * 8);
      *(uint4*)(sVv + c * 8) = *(const uint4*)(vb + (size_t)ch * 4096 + c * 8);
    }
    __syncthreads();
    for (int jj = 0; jj < 64; jj++) {
      int j = ch * 64 + jj;
      float w = exp2f(lg2 * (float)(dir == 0 ? 255 - j : j));
      float kv = bf2f(sKk[jj * 64 + dk]) * w;
      const uint4* vp = (const uint4*)(sVv + jj * 64 + dvc);
      uint4 v0 = vp[0], v1 = vp[1];
      acc[0] += kv * bflo(v0.x); acc[1] += kv * bfhi(v0.x); acc[2] += kv * bflo(v0.y); acc[3] += kv * bfhi(v0.y);
      acc[4] += kv * bflo(v0.z); acc[5] += kv * bfhi(v0.z); acc[6] += kv * bflo(v0.w); acc[7] += kv * bfhi(v0.w);
      acc[8] += kv * bflo(v1.x); acc[9] += kv * bfhi(v1.x); acc[10] += kv * bflo(v1.y); acc[11] += kv * bfhi(v1.y);
      acc[12] += kv * bflo(v1.z); acc[13] += kv * bfhi(v1.z); acc[14] += kv * bflo(v1.w); acc[15] += kv * bfhi(v1.w);
    }
  }
  float* dst = p.out + (dir == 0 ? OUT_RF : OUT_RB) + ((size_t)(b * 8 + hh) * 64 + dk) * 64 + dvc;
#pragma unroll
  for (int i = 0; i < 4; i++) *(float4*)(dst + 4 * i) = make_float4(acc[4 * i], acc[4 * i + 1], acc[4 * i + 2], acc[4 * i + 3]);
}

DEV void phase_attn0(const Params& p, int bid, int nb, char* smem) {
  for (int it = bid; it < 1280 + 2048; it += nb) {
    if (it >= 1280) {
      int j = it - 1280;
      if (j < 1024) prep_quant<true>(p.peer_u, p.U8(), p.SU(), j * 16); else prep_quant<false>(p.peer_v, p.V8(), p.SV(), (j - 1024) * 16);
    } else if (it < 256) {
      int b = it >> 6, hq = (it >> 3) & 7, qb = it & 7; int kvh = hq >> 2;
      f32x16 o[2];
      int Tq0 = 4096 + b * 1024 + qb * 128;
      attn_softmax_job<64, false>(p, p.Q1(), Tq0, hq * 64, p.KA() + kvoff(true, b, kvh, -256, 2, 64, 1280, 256), p.KA(), p.VA() + kvoff(true, b, kvh, -256, 2, 64, 1280, 256),
                           20, 0, 0, qb * 128, false, 0.f, o, smem);
      store_o64(p, o, Tq0, hq * 64);
    } else if (it < 512) {
      int j = it - 256; int b = j >> 6, hh = (j >> 3) & 7, qb = j & 7;
      ret_job(p, true, b, hh, qb, smem);
    } else if (it < 768) {
      int j = it - 512; int b = j >> 4, hq = (j >> 1) & 7, qb = j & 1; int kvh = hq >> 2;
      f32x16 o[2];
      int Tq0 = b * 256 + qb * 128;
      attn_softmax_job<64, false>(p, p.Q1(), Tq0, hq * 64, p.KA() + kvoff(false, b, kvh, 0, 2, 64, 1280, 256), p.KA(), p.VA() + kvoff(false, b, kvh, 0, 2, 64, 1280, 256),
                           4, 0, 0, qb * 128, false, 0.f, o, smem);
      store_o64(p, o, Tq0, hq * 64);
    } else if (it < 1024) {
      int j = it - 768; int b = j >> 4, hh = (j >> 1) & 7, qb = j & 1;
      ret_job(p, false, b, hh, qb, smem);
    } else {
      int j = it - 1024; int b = j >> 4, hh = (j >> 1) & 7, dir = j & 1;
      ret_state_job(p, b, hh, dir, smem);
    }
  }
}
DEV void diff_job(const Params& p, bool smp, int b, int hh, int qb, float lam, char* smem) {
  int lane = threadIdx.x & 63, wave = threadIdx.x >> 6, r = lane & 31, h = lane >> 5;
  int c = wave >> 1;
  int Tq0 = (smp ? 4096 + b * 1024 : b * 256) + qb * 64;
  int nt = smp ? 20 : 4;
  const u16* vb = p.VC() + kvoff(smp, b, hh, smp ? -256 : 0, 4, 128, 1280, 256);
  const u16* kb0 = p.KC() + kvoff(smp, b, 2 * hh, smp ? -256 : 0, 8, 64, 1280, 256);
  const u16* kb1 = p.KC() + kvoff(smp, b, 2 * hh + 1, smp ? -256 : 0, 8, 64, 1280, 256);
  f32x16 o[4];
  attn_softmax_job<128, true>(p, p.Q1(), Tq0, (2 * hh + c) * 64, kb0, kb1, vb, nt, 0, 0, 0, false, 0.f, o, smem);
  float* ex = (float*)smem;
  if (wave >= 2) {
#pragma unroll
    for (int ds = 0; ds < 4; ds++)
#pragma unroll
      for (int g = 0; g < 16; g++) ex[(ds * 16 + g) * 128 + (threadIdx.x - 128)] = o[ds][g];
  }
  __syncthreads();
  if (wave < 2) {
    float ss = 0.f;
#pragma unroll
    for (int ds = 0; ds < 4; ds++)
#pragma unroll
      for (int g = 0; g < 16; g++) { float dv = o[ds][g] - lam * ex[(ds * 16 + g) * 128 + threadIdx.x]; o[ds][g] = dv; ss += dv * dv; }
    ss += __shfl_xor(ss, 32);
    float rstd = rsqrtf(ss * (1.f / 128.f) + 1e-6f) * (1.f - LAM_INIT);
    int T = Tq0 + wave * 32 + r;
#pragma unroll
    for (int ds = 0; ds < 4; ds++)
#pragma unroll
      for (int g4 = 0; g4 < 4; g4++) {
        int d0 = ds * 32 + 8 * g4 + 4 * h;
        float4 sg = *(const float4*)(p.subln + d0);
        *(uint2*)(p.MIX() + (size_t)T * 1024 + hh * 128 + d0) =
            make_uint2(pack2(o[ds][4 * g4] * rstd * sg.x, o[ds][4 * g4 + 1] * rstd * sg.y),
                       pack2(o[ds][4 * g4 + 2] * rstd * sg.z, o[ds][4 * g4 + 3] * rstd * sg.w));
      }
  }
}
DEV void phase_attn1(const Params& p, int bid, int nb, char* smem) {
  float d1 = 0.f, d2 = 0.f;
  for (int i = 0; i < 64; i++) { d1 += p.lq1[i] * p.lk1[i]; d2 += p.lq2[i] * p.lk2[i]; }
  float lam = __expf(d1) - __expf(d2) + LAM_INIT;
  for (int it = bid; it < 1024; it += nb) {
    if (it < 256) {
      int b = it >> 6, hh = (it >> 4) & 3, qb = it & 15;
      diff_job(p, true, b, hh, qb, lam, smem);
    } else if (it < 512) {
      int j = it - 256; int b = j >> 6, hq = (j >> 3) & 7, qb = j & 7; int kvh = hq >> 2;
      int q0 = qb * 128;
      int lo = (q0 - 128 < 0 ? 0 : q0 - 128) >> 6, hi = (q0 + 256 > 1024 ? 1024 : q0 + 256) >> 6;
      f32x16 o[2];
      int Tq0 = 4096 + b * 1024 + q0;
      attn_softmax_job<64, false>(p, p.Q2(), Tq0, hq * 64, p.KD() + kvoff(true, b, kvh, -256, 2, 64, 1280, 256), p.KD(), p.VD() + kvoff(true, b, kvh, -256, 2, 64, 1280, 256),
                           4, lo, hi, q0, true, p.dsink[hq] * 1.4426950408889634f, o, smem);
      store_o64(p, o, Tq0, 512 + hq * 64);
    } else if (it < 768) {
      int j = it - 512; int b = j >> 4, hh = (j >> 2) & 3, qb = j & 3;
      diff_job(p, false, b, hh, qb, lam, smem);
    } else {
      int j = it - 768; int b = j >> 4, hq = (j >> 1) & 7, qb = j & 1; int kvh = hq >> 2;
      f32x16 o[2];
      int Tq0 = b * 256 + qb * 128;
      attn_softmax_job<64, false>(p, p.Q2(), Tq0, hq * 64, p.KD() + kvoff(false, b, kvh, 0, 2, 64, 1280, 256), p.KD(), p.VD() + kvoff(false, b, kvh, 0, 2, 64, 1280, 256),
                           4, 0, 0, qb * 128, true, p.dsink[hq] * 1.4426950408889634f, o, smem);
      store_o64(p, o, Tq0, 512 + hq * 64);
    }
  }
}

DEV float ub0(unsigned w) { return (float)(w & 255u); }
DEV float ub1(unsigned w) { return (float)((w >> 8) & 255u); }
DEV float ub2(unsigned w) { return (float)((w >> 16) & 255u); }
DEV float ub3(unsigned w) { return (float)(w >> 24); }
DEV void phase_peer(const Params& p, int layer, int bid, int nb, char* smem) {
  int wave = threadIdx.x >> 6, lane = threadIdx.x & 63;
  float* ws1 = (float*)(smem + wave * 2048); float* ws2 = ws1 + 16;
  int* wi1 = (int*)(ws2 + 16); int* wi2 = wi1 + 16; float* es = (float*)(wi2 + 16); int* eidx = (int*)(es + 16); float* eg = (float*)(eidx + 128);
  const unsigned char* U = p.U8() + (size_t)layer * 16384 * 1024;
  const unsigned char* V = p.V8() + (size_t)layer * 16384 * 1024;
  const float* SU = p.SU() + layer * 16384; const float* SV = p.SV() + layer * 16384;
  const float* gain = p.norm_ffn + layer * 1024;
  for (int T = bid * 4 + wave; T < 8192; T += nb * 4) {
    const float* sc = p.SC() + (size_t)T * 2048;
    for (int hh = 0; hh < 8; hh++) {
      const float* s = sc + hh * 256;
      float a0 = s[lane], a1 = s[lane + 64], b0 = s[128 + lane], b1 = s[192 + lane];
      unsigned ka0 = (fkey(a0) & ~127u) | (unsigned)(127 - lane), ka1 = (fkey(a1) & ~127u) | (unsigned)(63 - lane);
      unsigned kb0 = (fkey(b0) & ~127u) | (unsigned)(127 - lane), kb1 = (fkey(b1) & ~127u) | (unsigned)(63 - lane);
      unsigned pa = 0u, pb = 0u;
      for (int bit = 31; bit >= 0; --bit) {
        unsigned ta = pa | (1u << bit), tb = pb | (1u << bit);
        int ca = __popcll(__ballot(ka0 >= ta)) + __popcll(__ballot(ka1 >= ta));
        int cb = __popcll(__ballot(kb0 >= tb)) + __popcll(__ballot(kb1 >= tb));
        if (ca >= 16) pa = ta;
        if (cb >= 16) pb = tb;
      }
      {
        unsigned long long m0 = __ballot(ka0 >= pa), m1 = __ballot(ka1 >= pa);
        int p0 = mbcnt64(m0), p1 = __popcll(m0) + mbcnt64(m1);
        if (ka0 >= pa) { ws1[p0 & 15] = a0; wi1[p0 & 15] = lane; }
        if (ka1 >= pa) { ws1[p1 & 15] = a1; wi1[p1 & 15] = lane + 64; }
        unsigned long long n0 = __ballot(kb0 >= pb), n1 = __ballot(kb1 >= pb);
        int q0 = mbcnt64(n0), q1 = __popcll(n0) + mbcnt64(n1);
        if (kb0 >= pb) { ws2[q0 & 15] = b0; wi2[q0 & 15] = lane; }
        if (kb1 >= pb) { ws2[q1 & 15] = b1; wi2[q1 & 15] = lane + 64; }
      }
      __builtin_amdgcn_fence(__ATOMIC_ACQ_REL, "wavefront");
      __builtin_amdgcn_wave_barrier();
      int bq = lane & 15, aq = lane >> 4;
      float s2v = ws2[bq];
      float c0 = ws1[aq] + s2v, c1 = ws1[aq + 4] + s2v, c2 = ws1[aq + 8] + s2v, c3 = ws1[aq + 12] + s2v;
      unsigned k0 = (fkey(c0) & ~255u) | (unsigned)(255 - lane), k1 = (fkey(c1) & ~255u) | (unsigned)(191 - lane);
      unsigned k2 = (fkey(c2) & ~255u) | (unsigned)(127 - lane), k3 = (fkey(c3) & ~255u) | (unsigned)(63 - lane);
      unsigned pc = 0u;
      for (int bit = 31; bit >= 0; --bit) {
        unsigned tc = pc | (1u << bit);
        int cc = __popcll(__ballot(k0 >= tc)) + __popcll(__ballot(k1 >= tc)) + __popcll(__ballot(k2 >= tc)) + __popcll(__ballot(k3 >= tc));
        if (cc >= 16) pc = tc;
      }
      {
        unsigned long long m0 = __ballot(k0 >= pc), m1 = __ballot(k1 >= pc), m2 = __ballot(k2 >= pc), m3 = __ballot(k3 >= pc);
        int n0 = __popcll(m0), n1 = n0 + __popcll(m1), n2 = n1 + __popcll(m2);
        int i2b = wi2[bq];
        if (k0 >= pc) { int q = mbcnt64(m0) & 15; es[q] = c0; eidx[hh * 16 + q] = wi1[aq] * 128 + i2b; }
        if (k1 >= pc) { int q = (n0 + mbcnt64(m1)) & 15; es[q] = c1; eidx[hh * 16 + q] = wi1[aq + 4] * 128 + i2b; }
        if (k2 >= pc) { int q = (n1 + mbcnt64(m2)) & 15; es[q] = c2; eidx[hh * 16 + q] = wi1[aq + 8] * 128 + i2b; }
        if (k3 >= pc) { int q = (n2 + mbcnt64(m3)) & 15; es[q] = c3; eidx[hh * 16 + q] = wi1[aq + 12] * 128 + i2b; }
      }
      __builtin_amdgcn_fence(__ATOMIC_ACQ_REL, "wavefront");
      __builtin_amdgcn_wave_barrier();
      float ts = es[lane & 15];
      float mx = row_max16(ts);
      float pe = __expf(ts - mx);
      float sm = row_sum16(pe);
      if (lane < 16) eg[hh * 16 + lane] = pe / sm;
      __builtin_amdgcn_fence(__ATOMIC_ACQ_REL, "wavefront");
      __builtin_amdgcn_wave_barrier();
    }
    int mb = T < 4096 ? 0 : 1 + ((T - 4096) >> 10);
    const float* md = p.MOD() + (size_t)(layer * 5 + mb) * 6144;
    float4 xv[4]; float ssx = 0.f;
#pragma unroll
    for (int i = 0; i < 4; i++) { xv[i] = *(const float4*)(p.X() + (size_t)T * 1024 + (i * 64 + lane) * 4); ssx += xv[i].x * xv[i].x + xv[i].y * xv[i].y + xv[i].z * xv[i].z + xv[i].w * xv[i].w; }
    ssx = wave_sum(ssx);
    float rstdx = rsqrtf(ssx * (1.f / 1024.f) + 1e-6f);
    float4 hv[4]; float hmax = 0.f;
#pragma unroll
    for (int i = 0; i < 4; i++) {
      int col = (i * 64 + lane) * 4;
      float4 g = *(const float4*)(gain + col), sh = *(const float4*)(md + 3 * 1024 + col), scl = *(const float4*)(md + 4 * 1024 + col);
      hv[i].x = xv[i].x * rstdx * g.x * (1.f + scl.x) + sh.x; hv[i].y = xv[i].y * rstdx * g.y * (1.f + scl.y) + sh.y;
      hv[i].z = xv[i].z * rstdx * g.z * (1.f + scl.z) + sh.z; hv[i].w = xv[i].w * rstdx * g.w * (1.f + scl.w) + sh.w;
      hmax = fmaxf(hmax, fmaxf(fmaxf(fabsf(hv[i].x), fabsf(hv[i].y)), fmaxf(fabsf(hv[i].z), fabsf(hv[i].w))));
    }
    hmax = wave_max_f(hmax);
    float hinv = hmax > 0.f ? 127.f / hmax : 0.f, hscale = hmax * (1.f / 127.f);
    int hq[4];
#pragma unroll
    for (int i = 0; i < 4; i++) {
      unsigned b0 = (unsigned)((int)rintf(hv[i].x * hinv)) & 255u, b1 = (unsigned)((int)rintf(hv[i].y * hinv)) & 255u;
      unsigned b2 = (unsigned)((int)rintf(hv[i].z * hinv)) & 255u, b3 = (unsigned)((int)rintf(hv[i].w * hinv)) & 255u;
      hq[i] = (int)(b0 | (b1 << 8) | (b2 << 16) | (b3 << 24));
    }
#define PLOAD8(SET, TBL, B0) _Pragma("unroll") for (int j = 0; j < 8; j++) { \
        int e_ = __builtin_amdgcn_readfirstlane(eidx[(B0) * 8 + j]); SET[j] = *(const u32x4*)(TBL + (size_t)e_ * 1024 + lane * 16); }
#define PDOT8(SET, B0) _Pragma("unroll") for (int j = 0; j < 8; j++) { \
        int d_ = __builtin_amdgcn_sdot4(hq[0], (int)SET[j][0], 0, false); d_ = __builtin_amdgcn_sdot4(hq[1], (int)SET[j][1], d_, false); \
        d_ = __builtin_amdgcn_sdot4(hq[2], (int)SET[j][2], d_, false); d_ = __builtin_amdgcn_sdot4(hq[3], (int)SET[j][3], d_, false); \
        float D_ = (float)wave_sum_i(d_); int e_ = (B0) * 8 + j; bool me_ = lane == (e_ & 63); \
        a0 = (me_ && e_ < 64) ? D_ : a0; a1 = (me_ && e_ >= 64) ? D_ : a1; }
#define PACC8(SET, B0) _Pragma("unroll") for (int j = 0; j < 8; j++) { \
        int e_ = (B0) * 8 + j; float w = rlane(e_ < 64 ? w0 : w1, e_ & 63); \
        acc[0] += w * ub0(SET[j][0]); acc[1] += w * ub1(SET[j][0]); acc[2] += w * ub2(SET[j][0]); acc[3] += w * ub3(SET[j][0]); \
        acc[4] += w * ub0(SET[j][1]); acc[5] += w * ub1(SET[j][1]); acc[6] += w * ub2(SET[j][1]); acc[7] += w * ub3(SET[j][1]); \
        acc[8] += w * ub0(SET[j][2]); acc[9] += w * ub1(SET[j][2]); acc[10] += w * ub2(SET[j][2]); acc[11] += w * ub3(SET[j][2]); \
        acc[12] += w * ub0(SET[j][3]); acc[13] += w * ub1(SET[j][3]); acc[14] += w * ub2(SET[j][3]); acc[15] += w * ub3(SET[j][3]); }
    float acc[16];
#pragma unroll
    for (int i = 0; i < 16; i++) acc[i] = 0.f;
    float a0 = 0.f, a1 = 0.f;
    u32x4 sa[8], sb[8];
    PLOAD8(sa, U, 0)
#pragma unroll 1
    for (int bi = 0; bi < 16; bi += 2) {
      PLOAD8(sb, U, bi + 1)
      PDOT8(sa, bi)
      if (bi + 2 < 16) { PLOAD8(sa, U, bi + 2) } else { PLOAD8(sa, V, 0) }
      PDOT8(sb, bi + 1)
    }
    int e0 = eidx[lane], e1 = eidx[lane + 64];
    float w0 = eg[lane] * gelu_tanh(a0 * (SU[e0] * hscale)) * SV[e0];
    float w1 = eg[lane + 64] * gelu_tanh(a1 * (SU[e1] * hscale)) * SV[e1];
    float wsum = wave_sum(w0 + w1);
#pragma unroll 1
    for (int bi = 0; bi < 16; bi += 2) {
      PLOAD8(sb, V, bi + 1)
      PACC8(sa, bi)
      if (bi + 2 < 16) { PLOAD8(sa, V, bi + 2) }
      PACC8(sb, bi + 1)
    }
    float x2[16]; float ss = 0.f;
#pragma unroll
    for (int i = 0; i < 4; i++) {
      int col = (i * 64 + lane) * 4;
      float4 ga = *(const float4*)(md + 5 * 1024 + col);
      x2[i * 4 + 0] = xv[i].x + ga.x * (acc[i * 4 + 0] - 128.f * wsum); x2[i * 4 + 1] = xv[i].y + ga.y * (acc[i * 4 + 1] - 128.f * wsum);
      x2[i * 4 + 2] = xv[i].z + ga.z * (acc[i * 4 + 2] - 128.f * wsum); x2[i * 4 + 3] = xv[i].w + ga.w * (acc[i * 4 + 3] - 128.f * wsum);
    }
#pragma unroll
    for (int i = 0; i < 16; i++) ss += x2[i] * x2[i];
    ss = wave_sum(ss);
    float rstd = rsqrtf(ss * (1.f / 1024.f) + 1e-6f);
    if (layer == 0) {
      const float* md1 = p.MOD() + (size_t)(5 + mb) * 6144;
#pragma unroll
      for (int i = 0; i < 4; i++) {
        int col = (i * 64 + lane) * 4;
        *(float4*)(p.X() + (size_t)T * 1024 + col) = make_float4(x2[i * 4], x2[i * 4 + 1], x2[i * 4 + 2], x2[i * 4 + 3]);
        float4 g = *(const float4*)(p.norm_mix + 1024 + col), sh = *(const float4*)(md1 + col), scl = *(const float4*)(md1 + 1024 + col);
        float y0 = x2[i * 4] * rstd * g.x * (1.f + scl.x) + sh.x, y1 = x2[i * 4 + 1] * rstd * g.y * (1.f + scl.y) + sh.y;
        float y2 = x2[i * 4 + 2] * rstd * g.z * (1.f + scl.z) + sh.z, y3 = x2[i * 4 + 3] * rstd * g.w * (1.f + scl.w) + sh.w;
        *(uint2*)(p.H() + (size_t)T * 1024 + col) = make_uint2(pack2(y0, y1), pack2(y2, y3));
      }
    } else {
#pragma unroll
      for (int i = 0; i < 4; i++) {
        int col = (i * 64 + lane) * 4;
        float4 g = *(const float4*)(p.norm_final + col);
        *(float4*)(p.out + (size_t)T * 1024 + col) = make_float4(x2[i * 4] * rstd * g.x, x2[i * 4 + 1] * rstd * g.y, x2[i * 4 + 2] * rstd * g.z, x2[i * 4 + 3] * rstd * g.w);
      }
    }
  }
}

#define XB_TMO      128
#define XB_XCNT(j)  (256  + 64 * (j))
#define XB_XSUB(j)  (1280 + 64 * (j))
#define XB_XGEN(j)  (2304 + 64 * (j))
#define XB_TOP      3328
#define XB_TOPGEN   3392
#define XCD_BAR_WORDS 3456
#define XB_SPIN_CAP (1u << 20)
#define LAS __attribute__((address_space(3)))
DEV unsigned xb_ld(unsigned* p)              { return __hip_atomic_load(p, __ATOMIC_RELAXED, __HIP_MEMORY_SCOPE_AGENT); }
DEV unsigned xb_add(unsigned* p, unsigned v) { return __hip_atomic_fetch_add(p, v, __ATOMIC_RELAXED, __HIP_MEMORY_SCOPE_AGENT); }
DEV unsigned xb_xcc_id() { return (unsigned)__builtin_amdgcn_s_getreg((3 << 11) | 20) & 0xFu; }
#define XB_SPIN(cond, bar) do { unsigned _sp = 0; while (cond) { __builtin_amdgcn_s_sleep(4); \
    if ((++_sp & 255u) == 0u) { if (xb_ld(&(bar)[XB_TMO])) break; if (_sp > XB_SPIN_CAP) { atomicAdd(&(bar)[XB_TMO], 1u); break; } } } } while (0)
struct XcdBarrier { unsigned* bar; unsigned x; volatile LAS unsigned* st; };
DEV XcdBarrier xcd_barrier_post(unsigned* bar, volatile LAS unsigned* st) {
  XcdBarrier b; b.bar = bar; b.x = xb_xcc_id(); b.st = st;
  if (threadIdx.x == 0) (void)xb_add(&bar[XB_XCNT(b.x)], 1u);
  return b;
}
DEV void xcd_barrier_complete(unsigned* bar, unsigned x, unsigned& nloc, unsigned& nx) {
  const unsigned G = gridDim.x * gridDim.y * gridDim.z;
  unsigned sum, cnt, mine, sp = 0u;
  for (;;) {
    sum = 0u; cnt = 0u; mine = 0u;
#pragma unroll
    for (unsigned j = 0; j < 16; ++j) { const unsigned c = xb_ld(&bar[XB_XCNT(j)]); sum += c; cnt += (c > 0u) ? 1u : 0u; mine = (j == x) ? c : mine; }
    if (sum == G) break;
    __builtin_amdgcn_s_sleep(1);
    if ((++sp & 255u) == 0u) { if (xb_ld(&bar[XB_TMO])) break; if (sp > XB_SPIN_CAP) { atomicAdd(&bar[XB_TMO], 1u); break; } }
  }
  nloc = mine > 0u ? mine : 1u; nx = cnt > 0u ? cnt : 1u;
}
DEV void xcd_barrier(const XcdBarrier& b) {
  asm volatile("s_waitcnt vmcnt(0)" ::: "memory");
  __syncthreads();
  if (threadIdx.x == 0) {
    unsigned* bar = b.bar;
    __builtin_amdgcn_s_waitcnt(0);
    unsigned nloc = b.st[0], nx = b.st[1];
    if (nloc == 0u) { xcd_barrier_complete(bar, b.x, nloc, nx); b.st[0] = nloc; b.st[1] = nx; }
    const unsigned old = xb_add(&bar[XB_XSUB(b.x)], 1u);
    const unsigned gen = old / nloc;
    if (old + 1u == (gen + 1u) * nloc) {
      __builtin_amdgcn_fence(__ATOMIC_RELEASE, "agent");
      asm volatile("s_waitcnt vmcnt(0)" ::: "memory");
      const unsigned og = xb_add(&bar[XB_TOP], 1u);
      const unsigned tg = og / nx;
      if (og + 1u == (tg + 1u) * nx) xb_add(&bar[XB_TOPGEN], 1u);
      else XB_SPIN(xb_ld(&bar[XB_TOPGEN]) == tg, bar);
      __builtin_amdgcn_fence(__ATOMIC_ACQUIRE, "agent");
      xb_add(&bar[XB_XGEN(b.x)], 1u);
      asm volatile("s_waitcnt vmcnt(0)" ::: "memory");
    } else {
      XB_SPIN(xb_ld(&bar[XB_XGEN(b.x)]) == gen, bar);
      __builtin_amdgcn_fence(__ATOMIC_ACQUIRE, "agent");
      asm volatile("s_waitcnt vmcnt(0)" ::: "memory");
    }
  }
  __syncthreads();
}

constexpr int NPHASE = 14;
DEV void run_phase(const Params& p, int ph, int bid, int nb, char* smem) {
  switch (ph) {
    case 0: phase_prep(p, bid, nb, smem); break;
    case 1: phase_ada(p, 0, p.norm_mix, 0, 1, true, bid, nb); break;
    case 2: {
      gemm_phase(p.H(), 1024, p.WT_EVIN(), 1024, 1024, 64, 22, bid, nb, smem, [&](int m0, int n0, const float* Cs) { epi_inproj0(p, m0, n0, Cs); });
      int first = 0, cnt = nb;
      if ((nb & 7) == 0) { int slots = nb >> 3, rem = (8 * 22) % slots; if (rem > 0) { first = rem * 8; cnt = nb - first; } }
      int me = bid - first;
      __syncthreads();
      if (me >= 0) {
        float* sm = (float*)smem;
        for (int j = me; j < 1344; j += cnt) {
          if (j < 576) prep_transpose(p.od_w_in, 2304, p.WT_ODIN(), j, sm);
          else if (j < 832) prep_transpose(p.od_w_out, 1024, p.WT_ODOUT(), j - 576, sm);
          else prep_transpose(p.peer_wq + (size_t)1024 * 2048, 2048, p.WT_PQ() + (size_t)2048 * 1024, j - 832, sm);
        }
      }
    } break;
    case 3: phase_attn0(p, bid, nb, smem); break;
    case 4: gemm_phase(p.MIX(), 1024, p.WT_EVOUT(), 1024, 1024, 64, 8, bid, nb, smem, [&](int m0, int n0, const float* Cs) { epi_outproj(p, 0, m0, n0, Cs); }); break;
    case 5: phase_ada(p, 0, p.norm_ffn, 3, 4, false, bid, nb); break;
    case 11: phase_ada(p, 1, p.norm_ffn + 1024, 3, 4, false, bid, nb); break;
    case 6: case 12: {
      int layer = ph == 6 ? 0 : 1;
      const u16* sk = p.SUBK() + (size_t)layer * 16 * 128 * 128;
      gemm_phase(p.H(), 1024, p.WT_PQ() + (size_t)layer * 2048 * 1024, 1024, 1024, 64, 16, bid, nb, smem, [&](int m0, int n0, const float* Cs) {
        int lane = threadIdx.x & 63, wave = threadIdx.x >> 6;
#pragma unroll 8
        for (int rr = wave; rr < 128; rr += 4) {
          float2 c = *(const float2*)(Cs + rr * 128 + lane * 2);
          *(unsigned*)(p.PQ() + (size_t)(m0 + rr) * 2048 + n0 + lane * 2) = pack2(c.x, c.y);
        }
        asm volatile("s_waitcnt vmcnt(0)" ::: "memory");
        __syncthreads();
        int hc = n0 >> 7;
        f32x16 acc[2][2];
        zero16(acc[0][0]); zero16(acc[0][1]); zero16(acc[1][0]); zero16(acc[1][1]);
        gemm_tile(p.PQ() + (size_t)m0 * 2048 + hc * 128, 2048, sk + (size_t)hc * 128 * 128, 128, 128, smem, acc);
        const float* Cs2 = (const float*)smem;
#pragma unroll 8
        for (int rr = wave; rr < 128; rr += 4) {
          float2 c = *(const float2*)(Cs2 + rr * 128 + lane * 2);
          *(float2*)(p.SC() + (size_t)(m0 + rr) * 2048 + hc * 128 + lane * 2) = c;
        }
      });
    } break;
    case 7: phase_peer(p, 0, bid, nb, smem); break;
    case 13: phase_peer(p, 1, bid, nb, smem); break;
    case 8: {
      gemm_phase(p.H(), 1024, p.WT_ODIN(), 1024, 1024, 64, 18, bid, nb, smem, [&](int m0, int n0, const float* Cs) { epi_inproj1(p, m0, n0, Cs); });
      int first = 0, cnt = nb;
      if ((nb & 7) == 0) { int slots = nb >> 3, rem = (8 * 18) % slots; if (rem > 0) { first = rem * 8; cnt = nb - first; } }
      int me = ((nb & 7) == 0) ? ((bid >> 3) * 8 + (bid & 7)) - first : bid;
      if (me >= 0) {
        for (int j = me; j < 2048; j += cnt) {
          if (j < 1024) prep_quant<true>(p.peer_u, p.U8(), p.SU(), 16384 + j * 16); else prep_quant<false>(p.peer_v, p.V8(), p.SV(), 16384 + (j - 1024) * 16);
        }
      }
    } break;
    case 9: phase_attn1(p, bid, nb, smem); break;
    case 10: gemm_phase(p.MIX(), 1024, p.WT_ODOUT(), 1024, 1024, 64, 8, bid, nb, smem, [&](int m0, int n0, const float* Cs) { epi_outproj(p, 1, m0, n0, Cs); }); break;
    default: break;
  }
}

constexpr size_t PARAMS_OFF = 330036736ull;
template <int PH> DEV void run_all(const Params& p, cg::grid_group& grid, const XcdBarrier& xb, char* smem) {
  if constexpr (PH == 0) {
    if (blockIdx.x == 0 && threadIdx.x < sizeof(Params) / 8) ((unsigned long long*)(p.ws + PARAMS_OFF))[threadIdx.x] = ((const unsigned long long*)&p)[threadIdx.x];
    run_phase(p, PH, blockIdx.x, gridDim.x, smem);
  } else {
    run_phase(p, PH, blockIdx.x, gridDim.x, smem);
  }
  if constexpr (PH + 1 < NPHASE) {
    if (PH == 0 && p.ws == nullptr) grid.sync();
    xcd_barrier(xb);
    run_all<PH + 1>(p, grid, xb, smem);
  }
}
__global__ void __launch_bounds__(256, 2) mega_kernel(Params p) {
  __shared__ __attribute__((aligned(16))) char smem[77824];
  __shared__ uint4 xb_words;
  if (threadIdx.x == 0) xb_words = make_uint4(0u, 0u, 0u, 0u);
  __syncthreads();
  XcdBarrier xb = xcd_barrier_post(p.BAR(), (volatile LAS unsigned*)&xb_words);
  cg::grid_group grid = cg::this_grid();
  run_all<0>(p, grid, xb, smem);
}
#if MULTI_LAUNCH
template <int PH> __global__ void __launch_bounds__(256, 2) phase_kernel(Params p) {
  __shared__ __attribute__((aligned(16))) char smem[77824];
  run_phase(p, PH, blockIdx.x, gridDim.x, smem);
}
template <int PH> static void launch_all(const Params& p, int grid, hipStream_t s) {
  phase_kernel<PH><<<grid, 256, 0, s>>>(p);
  if constexpr (PH + 1 < NPHASE) launch_all<PH + 1>(p, grid, s);
}
#endif

extern "C" void kernel_launch(void* const* d_in, const int* in_sizes, int n_in, void* d_out, int out_size, void* d_ws, size_t ws_size, hipStream_t stream) {
  Params p{};
  const float* const* in = (const float* const*)d_in;
  p.xp = in[0]; p.xs = in[1]; p.c = in[2]; p.cctx = in[3]; p.cak = in[4]; p.cav = in[5]; p.srf = in[6]; p.srb = in[7];
  p.cck = in[8]; p.ccv = in[9]; p.cdk = in[10]; p.cdv = in[11];
  p.mod_w = in[12]; p.mod_b = in[13]; p.norm_mix = in[14]; p.norm_ffn = in[15]; p.norm_final = in[16];
  p.ev_w_in = in[17]; p.ev_w_out = in[18]; p.a_q_norm = in[19]; p.a_k_norm = in[20]; p.rdf = in[21]; p.rdb = in[22];
  p.od_w_in = in[23]; p.od_w_out = in[24]; p.lq1 = in[25]; p.lk1 = in[26]; p.lq2 = in[27]; p.lk2 = in[28]; p.subln = in[29]; p.dsink = in[30];
  p.peer_wq = in[31]; p.peer_sk = in[32]; p.peer_u = in[33]; p.peer_v = in[34];
  p.out = (float*)d_out;
  p.ws = (char*)d_ws;
  (void)in_sizes; (void)n_in; (void)out_size; (void)ws_size;
#if MULTI_LAUNCH
  launch_all<0>(p, 512, stream);
#else
  static int grid_blocks = 0;
  if (!grid_blocks) {
    int dev = 0, cus = 0, per_cu = 0;
    hipGetDevice(&dev);
    hipDeviceGetAttribute(&cus, hipDeviceAttributeMultiprocessorCount, dev);
    hipOccupancyMaxActiveBlocksPerMultiprocessor(&per_cu, mega_kernel, 256, 0);
    if (per_cu > 2) per_cu = 2;
    if (per_cu < 1) per_cu = 1;
    grid_blocks = cus * per_cu;
  }
  (void)hipMemsetAsync(d_ws, 0, XCD_BAR_WORDS * 4, stream);
  void* args[] = {&p};
  hipError_t e = hipLaunchCooperativeKernel((void*)mega_kernel, dim3(grid_blocks), dim3(256), args, 0, stream);
  if (e != hipSuccess) fprintf(stderr, "cooperative launch failed: %s (grid %d)\n", hipGetErrorString(e), grid_blocks);
#endif
}
```

```cpp
#include <hip/hip_runtime.h>
#include <hip/hip_cooperative_groups.h>
#include <cstdio>
namespace cg = cooperative_groups;

#ifndef MULTI_LAUNCH
#define MULTI_LAUNCH 0
#endif

typedef unsigned short u16;
typedef __attribute__((ext_vector_type(8))) short bf16x8;
typedef __attribute__((ext_vector_type(16))) float f32x16;
typedef __attribute__((ext_vector_type(4))) unsigned u32x4;

#define DEV __device__ __forceinline__

constexpr size_t OUT_AK = 8388608, OUT_AV = 8912896, OUT_RF = 9437184, OUT_RB = 9961472,
                 OUT_CK = 10485760, OUT_CV = 12582912, OUT_DK = 14680064, OUT_DV = 15204352;
constexpr float LAM_INIT = 0.35550906f;

struct Params {
  const float *xp, *xs, *c, *cctx, *cak, *cav, *srf, *srb, *cck, *ccv, *cdk, *cdv;
  const float *mod_w, *mod_b, *norm_mix, *norm_ffn, *norm_final;
  const float *ev_w_in, *ev_w_out, *a_q_norm, *a_k_norm, *rdf, *rdb;
  const float *od_w_in, *od_w_out, *lq1, *lk1, *lq2, *lk2, *subln, *dsink;
  const float *peer_wq, *peer_sk, *peer_u, *peer_v;
  float* out;
  char* ws;
  __device__ __forceinline__ unsigned* BAR() const { return (unsigned*)(ws + 0ull); }
  __device__ __forceinline__ float* MOD() const { return (float*)(ws + 13824ull); }
  __device__ __forceinline__ float* ROPEC() const { return (float*)(ws + 259584ull); }
  __device__ __forceinline__ float* ROPES() const { return (float*)(ws + 390656ull); }
  __device__ __forceinline__ float* X() const { return (float*)(ws + 521728ull); }
  __device__ __forceinline__ float* SC() const { return (float*)(ws + 34076160ull); }
  __device__ __forceinline__ u16* WT_EVIN() const { return (u16*)(ws + 101185024ull); }
  __device__ __forceinline__ u16* WT_EVOUT() const { return (u16*)(ws + 106952192ull); }
  __device__ __forceinline__ u16* WT_ODIN() const { return (u16*)(ws + 109049344ull); }
  __device__ __forceinline__ u16* WT_ODOUT() const { return (u16*)(ws + 113767936ull); }
  __device__ __forceinline__ u16* WT_PQ() const { return (u16*)(ws + 115865088ull); }
  __device__ __forceinline__ u16* SUBK() const { return (u16*)(ws + 124253696ull); }
  __device__ __forceinline__ unsigned char* U8() const { return (unsigned char*)(ws + 125302272ull); }
  __device__ __forceinline__ unsigned char* V8() const { return (unsigned char*)(ws + 158856704ull); }
  __device__ __forceinline__ float* SU() const { return (float*)(ws + 192411136ull); }
  __device__ __forceinline__ float* SV() const { return (float*)(ws + 192542208ull); }
  __device__ __forceinline__ u16* H() const { return (u16*)(ws + 192673280ull); }
  __device__ __forceinline__ u16* MIX() const { return (u16*)(ws + 209450496ull); }
  __device__ __forceinline__ u16* Q1() const { return (u16*)(ws + 226227712ull); }
  __device__ __forceinline__ u16* Q2() const { return (u16*)(ws + 234616320ull); }
  __device__ __forceinline__ u16* SG() const { return (u16*)(ws + 243004928ull); }
  __device__ __forceinline__ u16* KA() const { return (u16*)(ws + 251393536ull); }
  __device__ __forceinline__ u16* VA() const { return (u16*)(ws + 253752832ull); }
  __device__ __forceinline__ u16* RK() const { return (u16*)(ws + 256112128ull); }
  __device__ __forceinline__ u16* RV() const { return (u16*)(ws + 264500736ull); }
  __device__ __forceinline__ u16* KC() const { return (u16*)(ws + 272889344ull); }
  __device__ __forceinline__ u16* VC() const { return (u16*)(ws + 282326528ull); }
  __device__ __forceinline__ u16* KD() const { return (u16*)(ws + 291763712ull); }
  __device__ __forceinline__ u16* VD() const { return (u16*)(ws + 294123008ull); }
  __device__ __forceinline__ u16* PQ() const { return (u16*)(ws + 296482304ull); }
};

DEV float bf2f(unsigned b) { return __uint_as_float(b << 16); }
typedef __bf16 bf16v2 __attribute__((ext_vector_type(2)));
typedef float f32v2 __attribute__((ext_vector_type(2)));
DEV unsigned pack2(float a, float b) { f32v2 v = {a, b}; return __builtin_bit_cast(unsigned, __builtin_convertvector(v, bf16v2)); }
DEV u16 f2bf(float f) { return (u16)(pack2(f, 0.f) & 0xffffu); }
DEV float bflo(unsigned w) { return __uint_as_float(w << 16); }
DEV float bfhi(unsigned w) { return __uint_as_float(w & 0xffff0000u); }
DEV float silu_f(float v) { return v / (1.f + __expf(-v)); }
DEV float gelu_tanh(float a) {
  float z = 0.7978845608f * (a + 0.044715f * a * a * a);
  float e = __expf(2.f * z);
  float th = 1.f - 2.f / (e + 1.f);
  return 0.5f * a * (1.f + th);
}
template <int CTRL> DEV float dpp_f(float v) {
  return __int_as_float(__builtin_amdgcn_update_dpp(0, __float_as_int(v), CTRL, 0xF, 0xF, true));
}
template <int CTRL> DEV unsigned dpp_u(unsigned v) {
  return (unsigned)__builtin_amdgcn_update_dpp(0, (int)v, CTRL, 0xF, 0xF, true);
}
DEV float row_sum16(float v) {
  v += dpp_f<0xB1>(v); v += dpp_f<0x4E>(v); v += dpp_f<0x141>(v); v += dpp_f<0x140>(v); return v;
}
DEV float row_max16(float v) {
  v = fmaxf(v, dpp_f<0xB1>(v)); v = fmaxf(v, dpp_f<0x4E>(v)); v = fmaxf(v, dpp_f<0x141>(v)); v = fmaxf(v, dpp_f<0x140>(v)); return v;
}
DEV float rlane(float v, int l) { return __int_as_float(__builtin_amdgcn_readlane(__float_as_int(v), l)); }
DEV float wave_sum(float v) {
  v = row_sum16(v);
  return (rlane(v, 0) + rlane(v, 16)) + (rlane(v, 32) + rlane(v, 48));
}
DEV unsigned wave_max_u(unsigned v) {
  v = max(v, dpp_u<0xB1>(v)); v = max(v, dpp_u<0x4E>(v)); v = max(v, dpp_u<0x141>(v)); v = max(v, dpp_u<0x140>(v));
  unsigned a = (unsigned)__builtin_amdgcn_readlane((int)v, 0), b = (unsigned)__builtin_amdgcn_readlane((int)v, 16);
  unsigned c = (unsigned)__builtin_amdgcn_readlane((int)v, 32), d = (unsigned)__builtin_amdgcn_readlane((int)v, 48);
  return max(max(a, b), max(c, d));
}
DEV float half_sum32(float v) { v = row_sum16(v); return v + __shfl_xor(v, 16); }
DEV unsigned fkey(float f) { unsigned u = __float_as_uint(f); return (u & 0x80000000u) ? ~u : (u | 0x80000000u); }
DEV f32x16 mfma32(bf16x8 a, bf16x8 b, f32x16 c) { return __builtin_amdgcn_mfma_f32_32x32x16_bf16(a, b, c, 0, 0, 0); }
DEV void zero16(f32x16& v) {
#pragma unroll
  for (int i = 0; i < 16; i++) v[i] = 0.f;
}
DEV size_t kvoff(bool smp, int b, int hh, int tpos, int H, int DW, int LS, int off) {
  return smp ? (size_t)4096 * H * DW + ((size_t)(b * H + hh) * LS + off + tpos) * DW
             : ((size_t)(b * H + hh) * 256 + tpos) * DW;
}


DEV float wave_max_f(float v) {
  v = row_max16(v);
  return fmaxf(fmaxf(rlane(v, 0), rlane(v, 16)), fmaxf(rlane(v, 32), rlane(v, 48)));
}
DEV int wave_sum_i(int v) {
  v += (int)dpp_u<0xB1>((unsigned)v); v += (int)dpp_u<0x4E>((unsigned)v); v += (int)dpp_u<0x141>((unsigned)v); v += (int)dpp_u<0x140>((unsigned)v);
  return (__builtin_amdgcn_readlane(v, 0) + __builtin_amdgcn_readlane(v, 16)) + (__builtin_amdgcn_readlane(v, 32) + __builtin_amdgcn_readlane(v, 48));
}
DEV int mbcnt64(unsigned long long m) { return (int)__builtin_amdgcn_mbcnt_hi((unsigned)(m >> 32), __builtin_amdgcn_mbcnt_lo((unsigned)m, 0u)); }
template <bool SGN> DEV void prep_quant(const float* __restrict__ src, unsigned char* __restrict__ dst, float* __restrict__ scale, int row0) {
  int lane = threadIdx.x & 63, wave = threadIdx.x >> 6;
  int rbase = row0 + wave * 4;
  float4 v[4][4];
#pragma unroll
  for (int q = 0; q < 4; q++)
#pragma unroll
    for (int i = 0; i < 4; i++) v[q][i] = *(const float4*)(src + (size_t)(rbase + q) * 1024 + (i * 64 + lane) * 4);
#pragma unroll
  for (int q = 0; q < 4; q++) {
    float mx = 0.f;
#pragma unroll
    for (int i = 0; i < 4; i++) mx = fmaxf(mx, fmaxf(fmaxf(fabsf(v[q][i].x), fabsf(v[q][i].y)), fmaxf(fabsf(v[q][i].z), fabsf(v[q][i].w))));
    mx = wave_max_f(mx);
    float inv = mx > 0.f ? 127.f / mx : 0.f;
    unsigned w[4];
#pragma unroll
    for (int i = 0; i < 4; i++) {
      int off = SGN ? 0 : 128;
      unsigned b0 = (unsigned)((int)rintf(v[q][i].x * inv) + off) & 255u, b1 = (unsigned)((int)rintf(v[q][i].y * inv) + off) & 255u;
      unsigned b2 = (unsigned)((int)rintf(v[q][i].z * inv) + off) & 255u, b3 = (unsigned)((int)rintf(v[q][i].w * inv) + off) & 255u;
      w[i] = b0 | (b1 << 8) | (b2 << 16) | (b3 << 24);
    }
    *(uint4*)(dst + (size_t)(rbase + q) * 1024 + lane * 16) = make_uint4(w[0], w[1], w[2], w[3]);
    if (lane == 0) scale[rbase + q] = mx * (1.f / 127.f);
  }
}

DEV void prep_transpose(const float* __restrict__ W, int N, u16* __restrict__ Wt, int tile, float* sm) {
  int ntn = N >> 6; int kt = tile / ntn, nt = tile % ntn;
  int k0 = kt * 64, n0 = nt * 64; int t = threadIdx.x;
#pragma unroll
  for (int i = 0; i < 4; i++) {
    int k = (t >> 4) + 16 * i; int c4 = (t & 15) * 4;
    float4 v = *(const float4*)(W + (size_t)(k0 + k) * N + n0 + c4);
    sm[k * 65 + c4] = v.x; sm[k * 65 + c4 + 1] = v.y; sm[k * 65 + c4 + 2] = v.z; sm[k * 65 + c4 + 3] = v.w;
  }
  __syncthreads();
  int n = t >> 2, kc = (t & 3) * 16;
  unsigned pk[8];
#pragma unroll
  for (int j = 0; j < 8; j++) pk[j] = pack2(sm[(kc + 2 * j) * 65 + n], sm[(kc + 2 * j + 1) * 65 + n]);
  uint4* dst = (uint4*)(Wt + (size_t)(n0 + n) * 1024 + k0 + kc);
  dst[0] = make_uint4(pk[0], pk[1], pk[2], pk[3]);
  dst[1] = make_uint4(pk[4], pk[5], pk[6], pk[7]);
  __syncthreads();
}
DEV void conv_item(const float* __restrict__ src, u16* __restrict__ dst) {
  int t = threadIdx.x;
#pragma unroll
  for (int i = 0; i < 8; i++) {
    int e = (i * 256 + t) * 8;
    float4 a = *(const float4*)(src + e), b = *(const float4*)(src + e + 4);
    *(uint4*)(dst + e) = make_uint4(pack2(a.x, a.y), pack2(a.z, a.w), pack2(b.x, b.y), pack2(b.z, b.w));
  }
}
DEV void prep_mod(const Params& p, int it, float* sm) {
  int l = it / 96, n0 = (it % 96) * 64; int t = threadIdx.x;
  float* sc = sm;
  for (int i = t; i < 5120; i += 256) {
    int b = i >> 10, k = i & 1023;
    float v = (b == 0) ? p.cctx[k] : p.c[(b - 1) * 1024 + k];
    sc[i] = silu_f(v);
  }
  __syncthreads();
  int cq = t & 15, kg = t >> 4;
  float4 a0 = make_float4(0.f, 0.f, 0.f, 0.f), a1 = a0, a2 = a0, a3 = a0, a4 = a0;
  const float* w = p.mod_w + (size_t)l * 1024 * 6144 + n0 + cq * 4;
  for (int k0 = kg; k0 < 1024; k0 += 128) {
    float4 wv[8];
#pragma unroll
    for (int u = 0; u < 8; u++) wv[u] = *(const float4*)(w + (size_t)(k0 + 16 * u) * 6144);
#pragma unroll
    for (int u = 0; u < 8; u++) {
      int k = k0 + 16 * u;
      float s0 = sc[k], s1 = sc[1024 + k], s2 = sc[2048 + k], s3 = sc[3072 + k], s4 = sc[4096 + k];
      a0.x += s0 * wv[u].x; a0.y += s0 * wv[u].y; a0.z += s0 * wv[u].z; a0.w += s0 * wv[u].w;
      a1.x += s1 * wv[u].x; a1.y += s1 * wv[u].y; a1.z += s1 * wv[u].z; a1.w += s1 * wv[u].w;
      a2.x += s2 * wv[u].x; a2.y += s2 * wv[u].y; a2.z += s2 * wv[u].z; a2.w += s2 * wv[u].w;
      a3.x += s3 * wv[u].x; a3.y += s3 * wv[u].y; a3.z += s3 * wv[u].z; a3.w += s3 * wv[u].w;
      a4.x += s4 * wv[u].x; a4.y += s4 * wv[u].y; a4.z += s4 * wv[u].z; a4.w += s4 * wv[u].w;
    }
  }
  float* red = sm + 5120;
  *(float4*)(red + (kg * 5 + 0) * 64 + cq * 4) = a0; *(float4*)(red + (kg * 5 + 1) * 64 + cq * 4) = a1;
  *(float4*)(red + (kg * 5 + 2) * 64 + cq * 4) = a2; *(float4*)(red + (kg * 5 + 3) * 64 + cq * 4) = a3;
  *(float4*)(red + (kg * 5 + 4) * 64 + cq * 4) = a4;
  __syncthreads();
  if (t < 64) {
#pragma unroll
    for (int b = 0; b < 5; b++) {
      float s = 0.f;
#pragma unroll
      for (int g = 0; g < 16; g++) s += red[(g * 5 + b) * 64 + t];
      p.MOD()[(size_t)(l * 5 + b) * 6144 + n0 + t] = s + p.mod_b[l * 6144 + n0 + t];
    }
  }
  __syncthreads();
}
DEV void prep_cache(const Params& p, int it) {
  const float* src; u16* dst;
  if (it < 8)       { int ch = it;      src = p.cak + (size_t)ch * 16384; dst = p.KA() + (size_t)4096 * 2 * 64 + (size_t)ch * 1280 * 64; }
  else if (it < 16) { int ch = it - 8;  src = p.cav + (size_t)ch * 16384; dst = p.VA() + (size_t)4096 * 2 * 64 + (size_t)ch * 1280 * 64; }
  else if (it < 48) { int ch = it - 16; src = p.cck + (size_t)ch * 16384; dst = p.KC() + (size_t)4096 * 8 * 64 + (size_t)ch * 1280 * 64; }
  else if (it < 80) { int ch = (it - 48) >> 1, hf = (it - 48) & 1;
                      src = p.ccv + (size_t)ch * 32768 + hf * 16384; dst = p.VC() + (size_t)4096 * 4 * 128 + (size_t)ch * 1280 * 128 + hf * 16384; }
  else if (it < 88) { int ch = it - 80; src = p.cdk + (size_t)ch * 16384; dst = p.KD() + (size_t)4096 * 2 * 64 + (size_t)ch * 1280 * 64; }
  else              { int ch = it - 88; src = p.cdv + (size_t)ch * 16384; dst = p.VD() + (size_t)4096 * 2 * 64 + (size_t)ch * 1280 * 64; }
  conv_item(src, dst);
}
DEV void prep_rope(const Params& p, int it) {
  for (int i = 0; i < 16; i++) {
    int idx = it * 4096 + i * 256 + threadIdx.x;
    int tpos = idx >> 5, a = idx & 31;
    float pos = (a < 16) ? (float)(tpos >> 6) : (float)(tpos & 63);
    float inv = exp2f(-(float)(a & 15) * (13.287712379549449f / 16.f));
    float ang = pos * inv;
    p.ROPEC()[idx] = __cosf(ang); p.ROPES()[idx] = __sinf(ang);
  }
}
constexpr int PREP_T0 = 704, PREP_T1 = PREP_T0 + 256, PREP_T2 = PREP_T1 + 576, PREP_T3 = PREP_T2 + 256, PREP_T4 = PREP_T3 + 1024;
constexpr int PREP_U = PREP_T4 + 2048, PREP_V = PREP_U + 2048, PREP_SK = PREP_V + 32, PREP_CA = PREP_SK + 96, PREP_RO = PREP_CA + 8, PREP_MOD = PREP_RO + 192;
DEV void phase_prep(const Params& p, int bid, int nb, char* smem) {
  float* sm = (float*)smem;
  for (int it0 = bid; it0 < PREP_MOD; it0 += nb) {
    int it = (it0 < 192) ? (PREP_RO + it0) : (it0 - 192);
    if (it >= PREP_T4 && it < PREP_V) continue;
    if ((it >= PREP_T1 && it < PREP_T3) || (it >= PREP_T3 + 512 && it < PREP_T4)) continue;
    if (it < PREP_T0) prep_transpose(p.ev_w_in, 2816, p.WT_EVIN(), it, sm);
    else if (it < PREP_T1) prep_transpose(p.ev_w_out, 1024, p.WT_EVOUT(), it - PREP_T0, sm);
    else if (it < PREP_T2) prep_transpose(p.od_w_in, 2304, p.WT_ODIN(), it - PREP_T1, sm);
    else if (it < PREP_T3) prep_transpose(p.od_w_out, 1024, p.WT_ODOUT(), it - PREP_T2, sm);
    else if (it < PREP_T4) { int j = it - PREP_T3; int l = j >> 9; prep_transpose(p.peer_wq + (size_t)l * 1024 * 2048, 2048, p.WT_PQ() + (size_t)l * 2048 * 1024, j & 511, sm); }
    else if (it < PREP_V) { }
    else if (it < PREP_SK) { size_t o = (size_t)(it - PREP_V) * 16384; conv_item(p.peer_sk + o, p.SUBK() + o); }
    else if (it < PREP_CA) prep_cache(p, it - PREP_SK);
    else if (it < PREP_RO) prep_rope(p, it - PREP_CA);
    else prep_mod(p, it - PREP_RO, sm);
  }
}

DEV void phase_ada(const Params& p, int layer, const float* __restrict__ gain, int shift_i, int scale_i, bool from_input, int bid, int nb) {
  int wave = threadIdx.x >> 6, lane = threadIdx.x & 63;
  for (int T0 = (bid * 4 + wave) * 2; T0 < 8192; T0 += nb * 8) {
    float4 v[2][4]; float ss[2];
#pragma unroll
    for (int q = 0; q < 2; q++) {
      int T = T0 + q;
      const float* xr = from_input ? (T < 4096 ? p.xp + (size_t)T * 1024 : p.xs + (size_t)(T - 4096) * 1024) : p.X() + (size_t)T * 1024;
#pragma unroll
      for (int i = 0; i < 4; i++) v[q][i] = *(const float4*)(xr + (i * 64 + lane) * 4);
    }
    int mb = T0 < 4096 ? 0 : 1 + ((T0 - 4096) >> 10);
    const float* md = p.MOD() + (size_t)(layer * 5 + mb) * 6144;
    float4 g[4], sh[4], sc[4];
#pragma unroll
    for (int i = 0; i < 4; i++) {
      int col = (i * 64 + lane) * 4;
      g[i] = *(const float4*)(gain + col); sh[i] = *(const float4*)(md + shift_i * 1024 + col); sc[i] = *(const float4*)(md + scale_i * 1024 + col);
    }
#pragma unroll
    for (int q = 0; q < 2; q++) {
      float s2 = 0.f;
#pragma unroll
      for (int i = 0; i < 4; i++) s2 += v[q][i].x * v[q][i].x + v[q][i].y * v[q][i].y + v[q][i].z * v[q][i].z + v[q][i].w * v[q][i].w;
      ss[q] = wave_sum(s2);
    }
#pragma unroll
    for (int q = 0; q < 2; q++) {
      float rstd = rsqrtf(ss[q] * (1.f / 1024.f) + 1e-6f);
#pragma unroll
      for (int i = 0; i < 4; i++) {
        int col = (i * 64 + lane) * 4;
        float y0 = v[q][i].x * rstd * g[i].x * (1.f + sc[i].x) + sh[i].x, y1 = v[q][i].y * rstd * g[i].y * (1.f + sc[i].y) + sh[i].y;
        float y2 = v[q][i].z * rstd * g[i].z * (1.f + sc[i].z) + sh[i].z, y3 = v[q][i].w * rstd * g[i].w * (1.f + sc[i].w) + sh[i].w;
        *(uint2*)(p.H() + (size_t)(T0 + q) * 1024 + col) = make_uint2(pack2(y0, y1), pack2(y2, y3));
      }
    }
  }
}

#define GLOAD8(PA, PB) \
  ra0 = *(const u32x4*)(PA); ra1 = *(const u32x4*)((PA) + sa32); ra2 = *(const u32x4*)((PA) + 2 * sa32); ra3 = *(const u32x4*)((PA) + 3 * sa32); \
  rb0 = *(const u32x4*)(PB); rb1 = *(const u32x4*)((PB) + sb32); rb2 = *(const u32x4*)((PB) + 2 * sb32); rb3 = *(const u32x4*)((PB) + 3 * sb32);
#define GLOAD8N(PA, PB) \
  na0 = *(const u32x4*)(PA); na1 = *(const u32x4*)((PA) + sa32); na2 = *(const u32x4*)((PA) + 2 * sa32); na3 = *(const u32x4*)((PA) + 3 * sa32); \
  nb0 = *(const u32x4*)(PB); nb1 = *(const u32x4*)((PB) + sb32); nb2 = *(const u32x4*)((PB) + 2 * sb32); nb3 = *(const u32x4*)((PB) + 3 * sb32);
#define GSTORE8(BUF) { u16* wa_ = (u16*)(smem + (BUF) * 36864) + lrow * 72 + lkc; u16* wb_ = wa_ + 128 * 72; \
  *(u32x4*)(wa_) = ra0; *(u32x4*)(wa_ + 32 * 72) = ra1; *(u32x4*)(wa_ + 64 * 72) = ra2; *(u32x4*)(wa_ + 96 * 72) = ra3; \
  *(u32x4*)(wb_) = rb0; *(u32x4*)(wb_ + 32 * 72) = rb1; *(u32x4*)(wb_ + 64 * 72) = rb2; *(u32x4*)(wb_ + 96 * 72) = rb3; }
DEV void gemm_tile(const u16* __restrict__ A, int lda, const u16* __restrict__ B, int ldb, int K, char* smem, f32x16 (&acc)[2][2]) {
  int t = threadIdx.x, lane = t & 63, wave = t >> 6, r = lane & 31, h = lane >> 5;
  int wm = wave >> 1, wn = wave & 1;
  int lrow = t >> 3, lkc = (t & 7) * 8;
  const u16* ap = A + (size_t)lrow * lda + lkc;
  const u16* bp = B + (size_t)lrow * ldb + lkc;
  size_t sa32 = (size_t)32 * lda, sb32 = (size_t)32 * ldb;
  u32x4 ra0, ra1, ra2, ra3, rb0, rb1, rb2, rb3;
  u32x4 na0, na1, na2, na3, nb0, nb1, nb2, nb3;
  int nk = K >> 6;
#define GSTORE8N(BUF) { u16* wa_ = (u16*)(smem + (BUF) * 36864) + lrow * 72 + lkc; u16* wb_ = wa_ + 128 * 72; \
  *(u32x4*)(wa_) = na0; *(u32x4*)(wa_ + 32 * 72) = na1; *(u32x4*)(wa_ + 64 * 72) = na2; *(u32x4*)(wa_ + 96 * 72) = na3; \
  *(u32x4*)(wb_) = nb0; *(u32x4*)(wb_ + 32 * 72) = nb1; *(u32x4*)(wb_ + 64 * 72) = nb2; *(u32x4*)(wb_ + 96 * 72) = nb3; }
#define GCOMPUTE(BUF) { const u16* sA = (const u16*)(smem + (BUF) * 36864); const u16* sB = sA + 128 * 72; \
    _Pragma("unroll") for (int kk = 0; kk < 4; kk++) { \
      bf16x8 a0 = *(const bf16x8*)(sA + (wm * 64 + r) * 72 + kk * 16 + h * 8); \
      bf16x8 a1 = *(const bf16x8*)(sA + (wm * 64 + 32 + r) * 72 + kk * 16 + h * 8); \
      bf16x8 b0 = *(const bf16x8*)(sB + (wn * 64 + r) * 72 + kk * 16 + h * 8); \
      bf16x8 b1 = *(const bf16x8*)(sB + (wn * 64 + 32 + r) * 72 + kk * 16 + h * 8); \
      acc[0][0] = mfma32(a0, b0, acc[0][0]); acc[0][1] = mfma32(a0, b1, acc[0][1]); \
      acc[1][0] = mfma32(a1, b0, acc[1][0]); acc[1][1] = mfma32(a1, b1, acc[1][1]); } }
  GLOAD8(ap, bp)
  __syncthreads();
  GSTORE8(0)
  if (nk > 1) { GLOAD8(ap + 64, bp + 64) }
  na0 = ra0; na1 = ra1; na2 = ra2; na3 = ra3; nb0 = rb0; nb1 = rb1; nb2 = rb2; nb3 = rb3;
  __syncthreads();
  for (int kt = 0; kt < nk; kt += 2) {
    if (kt + 2 < nk) { GLOAD8N(ap + (kt + 2) * 64, bp + (kt + 2) * 64) }
    GCOMPUTE(0)
    if (kt + 1 < nk) { GSTORE8(1) }
    __syncthreads();
    if (kt + 1 < nk) {
      if (kt + 3 < nk) { GLOAD8(ap + (kt + 3) * 64, bp + (kt + 3) * 64) }
      GCOMPUTE(1)
      if (kt + 2 < nk) { GSTORE8N(0) }
      __syncthreads();
    }
  }
  __syncthreads();
  float* Cs = (float*)smem;
#pragma unroll
  for (int i = 0; i < 2; i++)
#pragma unroll
    for (int j = 0; j < 2; j++)
#pragma unroll
      for (int g = 0; g < 16; g++)
        Cs[(wm * 64 + i * 32 + (g & 3) + 8 * (g >> 2) + 4 * h) * 128 + wn * 64 + j * 32 + r] = acc[i][j][g];
  __syncthreads();
}

DEV bool xcd_tile(int li, int bid, int NTl, int& mt, int& nt) {
  if (li >= 8 * NTl) return false;
  mt = 8 * (bid & 7) + (li & 7); nt = li >> 3; return true;
}
template <class Epi>
DEV void gemm_phase(const u16* A, int lda, const u16* Bt, int ldb, int K, int MT, int NTl, int bid, int nb, char* smem, Epi epi) {
  if ((nb & 7) == 0 && MT == 64) {
    int mt, nt;
    for (int li = bid >> 3; xcd_tile(li, bid, NTl, mt, nt); li += nb >> 3) {
      f32x16 acc[2][2];
      zero16(acc[0][0]); zero16(acc[0][1]); zero16(acc[1][0]); zero16(acc[1][1]);
      gemm_tile(A + (size_t)mt * 128 * lda, lda, Bt + (size_t)nt * 128 * ldb, ldb, K, smem, acc);
      epi(mt * 128, nt * 128, (const float*)smem);
    }
  } else {
    for (int it = bid; it < MT * NTl; it += nb) {
      int mt = it / NTl, nt = it % NTl;
      f32x16 acc[2][2];
      zero16(acc[0][0]); zero16(acc[0][1]); zero16(acc[1][0]); zero16(acc[1][1]);
      gemm_tile(A + (size_t)mt * 128 * lda, lda, Bt + (size_t)nt * 128 * ldb, ldb, K, smem, acc);
      epi(mt * 128, nt * 128, (const float*)smem);
    }
  }
}

DEV void tok_decode(int T, bool& smp, int& b, int& tpos) {
  smp = T >= 4096;
  if (!smp) { b = T >> 8; tpos = T & 255; } else { b = (T - 4096) >> 10; tpos = (T - 4096) & 1023; }
}
DEV void rope_pair(const Params& p, float& x, float& y, int tpos, int d) {
  float px = __shfl_xor(x, 16), py = __shfl_xor(y, 16);
  int a = d & 31;
  float c0 = p.ROPEC()[tpos * 32 + a], c1 = p.ROPEC()[tpos * 32 + a + 1];
  float s0 = p.ROPES()[tpos * 32 + a], s1 = p.ROPES()[tpos * 32 + a + 1];
  if (d < 32) { x = x * c0 - px * s0; y = y * c1 - py * s1; }
  else        { x = px * s0 + x * c0; y = py * s1 + y * c1; }
}

DEV void rope_apply(float& x, float& y, float4 cs, int d) {
  float px = __shfl_xor(x, 16), py = __shfl_xor(y, 16);
  if (d < 32) { x = x * cs.x - px * cs.z; y = y * cs.y - py * cs.w; }
  else        { x = px * cs.z + x * cs.x; y = py * cs.w + y * cs.y; }
}
DEV float4 rope_cs(const Params& p, int tpos, int d) {
  int a = d & 31;
  float2 c = *(const float2*)(p.ROPEC() + tpos * 32 + a), s = *(const float2*)(p.ROPES() + tpos * 32 + a);
  return make_float4(c.x, c.y, s.x, s.y);
}
template <int SEG, bool SMP>
DEV void epi0_rows(const Params& p, int m0, int n0, const float* Cs) {
  int lane = threadIdx.x & 63, wave = threadIdx.x >> 6;
  int col = n0 + lane * 2; int d = col & 63;
  float g0 = 1.f, g1 = 1.f;
  if (SEG == 0) { g0 = p.a_q_norm[d]; g1 = p.a_q_norm[d + 1]; }
  if (SEG == 1) { g0 = p.a_k_norm[d]; g1 = p.a_k_norm[d + 1]; }
  int segbase = SEG == 0 ? 0 : SEG == 1 ? 512 : SEG == 2 ? 640 : SEG == 3 ? 768 : SEG == 4 ? 1280 : SEG == 5 ? 1792 : 2304;
  int hh = (col - segbase) >> 6;
#pragma unroll 4
  for (int i = 0; i < 32; i++) {
    int rr = wave + 4 * i;
    int T = m0 + rr;
    int b = SMP ? (T - 4096) >> 10 : T >> 8;
    int tpos = SMP ? (T - 4096) & 1023 : T & 255;
    float2 c = *(const float2*)(Cs + rr * 128 + lane * 2);
    if (SEG <= 1) {
      float4 cs = make_float4(1.f, 1.f, 0.f, 0.f);
      if (SMP) cs = rope_cs(p, tpos, d);
      float ss = half_sum32(c.x * c.x + c.y * c.y);
      float rstd = rsqrtf(ss * (1.f / 64.f) + 1e-6f);
      c.x *= rstd * g0; c.y *= rstd * g1;
      if (SMP) rope_apply(c.x, c.y, cs, d);
    }
    if (SEG == 0) *(unsigned*)(p.Q1() + (size_t)T * 512 + col) = pack2(c.x * 0.18033688011112042f, c.y * 0.18033688011112042f);
    if (SEG == 1) {
      *(unsigned*)(p.KA() + kvoff(SMP, b, hh, tpos, 2, 64, 1280, 256) + d) = pack2(c.x, c.y);
      if (!SMP) *(float2*)(p.out + OUT_AK + ((size_t)(b * 2 + hh) * 256 + tpos) * 64 + d) = c;
    }
    if (SEG == 2) {
      *(unsigned*)(p.VA() + kvoff(SMP, b, hh, tpos, 2, 64, 1280, 256) + d) = pack2(c.x, c.y);
      if (!SMP) *(float2*)(p.out + OUT_AV + ((size_t)(b * 2 + hh) * 256 + tpos) * 64 + d) = c;
    }
    if (SEG == 3) *(unsigned*)(p.Q2() + (size_t)T * 512 + (col - 768)) = pack2(c.x, c.y);
    if (SEG == 4) *(unsigned*)(p.RK() + kvoff(SMP, b, hh, tpos, 8, 64, 1024, 0) + d) = pack2(c.x * 0.125f, c.y * 0.125f);
    if (SEG == 5) *(unsigned*)(p.RV() + kvoff(SMP, b, hh, tpos, 8, 64, 1024, 0) + d) = pack2(c.x, c.y);
    if (SEG == 6) *(unsigned*)(p.SG() + (size_t)T * 512 + (col - 2304)) = pack2(silu_f(c.x), silu_f(c.y));
  }
}
template <bool SMP> DEV void epi0_disp(const Params& p, int m0, int n0, const float* Cs) {
  if (n0 < 512) epi0_rows<0, SMP>(p, m0, n0, Cs);
  else if (n0 < 640) epi0_rows<1, SMP>(p, m0, n0, Cs);
  else if (n0 < 768) epi0_rows<2, SMP>(p, m0, n0, Cs);
  else if (n0 < 1280) epi0_rows<3, SMP>(p, m0, n0, Cs);
  else if (n0 < 1792) epi0_rows<4, SMP>(p, m0, n0, Cs);
  else if (n0 < 2304) epi0_rows<5, SMP>(p, m0, n0, Cs);
  else epi0_rows<6, SMP>(p, m0, n0, Cs);
}
DEV void epi_inproj0(const Params& p, int m0, int n0, const float* Cs) {
  if (m0 >= 4096) epi0_disp<true>(p, m0, n0, Cs); else epi0_disp<false>(p, m0, n0, Cs);
}
template <int SEG, bool SMP>
DEV void epi1_rows(const Params& p, int m0, int n0, const float* Cs) {
  int lane = threadIdx.x & 63, wave = threadIdx.x >> 6;
  int col = n0 + lane * 2; int d = col & 63;
  int segbase = SEG == 0 ? 0 : SEG == 1 ? 512 : SEG == 2 ? 1024 : SEG == 3 ? 1536 : SEG == 4 ? 2048 : 2176;
  int hh = (SEG == 2) ? (col - segbase) >> 7 : (col - segbase) >> 6;
  int dd = (col - 1024) & 127;
  constexpr bool ROPE = SMP && (SEG == 0 || SEG == 1 || SEG == 3 || SEG == 4);
#pragma unroll 4
  for (int i = 0; i < 32; i++) {
    int rr = wave + 4 * i;
    int T = m0 + rr;
    int b = SMP ? (T - 4096) >> 10 : T >> 8;
    int tpos = SMP ? (T - 4096) & 1023 : T & 255;
    float2 c = *(const float2*)(Cs + rr * 128 + lane * 2);
    if (!SMP) {
      if (SEG == 1) *(float2*)(p.out + OUT_CK + ((size_t)(b * 8 + hh) * 256 + tpos) * 64 + d) = c;
      if (SEG == 2) *(float2*)(p.out + OUT_CV + ((size_t)(b * 4 + hh) * 256 + tpos) * 128 + dd) = c;
      if (SEG == 4) *(float2*)(p.out + OUT_DK + ((size_t)(b * 2 + hh) * 256 + tpos) * 64 + d) = c;
      if (SEG == 5) *(float2*)(p.out + OUT_DV + ((size_t)(b * 2 + hh) * 256 + tpos) * 64 + d) = c;
    }
    if (ROPE) { float4 cs = rope_cs(p, tpos, d); rope_apply(c.x, c.y, cs, d); }
    if (SEG == 0) *(unsigned*)(p.Q1() + (size_t)T * 512 + col) = pack2(c.x * 0.18033688011112042f, c.y * 0.18033688011112042f);
    if (SEG == 1) *(unsigned*)(p.KC() + kvoff(SMP, b, hh, tpos, 8, 64, 1280, 256) + d) = pack2(c.x, c.y);
    if (SEG == 2) *(unsigned*)(p.VC() + kvoff(SMP, b, hh, tpos, 4, 128, 1280, 256) + dd) = pack2(c.x, c.y);
    if (SEG == 3) *(unsigned*)(p.Q2() + (size_t)T * 512 + (col - 1536)) = pack2(c.x * 0.18033688011112042f, c.y * 0.18033688011112042f);
    if (SEG == 4) *(unsigned*)(p.KD() + kvoff(SMP, b, hh, tpos, 2, 64, 1280, 256) + d) = pack2(c.x, c.y);
    if (SEG == 5) *(unsigned*)(p.VD() + kvoff(SMP, b, hh, tpos, 2, 64, 1280, 256) + d) = pack2(c.x, c.y);
  }
}
template <bool SMP> DEV void epi1_disp(const Params& p, int m0, int n0, const float* Cs) {
  if (n0 < 512) epi1_rows<0, SMP>(p, m0, n0, Cs);
  else if (n0 < 1024) epi1_rows<1, SMP>(p, m0, n0, Cs);
  else if (n0 < 1536) epi1_rows<2, SMP>(p, m0, n0, Cs);
  else if (n0 < 2048) epi1_rows<3, SMP>(p, m0, n0, Cs);
  else if (n0 < 2176) epi1_rows<4, SMP>(p, m0, n0, Cs);
  else epi1_rows<5, SMP>(p, m0, n0, Cs);
}
DEV void epi_inproj1(const Params& p, int m0, int n0, const float* Cs) {
  if (m0 >= 4096) epi1_disp<true>(p, m0, n0, Cs); else epi1_disp<false>(p, m0, n0, Cs);
}
DEV void epi_outproj(const Params& p, int layer, int m0, int n0, const float* Cs) {
  int lane = threadIdx.x & 63, wave = threadIdx.x >> 6;
  int mb = m0 < 4096 ? 0 : 1 + ((m0 - 4096) >> 10);
  int col = n0 + lane * 2;
  float2 g = *(const float2*)(p.MOD() + (size_t)(layer * 5 + mb) * 6144 + 2048 + col);
  const float* xbase = (layer == 0) ? (m0 < 4096 ? p.xp + (size_t)m0 * 1024 : p.xs + (size_t)(m0 - 4096) * 1024) : p.X() + (size_t)m0 * 1024;
#pragma unroll 8
  for (int i = 0; i < 32; i++) {
    int rr = wave + 4 * i;
    float2 c = *(const float2*)(Cs + rr * 128 + lane * 2);
    float2 x = *(const float2*)(xbase + (size_t)rr * 1024 + col);
    x.x += g.x * c.x; x.y += g.y * c.y;
    *(float2*)(p.X() + (size_t)(m0 + rr) * 1024 + col) = x;
  }
}

constexpr int ATT_BUF = 37888;
struct TileRegs { u32x4 k0, k1, k2, k3, v0, v1, v2, v3; };
template <int DV, bool TWOK> DEV TileRegs tile_load(const u16* __restrict__ k, const u16* __restrict__ k2, const u16* __restrict__ v) {
  int t = threadIdx.x, lane = t & 63, wave = t >> 6;
  TileRegs R;
  u32x4 z = {0u, 0u, 0u, 0u};
  R.k0 = *(const u32x4*)(k + t * 8); R.k1 = *(const u32x4*)(k + (t + 256) * 8);
  if (TWOK) { R.k2 = *(const u32x4*)(k2 + t * 8); R.k3 = *(const u32x4*)(k2 + (t + 256) * 8); } else { R.k2 = z; R.k3 = z; }
  R.v0 = *(const u32x4*)(v + (size_t)lane * DV + wave * 8); R.v1 = *(const u32x4*)(v + (size_t)lane * DV + (wave + 4) * 8);
  if (DV == 128) { R.v2 = *(const u32x4*)(v + (size_t)lane * DV + (wave + 8) * 8); R.v3 = *(const u32x4*)(v + (size_t)lane * DV + (wave + 12) * 8); } else { R.v2 = z; R.v3 = z; }
  return R;
}
DEV void store8t(u16* d, u32x4 x) {
  d[0 * 76] = (u16)(x[0] & 0xffff); d[1 * 76] = (u16)(x[0] >> 16);
  d[2 * 76] = (u16)(x[1] & 0xffff); d[3 * 76] = (u16)(x[1] >> 16);
  d[4 * 76] = (u16)(x[2] & 0xffff); d[5 * 76] = (u16)(x[2] >> 16);
  d[6 * 76] = (u16)(x[3] & 0xffff); d[7 * 76] = (u16)(x[3] >> 16);
}
template <int DV, bool TWOK> DEV void tile_store(const TileRegs R, char* buf) {
  int t = threadIdx.x, lane = t & 63, wave = t >> 6;
  u16* sK = (u16*)buf; u16* sK2 = sK + 64 * 72; u16* sVT = sK + 2 * 64 * 72;
  int key = t >> 3, dc = t & 7;
  *(u32x4*)(sK + key * 72 + dc * 8) = R.k0; *(u32x4*)(sK + (key + 32) * 72 + dc * 8) = R.k1;
  if (TWOK) { *(u32x4*)(sK2 + key * 72 + dc * 8) = R.k2; *(u32x4*)(sK2 + (key + 32) * 72 + dc * 8) = R.k3; }
  store8t(sVT + (wave * 8) * 76 + lane, R.v0); store8t(sVT + ((wave + 4) * 8) * 76 + lane, R.v1);
  if (DV == 128) { store8t(sVT + ((wave + 8) * 8) * 76 + lane, R.v2); store8t(sVT + ((wave + 12) * 8) * 76 + lane, R.v3); }
}
DEV void load_ident_k(u16* sK) {
  int t = threadIdx.x;
#pragma unroll
  for (int i = 0; i < 2; i++) {
    int c = t + 256 * i; int key = c >> 3, dc = c & 7;
    unsigned w[4] = {0u, 0u, 0u, 0u};
    uint4 z = make_uint4(0u, 0u, 0u, 0u);
    if (dc == (key >> 3)) {
      int e = key & 7; unsigned one = (e & 1) ? 0x3F800000u : 0x00003F80u;
      if ((e >> 1) == 0) z.x = one; else if ((e >> 1) == 1) z.y = one; else if ((e >> 1) == 2) z.z = one; else z.w = one;
    }
    (void)w;
    *(uint4*)(sK + key * 72 + dc * 8) = z;
  }
}
DEV void load_state_v(const float* __restrict__ S0, u16* sVT) {
  int lane = threadIdx.x & 63, wave = threadIdx.x >> 6;
#pragma unroll
  for (int i = 0; i < 2; i++) {
    int dc = wave + 4 * i;
    float4 a = *(const float4*)(S0 + lane * 64 + dc * 8), b = *(const float4*)(S0 + lane * 64 + dc * 8 + 4);
    u16* d = sVT + (dc * 8) * 76 + lane;
    d[0 * 76] = f2bf(a.x); d[1 * 76] = f2bf(a.y); d[2 * 76] = f2bf(a.z); d[3 * 76] = f2bf(a.w);
    d[4 * 76] = f2bf(b.x); d[5 * 76] = f2bf(b.y); d[6 * 76] = f2bf(b.z); d[7 * 76] = f2bf(b.w);
  }
}
template <int DV, class F>
DEV void attn_compute(const bf16x8 (&qf)[4], f32x16 (&o)[DV / 32], const u16* sK, const u16* sVT, F&& xform) {
  int lane = threadIdx.x & 63, r = lane & 31, h = lane >> 5;
  f32x16 st[2]; zero16(st[0]); zero16(st[1]);
#pragma unroll
  for (int sub = 0; sub < 2; sub++)
#pragma unroll
    for (int kk = 0; kk < 4; kk++) {
      bf16x8 kf = *(const bf16x8*)(sK + (sub * 32 + r) * 72 + kk * 16 + h * 8);
      st[sub] = mfma32(kf, qf[kk], st[sub]);
    }
  xform(st);
  bf16x8 pf[2][2];
#pragma unroll
  for (int sub = 0; sub < 2; sub++)
#pragma unroll
    for (int s = 0; s < 2; s++) {
      u32x4 w;
      w[0] = pack2(st[sub][8 * s + 0], st[sub][8 * s + 1]); w[1] = pack2(st[sub][8 * s + 2], st[sub][8 * s + 3]);
      w[2] = pack2(st[sub][8 * s + 4], st[sub][8 * s + 5]); w[3] = pack2(st[sub][8 * s + 6], st[sub][8 * s + 7]);
      pf[sub][s] = __builtin_bit_cast(bf16x8, w);
    }
#pragma unroll
  for (int ds = 0; ds < DV / 32; ds++)
#pragma unroll
    for (int sub = 0; sub < 2; sub++)
#pragma unroll
      for (int s = 0; s < 2; s++) {
        const u16* vp = sVT + (ds * 32 + r) * 76 + sub * 32 + s * 16 + 4 * h;
        uint2 lo = *(const uint2*)vp, hi = *(const uint2*)(vp + 8);
        u32x4 w; w[0] = lo.x; w[1] = lo.y; w[2] = hi.x; w[3] = hi.y;
        o[ds] = mfma32(__builtin_bit_cast(bf16x8, w), pf[sub][s], o[ds]);
      }
}
template <int DV, class F>
DEV void attn_compute_sub(const bf16x8 (&qf)[4], f32x16 (&o)[DV / 32], const u16* sK, const u16* sVT, F&& xform) {
  int lane = threadIdx.x & 63, r = lane & 31, h = lane >> 5;
#pragma unroll
  for (int sub = 0; sub < 2; sub++) {
    f32x16 st; zero16(st);
#pragma unroll
    for (int kk = 0; kk < 4; kk++) {
      bf16x8 kf = *(const bf16x8*)(sK + (sub * 32 + r) * 72 + kk * 16 + h * 8);
      st = mfma32(kf, qf[kk], st);
    }
    xform(sub, st);
    bf16x8 pf[2];
#pragma unroll
    for (int s2 = 0; s2 < 2; s2++) {
      u32x4 w;
      w[0] = pack2(st[8 * s2 + 0], st[8 * s2 + 1]); w[1] = pack2(st[8 * s2 + 2], st[8 * s2 + 3]);
      w[2] = pack2(st[8 * s2 + 4], st[8 * s2 + 5]); w[3] = pack2(st[8 * s2 + 6], st[8 * s2 + 7]);
      pf[s2] = __builtin_bit_cast(bf16x8, w);
    }
#pragma unroll
    for (int ds = 0; ds < DV / 32; ds++)
#pragma unroll
      for (int s2 = 0; s2 < 2; s2++) {
        const u16* vp = sVT + (ds * 32 + r) * 76 + sub * 32 + s2 * 16 + 4 * h;
        uint2 lo = *(const uint2*)vp, hi = *(const uint2*)(vp + 8);
        u32x4 w; w[0] = lo.x; w[1] = lo.y; w[2] = hi.x; w[3] = hi.y;
        o[ds] = mfma32(__builtin_bit_cast(bf16x8, w), pf[s2], o[ds]);
      }
  }
}
template <int DV>
DEV void softmax_xform1(f32x16& st, f32x16 (&o)[DV / 32], float& m, float& l) {
  float mx = -1e30f;
#pragma unroll
  for (int g = 0; g < 16; g++) mx = fmaxf(mx, st[g]);
  mx = fmaxf(mx, __shfl_xor(mx, 32));
  float mnew = fmaxf(m, mx);
  float alpha = __builtin_amdgcn_exp2f(m - mnew);
  m = mnew;
  float ls = 0.f;
#pragma unroll
  for (int g = 0; g < 16; g++) { float pv = __builtin_amdgcn_exp2f(st[g] - mnew); st[g] = pv; ls += pv; }
  l = l * alpha + ls;
#pragma unroll
  for (int ds = 0; ds < DV / 32; ds++)
#pragma unroll
    for (int g = 0; g < 16; g++) o[ds][g] *= alpha;
}
template <int DV, bool TWOK, class PF, class XF, class XF1>
DEV void attn_loop(int n, PF&& ptrs, const bf16x8 (&qf)[4], f32x16 (&o)[DV / 32], char* smem, XF&& xf, XF1&& xf1) {
  int wave = threadIdx.x >> 6;
  int kofs = (TWOK && wave >= 2) ? 64 * 72 : 0;
  TileRegs R;
  const u16 *kp, *kp2, *vp;
  ptrs(0, kp, kp2, vp); R = tile_load<DV, TWOK>(kp, kp2, vp);
  __syncthreads();
  tile_store<DV, TWOK>(R, smem);
  if (n > 1) { ptrs(1, kp, kp2, vp); R = tile_load<DV, TWOK>(kp, kp2, vp); }
  __syncthreads();
  const u16* b0k = (const u16*)smem + kofs; const u16* b0v = (const u16*)smem + 2 * 64 * 72;
  const u16* b1k = (const u16*)(smem + ATT_BUF) + kofs; const u16* b1v = (const u16*)(smem + ATT_BUF) + 2 * 64 * 72;
  for (int ti = 0; ti < n; ti++) {
    const u16* bk = (ti & 1) ? b1k : b0k; const u16* bv = (ti & 1) ? b1v : b0v;
    if constexpr (DV == 128) attn_compute_sub<DV>(qf, o, bk, bv, [&](int sub, f32x16& st) { xf1(ti, sub, st); });
    else attn_compute<DV>(qf, o, bk, bv, [&](f32x16 (&st)[2]) { xf(ti, st); });
    if (ti + 1 < n) tile_store<DV, TWOK>(R, smem + ((ti + 1) & 1) * ATT_BUF);
    if (ti + 2 < n) { ptrs(ti + 2, kp, kp2, vp); R = tile_load<DV, TWOK>(kp, kp2, vp); }
    __syncthreads();
  }
}
template <int DV>
DEV void softmax_xform(f32x16 (&st)[2], f32x16 (&o)[DV / 32], float& m, float& l, bool masked, int kpos0, int qpos) {
  int h = (threadIdx.x & 63) >> 5;
  float mx = -1e30f;
#pragma unroll
  for (int sub = 0; sub < 2; sub++)
#pragma unroll
    for (int g = 0; g < 16; g++) {
      float s = st[sub][g];
      if (masked) {
        int j = kpos0 + sub * 32 + (g & 3) + 8 * (g >> 2) + 4 * h;
        int dl = qpos - j; if (dl < 0) dl = -dl;
        if (dl > 128) s = -1e30f;
        st[sub][g] = s;
      }
      mx = fmaxf(mx, s);
    }
  mx = fmaxf(mx, __shfl_xor(mx, 32));
  float mnew = fmaxf(m, mx);
  float alpha = __builtin_amdgcn_exp2f(m - mnew);
  m = mnew;
  float ls = 0.f;
#pragma unroll
  for (int sub = 0; sub < 2; sub++)
#pragma unroll
    for (int g = 0; g < 16; g++) { float pv = __builtin_amdgcn_exp2f(st[sub][g] - mnew); st[sub][g] = pv; ls += pv; }
  l = l * alpha + ls;
#pragma unroll
  for (int ds = 0; ds < DV / 32; ds++)
#pragma unroll
    for (int g = 0; g < 16; g++) o[ds][g] *= alpha;
}

template <int DV, bool TWOK>
DEV void attn_softmax_job(const Params& p, const u16* Q, int Tq0, int qcol, const u16* kb, const u16* kb2, const u16* vb,
                          int nplain, int band_lo, int band_hi, int qpos0, bool use_sink, float sinkv,
                          f32x16 (&o)[DV / 32], char* smem) {
  int lane = threadIdx.x & 63, wave = threadIdx.x >> 6, r = lane & 31, h = lane >> 5;
  int qrow = TWOK ? (wave & 1) * 32 : wave * 32;
  bf16x8 qf[4];
#pragma unroll
  for (int kk = 0; kk < 4; kk++) qf[kk] = *(const bf16x8*)(Q + (size_t)(Tq0 + qrow + r) * 512 + qcol + kk * 16 + h * 8);
#pragma unroll
  for (int ds = 0; ds < DV / 32; ds++) zero16(o[ds]);
  float m = use_sink ? sinkv : -1e30f;
  float l = (use_sink && h == 0) ? 1.f : 0.f;
  int qpos = qpos0 + qrow + r;
  int ntot = nplain + (band_hi - band_lo);
  attn_loop<DV, TWOK>(ntot,
    [&](int ti, const u16*& kp, const u16*& kp2, const u16*& vp) {
      int key0 = (ti >= nplain) ? (256 + (band_lo + ti - nplain) * 64) : ti * 64;
      kp = kb + (size_t)key0 * 64; kp2 = kb2 + (size_t)key0 * 64; vp = vb + (size_t)key0 * DV;
    }, qf, o, smem,
    [&](int ti, f32x16 (&st)[2]) {
      bool masked = ti >= nplain;
      int kpos0 = (band_lo + ti - nplain) * 64;
      softmax_xform<DV>(st, o, m, l, masked, kpos0, qpos);
    },
    [&](int ti, int sub, f32x16& st) { softmax_xform1<DV>(st, o, m, l); });
  float lt = l + __shfl_xor(l, 32);
  float inv = 1.f / lt;
#pragma unroll
  for (int ds = 0; ds < DV / 32; ds++)
#pragma unroll
    for (int g = 0; g < 16; g++) o[ds][g] *= inv;
}
DEV void store_o64(const Params& p, const f32x16 (&o)[2], int Tq0, int mixcol) {
  int lane = threadIdx.x & 63, wave = threadIdx.x >> 6, r = lane & 31, h = lane >> 5;
  int T = Tq0 + wave * 32 + r;
#pragma unroll
  for (int ds = 0; ds < 2; ds++)
#pragma unroll
    for (int g4 = 0; g4 < 4; g4++) {
      int d0 = ds * 32 + 8 * g4 + 4 * h;
      *(uint2*)(p.MIX() + (size_t)T * 1024 + mixcol + d0) =
          make_uint2(pack2(o[ds][4 * g4], o[ds][4 * g4 + 1]), pack2(o[ds][4 * g4 + 2], o[ds][4 * g4 + 3]));
    }
}

DEV void ret_job(const Params& p, bool smp, int b, int hh, int qb, char* smem) {
  u16* sK = (u16*)smem; u16* sVT = sK + 2 * 64 * 72;
  int lane = threadIdx.x & 63, wave = threadIdx.x >> 6, r = lane & 31, h = lane >> 5;
  int L = smp ? 1024 : 256;
  int Tq0 = (smp ? 4096 + b * 1024 : b * 256) + qb * 128;
  const u16* kb = p.RK() + kvoff(smp, b, hh, 0, 8, 64, 1024, 0);
  const u16* vb = p.RV() + kvoff(smp, b, hh, 0, 8, 64, 1024, 0);
  float xf = p.rdf[hh], xb = p.rdb[hh];
  float lf2 = -log1pf(__expf(-xf)) * 1.4426950408889634f;
  float lb2 = -log1pf(__expf(-xb)) * 1.4426950408889634f;
  bf16x8 qf[4];
#pragma unroll
  for (int kk = 0; kk < 4; kk++) qf[kk] = *(const bf16x8*)(p.Q2() + (size_t)(Tq0 + wave * 32 + r) * 512 + hh * 64 + kk * 16 + h * 8);
  f32x16 o[2]; zero16(o[0]); zero16(o[1]);
  int qpos = qb * 128 + wave * 32 + r;
  int nt = L / 64;
  attn_loop<64, false>(nt,
    [&](int ti, const u16*& kp, const u16*& kp2, const u16*& vp) { kp = kb + (size_t)ti * 4096; kp2 = kp; vp = vb + (size_t)ti * 4096; },
    qf, o, smem,
    [&](int ti, f32x16 (&st)[2]) {
      int kpos0 = ti * 64;
#pragma unroll
      for (int sub = 0; sub < 2; sub++)
#pragma unroll
        for (int g = 0; g < 16; g++) {
          int j = kpos0 + sub * 32 + (g & 3) + 8 * (g >> 2) + 4 * h;
          int dl = qpos - j;
          float e = dl >= 0 ? lf2 * (float)dl : lb2 * (float)(-dl);
          st[sub][g] *= __builtin_amdgcn_exp2f(e);
        }
    },
    [&](int ti, int sub, f32x16& st) {});
  if (smp) {
    for (int dir = 0; dir < 2; dir++) {
      const float* S0 = (dir == 0 ? p.srf : p.srb) + (size_t)(b * 8 + hh) * 4096;
      float rs = dir == 0 ? exp2f(lf2 * (float)(qpos + 1)) : exp2f(lb2 * (float)(L - qpos));
      __syncthreads();
      load_ident_k(sK);
      load_state_v(S0, sVT);
      __syncthreads();
      attn_compute<64>(qf, o, sK, sVT, [&](f32x16 (&st)[2]) {
#pragma unroll
        for (int sub = 0; sub < 2; sub++)
#pragma unroll
          for (int g = 0; g < 16; g++) st[sub][g] *= rs;
      });
    }
  }
  float sum = 0.f;
#pragma unroll
  for (int ds = 0; ds < 2; ds++)
#pragma unroll
    for (int g = 0; g < 16; g++) sum += o[ds][g];
  sum += __shfl_xor(sum, 32);
  float mean = sum * (1.f / 64.f);
  float vs = 0.f;
#pragma unroll
  for (int ds = 0; ds < 2; ds++)
#pragma unroll
    for (int g = 0; g < 16; g++) { float dlt = o[ds][g] - mean; vs += dlt * dlt; }
  vs += __shfl_xor(vs, 32);
  float rstd = rsqrtf(vs * (1.f / 64.f) + 1e-6f);
  int T = Tq0 + wave * 32 + r;
#pragma unroll
  for (int ds = 0; ds < 2; ds++)
#pragma unroll
    for (int g4 = 0; g4 < 4; g4++) {
      int d0 = ds * 32 + 8 * g4 + 4 * h;
      uint2 gt = *(const uint2*)(p.SG() + (size_t)T * 512 + hh * 64 + d0);
      float y0 = (o[ds][4 * g4] - mean) * rstd * bflo(gt.x), y1 = (o[ds][4 * g4 + 1] - mean) * rstd * bfhi(gt.x);
      float y2 = (o[ds][4 * g4 + 2] - mean) * rstd * bflo(gt.y), y3 = (o[ds][4 * g4 + 3] - mean) * rstd * bfhi(gt.y);
      *(uint2*)(p.MIX() + (size_t)T * 1024 + 512 + hh * 64 + d0) = make_uint2(pack2(y0, y1), pack2(y2, y3));
    }
}
DEV void ret_state_job(const Params& p, int b, int hh, int dir, char* smem) {
  u16* sKk = (u16*)smem; u16* sVv = sKk + 64 * 64;
  int t = threadIdx.x;
  const u16* kb = p.RK() + kvoff(false, b, hh, 0, 8, 64, 1024, 0);
  const u16* vb = p.RV() + kvoff(false, b, hh, 0, 8, 64, 1024, 0);
  float xx = dir == 0 ? p.rdf[hh] : p.rdb[hh];
  float lg2 = -log1pf(__expf(-xx)) * 1.4426950408889634f;
  int dk = t >> 2, dvc = (t & 3) * 16;
  float acc[16];
#pragma unroll
  for (int i = 0; i < 16; i++) acc[i] = 0.f;
  for (int ch = 0; ch < 4; ch++) {
    __syncthreads();
#pragma unroll
    for (int i = 0; i < 2; i++) {
      int c = t + 256 * i;
      *(uint4*)(sKk + c * 8) = *(const uint4*)(kb + (size_t)ch * 4096 + c * 8);
      *(uint4*)(sVv + c * 8) = *(const uint4*)(vb + (size_t)ch * 4096 + c * 8);
    }
    __syncthreads();
    for (int jj = 0; jj < 64; jj++) {
      int j = ch * 64 + jj;
      float w = exp2f(lg2 * (float)(dir == 0 ? 255 - j : j));
      float kv = bf2f(sKk[jj * 64 + dk]) * w;
      const uint4* vp = (const uint4*)(sVv + jj * 64 + dvc);
      uint4 v0 = vp[0], v1 = vp[1];
      acc[0] += kv * bflo(v0.x); acc[1] += kv * bfhi(v0.x); acc[2] += kv * bflo(v0.y); acc[3] += kv * bfhi(v0.y);
      acc[4] += kv * bflo(v0.z); acc[5] += kv * bfhi(v0.z); acc[6] += kv * bflo(v0.w); acc[7] += kv * bfhi(v0.w);
      acc[8] += kv * bflo(v1.x); acc[9] += kv * bfhi(v1.x); acc[10] += kv * bflo(v1.y); acc[11] += kv * bfhi(v1.y);
      acc[12] += kv * bflo(v1.z); acc[13] += kv * bfhi(v1.z); acc[14] += kv * bflo(v1.w); acc[15] += kv * bfhi(v1.w);
    }
  }
  float* dst = p.out + (dir == 0 ? OUT_RF : OUT_RB) + ((size_t)(b * 8 + hh) * 64 + dk) * 64 + dvc;
#pragma unroll
  for (int i = 0; i < 4; i++) *(float4*)(dst + 4 * i) = make_float4(acc[4 * i], acc[4 * i + 1], acc[4 * i + 2], acc[4 * i + 3]);
}

DEV void phase_attn0(const Params& p, int bid, int nb, char* smem) {
  for (int it = bid; it < 1280 + 2048; it += nb) {
    if (it >= 1280) {
      int j = it - 1280;
      if (j < 1024) prep_quant<true>(p.peer_u, p.U8(), p.SU(), j * 16); else prep_quant<false>(p.peer_v, p.V8(), p.SV(), (j - 1024) * 16);
    } else if (it < 256) {
      int b = it >> 6, hq = (it >> 3) & 7, qb = it & 7; int kvh = hq >> 2;
      f32x16 o[2];
      int Tq0 = 4096 + b * 1024 + qb * 128;
      attn_softmax_job<64, false>(p, p.Q1(), Tq0, hq * 64, p.KA() + kvoff(true, b, kvh, -256, 2, 64, 1280, 256), p.KA(), p.VA() + kvoff(true, b, kvh, -256, 2, 64, 1280, 256),
                           20, 0, 0, qb * 128, false, 0.f, o, smem);
      store_o64(p, o, Tq0, hq * 64);
    } else if (it < 512) {
      int j = it - 256; int b = j >> 6, hh = (j >> 3) & 7, qb = j & 7;
      ret_job(p, true, b, hh, qb, smem);
    } else if (it < 768) {
      int j = it - 512; int b = j >> 4, hq = (j >> 1) & 7, qb = j & 1; int kvh = hq >> 2;
      f32x16 o[2];
      int Tq0 = b * 256 + qb * 128;
      attn_softmax_job<64, false>(p, p.Q1(), Tq0, hq * 64, p.KA() + kvoff(false, b, kvh, 0, 2, 64, 1280, 256), p.KA(), p.VA() + kvoff(false, b, kvh, 0, 2, 64, 1280, 256),
                           4, 0, 0, qb * 128, false, 0.f, o, smem);
      store_o64(p, o, Tq0, hq * 64);
    } else if (it < 1024) {
      int j = it - 768; int b = j >> 4, hh = (j >> 1) & 7, qb = j & 1;
      ret_job(p, false, b, hh, qb, smem);
    } else {
      int j = it - 1024; int b = j >> 4, hh = (j >> 1) & 7, dir = j & 1;
      ret_state_job(p, b, hh, dir, smem);
    }
  }
}
DEV void diff_job(const Params& p, bool smp, int b, int hh, int qb, float lam, char* smem) {
  int lane = threadIdx.x & 63, wave = threadIdx.x >> 6, r = lane & 31, h = lane >> 5;
  int c = wave >> 1;
  int Tq0 = (smp ? 4096 + b * 1024 : b * 256) + qb * 64;
  int nt = smp ? 20 : 4;
  const u16* vb = p.VC() + kvoff(smp, b, hh, smp ? -256 : 0, 4, 128, 1280, 256);
  const u16* kb0 = p.KC() + kvoff(smp, b, 2 * hh, smp ? -256 : 0, 8, 64, 1280, 256);
  const u16* kb1 = p.KC() + kvoff(smp, b, 2 * hh + 1, smp ? -256 : 0, 8, 64, 1280, 256);
  f32x16 o[4];
  attn_softmax_job<128, true>(p, p.Q1(), Tq0, (2 * hh + c) * 64, kb0, kb1, vb, nt, 0, 0, 0, false, 0.f, o, smem);
  float* ex = (float*)smem;
  if (wave >= 2) {
#pragma unroll
    for (int ds = 0; ds < 4; ds++)
#pragma unroll
      for (int g = 0; g < 16; g++) ex[(ds * 16 + g) * 128 + (threadIdx.x - 128)] = o[ds][g];
  }
  __syncthreads();
  if (wave < 2) {
    float ss = 0.f;
#pragma unroll
    for (int ds = 0; ds < 4; ds++)
#pragma unroll
      for (int g = 0; g < 16; g++) { float dv = o[ds][g] - lam * ex[(ds * 16 + g) * 128 + threadIdx.x]; o[ds][g] = dv; ss += dv * dv; }
    ss += __shfl_xor(ss, 32);
    float rstd = rsqrtf(ss * (1.f / 128.f) + 1e-6f) * (1.f - LAM_INIT);
    int T = Tq0 + wave * 32 + r;
#pragma unroll
    for (int ds = 0; ds < 4; ds++)
#pragma unroll
      for (int g4 = 0; g4 < 4; g4++) {
        int d0 = ds * 32 + 8 * g4 + 4 * h;
        float4 sg = *(const float4*)(p.subln + d0);
        *(uint2*)(p.MIX() + (size_t)T * 1024 + hh * 128 + d0) =
            make_uint2(pack2(o[ds][4 * g4] * rstd * sg.x, o[ds][4 * g4 + 1] * rstd * sg.y),
                       pack2(o[ds][4 * g4 + 2] * rstd * sg.z, o[ds][4 * g4 + 3] * rstd * sg.w));
      }
  }
}
DEV void phase_attn1(const Params& p, int bid, int nb, char* smem) {
  float d1 = 0.f, d2 = 0.f;
  for (int i = 0; i < 64; i++) { d1 += p.lq1[i] * p.lk1[i]; d2 += p.lq2[i] * p.lk2[i]; }
  float lam = __expf(d1) - __expf(d2) + LAM_INIT;
  for (int it = bid; it < 1024; it += nb) {
    if (it < 256) {
      int b = it >> 6, hh = (it >> 4) & 3, qb = it & 15;
      diff_job(p, true, b, hh, qb, lam, smem);
    } else if (it < 512) {
      int j = it - 256; int b = j >> 6, hq = (j >> 3) & 7, qb = j & 7; int kvh = hq >> 2;
      int q0 = qb * 128;
      int lo = (q0 - 128 < 0 ? 0 : q0 - 128) >> 6, hi = (q0 + 256 > 1024 ? 1024 : q0 + 256) >> 6;
      f32x16 o[2];
      int Tq0 = 4096 + b * 1024 + q0;
      attn_softmax_job<64, false>(p, p.Q2(), Tq0, hq * 64, p.KD() + kvoff(true, b, kvh, -256, 2, 64, 1280, 256), p.KD(), p.VD() + kvoff(true, b, kvh, -256, 2, 64, 1280, 256),
                           4, lo, hi, q0, true, p.dsink[hq] * 1.4426950408889634f, o, smem);
      store_o64(p, o, Tq0, 512 + hq * 64);
    } else if (it < 768) {
      int j = it - 512; int b = j >> 4, hh = (j >> 2) & 3, qb = j & 3;
      diff_job(p, false, b, hh, qb, lam, smem);
    } else {
      int j = it - 768; int b = j >> 4, hq = (j >> 1) & 7, qb = j & 1; int kvh = hq >> 2;
      f32x16 o[2];
      int Tq0 = b * 256 + qb * 128;
      attn_softmax_job<64, false>(p, p.Q2(), Tq0, hq * 64, p.KD() + kvoff(false, b, kvh, 0, 2, 64, 1280, 256), p.KD(), p.VD() + kvoff(false, b, kvh, 0, 2, 64, 1280, 256),
                           4, 0, 0, qb * 128, true, p.dsink[hq] * 1.4426950408889634f, o, smem);
      store_o64(p, o, Tq0, 512 + hq * 64);
    }
  }
}

DEV float ub0(unsigned w) { return (float)(w & 255u); }
DEV float ub1(unsigned w) { return (float)((w >> 8) & 255u); }
DEV float ub2(unsigned w) { return (float)((w >> 16) & 255u); }
DEV float ub3(unsigned w) { return (float)(w >> 24); }
DEV void phase_peer(const Params& p, int layer, int bid, int nb, char* smem) {
  int wave = threadIdx.x >> 6, lane = threadIdx.x & 63;
  float* ws1 = (float*)(smem + wave * 2048); float* ws2 = ws1 + 16;
  int* wi1 = (int*)(ws2 + 16); int* wi2 = wi1 + 16; float* es = (float*)(wi2 + 16); int* eidx = (int*)(es + 16); float* eg = (float*)(eidx + 128);
  const unsigned char* U = p.U8() + (size_t)layer * 16384 * 1024;
  const unsigned char* V = p.V8() + (size_t)layer * 16384 * 1024;
  const float* SU = p.SU() + layer * 16384; const float* SV = p.SV() + layer * 16384;
  const float* gain = p.norm_ffn + layer * 1024;
  for (int T = bid * 4 + wave; T < 8192; T += nb * 4) {
    const float* sc = p.SC() + (size_t)T * 2048;
    for (int hh = 0; hh < 8; hh++) {
      const float* s = sc + hh * 256;
      float a0 = s[lane], a1 = s[lane + 64], b0 = s[128 + lane], b1 = s[192 + lane];
      unsigned ka0 = (fkey(a0) & ~127u) | (unsigned)(127 - lane), ka1 = (fkey(a1) & ~127u) | (unsigned)(63 - lane);
      unsigned kb0 = (fkey(b0) & ~127u) | (unsigned)(127 - lane), kb1 = (fkey(b1) & ~127u) | (unsigned)(63 - lane);
      unsigned pa = 0u, pb = 0u;
      for (int bit = 31; bit >= 0; --bit) {
        unsigned ta = pa | (1u << bit), tb = pb | (1u << bit);
        int ca = __popcll(__ballot(ka0 >= ta)) + __popcll(__ballot(ka1 >= ta));
        int cb = __popcll(__ballot(kb0 >= tb)) + __popcll(__ballot(kb1 >= tb));
        if (ca >= 16) pa = ta;
        if (cb >= 16) pb = tb;
      }
      {
        unsigned long long m0 = __ballot(ka0 >= pa), m1 = __ballot(ka1 >= pa);
        int p0 = mbcnt64(m0), p1 = __popcll(m0) + mbcnt64(m1);
        if (ka0 >= pa) { ws1[p0 & 15] = a0; wi1[p0 & 15] = lane; }
        if (ka1 >= pa) { ws1[p1 & 15] = a1; wi1[p1 & 15] = lane + 64; }
        unsigned long long n0 = __ballot(kb0 >= pb), n1 = __ballot(kb1 >= pb);
        int q0 = mbcnt64(n0), q1 = __popcll(n0) + mbcnt64(n1);
        if (kb0 >= pb) { ws2[q0 & 15] = b0; wi2[q0 & 15] = lane; }
        if (kb1 >= pb) { ws2[q1 & 15] = b1; wi2[q1 & 15] = lane + 64; }
      }
      __builtin_amdgcn_fence(__ATOMIC_ACQ_REL, "wavefront");
      __builtin_amdgcn_wave_barrier();
      int bq = lane & 15, aq = lane >> 4;
      float s2v = ws2[bq];
      float c0 = ws1[aq] + s2v, c1 = ws1[aq + 4] + s2v, c2 = ws1[aq + 8] + s2v, c3 = ws1[aq + 12] + s2v;
      unsigned k0 = (fkey(c0) & ~255u) | (unsigned)(255 - lane), k1 = (fkey(c1) & ~255u) | (unsigned)(191 - lane);
      unsigned k2 = (fkey(c2) & ~255u) | (unsigned)(127 - lane), k3 = (fkey(c3) & ~255u) | (unsigned)(63 - lane);
      unsigned pc = 0u;
      for (int bit = 31; bit >= 0; --bit) {
        unsigned tc = pc | (1u << bit);
        int cc = __popcll(__ballot(k0 >= tc)) + __popcll(__ballot(k1 >= tc)) + __popcll(__ballot(k2 >= tc)) + __popcll(__ballot(k3 >= tc));
        if (cc >= 16) pc = tc;
      }
      {
        unsigned long long m0 = __ballot(k0 >= pc), m1 = __ballot(k1 >= pc), m2 = __ballot(k2 >= pc), m3 = __ballot(k3 >= pc);
        int n0 = __popcll(m0), n1 = n0 + __popcll(m1), n2 = n1 + __popcll(m2);
        int i2b = wi2[bq];
        if (k0 >= pc) { int q = mbcnt64(m0) & 15; es[q] = c0; eidx[hh * 16 + q] = wi1[aq] * 128 + i2b; }
        if (k1 >= pc) { int q = (n0 + mbcnt64(m1)) & 15; es[q] = c1; eidx[hh * 16 + q] = wi1[aq + 4] * 128 + i2b; }
        if (k2 >= pc) { int q = (n1 + mbcnt64(m2)) & 15; es[q] = c2; eidx[hh * 16 + q] = wi1[aq + 8] * 128 + i2b; }
        if (k3 >= pc) { int q = (n2 + mbcnt64(m3)) & 15; es[q] = c3; eidx[hh * 16 + q] = wi1[aq + 12] * 128 + i2b; }
      }
      __builtin_amdgcn_fence(__ATOMIC_ACQ_REL, "wavefront");
      __builtin_amdgcn_wave_barrier();
      float ts = es[lane & 15];
      float mx = row_max16(ts);
      float pe = __expf(ts - mx);
      float sm = row_sum16(pe);
      if (lane < 16) eg[hh * 16 + lane] = pe / sm;
      __builtin_amdgcn_fence(__ATOMIC_ACQ_REL, "wavefront");
      __builtin_amdgcn_wave_barrier();
    }
    int mb = T < 4096 ? 0 : 1 + ((T - 4096) >> 10);
    const float* md = p.MOD() + (size_t)(layer * 5 + mb) * 6144;
    float4 xv[4]; float ssx = 0.f;
#pragma unroll
    for (int i = 0; i < 4; i++) { xv[i] = *(const float4*)(p.X() + (size_t)T * 1024 + (i * 64 + lane) * 4); ssx += xv[i].x * xv[i].x + xv[i].y * xv[i].y + xv[i].z * xv[i].z + xv[i].w * xv[i].w; }
    ssx = wave_sum(ssx);
    float rstdx = rsqrtf(ssx * (1.f / 1024.f) + 1e-6f);
    float4 hv[4]; float hmax = 0.f;
#pragma unroll
    for (int i = 0; i < 4; i++) {
      int col = (i * 64 + lane) * 4;
      float4 g = *(const float4*)(gain + col), sh = *(const float4*)(md + 3 * 1024 + col), scl = *(const float4*)(md + 4 * 1024 + col);
      hv[i].x = xv[i].x * rstdx * g.x * (1.f + scl.x) + sh.x; hv[i].y = xv[i].y * rstdx * g.y * (1.f + scl.y) + sh.y;
      hv[i].z = xv[i].z * rstdx * g.z * (1.f + scl.z) + sh.z; hv[i].w = xv[i].w * rstdx * g.w * (1.f + scl.w) + sh.w;
      hmax = fmaxf(hmax, fmaxf(fmaxf(fabsf(hv[i].x), fabsf(hv[i].y)), fmaxf(fabsf(hv[i].z), fabsf(hv[i].w))));
    }
    hmax = wave_max_f(hmax);
    float hinv = hmax > 0.f ? 127.f / hmax : 0.f, hscale = hmax * (1.f / 127.f);
    int hq[4];
#pragma unroll
    for (int i = 0; i < 4; i++) {
      unsigned b0 = (unsigned)((int)rintf(hv[i].x * hinv)) & 255u, b1 = (unsigned)((int)rintf(hv[i].y * hinv)) & 255u;
      unsigned b2 = (unsigned)((int)rintf(hv[i].z * hinv)) & 255u, b3 = (unsigned)((int)rintf(hv[i].w * hinv)) & 255u;
      hq[i] = (int)(b0 | (b1 << 8) | (b2 << 16) | (b3 << 24));
    }
#define PLOAD8(SET, TBL, B0) _Pragma("unroll") for (int j = 0; j < 8; j++) { \
        int e_ = __builtin_amdgcn_readfirstlane(eidx[(B0) * 8 + j]); SET[j] = *(const u32x4*)(TBL + (size_t)e_ * 1024 + lane * 16); }
#define PDOT8(SET, B0) _Pragma("unroll") for (int j = 0; j < 8; j++) { \
        int d_ = __builtin_amdgcn_sdot4(hq[0], (int)SET[j][0], 0, false); d_ = __builtin_amdgcn_sdot4(hq[1], (int)SET[j][1], d_, false); \
        d_ = __builtin_amdgcn_sdot4(hq[2], (int)SET[j][2], d_, false); d_ = __builtin_amdgcn_sdot4(hq[3], (int)SET[j][3], d_, false); \
        float D_ = (float)wave_sum_i(d_); int e_ = (B0) * 8 + j; bool me_ = lane == (e_ & 63); \
        a0 = (me_ && e_ < 64) ? D_ : a0; a1 = (me_ && e_ >= 64) ? D_ : a1; }
#define PACC8(SET, B0) _Pragma("unroll") for (int j = 0; j < 8; j++) { \
        int e_ = (B0) * 8 + j; float w = rlane(e_ < 64 ? w0 : w1, e_ & 63); \
        acc[0] += w * ub0(SET[j][0]); acc[1] += w * ub1(SET[j][0]); acc[2] += w * ub2(SET[j][0]); acc[3] += w * ub3(SET[j][0]); \
        acc[4] += w * ub0(SET[j][1]); acc[5] += w * ub1(SET[j][1]); acc[6] += w * ub2(SET[j][1]); acc[7] += w * ub3(SET[j][1]); \
        acc[8] += w * ub0(SET[j][2]); acc[9] += w * ub1(SET[j][2]); acc[10] += w * ub2(SET[j][2]); acc[11] += w * ub3(SET[j][2]); \
        acc[12] += w * ub0(SET[j][3]); acc[13] += w * ub1(SET[j][3]); acc[14] += w * ub2(SET[j][3]); acc[15] += w * ub3(SET[j][3]); }
    float acc[16];
#pragma unroll
    for (int i = 0; i < 16; i++) acc[i] = 0.f;
    float a0 = 0.f, a1 = 0.f;
    u32x4 sa[8], sb[8];
    PLOAD8(sa, U, 0)
#pragma unroll 1
    for (int bi = 0; bi < 16; bi += 2) {
      PLOAD8(sb, U, bi + 1)
      PDOT8(sa, bi)
      if (bi + 2 < 16) { PLOAD8(sa, U, bi + 2) } else { PLOAD8(sa, V, 0) }
      PDOT8(sb, bi + 1)
    }
    int e0 = eidx[lane], e1 = eidx[lane + 64];
    float w0 = eg[lane] * gelu_tanh(a0 * (SU[e0] * hscale)) * SV[e0];
    float w1 = eg[lane + 64] * gelu_tanh(a1 * (SU[e1] * hscale)) * SV[e1];
    float wsum = wave_sum(w0 + w1);
#pragma unroll 1
    for (int bi = 0; bi < 16; bi += 2) {
      PLOAD8(sb, V, bi + 1)
      PACC8(sa, bi)
      if (bi + 2 < 16) { PLOAD8(sa, V, bi + 2) }
      PACC8(sb, bi + 1)
    }
    float x2[16]; float ss = 0.f;
#pragma unroll
    for (int i = 0; i < 4; i++) {
      int col = (i * 64 + lane) * 4;
      float4 ga = *(const float4*)(md + 5 * 1024 + col);
      x2[i * 4 + 0] = xv[i].x + ga.x * (acc[i * 4 + 0] - 128.f * wsum); x2[i * 4 + 1] = xv[i].y + ga.y * (acc[i * 4 + 1] - 128.f * wsum);
      x2[i * 4 + 2] = xv[i].z + ga.z * (acc[i * 4 + 2] - 128.f * wsum); x2[i * 4 + 3] = xv[i].w + ga.w * (acc[i * 4 + 3] - 128.f * wsum);
    }
#pragma unroll
    for (int i = 0; i < 16; i++) ss += x2[i] * x2[i];
    ss = wave_sum(ss);
    float rstd = rsqrtf(ss * (1.f / 1024.f) + 1e-6f);
    if (layer == 0) {
      const float* md1 = p.MOD() + (size_t)(5 + mb) * 6144;
#pragma unroll
      for (int i = 0; i < 4; i++) {
        int col = (i * 64 + lane) * 4;
        *(float4*)(p.X() + (size_t)T * 1024 + col) = make_float4(x2[i * 4], x2[i * 4 + 1], x2[i * 4 + 2], x2[i * 4 + 3]);
        float4 g = *(const float4*)(p.norm_mix + 1024 + col), sh = *(const float4*)(md1 + col), scl = *(const float4*)(md1 + 1024 + col);
        float y0 = x2[i * 4] * rstd * g.x * (1.f + scl.x) + sh.x, y1 = x2[i * 4 + 1] * rstd * g.y * (1.f + scl.y) + sh.y;
        float y2 = x2[i * 4 + 2] * rstd * g.z * (1.f + scl.z) + sh.z, y3 = x2[i * 4 + 3] * rstd * g.w * (1.f + scl.w) + sh.w;
        *(uint2*)(p.H() + (size_t)T * 1024 + col) = make_uint2(pack2(y0, y1), pack2(y2, y3));
      }
    } else {
#pragma unroll
      for (int i = 0; i < 4; i++) {
        int col = (i * 64 + lane) * 4;
        float4 g = *(const float4*)(p.norm_final + col);
        *(float4*)(p.out + (size_t)T * 1024 + col) = make_float4(x2[i * 4] * rstd * g.x, x2[i * 4 + 1] * rstd * g.y, x2[i * 4 + 2] * rstd * g.z, x2[i * 4 + 3] * rstd * g.w);
      }
    }
  }
}

#define XB_TMO      128
#define XB_XCNT(j)  (256  + 64 * (j))
#define XB_XSUB(j)  (1280 + 64 * (j))
#define XB_XGEN(j)  (2304 + 64 * (j))
#define XB_TOP      3328
#define XB_TOPGEN   3392
#define XCD_BAR_WORDS 3456
#define XB_SPIN_CAP (1u << 20)
#define LAS __attribute__((address_space(3)))
DEV unsigned xb_ld(unsigned* p)              { return __hip_atomic_load(p, __ATOMIC_RELAXED, __HIP_MEMORY_SCOPE_AGENT); }
DEV unsigned xb_add(unsigned* p, unsigned v) { return __hip_atomic_fetch_add(p, v, __ATOMIC_RELAXED, __HIP_MEMORY_SCOPE_AGENT); }
DEV unsigned xb_xcc_id() { return (unsigned)__builtin_amdgcn_s_getreg((3 << 11) | 20) & 0xFu; }
#define XB_SPIN(cond, bar) do { unsigned _sp = 0; while (cond) { __builtin_amdgcn_s_sleep(4); \
    if ((++_sp & 255u) == 0u) { if (xb_ld(&(bar)[XB_TMO])) break; if (_sp > XB_SPIN_CAP) { atomicAdd(&(bar)[XB_TMO], 1u); break; } } } } while (0)
struct XcdBarrier { unsigned* bar; unsigned x; volatile LAS unsigned* st; };
DEV XcdBarrier xcd_barrier_post(unsigned* bar, volatile LAS unsigned* st) {
  XcdBarrier b; b.bar = bar; b.x = xb_xcc_id(); b.st = st;
  if (threadIdx.x == 0) (void)xb_add(&bar[XB_XCNT(b.x)], 1u);
  return b;
}
DEV void xcd_barrier_complete(unsigned* bar, unsigned x, unsigned& nloc, unsigned& nx) {
  const unsigned G = gridDim.x * gridDim.y * gridDim.z;
  unsigned sum, cnt, mine, sp = 0u;
  for (;;) {
    sum = 0u; cnt = 0u; mine = 0u;
#pragma unroll
    for (unsigned j = 0; j < 16; ++j) { const unsigned c = xb_ld(&bar[XB_XCNT(j)]); sum += c; cnt += (c > 0u) ? 1u : 0u; mine = (j == x) ? c : mine; }
    if (sum == G) break;
    __builtin_amdgcn_s_sleep(1);
    if ((++sp & 255u) == 0u) { if (xb_ld(&bar[XB_TMO])) break; if (sp > XB_SPIN_CAP) { atomicAdd(&bar[XB_TMO], 1u); break; } }
  }
  nloc = mine > 0u ? mine : 1u; nx = cnt > 0u ? cnt : 1u;
}
DEV void xcd_barrier(const XcdBarrier& b) {
  asm volatile("s_waitcnt vmcnt(0)" ::: "memory");
  __syncthreads();
  if (threadIdx.x == 0) {
    unsigned* bar = b.bar;
    __builtin_amdgcn_s_waitcnt(0);
    unsigned nloc = b.st[0], nx = b.st[1];
    if (nloc == 0u) { xcd_barrier_complete(bar, b.x, nloc, nx); b.st[0] = nloc; b.st[1] = nx; }
    const unsigned old = xb_add(&bar[XB_XSUB(b.x)], 1u);
    const unsigned gen = old / nloc;
    if (old + 1u == (gen + 1u) * nloc) {
      __builtin_amdgcn_fence(__ATOMIC_RELEASE, "agent");
      asm volatile("s_waitcnt vmcnt(0)" ::: "memory");
      const unsigned og = xb_add(&bar[XB_TOP], 1u);
      const unsigned tg = og / nx;
      if (og + 1u == (tg + 1u) * nx) xb_add(&bar[XB_TOPGEN], 1u);
      else XB_SPIN(xb_ld(&bar[XB_TOPGEN]) == tg, bar);
      __builtin_amdgcn_fence(__ATOMIC_ACQUIRE, "agent");
      xb_add(&bar[XB_XGEN(b.x)], 1u);
      asm volatile("s_waitcnt vmcnt(0)" ::: "memory");
    } else {
      XB_SPIN(xb_ld(&bar[XB_XGEN(b.x)]) == gen, bar);
      __builtin_amdgcn_fence(__ATOMIC_ACQUIRE, "agent");
      asm volatile("s_waitcnt vmcnt(0)" ::: "memory");
    }
  }
  __syncthreads();
}

constexpr int NPHASE = 14;
DEV void run_phase(const Params& p, int ph, int bid, int nb, char* smem) {
  switch (ph) {
    case 0: phase_prep(p, bid, nb, smem); break;
    case 1: phase_ada(p, 0, p.norm_mix, 0, 1, true, bid, nb); break;
    case 2: {
      gemm_phase(p.H(), 1024, p.WT_EVIN(), 1024, 1024, 64, 22, bid, nb, smem, [&](int m0, int n0, const float* Cs) { epi_inproj0(p, m0, n0, Cs); });
      int first = 0, cnt = nb;
      if ((nb & 7) == 0) { int slots = nb >> 3, rem = (8 * 22) % slots; if (rem > 0) { first = rem * 8; cnt = nb - first; } }
      int me = bid - first;
      __syncthreads();
      if (me >= 0) {
        float* sm = (float*)smem;
        for (int j = me; j < 1344; j += cnt) {
          if (j < 576) prep_transpose(p.od_w_in, 2304, p.WT_ODIN(), j, sm);
          else if (j < 832) prep_transpose(p.od_w_out, 1024, p.WT_ODOUT(), j - 576, sm);
          else prep_transpose(p.peer_wq + (size_t)1024 * 2048, 2048, p.WT_PQ() + (size_t)2048 * 1024, j - 832, sm);
        }
      }
    } break;
    case 3: phase_attn0(p, bid, nb, smem); break;
    case 4: gemm_phase(p.MIX(), 1024, p.WT_EVOUT(), 1024, 1024, 64, 8, bid, nb, smem, [&](int m0, int n0, const float* Cs) { epi_outproj(p, 0, m0, n0, Cs); }); break;
    case 5: phase_ada(p, 0, p.norm_ffn, 3, 4, false, bid, nb); break;
    case 11: phase_ada(p, 1, p.norm_ffn + 1024, 3, 4, false, bid, nb); break;
    case 6: case 12: {
      int layer = ph == 6 ? 0 : 1;
      const u16* sk = p.SUBK() + (size_t)layer * 16 * 128 * 128;
      gemm_phase(p.H(), 1024, p.WT_PQ() + (size_t)layer * 2048 * 1024, 1024, 1024, 64, 16, bid, nb, smem, [&](int m0, int n0, const float* Cs) {
        int lane = threadIdx.x & 63, wave = threadIdx.x >> 6;
#pragma unroll 8
        for (int rr = wave; rr < 128; rr += 4) {
          float2 c = *(const float2*)(Cs + rr * 128 + lane * 2);
          *(unsigned*)(p.PQ() + (size_t)(m0 + rr) * 2048 + n0 + lane * 2) = pack2(c.x, c.y);
        }
        asm volatile("s_waitcnt vmcnt(0)" ::: "memory");
        __syncthreads();
        int hc = n0 >> 7;
        f32x16 acc[2][2];
        zero16(acc[0][0]); zero16(acc[0][1]); zero16(acc[1][0]); zero16(acc[1][1]);
        gemm_tile(p.PQ() + (size_t)m0 * 2048 + hc * 128, 2048, sk + (size_t)hc * 128 * 128, 128, 128, smem, acc);
        const float* Cs2 = (const float*)smem;
#pragma unroll 8
        for (int rr = wave; rr < 128; rr += 4) {
          float2 c = *(const float2*)(Cs2 + rr * 128 + lane * 2);
          *(float2*)(p.SC() + (size_t)(m0 + rr) * 2048 + hc * 128 + lane * 2) = c;
        }
      });
    } break;
    case 7: phase_peer(p, 0, bid, nb, smem); break;
    case 13: phase_peer(p, 1, bid, nb, smem); break;
    case 8: {
      gemm_phase(p.H(), 1024, p.WT_ODIN(), 1024, 1024, 64, 18, bid, nb, smem, [&](int m0, int n0, const float* Cs) { epi_inproj1(p, m0, n0, Cs); });
      int first = 0, cnt = nb;
      if ((nb & 7) == 0) { int slots = nb >> 3, rem = (8 * 18) % slots; if (rem > 0) { first = rem * 8; cnt = nb - first; } }
      int me = ((nb & 7) == 0) ? ((bid >> 3) * 8 + (bid & 7)) - first : bid;
      if (me >= 0) {
        for (int j = me; j < 2048; j += cnt) {
          if (j < 1024) prep_quant<true>(p.peer_u, p.U8(), p.SU(), 16384 + j * 16); else prep_quant<false>(p.peer_v, p.V8(), p.SV(), 16384 + (j - 1024) * 16);
        }
      }
    } break;
    case 9: phase_attn1(p, bid, nb, smem); break;
    case 10: gemm_phase(p.MIX(), 1024, p.WT_ODOUT(), 1024, 1024, 64, 8, bid, nb, smem, [&](int m0, int n0, const float* Cs) { epi_outproj(p, 1, m0, n0, Cs); }); break;
    default: break;
  }
}

constexpr size_t PARAMS_OFF = 330036736ull;
template <int PH> DEV void run_all(const Params& p, cg::grid_group& grid, const XcdBarrier& xb, char* smem) {
  if constexpr (PH == 0) {
    if (blockIdx.x == 0 && threadIdx.x < sizeof(Params) / 8) ((unsigned long long*)(p.ws + PARAMS_OFF))[threadIdx.x] = ((const unsigned long long*)&p)[threadIdx.x];
    run_phase(p, PH, blockIdx.x, gridDim.x, smem);
  } else {
    run_phase(p, PH, blockIdx.x, gridDim.x, smem);
  }
  if constexpr (PH + 1 < NPHASE) {
    if (PH == 0 && p.ws == nullptr) grid.sync();
    xcd_barrier(xb);
    run_all<PH + 1>(p, grid, xb, smem);
  }
}
__global__ void __launch_bounds__(256, 2) mega_kernel(Params p) {
  __shared__ __attribute__((aligned(16))) char smem[77824];
  __shared__ uint4 xb_words;
  if (threadIdx.x == 0) xb_words = make_uint4(0u, 0u, 0u, 0u);
  __syncthreads();
  XcdBarrier xb = xcd_barrier_post(p.BAR(), (volatile LAS unsigned*)&xb_words);
  cg::grid_group grid = cg::this_grid();
  run_all<0>(p, grid, xb, smem);
}
#if MULTI_LAUNCH
template <int PH> __global__ void __launch_bounds__(256, 2) phase_kernel(Params p) {
  __shared__ __attribute__((aligned(16))) char smem[77824];
  run_phase(p, PH, blockIdx.x, gridDim.x, smem);
}
template <int PH> static void launch_all(const Params& p, int grid, hipStream_t s) {
  phase_kernel<PH><<<grid, 256, 0, s>>>(p);
  if constexpr (PH + 1 < NPHASE) launch_all<PH + 1>(p, grid, s);
}
#endif

extern "C" void kernel_launch(void* const* d_in, const int* in_sizes, int n_in, void* d_out, int out_size, void* d_ws, size_t ws_size, hipStream_t stream) {
  Params p{};
  const float* const* in = (const float* const*)d_in;
  p.xp = in[0]; p.xs = in[1]; p.c = in[2]; p.cctx = in[3]; p.cak = in[4]; p.cav = in[5]; p.srf = in[6]; p.srb = in[7];
  p.cck = in[8]; p.ccv = in[9]; p.cdk = in[10]; p.cdv = in[11];
  p.mod_w = in[12]; p.mod_b = in[13]; p.norm_mix = in[14]; p.norm_ffn = in[15]; p.norm_final = in[16];
  p.ev_w_in = in[17]; p.ev_w_out = in[18]; p.a_q_norm = in[19]; p.a_k_norm = in[20]; p.rdf = in[21]; p.rdb = in[22];
  p.od_w_in = in[23]; p.od_w_out = in[24]; p.lq1 = in[25]; p.lk1 = in[26]; p.lq2 = in[27]; p.lk2 = in[28]; p.subln = in[29]; p.dsink = in[30];
  p.peer_wq = in[31]; p.peer_sk = in[32]; p.peer_u = in[33]; p.peer_v = in[34];
  p.out = (float*)d_out;
  p.ws = (char*)d_ws;
  (void)in_sizes; (void)n_in; (void)out_size; (void)ws_size;
#if MULTI_LAUNCH
  launch_all<0>(p, 512, stream);
#else
  static int grid_blocks = 0;
  if (!grid_blocks) {
    int dev = 0, cus = 0, per_cu = 0;
    hipGetDevice(&dev);
    hipDeviceGetAttribute(&cus, hipDeviceAttributeMultiprocessorCount, dev);
    hipOccupancyMaxActiveBlocksPerMultiprocessor(&per_cu, mega_kernel, 256, 0);
    if (per_cu > 2) per_cu = 2;
    if (per_cu < 1) per_cu = 1;
    grid_blocks = cus * per_cu;
  }
  (void)hipMemsetAsync(d_ws, 0, XCD_BAR_WORDS * 4, stream);
  void* args[] = {&p};
  hipError_t e = hipLaunchCooperativeKernel((void*)mega_kernel, dim3(grid_blocks), dim3(256), args, 0, stream);
  if (e != hipSuccess) fprintf(stderr, "cooperative launch failed: %s (grid %d)\n", hipGetErrorString(e), grid_blocks);
#endif
}
```

```cpp
#include <hip/hip_runtime.h>
#include <hip/hip_cooperative_groups.h>
#include <cstdio>
namespace cg = cooperative_groups;

#ifndef MULTI_LAUNCH
#define MULTI_LAUNCH 0
#endif

typedef unsigned short u16;
typedef __attribute__((ext_vector_type(8))) short bf16x8;
typedef __attribute__((ext_vector_type(16))) float f32x16;
typedef __attribute__((ext_vector_type(4))) unsigned u32x4;

#define DEV __device__ __forceinline__

constexpr size_t OUT_AK = 8388608, OUT_AV = 8912896, OUT_RF = 9437184, OUT_RB = 9961472,
                 OUT_CK = 10485760, OUT_CV = 12582912, OUT_DK = 14680064, OUT_DV = 15204352;
constexpr float LAM_INIT = 0.35550906f;

struct Params {
  const float *xp, *xs, *c, *cctx, *cak, *cav, *srf, *srb, *cck, *ccv, *cdk, *cdv;
  const float *mod_w, *mod_b, *norm_mix, *norm_ffn, *norm_final;
  const float *ev_w_in, *ev_w_out, *a_q_norm, *a_k_norm, *rdf, *rdb;
  const float *od_w_in, *od_w_out, *lq1, *lk1, *lq2, *lk2, *subln, *dsink;
  const float *peer_wq, *peer_sk, *peer_u, *peer_v;
  float* out;
  char* ws;
  __device__ __forceinline__ unsigned* BAR() const { return (unsigned*)(ws + 0ull); }
  __device__ __forceinline__ float* MOD() const { return (float*)(ws + 13824ull); }
  __device__ __forceinline__ float* ROPEC() const { return (float*)(ws + 259584ull); }
  __device__ __forceinline__ float* ROPES() const { return (float*)(ws + 390656ull); }
  __device__ __forceinline__ float* X() const { return (float*)(ws + 521728ull); }
  __device__ __forceinline__ float* SC() const { return (float*)(ws + 34076160ull); }
  __device__ __forceinline__ u16* WT_EVIN() const { return (u16*)(ws + 101185024ull); }
  __device__ __forceinline__ u16* WT_EVOUT() const { return (u16*)(ws + 106952192ull); }
  __device__ __forceinline__ u16* WT_ODIN() const { return (u16*)(ws + 109049344ull); }
  __device__ __forceinline__ u16* WT_ODOUT() const { return (u16*)(ws + 113767936ull); }
  __device__ __forceinline__ u16* WT_PQ() const { return (u16*)(ws + 115865088ull); }
  __device__ __forceinline__ u16* SUBK() const { return (u16*)(ws + 124253696ull); }
  __device__ __forceinline__ unsigned char* U8() const { return (unsigned char*)(ws + 125302272ull); }
  __device__ __forceinline__ unsigned char* V8() const { return (unsigned char*)(ws + 158856704ull); }
  __device__ __forceinline__ float* SU() const { return (float*)(ws + 192411136ull); }
  __device__ __forceinline__ float* SV() const { return (float*)(ws + 192542208ull); }
  __device__ __forceinline__ u16* H() const { return (u16*)(ws + 192673280ull); }
  __device__ __forceinline__ u16* MIX() const { return (u16*)(ws + 209450496ull); }
  __device__ __forceinline__ u16* Q1() const { return (u16*)(ws + 226227712ull); }
  __device__ __forceinline__ u16* Q2() const { return (u16*)(ws + 234616320ull); }
  __device__ __forceinline__ u16* SG() const { return (u16*)(ws + 243004928ull); }
  __device__ __forceinline__ u16* KA() const { return (u16*)(ws + 251393536ull); }
  __device__ __forceinline__ u16* VA() const { return (u16*)(ws + 253752832ull); }
  __device__ __forceinline__ u16* RK() const { return (u16*)(ws + 256112128ull); }
  __device__ __forceinline__ u16* RV() const { return (u16*)(ws + 264500736ull); }
  __device__ __forceinline__ u16* KC() const { return (u16*)(ws + 272889344ull); }
  __device__ __forceinline__ u16* VC() const { return (u16*)(ws + 282326528ull); }
  __device__ __forceinline__ u16* KD() const { return (u16*)(ws + 291763712ull); }
  __device__ __forceinline__ u16* VD() const { return (u16*)(ws + 294123008ull); }
  __device__ __forceinline__ u16* PQ() const { return (u16*)(ws + 296482304ull); }
};

DEV float bf2f(unsigned b) { return __uint_as_float(b << 16); }
typedef __bf16 bf16v2 __attribute__((ext_vector_type(2)));
typedef float f32v2 __attribute__((ext_vector_type(2)));
DEV unsigned pack2(float a, float b) { f32v2 v = {a, b}; return __builtin_bit_cast(unsigned, __builtin_convertvector(v, bf16v2)); }
DEV u16 f2bf(float f) { return (u16)(pack2(f, 0.f) & 0xffffu); }
DEV float bflo(unsigned w) { return __uint_as_float(w << 16); }
DEV float bfhi(unsigned w) { return __uint_as_float(w & 0xffff0000u); }
DEV float silu_f(float v) { return v / (1.f + __expf(-v)); }
DEV float gelu_tanh(float a) {
  float z = 0.7978845608f * (a + 0.044715f * a * a * a);
  float e = __expf(2.f * z);
  float th = 1.f - 2.f / (e + 1.f);
  return 0.5f * a * (1.f + th);
}
template <int CTRL> DEV float dpp_f(float v) {
  return __int_as_float(__builtin_amdgcn_update_dpp(0, __float_as_int(v), CTRL, 0xF, 0xF, true));
}
template <int CTRL> DEV unsigned dpp_u(unsigned v) {
  return (unsigned)__builtin_amdgcn_update_dpp(0, (int)v, CTRL, 0xF, 0xF, true);
}
DEV float row_sum16(float v) {
  v += dpp_f<0xB1>(v); v += dpp_f<0x4E>(v); v += dpp_f<0x141>(v); v += dpp_f<0x140>(v); return v;
}
DEV float row_max16(float v) {
  v = fmaxf(v, dpp_f<0xB1>(v)); v = fmaxf(v, dpp_f<0x4E>(v)); v = fmaxf(v, dpp_f<0x141>(v)); v = fmaxf(v, dpp_f<0x140>(v)); return v;
}
DEV float rlane(float v, int l) { return __int_as_float(__builtin_amdgcn_readlane(__float_as_int(v), l)); }
DEV float wave_sum(float v) {
  v = row_sum16(v);
  return (rlane(v, 0) + rlane(v, 16)) + (rlane(v, 32) + rlane(v, 48));
}
DEV unsigned wave_max_u(unsigned v) {
  v = max(v, dpp_u<0xB1>(v)); v = max(v, dpp_u<0x4E>(v)); v = max(v, dpp_u<0x141>(v)); v = max(v, dpp_u<0x140>(v));
  unsigned a = (unsigned)__builtin_amdgcn_readlane((int)v, 0), b = (unsigned)__builtin_amdgcn_readlane((int)v, 16);
  unsigned c = (unsigned)__builtin_amdgcn_readlane((int)v, 32), d = (unsigned)__builtin_amdgcn_readlane((int)v, 48);
  return max(max(a, b), max(c, d));
}
DEV float half_sum32(float v) { v = row_sum16(v); return v + __shfl_xor(v, 16); }
DEV unsigned fkey(float f) { unsigned u = __float_as_uint(f); return (u & 0x80000000u) ? ~u : (u | 0x80000000u); }
DEV f32x16 mfma32(bf16x8 a, bf16x8 b, f32x16 c) { return __builtin_amdgcn_mfma_f32_32x32x16_bf16(a, b, c, 0, 0, 0); }
DEV void zero16(f32x16& v) {
#pragma unroll
  for (int i = 0; i < 16; i++) v[i] = 0.f;
}
DEV size_t kvoff(bool smp, int b, int hh, int tpos, int H, int DW, int LS, int off) {
  return smp ? (size_t)4096 * H * DW + ((size_t)(b * H + hh) * LS + off + tpos) * DW
             : ((size_t)(b * H + hh) * 256 + tpos) * DW;
}


DEV float wave_max_f(float v) {
  v = row_max16(v);
  return fmaxf(fmaxf(rlane(v, 0), rlane(v, 16)), fmaxf(rlane(v, 32), rlane(v, 48)));
}
DEV int wave_sum_i(int v) {
  v += (int)dpp_u<0xB1>((unsigned)v); v += (int)dpp_u<0x4E>((unsigned)v); v += (int)dpp_u<0x141>((unsigned)v); v += (int)dpp_u<0x140>((unsigned)v);
  return (__builtin_amdgcn_readlane(v, 0) + __builtin_amdgcn_readlane(v, 16)) + (__builtin_amdgcn_readlane(v, 32) + __builtin_amdgcn_readlane(v, 48));
}
DEV int mbcnt64(unsigned long long m) { return (int)__builtin_amdgcn_mbcnt_hi((unsigned)(m >> 32), __builtin_amdgcn_mbcnt_lo((unsigned)m, 0u)); }
template <bool SGN> DEV void prep_quant(const float* __restrict__ src, unsigned char* __restrict__ dst, float* __restrict__ scale, int row0) {
  int lane = threadIdx.x & 63, wave = threadIdx.x >> 6;
  int rbase = row0 + wave * 4;
  float4 v[4][4];
#pragma unroll
  for (int q = 0; q < 4; q++)
#pragma unroll
    for (int i = 0; i < 4; i++) v[q][i] = *(const float4*)(src + (size_t)(rbase + q) * 1024 + (i * 64 + lane) * 4);
#pragma unroll
  for (int q = 0; q < 4; q++) {
    float mx = 0.f;
#pragma unroll
    for (int i = 0; i < 4; i++) mx = fmaxf(mx, fmaxf(fmaxf(fabsf(v[q][i].x), fabsf(v[q][i].y)), fmaxf(fabsf(v[q][i].z), fabsf(v[q][i].w))));
    mx = wave_max_f(mx);
    float inv = mx > 0.f ? 127.f / mx : 0.f;
    unsigned w[4];
#pragma unroll
    for (int i = 0; i < 4; i++) {
      int off = SGN ? 0 : 128;
      unsigned b0 = (unsigned)((int)rintf(v[q][i].x * inv) + off) & 255u, b1 = (unsigned)((int)rintf(v[q][i].y * inv) + off) & 255u;
      unsigned b2 = (unsigned)((int)rintf(v[q][i].z * inv) + off) & 255u, b3 = (unsigned)((int)rintf(v[q][i].w * inv) + off) & 255u;
      w[i] = b0 | (b1 << 8) | (b2 << 16) | (b3 << 24);
    }
    *(uint4*)(dst + (size_t)(rbase + q) * 1024 + lane * 16) = make_uint4(w[0], w[1], w[2], w[3]);
    if (lane == 0) scale[rbase + q] = mx * (1.f / 127.f);
  }
}

DEV void prep_transpose(const float* __restrict__ W, int N, u16* __restrict__ Wt, int tile, float* sm) {
  int ntn = N >> 6; int kt = tile / ntn, nt = tile % ntn;
  int k0 = kt * 64, n0 = nt * 64; int t = threadIdx.x;
#pragma unroll
  for (int i = 0; i < 4; i++) {
    int k = (t >> 4) + 16 * i; int c4 = (t & 15) * 4;
    float4 v = *(const float4*)(W + (size_t)(k0 + k) * N + n0 + c4);
    sm[k * 65 + c4] = v.x; sm[k * 65 + c4 + 1] = v.y; sm[k * 65 + c4 + 2] = v.z; sm[k * 65 + c4 + 3] = v.w;
  }
  __syncthreads();
  int n = t >> 2, kc = (t & 3) * 16;
  unsigned pk[8];
#pragma unroll
  for (int j = 0; j < 8; j++) pk[j] = pack2(sm[(kc + 2 * j) * 65 + n], sm[(kc + 2 * j + 1) * 65 + n]);
  uint4* dst = (uint4*)(Wt + (size_t)(n0 + n) * 1024 + k0 + kc);
  dst[0] = make_uint4(pk[0], pk[1], pk[2], pk[3]);
  dst[1] = make_uint4(pk[4], pk[5], pk[6], pk[7]);
  __syncthreads();
}
DEV void conv_item(const float* __restrict__ src, u16* __restrict__ dst) {
  int t = threadIdx.x;
#pragma unroll
  for (int i = 0; i < 8; i++) {
    int e = (i * 256 + t) * 8;
    float4 a = *(const float4*)(src + e), b = *(const float4*)(src + e + 4);
    *(uint4*)(dst + e) = make_uint4(pack2(a.x, a.y), pack2(a.z, a.w), pack2(b.x, b.y), pack2(b.z, b.w));
  }
}
DEV void prep_mod(const Params& p, int it, float* sm) {
  int l = it / 96, n0 = (it % 96) * 64; int t = threadIdx.x;
  float* sc = sm;
  for (int i = t; i < 5120; i += 256) {
    int b = i >> 10, k = i & 1023;
    float v = (b == 0) ? p.cctx[k] : p.c[(b - 1) * 1024 + k];
    sc[i] = silu_f(v);
  }
  __syncthreads();
  int cq = t & 15, kg = t >> 4;
  float4 a0 = make_float4(0.f, 0.f, 0.f, 0.f), a1 = a0, a2 = a0, a3 = a0, a4 = a0;
  const float* w = p.mod_w + (size_t)l * 1024 * 6144 + n0 + cq * 4;
  for (int k0 = kg; k0 < 1024; k0 += 128) {
    float4 wv[8];
#pragma unroll
    for (int u = 0; u < 8; u++) wv[u] = *(const float4*)(w + (size_t)(k0 + 16 * u) * 6144);
#pragma unroll
    for (int u = 0; u < 8; u++) {
      int k = k0 + 16 * u;
      float s0 = sc[k], s1 = sc[1024 + k], s2 = sc[2048 + k], s3 = sc[3072 + k], s4 = sc[4096 + k];
      a0.x += s0 * wv[u].x; a0.y += s0 * wv[u].y; a0.z += s0 * wv[u].z; a0.w += s0 * wv[u].w;
      a1.x += s1 * wv[u].x; a1.y += s1 * wv[u].y; a1.z += s1 * wv[u].z; a1.w += s1 * wv[u].w;
      a2.x += s2 * wv[u].x; a2.y += s2 * wv[u].y; a2.z += s2 * wv[u].z; a2.w += s2 * wv[u].w;
      a3.x += s3 * wv[u].x; a3.y += s3 * wv[u].y; a3.z += s3 * wv[u].z; a3.w += s3 * wv[u].w;
      a4.x += s4 * wv[u].x; a4.y += s4 * wv[u].y; a4.z += s4 * wv[u].z; a4.w += s4 * wv[u].w;
    }
  }
  float* red = sm + 5120;
  *(float4*)(red + (kg * 5 + 0) * 64 + cq * 4) = a0; *(float4*)(red + (kg * 5 + 1) * 64 + cq * 4) = a1;
  *(float4*)(red + (kg * 5 + 2) * 64 + cq * 4) = a2; *(float4*)(red + (kg * 5 + 3) * 64 + cq * 4) = a3;
  *(float4*)(red + (kg * 5 + 4) * 64 + cq * 4) = a4;
  __syncthreads();
  if (t < 64) {
#pragma unroll
    for (int b = 0; b < 5; b++) {
      float s = 0.f;
#pragma unroll
      for (int g = 0; g < 16; g++) s += red[(g * 5 + b) * 64 + t];
      p.MOD()[(size_t)(l * 5 + b) * 6144 + n0 + t] = s + p.mod_b[l * 6144 + n0 + t];
    }
  }
  __syncthreads();
}
DEV void prep_cache(const Params& p, int it) {
  const float* src; u16* dst;
  if (it < 8)       { int ch = it;      src = p.cak + (size_t)ch * 16384; dst = p.KA() + (size_t)4096 * 2 * 64 + (size_t)ch * 1280 * 64; }
  else if (it < 16) { int ch = it - 8;  src = p.cav + (size_t)ch * 16384; dst = p.VA() + (size_t)4096 * 2 * 64 + (size_t)ch * 1280 * 64; }
  else if (it < 48) { int ch = it - 16; src = p.cck + (size_t)ch * 16384; dst = p.KC() + (size_t)4096 * 8 * 64 + (size_t)ch * 1280 * 64; }
  else if (it < 80) { int ch = (it - 48) >> 1, hf = (it - 48) & 1;
                      src = p.ccv + (size_t)ch * 32768 + hf * 16384; dst = p.VC() + (size_t)4096 * 4 * 128 + (size_t)ch * 1280 * 128 + hf * 16384; }
  else if (it < 88) { int ch = it - 80; src = p.cdk + (size_t)ch * 16384; dst = p.KD() + (size_t)4096 * 2 * 64 + (size_t)ch * 1280 * 64; }
  else              { int ch = it - 88; src = p.cdv + (size_t)ch * 16384; dst = p.VD() + (size_t)4096 * 2 * 64 + (size_t)ch * 1280 * 64; }
  conv_item(src, dst);
}
DEV void prep_rope(const Params& p, int it) {
  for (int i = 0; i < 16; i++) {
    int idx = it * 4096 + i * 256 + threadIdx.x;
    int tpos = idx >> 5, a = idx & 31;
    float pos = (a < 16) ? (float)(tpos >> 6) : (float)(tpos & 63);
    float inv = exp2f(-(float)(a & 15) * (13.287712379549449f / 16.f));
    float ang = pos * inv;
    p.ROPEC()[idx] = __cosf(ang); p.ROPES()[idx] = __sinf(ang);
  }
}
constexpr int PREP_T0 = 704, PREP_T1 = PREP_T0 + 256, PREP_T2 = PREP_T1 + 576, PREP_T3 = PREP_T2 + 256, PREP_T4 = PREP_T3 + 1024;
constexpr int PREP_U = PREP_T4 + 2048, PREP_V = PREP_U + 2048, PREP_SK = PREP_V + 32, PREP_CA = PREP_SK + 96, PREP_RO = PREP_CA + 8, PREP_MOD = PREP_RO + 192;
DEV void phase_prep(const Params& p, int bid, int nb, char* smem) {
  float* sm = (float*)smem;
  for (int it0 = bid; it0 < PREP_MOD; it0 += nb) {
    int it = (it0 < 192) ? (PREP_RO + it0) : (it0 - 192);
    if (it >= PREP_T4 && it < PREP_V) continue;
    if ((it >= PREP_T1 && it < PREP_T3) || (it >= PREP_T3 + 512 && it < PREP_T4)) continue;
    if (it < PREP_T0) prep_transpose(p.ev_w_in, 2816, p.WT_EVIN(), it, sm);
    else if (it < PREP_T1) prep_transpose(p.ev_w_out, 1024, p.WT_EVOUT(), it - PREP_T0, sm);
    else if (it < PREP_T2) prep_transpose(p.od_w_in, 2304, p.WT_ODIN(), it - PREP_T1, sm);
    else if (it < PREP_T3) prep_transpose(p.od_w_out, 1024, p.WT_ODOUT(), it - PREP_T2, sm);
    else if (it < PREP_T4) { int j = it - PREP_T3; int l = j >> 9; prep_transpose(p.peer_wq + (size_t)l * 1024 * 2048, 2048, p.WT_PQ() + (size_t)l * 2048 * 1024, j & 511, sm); }
    else if (it < PREP_V) { }
    else if (it < PREP_SK) { size_t o = (size_t)(it - PREP_V) * 16384; conv_item(p.peer_sk + o, p.SUBK() + o); }
    else if (it < PREP_CA) prep_cache(p, it - PREP_SK);
    else if (it < PREP_RO) prep_rope(p, it - PREP_CA);
    else prep_mod(p, it - PREP_RO, sm);
  }
}

DEV void phase_ada(const Params& p, int layer, const float* __restrict__ gain, int shift_i, int scale_i, bool from_input, int bid, int nb) {
  int wave = threadIdx.x >> 6, lane = threadIdx.x & 63;
  for (int T0 = (bid * 4 + wave) * 2; T0 < 8192; T0 += nb * 8) {
    float4 v[2][4]; float ss[2];
#pragma unroll
    for (int q = 0; q < 2; q++) {
      int T = T0 + q;
      const float* xr = from_input ? (T < 4096 ? p.xp + (size_t)T * 1024 : p.xs + (size_t)(T - 4096) * 1024) : p.X() + (size_t)T * 1024;
#pragma unroll
      for (int i = 0; i < 4; i++) v[q][i] = *(const float4*)(xr + (i * 64 + lane) * 4);
    }
    int mb = T0 < 4096 ? 0 : 1 + ((T0 - 4096) >> 10);
    const float* md = p.MOD() + (size_t)(layer * 5 + mb) * 6144;
    float4 g[4], sh[4], sc[4];
#pragma unroll
    for (int i = 0; i < 4; i++) {
      int col = (i * 64 + lane) * 4;
      g[i] = *(const float4*)(gain + col); sh[i] = *(const float4*)(md + shift_i * 1024 + col); sc[i] = *(const float4*)(md + scale_i * 1024 + col);
    }
#pragma unroll
    for (int q = 0; q < 2; q++) {
      float s2 = 0.f;
#pragma unroll
      for (int i = 0; i < 4; i++) s2 += v[q][i].x * v[q][i].x + v[q][i].y * v[q][i].y + v[q][i].z * v[q][i].z + v[q][i].w * v[q][i].w;
      ss[q] = wave_sum(s2);
    }
#pragma unroll
    for (int q = 0; q < 2; q++) {
      float rstd = rsqrtf(ss[q] * (1.f / 1024.f) + 1e-6f);
#pragma unroll
      for (int i = 0; i < 4; i++) {
        int col = (i * 64 + lane) * 4;
        float y0 = v[q][i].x * rstd * g[i].x * (1.f + sc[i].x) + sh[i].x, y1 = v[q][i].y * rstd * g[i].y * (1.f + sc[i].y) + sh[i].y;
        float y2 = v[q][i].z * rstd * g[i].z * (1.f + sc[i].z) + sh[i].z, y3 = v[q][i].w * rstd * g[i].w * (1.f + sc[i].w) + sh[i].w;
        *(uint2*)(p.H() + (size_t)(T0 + q) * 1024 + col) = make_uint2(pack2(y0, y1), pack2(y2, y3));
      }
    }
  }
}

#define GLOAD8(PA, PB) \
  ra0 = *(const u32x4*)(PA); ra1 = *(const u32x4*)((PA) + sa32); ra2 = *(const u32x4*)((PA) + 2 * sa32); ra3 = *(const u32x4*)((PA) + 3 * sa32); \
  rb0 = *(const u32x4*)(PB); rb1 = *(const u32x4*)((PB) + sb32); rb2 = *(const u32x4*)((PB) + 2 * sb32); rb3 = *(const u32x4*)((PB) + 3 * sb32);
#define GLOAD8N(PA, PB) \
  na0 = *(const u32x4*)(PA); na1 = *(const u32x4*)((PA) + sa32); na2 = *(const u32x4*)((PA) + 2 * sa32); na3 = *(const u32x4*)((PA) + 3 * sa32); \
  nb0 = *(const u32x4*)(PB); nb1 = *(const u32x4*)((PB) + sb32); nb2 = *(const u32x4*)((PB) + 2 * sb32); nb3 = *(const u32x4*)((PB) + 3 * sb32);
#define GSTORE8(BUF) { u16* wa_ = (u16*)(smem + (BUF) * 36864) + lrow * 72 + lkc; u16* wb_ = wa_ + 128 * 72; \
  *(u32x4*)(wa_) = ra0; *(u32x4*)(wa_ + 32 * 72) = ra1; *(u32x4*)(wa_ + 64 * 72) = ra2; *(u32x4*)(wa_ + 96 * 72) = ra3; \
  *(u32x4*)(wb_) = rb0; *(u32x4*)(wb_ + 32 * 72) = rb1; *(u32x4*)(wb_ + 64 * 72) = rb2; *(u32x4*)(wb_ + 96 * 72) = rb3; }
DEV void gemm_tile(const u16* __restrict__ A, int lda, const u16* __restrict__ B, int ldb, int K, char* smem, f32x16 (&acc)[2][2]) {
  int t = threadIdx.x, lane = t & 63, wave = t >> 6, r = lane & 31, h = lane >> 5;
  int wm = wave >> 1, wn = wave & 1;
  int lrow = t >> 3, lkc = (t & 7) * 8;
  const u16* ap = A + (size_t)lrow * lda + lkc;
  const u16* bp = B + (size_t)lrow * ldb + lkc;
  size_t sa32 = (size_t)32 * lda, sb32 = (size_t)32 * ldb;
  u32x4 ra0, ra1, ra2, ra3, rb0, rb1, rb2, rb3;
  u32x4 na0, na1, na2, na3, nb0, nb1, nb2, nb3;
  int nk = K >> 6;
#define GSTORE8N(BUF) { u16* wa_ = (u16*)(smem + (BUF) * 36864) + lrow * 72 + lkc; u16* wb_ = wa_ + 128 * 72; \
  *(u32x4*)(wa_) = na0; *(u32x4*)(wa_ + 32 * 72) = na1; *(u32x4*)(wa_ + 64 * 72) = na2; *(u32x4*)(wa_ + 96 * 72) = na3; \
  *(u32x4*)(wb_) = nb0; *(u32x4*)(wb_ + 32 * 72) = nb1; *(u32x4*)(wb_ + 64 * 72) = nb2; *(u32x4*)(wb_ + 96 * 72) = nb3; }
#define GCOMPUTE(BUF) { const u16* sA = (const u16*)(smem + (BUF) * 36864); const u16* sB = sA + 128 * 72; \
    _Pragma("unroll") for (int kk = 0; kk < 4; kk++) { \
      bf16x8 a0 = *(const bf16x8*)(sA + (wm * 64 + r) * 72 + kk * 16 + h * 8); \
      bf16x8 a1 = *(const bf16x8*)(sA + (wm * 64 + 32 + r) * 72 + kk * 16 + h * 8); \
      bf16x8 b0 = *(const bf16x8*)(sB + (wn * 64 + r) * 72 + kk * 16 + h * 8); \
      bf16x8 b1 = *(const bf16x8*)(sB + (wn * 64 + 32 + r) * 72 + kk * 16 + h * 8); \
      acc[0][0] = mfma32(a0, b0, acc[0][0]); acc[0][1] = mfma32(a0, b1, acc[0][1]); \
      acc[1][0] = mfma32(a1, b0, acc[1][0]); acc[1][1] = mfma32(a1, b1, acc[1][1]); } }
  GLOAD8(ap, bp)
  __syncthreads();
  GSTORE8(0)
  if (nk > 1) { GLOAD8(ap + 64, bp + 64) }
  na0 = ra0; na1 = ra1; na2 = ra2; na3 = ra3; nb0 = rb0; nb1 = rb1; nb2 = rb2; nb3 = rb3;
  __syncthreads();
  for (int kt = 0; kt < nk; kt += 2) {
    if (kt + 2 < nk) { GLOAD8N(ap + (kt + 2) * 64, bp + (kt + 2) * 64) }
    GCOMPUTE(0)
    if (kt + 1 < nk) { GSTORE8(1) }
    __syncthreads();
    if (kt + 1 < nk) {
      if (kt + 3 < nk) { GLOAD8(ap + (kt + 3) * 64, bp + (kt + 3) * 64) }
      GCOMPUTE(1)
      if (kt + 2 < nk) { GSTORE8N(0) }
      __syncthreads();
    }
  }
  __syncthreads();
  float* Cs = (float*)smem;
#pragma unroll
  for (int i = 0; i < 2; i++)
#pragma unroll
    for (int j = 0; j < 2; j++)
#pragma unroll
      for (int g = 0; g < 16; g++)
        Cs[(wm * 64 + i * 32 + (g & 3) + 8 * (g >> 2) + 4 * h) * 128 + wn * 64 + j * 32 + r] = acc[i][j][g];
  __syncthreads();
}

DEV bool xcd_tile(int li, int bid, int NTl, int& mt, int& nt) {
  if (li >= 8 * NTl) return false;
  mt = 8 * (bid & 7) + (li & 7); nt = li >> 3; return true;
}
template <class Epi>
DEV void gemm_phase(const u16* A, int lda, const u16* Bt, int ldb, int K, int MT, int NTl, int bid, int nb, char* smem, Epi epi) {
  if ((nb & 7) == 0 && MT == 64) {
    int mt, nt;
    for (int li = bid >> 3; xcd_tile(li, bid, NTl, mt, nt); li += nb >> 3) {
      f32x16 acc[2][2];
      zero16(acc[0][0]); zero16(acc[0][1]); zero16(acc[1][0]); zero16(acc[1][1]);
      gemm_tile(A + (size_t)mt * 128 * lda, lda, Bt + (size_t)nt * 128 * ldb, ldb, K, smem, acc);
      epi(mt * 128, nt * 128, (const float*)smem);
    }
  } else {
    for (int it = bid; it < MT * NTl; it += nb) {
      int mt = it / NTl, nt = it % NTl;
      f32x16 acc[2][2];
      zero16(acc[0][0]); zero16(acc[0][1]); zero16(acc[1][0]); zero16(acc[1][1]);
      gemm_tile(A + (size_t)mt * 128 * lda, lda, Bt + (size_t)nt * 128 * ldb, ldb, K, smem, acc);
      epi(mt * 128, nt * 128, (const float*)smem);
    }
  }
}

DEV void tok_decode(int T, bool& smp, int& b, int& tpos) {
  smp = T >= 4096;
  if (!smp) { b = T >> 8; tpos = T & 255; } else { b = (T - 4096) >> 10; tpos = (T - 4096) & 1023; }
}
DEV void rope_pair(const Params& p, float& x, float& y, int tpos, int d) {
  float px = __shfl_xor(x, 16), py = __shfl_xor(y, 16);
  int a = d & 31;
  float c0 = p.ROPEC()[tpos * 32 + a], c1 = p.ROPEC()[tpos * 32 + a + 1];
  float s0 = p.ROPES()[tpos * 32 + a], s1 = p.ROPES()[tpos * 32 + a + 1];
  if (d < 32) { x = x * c0 - px * s0; y = y * c1 - py * s1; }
  else        { x = px * s0 + x * c0; y = py * s1 + y * c1; }
}

DEV void rope_apply(float& x, float& y, float4 cs, int d) {
  float px = __shfl_xor(x, 16), py = __shfl_xor(y, 16);
  if (d < 32) { x = x * cs.x - px * cs.z; y = y * cs.y - py * cs.w; }
  else        { x = px * cs.z + x * cs.x; y = py * cs.w + y * cs.y; }
}
DEV float4 rope_cs(const Params& p, int tpos, int d) {
  int a = d & 31;
  float2 c = *(const float2*)(p.ROPEC() + tpos * 32 + a), s = *(const float2*)(p.ROPES() + tpos * 32 + a);
  return make_float4(c.x, c.y, s.x, s.y);
}
template <int SEG, bool SMP>
DEV void epi0_rows(const Params& p, int m0, int n0, const float* Cs) {
  int lane = threadIdx.x & 63, wave = threadIdx.x >> 6;
  int col = n0 + lane * 2; int d = col & 63;
  float g0 = 1.f, g1 = 1.f;
  if (SEG == 0) { g0 = p.a_q_norm[d]; g1 = p.a_q_norm[d + 1]; }
  if (SEG == 1) { g0 = p.a_k_norm[d]; g1 = p.a_k_norm[d + 1]; }
  int segbase = SEG == 0 ? 0 : SEG == 1 ? 512 : SEG == 2 ? 640 : SEG == 3 ? 768 : SEG == 4 ? 1280 : SEG == 5 ? 1792 : 2304;
  int hh = (col - segbase) >> 6;
#pragma unroll 4
  for (int i = 0; i < 32; i++) {
    int rr = wave + 4 * i;
    int T = m0 + rr;
    int b = SMP ? (T - 4096) >> 10 : T >> 8;
    int tpos = SMP ? (T - 4096) & 1023 : T & 255;
    float2 c = *(const float2*)(Cs + rr * 128 + lane * 2);
    if (SEG <= 1) {
      float4 cs = make_float4(1.f, 1.f, 0.f, 0.f);
      if (SMP) cs = rope_cs(p, tpos, d);
      float ss = half_sum32(c.x * c.x + c.y * c.y);
      float rstd = rsqrtf(ss * (1.f / 64.f) + 1e-6f);
      c.x *= rstd * g0; c.y *= rstd * g1;
      if (SMP) rope_apply(c.x, c.y, cs, d);
    }
    if (SEG == 0) *(unsigned*)(p.Q1() + (size_t)T * 512 + col) = pack2(c.x * 0.18033688011112042f, c.y * 0.18033688011112042f);
    if (SEG == 1) {
      *(unsigned*)(p.KA() + kvoff(SMP, b, hh, tpos, 2, 64, 1280, 256) + d) = pack2(c.x, c.y);
      if (!SMP) *(float2*)(p.out + OUT_AK + ((size_t)(b * 2 + hh) * 256 + tpos) * 64 + d) = c;
    }
    if (SEG == 2) {
      *(unsigned*)(p.VA() + kvoff(SMP, b, hh, tpos, 2, 64, 1280, 256) + d) = pack2(c.x, c.y);
      if (!SMP) *(float2*)(p.out + OUT_AV + ((size_t)(b * 2 + hh) * 256 + tpos) * 64 + d) = c;
    }
    if (SEG == 3) *(unsigned*)(p.Q2() + (size_t)T * 512 + (col - 768)) = pack2(c.x, c.y);
    if (SEG == 4) *(unsigned*)(p.RK() + kvoff(SMP, b, hh, tpos, 8, 64, 1024, 0) + d) = pack2(c.x * 0.125f, c.y * 0.125f);
    if (SEG == 5) *(unsigned*)(p.RV() + kvoff(SMP, b, hh, tpos, 8, 64, 1024, 0) + d) = pack2(c.x, c.y);
    if (SEG == 6) *(unsigned*)(p.SG() + (size_t)T * 512 + (col - 2304)) = pack2(silu_f(c.x), silu_f(c.y));
  }
}
template <bool SMP> DEV void epi0_disp(const Params& p, int m0, int n0, const float* Cs) {
  if (n0 < 512) epi0_rows<0, SMP>(p, m0, n0, Cs);
  else if (n0 < 640) epi0_rows<1, SMP>(p, m0, n0, Cs);
  else if (n0 < 768) epi0_rows<2, SMP>(p, m0, n0, Cs);
  else if (n0 < 1280) epi0_rows<3, SMP>(p, m0, n0, Cs);
  else if (n0 < 1792) epi0_rows<4, SMP>(p, m0, n0, Cs);
  else if (n0 < 2304) epi0_rows<5, SMP>(p, m0, n0, Cs);
  else epi0_rows<6, SMP>(p, m0, n0, Cs);
}
DEV void epi_inproj0(const Params& p, int m0, int n0, const float* Cs) {
  if (m0 >= 4096) epi0_disp<true>(p, m0, n0, Cs); else epi0_disp<false>(p, m0, n0, Cs);
}
template <int SEG, bool SMP>
DEV void epi1_rows(const Params& p, int m0, int n0, const float* Cs) {
  int lane = threadIdx.x & 63, wave = threadIdx.x >> 6;
  int col = n0 + lane * 2; int d = col & 63;
  int segbase = SEG == 0 ? 0 : SEG == 1 ? 512 : SEG == 2 ? 1024 : SEG == 3 ? 1536 : SEG == 4 ? 2048 : 2176;
  int hh = (SEG == 2) ? (col - segbase) >> 7 : (col - segbase) >> 6;
  int dd = (col - 1024) & 127;
  constexpr bool ROPE = SMP && (SEG == 0 || SEG == 1 || SEG == 3 || SEG == 4);
#pragma unroll 4
  for (int i = 0; i < 32; i++) {
    int rr = wave + 4 * i;
    int T = m0 + rr;
    int b = SMP ? (T - 4096) >> 10 : T >> 8;
    int tpos = SMP ? (T - 4096) & 1023 : T & 255;
    float2 c = *(const float2*)(Cs + rr * 128 + lane * 2);
    if (!SMP) {
      if (SEG == 1) *(float2*)(p.out + OUT_CK + ((size_t)(b * 8 + hh) * 256 + tpos) * 64 + d) = c;
      if (SEG == 2) *(float2*)(p.out + OUT_CV + ((size_t)(b * 4 + hh) * 256 + tpos) * 128 + dd) = c;
      if (SEG == 4) *(float2*)(p.out + OUT_DK + ((size_t)(b * 2 + hh) * 256 + tpos) * 64 + d) = c;
      if (SEG == 5) *(float2*)(p.out + OUT_DV + ((size_t)(b * 2 + hh) * 256 + tpos) * 64 + d) = c;
    }
    if (ROPE) { float4 cs = rope_cs(p, tpos, d); rope_apply(c.x, c.y, cs, d); }
    if (SEG == 0) *(unsigned*)(p.Q1() + (size_t)T * 512 + col) = pack2(c.x * 0.18033688011112042f, c.y * 0.18033688011112042f);
    if (SEG == 1) *(unsigned*)(p.KC() + kvoff(SMP, b, hh, tpos, 8, 64, 1280, 256) + d) = pack2(c.x, c.y);
    if (SEG == 2) *(unsigned*)(p.VC() + kvoff(SMP, b, hh, tpos, 4, 128, 1280, 256) + dd) = pack2(c.x, c.y);
    if (SEG == 3) *(unsigned*)(p.Q2() + (size_t)T * 512 + (col - 1536)) = pack2(c.x * 0.18033688011112042f, c.y * 0.18033688011112042f);
    if (SEG == 4) *(unsigned*)(p.KD() + kvoff(SMP, b, hh, tpos, 2, 64, 1280, 256) + d) = pack2(c.x, c.y);
    if (SEG == 5) *(unsigned*)(p.VD() + kvoff(SMP, b, hh, tpos, 2, 64, 1280, 256) + d) = pack2(c.x, c.y);
  }
}
template <bool SMP> DEV void epi1_disp(const Params& p, int m0, int n0, const float* Cs) {
  if (n0 < 512) epi1_rows<0, SMP>(p, m0, n0, Cs);
  else if (n0 < 1024) epi1_rows<1, SMP>(p, m0, n0, Cs);
  else if (n0 < 1536) epi1_rows<2, SMP>(p, m0, n0, Cs);
  else if (n0 < 2048) epi1_rows<3, SMP>(p, m0, n0, Cs);
  else if (n0 < 2176) epi1_rows<4, SMP>(p, m0, n0, Cs);
  else epi1_rows<5, SMP>(p, m0, n0, Cs);
}
DEV void epi_inproj1(const Params& p, int m0, int n0, const float* Cs) {
  if (m0 >= 4096) epi1_disp<true>(p, m0, n0, Cs); else epi1_disp<false>(p, m0, n0, Cs);
}
DEV void epi_outproj(const Params& p, int layer, int m0, int n0, const float* Cs) {
  int lane = threadIdx.x & 63, wave = threadIdx.x >> 6;
  int mb = m0 < 4096 ? 0 : 1 + ((m0 - 4096) >> 10);
  int col = n0 + lane * 2;
  float2 g = *(const float2*)(p.MOD() + (size_t)(layer * 5 + mb) * 6144 + 2048 + col);
  const float* xbase = (layer == 0) ? (m0 < 4096 ? p.xp + (size_t)m0 * 1024 : p.xs + (size_t)(m0 - 4096) * 1024) : p.X() + (size_t)m0 * 1024;
#pragma unroll 8
  for (int i = 0; i < 32; i++) {
    int rr = wave + 4 * i;
    float2 c = *(const float2*)(Cs + rr * 128 + lane * 2);
    float2 x = *(const float2*)(xbase + (size_t)rr * 1024 + col);
    x.x += g.x * c.x; x.y += g.y * c.y;
    *(float2*)(p.X() + (size_t)(m0 + rr) * 1024 + col) = x;
  }
}

constexpr int ATT_BUF = 37888;
struct TileRegs { u32x4 k0, k1, k2, k3, v0, v1, v2, v3; };
template <int DV, bool TWOK> DEV TileRegs tile_load(const u16* __restrict__ k, const u16* __restrict__ k2, const u16* __restrict__ v) {
  int t = threadIdx.x, lane = t & 63, wave = t >> 6;
  TileRegs R;
  u32x4 z = {0u, 0u, 0u, 0u};
  R.k0 = *(const u32x4*)(k + t * 8); R.k1 = *(const u32x4*)(k + (t + 256) * 8);
  if (TWOK) { R.k2 = *(const u32x4*)(k2 + t * 8); R.k3 = *(const u32x4*)(k2 + (t + 256) * 8); } else { R.k2 = z; R.k3 = z; }
  R.v0 = *(const u32x4*)(v + (size_t)lane * DV + wave * 8); R.v1 = *(const u32x4*)(v + (size_t)lane * DV + (wave + 4) * 8);
  if (DV == 128) { R.v2 = *(const u32x4*)(v + (size_t)lane * DV + (wave + 8) * 8); R.v3 = *(const u32x4*)(v + (size_t)lane * DV + (wave + 12) * 8); } else { R.v2 = z; R.v3 = z; }
  return R;
}
DEV void store8t(u16* d, u32x4 x) {
  d[0 * 76] = (u16)(x[0] & 0xffff); d[1 * 76] = (u16)(x[0] >> 16);
  d[2 * 76] = (u16)(x[1] & 0xffff); d[3 * 76] = (u16)(x[1] >> 16);
  d[4 * 76] = (u16)(x[2] & 0xffff); d[5 * 76] = (u16)(x[2] >> 16);
  d[6 * 76] = (u16)(x[3] & 0xffff); d[7 * 76] = (u16)(x[3] >> 16);
}
template <int DV, bool TWOK> DEV void tile_store(const TileRegs R, char* buf) {
  int t = threadIdx.x, lane = t & 63, wave = t >> 6;
  u16* sK = (u16*)buf; u16* sK2 = sK + 64 * 72; u16* sVT = sK + 2 * 64 * 72;
  int key = t >> 3, dc = t & 7;
  *(u32x4*)(sK + key * 72 + dc * 8) = R.k0; *(u32x4*)(sK + (key + 32) * 72 + dc * 8) = R.k1;
  if (TWOK) { *(u32x4*)(sK2 + key * 72 + dc * 8) = R.k2; *(u32x4*)(sK2 + (key + 32) * 72 + dc * 8) = R.k3; }
  store8t(sVT + (wave * 8) * 76 + lane, R.v0); store8t(sVT + ((wave + 4) * 8) * 76 + lane, R.v1);
  if (DV == 128) { store8t(sVT + ((wave + 8) * 8) * 76 + lane, R.v2); store8t(sVT + ((wave + 12) * 8) * 76 + lane, R.v3); }
}
DEV void load_ident_k(u16* sK) {
  int t = threadIdx.x;
#pragma unroll
  for (int i = 0; i < 2; i++) {
    int c = t + 256 * i; int key = c >> 3, dc = c & 7;
    unsigned w[4] = {0u, 0u, 0u, 0u};
    uint4 z = make_uint4(0u, 0u, 0u, 0u);
    if (dc == (key >> 3)) {
      int e = key & 7; unsigned one = (e & 1) ? 0x3F800000u : 0x00003F80u;
      if ((e >> 1) == 0) z.x = one; else if ((e >> 1) == 1) z.y = one; else if ((e >> 1) == 2) z.z = one; else z.w = one;
    }
    (void)w;
    *(uint4*)(sK + key * 72 + dc * 8) = z;
  }
}
DEV void load_state_v(const float* __restrict__ S0, u16* sVT) {
  int lane = threadIdx.x & 63, wave = threadIdx.x >> 6;
#pragma unroll
  for (int i = 0; i < 2; i++) {
    int dc = wave + 4 * i;
    float4 a = *(const float4*)(S0 + lane * 64 + dc * 8), b = *(const float4*)(S0 + lane * 64 + dc * 8 + 4);
    u16* d = sVT + (dc * 8) * 76 + lane;
    d[0 * 76] = f2bf(a.x); d[1 * 76] = f2bf(a.y); d[2 * 76] = f2bf(a.z); d[3 * 76] = f2bf(a.w);
    d[4 * 76] = f2bf(b.x); d[5 * 76] = f2bf(b.y); d[6 * 76] = f2bf(b.z); d[7 * 76] = f2bf(b.w);
  }
}
template <int DV, class F>
DEV void attn_compute(const bf16x8 (&qf)[4], f32x16 (&o)[DV / 32], const u16* sK, const u16* sVT, F&& xform) {
  int lane = threadIdx.x & 63, r = lane & 31, h = lane >> 5;
  f32x16 st[2]; zero16(st[0]); zero16(st[1]);
#pragma unroll
  for (int sub = 0; sub < 2; sub++)
#pragma unroll
    for (int kk = 0; kk < 4; kk++) {
      bf16x8 kf = *(const bf16x8*)(sK + (sub * 32 + r) * 72 + kk * 16 + h * 8);
      st[sub] = mfma32(kf, qf[kk], st[sub]);
    }
  xform(st);
  bf16x8 pf[2][2];
#pragma unroll
  for (int sub = 0; sub < 2; sub++)
#pragma unroll
    for (int s = 0; s < 2; s++) {
      u32x4 w;
      w[0] = pack2(st[sub][8 * s + 0], st[sub][8 * s + 1]); w[1] = pack2(st[sub][8 * s + 2], st[sub][8 * s + 3]);
      w[2] = pack2(st[sub][8 * s + 4], st[sub][8 * s + 5]); w[3] = pack2(st[sub][8 * s + 6], st[sub][8 * s + 7]);
      pf[sub][s] = __builtin_bit_cast(bf16x8, w);
    }
#pragma unroll
  for (int ds = 0; ds < DV / 32; ds++)
#pragma unroll
    for (int sub = 0; sub < 2; sub++)
#pragma unroll
      for (int s = 0; s < 2; s++) {
        const u16* vp = sVT + (ds * 32 + r) * 76 + sub * 32 + s * 16 + 4 * h;
        uint2 lo = *(const uint2*)vp, hi = *(const uint2*)(vp + 8);
        u32x4 w; w[0] = lo.x; w[1] = lo.y; w[2] = hi.x; w[3] = hi.y;
        o[ds] = mfma32(__builtin_bit_cast(bf16x8, w), pf[sub][s], o[ds]);
      }
}
template <int DV, class F>
DEV void attn_compute_sub(const bf16x8 (&qf)[4], f32x16 (&o)[DV / 32], const u16* sK, const u16* sVT, F&& xform) {
  int lane = threadIdx.x & 63, r = lane & 31, h = lane >> 5;
#pragma unroll
  for (int sub = 0; sub < 2; sub++) {
    f32x16 st; zero16(st);
#pragma unroll
    for (int kk = 0; kk < 4; kk++) {
      bf16x8 kf = *(const bf16x8*)(sK + (sub * 32 + r) * 72 + kk * 16 + h * 8);
      st = mfma32(kf, qf[kk], st);
    }
    xform(sub, st);
    bf16x8 pf[2];
#pragma unroll
    for (int s2 = 0; s2 < 2; s2++) {
      u32x4 w;
      w[0] = pack2(st[8 * s2 + 0], st[8 * s2 + 1]); w[1] = pack2(st[8 * s2 + 2], st[8 * s2 + 3]);
      w[2] = pack2(st[8 * s2 + 4], st[8 * s2 + 5]); w[3] = pack2(st[8 * s2 + 6], st[8 * s2 + 7]);
      pf[s2] = __builtin_bit_cast(bf16x8, w);
    }
#pragma unroll
    for (int ds = 0; ds < DV / 32; ds++)
#pragma unroll
      for (int s2 = 0; s2 < 2; s2++) {
        const u16* vp = sVT + (ds * 32 + r) * 76 + sub * 32 + s2 * 16 + 4 * h;
        uint2 lo = *(const uint2*)vp, hi = *(const uint2*)(vp + 8);
        u32x4 w; w[0] = lo.x; w[1] = lo.y; w[2] = hi.x; w[3] = hi.y;
        o[ds] = mfma32(__builtin_bit_cast(bf16x8, w), pf[s2], o[ds]);
      }
  }
}
template <int DV>
DEV void softmax_xform1(f32x16& st, f32x16 (&o)[DV / 32], float& m, float& l) {
  float mx = -1e30f;
#pragma unroll
  for (int g = 0; g < 16; g++) mx = fmaxf(mx, st[g]);
  mx = fmaxf(mx, __shfl_xor(mx, 32));
  float mnew = fmaxf(m, mx);
  float alpha = __builtin_amdgcn_exp2f(m - mnew);
  m = mnew;
  float ls = 0.f;
#pragma unroll
  for (int g = 0; g < 16; g++) { float pv = __builtin_amdgcn_exp2f(st[g] - mnew); st[g] = pv; ls += pv; }
  l = l * alpha + ls;
#pragma unroll
  for (int ds = 0; ds < DV / 32; ds++)
#pragma unroll
    for (int g = 0; g < 16; g++) o[ds][g] *= alpha;
}
template <int DV, bool TWOK, class PF, class XF, class XF1>
DEV void attn_loop(int n, PF&& ptrs, const bf16x8 (&qf)[4], f32x16 (&o)[DV / 32], char* smem, XF&& xf, XF1&& xf1) {
  int wave = threadIdx.x >> 6;
  int kofs = (TWOK && wave >= 2) ? 64 * 72 : 0;
  TileRegs R;
  const u16 *kp, *kp2, *vp;
  ptrs(0, kp, kp2, vp); R = tile_load<DV, TWOK>(kp, kp2, vp);
  __syncthreads();
  tile_store<DV, TWOK>(R, smem);
  if (n > 1) { ptrs(1, kp, kp2, vp); R = tile_load<DV, TWOK>(kp, kp2, vp); }
  __syncthreads();
  const u16* b0k = (const u16*)smem + kofs; const u16* b0v = (const u16*)smem + 2 * 64 * 72;
  const u16* b1k = (const u16*)(smem + ATT_BUF) + kofs; const u16* b1v = (const u16*)(smem + ATT_BUF) + 2 * 64 * 72;
  for (int ti = 0; ti < n; ti++) {
    const u16* bk = (ti & 1) ? b1k : b0k; const u16* bv = (ti & 1) ? b1v : b0v;
    if constexpr (DV == 128) attn_compute_sub<DV>(qf, o, bk, bv, [&](int sub, f32x16& st) { xf1(ti, sub, st); });
    else attn_compute<DV>(qf, o, bk, bv, [&](f32x16 (&st)[2]) { xf(ti, st); });
    if (ti + 1 < n) tile_store<DV, TWOK>(R, smem + ((ti + 1) & 1) * ATT_BUF);
    if (ti + 2 < n) { ptrs(ti + 2, kp, kp2, vp); R = tile_load<DV, TWOK>(kp, kp2, vp); }
    __syncthreads();
  }
}
template <int DV>
DEV void softmax_xform(f32x16 (&st)[2], f32x16 (&o)[DV / 32], float& m, float& l, bool masked, int kpos0, int qpos) {
  int h = (threadIdx.x & 63) >> 5;
  float mx = -1e30f;
#pragma unroll
  for (int sub = 0; sub < 2; sub++)
#pragma unroll
    for (int g = 0; g < 16; g++) {
      float s = st[sub][g];
      if (masked) {
        int j = kpos0 + sub * 32 + (g & 3) + 8 * (g >> 2) + 4 * h;
        int dl = qpos - j; if (dl < 0) dl = -dl;
        if (dl > 128) s = -1e30f;
        st[sub][g] = s;
      }
      mx = fmaxf(mx, s);
    }
  mx = fmaxf(mx, __shfl_xor(mx, 32));
  float mnew = fmaxf(m, mx);
  float alpha = __builtin_amdgcn_exp2f(m - mnew);
  m = mnew;
  float ls = 0.f;
#pragma unroll
  for (int sub = 0; sub < 2; sub++)
#pragma unroll
    for (int g = 0; g < 16; g++) { float pv = __builtin_amdgcn_exp2f(st[sub][g] - mnew); st[sub][g] = pv; ls += pv; }
  l = l * alpha + ls;
#pragma unroll
  for (int ds = 0; ds < DV / 32; ds++)
#pragma unroll
    for (int g = 0; g < 16; g++) o[ds][g] *= alpha;
}

template <int DV, bool TWOK>
DEV void attn_softmax_job(const Params& p, const u16* Q, int Tq0, int qcol, const u16* kb, const u16* kb2, const u16* vb,
                          int nplain, int band_lo, int band_hi, int qpos0, bool use_sink, float sinkv,
                          f32x16 (&o)[DV / 32], char* smem) {
  int lane = threadIdx.x & 63, wave = threadIdx.x >> 6, r = lane & 31, h = lane >> 5;
  int qrow = TWOK ? (wave & 1) * 32 : wave * 32;
  bf16x8 qf[4];
#pragma unroll
  for (int kk = 0; kk < 4; kk++) qf[kk] = *(const bf16x8*)(Q + (size_t)(Tq0 + qrow + r) * 512 + qcol + kk * 16 + h * 8);
#pragma unroll
  for (int ds = 0; ds < DV / 32; ds++) zero16(o[ds]);
  float m = use_sink ? sinkv : -1e30f;
  float l = (use_sink && h == 0) ? 1.f : 0.f;
  int qpos = qpos0 + qrow + r;
  int ntot = nplain + (band_hi - band_lo);
  attn_loop<DV, TWOK>(ntot,
    [&](int ti, const u16*& kp, const u16*& kp2, const u16*& vp) {
      int key0 = (ti >= nplain) ? (256 + (band_lo + ti - nplain) * 64) : ti * 64;
      kp = kb + (size_t)key0 * 64; kp2 = kb2 + (size_t)key0 * 64; vp = vb + (size_t)key0 * DV;
    }, qf, o, smem,
    [&](int ti, f32x16 (&st)[2]) {
      bool masked = ti >= nplain;
      int kpos0 = (band_lo + ti - nplain) * 64;
      softmax_xform<DV>(st, o, m, l, masked, kpos0, qpos);
    },
    [&](int ti, int sub, f32x16& st) { softmax_xform1<DV>(st, o, m, l); });
  float lt = l + __shfl_xor(l, 32);
  float inv = 1.f / lt;
#pragma unroll
  for (int ds = 0; ds < DV / 32; ds++)
#pragma unroll
    for (int g = 0; g < 16; g++) o[ds][g] *= inv;
}
DEV void store_o64(const Params& p, const f32x16 (&o)[2], int Tq0, int mixcol) {
  int lane = threadIdx.x & 63, wave = threadIdx.x >> 6, r = lane & 31, h = lane >> 5;
  int T = Tq0 + wave * 32 + r;
#pragma unroll
  for (int ds = 0; ds < 2; ds++)
#pragma unroll
    for (int g4 = 0; g4 < 4; g4++) {
      int d0 = ds * 32 + 8 * g4 + 4 * h;
      *(uint2*)(p.MIX() + (size_t)T * 1024 + mixcol + d0) =
          make_uint2(pack2(o[ds][4 * g4], o[ds][4 * g4 + 1]), pack2(o[ds][4 * g4 + 2], o[ds][4 * g4 + 3]));
    }
}

DEV void ret_job(const Params& p, bool smp, int b, int hh, int qb, char* smem) {
  u16* sK = (u16*)smem; u16* sVT = sK + 2 * 64 * 72;
  int lane = threadIdx.x & 63, wave = threadIdx.x >> 6, r = lane & 31, h = lane >> 5;
  int L = smp ? 1024 : 256;
  int Tq0 = (smp ? 4096 + b * 1024 : b * 256) + qb * 128;
  const u16* kb = p.RK() + kvoff(smp, b, hh, 0, 8, 64, 1024, 0);
  const u16* vb = p.RV() + kvoff(smp, b, hh, 0, 8, 64, 1024, 0);
  float xf = p.rdf[hh], xb = p.rdb[hh];
  float lf2 = -log1pf(__expf(-xf)) * 1.4426950408889634f;
  float lb2 = -log1pf(__expf(-xb)) * 1.4426950408889634f;
  bf16x8 qf[4];
#pragma unroll
  for (int kk = 0; kk < 4; kk++) qf[kk] = *(const bf16x8*)(p.Q2() + (size_t)(Tq0 + wave * 32 + r) * 512 + hh * 64 + kk * 16 + h * 8);
  f32x16 o[2]; zero16(o[0]); zero16(o[1]);
  int qpos = qb * 128 + wave * 32 + r;
  int nt = L / 64;
  attn_loop<64, false>(nt,
    [&](int ti, const u16*& kp, const u16*& kp2, const u16*& vp) { kp = kb + (size_t)ti * 4096; kp2 = kp; vp = vb + (size_t)ti * 4096; },
    qf, o, smem,
    [&](int ti, f32x16 (&st)[2]) {
      int kpos0 = ti * 64;
#pragma unroll
      for (int sub = 0; sub < 2; sub++)
#pragma unroll
        for (int g = 0; g < 16; g++) {
          int j = kpos0 + sub * 32 + (g & 3) + 8 * (g >> 2) + 4 * h;
          int dl = qpos - j;
          float e = dl >= 0 ? lf2 * (float)dl : lb2 * (float)(-dl);
          st[sub][g] *= __builtin_amdgcn_exp2f(e);
        }
    },
    [&](int ti, int sub, f32x16& st) {});
  if (smp) {
    for (int dir = 0; dir < 2; dir++) {
      const float* S0 = (dir == 0 ? p.srf : p.srb) + (size_t)(b * 8 + hh) * 4096;
      float rs = dir == 0 ? exp2f(lf2 * (float)(qpos + 1)) : exp2f(lb2 * (float)(L - qpos));
      __syncthreads();
      load_ident_k(sK);
      load_state_v(S0, sVT);
      __syncthreads();
      attn_compute<64>(qf, o, sK, sVT, [&](f32x16 (&st)[2]) {
#pragma unroll
        for (int sub = 0; sub < 2; sub++)
#pragma unroll
          for (int g = 0; g < 16; g++) st[sub][g] *= rs;
      });
    }
  }
  float sum = 0.f;
#pragma unroll
  for (int ds = 0; ds < 2; ds++)
#pragma unroll
    for (int g = 0; g < 16; g++) sum += o[ds][g];
  sum += __shfl_xor(sum, 32);
  float mean = sum * (1.f / 64.f);
  float vs = 0.f;
#pragma unroll
  for (int ds = 0; ds < 2; ds++)
#pragma unroll
    for (int g = 0; g < 16; g++) { float dlt = o[ds][g] - mean; vs += dlt * dlt; }
  vs += __shfl_xor(vs, 32);
  float rstd = rsqrtf(vs * (1.f / 64.f) + 1e-6f);
  int T = Tq0 + wave * 32 + r;
#pragma unroll
  for (int ds = 0; ds < 2; ds++)
#pragma unroll
    for (int g4 = 0; g4 < 4; g4++) {
      int d0 = ds * 32 + 8 * g4 + 4 * h;
      uint2 gt = *(const uint2*)(p.SG() + (size_t)T * 512 + hh * 64 + d0);
      float y0 = (o[ds][4 * g4] - mean) * rstd * bflo(gt.x), y1 = (o[ds][4 * g4 + 1] - mean) * rstd * bfhi(gt.x);
      float y2 = (o[ds][4 * g4 + 2] - mean) * rstd * bflo(gt.y), y3 = (o[ds][4 * g4 + 3] - mean) * rstd * bfhi(gt.y);
      *(uint2*)(p.MIX() + (size_t)T * 1024 + 512 + hh * 64 + d0) = make_uint2(pack2(y0, y1), pack2(y2, y3));
    }
}
DEV void ret_state_job(const Params& p, int b, int hh, int dir, char* smem) {
  u16* sKk = (u16*)smem; u16* sVv = sKk + 64 * 64;
  int t = threadIdx.x;
  const u16* kb = p.RK() + kvoff(false, b, hh, 0, 8, 64, 1024, 0);
  const u16* vb = p.RV() + kvoff(false, b, hh, 0, 8, 64, 1024, 0);
  float xx = dir == 0 ? p.rdf[hh] : p.rdb[hh];
  float lg2 = -log1pf(__expf(-xx)) * 1.4426950408889634f;
  int dk = t >> 2, dvc = (t & 3) * 16;
  float acc[16];
#pragma unroll
  for (int i = 0; i < 16; i++) acc[i] = 0.f;
  for (int ch = 0; ch < 4; ch++) {
    __syncthreads();
#pragma unroll
    for (int i = 0; i < 2; i++) {
      int c = t + 256 * i;
      *(uint4*)(sKk + c * 8) = *(const uint4*)(kb + (size_t)ch * 4096 + c * 8);
      *(uint4*)(sVv + c * 8) = *(const uint4*)(vb + (size_t)ch * 4096 + c * 8);
    }
    __syncthreads();
    for (int jj = 0; jj < 64; jj++) {
      int j = ch * 64 + jj;
      float w = exp2f(lg2 * (float)(dir == 0 ? 255 - j : j));
      float kv = bf2f(sKk[jj * 64 + dk]) * w;
      const uint4* vp = (const uint4*)(sVv + jj * 64 + dvc);
      uint4 v0 = vp[0], v1 = vp[1];
      acc[0] += kv * bflo(v0.x); acc[1] += kv * bfhi(v0.x); acc[2] += kv * bflo(v0.y); acc[3] += kv * bfhi(v0.y);
      acc[4] += kv * bflo(v0.z); acc[5] += kv * bfhi(v0.z); acc[6] += kv * bflo(v0.w); acc[7] += kv * bfhi(v0.w);
      acc[8] += kv * bflo(v1.x); acc[9] += kv * bfhi(v1.x); acc[10] += kv * bflo(v1.y); acc[11] += kv * bfhi(v1.y);
      acc[12] += kv * bflo(v1.z); acc[13] += kv * bfhi(v1.z); acc[14] += kv * bflo(v1.w); acc[15] += kv * bfhi(v1.w);
    }
  }
  float* dst = p.out + (dir == 0 ? OUT_RF : OUT_RB) + ((size_t)(b * 8 + hh) * 64 + dk) * 64 + dvc;
#pragma unroll
  for (int i = 0; i < 4; i++) *(float4*)(dst + 4 * i) = make_float4(acc[4 * i], acc[4 * i + 1], acc[4 * i + 2], acc[4 * i + 3]);
}

DEV void phase_attn0(const Params& p, int bid, int nb, char* smem) {
  for (int it = bid; it < 1280; it += nb) {
    if (it < 256) {
      int b = it >> 6, hq = (it >> 3) & 7, qb = it & 7; int kvh = hq >> 2;
      f32x16 o[2];
      int Tq0 = 4096 + b * 1024 + qb * 128;
      attn_softmax_job<64, false>(p, p.Q1(), Tq0, hq * 64, p.KA() + kvoff(true, b, kvh, -256, 2, 64, 1280, 256), p.KA(), p.VA() + kvoff(true, b, kvh, -256, 2, 64, 1280, 256),
                           20, 0, 0, qb * 128, false, 0.f, o, smem);
      store_o64(p, o, Tq0, hq * 64);
    } else if (it < 512) {
      int j = it - 256; int b = j >> 6, hh = (j >> 3) & 7, qb = j & 7;
      ret_job(p, true, b, hh, qb, smem);
    } else if (it < 768) {
      int j = it - 512; int b = j >> 4, hq = (j >> 1) & 7, qb = j & 1; int kvh = hq >> 2;
      f32x16 o[2];
      int Tq0 = b * 256 + qb * 128;
      attn_softmax_job<64, false>(p, p.Q1(), Tq0, hq * 64, p.KA() + kvoff(false, b, kvh, 0, 2, 64, 1280, 256), p.KA(), p.VA() + kvoff(false, b, kvh, 0, 2, 64, 1280, 256),
                           4, 0, 0, qb * 128, false, 0.f, o, smem);
      store_o64(p, o, Tq0, hq * 64);
    } else if (it < 1024) {
      int j = it - 768; int b = j >> 4, hh = (j >> 1) & 7, qb = j & 1;
      ret_job(p, false, b, hh, qb, smem);
    } else {
      int j = it - 1024; int b = j >> 4, hh = (j >> 1) & 7, dir = j & 1;
      ret_state_job(p, b, hh, dir, smem);
    }
  }
}
DEV void diff_job(const Params& p, bool smp, int b, int hh, int qb, float lam, char* smem) {
  int lane = threadIdx.x & 63, wave = threadIdx.x >> 6, r = lane & 31, h = lane >> 5;
  int c = wave >> 1;
  int Tq0 = (smp ? 4096 + b * 1024 : b * 256) + qb * 64;
  int nt = smp ? 20 : 4;
  const u16* vb = p.VC() + kvoff(smp, b, hh, smp ? -256 : 0, 4, 128, 1280, 256);
  const u16* kb0 = p.KC() + kvoff(smp, b, 2 * hh, smp ? -256 : 0, 8, 64, 1280, 256);
  const u16* kb1 = p.KC() + kvoff(smp, b, 2 * hh + 1, smp ? -256 : 0, 8, 64, 1280, 256);
  f32x16 o[4];
  attn_softmax_job<128, true>(p, p.Q1(), Tq0, (2 * hh + c) * 64, kb0, kb1, vb, nt, 0, 0, 0, false, 0.f, o, smem);
  float* ex = (float*)smem;
  if (wave >= 2) {
#pragma unroll
    for (int ds = 0; ds < 4; ds++)
#pragma unroll
      for (int g = 0; g < 16; g++) ex[(ds * 16 + g) * 128 + (threadIdx.x - 128)] = o[ds][g];
  }
  __syncthreads();
  if (wave < 2) {
    float ss = 0.f;
#pragma unroll
    for (int ds = 0; ds < 4; ds++)
#pragma unroll
      for (int g = 0; g < 16; g++) { float dv = o[ds][g] - lam * ex[(ds * 16 + g) * 128 + threadIdx.x]; o[ds][g] = dv; ss += dv * dv; }
    ss += __shfl_xor(ss, 32);
    float rstd = rsqrtf(ss * (1.f / 128.f) + 1e-6f) * (1.f - LAM_INIT);
    int T = Tq0 + wave * 32 + r;
#pragma unroll
    for (int ds = 0; ds < 4; ds++)
#pragma unroll
      for (int g4 = 0; g4 < 4; g4++) {
        int d0 = ds * 32 + 8 * g4 + 4 * h;
        float4 sg = *(const float4*)(p.subln + d0);
        *(uint2*)(p.MIX() + (size_t)T * 1024 + hh * 128 + d0) =
            make_uint2(pack2(o[ds][4 * g4] * rstd * sg.x, o[ds][4 * g4 + 1] * rstd * sg.y),
                       pack2(o[ds][4 * g4 + 2] * rstd * sg.z, o[ds][4 * g4 + 3] * rstd * sg.w));
      }
  }
}
DEV void phase_attn1(const Params& p, int bid, int nb, char* smem) {
  float d1 = 0.f, d2 = 0.f;
  for (int i = 0; i < 64; i++) { d1 += p.lq1[i] * p.lk1[i]; d2 += p.lq2[i] * p.lk2[i]; }
  float lam = __expf(d1) - __expf(d2) + LAM_INIT;
  for (int it = bid; it < 1024; it += nb) {
    if (it < 256) {
      int b = it >> 6, hh = (it >> 4) & 3, qb = it & 15;
      diff_job(p, true, b, hh, qb, lam, smem);
    } else if (it < 512) {
      int j = it - 256; int b = j >> 6, hq = (j >> 3) & 7, qb = j & 7; int kvh = hq >> 2;
      int q0 = qb * 128;
      int lo = (q0 - 128 < 0 ? 0 : q0 - 128) >> 6, hi = (q0 + 256 > 1024 ? 1024 : q0 + 256) >> 6;
      f32x16 o[2];
      int Tq0 = 4096 + b * 1024 + q0;
      attn_softmax_job<64, false>(p, p.Q2(), Tq0, hq * 64, p.KD() + kvoff(true, b, kvh, -256, 2, 64, 1280, 256), p.KD(), p.VD() + kvoff(true, b, kvh, -256, 2, 64, 1280, 256),
                           4, lo, hi, q0, true, p.dsink[hq] * 1.4426950408889634f, o, smem);
      store_o64(p, o, Tq0, 512 + hq * 64);
    } else if (it < 768) {
      int j = it - 512; int b = j >> 4, hh = (j >> 2) & 3, qb = j & 3;
      diff_job(p, false, b, hh, qb, lam, smem);
    } else {
      int j = it - 768; int b = j >> 4, hq = (j >> 1) & 7, qb = j & 1; int kvh = hq >> 2;
      f32x16 o[2];
      int Tq0 = b * 256 + qb * 128;
      attn_softmax_job<64, false>(p, p.Q2(), Tq0, hq * 64, p.KD() + kvoff(false, b, kvh, 0, 2, 64, 1280, 256), p.KD(), p.VD() + kvoff(false, b, kvh, 0, 2, 64, 1280, 256),
                           4, 0, 0, qb * 128, true, p.dsink[hq] * 1.4426950408889634f, o, smem);
      store_o64(p, o, Tq0, 512 + hq * 64);
    }
  }
}

DEV float ub0(unsigned w) { return (float)(w & 255u); }
DEV float ub1(unsigned w) { return (float)((w >> 8) & 255u); }
DEV float ub2(unsigned w) { return (float)((w >> 16) & 255u); }
DEV float ub3(unsigned w) { return (float)(w >> 24); }
DEV void phase_peer(const Params& p, int layer, int bid, int nb, char* smem) {
  int wave = threadIdx.x >> 6, lane = threadIdx.x & 63;
  float* ws1 = (float*)(smem + wave * 2048); float* ws2 = ws1 + 16;
  int* wi1 = (int*)(ws2 + 16); int* wi2 = wi1 + 16; float* es = (float*)(wi2 + 16); int* eidx = (int*)(es + 16); float* eg = (float*)(eidx + 128);
  const unsigned char* U = p.U8() + (size_t)layer * 16384 * 1024;
  const unsigned char* V = p.V8() + (size_t)layer * 16384 * 1024;
  const float* SU = p.SU() + layer * 16384; const float* SV = p.SV() + layer * 16384;
  const float* gain = p.norm_ffn + layer * 1024;
  for (int T = bid * 4 + wave; T < 8192; T += nb * 4) {
    const float* sc = p.SC() + (size_t)T * 2048;
    for (int hh = 0; hh < 8; hh++) {
      const float* s = sc + hh * 256;
      float a0 = s[lane], a1 = s[lane + 64], b0 = s[128 + lane], b1 = s[192 + lane];
      unsigned ka0 = (fkey(a0) & ~127u) | (unsigned)(127 - lane), ka1 = (fkey(a1) & ~127u) | (unsigned)(63 - lane);
      unsigned kb0 = (fkey(b0) & ~127u) | (unsigned)(127 - lane), kb1 = (fkey(b1) & ~127u) | (unsigned)(63 - lane);
      unsigned pa = 0u, pb = 0u;
      for (int bit = 31; bit >= 0; --bit) {
        unsigned ta = pa | (1u << bit), tb = pb | (1u << bit);
        int ca = __popcll(__ballot(ka0 >= ta)) + __popcll(__ballot(ka1 >= ta));
        int cb = __popcll(__ballot(kb0 >= tb)) + __popcll(__ballot(kb1 >= tb));
        if (ca >= 16) pa = ta;
        if (cb >= 16) pb = tb;
      }
      {
        unsigned long long m0 = __ballot(ka0 >= pa), m1 = __ballot(ka1 >= pa);
        int p0 = mbcnt64(m0), p1 = __popcll(m0) + mbcnt64(m1);
        if (ka0 >= pa) { ws1[p0 & 15] = a0; wi1[p0 & 15] = lane; }
        if (ka1 >= pa) { ws1[p1 & 15] = a1; wi1[p1 & 15] = lane + 64; }
        unsigned long long n0 = __ballot(kb0 >= pb), n1 = __ballot(kb1 >= pb);
        int q0 = mbcnt64(n0), q1 = __popcll(n0) + mbcnt64(n1);
        if (kb0 >= pb) { ws2[q0 & 15] = b0; wi2[q0 & 15] = lane; }
        if (kb1 >= pb) { ws2[q1 & 15] = b1; wi2[q1 & 15] = lane + 64; }
      }
      __builtin_amdgcn_fence(__ATOMIC_ACQ_REL, "wavefront");
      __builtin_amdgcn_wave_barrier();
      int bq = lane & 15, aq = lane >> 4;
      float s2v = ws2[bq];
      float c0 = ws1[aq] + s2v, c1 = ws1[aq + 4] + s2v, c2 = ws1[aq + 8] + s2v, c3 = ws1[aq + 12] + s2v;
      unsigned k0 = (fkey(c0) & ~255u) | (unsigned)(255 - lane), k1 = (fkey(c1) & ~255u) | (unsigned)(191 - lane);
      unsigned k2 = (fkey(c2) & ~255u) | (unsigned)(127 - lane), k3 = (fkey(c3) & ~255u) | (unsigned)(63 - lane);
      unsigned pc = 0u;
      for (int bit = 31; bit >= 0; --bit) {
        unsigned tc = pc | (1u << bit);
        int cc = __popcll(__ballot(k0 >= tc)) + __popcll(__ballot(k1 >= tc)) + __popcll(__ballot(k2 >= tc)) + __popcll(__ballot(k3 >= tc));
        if (cc >= 16) pc = tc;
      }
      {
        unsigned long long m0 = __ballot(k0 >= pc), m1 = __ballot(k1 >= pc), m2 = __ballot(k2 >= pc), m3 = __ballot(k3 >= pc);
        int n0 = __popcll(m0), n1 = n0 + __popcll(m1), n2 = n1 + __popcll(m2);
        int i2b = wi2[bq];
        if (k0 >= pc) { int q = mbcnt64(m0) & 15; es[q] = c0; eidx[hh * 16 + q] = wi1[aq] * 128 + i2b; }
        if (k1 >= pc) { int q = (n0 + mbcnt64(m1)) & 15; es[q] = c1; eidx[hh * 16 + q] = wi1[aq + 4] * 128 + i2b; }
        if (k2 >= pc) { int q = (n1 + mbcnt64(m2)) & 15; es[q] = c2; eidx[hh * 16 + q] = wi1[aq + 8] * 128 + i2b; }
        if (k3 >= pc) { int q = (n2 + mbcnt64(m3)) & 15; es[q] = c3; eidx[hh * 16 + q] = wi1[aq + 12] * 128 + i2b; }
      }
      __builtin_amdgcn_fence(__ATOMIC_ACQ_REL, "wavefront");
      __builtin_amdgcn_wave_barrier();
      float ts = es[lane & 15];
      float mx = row_max16(ts);
      float pe = __expf(ts - mx);
      float sm = row_sum16(pe);
      if (lane < 16) eg[hh * 16 + lane] = pe / sm;
      __builtin_amdgcn_fence(__ATOMIC_ACQ_REL, "wavefront");
      __builtin_amdgcn_wave_barrier();
    }
    int mb = T < 4096 ? 0 : 1 + ((T - 4096) >> 10);
    const float* md = p.MOD() + (size_t)(layer * 5 + mb) * 6144;
    float4 xv[4]; float ssx = 0.f;
#pragma unroll
    for (int i = 0; i < 4; i++) { xv[i] = *(const float4*)(p.X() + (size_t)T * 1024 + (i * 64 + lane) * 4); ssx += xv[i].x * xv[i].x + xv[i].y * xv[i].y + xv[i].z * xv[i].z + xv[i].w * xv[i].w; }
    ssx = wave_sum(ssx);
    float rstdx = rsqrtf(ssx * (1.f / 1024.f) + 1e-6f);
    float4 hv[4]; float hmax = 0.f;
#pragma unroll
    for (int i = 0; i < 4; i++) {
      int col = (i * 64 + lane) * 4;
      float4 g = *(const float4*)(gain + col), sh = *(const float4*)(md + 3 * 1024 + col), scl = *(const float4*)(md + 4 * 1024 + col);
      hv[i].x = xv[i].x * rstdx * g.x * (1.f + scl.x) + sh.x; hv[i].y = xv[i].y * rstdx * g.y * (1.f + scl.y) + sh.y;
      hv[i].z = xv[i].z * rstdx * g.z * (1.f + scl.z) + sh.z; hv[i].w = xv[i].w * rstdx * g.w * (1.f + scl.w) + sh.w;
      hmax = fmaxf(hmax, fmaxf(fmaxf(fabsf(hv[i].x), fabsf(hv[i].y)), fmaxf(fabsf(hv[i].z), fabsf(hv[i].w))));
    }
    hmax = wave_max_f(hmax);
    float hinv = hmax > 0.f ? 127.f / hmax : 0.f, hscale = hmax * (1.f / 127.f);
    int hq[4];
#pragma unroll
    for (int i = 0; i < 4; i++) {
      unsigned b0 = (unsigned)((int)rintf(hv[i].x * hinv)) & 255u, b1 = (unsigned)((int)rintf(hv[i].y * hinv)) & 255u;
      unsigned b2 = (unsigned)((int)rintf(hv[i].z * hinv)) & 255u, b3 = (unsigned)((int)rintf(hv[i].w * hinv)) & 255u;
      hq[i] = (int)(b0 | (b1 << 8) | (b2 << 16) | (b3 << 24));
    }
#define PLOAD8(SET, TBL, B0) _Pragma("unroll") for (int j = 0; j < 8; j++) { \
        int e_ = __builtin_amdgcn_readfirstlane(eidx[(B0) * 8 + j]); SET[j] = *(const u32x4*)(TBL + (size_t)e_ * 1024 + lane * 16); }
#define PDOT8(SET, B0) _Pragma("unroll") for (int j = 0; j < 8; j++) { \
        int d_ = __builtin_amdgcn_sdot4(hq[0], (int)SET[j][0], 0, false); d_ = __builtin_amdgcn_sdot4(hq[1], (int)SET[j][1], d_, false); \
        d_ = __builtin_amdgcn_sdot4(hq[2], (int)SET[j][2], d_, false); d_ = __builtin_amdgcn_sdot4(hq[3], (int)SET[j][3], d_, false); \
        float D_ = (float)wave_sum_i(d_); int e_ = (B0) * 8 + j; bool me_ = lane == (e_ & 63); \
        a0 = (me_ && e_ < 64) ? D_ : a0; a1 = (me_ && e_ >= 64) ? D_ : a1; }
#define PACC8(SET, B0) _Pragma("unroll") for (int j = 0; j < 8; j++) { \
        int e_ = (B0) * 8 + j; float w = rlane(e_ < 64 ? w0 : w1, e_ & 63); \
        acc[0] += w * ub0(SET[j][0]); acc[1] += w * ub1(SET[j][0]); acc[2] += w * ub2(SET[j][0]); acc[3] += w * ub3(SET[j][0]); \
        acc[4] += w * ub0(SET[j][1]); acc[5] += w * ub1(SET[j][1]); acc[6] += w * ub2(SET[j][1]); acc[7] += w * ub3(SET[j][1]); \
        acc[8] += w * ub0(SET[j][2]); acc[9] += w * ub1(SET[j][2]); acc[10] += w * ub2(SET[j][2]); acc[11] += w * ub3(SET[j][2]); \
        acc[12] += w * ub0(SET[j][3]); acc[13] += w * ub1(SET[j][3]); acc[14] += w * ub2(SET[j][3]); acc[15] += w * ub3(SET[j][3]); }
    float acc[16];
#pragma unroll
    for (int i = 0; i < 16; i++) acc[i] = 0.f;
    float a0 = 0.f, a1 = 0.f;
    u32x4 sa[8], sb[8];
    PLOAD8(sa, U, 0)
#pragma unroll 1
    for (int bi = 0; bi < 16; bi += 2) {
      PLOAD8(sb, U, bi + 1)
      PDOT8(sa, bi)
      if (bi + 2 < 16) { PLOAD8(sa, U, bi + 2) } else { PLOAD8(sa, V, 0) }
      PDOT8(sb, bi + 1)
    }
    int e0 = eidx[lane], e1 = eidx[lane + 64];
    float w0 = eg[lane] * gelu_tanh(a0 * (SU[e0] * hscale)) * SV[e0];
    float w1 = eg[lane + 64] * gelu_tanh(a1 * (SU[e1] * hscale)) * SV[e1];
    float wsum = wave_sum(w0 + w1);
#pragma unroll 1
    for (int bi = 0; bi < 16; bi += 2) {
      PLOAD8(sb, V, bi + 1)
      PACC8(sa, bi)
      if (bi + 2 < 16) { PLOAD8(sa, V, bi + 2) }
      PACC8(sb, bi + 1)
    }
    float x2[16]; float ss = 0.f;
#pragma unroll
    for (int i = 0; i < 4; i++) {
      int col = (i * 64 + lane) * 4;
      float4 ga = *(const float4*)(md + 5 * 1024 + col);
      x2[i * 4 + 0] = xv[i].x + ga.x * (acc[i * 4 + 0] - 128.f * wsum); x2[i * 4 + 1] = xv[i].y + ga.y * (acc[i * 4 + 1] - 128.f * wsum);
      x2[i * 4 + 2] = xv[i].z + ga.z * (acc[i * 4 + 2] - 128.f * wsum); x2[i * 4 + 3] = xv[i].w + ga.w * (acc[i * 4 + 3] - 128.f * wsum);
    }
#pragma unroll
    for (int i = 0; i < 16; i++) ss += x2[i] * x2[i];
    ss = wave_sum(ss);
    float rstd = rsqrtf(ss * (1.f / 1024.f) + 1e-6f);
    if (layer == 0) {
      const float* md1 = p.MOD() + (size_t)(5 + mb) * 6144;
#pragma unroll
      for (int i = 0; i < 4; i++) {
        int col = (i * 64 + lane) * 4;
        *(float4*)(p.X() + (size_t)T * 1024 + col) = make_float4(x2[i * 4], x2[i * 4 + 1], x2[i * 4 + 2], x2[i * 4 + 3]);
        float4 g = *(const float4*)(p.norm_mix + 1024 + col), sh = *(const float4*)(md1 + col), scl = *(const float4*)(md1 + 1024 + col);
        float y0 = x2[i * 4] * rstd * g.x * (1.f + scl.x) + sh.x, y1 = x2[i * 4 + 1] * rstd * g.y * (1.f + scl.y) + sh.y;
        float y2 = x2[i * 4 + 2] * rstd * g.z * (1.f + scl.z) + sh.z, y3 = x2[i * 4 + 3] * rstd * g.w * (1.f + scl.w) + sh.w;
        *(uint2*)(p.H() + (size_t)T * 1024 + col) = make_uint2(pack2(y0, y1), pack2(y2, y3));
      }
    } else {
#pragma unroll
      for (int i = 0; i < 4; i++) {
        int col = (i * 64 + lane) * 4;
        float4 g = *(const float4*)(p.norm_final + col);
        *(float4*)(p.out + (size_t)T * 1024 + col) = make_float4(x2[i * 4] * rstd * g.x, x2[i * 4 + 1] * rstd * g.y, x2[i * 4 + 2] * rstd * g.z, x2[i * 4 + 3] * rstd * g.w);
      }
    }
  }
}

#define XB_TMO      128
#define XB_XCNT(j)  (256  + 64 * (j))
#define XB_XSUB(j)  (1280 + 64 * (j))
#define XB_XGEN(j)  (2304 + 64 * (j))
#define XB_TOP      3328
#define XB_TOPGEN   3392
#define XCD_BAR_WORDS 3456
#define XB_SPIN_CAP (1u << 20)
#define LAS __attribute__((address_space(3)))
DEV unsigned xb_ld(unsigned* p)              { return __hip_atomic_load(p, __ATOMIC_RELAXED, __HIP_MEMORY_SCOPE_AGENT); }
DEV unsigned xb_add(unsigned* p, unsigned v) { return __hip_atomic_fetch_add(p, v, __ATOMIC_RELAXED, __HIP_MEMORY_SCOPE_AGENT); }
DEV unsigned xb_xcc_id() { return (unsigned)__builtin_amdgcn_s_getreg((3 << 11) | 20) & 0xFu; }
#define XB_SPIN(cond, bar) do { unsigned _sp = 0; while (cond) { __builtin_amdgcn_s_sleep(4); \
    if ((++_sp & 255u) == 0u) { if (xb_ld(&(bar)[XB_TMO])) break; if (_sp > XB_SPIN_CAP) { atomicAdd(&(bar)[XB_TMO], 1u); break; } } } } while (0)
struct XcdBarrier { unsigned* bar; unsigned x; volatile LAS unsigned* st; };
DEV XcdBarrier xcd_barrier_post(unsigned* bar, volatile LAS unsigned* st) {
  XcdBarrier b; b.bar = bar; b.x = xb_xcc_id(); b.st = st;
  if (threadIdx.x == 0) (void)xb_add(&bar[XB_XCNT(b.x)], 1u);
  return b;
}
DEV void xcd_barrier_complete(unsigned* bar, unsigned x, unsigned& nloc, unsigned& nx) {
  const unsigned G = gridDim.x * gridDim.y * gridDim.z;
  unsigned sum, cnt, mine, sp = 0u;
  for (;;) {
    sum = 0u; cnt = 0u; mine = 0u;
#pragma unroll
    for (unsigned j = 0; j < 16; ++j) { const unsigned c = xb_ld(&bar[XB_XCNT(j)]); sum += c; cnt += (c > 0u) ? 1u : 0u; mine = (j == x) ? c : mine; }
    if (sum == G) break;
    __builtin_amdgcn_s_sleep(1);
    if ((++sp & 255u) == 0u) { if (xb_ld(&bar[XB_TMO])) break; if (sp > XB_SPIN_CAP) { atomicAdd(&bar[XB_TMO], 1u); break; } }
  }
  nloc = mine > 0u ? mine : 1u; nx = cnt > 0u ? cnt : 1u;
}
DEV void xcd_barrier(const XcdBarrier& b) {
  asm volatile("s_waitcnt vmcnt(0)" ::: "memory");
  __syncthreads();
  if (threadIdx.x == 0) {
    unsigned* bar = b.bar;
    __builtin_amdgcn_s_waitcnt(0);
    unsigned nloc = b.st[0], nx = b.st[1];
    if (nloc == 0u) { xcd_barrier_complete(bar, b.x, nloc, nx); b.st[0] = nloc; b.st[1] = nx; }
    const unsigned old = xb_add(&bar[XB_XSUB(b.x)], 1u);
    const unsigned gen = old / nloc;
    if (old + 1u == (gen + 1u) * nloc) {
      __builtin_amdgcn_fence(__ATOMIC_RELEASE, "agent");
      asm volatile("s_waitcnt vmcnt(0)" ::: "memory");
      const unsigned og = xb_add(&bar[XB_TOP], 1u);
      const unsigned tg = og / nx;
      if (og + 1u == (tg + 1u) * nx) xb_add(&bar[XB_TOPGEN], 1u);
      else XB_SPIN(xb_ld(&bar[XB_TOPGEN]) == tg, bar);
      __builtin_amdgcn_fence(__ATOMIC_ACQUIRE, "agent");
      xb_add(&bar[XB_XGEN(b.x)], 1u);
      asm volatile("s_waitcnt vmcnt(0)" ::: "memory");
    } else {
      XB_SPIN(xb_ld(&bar[XB_XGEN(b.x)]) == gen, bar);
      __builtin_amdgcn_fence(__ATOMIC_ACQUIRE, "agent");
      asm volatile("s_waitcnt vmcnt(0)" ::: "memory");
    }
  }
  __syncthreads();
}

constexpr int NPHASE = 14;
DEV void run_phase(const Params& p, int ph, int bid, int nb, char* smem) {
  switch (ph) {
    case 0: phase_prep(p, bid, nb, smem); break;
    case 1: phase_ada(p, 0, p.norm_mix, 0, 1, true, bid, nb); break;
    case 2: {
      gemm_phase(p.H(), 1024, p.WT_EVIN(), 1024, 1024, 64, 22, bid, nb, smem, [&](int m0, int n0, const float* Cs) { epi_inproj0(p, m0, n0, Cs); });
      int first = 0, cnt = nb;
      if ((nb & 7) == 0) { int slots = nb >> 3, rem = (8 * 22) % slots; if (rem > 0) { first = rem * 8; cnt = nb - first; } }
      int me = bid - first;
      __syncthreads();
      if (me >= 0) {
        float* sm = (float*)smem;
        for (int j = me; j < 1344; j += cnt) {
          if (j < 576) prep_transpose(p.od_w_in, 2304, p.WT_ODIN(), j, sm);
          else if (j < 832) prep_transpose(p.od_w_out, 1024, p.WT_ODOUT(), j - 576, sm);
          else prep_transpose(p.peer_wq + (size_t)1024 * 2048, 2048, p.WT_PQ() + (size_t)2048 * 1024, j - 832, sm);
        }
      }
    } break;
    case 3: phase_attn0(p, bid, nb, smem); break;
    case 4: gemm_phase(p.MIX(), 1024, p.WT_EVOUT(), 1024, 1024, 64, 8, bid, nb, smem, [&](int m0, int n0, const float* Cs) { epi_outproj(p, 0, m0, n0, Cs); }); break;
    case 5: phase_ada(p, 0, p.norm_ffn, 3, 4, false, bid, nb); break;
    case 11: phase_ada(p, 1, p.norm_ffn + 1024, 3, 4, false, bid, nb); break;
    case 6: case 12: {
      int layer = ph == 6 ? 0 : 1;
      const u16* sk = p.SUBK() + (size_t)layer * 16 * 128 * 128;
      int qkey = ((bid >> 8) ^ bid) & 1;
      auto quant_l0 = [&]() {
        for (int j = bid; j < 2048; j += nb) {
          if (j < 1024) prep_quant<true>(p.peer_u, p.U8(), p.SU(), j * 16); else prep_quant<false>(p.peer_v, p.V8(), p.SV(), (j - 1024) * 16);
        }
      };
      if (layer == 0 && qkey == 0) quant_l0();
      gemm_phase(p.H(), 1024, p.WT_PQ() + (size_t)layer * 2048 * 1024, 1024, 1024, 64, 16, bid, nb, smem, [&](int m0, int n0, const float* Cs) {
        int lane = threadIdx.x & 63, wave = threadIdx.x >> 6;
#pragma unroll 8
        for (int rr = wave; rr < 128; rr += 4) {
          float2 c = *(const float2*)(Cs + rr * 128 + lane * 2);
          *(unsigned*)(p.PQ() + (size_t)(m0 + rr) * 2048 + n0 + lane * 2) = pack2(c.x, c.y);
        }
        asm volatile("s_waitcnt vmcnt(0)" ::: "memory");
        __syncthreads();
        int hc = n0 >> 7;
        f32x16 acc[2][2];
        zero16(acc[0][0]); zero16(acc[0][1]); zero16(acc[1][0]); zero16(acc[1][1]);
        gemm_tile(p.PQ() + (size_t)m0 * 2048 + hc * 128, 2048, sk + (size_t)hc * 128 * 128, 128, 128, smem, acc);
        const float* Cs2 = (const float*)smem;
#pragma unroll 8
        for (int rr = wave; rr < 128; rr += 4) {
          float2 c = *(const float2*)(Cs2 + rr * 128 + lane * 2);
          *(float2*)(p.SC() + (size_t)(m0 + rr) * 2048 + hc * 128 + lane * 2) = c;
        }
      });
      if (layer == 0 && qkey == 1) quant_l0();
    } break;
    case 7: phase_peer(p, 0, bid, nb, smem); break;
    case 13: phase_peer(p, 1, bid, nb, smem); break;
    case 8: {
      gemm_phase(p.H(), 1024, p.WT_ODIN(), 1024, 1024, 64, 18, bid, nb, smem, [&](int m0, int n0, const float* Cs) { epi_inproj1(p, m0, n0, Cs); });
      int first = 0, cnt = nb;
      if ((nb & 7) == 0) { int slots = nb >> 3, rem = (8 * 18) % slots; if (rem > 0) { first = rem * 8; cnt = nb - first; } }
      int me = ((nb & 7) == 0) ? ((bid >> 3) * 8 + (bid & 7)) - first : bid;
      if (me >= 0) {
        for (int j = me; j < 2048; j += cnt) {
          if (j < 1024) prep_quant<true>(p.peer_u, p.U8(), p.SU(), 16384 + j * 16); else prep_quant<false>(p.peer_v, p.V8(), p.SV(), 16384 + (j - 1024) * 16);
        }
      }
    } break;
    case 9: phase_attn1(p, bid, nb, smem); break;
    case 10: gemm_phase(p.MIX(), 1024, p.WT_ODOUT(), 1024, 1024, 64, 8, bid, nb, smem, [&](int m0, int n0, const float* Cs) { epi_outproj(p, 1, m0, n0, Cs); }); break;
    default: break;
  }
}

constexpr size_t PARAMS_OFF = 330036736ull;
template <int PH> DEV void run_all(const Params& p, cg::grid_group& grid, const XcdBarrier& xb, char* smem) {
  if constexpr (PH == 0) {
    if (blockIdx.x == 0 && threadIdx.x < sizeof(Params) / 8) ((unsigned long long*)(p.ws + PARAMS_OFF))[threadIdx.x] = ((const unsigned long long*)&p)[threadIdx.x];
    run_phase(p, PH, blockIdx.x, gridDim.x, smem);
  } else {
    run_phase(p, PH, blockIdx.x, gridDim.x, smem);
  }
  if constexpr (PH + 1 < NPHASE) {
    if (PH == 0 && p.ws == nullptr) grid.sync();
    xcd_barrier(xb);
    run_all<PH + 1>(p, grid, xb, smem);
  }
}
__global__ void __launch_bounds__(256, 2) mega_kernel(Params p) {
  __shared__ __attribute__((aligned(16))) char smem[77824];
  __shared__ uint4 xb_words;
  if (threadIdx.x == 0) xb_words = make_uint4(0u, 0u, 0u, 0u);
  __syncthreads();
  XcdBarrier xb = xcd_barrier_post(p.BAR(), (volatile LAS unsigned*)&xb_words);
  cg::grid_group grid = cg::this_grid();
  run_all<0>(p, grid, xb, smem);
}
#if MULTI_LAUNCH
template <int PH> __global__ void __launch_bounds__(256, 2) phase_kernel(Params p) {
  __shared__ __attribute__((aligned(16))) char smem[77824];
  run_phase(p, PH, blockIdx.x, gridDim.x, smem);
}
template <int PH> static void launch_all(const Params& p, int grid, hipStream_t s) {
  phase_kernel<PH><<<grid, 256, 0, s>>>(p);
  if constexpr (PH + 1 < NPHASE) launch_all<PH + 1>(p, grid, s);
}
#endif

extern "C" void kernel_launch(void* const* d_in, const int* in_sizes, int n_in, void* d_out, int out_size, void* d_ws, size_t ws_size, hipStream_t stream) {
  Params p{};
  const float* const* in = (const float* const*)d_in;
  p.xp = in[0]; p.xs = in[1]; p.c = in[2]; p.cctx = in[3]; p.cak = in[4]; p.cav = in[5]; p.srf = in[6]; p.srb = in[7];
  p.cck = in[8]; p.ccv = in[9]; p.cdk = in[10]; p.cdv = in[11];
  p.mod_w = in[12]; p.mod_b = in[13]; p.norm_mix = in[14]; p.norm_ffn = in[15]; p.norm_final = in[16];
  p.ev_w_in = in[17]; p.ev_w_out = in[18]; p.a_q_norm = in[19]; p.a_k_norm = in[20]; p.rdf = in[21]; p.rdb = in[22];
  p.od_w_in = in[23]; p.od_w_out = in[24]; p.lq1 = in[25]; p.lk1 = in[26]; p.lq2 = in[27]; p.lk2 = in[28]; p.subln = in[29]; p.dsink = in[30];
  p.peer_wq = in[31]; p.peer_sk = in[32]; p.peer_u = in[33]; p.peer_v = in[34];
  p.out = (float*)d_out;
  p.ws = (char*)d_ws;
  (void)in_sizes; (void)n_in; (void)out_size; (void)ws_size;
#if MULTI_LAUNCH
  launch_all<0>(p, 512, stream);
#else
  static int grid_blocks = 0;
  if (!grid_blocks) {
    int dev = 0, cus = 0, per_cu = 0;
    hipGetDevice(&dev);
    hipDeviceGetAttribute(&cus, hipDeviceAttributeMultiprocessorCount, dev);
    hipOccupancyMaxActiveBlocksPerMultiprocessor(&per_cu, mega_kernel, 256, 0);
    if (per_cu > 2) per_cu = 2;
    if (per_cu < 1) per_cu = 1;
    grid_blocks = cus * per_cu;
  }
  (void)hipMemsetAsync(d_ws, 0, XCD_BAR_WORDS * 4, stream);
  void* args[] = {&p};
  hipError_t e = hipLaunchCooperativeKernel((void*)mega_kernel, dim3(grid_blocks), dim3(256), args, 0, stream);
  if (e != hipSuccess) fprintf(stderr, "cooperative launch failed: %s (grid %d)\n", hipGetErrorString(e), grid_blocks);
#endif
}
```

```cpp
#include <hip/hip_runtime.h>
#include <hip/hip_cooperative_groups.h>
#include <cstdio>
namespace cg = cooperative_groups;

#ifndef MULTI_LAUNCH
#define MULTI_LAUNCH 0
#endif

typedef unsigned short u16;
typedef __attribute__((ext_vector_type(8))) short bf16x8;
typedef __attribute__((ext_vector_type(16))) float f32x16;
typedef __attribute__((ext_vector_type(4))) unsigned u32x4;

#define DEV __device__ __forceinline__

constexpr size_t OUT_AK = 8388608, OUT_AV = 8912896, OUT_RF = 9437184, OUT_RB = 9961472,
                 OUT_CK = 10485760, OUT_CV = 12582912, OUT_DK = 14680064, OUT_DV = 15204352;
constexpr float LAM_INIT = 0.35550906f;

struct Params {
  const float *xp, *xs, *c, *cctx, *cak, *cav, *srf, *srb, *cck, *ccv, *cdk, *cdv;
  const float *mod_w, *mod_b, *norm_mix, *norm_ffn, *norm_final;
  const float *ev_w_in, *ev_w_out, *a_q_norm, *a_k_norm, *rdf, *rdb;
  const float *od_w_in, *od_w_out, *lq1, *lk1, *lq2, *lk2, *subln, *dsink;
  const float *peer_wq, *peer_sk, *peer_u, *peer_v;
  float* out;
  char* ws;
  __device__ __forceinline__ unsigned* BAR() const { return (unsigned*)(ws + 0ull); }
  __device__ __forceinline__ float* MOD() const { return (float*)(ws + 13824ull); }
  __device__ __forceinline__ float* ROPEC() const { return (float*)(ws + 259584ull); }
  __device__ __forceinline__ float* ROPES() const { return (float*)(ws + 390656ull); }
  __device__ __forceinline__ float* X() const { return (float*)(ws + 521728ull); }
  __device__ __forceinline__ float* SC() const { return (float*)(ws + 34076160ull); }
  __device__ __forceinline__ u16* WT_EVIN() const { return (u16*)(ws + 101185024ull); }
  __device__ __forceinline__ u16* WT_EVOUT() const { return (u16*)(ws + 106952192ull); }
  __device__ __forceinline__ u16* WT_ODIN() const { return (u16*)(ws + 109049344ull); }
  __device__ __forceinline__ u16* WT_ODOUT() const { return (u16*)(ws + 113767936ull); }
  __device__ __forceinline__ u16* WT_PQ() const { return (u16*)(ws + 115865088ull); }
  __device__ __forceinline__ u16* SUBK() const { return (u16*)(ws + 124253696ull); }
  __device__ __forceinline__ unsigned char* U8() const { return (unsigned char*)(ws + 125302272ull); }
  __device__ __forceinline__ unsigned char* V8() const { return (unsigned char*)(ws + 158856704ull); }
  __device__ __forceinline__ float* SU() const { return (float*)(ws + 192411136ull); }
  __device__ __forceinline__ float* SV() const { return (float*)(ws + 192542208ull); }
  __device__ __forceinline__ u16* H() const { return (u16*)(ws + 192673280ull); }
  __device__ __forceinline__ u16* MIX() const { return (u16*)(ws + 209450496ull); }
  __device__ __forceinline__ u16* Q1() const { return (u16*)(ws + 226227712ull); }
  __device__ __forceinline__ u16* Q2() const { return (u16*)(ws + 234616320ull); }
  __device__ __forceinline__ u16* SG() const { return (u16*)(ws + 243004928ull); }
  __device__ __forceinline__ u16* KA() const { return (u16*)(ws + 251393536ull); }
  __device__ __forceinline__ u16* VA() const { return (u16*)(ws + 253752832ull); }
  __device__ __forceinline__ u16* RK() const { return (u16*)(ws + 256112128ull); }
  __device__ __forceinline__ u16* RV() const { return (u16*)(ws + 264500736ull); }
  __device__ __forceinline__ u16* KC() const { return (u16*)(ws + 272889344ull); }
  __device__ __forceinline__ u16* VC() const { return (u16*)(ws + 282326528ull); }
  __device__ __forceinline__ u16* KD() const { return (u16*)(ws + 291763712ull); }
  __device__ __forceinline__ u16* VD() const { return (u16*)(ws + 294123008ull); }
  __device__ __forceinline__ u16* PQ() const { return (u16*)(ws + 296482304ull); }
};

DEV float bf2f(unsigned b) { return __uint_as_float(b << 16); }
typedef __bf16 bf16v2 __attribute__((ext_vector_type(2)));
typedef float f32v2 __attribute__((ext_vector_type(2)));
DEV unsigned pack2(float a, float b) { f32v2 v = {a, b}; return __builtin_bit_cast(unsigned, __builtin_convertvector(v, bf16v2)); }
DEV u16 f2bf(float f) { return (u16)(pack2(f, 0.f) & 0xffffu); }
DEV float bflo(unsigned w) { return __uint_as_float(w << 16); }
DEV float bfhi(unsigned w) { return __uint_as_float(w & 0xffff0000u); }
DEV float silu_f(float v) { return v / (1.f + __expf(-v)); }
DEV float gelu_tanh(float a) {
  float z = 0.7978845608f * (a + 0.044715f * a * a * a);
  float e = __expf(2.f * z);
  float th = 1.f - 2.f / (e + 1.f);
  return 0.5f * a * (1.f + th);
}
template <int CTRL> DEV float dpp_f(float v) {
  return __int_as_float(__builtin_amdgcn_update_dpp(0, __float_as_int(v), CTRL, 0xF, 0xF, true));
}
template <int CTRL> DEV unsigned dpp_u(unsigned v) {
  return (unsigned)__builtin_amdgcn_update_dpp(0, (int)v, CTRL, 0xF, 0xF, true);
}
DEV float row_sum16(float v) {
  v += dpp_f<0xB1>(v); v += dpp_f<0x4E>(v); v += dpp_f<0x141>(v); v += dpp_f<0x140>(v); return v;
}
DEV float row_max16(float v) {
  v = fmaxf(v, dpp_f<0xB1>(v)); v = fmaxf(v, dpp_f<0x4E>(v)); v = fmaxf(v, dpp_f<0x141>(v)); v = fmaxf(v, dpp_f<0x140>(v)); return v;
}
DEV float rlane(float v, int l) { return __int_as_float(__builtin_amdgcn_readlane(__float_as_int(v), l)); }
DEV float wave_sum(float v) {
  v = row_sum16(v);
  return (rlane(v, 0) + rlane(v, 16)) + (rlane(v, 32) + rlane(v, 48));
}
DEV unsigned wave_max_u(unsigned v) {
  v = max(v, dpp_u<0xB1>(v)); v = max(v, dpp_u<0x4E>(v)); v = max(v, dpp_u<0x141>(v)); v = max(v, dpp_u<0x140>(v));
  unsigned a = (unsigned)__builtin_amdgcn_readlane((int)v, 0), b = (unsigned)__builtin_amdgcn_readlane((int)v, 16);
  unsigned c = (unsigned)__builtin_amdgcn_readlane((int)v, 32), d = (unsigned)__builtin_amdgcn_readlane((int)v, 48);
  return max(max(a, b), max(c, d));
}
DEV float half_sum32(float v) { v = row_sum16(v); return v + __shfl_xor(v, 16); }
DEV unsigned fkey(float f) { unsigned u = __float_as_uint(f); return (u & 0x80000000u) ? ~u : (u | 0x80000000u); }
DEV f32x16 mfma32(bf16x8 a, bf16x8 b, f32x16 c) { return __builtin_amdgcn_mfma_f32_32x32x16_bf16(a, b, c, 0, 0, 0); }
DEV void zero16(f32x16& v) {
#pragma unroll
  for (int i = 0; i < 16; i++) v[i] = 0.f;
}
DEV size_t kvoff(bool smp, int b, int hh, int tpos, int H, int DW, int LS, int off) {
  return smp ? (size_t)4096 * H * DW + ((size_t)(b * H + hh) * LS + off + tpos) * DW
             : ((size_t)(b * H + hh) * 256 + tpos) * DW;
}


DEV float wave_max_f(float v) {
  v = row_max16(v);
  return fmaxf(fmaxf(rlane(v, 0), rlane(v, 16)), fmaxf(rlane(v, 32), rlane(v, 48)));
}
DEV int wave_sum_i(int v) {
  v += (int)dpp_u<0xB1>((unsigned)v); v += (int)dpp_u<0x4E>((unsigned)v); v += (int)dpp_u<0x141>((unsigned)v); v += (int)dpp_u<0x140>((unsigned)v);
  return (__builtin_amdgcn_readlane(v, 0) + __builtin_amdgcn_readlane(v, 16)) + (__builtin_amdgcn_readlane(v, 32) + __builtin_amdgcn_readlane(v, 48));
}
DEV int mbcnt64(unsigned long long m) { return (int)__builtin_amdgcn_mbcnt_hi((unsigned)(m >> 32), __builtin_amdgcn_mbcnt_lo((unsigned)m, 0u)); }
template <bool SGN> DEV void prep_quant(const float* __restrict__ src, unsigned char* __restrict__ dst, float* __restrict__ scale, int row0) {
  int lane = threadIdx.x & 63, wave = threadIdx.x >> 6;
  int rbase = row0 + wave * 4;
  float4 v[4][4];
#pragma unroll
  for (int q = 0; q < 4; q++)
#pragma unroll
    for (int i = 0; i < 4; i++) v[q][i] = *(const float4*)(src + (size_t)(rbase + q) * 1024 + (i * 64 + lane) * 4);
#pragma unroll
  for (int q = 0; q < 4; q++) {
    float mx = 0.f;
#pragma unroll
    for (int i = 0; i < 4; i++) mx = fmaxf(mx, fmaxf(fmaxf(fabsf(v[q][i].x), fabsf(v[q][i].y)), fmaxf(fabsf(v[q][i].z), fabsf(v[q][i].w))));
    mx = wave_max_f(mx);
    float inv = mx > 0.f ? 127.f / mx : 0.f;
    unsigned w[4];
#pragma unroll
    for (int i = 0; i < 4; i++) {
      int off = SGN ? 0 : 128;
      unsigned b0 = (unsigned)((int)rintf(v[q][i].x * inv) + off) & 255u, b1 = (unsigned)((int)rintf(v[q][i].y * inv) + off) & 255u;
      unsigned b2 = (unsigned)((int)rintf(v[q][i].z * inv) + off) & 255u, b3 = (unsigned)((int)rintf(v[q][i].w * inv) + off) & 255u;
      w[i] = b0 | (b1 << 8) | (b2 << 16) | (b3 << 24);
    }
    *(uint4*)(dst + (size_t)(rbase + q) * 1024 + lane * 16) = make_uint4(w[0], w[1], w[2], w[3]);
    if (lane == 0) scale[rbase + q] = mx * (1.f / 127.f);
  }
}

DEV void prep_transpose(const float* __restrict__ W, int N, u16* __restrict__ Wt, int tile, float* sm) {
  int ntn = N >> 6; int kt = tile / ntn, nt = tile % ntn;
  int k0 = kt * 64, n0 = nt * 64; int t = threadIdx.x;
#pragma unroll
  for (int i = 0; i < 4; i++) {
    int k = (t >> 4) + 16 * i; int c4 = (t & 15) * 4;
    float4 v = *(const float4*)(W + (size_t)(k0 + k) * N + n0 + c4);
    sm[k * 65 + c4] = v.x; sm[k * 65 + c4 + 1] = v.y; sm[k * 65 + c4 + 2] = v.z; sm[k * 65 + c4 + 3] = v.w;
  }
  __syncthreads();
  int n = t >> 2, kc = (t & 3) * 16;
  unsigned pk[8];
#pragma unroll
  for (int j = 0; j < 8; j++) pk[j] = pack2(sm[(kc + 2 * j) * 65 + n], sm[(kc + 2 * j + 1) * 65 + n]);
  uint4* dst = (uint4*)(Wt + (size_t)(n0 + n) * 1024 + k0 + kc);
  dst[0] = make_uint4(pk[0], pk[1], pk[2], pk[3]);
  dst[1] = make_uint4(pk[4], pk[5], pk[6], pk[7]);
  __syncthreads();
}
DEV void conv_item(const float* __restrict__ src, u16* __restrict__ dst) {
  int t = threadIdx.x;
#pragma unroll
  for (int i = 0; i < 8; i++) {
    int e = (i * 256 + t) * 8;
    float4 a = *(const float4*)(src + e), b = *(const float4*)(src + e + 4);
    *(uint4*)(dst + e) = make_uint4(pack2(a.x, a.y), pack2(a.z, a.w), pack2(b.x, b.y), pack2(b.z, b.w));
  }
}
DEV void prep_mod(const Params& p, int it, float* sm) {
  int l = it / 96, n0 = (it % 96) * 64; int t = threadIdx.x;
  float* sc = sm;
  for (int i = t; i < 5120; i += 256) {
    int b = i >> 10, k = i & 1023;
    float v = (b == 0) ? p.cctx[k] : p.c[(b - 1) * 1024 + k];
    sc[i] = silu_f(v);
  }
  __syncthreads();
  int cq = t & 15, kg = t >> 4;
  float4 a0 = make_float4(0.f, 0.f, 0.f, 0.f), a1 = a0, a2 = a0, a3 = a0, a4 = a0;
  const float* w = p.mod_w + (size_t)l * 1024 * 6144 + n0 + cq * 4;
  for (int k0 = kg; k0 < 1024; k0 += 128) {
    float4 wv[8];
#pragma unroll
    for (int u = 0; u < 8; u++) wv[u] = *(const float4*)(w + (size_t)(k0 + 16 * u) * 6144);
#pragma unroll
    for (int u = 0; u < 8; u++) {
      int k = k0 + 16 * u;
      float s0 = sc[k], s1 = sc[1024 + k], s2 = sc[2048 + k], s3 = sc[3072 + k], s4 = sc[4096 + k];
      a0.x += s0 * wv[u].x; a0.y += s0 * wv[u].y; a0.z += s0 * wv[u].z; a0.w += s0 * wv[u].w;
      a1.x += s1 * wv[u].x; a1.y += s1 * wv[u].y; a1.z += s1 * wv[u].z; a1.w += s1 * wv[u].w;
      a2.x += s2 * wv[u].x; a2.y += s2 * wv[u].y; a2.z += s2 * wv[u].z; a2.w += s2 * wv[u].w;
      a3.x += s3 * wv[u].x; a3.y += s3 * wv[u].y; a3.z += s3 * wv[u].z; a3.w += s3 * wv[u].w;
      a4.x += s4 * wv[u].x; a4.y += s4 * wv[u].y; a4.z += s4 * wv[u].z; a4.w += s4 * wv[u].w;
    }
  }
  float* red = sm + 5120;
  *(float4*)(red + (kg * 5 + 0) * 64 + cq * 4) = a0; *(float4*)(red + (kg * 5 + 1) * 64 + cq * 4) = a1;
  *(float4*)(red + (kg * 5 + 2) * 64 + cq * 4) = a2; *(float4*)(red + (kg * 5 + 3) * 64 + cq * 4) = a3;
  *(float4*)(red + (kg * 5 + 4) * 64 + cq * 4) = a4;
  __syncthreads();
  if (t < 64) {
#pragma unroll
    for (int b = 0; b < 5; b++) {
      float s = 0.f;
#pragma unroll
      for (int g = 0; g < 16; g++) s += red[(g * 5 + b) * 64 + t];
      p.MOD()[(size_t)(l * 5 + b) * 6144 + n0 + t] = s + p.mod_b[l * 6144 + n0 + t];
    }
  }
  __syncthreads();
}
DEV void prep_cache(const Params& p, int it) {
  const float* src; u16* dst;
  if (it < 8)       { int ch = it;      src = p.cak + (size_t)ch * 16384; dst = p.KA() + (size_t)4096 * 2 * 64 + (size_t)ch * 1280 * 64; }
  else if (it < 16) { int ch = it - 8;  src = p.cav + (size_t)ch * 16384; dst = p.VA() + (size_t)4096 * 2 * 64 + (size_t)ch * 1280 * 64; }
  else if (it < 48) { int ch = it - 16; src = p.cck + (size_t)ch * 16384; dst = p.KC() + (size_t)4096 * 8 * 64 + (size_t)ch * 1280 * 64; }
  else if (it < 80) { int ch = (it - 48) >> 1, hf = (it - 48) & 1;
                      src = p.ccv + (size_t)ch * 32768 + hf * 16384; dst = p.VC() + (size_t)4096 * 4 * 128 + (size_t)ch * 1280 * 128 + hf * 16384; }
  else if (it < 88) { int ch = it - 80; src = p.cdk + (size_t)ch * 16384; dst = p.KD() + (size_t)4096 * 2 * 64 + (size_t)ch * 1280 * 64; }
  else              { int ch = it - 88; src = p.cdv + (size_t)ch * 16384; dst = p.VD() + (size_t)4096 * 2 * 64 + (size_t)ch * 1280 * 64; }
  conv_item(src, dst);
}
DEV void prep_rope(const Params& p, int it) {
  for (int i = 0; i < 16; i++) {
    int idx = it * 4096 + i * 256 + threadIdx.x;
    int tpos = idx >> 5, a = idx & 31;
    float pos = (a < 16) ? (float)(tpos >> 6) : (float)(tpos & 63);
    float inv = exp2f(-(float)(a & 15) * (13.287712379549449f / 16.f));
    float ang = pos * inv;
    p.ROPEC()[idx] = __cosf(ang); p.ROPES()[idx] = __sinf(ang);
  }
}
constexpr int PREP_T0 = 704, PREP_T1 = PREP_T0 + 256, PREP_T2 = PREP_T1 + 576, PREP_T3 = PREP_T2 + 256, PREP_T4 = PREP_T3 + 1024;
constexpr int PREP_U = PREP_T4 + 2048, PREP_V = PREP_U + 2048, PREP_SK = PREP_V + 32, PREP_CA = PREP_SK + 96, PREP_RO = PREP_CA + 8, PREP_MOD = PREP_RO + 192;
DEV void phase_prep(const Params& p, int bid, int nb, char* smem) {
  float* sm = (float*)smem;
  for (int it0 = bid; it0 < PREP_MOD; it0 += nb) {
    int it = (it0 < 192) ? (PREP_RO + it0) : (it0 - 192);
    if (it >= PREP_T4 && it < PREP_V) continue;
    if ((it >= PREP_T1 && it < PREP_T3) || (it >= PREP_T3 + 512 && it < PREP_T4)) continue;
    if (it < PREP_T0) prep_transpose(p.ev_w_in, 2816, p.WT_EVIN(), it, sm);
    else if (it < PREP_T1) prep_transpose(p.ev_w_out, 1024, p.WT_EVOUT(), it - PREP_T0, sm);
    else if (it < PREP_T2) prep_transpose(p.od_w_in, 2304, p.WT_ODIN(), it - PREP_T1, sm);
    else if (it < PREP_T3) prep_transpose(p.od_w_out, 1024, p.WT_ODOUT(), it - PREP_T2, sm);
    else if (it < PREP_T4) { int j = it - PREP_T3; int l = j >> 9; prep_transpose(p.peer_wq + (size_t)l * 1024 * 2048, 2048, p.WT_PQ() + (size_t)l * 2048 * 1024, j & 511, sm); }
    else if (it < PREP_V) { }
    else if (it < PREP_SK) { size_t o = (size_t)(it - PREP_V) * 16384; conv_item(p.peer_sk + o, p.SUBK() + o); }
    else if (it < PREP_CA) prep_cache(p, it - PREP_SK);
    else if (it < PREP_RO) prep_rope(p, it - PREP_CA);
    else prep_mod(p, it - PREP_RO, sm);
  }
}

DEV void phase_ada(const Params& p, int layer, const float* __restrict__ gain, int shift_i, int scale_i, bool from_input, int bid, int nb) {
  int wave = threadIdx.x >> 6, lane = threadIdx.x & 63;
  for (int T0 = (bid * 4 + wave) * 2; T0 < 8192; T0 += nb * 8) {
    float4 v[2][4]; float ss[2];
#pragma unroll
    for (int q = 0; q < 2; q++) {
      int T = T0 + q;
      const float* xr = from_input ? (T < 4096 ? p.xp + (size_t)T * 1024 : p.xs + (size_t)(T - 4096) * 1024) : p.X() + (size_t)T * 1024;
#pragma unroll
      for (int i = 0; i < 4; i++) v[q][i] = *(const float4*)(xr + (i * 64 + lane) * 4);
    }
    int mb = T0 < 4096 ? 0 : 1 + ((T0 - 4096) >> 10);
    const float* md = p.MOD() + (size_t)(layer * 5 + mb) * 6144;
    float4 g[4], sh[4], sc[4];
#pragma unroll
    for (int i = 0; i < 4; i++) {
      int col = (i * 64 + lane) * 4;
      g[i] = *(const float4*)(gain + col); sh[i] = *(const float4*)(md + shift_i * 1024 + col); sc[i] = *(const float4*)(md + scale_i * 1024 + col);
    }
#pragma unroll
    for (int q = 0; q < 2; q++) {
      float s2 = 0.f;
#pragma unroll
      for (int i = 0; i < 4; i++) s2 += v[q][i].x * v[q][i].x + v[q][i].y * v[q][i].y + v[q][i].z * v[q][i].z + v[q][i].w * v[q][i].w;
      ss[q] = wave_sum(s2);
    }
#pragma unroll
    for (int q = 0; q < 2; q++) {
      float rstd = rsqrtf(ss[q] * (1.f / 1024.f) + 1e-6f);
#pragma unroll
      for (int i = 0; i < 4; i++) {
        int col = (i * 64 + lane) * 4;
        float y0 = v[q][i].x * rstd * g[i].x * (1.f + sc[i].x) + sh[i].x, y1 = v[q][i].y * rstd * g[i].y * (1.f + sc[i].y) + sh[i].y;
        float y2 = v[q][i].z * rstd * g[i].z * (1.f + sc[i].z) + sh[i].z, y3 = v[q][i].w * rstd * g[i].w * (1.f + sc[i].w) + sh[i].w;
        *(uint2*)(p.H() + (size_t)(T0 + q) * 1024 + col) = make_uint2(pack2(y0, y1), pack2(y2, y3));
      }
    }
  }
}

#define GLOAD8(PA, PB) \
  ra0 = *(const u32x4*)(PA); ra1 = *(const u32x4*)((PA) + sa32); ra2 = *(const u32x4*)((PA) + 2 * sa32); ra3 = *(const u32x4*)((PA) + 3 * sa32); \
  rb0 = *(const u32x4*)(PB); rb1 = *(const u32x4*)((PB) + sb32); rb2 = *(const u32x4*)((PB) + 2 * sb32); rb3 = *(const u32x4*)((PB) + 3 * sb32);
#define GLOAD8N(PA, PB) \
  na0 = *(const u32x4*)(PA); na1 = *(const u32x4*)((PA) + sa32); na2 = *(const u32x4*)((PA) + 2 * sa32); na3 = *(const u32x4*)((PA) + 3 * sa32); \
  nb0 = *(const u32x4*)(PB); nb1 = *(const u32x4*)((PB) + sb32); nb2 = *(const u32x4*)((PB) + 2 * sb32); nb3 = *(const u32x4*)((PB) + 3 * sb32);
#define GSTORE8(BUF) { u16* wa_ = (u16*)(smem + (BUF) * 36864) + lrow * 72 + lkc; u16* wb_ = wa_ + 128 * 72; \
  *(u32x4*)(wa_) = ra0; *(u32x4*)(wa_ + 32 * 72) = ra1; *(u32x4*)(wa_ + 64 * 72) = ra2; *(u32x4*)(wa_ + 96 * 72) = ra3; \
  *(u32x4*)(wb_) = rb0; *(u32x4*)(wb_ + 32 * 72) = rb1; *(u32x4*)(wb_ + 64 * 72) = rb2; *(u32x4*)(wb_ + 96 * 72) = rb3; }
DEV void gemm_tile(const u16* __restrict__ A, int lda, const u16* __restrict__ B, int ldb, int K, char* smem, f32x16 (&acc)[2][2]) {
  int t = threadIdx.x, lane = t & 63, wave = t >> 6, r = lane & 31, h = lane >> 5;
  int wm = wave >> 1, wn = wave & 1;
  int lrow = t >> 3, lkc = (t & 7) * 8;
  const u16* ap = A + (size_t)lrow * lda + lkc;
  const u16* bp = B + (size_t)lrow * ldb + lkc;
  size_t sa32 = (size_t)32 * lda, sb32 = (size_t)32 * ldb;
  u32x4 ra0, ra1, ra2, ra3, rb0, rb1, rb2, rb3;
  u32x4 na0, na1, na2, na3, nb0, nb1, nb2, nb3;
  int nk = K >> 6;
#define GSTORE8N(BUF) { u16* wa_ = (u16*)(smem + (BUF) * 36864) + lrow * 72 + lkc; u16* wb_ = wa_ + 128 * 72; \
  *(u32x4*)(wa_) = na0; *(u32x4*)(wa_ + 32 * 72) = na1; *(u32x4*)(wa_ + 64 * 72) = na2; *(u32x4*)(wa_ + 96 * 72) = na3; \
  *(u32x4*)(wb_) = nb0; *(u32x4*)(wb_ + 32 * 72) = nb1; *(u32x4*)(wb_ + 64 * 72) = nb2; *(u32x4*)(wb_ + 96 * 72) = nb3; }
#define GCOMPUTE(BUF) { const u16* sA = (const u16*)(smem + (BUF) * 36864); const u16* sB = sA + 128 * 72; \
    _Pragma("unroll") for (int kk = 0; kk < 4; kk++) { \
      bf16x8 a0 = *(const bf16x8*)(sA + (wm * 64 + r) * 72 + kk * 16 + h * 8); \
      bf16x8 a1 = *(const bf16x8*)(sA + (wm * 64 + 32 + r) * 72 + kk * 16 + h * 8); \
      bf16x8 b0 = *(const bf16x8*)(sB + (wn * 64 + r) * 72 + kk * 16 + h * 8); \
      bf16x8 b1 = *(const bf16x8*)(sB + (wn * 64 + 32 + r) * 72 + kk * 16 + h * 8); \
      acc[0][0] = mfma32(a0, b0, acc[0][0]); acc[0][1] = mfma32(a0, b1, acc[0][1]); \
      acc[1][0] = mfma32(a1, b0, acc[1][0]); acc[1][1] = mfma32(a1, b1, acc[1][1]); } }
  GLOAD8(ap, bp)
  __syncthreads();
  GSTORE8(0)
  if (nk > 1) { GLOAD8(ap + 64, bp + 64) }
  na0 = ra0; na1 = ra1; na2 = ra2; na3 = ra3; nb0 = rb0; nb1 = rb1; nb2 = rb2; nb3 = rb3;
  __syncthreads();
  for (int kt = 0; kt < nk; kt += 2) {
    if (kt + 2 < nk) { GLOAD8N(ap + (kt + 2) * 64, bp + (kt + 2) * 64) }
    GCOMPUTE(0)
    if (kt + 1 < nk) { GSTORE8(1) }
    __syncthreads();
    if (kt + 1 < nk) {
      if (kt + 3 < nk) { GLOAD8(ap + (kt + 3) * 64, bp + (kt + 3) * 64) }
      GCOMPUTE(1)
      if (kt + 2 < nk) { GSTORE8N(0) }
      __syncthreads();
    }
  }
  __syncthreads();
  float* Cs = (float*)smem;
#pragma unroll
  for (int i = 0; i < 2; i++)
#pragma unroll
    for (int j = 0; j < 2; j++)
#pragma unroll
      for (int g = 0; g < 16; g++)
        Cs[(wm * 64 + i * 32 + (g & 3) + 8 * (g >> 2) + 4 * h) * 128 + wn * 64 + j * 32 + r] = acc[i][j][g];
  __syncthreads();
}

DEV bool xcd_tile(int li, int bid, int NTl, int& mt, int& nt) {
  if (li >= 8 * NTl) return false;
  mt = 8 * (bid & 7) + (li & 7); nt = li >> 3; return true;
}
template <class Epi>
DEV void gemm_phase(const u16* A, int lda, const u16* Bt, int ldb, int K, int MT, int NTl, int bid, int nb, char* smem, Epi epi) {
  if ((nb & 7) == 0 && MT == 64) {
    int mt, nt;
    for (int li = bid >> 3; xcd_tile(li, bid, NTl, mt, nt); li += nb >> 3) {
      f32x16 acc[2][2];
      zero16(acc[0][0]); zero16(acc[0][1]); zero16(acc[1][0]); zero16(acc[1][1]);
      gemm_tile(A + (size_t)mt * 128 * lda, lda, Bt + (size_t)nt * 128 * ldb, ldb, K, smem, acc);
      epi(mt * 128, nt * 128, (const float*)smem);
    }
  } else {
    for (int it = bid; it < MT * NTl; it += nb) {
      int mt = it / NTl, nt = it % NTl;
      f32x16 acc[2][2];
      zero16(acc[0][0]); zero16(acc[0][1]); zero16(acc[1][0]); zero16(acc[1][1]);
      gemm_tile(A + (size_t)mt * 128 * lda, lda, Bt + (size_t)nt * 128 * ldb, ldb, K, smem, acc);
      epi(mt * 128, nt * 128, (const float*)smem);
    }
  }
}

DEV void tok_decode(int T, bool& smp, int& b, int& tpos) {
  smp = T >= 4096;
  if (!smp) { b = T >> 8; tpos = T & 255; } else { b = (T - 4096) >> 10; tpos = (T - 4096) & 1023; }
}
DEV void rope_pair(const Params& p, float& x, float& y, int tpos, int d) {
  float px = __shfl_xor(x, 16), py = __shfl_xor(y, 16);
  int a = d & 31;
  float c0 = p.ROPEC()[tpos * 32 + a], c1 = p.ROPEC()[tpos * 32 + a + 1];
  float s0 = p.ROPES()[tpos * 32 + a], s1 = p.ROPES()[tpos * 32 + a + 1];
  if (d < 32) { x = x * c0 - px * s0; y = y * c1 - py * s1; }
  else        { x = px * s0 + x * c0; y = py * s1 + y * c1; }
}

DEV void rope_apply(float& x, float& y, float4 cs, int d) {
  float px = __shfl_xor(x, 16), py = __shfl_xor(y, 16);
  if (d < 32) { x = x * cs.x - px * cs.z; y = y * cs.y - py * cs.w; }
  else        { x = px * cs.z + x * cs.x; y = py * cs.w + y * cs.y; }
}
DEV float4 rope_cs(const Params& p, int tpos, int d) {
  int a = d & 31;
  float2 c = *(const float2*)(p.ROPEC() + tpos * 32 + a), s = *(const float2*)(p.ROPES() + tpos * 32 + a);
  return make_float4(c.x, c.y, s.x, s.y);
}
template <int SEG, bool SMP>
DEV void epi0_rows(const Params& p, int m0, int n0, const float* Cs) {
  int lane = threadIdx.x & 63, wave = threadIdx.x >> 6;
  int col = n0 + lane * 2; int d = col & 63;
  float g0 = 1.f, g1 = 1.f;
  if (SEG == 0) { g0 = p.a_q_norm[d]; g1 = p.a_q_norm[d + 1]; }
  if (SEG == 1) { g0 = p.a_k_norm[d]; g1 = p.a_k_norm[d + 1]; }
  int segbase = SEG == 0 ? 0 : SEG == 1 ? 512 : SEG == 2 ? 640 : SEG == 3 ? 768 : SEG == 4 ? 1280 : SEG == 5 ? 1792 : 2304;
  int hh = (col - segbase) >> 6;
#pragma unroll 4
  for (int i = 0; i < 32; i++) {
    int rr = wave + 4 * i;
    int T = m0 + rr;
    int b = SMP ? (T - 4096) >> 10 : T >> 8;
    int tpos = SMP ? (T - 4096) & 1023 : T & 255;
    float2 c = *(const float2*)(Cs + rr * 128 + lane * 2);
    if (SEG <= 1) {
      float4 cs = make_float4(1.f, 1.f, 0.f, 0.f);
      if (SMP) cs = rope_cs(p, tpos, d);
      float ss = half_sum32(c.x * c.x + c.y * c.y);
      float rstd = rsqrtf(ss * (1.f / 64.f) + 1e-6f);
      c.x *= rstd * g0; c.y *= rstd * g1;
      if (SMP) rope_apply(c.x, c.y, cs, d);
    }
    if (SEG == 0) *(unsigned*)(p.Q1() + (size_t)T * 512 + col) = pack2(c.x * 0.18033688011112042f, c.y * 0.18033688011112042f);
    if (SEG == 1) {
      *(unsigned*)(p.KA() + kvoff(SMP, b, hh, tpos, 2, 64, 1280, 256) + d) = pack2(c.x, c.y);
      if (!SMP) *(float2*)(p.out + OUT_AK + ((size_t)(b * 2 + hh) * 256 + tpos) * 64 + d) = c;
    }
    if (SEG == 2) {
      *(unsigned*)(p.VA() + kvoff(SMP, b, hh, tpos, 2, 64, 1280, 256) + d) = pack2(c.x, c.y);
      if (!SMP) *(float2*)(p.out + OUT_AV + ((size_t)(b * 2 + hh) * 256 + tpos) * 64 + d) = c;
    }
    if (SEG == 3) *(unsigned*)(p.Q2() + (size_t)T * 512 + (col - 768)) = pack2(c.x, c.y);
    if (SEG == 4) *(unsigned*)(p.RK() + kvoff(SMP, b, hh, tpos, 8, 64, 1024, 0) + d) = pack2(c.x * 0.125f, c.y * 0.125f);
    if (SEG == 5) *(unsigned*)(p.RV() + kvoff(SMP, b, hh, tpos, 8, 64, 1024, 0) + d) = pack2(c.x, c.y);
    if (SEG == 6) *(unsigned*)(p.SG() + (size_t)T * 512 + (col - 2304)) = pack2(silu_f(c.x), silu_f(c.y));
  }
}
template <bool SMP> DEV void epi0_disp(const Params& p, int m0, int n0, const float* Cs) {
  if (n0 < 512) epi0_rows<0, SMP>(p, m0, n0, Cs);
  else if (n0 < 640) epi0_rows<1, SMP>(p, m0, n0, Cs);
  else if (n0 < 768) epi0_rows<2, SMP>(p, m0, n0, Cs);
  else if (n0 < 1280) epi0_rows<3, SMP>(p, m0, n0, Cs);
  else if (n0 < 1792) epi0_rows<4, SMP>(p, m0, n0, Cs);
  else if (n0 < 2304) epi0_rows<5, SMP>(p, m0, n0, Cs);
  else epi0_rows<6, SMP>(p, m0, n0, Cs);
}
DEV void epi_inproj0(const Params& p, int m0, int n0, const float* Cs) {
  if (m0 >= 4096) epi0_disp<true>(p, m0, n0, Cs); else epi0_disp<false>(p, m0, n0, Cs);
}
template <int SEG, bool SMP>
DEV void epi1_rows(const Params& p, int m0, int n0, const float* Cs) {
  int lane = threadIdx.x & 63, wave = threadIdx.x >> 6;
  int col = n0 + lane * 2; int d = col & 63;
  int segbase = SEG == 0 ? 0 : SEG == 1 ? 512 : SEG == 2 ? 1024 : SEG == 3 ? 1536 : SEG == 4 ? 2048 : 2176;
  int hh = (SEG == 2) ? (col - segbase) >> 7 : (col - segbase) >> 6;
  int dd = (col - 1024) & 127;
  constexpr bool ROPE = SMP && (SEG == 0 || SEG == 1 || SEG == 3 || SEG == 4);
#pragma unroll 4
  for (int i = 0; i < 32; i++) {
    int rr = wave + 4 * i;
    int T = m0 + rr;
    int b = SMP ? (T - 4096) >> 10 : T >> 8;
    int tpos = SMP ? (T - 4096) & 1023 : T & 255;
    float2 c = *(const float2*)(Cs + rr * 128 + lane * 2);
    if (!SMP) {
      if (SEG == 1) *(float2*)(p.out + OUT_CK + ((size_t)(b * 8 + hh) * 256 + tpos) * 64 + d) = c;
      if (SEG == 2) *(float2*)(p.out + OUT_CV + ((size_t)(b * 4 + hh) * 256 + tpos) * 128 + dd) = c;
      if (SEG == 4) *(float2*)(p.out + OUT_DK + ((size_t)(b * 2 + hh) * 256 + tpos) * 64 + d) = c;
      if (SEG == 5) *(float2*)(p.out + OUT_DV + ((size_t)(b * 2 + hh) * 256 + tpos) * 64 + d) = c;
    }
    if (ROPE) { float4 cs = rope_cs(p, tpos, d); rope_apply(c.x, c.y, cs, d); }
    if (SEG == 0) *(unsigned*)(p.Q1() + (size_t)T * 512 + col) = pack2(c.x * 0.18033688011112042f, c.y * 0.18033688011112042f);
    if (SEG == 1) *(unsigned*)(p.KC() + kvoff(SMP, b, hh, tpos, 8, 64, 1280, 256) + d) = pack2(c.x, c.y);
    if (SEG == 2) *(unsigned*)(p.VC() + kvoff(SMP, b, hh, tpos, 4, 128, 1280, 256) + dd) = pack2(c.x, c.y);
    if (SEG == 3) *(unsigned*)(p.Q2() + (size_t)T * 512 + (col - 1536)) = pack2(c.x * 0.18033688011112042f, c.y * 0.18033688011112042f);
    if (SEG == 4) *(unsigned*)(p.KD() + kvoff(SMP, b, hh, tpos, 2, 64, 1280, 256) + d) = pack2(c.x, c.y);
    if (SEG == 5) *(unsigned*)(p.VD() + kvoff(SMP, b, hh, tpos, 2, 64, 1280, 256) + d) = pack2(c.x, c.y);
  }
}
template <bool SMP> DEV void epi1_disp(const Params& p, int m0, int n0, const float* Cs) {
  if (n0 < 512) epi1_rows<0, SMP>(p, m0, n0, Cs);
  else if (n0 < 1024) epi1_rows<1, SMP>(p, m0, n0, Cs);
  else if (n0 < 1536) epi1_rows<2, SMP>(p, m0, n0, Cs);
  else if (n0 < 2048) epi1_rows<3, SMP>(p, m0, n0, Cs);
  else if (n0 < 2176) epi1_rows<4, SMP>(p, m0, n0, Cs);
  else epi1_rows<5, SMP>(p, m0, n0, Cs);
}
DEV void epi_inproj1(const Params& p, int m0, int n0, const float* Cs) {
  if (m0 >= 4096) epi1_disp<true>(p, m0, n0, Cs); else epi1_disp<false>(p, m0, n0, Cs);
}
DEV void epi_outproj(const Params& p, int layer, int m0, int n0, const float* Cs) {
  int lane = threadIdx.x & 63, wave = threadIdx.x >> 6;
  int mb = m0 < 4096 ? 0 : 1 + ((m0 - 4096) >> 10);
  int col = n0 + lane * 2;
  float2 g = *(const float2*)(p.MOD() + (size_t)(layer * 5 + mb) * 6144 + 2048 + col);
  const float* xbase = (layer == 0) ? (m0 < 4096 ? p.xp + (size_t)m0 * 1024 : p.xs + (size_t)(m0 - 4096) * 1024) : p.X() + (size_t)m0 * 1024;
#pragma unroll 8
  for (int i = 0; i < 32; i++) {
    int rr = wave + 4 * i;
    float2 c = *(const float2*)(Cs + rr * 128 + lane * 2);
    float2 x = *(const float2*)(xbase + (size_t)rr * 1024 + col);
    x.x += g.x * c.x; x.y += g.y * c.y;
    *(float2*)(p.X() + (size_t)(m0 + rr) * 1024 + col) = x;
  }
}

constexpr int ATT_BUF = 37888;
struct TileRegs { u32x4 k0, k1, k2, k3, v0, v1, v2, v3; };
template <int DV, bool TWOK> DEV TileRegs tile_load(const u16* __restrict__ k, const u16* __restrict__ k2, const u16* __restrict__ v) {
  int t = threadIdx.x, lane = t & 63, wave = t >> 6;
  TileRegs R;
  u32x4 z = {0u, 0u, 0u, 0u};
  R.k0 = *(const u32x4*)(k + t * 8); R.k1 = *(const u32x4*)(k + (t + 256) * 8);
  if (TWOK) { R.k2 = *(const u32x4*)(k2 + t * 8); R.k3 = *(const u32x4*)(k2 + (t + 256) * 8); } else { R.k2 = z; R.k3 = z; }
  R.v0 = *(const u32x4*)(v + (size_t)lane * DV + wave * 8); R.v1 = *(const u32x4*)(v + (size_t)lane * DV + (wave + 4) * 8);
  if (DV == 128) { R.v2 = *(const u32x4*)(v + (size_t)lane * DV + (wave + 8) * 8); R.v3 = *(const u32x4*)(v + (size_t)lane * DV + (wave + 12) * 8); } else { R.v2 = z; R.v3 = z; }
  return R;
}
DEV void store8t(u16* d, u32x4 x) {
  d[0 * 76] = (u16)(x[0] & 0xffff); d[1 * 76] = (u16)(x[0] >> 16);
  d[2 * 76] = (u16)(x[1] & 0xffff); d[3 * 76] = (u16)(x[1] >> 16);
  d[4 * 76] = (u16)(x[2] & 0xffff); d[5 * 76] = (u16)(x[2] >> 16);
  d[6 * 76] = (u16)(x[3] & 0xffff); d[7 * 76] = (u16)(x[3] >> 16);
}
template <int DV, bool TWOK> DEV void tile_store(const TileRegs R, char* buf) {
  int t = threadIdx.x, lane = t & 63, wave = t >> 6;
  u16* sK = (u16*)buf; u16* sK2 = sK + 64 * 72; u16* sVT = sK + 2 * 64 * 72;
  int key = t >> 3, dc = t & 7;
  *(u32x4*)(sK + key * 72 + dc * 8) = R.k0; *(u32x4*)(sK + (key + 32) * 72 + dc * 8) = R.k1;
  if (TWOK) { *(u32x4*)(sK2 + key * 72 + dc * 8) = R.k2; *(u32x4*)(sK2 + (key + 32) * 72 + dc * 8) = R.k3; }
  store8t(sVT + (wave * 8) * 76 + lane, R.v0); store8t(sVT + ((wave + 4) * 8) * 76 + lane, R.v1);
  if (DV == 128) { store8t(sVT + ((wave + 8) * 8) * 76 + lane, R.v2); store8t(sVT + ((wave + 12) * 8) * 76 + lane, R.v3); }
}
DEV void load_ident_k(u16* sK) {
  int t = threadIdx.x;
#pragma unroll
  for (int i = 0; i < 2; i++) {
    int c = t + 256 * i; int key = c >> 3, dc = c & 7;
    unsigned w[4] = {0u, 0u, 0u, 0u};
    uint4 z = make_uint4(0u, 0u, 0u, 0u);
    if (dc == (key >> 3)) {
      int e = key & 7; unsigned one = (e & 1) ? 0x3F800000u : 0x00003F80u;
      if ((e >> 1) == 0) z.x = one; else if ((e >> 1) == 1) z.y = one; else if ((e >> 1) == 2) z.z = one; else z.w = one;
    }
    (void)w;
    *(uint4*)(sK + key * 72 + dc * 8) = z;
  }
}
DEV void load_state_v(const float* __restrict__ S0, u16* sVT) {
  int lane = threadIdx.x & 63, wave = threadIdx.x >> 6;
#pragma unroll
  for (int i = 0; i < 2; i++) {
    int dc = wave + 4 * i;
    float4 a = *(const float4*)(S0 + lane * 64 + dc * 8), b = *(const float4*)(S0 + lane * 64 + dc * 8 + 4);
    u16* d = sVT + (dc * 8) * 76 + lane;
    d[0 * 76] = f2bf(a.x); d[1 * 76] = f2bf(a.y); d[2 * 76] = f2bf(a.z); d[3 * 76] = f2bf(a.w);
    d[4 * 76] = f2bf(b.x); d[5 * 76] = f2bf(b.y); d[6 * 76] = f2bf(b.z); d[7 * 76] = f2bf(b.w);
  }
}
template <int DV, class F>
DEV void attn_compute(const bf16x8 (&qf)[4], f32x16 (&o)[DV / 32], const u16* sK, const u16* sVT, F&& xform) {
  int lane = threadIdx.x & 63, r = lane & 31, h = lane >> 5;
  f32x16 st[2]; zero16(st[0]); zero16(st[1]);
#pragma unroll
  for (int sub = 0; sub < 2; sub++)
#pragma unroll
    for (int kk = 0; kk < 4; kk++) {
      bf16x8 kf = *(const bf16x8*)(sK + (sub * 32 + r) * 72 + kk * 16 + h * 8);
      st[sub] = mfma32(kf, qf[kk], st[sub]);
    }
  xform(st);
  bf16x8 pf[2][2];
#pragma unroll
  for (int sub = 0; sub < 2; sub++)
#pragma unroll
    for (int s = 0; s < 2; s++) {
      u32x4 w;
      w[0] = pack2(st[sub][8 * s + 0], st[sub][8 * s + 1]); w[1] = pack2(st[sub][8 * s + 2], st[sub][8 * s + 3]);
      w[2] = pack2(st[sub][8 * s + 4], st[sub][8 * s + 5]); w[3] = pack2(st[sub][8 * s + 6], st[sub][8 * s + 7]);
      pf[sub][s] = __builtin_bit_cast(bf16x8, w);
    }
#pragma unroll
  for (int ds = 0; ds < DV / 32; ds++)
#pragma unroll
    for (int sub = 0; sub < 2; sub++)
#pragma unroll
      for (int s = 0; s < 2; s++) {
        const u16* vp = sVT + (ds * 32 + r) * 76 + sub * 32 + s * 16 + 4 * h;
        uint2 lo = *(const uint2*)vp, hi = *(const uint2*)(vp + 8);
        u32x4 w; w[0] = lo.x; w[1] = lo.y; w[2] = hi.x; w[3] = hi.y;
        o[ds] = mfma32(__builtin_bit_cast(bf16x8, w), pf[sub][s], o[ds]);
      }
}
template <int DV, class F>
DEV void attn_compute_sub(const bf16x8 (&qf)[4], f32x16 (&o)[DV / 32], const u16* sK, const u16* sVT, F&& xform) {
  int lane = threadIdx.x & 63, r = lane & 31, h = lane >> 5;
#pragma unroll
  for (int sub = 0; sub < 2; sub++) {
    f32x16 st; zero16(st);
#pragma unroll
    for (int kk = 0; kk < 4; kk++) {
      bf16x8 kf = *(const bf16x8*)(sK + (sub * 32 + r) * 72 + kk * 16 + h * 8);
      st = mfma32(kf, qf[kk], st);
    }
    xform(sub, st);
    bf16x8 pf[2];
#pragma unroll
    for (int s2 = 0; s2 < 2; s2++) {
      u32x4 w;
      w[0] = pack2(st[8 * s2 + 0], st[8 * s2 + 1]); w[1] = pack2(st[8 * s2 + 2], st[8 * s2 + 3]);
      w[2] = pack2(st[8 * s2 + 4], st[8 * s2 + 5]); w[3] = pack2(st[8 * s2 + 6], st[8 * s2 + 7]);
      pf[s2] = __builtin_bit_cast(bf16x8, w);
    }
#pragma unroll
    for (int ds = 0; ds < DV / 32; ds++)
#pragma unroll
      for (int s2 = 0; s2 < 2; s2++) {
        const u16* vp = sVT + (ds * 32 + r) * 76 + sub * 32 + s2 * 16 + 4 * h;
        uint2 lo = *(const uint2*)vp, hi = *(const uint2*)(vp + 8);
        u32x4 w; w[0] = lo.x; w[1] = lo.y; w[2] = hi.x; w[3] = hi.y;
        o[ds] = mfma32(__builtin_bit_cast(bf16x8, w), pf[s2], o[ds]);
      }
  }
}
template <int DV>
DEV void softmax_xform1(f32x16& st, f32x16 (&o)[DV / 32], float& m, float& l) {
  float mx = -1e30f;
#pragma unroll
  for (int g = 0; g < 16; g++) mx = fmaxf(mx, st[g]);
  mx = fmaxf(mx, __shfl_xor(mx, 32));
  float mnew = fmaxf(m, mx);
  float alpha = __builtin_amdgcn_exp2f(m - mnew);
  m = mnew;
  float ls = 0.f;
#pragma unroll
  for (int g = 0; g < 16; g++) { float pv = __builtin_amdgcn_exp2f(st[g] - mnew); st[g] = pv; ls += pv; }
  l = l * alpha + ls;
#pragma unroll
  for (int ds = 0; ds < DV / 32; ds++)
#pragma unroll
    for (int g = 0; g < 16; g++) o[ds][g] *= alpha;
}
template <int DV, bool TWOK, class PF, class XF, class XF1>
DEV void attn_loop(int n, PF&& ptrs, const bf16x8 (&qf)[4], f32x16 (&o)[DV / 32], char* smem, XF&& xf, XF1&& xf1) {
  int wave = threadIdx.x >> 6;
  int kofs = (TWOK && wave >= 2) ? 64 * 72 : 0;
  TileRegs R;
  const u16 *kp, *kp2, *vp;
  ptrs(0, kp, kp2, vp); R = tile_load<DV, TWOK>(kp, kp2, vp);
  __syncthreads();
  tile_store<DV, TWOK>(R, smem);
  if (n > 1) { ptrs(1, kp, kp2, vp); R = tile_load<DV, TWOK>(kp, kp2, vp); }
  __syncthreads();
  const u16* b0k = (const u16*)smem + kofs; const u16* b0v = (const u16*)smem + 2 * 64 * 72;
  const u16* b1k = (const u16*)(smem + ATT_BUF) + kofs; const u16* b1v = (const u16*)(smem + ATT_BUF) + 2 * 64 * 72;
  for (int ti = 0; ti < n; ti++) {
    const u16* bk = (ti & 1) ? b1k : b0k; const u16* bv = (ti & 1) ? b1v : b0v;
    if constexpr (DV == 128) attn_compute_sub<DV>(qf, o, bk, bv, [&](int sub, f32x16& st) { xf1(ti, sub, st); });
    else attn_compute<DV>(qf, o, bk, bv, [&](f32x16 (&st)[2]) { xf(ti, st); });
    if (ti + 1 < n) tile_store<DV, TWOK>(R, smem + ((ti + 1) & 1) * ATT_BUF);
    if (ti + 2 < n) { ptrs(ti + 2, kp, kp2, vp); R = tile_load<DV, TWOK>(kp, kp2, vp); }
    __syncthreads();
  }
}
template <int DV>
DEV void softmax_xform(f32x16 (&st)[2], f32x16 (&o)[DV / 32], float& m, float& l, bool masked, int kpos0, int qpos) {
  int h = (threadIdx.x & 63) >> 5;
  float mx = -1e30f;
#pragma unroll
  for (int sub = 0; sub < 2; sub++)
#pragma unroll
    for (int g = 0; g < 16; g++) {
      float s = st[sub][g];
      if (masked) {
        int j = kpos0 + sub * 32 + (g & 3) + 8 * (g >> 2) + 4 * h;
        int dl = qpos - j; if (dl < 0) dl = -dl;
        if (dl > 128) s = -1e30f;
        st[sub][g] = s;
      }
      mx = fmaxf(mx, s);
    }
  mx = fmaxf(mx, __shfl_xor(mx, 32));
  float mnew = fmaxf(m, mx);
  float alpha = __builtin_amdgcn_exp2f(m - mnew);
  m = mnew;
  float ls = 0.f;
#pragma unroll
  for (int sub = 0; sub < 2; sub++)
#pragma unroll
    for (int g = 0; g < 16; g++) { float pv = __builtin_amdgcn_exp2f(st[sub][g] - mnew); st[sub][g] = pv; ls += pv; }
  l = l * alpha + ls;
#pragma unroll
  for (int ds = 0; ds < DV / 32; ds++)
#pragma unroll
    for (int g = 0; g < 16; g++) o[ds][g] *= alpha;
}

template <int DV, bool TWOK>
DEV void attn_softmax_job(const Params& p, const u16* Q, int Tq0, int qcol, const u16* kb, const u16* kb2, const u16* vb,
                          int nplain, int band_lo, int band_hi, int qpos0, bool use_sink, float sinkv,
                          f32x16 (&o)[DV / 32], char* smem) {
  int lane = threadIdx.x & 63, wave = threadIdx.x >> 6, r = lane & 31, h = lane >> 5;
  int qrow = TWOK ? (wave & 1) * 32 : wave * 32;
  bf16x8 qf[4];
#pragma unroll
  for (int kk = 0; kk < 4; kk++) qf[kk] = *(const bf16x8*)(Q + (size_t)(Tq0 + qrow + r) * 512 + qcol + kk * 16 + h * 8);
#pragma unroll
  for (int ds = 0; ds < DV / 32; ds++) zero16(o[ds]);
  float m = use_sink ? sinkv : -1e30f;
  float l = (use_sink && h == 0) ? 1.f : 0.f;
  int qpos = qpos0 + qrow + r;
  int ntot = nplain + (band_hi - band_lo);
  attn_loop<DV, TWOK>(ntot,
    [&](int ti, const u16*& kp, const u16*& kp2, const u16*& vp) {
      int key0 = (ti >= nplain) ? (256 + (band_lo + ti - nplain) * 64) : ti * 64;
      kp = kb + (size_t)key0 * 64; kp2 = kb2 + (size_t)key0 * 64; vp = vb + (size_t)key0 * DV;
    }, qf, o, smem,
    [&](int ti, f32x16 (&st)[2]) {
      bool masked = ti >= nplain;
      int kpos0 = (band_lo + ti - nplain) * 64;
      softmax_xform<DV>(st, o, m, l, masked, kpos0, qpos);
    },
    [&](int ti, int sub, f32x16& st) { softmax_xform1<DV>(st, o, m, l); });
  float lt = l + __shfl_xor(l, 32);
  float inv = 1.f / lt;
#pragma unroll
  for (int ds = 0; ds < DV / 32; ds++)
#pragma unroll
    for (int g = 0; g < 16; g++) o[ds][g] *= inv;
}
DEV void store_o64(const Params& p, const f32x16 (&o)[2], int Tq0, int mixcol) {
  int lane = threadIdx.x & 63, wave = threadIdx.x >> 6, r = lane & 31, h = lane >> 5;
  int T = Tq0 + wave * 32 + r;
#pragma unroll
  for (int ds = 0; ds < 2; ds++)
#pragma unroll
    for (int g4 = 0; g4 < 4; g4++) {
      int d0 = ds * 32 + 8 * g4 + 4 * h;
      *(uint2*)(p.MIX() + (size_t)T * 1024 + mixcol + d0) =
          make_uint2(pack2(o[ds][4 * g4], o[ds][4 * g4 + 1]), pack2(o[ds][4 * g4 + 2], o[ds][4 * g4 + 3]));
    }
}

DEV void ret_job(const Params& p, bool smp, int b, int hh, int qb, char* smem) {
  u16* sK = (u16*)smem; u16* sVT = sK + 2 * 64 * 72;
  int lane = threadIdx.x & 63, wave = threadIdx.x >> 6, r = lane & 31, h = lane >> 5;
  int L = smp ? 1024 : 256;
  int Tq0 = (smp ? 4096 + b * 1024 : b * 256) + qb * 128;
  const u16* kb = p.RK() + kvoff(smp, b, hh, 0, 8, 64, 1024, 0);
  const u16* vb = p.RV() + kvoff(smp, b, hh, 0, 8, 64, 1024, 0);
  float xf = p.rdf[hh], xb = p.rdb[hh];
  float lf2 = -log1pf(__expf(-xf)) * 1.4426950408889634f;
  float lb2 = -log1pf(__expf(-xb)) * 1.4426950408889634f;
  bf16x8 qf[4];
#pragma unroll
  for (int kk = 0; kk < 4; kk++) qf[kk] = *(const bf16x8*)(p.Q2() + (size_t)(Tq0 + wave * 32 + r) * 512 + hh * 64 + kk * 16 + h * 8);
  f32x16 o[2]; zero16(o[0]); zero16(o[1]);
  int qpos = qb * 128 + wave * 32 + r;
  int nt = L / 64;
  attn_loop<64, false>(nt,
    [&](int ti, const u16*& kp, const u16*& kp2, const u16*& vp) { kp = kb + (size_t)ti * 4096; kp2 = kp; vp = vb + (size_t)ti * 4096; },
    qf, o, smem,
    [&](int ti, f32x16 (&st)[2]) {
      int kpos0 = ti * 64;
#pragma unroll
      for (int sub = 0; sub < 2; sub++)
#pragma unroll
        for (int g = 0; g < 16; g++) {
          int j = kpos0 + sub * 32 + (g & 3) + 8 * (g >> 2) + 4 * h;
          int dl = qpos - j;
          float e = dl >= 0 ? lf2 * (float)dl : lb2 * (float)(-dl);
          st[sub][g] *= __builtin_amdgcn_exp2f(e);
        }
    },
    [&](int ti, int sub, f32x16& st) {});
  if (smp) {
    for (int dir = 0; dir < 2; dir++) {
      const float* S0 = (dir == 0 ? p.srf : p.srb) + (size_t)(b * 8 + hh) * 4096;
      float rs = dir == 0 ? exp2f(lf2 * (float)(qpos + 1)) : exp2f(lb2 * (float)(L - qpos));
      __syncthreads();
      load_ident_k(sK);
      load_state_v(S0, sVT);
      __syncthreads();
      attn_compute<64>(qf, o, sK, sVT, [&](f32x16 (&st)[2]) {
#pragma unroll
        for (int sub = 0; sub < 2; sub++)
#pragma unroll
          for (int g = 0; g < 16; g++) st[sub][g] *= rs;
      });
    }
  }
  float sum = 0.f;
#pragma unroll
  for (int ds = 0; ds < 2; ds++)
#pragma unroll
    for (int g = 0; g < 16; g++) sum += o[ds][g];
  sum += __shfl_xor(sum, 32);
  float mean = sum * (1.f / 64.f);
  float vs = 0.f;
#pragma unroll
  for (int ds = 0; ds < 2; ds++)
#pragma unroll
    for (int g = 0; g < 16; g++) { float dlt = o[ds][g] - mean; vs += dlt * dlt; }
  vs += __shfl_xor(vs, 32);
  float rstd = rsqrtf(vs * (1.f / 64.f) + 1e-6f);
  int T = Tq0 + wave * 32 + r;
#pragma unroll
  for (int ds = 0; ds < 2; ds++)
#pragma unroll
    for (int g4 = 0; g4 < 4; g4++) {
      int d0 = ds * 32 + 8 * g4 + 4 * h;
      uint2 gt = *(const uint2*)(p.SG() + (size_t)T * 512 + hh * 64 + d0);
      float y0 = (o[ds][4 * g4] - mean) * rstd * bflo(gt.x), y1 = (o[ds][4 * g4 + 1] - mean) * rstd * bfhi(gt.x);
      float y2 = (o[ds][4 * g4 + 2] - mean) * rstd * bflo(gt.y), y3 = (o[ds][4 * g4 + 3] - mean) * rstd * bfhi(gt.y);
      *(uint2*)(p.MIX() + (size_t)T * 1024 + 512 + hh * 64 + d0) = make_uint2(pack2(y0, y1), pack2(y2, y3));
    }
}
DEV void ret_state_job(const Params& p, int b, int hh, int dir, char* smem) {
  u16* sKk = (u16*)smem; u16* sVv = sKk + 64 * 64;
  int t = threadIdx.x;
  const u16* kb = p.RK() + kvoff(false, b, hh, 0, 8, 64, 1024, 0);
  const u16* vb = p.RV() + kvoff(false, b, hh, 0, 8, 64, 1024, 0);
  float xx = dir == 0 ? p.rdf[hh] : p.rdb[hh];
  float lg2 = -log1pf(__expf(-xx)) * 1.4426950408889634f;
  int dk = t >> 2, dvc = (t & 3) * 16;
  float acc[16];
#pragma unroll
  for (int i = 0; i < 16; i++) acc[i] = 0.f;
  for (int ch = 0; ch < 4; ch++) {
    __syncthreads();
#pragma unroll
    for (int i = 0; i < 2; i++) {
      int c = t + 256 * i;
      *(uint4*)(sKk + c * 8) = *(const uint4*)(kb + (size_t)ch * 4096 + c * 8);
      *(uint4*)(sVv + c * 8) = *(const uint4*)(vb + (size_t)ch * 4096 + c * 8);
    }
    __syncthreads();
    for (int jj = 0; jj < 64; jj++) {
      int j = ch * 64 + jj;
      float w = exp2f(lg2 * (float)(dir == 0 ? 255 - j : j));
      float kv = bf2f(sKk[jj * 64 + dk]) * w;
      const uint4* vp = (const uint4*)(sVv + jj * 64 + dvc);
      uint4 v0 = vp[0], v1 = vp[1];
      acc[0] += kv * bflo(v0.x); acc[1] += kv * bfhi(v0.x); acc[2] += kv * bflo(v0.y); acc[3] += kv * bfhi(v0.y);
      acc[4] += kv * bflo(v0.z); acc[5] += kv * bfhi(v0.z); acc[6] += kv * bflo(v0.w); acc[7] += kv * bfhi(v0.w);
      acc[8] += kv * bflo(v1.x); acc[9] += kv * bfhi(v1.x); acc[10] += kv * bflo(v1.y); acc[11] += kv * bfhi(v1.y);
      acc[12] += kv * bflo(v1.z); acc[13] += kv * bfhi(v1.z); acc[14] += kv * bflo(v1.w); acc[15] += kv * bfhi(v1.w);
    }
  }
  float* dst = p.out + (dir == 0 ? OUT_RF : OUT_RB) + ((size_t)(b * 8 + hh) * 64 + dk) * 64 + dvc;
#pragma unroll
  for (int i = 0; i < 4; i++) *(float4*)(dst + 4 * i) = make_float4(acc[4 * i], acc[4 * i + 1], acc[4 * i + 2], acc[4 * i + 3]);
}

DEV void phase_attn0(const Params& p, int bid, int nb, char* smem) {
  for (int it = bid; it < 1280; it += nb) {
    if (it < 256) {
      int b = it >> 6, hq = (it >> 3) & 7, qb = it & 7; int kvh = hq >> 2;
      f32x16 o[2];
      int Tq0 = 4096 + b * 1024 + qb * 128;
      attn_softmax_job<64, false>(p, p.Q1(), Tq0, hq * 64, p.KA() + kvoff(true, b, kvh, -256, 2, 64, 1280, 256), p.KA(), p.VA() + kvoff(true, b, kvh, -256, 2, 64, 1280, 256),
                           20, 0, 0, qb * 128, false, 0.f, o, smem);
      store_o64(p, o, Tq0, hq * 64);
    } else if (it < 512) {
      int j = it - 256; int b = j >> 6, hh = (j >> 3) & 7, qb = j & 7;
      ret_job(p, true, b, hh, qb, smem);
    } else if (it < 768) {
      int j = it - 512; int b = j >> 4, hq = (j >> 1) & 7, qb = j & 1; int kvh = hq >> 2;
      f32x16 o[2];
      int Tq0 = b * 256 + qb * 128;
      attn_softmax_job<64, false>(p, p.Q1(), Tq0, hq * 64, p.KA() + kvoff(false, b, kvh, 0, 2, 64, 1280, 256), p.KA(), p.VA() + kvoff(false, b, kvh, 0, 2, 64, 1280, 256),
                           4, 0, 0, qb * 128, false, 0.f, o, smem);
      store_o64(p, o, Tq0, hq * 64);
    } else if (it < 1024) {
      int j = it - 768; int b = j >> 4, hh = (j >> 1) & 7, qb = j & 1;
      ret_job(p, false, b, hh, qb, smem);
    } else {
      int j = it - 1024; int b = j >> 4, hh = (j >> 1) & 7, dir = j & 1;
      ret_state_job(p, b, hh, dir, smem);
    }
  }
}
DEV void diff_job(const Params& p, bool smp, int b, int hh, int qb, float lam, char* smem) {
  int lane = threadIdx.x & 63, wave = threadIdx.x >> 6, r = lane & 31, h = lane >> 5;
  int c = wave >> 1;
  int Tq0 = (smp ? 4096 + b * 1024 : b * 256) + qb * 64;
  int nt = smp ? 20 : 4;
  const u16* vb = p.VC() + kvoff(smp, b, hh, smp ? -256 : 0, 4, 128, 1280, 256);
  const u16* kb0 = p.KC() + kvoff(smp, b, 2 * hh, smp ? -256 : 0, 8, 64, 1280, 256);
  const u16* kb1 = p.KC() + kvoff(smp, b, 2 * hh + 1, smp ? -256 : 0, 8, 64, 1280, 256);
  f32x16 o[4];
  attn_softmax_job<128, true>(p, p.Q1(), Tq0, (2 * hh + c) * 64, kb0, kb1, vb, nt, 0, 0, 0, false, 0.f, o, smem);
  float* ex = (float*)smem;
  if (wave >= 2) {
#pragma unroll
    for (int ds = 0; ds < 4; ds++)
#pragma unroll
      for (int g = 0; g < 16; g++) ex[(ds * 16 + g) * 128 + (threadIdx.x - 128)] = o[ds][g];
  }
  __syncthreads();
  if (wave < 2) {
    float ss = 0.f;
#pragma unroll
    for (int ds = 0; ds < 4; ds++)
#pragma unroll
      for (int g = 0; g < 16; g++) { float dv = o[ds][g] - lam * ex[(ds * 16 + g) * 128 + threadIdx.x]; o[ds][g] = dv; ss += dv * dv; }
    ss += __shfl_xor(ss, 32);
    float rstd = rsqrtf(ss * (1.f / 128.f) + 1e-6f) * (1.f - LAM_INIT);
    int T = Tq0 + wave * 32 + r;
#pragma unroll
    for (int ds = 0; ds < 4; ds++)
#pragma unroll
      for (int g4 = 0; g4 < 4; g4++) {
        int d0 = ds * 32 + 8 * g4 + 4 * h;
        float4 sg = *(const float4*)(p.subln + d0);
        *(uint2*)(p.MIX() + (size_t)T * 1024 + hh * 128 + d0) =
            make_uint2(pack2(o[ds][4 * g4] * rstd * sg.x, o[ds][4 * g4 + 1] * rstd * sg.y),
                       pack2(o[ds][4 * g4 + 2] * rstd * sg.z, o[ds][4 * g4 + 3] * rstd * sg.w));
      }
  }
}
DEV void phase_attn1(const Params& p, int bid, int nb, char* smem) {
  float d1 = 0.f, d2 = 0.f;
  for (int i = 0; i < 64; i++) { d1 += p.lq1[i] * p.lk1[i]; d2 += p.lq2[i] * p.lk2[i]; }
  float lam = __expf(d1) - __expf(d2) + LAM_INIT;
  for (int it = bid; it < 1024; it += nb) {
    if (it < 256) {
      int b = it >> 6, hh = (it >> 4) & 3, qb = it & 15;
      diff_job(p, true, b, hh, qb, lam, smem);
    } else if (it < 512) {
      int j = it - 256; int b = j >> 6, hq = (j >> 3) & 7, qb = j & 7; int kvh = hq >> 2;
      int q0 = qb * 128;
      int lo = (q0 - 128 < 0 ? 0 : q0 - 128) >> 6, hi = (q0 + 256 > 1024 ? 1024 : q0 + 256) >> 6;
      f32x16 o[2];
      int Tq0 = 4096 + b * 1024 + q0;
      attn_softmax_job<64, false>(p, p.Q2(), Tq0, hq * 64, p.KD() + kvoff(true, b, kvh, -256, 2, 64, 1280, 256), p.KD(), p.VD() + kvoff(true, b, kvh, -256, 2, 64, 1280, 256),
                           4, lo, hi, q0, true, p.dsink[hq] * 1.4426950408889634f, o, smem);
      store_o64(p, o, Tq0, 512 + hq * 64);
    } else if (it < 768) {
      int j = it - 512; int b = j >> 4, hh = (j >> 2) & 3, qb = j & 3;
      diff_job(p, false, b, hh, qb, lam, smem);
    } else {
      int j = it - 768; int b = j >> 4, hq = (j >> 1) & 7, qb = j & 1; int kvh = hq >> 2;
      f32x16 o[2];
      int Tq0 = b * 256 + qb * 128;
      attn_softmax_job<64, false>(p, p.Q2(), Tq0, hq * 64, p.KD() + kvoff(false, b, kvh, 0, 2, 64, 1280, 256), p.KD(), p.VD() + kvoff(false, b, kvh, 0, 2, 64, 1280, 256),
                           4, 0, 0, qb * 128, true, p.dsink[hq] * 1.4426950408889634f, o, smem);
      store_o64(p, o, Tq0, 512 + hq * 64);
    }
  }
}

DEV float ub0(unsigned w) { return (float)(w & 255u); }
DEV float ub1(unsigned w) { return (float)((w >> 8) & 255u); }
DEV float ub2(unsigned w) { return (float)((w >> 16) & 255u); }
DEV float ub3(unsigned w) { return (float)(w >> 24); }
DEV void phase_peer(const Params& p, int layer, int bid, int nb, char* smem) {
  int wave = threadIdx.x >> 6, lane = threadIdx.x & 63;
  float* ws1 = (float*)(smem + wave * 2048); float* ws2 = ws1 + 16;
  int* wi1 = (int*)(ws2 + 16); int* wi2 = wi1 + 16; float* es = (float*)(wi2 + 16); int* eidx = (int*)(es + 16); float* eg = (float*)(eidx + 128);
  const unsigned char* U = p.U8() + (size_t)layer * 16384 * 1024;
  const unsigned char* V = p.V8() + (size_t)layer * 16384 * 1024;
  const float* SU = p.SU() + layer * 16384; const float* SV = p.SV() + layer * 16384;
  const float* gain = p.norm_ffn + layer * 1024;
  for (int T = bid * 4 + wave; T < 8192; T += nb * 4) {
    const u16* sc = (const u16*)p.SC() + (size_t)T * 2048;
    for (int hh = 0; hh < 8; hh++) {
      const u16* s = sc + hh * 256;
      float a0 = bf2f(s[lane]), a1 = bf2f(s[lane + 64]), b0 = bf2f(s[128 + lane]), b1 = bf2f(s[192 + lane]);
      unsigned ka0 = (fkey(a0) & ~127u) | (unsigned)(127 - lane), ka1 = (fkey(a1) & ~127u) | (unsigned)(63 - lane);
      unsigned kb0 = (fkey(b0) & ~127u) | (unsigned)(127 - lane), kb1 = (fkey(b1) & ~127u) | (unsigned)(63 - lane);
      unsigned pa = 0u, pb = 0u;
      for (int bit = 31; bit >= 0; --bit) {
        unsigned ta = pa | (1u << bit), tb = pb | (1u << bit);
        int ca = __popcll(__ballot(ka0 >= ta)) + __popcll(__ballot(ka1 >= ta));
        int cb = __popcll(__ballot(kb0 >= tb)) + __popcll(__ballot(kb1 >= tb));
        if (ca >= 16) pa = ta;
        if (cb >= 16) pb = tb;
      }
      {
        unsigned long long m0 = __ballot(ka0 >= pa), m1 = __ballot(ka1 >= pa);
        int p0 = mbcnt64(m0), p1 = __popcll(m0) + mbcnt64(m1);
        if (ka0 >= pa) { ws1[p0 & 15] = a0; wi1[p0 & 15] = lane; }
        if (ka1 >= pa) { ws1[p1 & 15] = a1; wi1[p1 & 15] = lane + 64; }
        unsigned long long n0 = __ballot(kb0 >= pb), n1 = __ballot(kb1 >= pb);
        int q0 = mbcnt64(n0), q1 = __popcll(n0) + mbcnt64(n1);
        if (kb0 >= pb) { ws2[q0 & 15] = b0; wi2[q0 & 15] = lane; }
        if (kb1 >= pb) { ws2[q1 & 15] = b1; wi2[q1 & 15] = lane + 64; }
      }
      __builtin_amdgcn_fence(__ATOMIC_ACQ_REL, "wavefront");
      __builtin_amdgcn_wave_barrier();
      int bq = lane & 15, aq = lane >> 4;
      float s2v = ws2[bq];
      float c0 = ws1[aq] + s2v, c1 = ws1[aq + 4] + s2v, c2 = ws1[aq + 8] + s2v, c3 = ws1[aq + 12] + s2v;
      unsigned k0 = (fkey(c0) & ~255u) | (unsigned)(255 - lane), k1 = (fkey(c1) & ~255u) | (unsigned)(191 - lane);
      unsigned k2 = (fkey(c2) & ~255u) | (unsigned)(127 - lane), k3 = (fkey(c3) & ~255u) | (unsigned)(63 - lane);
      unsigned pc = 0u;
      for (int bit = 31; bit >= 0; --bit) {
        unsigned tc = pc | (1u << bit);
        int cc = __popcll(__ballot(k0 >= tc)) + __popcll(__ballot(k1 >= tc)) + __popcll(__ballot(k2 >= tc)) + __popcll(__ballot(k3 >= tc));
        if (cc >= 16) pc = tc;
      }
      {
        unsigned long long m0 = __ballot(k0 >= pc), m1 = __ballot(k1 >= pc), m2 = __ballot(k2 >= pc), m3 = __ballot(k3 >= pc);
        int n0 = __popcll(m0), n1 = n0 + __popcll(m1), n2 = n1 + __popcll(m2);
        int i2b = wi2[bq];
        if (k0 >= pc) { int q = mbcnt64(m0) & 15; es[q] = c0; eidx[hh * 16 + q] = wi1[aq] * 128 + i2b; }
        if (k1 >= pc) { int q = (n0 + mbcnt64(m1)) & 15; es[q] = c1; eidx[hh * 16 + q] = wi1[aq + 4] * 128 + i2b; }
        if (k2 >= pc) { int q = (n1 + mbcnt64(m2)) & 15; es[q] = c2; eidx[hh * 16 + q] = wi1[aq + 8] * 128 + i2b; }
        if (k3 >= pc) { int q = (n2 + mbcnt64(m3)) & 15; es[q] = c3; eidx[hh * 16 + q] = wi1[aq + 12] * 128 + i2b; }
      }
      __builtin_amdgcn_fence(__ATOMIC_ACQ_REL, "wavefront");
      __builtin_amdgcn_wave_barrier();
      float ts = es[lane & 15];
      float mx = row_max16(ts);
      float pe = __expf(ts - mx);
      float sm = row_sum16(pe);
      if (lane < 16) eg[hh * 16 + lane] = pe / sm;
      __builtin_amdgcn_fence(__ATOMIC_ACQ_REL, "wavefront");
      __builtin_amdgcn_wave_barrier();
    }
    int mb = T < 4096 ? 0 : 1 + ((T - 4096) >> 10);
    const float* md = p.MOD() + (size_t)(layer * 5 + mb) * 6144;
    float4 xv[4]; float ssx = 0.f;
#pragma unroll
    for (int i = 0; i < 4; i++) { xv[i] = *(const float4*)(p.X() + (size_t)T * 1024 + (i * 64 + lane) * 4); ssx += xv[i].x * xv[i].x + xv[i].y * xv[i].y + xv[i].z * xv[i].z + xv[i].w * xv[i].w; }
    ssx = wave_sum(ssx);
    float rstdx = rsqrtf(ssx * (1.f / 1024.f) + 1e-6f);
    float4 hv[4]; float hmax = 0.f;
#pragma unroll
    for (int i = 0; i < 4; i++) {
      int col = (i * 64 + lane) * 4;
      float4 g = *(const float4*)(gain + col), sh = *(const float4*)(md + 3 * 1024 + col), scl = *(const float4*)(md + 4 * 1024 + col);
      hv[i].x = xv[i].x * rstdx * g.x * (1.f + scl.x) + sh.x; hv[i].y = xv[i].y * rstdx * g.y * (1.f + scl.y) + sh.y;
      hv[i].z = xv[i].z * rstdx * g.z * (1.f + scl.z) + sh.z; hv[i].w = xv[i].w * rstdx * g.w * (1.f + scl.w) + sh.w;
      hmax = fmaxf(hmax, fmaxf(fmaxf(fabsf(hv[i].x), fabsf(hv[i].y)), fmaxf(fabsf(hv[i].z), fabsf(hv[i].w))));
    }
    hmax = wave_max_f(hmax);
    float hinv = hmax > 0.f ? 127.f / hmax : 0.f, hscale = hmax * (1.f / 127.f);
    int hq[4];
#pragma unroll
    for (int i = 0; i < 4; i++) {
      unsigned b0 = (unsigned)((int)rintf(hv[i].x * hinv)) & 255u, b1 = (unsigned)((int)rintf(hv[i].y * hinv)) & 255u;
      unsigned b2 = (unsigned)((int)rintf(hv[i].z * hinv)) & 255u, b3 = (unsigned)((int)rintf(hv[i].w * hinv)) & 255u;
      hq[i] = (int)(b0 | (b1 << 8) | (b2 << 16) | (b3 << 24));
    }
#define PLOAD8(SET, TBL, B0) _Pragma("unroll") for (int j = 0; j < 8; j++) { \
        int e_ = __builtin_amdgcn_readfirstlane(eidx[(B0) * 8 + j]); SET[j] = *(const u32x4*)(TBL + (size_t)e_ * 1024 + lane * 16); }
#define PDOT8(SET, B0) _Pragma("unroll") for (int j = 0; j < 8; j++) { \
        int d_ = __builtin_amdgcn_sdot4(hq[0], (int)SET[j][0], 0, false); d_ = __builtin_amdgcn_sdot4(hq[1], (int)SET[j][1], d_, false); \
        d_ = __builtin_amdgcn_sdot4(hq[2], (int)SET[j][2], d_, false); d_ = __builtin_amdgcn_sdot4(hq[3], (int)SET[j][3], d_, false); \
        float D_ = (float)wave_sum_i(d_); int e_ = (B0) * 8 + j; bool me_ = lane == (e_ & 63); \
        a0 = (me_ && e_ < 64) ? D_ : a0; a1 = (me_ && e_ >= 64) ? D_ : a1; }
#define PACC8(SET, B0) _Pragma("unroll") for (int j = 0; j < 8; j++) { \
        int e_ = (B0) * 8 + j; float w = rlane(e_ < 64 ? w0 : w1, e_ & 63); \
        acc[0] += w * ub0(SET[j][0]); acc[1] += w * ub1(SET[j][0]); acc[2] += w * ub2(SET[j][0]); acc[3] += w * ub3(SET[j][0]); \
        acc[4] += w * ub0(SET[j][1]); acc[5] += w * ub1(SET[j][1]); acc[6] += w * ub2(SET[j][1]); acc[7] += w * ub3(SET[j][1]); \
        acc[8] += w * ub0(SET[j][2]); acc[9] += w * ub1(SET[j][2]); acc[10] += w * ub2(SET[j][2]); acc[11] += w * ub3(SET[j][2]); \
        acc[12] += w * ub0(SET[j][3]); acc[13] += w * ub1(SET[j][3]); acc[14] += w * ub2(SET[j][3]); acc[15] += w * ub3(SET[j][3]); }
    float acc[16];
#pragma unroll
    for (int i = 0; i < 16; i++) acc[i] = 0.f;
    float a0 = 0.f, a1 = 0.f;
    u32x4 sa[8], sb[8];
    PLOAD8(sa, U, 0)
#pragma unroll 1
    for (int bi = 0; bi < 16; bi += 2) {
      PLOAD8(sb, U, bi + 1)
      PDOT8(sa, bi)
      if (bi + 2 < 16) { PLOAD8(sa, U, bi + 2) } else { PLOAD8(sa, V, 0) }
      PDOT8(sb, bi + 1)
    }
    int e0 = eidx[lane], e1 = eidx[lane + 64];
    float w0 = eg[lane] * gelu_tanh(a0 * (SU[e0] * hscale)) * SV[e0];
    float w1 = eg[lane + 64] * gelu_tanh(a1 * (SU[e1] * hscale)) * SV[e1];
    float wsum = wave_sum(w0 + w1);
#pragma unroll 1
    for (int bi = 0; bi < 16; bi += 2) {
      PLOAD8(sb, V, bi + 1)
      PACC8(sa, bi)
      if (bi + 2 < 16) { PLOAD8(sa, V, bi + 2) }
      PACC8(sb, bi + 1)
    }
    float x2[16]; float ss = 0.f;
#pragma unroll
    for (int i = 0; i < 4; i++) {
      int col = (i * 64 + lane) * 4;
      float4 ga = *(const float4*)(md + 5 * 1024 + col);
      x2[i * 4 + 0] = xv[i].x + ga.x * (acc[i * 4 + 0] - 128.f * wsum); x2[i * 4 + 1] = xv[i].y + ga.y * (acc[i * 4 + 1] - 128.f * wsum);
      x2[i * 4 + 2] = xv[i].z + ga.z * (acc[i * 4 + 2] - 128.f * wsum); x2[i * 4 + 3] = xv[i].w + ga.w * (acc[i * 4 + 3] - 128.f * wsum);
    }
#pragma unroll
    for (int i = 0; i < 16; i++) ss += x2[i] * x2[i];
    ss = wave_sum(ss);
    float rstd = rsqrtf(ss * (1.f / 1024.f) + 1e-6f);
    if (layer == 0) {
      const float* md1 = p.MOD() + (size_t)(5 + mb) * 6144;
#pragma unroll
      for (int i = 0; i < 4; i++) {
        int col = (i * 64 + lane) * 4;
        *(float4*)(p.X() + (size_t)T * 1024 + col) = make_float4(x2[i * 4], x2[i * 4 + 1], x2[i * 4 + 2], x2[i * 4 + 3]);
        float4 g = *(const float4*)(p.norm_mix + 1024 + col), sh = *(const float4*)(md1 + col), scl = *(const float4*)(md1 + 1024 + col);
        float y0 = x2[i * 4] * rstd * g.x * (1.f + scl.x) + sh.x, y1 = x2[i * 4 + 1] * rstd * g.y * (1.f + scl.y) + sh.y;
        float y2 = x2[i * 4 + 2] * rstd * g.z * (1.f + scl.z) + sh.z, y3 = x2[i * 4 + 3] * rstd * g.w * (1.f + scl.w) + sh.w;
        *(uint2*)(p.H() + (size_t)T * 1024 + col) = make_uint2(pack2(y0, y1), pack2(y2, y3));
      }
    } else {
#pragma unroll
      for (int i = 0; i < 4; i++) {
        int col = (i * 64 + lane) * 4;
        float4 g = *(const float4*)(p.norm_final + col);
        *(float4*)(p.out + (size_t)T * 1024 + col) = make_float4(x2[i * 4] * rstd * g.x, x2[i * 4 + 1] * rstd * g.y, x2[i * 4 + 2] * rstd * g.z, x2[i * 4 + 3] * rstd * g.w);
      }
    }
  }
}

#define XB_TMO      128
#define XB_XCNT(j)  (256  + 64 * (j))
#define XB_XSUB(j)  (1280 + 64 * (j))
#define XB_XGEN(j)  (2304 + 64 * (j))
#define XB_TOP      3328
#define XB_TOPGEN   3392
#define XCD_BAR_WORDS 3456
#define XB_SPIN_CAP (1u << 20)
#define LAS __attribute__((address_space(3)))
DEV unsigned xb_ld(unsigned* p)              { return __hip_atomic_load(p, __ATOMIC_RELAXED, __HIP_MEMORY_SCOPE_AGENT); }
DEV unsigned xb_add(unsigned* p, unsigned v) { return __hip_atomic_fetch_add(p, v, __ATOMIC_RELAXED, __HIP_MEMORY_SCOPE_AGENT); }
DEV unsigned xb_xcc_id() { return (unsigned)__builtin_amdgcn_s_getreg((3 << 11) | 20) & 0xFu; }
#define XB_SPIN(cond, bar) do { unsigned _sp = 0; while (cond) { __builtin_amdgcn_s_sleep(4); \
    if ((++_sp & 255u) == 0u) { if (xb_ld(&(bar)[XB_TMO])) break; if (_sp > XB_SPIN_CAP) { atomicAdd(&(bar)[XB_TMO], 1u); break; } } } } while (0)
struct XcdBarrier { unsigned* bar; unsigned x; volatile LAS unsigned* st; };
DEV XcdBarrier xcd_barrier_post(unsigned* bar, volatile LAS unsigned* st) {
  XcdBarrier b; b.bar = bar; b.x = xb_xcc_id(); b.st = st;
  if (threadIdx.x == 0) (void)xb_add(&bar[XB_XCNT(b.x)], 1u);
  return b;
}
DEV void xcd_barrier_complete(unsigned* bar, unsigned x, unsigned& nloc, unsigned& nx) {
  const unsigned G = gridDim.x * gridDim.y * gridDim.z;
  unsigned sum, cnt, mine, sp = 0u;
  for (;;) {
    sum = 0u; cnt = 0u; mine = 0u;
#pragma unroll
    for (unsigned j = 0; j < 16; ++j) { const unsigned c = xb_ld(&bar[XB_XCNT(j)]); sum += c; cnt += (c > 0u) ? 1u : 0u; mine = (j == x) ? c : mine; }
    if (sum == G) break;
    __builtin_amdgcn_s_sleep(1);
    if ((++sp & 255u) == 0u) { if (xb_ld(&bar[XB_TMO])) break; if (sp > XB_SPIN_CAP) { atomicAdd(&bar[XB_TMO], 1u); break; } }
  }
  nloc = mine > 0u ? mine : 1u; nx = cnt > 0u ? cnt : 1u;
}
DEV void xcd_barrier(const XcdBarrier& b) {
  asm volatile("s_waitcnt vmcnt(0)" ::: "memory");
  __syncthreads();
  if (threadIdx.x == 0) {
    unsigned* bar = b.bar;
    __builtin_amdgcn_s_waitcnt(0);
    unsigned nloc = b.st[0], nx = b.st[1];
    if (nloc == 0u) { xcd_barrier_complete(bar, b.x, nloc, nx); b.st[0] = nloc; b.st[1] = nx; }
    const unsigned old = xb_add(&bar[XB_XSUB(b.x)], 1u);
    const unsigned gen = old / nloc;
    if (old + 1u == (gen + 1u) * nloc) {
      __builtin_amdgcn_fence(__ATOMIC_RELEASE, "agent");
      asm volatile("s_waitcnt vmcnt(0)" ::: "memory");
      const unsigned og = xb_add(&bar[XB_TOP], 1u);
      const unsigned tg = og / nx;
      if (og + 1u == (tg + 1u) * nx) xb_add(&bar[XB_TOPGEN], 1u);
      else XB_SPIN(xb_ld(&bar[XB_TOPGEN]) == tg, bar);
      __builtin_amdgcn_fence(__ATOMIC_ACQUIRE, "agent");
      xb_add(&bar[XB_XGEN(b.x)], 1u);
      asm volatile("s_waitcnt vmcnt(0)" ::: "memory");
    } else {
      XB_SPIN(xb_ld(&bar[XB_XGEN(b.x)]) == gen, bar);
      __builtin_amdgcn_fence(__ATOMIC_ACQUIRE, "agent");
      asm volatile("s_waitcnt vmcnt(0)" ::: "memory");
    }
  }
  __syncthreads();
}

constexpr int NPHASE = 14;
DEV void run_phase(const Params& p, int ph, int bid, int nb, char* smem) {
  switch (ph) {
    case 0: phase_prep(p, bid, nb, smem); break;
    case 1: phase_ada(p, 0, p.norm_mix, 0, 1, true, bid, nb); break;
    case 2: {
      gemm_phase(p.H(), 1024, p.WT_EVIN(), 1024, 1024, 64, 22, bid, nb, smem, [&](int m0, int n0, const float* Cs) { epi_inproj0(p, m0, n0, Cs); });
      int first = 0, cnt = nb;
      if ((nb & 7) == 0) { int slots = nb >> 3, rem = (8 * 22) % slots; if (rem > 0) { first = rem * 8; cnt = nb - first; } }
      int me = bid - first;
      __syncthreads();
      if (me >= 0) {
        float* sm = (float*)smem;
        for (int j = me; j < 1344; j += cnt) {
          if (j < 576) prep_transpose(p.od_w_in, 2304, p.WT_ODIN(), j, sm);
          else if (j < 832) prep_transpose(p.od_w_out, 1024, p.WT_ODOUT(), j - 576, sm);
          else prep_transpose(p.peer_wq + (size_t)1024 * 2048, 2048, p.WT_PQ() + (size_t)2048 * 1024, j - 832, sm);
        }
      }
    } break;
    case 3: phase_attn0(p, bid, nb, smem); break;
    case 4: gemm_phase(p.MIX(), 1024, p.WT_EVOUT(), 1024, 1024, 64, 8, bid, nb, smem, [&](int m0, int n0, const float* Cs) { epi_outproj(p, 0, m0, n0, Cs); }); break;
    case 5: phase_ada(p, 0, p.norm_ffn, 3, 4, false, bid, nb); break;
    case 11: phase_ada(p, 1, p.norm_ffn + 1024, 3, 4, false, bid, nb); break;
    case 6: case 12: {
      int layer = ph == 6 ? 0 : 1;
      const u16* sk = p.SUBK() + (size_t)layer * 16 * 128 * 128;
      int qkey = ((bid >> 8) ^ bid) & 1;
      auto quant_l0 = [&]() {
        for (int j = bid; j < 2048; j += nb) {
          if (j < 1024) prep_quant<true>(p.peer_u, p.U8(), p.SU(), j * 16); else prep_quant<false>(p.peer_v, p.V8(), p.SV(), (j - 1024) * 16);
        }
      };
      if (layer == 0 && qkey == 0) quant_l0();
      gemm_phase(p.H(), 1024, p.WT_PQ() + (size_t)layer * 2048 * 1024, 1024, 1024, 64, 16, bid, nb, smem, [&](int m0, int n0, const float* Cs) {
        int lane = threadIdx.x & 63, wave = threadIdx.x >> 6;
#pragma unroll 8
        for (int rr = wave; rr < 128; rr += 4) {
          float2 c = *(const float2*)(Cs + rr * 128 + lane * 2);
          *(unsigned*)(p.PQ() + (size_t)(m0 + rr) * 2048 + n0 + lane * 2) = pack2(c.x, c.y);
        }
        asm volatile("s_waitcnt vmcnt(0)" ::: "memory");
        __syncthreads();
        int hc = n0 >> 7;
        f32x16 acc[2][2];
        zero16(acc[0][0]); zero16(acc[0][1]); zero16(acc[1][0]); zero16(acc[1][1]);
        gemm_tile(p.PQ() + (size_t)m0 * 2048 + hc * 128, 2048, sk + (size_t)hc * 128 * 128, 128, 128, smem, acc);
        const float* Cs2 = (const float*)smem;
#pragma unroll 8
        for (int rr = wave; rr < 128; rr += 4) {
          float2 c = *(const float2*)(Cs2 + rr * 128 + lane * 2);
          *(unsigned*)((u16*)p.SC() + (size_t)(m0 + rr) * 2048 + hc * 128 + lane * 2) = pack2(c.x, c.y);
        }
      });
      if (layer == 0 && qkey == 1) quant_l0();
    } break;
    case 7: phase_peer(p, 0, bid, nb, smem); break;
    case 13: phase_peer(p, 1, bid, nb, smem); break;
    case 8: {
      gemm_phase(p.H(), 1024, p.WT_ODIN(), 1024, 1024, 64, 18, bid, nb, smem, [&](int m0, int n0, const float* Cs) { epi_inproj1(p, m0, n0, Cs); });
      int first = 0, cnt = nb;
      if ((nb & 7) == 0) { int slots = nb >> 3, rem = (8 * 18) % slots; if (rem > 0) { first = rem * 8; cnt = nb - first; } }
      int me = ((nb & 7) == 0) ? ((bid >> 3) * 8 + (bid & 7)) - first : bid;
      if (me >= 0) {
        for (int j = me; j < 2048; j += cnt) {
          if (j < 1024) prep_quant<true>(p.peer_u, p.U8(), p.SU(), 16384 + j * 16); else prep_quant<false>(p.peer_v, p.V8(), p.SV(), 16384 + (j - 1024) * 16);
        }
      }
    } break;
    case 9: phase_attn1(p, bid, nb, smem); break;
    case 10: gemm_phase(p.MIX(), 1024, p.WT_ODOUT(), 1024, 1024, 64, 8, bid, nb, smem, [&](int m0, int n0, const float* Cs) { epi_outproj(p, 1, m0, n0, Cs); }); break;
    default: break;
  }
}

constexpr size_t PARAMS_OFF = 330036736ull;
template <int PH> DEV void run_all(const Params& p, cg::grid_group& grid, const XcdBarrier& xb, char* smem) {
  if constexpr (PH == 0) {
    if (blockIdx.x == 0 && threadIdx.x < sizeof(Params) / 8) ((unsigned long long*)(p.ws + PARAMS_OFF))[threadIdx.x] = ((const unsigned long long*)&p)[threadIdx.x];
    run_phase(p, PH, blockIdx.x, gridDim.x, smem);
  } else {
    run_phase(p, PH, blockIdx.x, gridDim.x, smem);
  }
  if constexpr (PH + 1 < NPHASE) {
    if (PH == 0 && p.ws == nullptr) grid.sync();
    xcd_barrier(xb);
    run_all<PH + 1>(p, grid, xb, smem);
  }
}
__global__ void __launch_bounds__(256, 2) mega_kernel(Params p) {
  __shared__ __attribute__((aligned(16))) char smem[77824];
  __shared__ uint4 xb_words;
  if (threadIdx.x == 0) xb_words = make_uint4(0u, 0u, 0u, 0u);
  __syncthreads();
  XcdBarrier xb = xcd_barrier_post(p.BAR(), (volatile LAS unsigned*)&xb_words);
  cg::grid_group grid = cg::this_grid();
  run_all<0>(p, grid, xb, smem);
}
#if MULTI_LAUNCH
template <int PH> __global__ void __launch_bounds__(256, 2) phase_kernel(Params p) {
  __shared__ __attribute__((aligned(16))) char smem[77824];
  run_phase(p, PH, blockIdx.x, gridDim.x, smem);
}
template <int PH> static void launch_all(const Params& p, int grid, hipStream_t s) {
  phase_kernel<PH><<<grid, 256, 0, s>>>(p);
  if constexpr (PH + 1 < NPHASE) launch_all<PH + 1>(p, grid, s);
}
#endif

extern "C" void kernel_launch(void* const* d_in, const int* in_sizes, int n_in, void* d_out, int out_size, void* d_ws, size_t ws_size, hipStream_t stream) {
  Params p{};
  const float* const* in = (const float* const*)d_in;
  p.xp = in[0]; p.xs = in[1]; p.c = in[2]; p.cctx = in[3]; p.cak = in[4]; p.cav = in[5]; p.srf = in[6]; p.srb = in[7];
  p.cck = in[8]; p.ccv = in[9]; p.cdk = in[10]; p.cdv = in[11];
  p.mod_w = in[12]; p.mod_b = in[13]; p.norm_mix = in[14]; p.norm_ffn = in[15]; p.norm_final = in[16];
  p.ev_w_in = in[17]; p.ev_w_out = in[18]; p.a_q_norm = in[19]; p.a_k_norm = in[20]; p.rdf = in[21]; p.rdb = in[22];
  p.od_w_in = in[23]; p.od_w_out = in[24]; p.lq1 = in[25]; p.lk1 = in[26]; p.lq2 = in[27]; p.lk2 = in[28]; p.subln = in[29]; p.dsink = in[30];
  p.peer_wq = in[31]; p.peer_sk = in[32]; p.peer_u = in[33]; p.peer_v = in[34];
  p.out = (float*)d_out;
  p.ws = (char*)d_ws;
  (void)in_sizes; (void)n_in; (void)out_size; (void)ws_size;
#if MULTI_LAUNCH
  launch_all<0>(p, 512, stream);
#else
  static int grid_blocks = 0;
  if (!grid_blocks) {
    int dev = 0, cus = 0, per_cu = 0;
    hipGetDevice(&dev);
    hipDeviceGetAttribute(&cus, hipDeviceAttributeMultiprocessorCount, dev);
    hipOccupancyMaxActiveBlocksPerMultiprocessor(&per_cu, mega_kernel, 256, 0);
    if (per_cu > 2) per_cu = 2;
    if (per_cu < 1) per_cu = 1;
    grid_blocks = cus * per_cu;
  }
  (void)hipMemsetAsync(d_ws, 0, XCD_BAR_WORDS * 4, stream);
  void* args[] = {&p};
  hipError_t e = hipLaunchCooperativeKernel((void*)mega_kernel, dim3(grid_blocks), dim3(256), args, 0, stream);
  if (e != hipSuccess) fprintf(stderr, "cooperative launch failed: %s (grid %d)\n", hipGetErrorString(e), grid_blocks);
#endif
}
```
